# Optimizing an MI355X kernel written in HIP

```python
import math
import jax
import jax.numpy as jnp
from jax import lax
import numpy as np

D_MODEL = 4096
BATCH = 1
SEQ = 16384
DEPTH = 4

N_MIXERS = 3
ATTN_BLOCK = 128
MASK_VALUE = -1e30
NORM_EPS = 1e-6
SWA_Q_HEADS = 64
SWA_KV_HEADS = 8
SWA_HEAD_DIM = D_MODEL // SWA_Q_HEADS
SWA_GROUP = SWA_Q_HEADS // SWA_KV_HEADS
WINDOW = 128
ROPE_THETA = 500000.0
ROPE_DIM = SWA_HEAD_DIM // 4
FOX_HEADS = 32
FOX_HEAD_DIM = D_MODEL // FOX_HEADS
S5_GROUP = 16
S5_GROUPS = D_MODEL // S5_GROUP
S5_STATE = 64
S5_CHUNK = 128
S5_DT_MIN = 1e-3
S5_DT_MAX = 1e-1
S5_MAX_RE = -1e-4
D_FF = 256 * ((8 * D_MODEL // 3 + 255) // 256)
CONV_WIDTH = 3

kernel_name = 'hybrid_swa_fox_s5_convffn'


def _rms_norm(x, g):
    xf = x.astype(jnp.float32)
    y = xf * lax.rsqrt(jnp.mean(xf * xf, axis=-1, keepdims=True) + NORM_EPS)
    return (y * g.astype(jnp.float32)).astype(x.dtype)


def _partial_rope(t, pos):
    half = ROPE_DIM // 2
    inv_freq = jnp.exp(-math.log(ROPE_THETA) * jnp.arange(half, dtype=jnp.float32) * (2.0 / ROPE_DIM))
    ang = pos.astype(jnp.float32)[:, None] * inv_freq[None, :]
    cos = jnp.cos(ang)[None, :, None, :]
    sin = jnp.sin(ang)[None, :, None, :]
    tr = t[..., :ROPE_DIM].astype(jnp.float32)
    t1, t2 = tr[..., :half], tr[..., half:]
    rot = jnp.concatenate([t1 * cos - t2 * sin, t2 * cos + t1 * sin], axis=-1).astype(t.dtype)
    return jnp.concatenate([rot, t[..., ROPE_DIM:]], axis=-1)


def _swa_mixer(h, w_qkv, b_qkv, sinks, w_o, b_o):
    b, l, _ = h.shape
    nb = l // ATTN_BLOCK
    qw = SWA_Q_HEADS * SWA_HEAD_DIM
    kvw = SWA_KV_HEADS * SWA_HEAD_DIM
    qkv = h @ w_qkv + b_qkv
    q = qkv[..., :qw].reshape(b, l, SWA_Q_HEADS, SWA_HEAD_DIM)
    k = qkv[..., qw:qw + kvw].reshape(b, l, SWA_KV_HEADS, SWA_HEAD_DIM)
    v = qkv[..., qw + kvw:].reshape(b, l, SWA_KV_HEADS, SWA_HEAD_DIM)
    pos = jnp.arange(l)
    q = _partial_rope(q, pos)
    k = _partial_rope(k, pos)
    qb = q.reshape(b, nb, ATTN_BLOCK, SWA_KV_HEADS, SWA_GROUP, SWA_HEAD_DIM)

    def band(t):
        tb = t.reshape(b, nb, ATTN_BLOCK, SWA_KV_HEADS, SWA_HEAD_DIM)
        prev = jnp.pad(tb[:, :-1], ((0, 0), (1, 0), (0, 0), (0, 0), (0, 0)))
        return jnp.concatenate([prev, tb], axis=2)

    kb, vb = band(k), band(v)
    s = jnp.einsum('bnqhgd,bnkhd->bnhgqk', qb, kb).astype(jnp.float32) * (SWA_HEAD_DIM ** -0.5)
    qi = jnp.arange(ATTN_BLOCK)[:, None]
    kj = jnp.arange(2 * ATTN_BLOCK)[None, :]
    rel = qi + ATTN_BLOCK - kj
    kpos = (jnp.arange(nb)[:, None, None] - 1) * ATTN_BLOCK + kj[None]
    valid = (rel >= 0) & (rel < WINDOW) & (kpos >= 0)
    s = jnp.where(valid[None, :, None, None], s, MASK_VALUE)
    sink = sinks.astype(jnp.float32).reshape(1, 1, SWA_KV_HEADS, SWA_GROUP, 1, 1)
    sink = jnp.broadcast_to(sink, s.shape[:-1] + (1,))
    p = jax.nn.softmax(jnp.concatenate([s, sink], axis=-1), axis=-1)[..., :-1]
    o = jnp.einsum('bnhgqk,bnkhd->bnqhgd', p.astype(vb.dtype), vb).reshape(b, l, qw)
    return o @ w_o + b_o


def _fox_mixer(h, w_qkvf, b_f, w_o):
    b, l, _ = h.shape
    nb = l // ATTN_BLOCK
    hw = FOX_HEADS * FOX_HEAD_DIM
    proj = h @ w_qkvf

    def heads(t):
        return t.reshape(b, l, FOX_HEADS, FOX_HEAD_DIM).transpose(0, 2, 1, 3)

    q = heads(proj[..., :hw])
    k = heads(proj[..., hw:2 * hw])
    v = heads(proj[..., 2 * hw:3 * hw])
    log_f = jax.nn.log_sigmoid(proj[..., 3 * hw:].astype(jnp.float32) + b_f.astype(jnp.float32))
    cum = jnp.cumsum(log_f, axis=1).transpose(0, 2, 1)
    q_blocks = q.reshape(b, FOX_HEADS, nb, ATTN_BLOCK, FOX_HEAD_DIM).transpose(2, 0, 1, 3, 4)
    cum_blocks = cum.reshape(b, FOX_HEADS, nb, ATTN_BLOCK).transpose(2, 0, 1, 3)
    kpos = jnp.arange(l)
    scale = FOX_HEAD_DIM ** -0.5

    def one_block(args):
        qb, cq, n = args
        s = jnp.einsum('bhqd,bhkd->bhqk', qb, k).astype(jnp.float32) * scale
        s = s + cq[..., :, None] - cum[:, :, None, :]
        qpos = n * ATTN_BLOCK + jnp.arange(ATTN_BLOCK)
        s = jnp.where(kpos[None, :] <= qpos[:, None], s, MASK_VALUE)
        p = jax.nn.softmax(s, axis=-1)
        return jnp.einsum('bhqk,bhkd->bhqd', p.astype(v.dtype), v)

    o = lax.map(one_block, (q_blocks, cum_blocks, jnp.arange(nb)))
    o = o.transpose(1, 0, 3, 2, 4).reshape(b, l, hw)
    return o @ w_o


def _ssm_combine(e1, e2):
    a1, b1 = e1
    a2, b2 = e2
    return a1 * a2, a2 * b1 + b2


def _s5_mixer(h, lam_re, lam_im, log_dt, b_re, b_im, c_re, c_im, d, w_glu, b_glu):
    b, l, _ = h.shape
    f32 = jnp.float32
    nc = l // S5_CHUNK
    lam = lax.complex(jnp.minimum(lam_re.astype(f32), S5_MAX_RE), lam_im.astype(f32))
    dt = jnp.exp(log_dt.astype(f32))[:, None]
    lam_bar = jnp.exp(lam * dt)
    bmat = lax.complex(b_re.astype(f32), b_im.astype(f32))
    b_bar = ((lam_bar - 1.0) / lam)[..., None] * bmat
    cmat = lax.complex(c_re.astype(f32), c_im.astype(f32))
    u = h.astype(f32).reshape(b, nc, S5_CHUNK, S5_GROUPS, S5_GROUP).transpose(1, 0, 2, 3, 4)
    a_elems = jnp.broadcast_to(lam_bar, (b, S5_CHUNK, S5_GROUPS, S5_STATE))

    def chunk_step(state, u_c):
        bu = jnp.einsum('btgh,gph->btgp', u_c.astype(jnp.complex64), b_bar)
        bu = bu.at[:, 0].add(lam_bar * state)
        _, xs = lax.associative_scan(_ssm_combine, (a_elems, bu), axis=1)
        y = jnp.einsum('btgp,ghp->btgh', xs, cmat).real
        return xs[:, -1], y

    init = jnp.zeros((b, S5_GROUPS, S5_STATE), jnp.complex64)
    _, y = lax.scan(chunk_step, init, u)
    y = y.transpose(1, 0, 2, 3, 4).reshape(b, l, D_MODEL) + d.astype(f32) * h.astype(f32)
    g = jax.nn.gelu(y).astype(h.dtype)
    z = g @ w_glu + b_glu
    return z[..., :D_MODEL] * jax.nn.sigmoid(z[..., D_MODEL:])


def _conv_ffn(h, w_in, conv_w, conv_b, w_out):
    l = h.shape[1]
    z = h @ w_in
    zp = jnp.pad(z, ((0, 0), (CONV_WIDTH - 1, 0), (0, 0)))
    zc = conv_b + conv_w[CONV_WIDTH - 1] * z
    for j in range(CONV_WIDTH - 1):
        zc = zc + conv_w[j] * zp[:, j:j + l]
    gate, up = zc[..., :D_FF], zc[..., D_FF:]
    return (jax.nn.gelu(gate, approximate=True) * up) @ w_out


def _normal(key, shape, scale):
    return jax.random.normal(key, shape, jnp.float32) * scale


def _gain(key):
    return 1.0 + _normal(key, (D_MODEL,), 0.1)


def _swa_params(key):
    k = jax.random.split(key, 5)
    qw = SWA_Q_HEADS * SWA_HEAD_DIM
    qkv_w = qw + 2 * SWA_KV_HEADS * SWA_HEAD_DIM
    return [('swa_w_qkv', _normal(k[0], (D_MODEL, qkv_w), D_MODEL ** -0.5)),
            ('swa_b_qkv', _normal(k[1], (qkv_w,), 0.01)),
            ('swa_sinks', _normal(k[2], (SWA_Q_HEADS,), 1.0)),
            ('swa_w_o', _normal(k[3], (qw, D_MODEL), qw ** -0.5)),
            ('swa_b_o', _normal(k[4], (D_MODEL,), 0.01))]


def _fox_params(key):
    k = jax.random.split(key, 3)
    hw = FOX_HEADS * FOX_HEAD_DIM
    return [('fox_w_qkvf', _normal(k[0], (D_MODEL, 3 * hw + FOX_HEADS), D_MODEL ** -0.5)),
            ('fox_b_f', jax.random.uniform(k[1], (FOX_HEADS,), jnp.float32, 1.0, 5.0)),
            ('fox_w_o', _normal(k[2], (hw, D_MODEL), hw ** -0.5))]


def _s5_params(key):
    k = jax.random.split(key, 10)
    n = jnp.arange(S5_STATE, dtype=jnp.float32)[None, :]
    return [('s5_lambda_re', -0.5 + _normal(k[0], (S5_GROUPS, S5_STATE), 0.01)),
            ('s5_lambda_im', math.pi * n + _normal(k[1], (S5_GROUPS, S5_STATE), 0.01)),
            ('s5_log_dt', jax.random.uniform(k[2], (S5_GROUPS,), jnp.float32, math.log(S5_DT_MIN), math.log(S5_DT_MAX))),
            ('s5_b_re', _normal(k[3], (S5_GROUPS, S5_STATE, S5_GROUP), (2 * S5_GROUP) ** -0.5)),
            ('s5_b_im', _normal(k[4], (S5_GROUPS, S5_STATE, S5_GROUP), (2 * S5_GROUP) ** -0.5)),
            ('s5_c_re', _normal(k[5], (S5_GROUPS, S5_GROUP, S5_STATE), S5_STATE ** -0.5)),
            ('s5_c_im', _normal(k[6], (S5_GROUPS, S5_GROUP, S5_STATE), S5_STATE ** -0.5)),
            ('s5_d', _normal(k[7], (D_MODEL,), 1.0)),
            ('s5_w_glu', _normal(k[8], (D_MODEL, 2 * D_MODEL), D_MODEL ** -0.5)),
            ('s5_b_glu', _normal(k[9], (2 * D_MODEL,), 0.01))]


def _ffn_params(key):
    k = jax.random.split(key, 4)
    return [('ffn_w_in', _normal(k[0], (D_MODEL, 2 * D_FF), D_MODEL ** -0.5)),
            ('ffn_conv_w', _normal(k[1], (CONV_WIDTH, 2 * D_FF), CONV_WIDTH ** -0.5)),
            ('ffn_conv_b', _normal(k[2], (2 * D_FF,), 0.01)),
            ('ffn_w_out', _normal(k[3], (D_FF, D_MODEL), D_FF ** -0.5))]


def setup_inputs(seed: int = 0) -> dict:
    key = jax.random.key(seed)
    keys = jax.random.split(key, DEPTH + 1)
    builders = (_swa_params, _fox_params, _s5_params)
    params = {'x': jax.random.normal(keys[0], (BATCH, SEQ, D_MODEL), jnp.float32)}
    for i in range(DEPTH):
        kl = jax.random.split(keys[i + 1], 6)
        p = f'l{i}_'
        params[p + 'mix_pre_g'] = _gain(kl[0])
        for name, arr in builders[i % N_MIXERS](kl[1]):
            params[p + name] = arr
        params[p + 'mix_post_g'] = _gain(kl[2])
        params[p + 'ffn_pre_g'] = _gain(kl[3])
        for name, arr in _ffn_params(kl[4]):
            params[p + name] = arr
        params[p + 'ffn_post_g'] = _gain(kl[5])
    return params


def reference(x,
              l0_mix_pre_g, l0_swa_w_qkv, l0_swa_b_qkv, l0_swa_sinks, l0_swa_w_o, l0_swa_b_o, l0_mix_post_g,
              l0_ffn_pre_g, l0_ffn_w_in, l0_ffn_conv_w, l0_ffn_conv_b, l0_ffn_w_out, l0_ffn_post_g,
              l1_mix_pre_g, l1_fox_w_qkvf, l1_fox_b_f, l1_fox_w_o, l1_mix_post_g,
              l1_ffn_pre_g, l1_ffn_w_in, l1_ffn_conv_w, l1_ffn_conv_b, l1_ffn_w_out, l1_ffn_post_g,
              l2_mix_pre_g, l2_s5_lambda_re, l2_s5_lambda_im, l2_s5_log_dt, l2_s5_b_re, l2_s5_b_im,
              l2_s5_c_re, l2_s5_c_im, l2_s5_d, l2_s5_w_glu, l2_s5_b_glu, l2_mix_post_g,
              l2_ffn_pre_g, l2_ffn_w_in, l2_ffn_conv_w, l2_ffn_conv_b, l2_ffn_w_out, l2_ffn_post_g,
              l3_mix_pre_g, l3_swa_w_qkv, l3_swa_b_qkv, l3_swa_sinks, l3_swa_w_o, l3_swa_b_o, l3_mix_post_g,
              l3_ffn_pre_g, l3_ffn_w_in, l3_ffn_conv_w, l3_ffn_conv_b, l3_ffn_w_out, l3_ffn_post_g):
    layers = (
        (l0_mix_pre_g, (l0_swa_w_qkv, l0_swa_b_qkv, l0_swa_sinks, l0_swa_w_o, l0_swa_b_o), l0_mix_post_g,
         l0_ffn_pre_g, (l0_ffn_w_in, l0_ffn_conv_w, l0_ffn_conv_b, l0_ffn_w_out), l0_ffn_post_g),
        (l1_mix_pre_g, (l1_fox_w_qkvf, l1_fox_b_f, l1_fox_w_o), l1_mix_post_g,
         l1_ffn_pre_g, (l1_ffn_w_in, l1_ffn_conv_w, l1_ffn_conv_b, l1_ffn_w_out), l1_ffn_post_g),
        (l2_mix_pre_g, (l2_s5_lambda_re, l2_s5_lambda_im, l2_s5_log_dt, l2_s5_b_re, l2_s5_b_im,
                        l2_s5_c_re, l2_s5_c_im, l2_s5_d, l2_s5_w_glu, l2_s5_b_glu), l2_mix_post_g,
         l2_ffn_pre_g, (l2_ffn_w_in, l2_ffn_conv_w, l2_ffn_conv_b, l2_ffn_w_out), l2_ffn_post_g),
        (l3_mix_pre_g, (l3_swa_w_qkv, l3_swa_b_qkv, l3_swa_sinks, l3_swa_w_o, l3_swa_b_o), l3_mix_post_g,
         l3_ffn_pre_g, (l3_ffn_w_in, l3_ffn_conv_w, l3_ffn_conv_b, l3_ffn_w_out), l3_ffn_post_g),
    )
    mixers = (_swa_mixer, _fox_mixer, _s5_mixer)
    h = x
    for i in range(DEPTH):
        mix_pre, mix_params, mix_post, ffn_pre, ffn_params, ffn_post = layers[i]
        h = h + _rms_norm(mixers[i % N_MIXERS](_rms_norm(h, mix_pre), *mix_params), mix_post)
        h = h + _rms_norm(_conv_ffn(_rms_norm(h, ffn_pre), *ffn_params), ffn_post)
    return h
```

```cpp
#include <hip/hip_runtime.h>
#include <cstdio>
#include <cstdint>
#include <cmath>

#ifndef MK_SPLIT_LAUNCHES
#define MK_SPLIT_LAUNCHES 0
#endif

__device__ __forceinline__ int mk_tid() { int t = threadIdx.x; asm volatile("" : "+v"(t)); return t; }
__device__ __forceinline__ int launder_s(int v) { asm volatile("" : "+s"(v)); return v; }

#ifndef REP_PRO
#define REP_PRO 1
#endif
#ifndef REP_FFN1
#define REP_FFN1 1
#endif
#ifndef REP_FFN2
#define REP_FFN2 1
#endif
#ifndef REP_NORM
#define REP_NORM 1
#endif
#ifndef REP_BAR
#define REP_BAR 1
#endif
#ifndef REP_FOX
#define REP_FOX 1
#endif
#ifndef REP_MIXG
#define REP_MIXG 1
#endif
#ifndef REP_MIX
#define REP_MIX 1
#endif

namespace pg8 {
#define PG8_LAS __attribute__((address_space(3)))
typedef unsigned short bf16_t;
typedef short bf16x8 __attribute__((ext_vector_type(8)));
typedef float f32x4 __attribute__((ext_vector_type(4)));
typedef unsigned u32x4 __attribute__((ext_vector_type(4)));
typedef unsigned u32x2 __attribute__((ext_vector_type(2)));
constexpr int BM = 256, BK = 64, HALF = 128, HTB = HALF * BK * 2  , STAGE_BYTES = 8 * HTB, NXCD = 8, WGM = 8;

__host__ __device__ __forceinline__ int lds_byte(int r, int c) { const int st = (r >> 4) * 2 + (c >> 5), rr = r & 15, cc = c & 31, ob = rr * 64 + cc * 2; return st * 1024 + (ob ^ (((ob >> 9) & 1) << 5)); }
__host__ __device__ __forceinline__ void stage_rc(int b, int& R, int& C) { const int st = b / 1024, sb = b % 1024, swz = sb ^ (((sb >> 9) & 1) << 5); R = (st >> 1) * 16 + swz / 64; C = (st & 1) * 32 + (swz % 64) / 2; }
__host__ __device__ __forceinline__ int perm32(int rho) { const int n = rho >> 4, i = rho & 15; return 8 * (i >> 2) + 4 * n + (i & 3); }

struct Unit { int pm, pn; };
struct Gemm { const bf16_t* A; const bf16_t* Bt; int M, N, K; int apr = 256; };

struct StaticOrder {
    int nM, nN, nwg, G, c;
    __host__ __device__ void init(int M, int N, int G_, int c_) { nM = M / BM; nN = N / BM; nwg = nM * nN; G = G_; c = c_; }
    __host__ __device__ bool next(int i, Unit& u) const {
        const long L = (long)i * G + c; if (L >= nwg) return false;
        int wgid = (int)L; { const int q = nwg / NXCD, r = nwg % NXCD, xcd = wgid % NXCD, off = wgid / NXCD; wgid = (xcd < r ? xcd * (q + 1) : r * (q + 1) + (xcd - r) * q) + off; }
        const int nig = WGM * nN, gid = wgid / nig, fm = gid * WGM, gsz = (nM - fm) < WGM ? (nM - fm) : WGM;
        u.pm = fm + ((wgid % nig) % gsz); u.pn = (wgid % nig) / gsz; return true;
    }
    __device__ __forceinline__ void a_ready(const Unit&) const {}
    __device__ __forceinline__ void done(const Unit&) const {}
};

__device__ __forceinline__ unsigned cvt_pk_bf16(float lo, float hi) { unsigned r; asm volatile("v_cvt_pk_bf16_f32 %0, %1, %2" : "=v"(r) : "v"(lo), "v"(hi)); return r; }

struct EpiF32B {
    static constexpr bool PERM = false, AFTER_DRAIN = false, APERM = false;
    float* C; int ldc; const float* bias;
    __device__ __forceinline__ void operator()(const f32x4 (&acc)[2][2][4][2], const Unit& u, int wr, int wc, int fr, int fq) const {
        const int row0 = u.pm * BM + wr * 64 + fr, col0 = u.pn * BM + wc * 32 + 4 * fq;
        f32x4 bv[2][2];
#pragma unroll
        for (int bj = 0; bj < 2; ++bj)
#pragma unroll
            for (int n = 0; n < 2; ++n) bv[bj][n] = bias ? *(const f32x4*)(bias + col0 + bj * HALF + n * 16) : (f32x4){0.f, 0.f, 0.f, 0.f};
#pragma unroll
        for (int ai = 0; ai < 2; ++ai)
#pragma unroll
            for (int m = 0; m < 4; ++m) { float* rowp = C + (size_t)(row0 + ai * HALF + m * 16) * ldc + col0;
#pragma unroll
                for (int bj = 0; bj < 2; ++bj)
#pragma unroll
                    for (int n = 0; n < 2; ++n) *(f32x4*)(rowp + bj * HALF + n * 16) = acc[ai][bj][m][n] + bv[bj][n]; }
    }
};
struct EpiBf16B {
    static constexpr bool PERM = true, AFTER_DRAIN = false, APERM = false;
    bf16_t* O; int ldc; const float* bias;
    __device__ __forceinline__ void operator()(const f32x4 (&acc)[2][2][4][2], const Unit& u, int wr, int wc, int fr, int fq) const {
        const int row0 = u.pm * BM + wr * 64 + fr; const int col0 = u.pn * BM + wc * 32 + 8 * fq;
        f32x4 bv[2][2];
#pragma unroll
        for (int bj = 0; bj < 2; ++bj)
#pragma unroll
            for (int n = 0; n < 2; ++n) bv[bj][n] = bias ? *(const f32x4*)(bias + col0 + bj * HALF + 4 * n) : (f32x4){0.f, 0.f, 0.f, 0.f};
#pragma unroll
        for (int ai = 0; ai < 2; ++ai)
#pragma unroll
            for (int m = 0; m < 4; ++m) { bf16_t* rowp = O + (size_t)(row0 + ai * HALF + m * 16) * ldc + col0;
#pragma unroll
                for (int bj = 0; bj < 2; ++bj) { const f32x4 v0 = acc[ai][bj][m][0] + bv[bj][0], v1 = acc[ai][bj][m][1] + bv[bj][1];
                    u32x4 w; w.x = cvt_pk_bf16(v0[0], v0[1]); w.y = cvt_pk_bf16(v0[2], v0[3]); w.z = cvt_pk_bf16(v1[0], v1[1]); w.w = cvt_pk_bf16(v1[2], v1[3]);
                    *(u32x4*)(rowp + bj * HALF) = w; } }
    }
};
struct EpiFox {
    static constexpr bool PERM = true, AFTER_DRAIN = false, APERM = false;
    bf16_t* QKV; float* logf; const float* bfg;
    __device__ __forceinline__ void operator()(const f32x4 (&acc)[2][2][4][2], const Unit& u, int wr, int wc, int fr, int fq) const {
        const int row0 = u.pm * BM + wr * 64 + fr;
        if (u.pn < 48) {
            const int t3 = u.pn >> 4, hp = u.pn & 15;
#pragma unroll
            for (int bj = 0; bj < 2; ++bj) { bf16_t* base = QKV + ((size_t)(t3 * 32 + 2 * hp + bj) * 16384) * 128 + wc * 32 + 8 * fq;
#pragma unroll
                for (int ai = 0; ai < 2; ++ai)
#pragma unroll
                    for (int m = 0; m < 4; ++m) { const f32x4 v0 = acc[ai][bj][m][0], v1 = acc[ai][bj][m][1];
                        u32x4 w; w.x = cvt_pk_bf16(v0[0], v0[1]); w.y = cvt_pk_bf16(v0[2], v0[3]); w.z = cvt_pk_bf16(v1[0], v1[1]); w.w = cvt_pk_bf16(v1[2], v1[3]);
                        *(u32x4*)(base + (size_t)(row0 + ai * HALF + m * 16) * 128) = w; } }
        } else if (wc == 0) {
            const f32x4 b0 = *(const f32x4*)(bfg + 8 * fq), b1 = *(const f32x4*)(bfg + 8 * fq + 4);
#pragma unroll
            for (int ai = 0; ai < 2; ++ai)
#pragma unroll
                for (int m = 0; m < 4; ++m) { float* rowp = logf + (size_t)(row0 + ai * HALF + m * 16) * 32 + 8 * fq;
#pragma unroll
                    for (int n = 0; n < 2; ++n) { const f32x4 z = acc[ai][0][m][n] + (n ? b1 : b0); f32x4 o;
#pragma unroll
                        for (int i = 0; i < 4; ++i) o[i] = fminf(z[i], 0.f) - log1pf(expf(-fabsf(z[i])));
                        *(f32x4*)(rowp + 4 * n) = o; } }
        }
    }
};
struct EpiGlu {
    static constexpr bool PERM = false, AFTER_DRAIN = false, APERM = false;
    bf16_t* C; const float* bias;
    __device__ __forceinline__ void operator()(const f32x4 (&acc)[2][2][4][2], const Unit& u, int wr, int wc, int fr, int fq) const {
        const int row0 = u.pm * BM + wr * 64 + fr, col0 = u.pn * HALF + wc * 32 + 4 * fq;
        f32x4 bv[2], bg[2];
#pragma unroll
        for (int n = 0; n < 2; ++n) { bv[n] = *(const f32x4*)(bias + col0 + n * 16); bg[n] = *(const f32x4*)(bias + 4096 + col0 + n * 16); }
#pragma unroll
        for (int ai = 0; ai < 2; ++ai)
#pragma unroll
            for (int m = 0; m < 4; ++m) { bf16_t* rowp = C + (size_t)(row0 + ai * HALF + m * 16) * 4096 + col0;
#pragma unroll
                for (int n = 0; n < 2; ++n) { const f32x4 zv = acc[ai][0][m][n] + bv[n], zg = acc[ai][1][m][n] + bg[n]; f32x4 o;
#pragma unroll
                    for (int i = 0; i < 4; ++i) o[i] = zv[i] * __builtin_amdgcn_rcpf(1.0f + __builtin_amdgcn_exp2f(-1.4426950408889634f * zg[i]));
                    u32x2 w; w.x = cvt_pk_bf16(o[0], o[1]); w.y = cvt_pk_bf16(o[2], o[3]); *(u32x2*)(rowp + n * 16) = w; } }
    }
};

struct EpiConvGeglu {
    static constexpr bool PERM = true, AFTER_DRAIN = false, APERM = true;
    bf16_t* ACT; const float* cw; const float* cb; PG8_LAS unsigned char* xl; int dff, nrows;
    static __device__ __forceinline__ float shr1(float old, float src) {
        return __builtin_bit_cast(float, __builtin_amdgcn_update_dpp(__builtin_bit_cast(int, old), __builtin_bit_cast(int, src), 0x111, 0xf, 0xf, false)); }
    static __device__ __forceinline__ float gelu_t(float x) { const float t = 0.7978845608028654f * (x + 0.044715f * x * x * x); return x * __builtin_amdgcn_rcpf(1.0f + __builtin_amdgcn_exp2f(-2.8853900817779268f * t)); }
    __device__ __forceinline__ void operator()(const f32x4 (&acc)[2][2][4][2], const Unit& u, int wr, int wc, int fr, int fq) const {
#define XOFF(ai_, w_, rr_, bj_, n_) ((((((ai_) * 2 + (w_)) * 2 + (rr_)) * 2 + (bj_)) * 4 + wc) * 128 + fq * 32 + (n_) * 16)
        f32x4 wv[8];
        { const int gc = u.pn * HALF + wc * 32 + 8 * fq;
            wv[0] = *(const f32x4*)(cw + gc); wv[1] = *(const f32x4*)(cw + 2 * dff + gc); wv[2] = *(const f32x4*)(cw + 4 * dff + gc); wv[3] = *(const f32x4*)(cb + gc);
            wv[4] = *(const f32x4*)(cw + dff + gc); wv[5] = *(const f32x4*)(cw + 3 * dff + gc); wv[6] = *(const f32x4*)(cw + 5 * dff + gc); wv[7] = *(const f32x4*)(cb + dff + gc); }
        if (fr == 15) {
#pragma unroll
            for (int ai = 0; ai < 2; ++ai)
#pragma unroll
                for (int bj = 0; bj < 2; ++bj)
#pragma unroll
                    for (int n = 0; n < 2; ++n) { *(PG8_LAS f32x4*)(xl + XOFF(ai, wr, 0, bj, n)) = acc[ai][bj][2][n]; *(PG8_LAS f32x4*)(xl + XOFF(ai, wr, 1, bj, n)) = acc[ai][bj][3][n]; }
        }
        asm volatile("s_waitcnt lgkmcnt(0)" ::: "memory"); __builtin_amdgcn_s_barrier(); asm volatile("" ::: "memory");
#pragma unroll
        for (int n = 0; n < 2; ++n) {
            const int gcol = u.pn * HALF + wc * 32 + 8 * fq + 4 * n;
            if (n) { wv[0] = *(const f32x4*)(cw + gcol); wv[1] = *(const f32x4*)(cw + 2 * dff + gcol); wv[2] = *(const f32x4*)(cw + 4 * dff + gcol); wv[3] = *(const f32x4*)(cb + gcol);
                     wv[4] = *(const f32x4*)(cw + dff + gcol); wv[5] = *(const f32x4*)(cw + 3 * dff + gcol); wv[6] = *(const f32x4*)(cw + 5 * dff + gcol); wv[7] = *(const f32x4*)(cb + dff + gcol); }
            const f32x4 wg0 = wv[0], wg1 = wv[1], wg2 = wv[2], bg = wv[3], wu0 = wv[4], wu1 = wv[5], wu2 = wv[6], bu = wv[7];
#pragma unroll
            for (int ai = 0; ai < 2; ++ai) {
                f32x4 Xg2 = {0.f, 0.f, 0.f, 0.f}, Xg3 = Xg2, Xu2 = Xg2, Xu3 = Xg2;
                if (ai + wr > 0) { const int pa = wr ? ai : ai - 1, pw = wr ? 0 : 1;
                    Xg2 = *(const PG8_LAS f32x4*)(xl + XOFF(pa, pw, 0, 0, n)); Xg3 = *(const PG8_LAS f32x4*)(xl + XOFF(pa, pw, 1, 0, n));
                    Xu2 = *(const PG8_LAS f32x4*)(xl + XOFF(pa, pw, 0, 1, n)); Xu3 = *(const PG8_LAS f32x4*)(xl + XOFF(pa, pw, 1, 1, n)); }
                float o[4][4];
#pragma unroll
                for (int i = 0; i < 4; ++i) {
                    const float g0 = acc[ai][0][0][n][i], g1 = acc[ai][0][1][n][i], g2 = acc[ai][0][2][n][i], g3 = acc[ai][0][3][n][i];
                    const float u0 = acc[ai][1][0][n][i], u1 = acc[ai][1][1][n][i], u2 = acc[ai][1][2][n][i], u3 = acc[ai][1][3][n][i];
                    const float gm1 = shr1(Xg3[i], g3), gm2 = shr1(Xg2[i], g2), um1 = shr1(Xu3[i], u3), um2 = shr1(Xu2[i], u2);
                    const float zg0 = ((bg[i] + wg2[i] * g0) + wg1[i] * gm1) + wg0[i] * gm2, zu0 = ((bu[i] + wu2[i] * u0) + wu1[i] * um1) + wu0[i] * um2;
                    const float zg1 = ((bg[i] + wg2[i] * g1) + wg1[i] * g0) + wg0[i] * gm1, zu1 = ((bu[i] + wu2[i] * u1) + wu1[i] * u0) + wu0[i] * um1;
                    const float zg2 = ((bg[i] + wg2[i] * g2) + wg1[i] * g1) + wg0[i] * g0, zu2 = ((bu[i] + wu2[i] * u2) + wu1[i] * u1) + wu0[i] * u0;
                    const float zg3 = ((bg[i] + wg2[i] * g3) + wg1[i] * g2) + wg0[i] * g1, zu3 = ((bu[i] + wu2[i] * u3) + wu1[i] * u2) + wu0[i] * u1;
                    o[0][i] = gelu_t(zg0) * zu0; o[1][i] = gelu_t(zg1) * zu1; o[2][i] = gelu_t(zg2) * zu2; o[3][i] = gelu_t(zg3) * zu3; }
#pragma unroll
                for (int m = 0; m < 4; ++m) { const int it = ai * HALF + wr * 64 + 4 * fr + m, grow = u.pm * 254 - 2 + it;
                    if (it >= 2 && grow < nrows) { u32x2 w; w.x = cvt_pk_bf16(o[m][0], o[m][1]); w.y = cvt_pk_bf16(o[m][2], o[m][3]); *(u32x2*)(ACT + (size_t)grow * dff + gcol) = w; } }
            }
        }
#undef XOFF
    }
};

template <class Epi, class Sched, bool ALIGN_EPI = false, bool SP2 = false>
__device__ __forceinline__ void gemm_phase(PG8_LAS unsigned char* lds, const Gemm g, const Sched& S, const Epi& E) {
    const int tid = mk_tid(), wid = __builtin_amdgcn_readfirstlane(tid >> 6), lane = tid & 63, wr = wid >> 2, wc = wid & 3, fr = lane & 15, fq = lane >> 4;
    const int K = g.K, nt = K / BK;
    unsigned voffA[2], voffB[2];
#pragma unroll
    for (int i = 0; i < 2; ++i) { int R, C; stage_rc(tid * 16 + i * 8192, R, C); const int Rb = Epi::PERM ? ((R & ~31) + perm32(R & 31)) : R;
        const int Ra = Epi::APERM ? ((R & ~63) + 4 * (R & 15) + ((R >> 4) & 3)) : R;
        voffA[i] = (unsigned)(Ra * K + C) * 2u; voffB[i] = (unsigned)(Rb * K + C) * 2u; }
    const size_t kstep = (size_t)(BK * 2);
    const size_t hstep = (size_t)HALF * K * 2;
    const size_t tstep = 2 * hstep;
    const size_t tstepA = (size_t)g.apr * K * 2;
    const unsigned ldsw = (unsigned)wid * 1024u;
    const int aoff = lds_byte(wr * 64 + fr, fq * 8), boff = lds_byte(wc * 32 + fr, fq * 8);
#define PG8_SA(b, h) (((b) * 2 + (h)) * HTB)
#define PG8_SB(b, h) ((4 + (b) * 2 + (h)) * HTB)
#define PG8_STAGE(bufoff, gbase, voff) do { _Pragma("unroll") for (int _i = 0; _i < 2; ++_i) \
        __builtin_amdgcn_global_load_lds((const unsigned*)((const char*)(gbase) + (voff)[_i]), (PG8_LAS unsigned*)(lds + (bufoff) + ldsw + _i * 8192), 16, 0, 0); } while (0)
#define PG8_LDA(dst, b, h) do { _Pragma("unroll") for (int m = 0; m < 4; ++m) _Pragma("unroll") for (int k = 0; k < 2; ++k) dst[m][k] = *(const PG8_LAS bf16x8*)(lds + PG8_SA(b, h) + aoff + m * 2048 + k * 1024); } while (0)
#define PG8_LDB(dst, b, h) do { _Pragma("unroll") for (int n = 0; n < 2; ++n) _Pragma("unroll") for (int k = 0; k < 2; ++k) dst[n][k] = *(const PG8_LAS bf16x8*)(lds + PG8_SB(b, h) + boff + n * 2048 + k * 1024); } while (0)
#define PG8_MMA(ai, bj, At, Bt) do { __builtin_amdgcn_s_setprio(1); _Pragma("unroll") for (int m = 0; m < 4; ++m) _Pragma("unroll") for (int n = 0; n < 2; ++n) _Pragma("unroll") for (int k = 0; k < 2; ++k) \
        acc[ai][bj][m][n] = __builtin_amdgcn_mfma_f32_16x16x32_bf16(Bt[n][k], At[m][k], acc[ai][bj][m][n], 0, 0, 0); __builtin_amdgcn_s_setprio(0); } while (0)
#define PG8_WAIT_V(n) asm volatile("s_waitcnt vmcnt(" #n ")" ::: "memory")
#define PG8_WAIT_L(n) asm volatile("s_waitcnt lgkmcnt(" #n ")" ::: "memory")
#define PG8_BAR __builtin_amdgcn_s_barrier()
#define PG8_SCHED __builtin_amdgcn_sched_barrier(0)
    Unit cur, nxt; int ui = 0;
    if (!S.next(0, cur)) return;
    f32x4 acc[2][2][4][2];
#pragma unroll
    for (int a = 0; a < 2; ++a)
#pragma unroll
        for (int b = 0; b < 2; ++b)
#pragma unroll
            for (int m = 0; m < 4; ++m)
#pragma unroll
                for (int n = 0; n < 2; ++n) acc[a][b][m][n] = (f32x4){0.f, 0.f, 0.f, 0.f};
    bf16x8 At[4][2], B0[2][2], B1[2][2];
    const char* cA = (const char*)g.A + (size_t)cur.pm * tstepA; const char* cB = (const char*)g.Bt + (size_t)cur.pn * tstep;
    S.a_ready(cur);
    if constexpr (SP2) {
        PG8_STAGE(PG8_SB(0, 0), cB, voffB); PG8_STAGE(PG8_SB(0, 1), cB + hstep, voffB); PG8_STAGE(PG8_SA(0, 0), cA, voffA); PG8_STAGE(PG8_SA(0, 1), cA + hstep, voffA);
        if (wr == 1) PG8_BAR;
        PG8_WAIT_V(2); PG8_BAR;
        PG8_STAGE(PG8_SB(1, 0), cB + kstep, voffB); PG8_STAGE(PG8_SA(1, 0), cA + kstep, voffA); PG8_STAGE(PG8_SB(1, 1), cB + hstep + kstep, voffB);
        PG8_WAIT_V(6); PG8_BAR;
    } else {
        PG8_STAGE(PG8_SB(0, 0), cB, voffB); PG8_STAGE(PG8_SA(0, 0), cA, voffA); PG8_STAGE(PG8_SB(0, 1), cB + hstep, voffB); PG8_STAGE(PG8_SA(0, 1), cA + hstep, voffA);
        if (wr == 1) PG8_BAR;
        PG8_WAIT_V(4); PG8_BAR;
        PG8_STAGE(PG8_SB(1, 0), cB + kstep, voffB); PG8_STAGE(PG8_SA(1, 0), cA + kstep, voffA); PG8_STAGE(PG8_SB(1, 1), cB + hstep + kstep, voffB);
        PG8_WAIT_V(6); PG8_BAR;
    }
    for (;;) {
        const bool has_next = S.next(ui + 1, nxt);
        const char* nA = has_next ? (const char*)g.A + (size_t)nxt.pm * tstepA : cA; const char* nB = has_next ? (const char*)g.Bt + (size_t)nxt.pn * tstep : cB;
        for (int t = 0; t < nt; t += 2) {
            const bool last = (t == nt - 2);
            const char* a1 = cA + (size_t)(t + 1) * kstep;
            const char* a2 = last ? nA : cA + (size_t)(t + 2) * kstep; const char* b2 = last ? nB : cB + (size_t)(t + 2) * kstep;
            const char* a3 = a2 + kstep; const char* b3 = b2 + kstep;
            if (last && has_next) S.a_ready(nxt);
            if constexpr (SP2) {
            PG8_LDB(B0, 0, 0); PG8_LDB(B1, 0, 1); PG8_SCHED; PG8_LDA(At, 0, 0); PG8_STAGE(PG8_SA(1, 1), a1 + hstep, voffA);
            PG8_WAIT_V(8); PG8_WAIT_L(0); PG8_BAR; PG8_MMA(0, 0, At, B0); PG8_MMA(0, 1, At, B1); PG8_BAR; PG8_SCHED;
            PG8_LDA(At, 0, 1); PG8_STAGE(PG8_SB(0, 0), b2, voffB); PG8_STAGE(PG8_SB(0, 1), b2 + hstep, voffB); PG8_STAGE(PG8_SA(0, 0), a2, voffA);
            PG8_WAIT_V(8); PG8_WAIT_L(0); PG8_BAR; PG8_MMA(1, 0, At, B0); PG8_MMA(1, 1, At, B1); PG8_BAR; PG8_SCHED;
            PG8_LDB(B0, 1, 0); PG8_LDB(B1, 1, 1); PG8_SCHED; PG8_LDA(At, 1, 0); PG8_STAGE(PG8_SA(0, 1), a2 + hstep, voffA);
            PG8_WAIT_V(8); PG8_WAIT_L(0); PG8_BAR; PG8_MMA(0, 0, At, B0); PG8_MMA(0, 1, At, B1); PG8_BAR; PG8_SCHED;
            PG8_LDA(At, 1, 1); PG8_STAGE(PG8_SB(1, 0), b3, voffB); PG8_STAGE(PG8_SB(1, 1), b3 + hstep, voffB); PG8_STAGE(PG8_SA(1, 0), a3, voffA);
            PG8_WAIT_V(8); PG8_WAIT_L(0); PG8_BAR; PG8_MMA(1, 0, At, B0); PG8_MMA(1, 1, At, B1); PG8_BAR; PG8_SCHED;
            } else {
            PG8_LDB(B0, 0, 0); PG8_SCHED; PG8_LDA(At, 0, 0); PG8_STAGE(PG8_SA(1, 1), a1 + hstep, voffA);
            PG8_WAIT_L(8); PG8_BAR; PG8_WAIT_L(0); PG8_MMA(0, 0, At, B0); PG8_BAR; PG8_SCHED;
            PG8_LDB(B1, 0, 1); PG8_STAGE(PG8_SB(0, 0), b2, voffB);
            PG8_BAR; PG8_WAIT_L(0); PG8_MMA(0, 1, At, B1); PG8_BAR;
            PG8_LDA(At, 0, 1); PG8_STAGE(PG8_SA(0, 0), a2, voffA);
            PG8_BAR; PG8_WAIT_L(0); PG8_MMA(1, 0, At, B0); PG8_BAR; PG8_SCHED;
            PG8_STAGE(PG8_SB(0, 1), b2 + hstep, voffB);
            PG8_WAIT_V(6); PG8_BAR; PG8_MMA(1, 1, At, B1); PG8_BAR;
            PG8_LDB(B0, 1, 0); PG8_SCHED; PG8_LDA(At, 1, 0); PG8_STAGE(PG8_SA(0, 1), a2 + hstep, voffA);
            PG8_WAIT_L(8); PG8_BAR; PG8_WAIT_L(0); PG8_MMA(0, 0, At, B0); PG8_BAR; PG8_SCHED;
            PG8_LDB(B1, 1, 1); PG8_STAGE(PG8_SB(1, 0), b3, voffB);
            PG8_BAR; PG8_WAIT_L(0); PG8_MMA(0, 1, At, B1); PG8_BAR;
            PG8_LDA(At, 1, 1); PG8_STAGE(PG8_SA(1, 0), a3, voffA);
            PG8_BAR; PG8_WAIT_L(0); PG8_MMA(1, 0, At, B0); PG8_BAR; PG8_SCHED;
            PG8_STAGE(PG8_SB(1, 1), b3 + hstep, voffB);
            PG8_WAIT_V(6); PG8_BAR; PG8_MMA(1, 1, At, B1); PG8_BAR;
            }
        }
        if constexpr (ALIGN_EPI) { if (wr == 0) PG8_BAR; }
        if constexpr (!Epi::AFTER_DRAIN) { E(acc, cur, wr, wc, fr, fq); S.done(cur); }
        if (!has_next) break;
#pragma unroll
        for (int a = 0; a < 2; ++a)
#pragma unroll
            for (int b = 0; b < 2; ++b)
#pragma unroll
                for (int m = 0; m < 4; ++m)
#pragma unroll
                    for (int n = 0; n < 2; ++n) acc[a][b][m][n] = (f32x4){0.f, 0.f, 0.f, 0.f};
        cur = nxt; cA = nA; cB = nB; ++ui;
        if constexpr (ALIGN_EPI) { if (wr == 1) PG8_BAR; }
    }
    PG8_WAIT_V(0);
    if constexpr (!ALIGN_EPI) { if (wr == 0) PG8_BAR; }
    PG8_BAR;
    if constexpr (Epi::AFTER_DRAIN) { E.fused(acc, cur, wr, wc, fr, fq, lds, wid, lane); S.done(cur); }
#undef PG8_SA
#undef PG8_SB
#undef PG8_STAGE
#undef PG8_LDA
#undef PG8_LDB
#undef PG8_MMA
#undef PG8_WAIT_V
#undef PG8_WAIT_L
#undef PG8_BAR
#undef PG8_SCHED
}
}

namespace fox {
#define LAS3 __attribute__((address_space(3)))
constexpr int D = 128, SEQ = 16384, NH = 32, OPITCH = 4096;
constexpr float SCALE = 0.08838834764831845f;
constexpr float THR = 8.f;
constexpr int NW = 8, QBLK = 32, KVBLK = 64, QB = NW * QBLK;
constexpr int SHM_V = KVBLK * D * 2, SHM_K = KVBLK * D * 2;
constexpr int OFF_WS = 2 * SHM_V + 2 * SHM_K, OFF_BIAS = OFF_WS + NW * 64 * 4, OFF_QW = OFF_BIAS + 2 * 64 * 4, OFF_JLO = OFF_QW + 16, LDS_BYTES = OFF_JLO + 2048;
constexpr float SKIP_T = 30.f;
typedef unsigned short bf16;
typedef short bf16x8 __attribute__((ext_vector_type(8)));
typedef short s16x4 __attribute__((ext_vector_type(4)));
typedef float f32x16 __attribute__((ext_vector_type(16)));
typedef float f32x4 __attribute__((ext_vector_type(4)));
typedef unsigned u32x4 __attribute__((ext_vector_type(4)));

#define KSWZ(row, colB) ((row) * 256 + ((colB) ^ (((row) & 7) << 4)))
#define SBAR() __builtin_amdgcn_sched_barrier(0)
__device__ __forceinline__ int v_st(int k, int c) { const int kk = (k & ~0xC) | ((k & 4) << 1) | ((k & 8) >> 1); return ((kk >> 3) * 4 + (c >> 5)) * 512 + ((kk & 7) * 32 + (c & 31)) * 2; }
__device__ __forceinline__ int v_rd_base(int lane) { return ((lane & 3) << 3) | (((lane >> 2) & 3) << 6) | (((lane >> 4) & 1) << 5) | (((lane >> 5) & 1) << 8); }
constexpr int v_rd_off(int d0, int ks, int half) { return d0 * 512 + ks * 4096 + half * 2048; }
__device__ __forceinline__ int crow(int r, int hi) { return (r & 3) + 8 * (r >> 2) + 4 * hi; }
__device__ __forceinline__ unsigned cvtpk(float lo, float hi) { unsigned r; asm volatile("v_cvt_pk_bf16_f32 %0, %1, %2" : "=v"(r) : "v"(lo), "v"(hi)); return r; }
__device__ __forceinline__ bf16x8 load8(const bf16* p) { return *reinterpret_cast<const bf16x8*>(p); }
__device__ __forceinline__ void mask_tile(f32x16& p0, f32x16& p1, int dq) {
    const float NEG = -__builtin_inff();
#pragma unroll
    for (int r = 0; r < 16; ++r) {
        const int c = (r & 3) + 8 * (r >> 2);
        if (dq - c < 0) p0[r] = NEG;
        if (dq - c - 32 < 0) p1[r] = NEG;
    }
}
__device__ __forceinline__ void partialSM(f32x16& p0, f32x16& p1, float& m_reg, float& mn, float& alpha) {
    float pmax = p0[0]; for (int r = 1; r < 16; ++r) pmax = fmaxf(pmax, p0[r]); for (int r = 0; r < 16; ++r) pmax = fmaxf(pmax, p1[r]);
    { auto rr = __builtin_amdgcn_permlane32_swap(__float_as_uint(pmax), __float_as_uint(pmax), false, false);
      pmax = fmaxf(__uint_as_float(rr[0]), __uint_as_float(rr[1])); }
    constexpr float C2 = 1.4426950408889634f * SCALE;
    if (__builtin_expect(__all((pmax - m_reg) * SCALE <= THR), 1)) { mn = m_reg; alpha = 1.f; }
    else { mn = fmaxf(m_reg, pmax); alpha = __builtin_amdgcn_exp2f((m_reg - mn) * C2); m_reg = mn; }
    const float mnL = -mn * C2;
    for (int r = 0; r < 16; ++r) p0[r] = fmaf(p0[r], C2, mnL); for (int r = 0; r < 16; ++r) p1[r] = fmaf(p1[r], C2, mnL);
    for (int r = 0; r < 16; ++r) p0[r] = __builtin_amdgcn_exp2f(p0[r]);
}
__device__ __forceinline__ void finishSM(f32x16& p0, f32x16& p1, float alpha, float& l_reg, bf16x8& pa0, bf16x8& pa1, bf16x8& pa2, bf16x8& pa3) {
    for (int r = 0; r < 16; ++r) p1[r] = __builtin_amdgcn_exp2f(p1[r]);
    float ps = 0; for (int r = 0; r < 16; ++r) ps += p0[r]; for (int r = 0; r < 16; ++r) ps += p1[r];
    { auto rr = __builtin_amdgcn_permlane32_swap(__float_as_uint(ps), __float_as_uint(ps), false, false);
      ps = __uint_as_float(rr[0]) + __uint_as_float(rr[1]); }
    l_reg = l_reg * alpha + ps;
#define PK4(P, B_, OUT) do { unsigned a0 = cvtpk(P[B_+0], P[B_+1]), a1 = cvtpk(P[B_+2], P[B_+3]);                          \
        unsigned b0 = cvtpk(P[B_+4], P[B_+5]), b1 = cvtpk(P[B_+6], P[B_+7]);                                             \
        auto r0 = __builtin_amdgcn_permlane32_swap(a0, b0, false, false); auto r1 = __builtin_amdgcn_permlane32_swap(a1, b1, false, false); \
        u32x4 w = {r0[0], r1[0], r0[1], r1[1]}; OUT = *reinterpret_cast<bf16x8*>(&w); } while (0)
    PK4(p0, 0, pa0); PK4(p0, 8, pa1); PK4(p1, 0, pa2); PK4(p1, 8, pa3);
}
template <int KB>
__device__ __forceinline__ void qkt(f32x16& p0, f32x16& p1, const char* K_lds, const char* B_lds, int r32, int hi, const bf16x8* qr) {
    const float* bl = (const float*)B_lds + KB * 64 + 4 * hi;
#pragma unroll
    for (int g = 0; g < 4; ++g) { const f32x4 a = *(const f32x4*)(bl + 8 * g), b = *(const f32x4*)(bl + 32 + 8 * g);
        p0[4 * g + 0] = a[0]; p0[4 * g + 1] = a[1]; p0[4 * g + 2] = a[2]; p0[4 * g + 3] = a[3];
        p1[4 * g + 0] = b[0]; p1[4 * g + 1] = b[1]; p1[4 * g + 2] = b[2]; p1[4 * g + 3] = b[3]; }
    const char* kb[4];
#pragma unroll
    for (int dd = 0; dd < 4; ++dd) kb[dd] = K_lds + KB * SHM_K + KSWZ(r32, (dd * 16 + hi * 8) * 2);
#pragma unroll
    for (int d0 = 0; d0 < 8; ++d0) { const char* a = kb[d0 & 3] + (d0 >> 2) * 128;
        bf16x8 b0 = *reinterpret_cast<const bf16x8*>(a);
        bf16x8 b1 = *reinterpret_cast<const bf16x8*>(a + 32 * 256);
        p0 = __builtin_amdgcn_mfma_f32_32x32x16_bf16(b0, qr[d0], p0, 0, 0, 0);
        p1 = __builtin_amdgcn_mfma_f32_32x32x16_bf16(b1, qr[d0], p1, 0, 0, 0); }
}
template <int VB>
__device__ __forceinline__ void pv_tile(f32x16* o, int vb0, bf16x8 pa0, bf16x8 pa1, bf16x8 pa2, bf16x8 pa3) {
#define TRRD(dst, off) asm volatile("ds_read_b64_tr_b16 %0, %1 offset:%2" : "=&v"(dst) : "v"(vb0), "i"(off) : "memory")
#define PV_D0(d0) do { s16x4 l0, l1, l2, l3, h0, h1, h2, h3; constexpr int b_ = VB * SHM_V + v_rd_off(d0, 0, 0);     \
        TRRD(l0, b_); TRRD(h0, b_ + 2048); TRRD(l1, b_ + 4096); TRRD(h1, b_ + 6144); TRRD(l2, b_ + 8192); TRRD(h2, b_ + 10240); TRRD(l3, b_ + 12288); TRRD(h3, b_ + 14336); \
        asm volatile("s_waitcnt lgkmcnt(0)" ::: "memory"); SBAR();                                                                              \
        o[d0] = __builtin_amdgcn_mfma_f32_32x32x16_bf16(pa0, (bf16x8){l0[0], l0[1], l0[2], l0[3], h0[0], h0[1], h0[2], h0[3]}, o[d0], 0, 0, 0);   \
        o[d0] = __builtin_amdgcn_mfma_f32_32x32x16_bf16(pa1, (bf16x8){l1[0], l1[1], l1[2], l1[3], h1[0], h1[1], h1[2], h1[3]}, o[d0], 0, 0, 0);   \
        o[d0] = __builtin_amdgcn_mfma_f32_32x32x16_bf16(pa2, (bf16x8){l2[0], l2[1], l2[2], l2[3], h2[0], h2[1], h2[2], h2[3]}, o[d0], 0, 0, 0);   \
        o[d0] = __builtin_amdgcn_mfma_f32_32x32x16_bf16(pa3, (bf16x8){l3[0], l3[1], l3[2], l3[3], h3[0], h3[1], h3[2], h3[3]}, o[d0], 0, 0, 0); } while (0)
    PV_D0(0); PV_D0(1); PV_D0(2); PV_D0(3);
#undef PV_D0
#undef TRRD
}

struct BlockRef { const bf16* Q; const bf16* K; const bf16* V; const float* C; bf16* O; int P0; int jlo; };
struct Seam {
    bf16x8 qr[8];
    bf16x8 st_v0, st_v1, st_k0, st_k1; float st_b;
};
#define ROW(p, k0, rr) ((p) + (size_t)((k0) + (rr)) * D + sc)
#define VMW() asm volatile("s_waitcnt vmcnt(0)" ::: "memory")
#define VMWN(n) asm volatile("s_waitcnt vmcnt(%0)" :: "i"(n) : "memory")
#define SLOAD_H(Kp, Vp, Cp, k0) do { S.st_v0 = load8(ROW(Vp, k0, sr)); S.st_v1 = load8(ROW(Vp, k0, 32 + sr));              \
                         S.st_k0 = load8(ROW(Kp, k0, sr)); S.st_k1 = load8(ROW(Kp, k0, 32 + sr)); if (tid < 64) S.st_b = (Cp)[(k0) + tid]; } while (0)
#define SWRITE_HK(bf, cr) do { *(bf16x8*)(K_lds + (bf) * SHM_K + kws) = S.st_k0; *(bf16x8*)(K_lds + (bf) * SHM_K + kws + 32 * 256) = S.st_k1; \
                         if (tid < 64) ((float*)B_lds)[(bf) * 64 + tid] = S.st_b - (cr); } while (0)
#define SWRITE_HV(bf) do { *(bf16x8*)(V_lds + (bf) * SHM_V + vst0) = S.st_v0; *(bf16x8*)(V_lds + (bf) * SHM_V + vst1) = S.st_v1; } while (0)
#define SWRITE_H(bf, cr) do { SWRITE_HV(bf); SWRITE_HK(bf, cr); } while (0)
__device__ __forceinline__ void fox_prime(const BlockRef& cur, char* lds, Seam& S) {
    const int tid = mk_tid(), wid = __builtin_amdgcn_readfirstlane(tid >> 6), lane = tid & 63, r32 = lane & 31, hi = lane >> 5;
    const int sr = tid >> 4, sc = (tid & 15) * 8, kws = KSWZ(sr, sc * 2); char* K_lds = lds + 2 * SHM_V; char* B_lds = lds + OFF_BIAS;
    const float cref = __uint_as_float(__builtin_amdgcn_readfirstlane(__float_as_uint(cur.C[cur.P0])));
    for (int d0 = 0; d0 < 8; ++d0) S.qr[d0] = load8(cur.Q + (size_t)(wid * QBLK + r32) * D + d0 * 16 + hi * 8);
    SLOAD_H(cur.K, cur.V, cur.C, cur.jlo * KVBLK); VMW(); SWRITE_HK(0, cref);
    __syncthreads();
}
template <class NextFn> __device__ __forceinline__ BlockRef fox_block(const BlockRef& cur, char* lds, Seam& S, unsigned* qctr, const NextFn& mkref, bool& has_next) {
    const int tid = mk_tid(), wid = __builtin_amdgcn_readfirstlane(tid >> 6), lane = tid & 63, r32 = lane & 31, hi = lane >> 5;
    const int j_lo = cur.jlo, NT = (cur.P0 + QB - 1) / KVBLK + 1 - j_lo;
    unsigned qv = 0u; if (tid == 0) qv = __hip_atomic_fetch_add(qctr, 1u, __ATOMIC_RELAXED, __HIP_MEMORY_SCOPE_AGENT);
    const int qlo = cur.P0 + wid * QBLK, qm = qlo + r32 - 4 * hi;
    char* V_lds = lds; char* K_lds = lds + 2 * SHM_V; char* B_lds = lds + OFF_BIAS;
    float* ws = (float*)(lds + OFF_WS) + wid * 64; float* li_l = ws, * al_l = ws + 32;
    float m_reg = -1e30f, l_reg = 0; f32x16 o[4] = {};
    const int sr = tid >> 4, sc = (tid & 15) * 8, vst0 = v_st(sr, sc), vst1 = v_st(32 + sr, sc), kws = KSWZ(sr, sc * 2);
    const int vb0 = (int)(uintptr_t)V_lds + v_rd_base(lane);
    const bf16* Kh = cur.K; const bf16* Vh = cur.V; const float* Ch = cur.C;
    const float cref = __uint_as_float(__builtin_amdgcn_readfirstlane(__float_as_uint(cur.C[cur.P0])));
#define RESC(a) do { if (__any((a) < 1.f)) { if (hi == 0) al_l[r32] = (a); asm volatile("s_waitcnt lgkmcnt(0)" ::: "memory");              \
                     for (int d_ = 0; d_ < 4; ++d_) for (int r = 0; r < 16; ++r) o[d_][r] *= al_l[crow(r, hi)]; } } while (0)
#define KBASE(t) ((j_lo + (t)) * KVBLK)
#define MASKT(P0_, P1_, t) do { const int kb_ = KBASE(t); if (kb_ + KVBLK - 1 > qlo) mask_tile(P0_, P1_, qm - kb_); } while (0)
    constexpr int NQL = 8;
#define SEAM_K0() do { VMWN(NQL); SWRITE_HK(0, crefn); SBAR(); } while (0)
    f32x16 pA0, pA1, pB0, pB1; float mnA, mnB, alA, alB; bf16x8 pa0, pa1, pa2, pa3;
    SWRITE_HV(0); SBAR();
    if (NT > 1) { SLOAD_H(Kh, Vh, Ch, KBASE(1)); }
    SBAR(); qkt<0>(pA0, pA1, K_lds, B_lds, r32, hi, S.qr);
    MASKT(pA0, pA1, 0); partialSM(pA0, pA1, m_reg, mnA, alA);
    if (NT > 1) { VMW(); SWRITE_H(1, cref); }
    if (tid == 0) *(volatile LAS3 unsigned*)(lds + OFF_QW) = qv;
    __syncthreads();
    const unsigned inext = (unsigned)__builtin_amdgcn_readfirstlane((int)*(volatile LAS3 unsigned*)(lds + OFF_QW)); has_next = inext < (unsigned)(NH * (SEQ / QB));
    const BlockRef nxt = has_next ? mkref((int)inext) : cur;
    const float crefn = __uint_as_float(__builtin_amdgcn_readfirstlane(__float_as_uint(nxt.C[nxt.P0]))); const int kbn = nxt.jlo * KVBLK;
#define HALF_STEP(PX0, PX1, mnX, alX, PY0, PY1, alY, t, KB, VB, SB) do {                                                      \
        SBAR(); qkt<KB>(PX0, PX1, K_lds, B_lds, r32, hi, S.qr);                                                               \
        finishSM(PY0, PY1, alY, l_reg, pa0, pa1, pa2, pa3); SBAR();                                                           \
        if ((t) + 1 < NT) { SLOAD_H(Kh, Vh, Ch, KBASE((t) + 1)); SBAR(); }                                                    \
        pv_tile<VB>(o, vb0, pa0, pa1, pa2, pa3); MASKT(PX0, PX1, (t)); partialSM(PX0, PX1, m_reg, mnX, alX);                  \
        __syncthreads();                                                                                                      \
        if ((t) + 1 < NT) { VMW(); SWRITE_H(SB, cref); }                                                                      \
        RESC(alX); __syncthreads(); } while (0)
    for (int t = 1; t + 1 < NT; t += 2) {
        HALF_STEP(pB0, pB1, mnB, alB, pA0, pA1, alA, t, 1, 0, 0);
        HALF_STEP(pA0, pA1, mnA, alA, pB0, pB1, alB, t + 1, 0, 1, 1);
    }
    const bool even = (NT & 1) == 0;
    if (even) { SBAR(); qkt<1>(pB0, pB1, K_lds, B_lds, r32, hi, S.qr); SBAR(); }
    SLOAD_H(nxt.K, nxt.V, nxt.C, kbn); SBAR();
#pragma unroll
    for (int d0 = 0; d0 < 8; ++d0) S.qr[d0] = load8(nxt.Q + (size_t)(wid * QBLK + r32) * D + d0 * 16 + hi * 8);
    SBAR();
    finishSM(pA0, pA1, alA, l_reg, pa0, pa1, pa2, pa3); SBAR();
    pv_tile<0>(o, vb0, pa0, pa1, pa2, pa3);
    if (even) { MASKT(pB0, pB1, NT - 1); partialSM(pB0, pB1, m_reg, mnB, alB); __syncthreads(); RESC(alB);
        finishSM(pB0, pB1, alB, l_reg, pa0, pa1, pa2, pa3); SBAR(); pv_tile<1>(o, vb0, pa0, pa1, pa2, pa3); }
    SBAR(); SEAM_K0();
    if (hi == 0) li_l[r32] = l_reg; asm volatile("s_waitcnt lgkmcnt(0)" ::: "memory");
    float rli[16];
#pragma unroll
    for (int r = 0; r < 16; ++r) rli[r] = __builtin_amdgcn_rcpf(li_l[crow(r, hi)]);
    bf16* Ow = cur.O + (size_t)(wid * QBLK) * OPITCH;
#pragma unroll
    for (int r = 0; r < 16; ++r) { const int orow = crow(r, hi);
#pragma unroll
        for (int d0 = 0; d0 < 4; ++d0) { const float v = o[d0][r] * rli[r];
            const float vn = __shfl_xor(v, 1);
            if ((r32 & 1) == 0) *(unsigned*)(Ow + (size_t)orow * OPITCH + d0 * 32 + r32) = cvtpk(v, vn); } }
    __syncthreads();
    return nxt;
#undef RESC
#undef KBASE
#undef MASKT
#undef SEAM_K0
#undef HALF_STEP
}
#undef ROW
#undef VMW
#undef VMWN
#undef SLOAD_H
#undef SWRITE_HK
#undef SWRITE_HV
#undef SWRITE_H
#undef PK4

__device__ __forceinline__ BlockRef fox_ref(int item, const bf16* Q, const bf16* K, const bf16* V, const float* Cn, bf16* O, const char* lds) {
    const int qb = SEQ / QB - 1 - (item >> 5), bh = item & 31;
    BlockRef r; r.Q = Q + ((size_t)bh * SEQ + (size_t)qb * QB) * D; r.K = K + (size_t)bh * SEQ * D; r.V = V + (size_t)bh * SEQ * D; r.C = Cn + (size_t)bh * SEQ;
    r.O = O + (size_t)(qb * QB) * OPITCH + bh * D; r.P0 = qb * QB; r.jlo = (int)((const unsigned char*)(lds + OFF_JLO))[bh * 64 + qb]; return r;
}
__device__ __forceinline__ void fox_attn_phase(char* lds, const bf16* Q, const bf16* K, const bf16* V, const float* Cn, const unsigned* nrm2, unsigned* qctr, bf16* O) {
    const int tid = mk_tid();
    {
        int lo[4], hi[4]; float thr[4]; const float* Cb[4];
#pragma unroll
        for (int k = 0; k < 4; ++k) { const int e = tid + 512 * k, bh = e >> 6, qb = e & 63, P0 = qb * QB; Cb[k] = Cn + (size_t)bh * SEQ;
            const float qn2 = __uint_as_float(nrm2[bh]), kn2 = __uint_as_float(nrm2[32 + bh]);
            const float Dh = SKIP_T * (1.0f / SCALE) + 2.04f * sqrtf(qn2 * kn2) + 1.0f;
            thr[k] = Cb[k][P0] - Dh; lo[k] = 0; hi[k] = P0 / KVBLK; }
#pragma unroll 1
        for (int it = 0; it < 8; ++it) {
            float v[4]; int mid[4];
#pragma unroll
            for (int k = 0; k < 4; ++k) { mid[k] = (lo[k] + hi[k]) >> 1; v[k] = Cb[k][mid[k] * KVBLK + KVBLK - 1]; }
#pragma unroll
            for (int k = 0; k < 4; ++k) if (lo[k] < hi[k]) { if (v[k] < thr[k]) lo[k] = mid[k] + 1; else hi[k] = mid[k]; }
        }
#pragma unroll
        for (int k = 0; k < 4; ++k) ((unsigned char*)(lds + OFF_JLO))[tid + 512 * k] = (unsigned char)lo[k];
    }
    if (tid == 0) *(volatile LAS3 unsigned*)(lds + OFF_QW) = __hip_atomic_fetch_add(qctr, 1u, __ATOMIC_RELAXED, __HIP_MEMORY_SCOPE_AGENT);
    __syncthreads();
    const unsigned i0 = (unsigned)__builtin_amdgcn_readfirstlane((int)*(volatile LAS3 unsigned*)(lds + OFF_QW));
    if (i0 >= (unsigned)(NH * (SEQ / QB))) return;
    __syncthreads();
    auto mk = [=](int item) { return fox_ref(item, Q, K, V, Cn, O, lds); };
    BlockRef cur = mk((int)i0);
    Seam S;
    fox_prime(cur, lds, S);
    for (;;) { bool has_next; const BlockRef nxt = fox_block(cur, lds, S, qctr, mk, has_next); if (!has_next) break; cur = nxt; }
}
#undef LAS3
#undef KSWZ
#undef SBAR
}

namespace swa {
constexpr int SEQ = 16384, QKVP = 5120, OP = 4096;
constexpr int K_OFF = 0, VT_OFF = 32768, VT_PITCH = 528, LI_OFF = VT_OFF + 64 * VT_PITCH, LDS_BYTES = LI_OFF + 8 * 32 * 4;
typedef unsigned short bf16;
typedef short bf16x8 __attribute__((ext_vector_type(8)));
typedef float f32x16 __attribute__((ext_vector_type(16)));
typedef float f32x4 __attribute__((ext_vector_type(4)));
typedef unsigned u32x4 __attribute__((ext_vector_type(4)));
__device__ __forceinline__ int crow(int r, int hi) { return (r & 3) + 8 * (r >> 2) + 4 * hi; }
__device__ __forceinline__ unsigned cvtpk(float lo, float hi) { unsigned r; asm volatile("v_cvt_pk_bf16_f32 %0, %1, %2" : "=v"(r) : "v"(lo), "v"(hi)); return r; }
__device__ __forceinline__ float bf2f(short b) { return __uint_as_float(((unsigned)(unsigned short)b) << 16); }
__device__ __forceinline__ bf16x8 pack8(const float* v) { u32x4 w = {cvtpk(v[0], v[1]), cvtpk(v[2], v[3]), cvtpk(v[4], v[5]), cvtpk(v[6], v[7])}; return *reinterpret_cast<bf16x8*>(&w); }
#define SWA_PK4(P, B_, OUT) do { unsigned a0 = cvtpk(P[B_+0], P[B_+1]), a1 = cvtpk(P[B_+2], P[B_+3]);                          \
        unsigned b0 = cvtpk(P[B_+4], P[B_+5]), b1 = cvtpk(P[B_+6], P[B_+7]);                                             \
        auto r0 = __builtin_amdgcn_permlane32_swap(a0, b0, false, false); auto r1 = __builtin_amdgcn_permlane32_swap(a1, b1, false, false); \
        u32x4 w = {r0[0], r1[0], r0[1], r1[1]}; OUT = *reinterpret_cast<bf16x8*>(&w); } while (0)

__device__ __forceinline__ void swa_attn_phase(char* lds, const bf16* QKV, const float* sinks, const float* cosT, const float* sinT, bf16* O, int wg, int G) {
    const int tid = mk_tid(), wid = __builtin_amdgcn_readfirstlane(tid >> 6), lane = tid & 63, r32 = lane & 31, hi = lane >> 5;
    float* li_l = (float*)(lds + LI_OFF) + wid * 32;
    for (int L = wg; L < 1024; L += G) {
        const int g = L & 7, n = L >> 3;
        __syncthreads();
        {
            const int row = tid >> 1, half = tid & 1, kpos = 128 * (n - 1) + row;
            bf16x8 kc[4], vc[4];
            if (kpos >= 0) {
                const bf16* kp = QKV + (size_t)kpos * QKVP + 4096 + g * 64 + half * 32; const bf16* vp = kp + 512;
#pragma unroll
                for (int c = 0; c < 4; ++c) { kc[c] = *(const bf16x8*)(kp + 8 * c); vc[c] = *(const bf16x8*)(vp + 8 * c); }
                if (half == 0) {
                    const f32x4 c0 = *(const f32x4*)(cosT + (size_t)kpos * 8), c1 = *(const f32x4*)(cosT + (size_t)kpos * 8 + 4);
                    const f32x4 s0 = *(const f32x4*)(sinT + (size_t)kpos * 8), s1 = *(const f32x4*)(sinT + (size_t)kpos * 8 + 4);
                    float o1[8], o2[8];
#pragma unroll
                    for (int i = 0; i < 8; ++i) { const float cs = i < 4 ? c0[i & 3] : c1[i & 3], sn = i < 4 ? s0[i & 3] : s1[i & 3];
                        const float x1 = bf2f(kc[0][i]), x2 = bf2f(kc[1][i]); o1[i] = x1 * cs - x2 * sn; o2[i] = x2 * cs + x1 * sn; }
                    kc[0] = pack8(o1); kc[1] = pack8(o2);
                }
            } else {
#pragma unroll
                for (int c = 0; c < 4; ++c) { kc[c] = (bf16x8){0, 0, 0, 0, 0, 0, 0, 0}; vc[c] = (bf16x8){0, 0, 0, 0, 0, 0, 0, 0}; }
            }
#pragma unroll
            for (int c = 0; c < 4; ++c) { const int chunk = half * 4 + c;
                *(bf16x8*)(lds + K_OFF + row * 128 + ((chunk ^ ((row >> 1) & 7)) << 4)) = kc[c];
#pragma unroll
                for (int j = 0; j < 8; ++j) *(short*)(lds + VT_OFF + (half * 32 + c * 8 + j) * VT_PITCH + row * 2) = vc[c][j]; }
        }
        __syncthreads();
        const int hq = g * 8 + wid; const float sink = sinks[hq];
        for (int a = 0; a < 4; ++a) {
            const int t = 128 * n + 32 * a + r32;
            const bf16* qp = QKV + (size_t)t * QKVP + hq * 64;
            bf16x8 qr[4];
#pragma unroll
            for (int d0 = 0; d0 < 4; ++d0) qr[d0] = *(const bf16x8*)(qp + 16 * d0 + 8 * hi);
            {
                const bf16x8 pr = *(const bf16x8*)(qp + 8 * (1 - hi));
                const f32x4 c0 = *(const f32x4*)(cosT + (size_t)t * 8), c1 = *(const f32x4*)(cosT + (size_t)t * 8 + 4);
                const f32x4 s0 = *(const f32x4*)(sinT + (size_t)t * 8), s1 = *(const f32x4*)(sinT + (size_t)t * 8 + 4);
                float ov[8];
#pragma unroll
                for (int i = 0; i < 8; ++i) { const float cs = i < 4 ? c0[i & 3] : c1[i & 3], sn = i < 4 ? s0[i & 3] : s1[i & 3];
                    const float own = bf2f(qr[0][i]), par = bf2f(pr[i]); ov[i] = own * cs + (hi ? par : -par) * sn; }
                qr[0] = pack8(ov);
            }
            f32x16 p[5];
#pragma unroll
            for (int bi = 0; bi < 5; ++bi) { const int row = 32 * (a + bi) + r32; const char* kb = lds + K_OFF + row * 128; const int sw = (row >> 1) & 7;
                f32x16 acc = {};
#pragma unroll
                for (int d0 = 0; d0 < 4; ++d0) { const bf16x8 kf = *(const bf16x8*)(kb + (((2 * d0 + hi) ^ sw) << 4)); acc = __builtin_amdgcn_mfma_f32_32x32x16_bf16(kf, qr[d0], acc, 0, 0, 0); }
                p[bi] = acc; }
            const float NEG = -__builtin_inff();
#pragma unroll
            for (int r = 0; r < 16; ++r) { const int c = crow(r, hi); if (!(c > r32)) p[0][r] = NEG; if (!(c <= r32)) p[4][r] = NEG; }
            if (n == 0) {
#pragma unroll
                for (int bi = 0; bi < 4; ++bi) if (a + bi < 4) {
#pragma unroll
                    for (int r = 0; r < 16; ++r) p[bi][r] = NEG; }
            }
            float mx = NEG;
#pragma unroll
            for (int bi = 0; bi < 5; ++bi)
#pragma unroll
                for (int r = 0; r < 16; ++r) mx = fmaxf(mx, p[bi][r]);
            { auto rr = __builtin_amdgcn_permlane32_swap(__float_as_uint(mx), __float_as_uint(mx), false, false); mx = fmaxf(__uint_as_float(rr[0]), __uint_as_float(rr[1])); }
            const float m = fmaxf(mx * 0.125f, sink);
            constexpr float LOG2E = 1.4426950408889634f, C2 = 0.125f * LOG2E;
            const float mL = -m * LOG2E;
            float ps = 0.f;
#pragma unroll
            for (int bi = 0; bi < 5; ++bi)
#pragma unroll
                for (int r = 0; r < 16; ++r) { const float e = __builtin_amdgcn_exp2f(fmaf(p[bi][r], C2, mL)); p[bi][r] = e; ps += e; }
            { auto rr = __builtin_amdgcn_permlane32_swap(__float_as_uint(ps), __float_as_uint(ps), false, false); ps = __uint_as_float(rr[0]) + __uint_as_float(rr[1]); }
            const float l = ps + __builtin_amdgcn_exp2f(fmaf(sink, LOG2E, mL));
            f32x16 o[2] = {};
#pragma unroll
            for (int bi = 0; bi < 5; ++bi) { bf16x8 pa[2]; SWA_PK4(p[bi], 0, pa[0]); SWA_PK4(p[bi], 8, pa[1]);
#pragma unroll
                for (int ks = 0; ks < 2; ++ks)
#pragma unroll
                    for (int db = 0; db < 2; ++db) { const bf16x8 vf = *(const bf16x8*)(lds + VT_OFF + (32 * db + r32) * VT_PITCH + (32 * (a + bi) + 16 * ks + 8 * hi) * 2);
                        o[db] = __builtin_amdgcn_mfma_f32_32x32x16_bf16(pa[ks], vf, o[db], 0, 0, 0); } }
            if (hi == 0) li_l[r32] = l; asm volatile("s_waitcnt lgkmcnt(0)" ::: "memory");
            bf16* Ow = O + (size_t)(128 * n + 32 * a) * OP + hq * 64;
#pragma unroll
            for (int r = 0; r < 16; ++r) { const int orow = crow(r, hi); const float rl = __builtin_amdgcn_rcpf(li_l[orow]);
#pragma unroll
                for (int db = 0; db < 2; ++db) { const float v = o[db][r] * rl; const float vn = __shfl_xor(v, 1);
                    if ((r32 & 1) == 0) *(unsigned*)(Ow + (size_t)orow * OP + db * 32 + r32) = cvtpk(v, vn); } }
            asm volatile("s_waitcnt lgkmcnt(0)" ::: "memory");
        }
    }
    __syncthreads();
}
#undef SWA_PK4
}

#define LAS __attribute__((address_space(3)))
#define GAS __attribute__((address_space(1)))
typedef unsigned short bf16;
typedef float f32x4 __attribute__((ext_vector_type(4)));
typedef unsigned u32x4 __attribute__((ext_vector_type(4)));
typedef unsigned u32x2 __attribute__((ext_vector_type(2)));
typedef short bf16x8 __attribute__((ext_vector_type(8)));
constexpr int SEQ = 16384, DM = 4096, DFF = 11008;
constexpr float NORM_EPS = 1e-6f;
__device__ __forceinline__ unsigned cvtpk(float lo, float hi) { unsigned r; asm volatile("v_cvt_pk_bf16_f32 %0, %1, %2" : "=v"(r) : "v"(lo), "v"(hi)); return r; }
__device__ __forceinline__ float bf_lo(unsigned w) { return __uint_as_float(w << 16); }
__device__ __forceinline__ float bf_hi(unsigned w) { return __uint_as_float(w & 0xffff0000u); }
__device__ __forceinline__ float wave_sum(float v) {
#pragma unroll
    for (int o = 1; o < 64; o <<= 1) v += __shfl_xor(v, o);
    return v;
}
__device__ __forceinline__ float gelu_tanh(float x) {
    const float u = 0.7978845608028654f * (x + 0.044715f * x * x * x);
    return x * __builtin_amdgcn_rcpf(1.0f + __builtin_amdgcn_exp2f(-2.8853900817779268f * u));
}
__device__ __forceinline__ void sincos_d(double a, double& s, double& c) {
    const double k = rint(a * 0.15915494309189535);
    double r = fma(-k, 6.283185307179586, a); r = fma(-k, 2.4492935982947064e-16, r);
    const double r2 = r * r; double ss = 1.0, cc = 1.0;
#pragma unroll
    for (int n = 29; n >= 3; n -= 2) ss = fma(-ss * r2, 1.0 / (double)(n * (n - 1)), 1.0);
#pragma unroll
    for (int n = 28; n >= 2; n -= 2) cc = fma(-cc * r2, 1.0 / (double)(n * (n - 1)), 1.0);
    s = r * ss; c = cc;
}
__device__ __forceinline__ double exp_d(double x) {
    const double k = rint(x * 1.4426950408889634);
    double r = fma(-k, 0.6931471803691238, x); r = fma(-k, 1.9082149292705877e-10, r);
    double p = 1.0;
#pragma unroll
    for (int n = 16; n >= 1; --n) p = fma(p * r, 1.0 / (double)n, 1.0);
    return ldexp(p, (int)k);
}

__device__ __forceinline__ void transpose_item(const float* __restrict__ W, int K, int N, bf16* __restrict__ WT, int mode, LAS float* scr, int item, int lane) {
    const int nblk = N / 32, kb = item / nblk, nb = item % nblk, k0 = 64 * kb, n0 = 32 * nb;
    int r0 = n0; if (mode == 1) { const int bj = n0 >> 12, rem = n0 & 4095; r0 = ((rem >> 7) << 8) + (bj << 7) + (rem & 127); }
    if (mode == 2) { const int bj = n0 >= DFF ? 1 : 0, rem = n0 - bj * DFF; r0 = ((rem >> 7) << 8) + (bj << 7) + (rem & 127); }
#pragma unroll 8
    for (int i = 0; i < 32; ++i) { const int kk = 2 * i + (lane >> 5); scr[kk * 33 + (lane & 31)] = __builtin_nontemporal_load(W + (size_t)(k0 + kk) * N + n0 + (lane & 31)); }
    asm volatile("s_waitcnt lgkmcnt(0)" ::: "memory");
    const int c = lane & 7;
#pragma unroll
    for (int j = 0; j < 4; ++j) { const int n = (lane >> 3) + 8 * j; const LAS float* s = scr + (8 * c) * 33 + n;
        u32x4 o; o.x = cvtpk(s[0 * 33], s[1 * 33]); o.y = cvtpk(s[2 * 33], s[3 * 33]); o.z = cvtpk(s[4 * 33], s[5 * 33]); o.w = cvtpk(s[6 * 33], s[7 * 33]);
        *(u32x4*)(WT + (size_t)(r0 + n) * K + k0 + 8 * c) = o; }
    asm volatile("s_waitcnt lgkmcnt(0)" ::: "memory");
}

__device__ __forceinline__ void norm_phase(int gw, int ngw, int lane, const bf16* tmp, const float* gpost, const float* hin, float* hout, const float* gpre, bf16* xn, float* U, float tscale = 1.0f) {
    for (int m = gw; m < SEQ; m += ngw) {
        f32x4 h[16];
        const f32x4* hr = (const f32x4*)(hin + (size_t)m * DM) + lane;
        if (tmp) {
            const u32x2* tr = (const u32x2*)(tmp + (size_t)m * DM) + lane; f32x4 t[16]; float ss = 0.f;
#pragma unroll
            for (int j = 0; j < 16; ++j) { const u32x2 w = __builtin_nontemporal_load(tr + 64 * j); t[j] = (f32x4){bf_lo(w.x), bf_hi(w.x), bf_lo(w.y), bf_hi(w.y)}; ss += (t[j].x * t[j].x + t[j].y * t[j].y) + (t[j].z * t[j].z + t[j].w * t[j].w); }
#pragma unroll
            for (int j = 0; j < 16; ++j) h[j] = __builtin_nontemporal_load(hr + 64 * j);
            const float r = tscale / sqrtf(wave_sum(ss) * (1.0f / DM) + NORM_EPS);
            f32x4* ho = (f32x4*)(hout + (size_t)m * DM) + lane; const f32x4* gp = (const f32x4*)gpost + lane;
#pragma unroll
            for (int j = 0; j < 16; ++j) { h[j] = h[j] + (t[j] * r) * gp[64 * j]; __builtin_nontemporal_store(h[j], ho + 64 * j); }
        } else {
#pragma unroll
            for (int j = 0; j < 16; ++j) h[j] = hr[64 * j];
        }
        if (gpre) {
            float ss = 0.f;
#pragma unroll
            for (int j = 0; j < 16; ++j) ss += (h[j].x * h[j].x + h[j].y * h[j].y) + (h[j].z * h[j].z + h[j].w * h[j].w);
            const float r = 1.0f / sqrtf(wave_sum(ss) * (1.0f / DM) + NORM_EPS);
            const f32x4* gp = (const f32x4*)gpre + lane;
            if (xn) { u32x2* o8 = (u32x2*)(xn + (size_t)m * DM) + lane;
#pragma unroll
                for (int j = 0; j < 16; ++j) { const f32x4 v = (h[j] * r) * gp[64 * j]; u32x2 w; w.x = cvtpk(v.x, v.y); w.y = cvtpk(v.z, v.w); o8[64 * j] = w; } }
            if (U) {
#pragma unroll
                for (int j = 0; j < 16; ++j) { const f32x4 v = (h[j] * r) * gp[64 * j];
                    *(f32x4*)(U + ((size_t)((lane >> 2) + 16 * j) * SEQ + m) * 16 + 4 * (lane & 3)) = v; } }
        }
    }
}

__device__ __forceinline__ void fox_cumsum_phase(char* lds, const float* __restrict__ logf, float* __restrict__ cneg, int wg, int G, int tid) {
    double* wtot = (double*)lds; const int lane = tid & 63, wid = tid >> 6;
    for (int h = wg; h < 32; h += G) {
        float v[32]; double s = 0.0;
#pragma unroll
        for (int j = 0; j < 32; ++j) { v[j] = logf[(size_t)(32 * tid + j) * 32 + h]; s += (double)v[j]; }
        double inc = s;
#pragma unroll
        for (int o = 1; o < 64; o <<= 1) { const double t = __shfl_up(inc, o); if (lane >= o) inc += t; }
        __syncthreads();
        if (lane == 63) wtot[wid] = inc;
        __syncthreads();
        double run = inc - s;
#pragma unroll
        for (int w = 0; w < 8; ++w) if (w < wid) run += wtot[w];
#pragma unroll
        for (int j = 0; j < 32; ++j) { run += (double)v[j]; cneg[(size_t)h * SEQ + 32 * tid + j] = (float)(-run * 11.313708498984761); }
    }
}

__device__ __forceinline__ void fox_norms_phase(const bf16* __restrict__ QK, unsigned* nrm2, int gw, int ngw, int lane) {
    for (int base = gw * 128; base < 64 * SEQ; base += ngw * 128) {
        const u32x4* p = (const u32x4*)(QK + (size_t)base * 128) + lane; float mx = 0.f;
#pragma unroll 8
        for (int i = 0; i < 32; ++i) { const u32x4 w = p[(size_t)i * 64]; float s = 0.f;
#pragma unroll
            for (int q = 0; q < 4; ++q) { const float a = bf_lo(w[q]), b = bf_hi(w[q]); s = fmaf(a, a, s); s = fmaf(b, b, s); }
            s += __shfl_xor(s, 1); s += __shfl_xor(s, 2); s += __shfl_xor(s, 4); s += __shfl_xor(s, 8); mx = fmaxf(mx, s); }
        mx = fmaxf(mx, __shfl_xor(mx, 16)); mx = fmaxf(mx, __shfl_xor(mx, 32));
        if (lane == 0) __hip_atomic_fetch_max(nrm2 + base / SEQ, __float_as_uint(mx), __ATOMIC_RELAXED, __HIP_MEMORY_SCOPE_AGENT);
    }
}

namespace s5 {
typedef float f32x16 __attribute__((ext_vector_type(16)));
constexpr int NG = 256, SEGL = 2048, XP = 272, WAVE_BYTES = 2048 + 32 * XP, E_OFF = 8 * WAVE_BYTES, LDS_BYTES = E_OFF + 8 * 128 * 4;
__device__ __forceinline__ bf16x8 pack8(f32x4 a, f32x4 b) { u32x4 w = {cvtpk(a[0], a[1]), cvtpk(a[2], a[3]), cvtpk(b[0], b[1]), cvtpk(b[2], b[3])}; return *reinterpret_cast<bf16x8*>(&w); }
__device__ __forceinline__ void state_consts(float lam_re_raw, float lam_im_raw, double dt, double& lbr, double& lbi, double& cfr, double& cfi, double& lre_o, double& lim_o) {
    const double lre = (double)fminf(lam_re_raw, -1e-4f), lim = (double)lam_im_raw; double sn, cs; sincos_d(lim * dt, sn, cs); const double er = exp_d(lre * dt);
    lbr = er * cs; lbi = er * sn; const double a = lbr - 1.0, b = lbi, den = 1.0 / (lre * lre + lim * lim); cfr = (a * lre + b * lim) * den; cfi = (b * lre - a * lim) * den; lre_o = lre; lim_o = lim;
}
__device__ __forceinline__ void s5_phase(char* lds, const float* __restrict__ U, const float* __restrict__ lam_re, const float* __restrict__ lam_im, const float* __restrict__ log_dt,
                                         const float* __restrict__ b_re, const float* __restrict__ b_im, const float* __restrict__ c_re, const float* __restrict__ c_im,
                                         const float* __restrict__ dskip, bf16* __restrict__ Gout, int wg, int G) {
    const int tid = mk_tid(), wid = __builtin_amdgcn_readfirstlane(tid >> 6), lane = tid & 63, r32 = lane & 31, hi = lane >> 5, l15 = lane & 15, q4 = lane >> 4;
    float* ublk = (float*)(lds + wid * WAVE_BYTES); char* xblk = lds + wid * WAVE_BYTES + 2048; float* Ebuf = (float*)(lds + E_OFF);
    for (int g = wg; g < NG; g += G) {
        float lr, li, l2r, l2i; bf16x8 Bf[4], Cf[4]; const float dsk = dskip[16 * g + l15];
        {
            const double dt = exp_d((double)log_dt[g]);
            { double lbr, lbi, cfr, cfi, lre, lim; state_consts(lam_re[g * 64 + lane], lam_im[g * 64 + lane], dt, lbr, lbi, cfr, cfi, lre, lim); lr = (float)lbr; li = (float)lbi;
              double sn2, cs2; sincos_d(lim * dt * (double)SEGL, sn2, cs2); const double e2 = exp_d(lre * dt * (double)SEGL); l2r = (float)(e2 * cs2); l2i = (float)(e2 * sn2); }
#pragma unroll
            for (int sb = 0; sb < 2; ++sb) { const int st = 32 * sb + r32; double lbr, lbi, cfr, cfi, lre, lim; state_consts(lam_re[g * 64 + st], lam_im[g * 64 + st], dt, lbr, lbi, cfr, cfi, lre, lim);
                const f32x4* br = (const f32x4*)(b_re + ((size_t)g * 64 + st) * 16 + 8 * hi); const f32x4* bi = (const f32x4*)(b_im + ((size_t)g * 64 + st) * 16 + 8 * hi);
                const f32x4 vr0 = br[0], vr1 = br[1], vi0 = bi[0], vi1 = bi[1]; f32x4 or0, or1, oi0, oi1;
#pragma unroll
                for (int i = 0; i < 4; ++i) { or0[i] = (float)(cfr * (double)vr0[i] - cfi * (double)vi0[i]); or1[i] = (float)(cfr * (double)vr1[i] - cfi * (double)vi1[i]);
                                              oi0[i] = (float)(cfr * (double)vi0[i] + cfi * (double)vr0[i]); oi1[i] = (float)(cfr * (double)vi1[i] + cfi * (double)vr1[i]); }
                Bf[sb] = pack8(or0, or1); Bf[2 + sb] = pack8(oi0, oi1); }
#pragma unroll
            for (int kk = 0; kk < 4; ++kk) { const float* cp = (kk < 2 ? c_re : c_im) + ((size_t)g * 16 + l15) * 64 + 32 * (kk & 1) + 8 * q4; const float sg = kk < 2 ? 1.f : -1.f;
                const f32x4 v0 = *(const f32x4*)cp, v1 = *(const f32x4*)(cp + 4); Cf[kk] = pack8(v0 * sg, v1 * sg); }
        }
        const float* Ug = U + ((size_t)g * SEQ + (size_t)wid * SEGL) * 16;
        float xr = 0.f, xi = 0.f;
#pragma unroll 1
        for (int pass = 0; pass < 2; ++pass) {
            f32x4 ua0, ua1; { const f32x4* up = (const f32x4*)(Ug + (size_t)r32 * 16 + 8 * hi); ua0 = up[0]; ua1 = up[1]; }
#pragma unroll 1
            for (int blk = 0; blk < SEGL / 32; ++blk) {
                f32x4 un0 = ua0, un1 = ua1;
                if (blk + 1 < SEGL / 32) { const f32x4* up = (const f32x4*)(Ug + ((size_t)(blk + 1) * 32 + r32) * 16 + 8 * hi); un0 = up[0]; un1 = up[1]; }
                const bf16x8 af = pack8(ua0, ua1);
                if (pass) { *(f32x4*)(ublk + r32 * 16 + 8 * hi) = ua0; *(f32x4*)(ublk + r32 * 16 + 8 * hi + 4) = ua1; }
                f32x16 a0 = {}, a1 = {}, a2 = {}, a3 = {};
                a0 = __builtin_amdgcn_mfma_f32_32x32x16_bf16(af, Bf[0], a0, 0, 0, 0); a1 = __builtin_amdgcn_mfma_f32_32x32x16_bf16(af, Bf[1], a1, 0, 0, 0);
                a2 = __builtin_amdgcn_mfma_f32_32x32x16_bf16(af, Bf[2], a2, 0, 0, 0); a3 = __builtin_amdgcn_mfma_f32_32x32x16_bf16(af, Bf[3], a3, 0, 0, 0);
#pragma unroll
                for (int r = 0; r < 16; ++r) { auto t0 = __builtin_amdgcn_permlane32_swap(__float_as_uint(a0[r]), __float_as_uint(a1[r]), false, false); a0[r] = __uint_as_float(t0[0]); a1[r] = __uint_as_float(t0[1]);
                                               auto t1 = __builtin_amdgcn_permlane32_swap(__float_as_uint(a2[r]), __float_as_uint(a3[r]), false, false); a2[r] = __uint_as_float(t1[0]); a3[r] = __uint_as_float(t1[1]); }
#pragma unroll
                for (int s = 0; s < 32; ++s) { const int h = (s >> 2) & 1, r = (s & 3) + 4 * (s >> 3); const float bre = h ? a1[r] : a0[r], bim = h ? a3[r] : a2[r];
                    const float nr = fmaf(lr, xr, fmaf(-li, xi, bre)), ni = fmaf(lr, xi, fmaf(li, xr, bim)); xr = nr; xi = ni;
                    if (pass) { const unsigned pk = cvtpk(xr, xi); *(unsigned short*)(xblk + s * XP + lane * 2) = (unsigned short)pk; *(unsigned short*)(xblk + s * XP + 128 + lane * 2) = (unsigned short)(pk >> 16); } }
                if (pass) {
#pragma unroll
                    for (int rb = 0; rb < 2; ++rb) { f32x4 acc = {0.f, 0.f, 0.f, 0.f};
#pragma unroll
                        for (int kk = 0; kk < 4; ++kk) { const bf16x8 xa = *(const bf16x8*)(xblk + (16 * rb + l15) * XP + (32 * kk + 8 * q4) * 2); acc = __builtin_amdgcn_mfma_f32_16x16x32_bf16(xa, Cf[kk], acc, 0, 0, 0); }
#pragma unroll
                        for (int i = 0; i < 4; ++i) { const int sl = 16 * rb + 4 * q4 + i; const float uv = ublk[sl * 16 + l15];
                            const float v = gelu_tanh(acc[i] + dsk * uv); const float vn = __shfl_xor(v, 1);
                            if ((l15 & 1) == 0) *(unsigned*)(Gout + ((size_t)wid * SEGL + blk * 32 + sl) * DM + 16 * g + l15) = cvtpk(v, vn); } }
                }
                ua0 = un0; ua1 = un1;
            }
            if (pass == 0) {
                Ebuf[wid * 128 + lane] = xr; Ebuf[wid * 128 + 64 + lane] = xi;
                __syncthreads();
                float sr = 0.f, si = 0.f;
                for (int v = 0; v < wid; ++v) { const float er = Ebuf[v * 128 + lane], ei = Ebuf[v * 128 + 64 + lane];
                    const float nr = fmaf(l2r, sr, fmaf(-l2i, si, er)), ni = fmaf(l2r, si, fmaf(l2i, sr, ei)); sr = nr; si = ni; }
                xr = sr; xi = si;
            }
        }
        __syncthreads();
    }
}
}
#define XB_TMO      128
#define XB_XCNT(j)  (256  + 64 * (j))
#define XB_XSUB(j)  (1280 + 64 * (j))
#define XB_XGEN(j)  (2304 + 64 * (j))
#define XB_TOP      3328
#define XB_TOPGEN   3392
#define XCD_BAR_WORDS 3456
#define XB_SPIN_CAP (1u << 18)

__device__ __forceinline__ unsigned xb_ld(unsigned* p)              { return __hip_atomic_load(p, __ATOMIC_RELAXED, __HIP_MEMORY_SCOPE_AGENT); }
__device__ __forceinline__ unsigned xb_add(unsigned* p, unsigned v) { return __hip_atomic_fetch_add(p, v, __ATOMIC_RELAXED, __HIP_MEMORY_SCOPE_AGENT); }
__device__ __forceinline__ unsigned xb_xcc_id() { return (unsigned)__builtin_amdgcn_s_getreg((3 << 11) | 20) & 0xFu; }
#define XB_SPIN(cond, bar) do { unsigned _sp = 0; while (cond) { __builtin_amdgcn_s_sleep(1); \
    if ((++_sp & 255u) == 0u) { if (xb_ld(&(bar)[XB_TMO])) break; if (_sp > XB_SPIN_CAP) { atomicAdd(&(bar)[XB_TMO], 1u); break; } } } } while (0)

struct XcdBarrier {
    unsigned* bar; unsigned x;
    volatile LAS unsigned* st;
};

__device__ __forceinline__ XcdBarrier xcd_barrier_post(unsigned* bar, volatile LAS unsigned* st) {
    XcdBarrier b; b.bar = bar; b.x = xb_xcc_id(); b.st = st;
    if (threadIdx.x == 0) (void)xb_add(&bar[XB_XCNT(b.x)], 1u);
    return b;
}
__device__ __forceinline__ void xcd_barrier_complete(unsigned* bar, unsigned x, unsigned& nloc, unsigned& nx) {
    const unsigned G = gridDim.x * gridDim.y * gridDim.z;
    unsigned sum, cnt, mine, sp = 0u;
    for (;;) {
        sum = 0u; cnt = 0u; mine = 0u;
#pragma unroll
        for (unsigned j = 0; j < 16; ++j) { const unsigned c = xb_ld(&bar[XB_XCNT(j)]); sum += c; cnt += (c > 0u) ? 1u : 0u; mine = (j == x) ? c : mine; }
        if (sum == G) break;
        __builtin_amdgcn_s_sleep(1);
        if ((++sp & 255u) == 0u) { if (xb_ld(&bar[XB_TMO])) break; if (sp > XB_SPIN_CAP) { atomicAdd(&bar[XB_TMO], 1u); break; } }
    }
    nloc = mine > 0u ? mine : 1u; nx = cnt > 0u ? cnt : 1u;
}

__device__ __forceinline__ void xcd_barrier(const XcdBarrier& b) {
    asm volatile("s_waitcnt vmcnt(0)" ::: "memory");
    __syncthreads();
    if (threadIdx.x == 0) {
        unsigned* bar = b.bar;
        __builtin_amdgcn_s_waitcnt(0);
        unsigned nloc = b.st[0], nx = b.st[1];
        if (nloc == 0u) { xcd_barrier_complete(bar, b.x, nloc, nx); b.st[0] = nloc; b.st[1] = nx; }
        const unsigned old = xb_add(&bar[XB_XSUB(b.x)], 1u);
        const unsigned gen = old / nloc;
        if (old + 1u == (gen + 1u) * nloc) {
            __builtin_amdgcn_fence(__ATOMIC_RELEASE, "agent");
            asm volatile("s_waitcnt vmcnt(0)" ::: "memory");
            const unsigned og = xb_add(&bar[XB_TOP], 1u);
            const unsigned tg = og / nx;
            if (og + 1u == (tg + 1u) * nx) xb_add(&bar[XB_TOPGEN], 1u);
            else XB_SPIN(xb_ld(&bar[XB_TOPGEN]) == tg, bar);
            __builtin_amdgcn_fence(__ATOMIC_ACQUIRE, "agent");
            xb_add(&bar[XB_XGEN(b.x)], 1u);
            asm volatile("s_waitcnt vmcnt(0)" ::: "memory");
        } else {
            XB_SPIN(xb_ld(&bar[XB_XGEN(b.x)]) == gen, bar);
            __builtin_amdgcn_fence(__ATOMIC_ACQUIRE, "agent");
            asm volatile("s_waitcnt vmcnt(0)" ::: "memory");
        }
    }
    __syncthreads();
}

constexpr size_t MiB = (size_t)1 << 20;
constexpr int NTHR = 512, NWAVES = 8;
constexpr int LDS_BYTES = 147456;
constexpr int LDS_MISC = LDS_BYTES - 1024;
__device__ __forceinline__ const float* uptr(const LAS unsigned long long* tab, int i) {
    const unsigned long long v = tab[i]; const unsigned lo = __builtin_amdgcn_readfirstlane((unsigned)v), hi = __builtin_amdgcn_readfirstlane((unsigned)(v >> 32));
    return (const float*)(const GAS float*)(((unsigned long long)hi << 32) | lo);
}
template <class T> __device__ __forceinline__ LAS T* launder_l(LAS T* p) { asm volatile("" : "+s"(p)); return p; }
template <class T> __device__ __forceinline__ T* launder(T* p) { GAS T* q = (GAS T*)p; asm volatile("" : "+s"(q)); return (T*)q; }
static_assert(pg8::STAGE_BYTES <= LDS_MISC && fox::LDS_BYTES <= LDS_MISC && swa::LDS_BYTES <= LDS_MISC && s5::LDS_BYTES <= LDS_MISC, "LDS map");
constexpr size_t WS_CTL = 0, CTL_ZERO_BYTES = 64 * 1024;
constexpr size_t CTL_QCTR = 16384, CTL_NRM2 = 20480;
constexpr size_t WS_ROPE = 1 * MiB;
constexpr size_t WS_W = 2 * MiB;
constexpr size_t W_L0_QKV = WS_W, W_L0_O = W_L0_QKV + 40 * MiB, W_L1_QKVF = W_L0_O + 32 * MiB, W_L1_O = W_L1_QKVF + 98 * MiB, W_L2_GLU = W_L1_O + 32 * MiB,
                 W_L3_QKV = W_L2_GLU + 64 * MiB, W_L3_O = W_L3_QKV + 40 * MiB, W_FFN = W_L3_O + 32 * MiB, W_FFN_STRIDE = 258 * MiB, W_FFN_OUT = 172 * MiB;
constexpr size_t WS_XN = W_FFN + 4 * W_FFN_STRIDE;
constexpr size_t WS_BIG = WS_XN + 129 * MiB;
constexpr size_t WS_Z = WS_BIG, WS_ACT = WS_BIG + 688 * MiB, WS_TMPF = WS_BIG, WS_TMPM = WS_BIG + 688 * MiB;
constexpr size_t WS_SWA_QKV = WS_BIG, WS_SWA_O = WS_BIG + 160 * MiB;
constexpr size_t WS_FOX_QKV = WS_BIG, WS_FOX_O = WS_BIG + 384 * MiB, WS_FOX_LOGF = WS_BIG + 512 * MiB, WS_FOX_CNEG = WS_BIG + 514 * MiB;
constexpr size_t WS_S5_U = WS_BIG + 256 * MiB, WS_S5_G = WS_BIG + 512 * MiB;
constexpr size_t WS_END = WS_BIG + 1032 * MiB;
static_assert((size_t)SEQ * 2 * DFF * 2 == 688 * MiB && (size_t)SEQ * DFF * 2 == 344 * MiB && (size_t)12544 * 4096 * 2 == 98 * MiB && (size_t)22016 * 4096 * 2 == 172 * MiB, "sizes");

struct Args { const float* in[56]; float* out; unsigned char* ws; float inv_freq[8]; int ph_lo, ph_hi; };

__global__ void __launch_bounds__(NTHR, 2) mk_fwd(Args args) {
    extern __shared__ __attribute__((aligned(16))) unsigned char lds[];
    if (threadIdx.x < 16) ((LAS unsigned*)((LAS unsigned char*)lds + LDS_MISC))[threadIdx.x] = 0u;
    if (threadIdx.x == 64) { LAS unsigned long long* ptab0 = (LAS unsigned long long*)((LAS unsigned char*)lds + LDS_MISC + 64);
#pragma unroll
        for (int i = 0; i < 56; ++i) ptab0[i] = (unsigned long long)args.in[i]; }
#define IN(i) uptr(ptab, (i))
    __syncthreads();
    XcdBarrier bar = xcd_barrier_post((unsigned*)(args.ws + WS_CTL), (volatile LAS unsigned*)((LAS unsigned char*)lds + LDS_MISC));
    int need_bar = 0;
#define PH_BEGIN(id) if (args.ph_lo <= (id) && (id) < args.ph_hi) { \
        if (need_bar) { XcdBarrier b2; b2.bar = launder(bar.bar); b2.x = (unsigned)launder_s((int)bar.x); b2.st = bar.st; for (int rb_ = 0; rb_ < REP_BAR; ++rb_) xcd_barrier(b2); } need_bar = 1; \
        unsigned char* const ws = launder(args.ws); float* const out = launder(args.out); (void)out; \
        LAS unsigned char* const ldsl = launder_l((LAS unsigned char*)lds); char* const ldsg = (char*)ldsl; (void)ldsg; const LAS unsigned long long* const ptab = (const LAS unsigned long long*)(ldsl + LDS_MISC + 64); \
        const int tid = mk_tid(), lane = tid & 63, wave = __builtin_amdgcn_readfirstlane(tid >> 6); (void)lane; (void)wave; \
        const int G = launder_s((int)gridDim.x), bx = launder_s((int)blockIdx.x), vcu = (G % 8 == 0) ? (bx % 8) * (G / 8) + bx / 8 : bx, gw = vcu * NWAVES + wave, ngw = G * NWAVES; (void)gw; (void)ngw; \
        bf16* const XN = (bf16*)(ws + WS_XN + 16384); float* const cosT = (float*)(ws + WS_ROPE); float* const sinT = cosT + SEQ * 8; bf16* const TMPM = (bf16*)(ws + WS_TMPM); bf16* const TMPF = (bf16*)(ws + WS_TMPF); \
        (void)XN; (void)cosT; (void)sinT; (void)TMPM; (void)TMPF;
#define PH_END }

    PH_BEGIN(0)
      for (int rep = 0; rep < REP_PRO; ++rep) {
        LAS float* scr = (LAS float*)(ldsl + wave * 16384);
        constexpr int I_QKV = 64 * 160, I_O = 64 * 128, I_QKVF = 64 * 385, I_GLU = 64 * 256, I_IN = 64 * 688, I_OUT = 172 * 128;
        constexpr int NITEMS = 2 * (I_QKV + I_O) + I_QKVF + I_O + I_GLU + 4 * (I_IN + I_OUT);
        for (int it = gw; it < NITEMS; it += ngw) {
            int r = it;
#define TR(cnt, src, K_, N_, dstoff, mode) if (r < (cnt)) { transpose_item(IN(src), K_, N_, (bf16*)(ws + (dstoff)), mode, scr, r, lane); continue; } r -= (cnt);
            TR(I_QKV, 2, 4096, 5120, W_L0_QKV, 0)
            TR(I_O, 5, 4096, 4096, W_L0_O, 0)
            TR(I_IN, 9, 4096, 22016, W_FFN, 2)
            TR(I_OUT, 12, 11008, 4096, W_FFN + W_FFN_OUT, 0)
            TR(I_QKVF, 15, 4096, 12320, W_L1_QKVF, 0)
            TR(I_O, 17, 4096, 4096, W_L1_O, 0)
            TR(I_IN, 20, 4096, 22016, W_FFN + W_FFN_STRIDE, 2)
            TR(I_OUT, 23, 11008, 4096, W_FFN + W_FFN_STRIDE + W_FFN_OUT, 0)
            TR(I_GLU, 34, 4096, 8192, W_L2_GLU, 1)
            TR(I_IN, 38, 4096, 22016, W_FFN + 2 * W_FFN_STRIDE, 2)
            TR(I_OUT, 41, 11008, 4096, W_FFN + 2 * W_FFN_STRIDE + W_FFN_OUT, 0)
            TR(I_QKV, 44, 4096, 5120, W_L3_QKV, 0)
            TR(I_O, 47, 4096, 4096, W_L3_O, 0)
            TR(I_IN, 51, 4096, 22016, W_FFN + 3 * W_FFN_STRIDE, 2)
            TR(I_OUT, 54, 11008, 4096, W_FFN + 3 * W_FFN_STRIDE + W_FFN_OUT, 0)
#undef TR
        }
        if (vcu == 0) { u32x4* zh = (u32x4*)(ws + WS_XN); const u32x4 zero = {0u, 0u, 0u, 0u}; for (int i = tid; i < 1024; i += NTHR) zh[i] = zero; }
        {
            u32x4* z = (u32x4*)(ws + W_L1_QKVF + (size_t)12320 * 4096 * 2); const u32x4 zero = {0u, 0u, 0u, 0u};
            for (int i = vcu * NTHR + tid; i < 224 * 4096 * 2 / 16; i += G * NTHR) z[i] = zero;
        }
        for (int i = vcu * NTHR + tid; i < SEQ * 8; i += G * NTHR) {
            const int f = i & 7;
            const float fr = f == 0 ? args.inv_freq[0] : f == 1 ? args.inv_freq[1] : f == 2 ? args.inv_freq[2] : f == 3 ? args.inv_freq[3] : f == 4 ? args.inv_freq[4] : f == 5 ? args.inv_freq[5] : f == 6 ? args.inv_freq[6] : args.inv_freq[7];
            const float ang = (float)(i >> 3) * fr; double s, c; sincos_d((double)ang, s, c); cosT[i] = (float)c; sinT[i] = (float)s;
        }
        norm_phase(gw, ngw, lane, nullptr, nullptr, IN(0), nullptr, IN(1), XN, nullptr);
      }
    PH_END

#define SEL(a, b, c, d) IN(L == 0 ? (a) : L == 1 ? (b) : L == 2 ? (c) : (d))
    { constexpr int L = 0;

        const int type = L == 3 ? 0 : L, pb = 1 + 9 * L;
        const size_t wffn = W_FFN + (size_t)L * W_FFN_STRIDE;

        PH_BEGIN(pb + 0)
            if (type == 0) {
                pg8::Gemm g{XN, (const bf16*)(ws + (L == 0 ? W_L0_QKV : W_L3_QKV)), SEQ, 5120, 4096}; pg8::StaticOrder S; S.init(SEQ, 5120, G, bx);
                pg8::EpiBf16B E{(bf16*)(ws + WS_SWA_QKV), 5120, L == 0 ? IN(3) : IN(45)};
                for (int rep = 0; rep < REP_MIXG; ++rep) pg8::gemm_phase<pg8::EpiBf16B, pg8::StaticOrder, true, true>(ldsl, g, S, E);
            } else if (type == 1) {
                pg8::Gemm g{XN, (const bf16*)(ws + W_L1_QKVF), SEQ, 12544, 4096}; pg8::StaticOrder S; S.init(SEQ, 12544, G, bx);
                pg8::EpiFox E{(bf16*)(ws + WS_FOX_QKV), (float*)(ws + WS_FOX_LOGF), IN(16)};
                for (int rep = 0; rep < REP_MIXG; ++rep) pg8::gemm_phase<pg8::EpiFox, pg8::StaticOrder, true, true>(ldsl, g, S, E);
            } else {
              for (int rep = 0; rep < REP_MIX; ++rep)
                s5::s5_phase(ldsg, (const float*)(ws + WS_S5_U), IN(26), IN(27), IN(28), IN(29), IN(30), IN(31), IN(32), IN(33),
                             (bf16*)(ws + WS_S5_G), vcu, G);
            }
        PH_END
        if (type != 2) {
        PH_BEGIN(pb + 1)
          for (int rep = 0; rep < REP_MIX; ++rep) {
            if (type == 0) swa::swa_attn_phase(ldsg, (const bf16*)(ws + WS_SWA_QKV), L == 0 ? IN(4) : IN(46), cosT, sinT, (bf16*)(ws + WS_SWA_O), vcu, G);
            else { fox_cumsum_phase(ldsg, (const float*)(ws + WS_FOX_LOGF), (float*)(ws + WS_FOX_CNEG), vcu, G, tid);
                   if (G > 64) { if (vcu >= 32) fox_norms_phase((const bf16*)(ws + WS_FOX_QKV), (unsigned*)(ws + WS_CTL + CTL_NRM2), (vcu - 32) * NWAVES + wave, (G - 32) * NWAVES, lane); }
                   else fox_norms_phase((const bf16*)(ws + WS_FOX_QKV), (unsigned*)(ws + WS_CTL + CTL_NRM2), gw, ngw, lane); }
          }
        PH_END
        }
        if (type == 1) {
        PH_BEGIN(pb + 2)
            const bf16* q = (const bf16*)(ws + WS_FOX_QKV);
            fox::fox_attn_phase(ldsg, q, q + (size_t)32 * SEQ * 128, q + (size_t)64 * SEQ * 128, (const float*)(ws + WS_FOX_CNEG), (const unsigned*)(ws + WS_CTL + CTL_NRM2), (unsigned*)(ws + WS_CTL + CTL_QCTR), (bf16*)(ws + WS_FOX_O));
#if REP_FOX > 1
            __syncthreads();
            fox::fox_attn_phase(ldsg, q, q + (size_t)32 * SEQ * 128, q + (size_t)64 * SEQ * 128, (const float*)(ws + WS_FOX_CNEG), (const unsigned*)(ws + WS_CTL + CTL_NRM2), (unsigned*)(ws + WS_CTL + CTL_QCTR) + 64, (bf16*)(ws + WS_FOX_O));
#endif
        PH_END
        }
        PH_BEGIN(pb + 3)
            if (type == 2) {
                pg8::Gemm g{(const bf16*)(ws + WS_S5_G), (const bf16*)(ws + W_L2_GLU), SEQ, 8192, 4096}; pg8::StaticOrder S; S.init(SEQ, 8192, G, bx);
                pg8::EpiGlu E{TMPM, IN(35)};
                for (int rep = 0; rep < REP_MIXG; ++rep) pg8::gemm_phase<pg8::EpiGlu, pg8::StaticOrder, true, true>(ldsl, g, S, E);
            } else {
                pg8::Gemm g{(const bf16*)(ws + (type == 0 ? WS_SWA_O : WS_FOX_O)), (const bf16*)(ws + (L == 0 ? W_L0_O : L == 1 ? W_L1_O : W_L3_O)), SEQ, 4096, 4096};
                pg8::StaticOrder S; S.init(SEQ, 4096, G, bx);
                pg8::EpiBf16B E{TMPM, 4096, L == 0 ? IN(6) : L == 3 ? IN(48) : nullptr};
                for (int rep = 0; rep < REP_MIXG; ++rep) pg8::gemm_phase<pg8::EpiBf16B, pg8::StaticOrder, true, true>(ldsl, g, S, E);
            }
        PH_END
        PH_BEGIN(pb + 4)
          for (int rep = 0; rep < REP_NORM; ++rep)
            norm_phase(gw, ngw, lane, TMPM, SEL(7, 18, 36, 49), (L == 0 && rep == 0) ? IN(0) : out, out, SEL(8, 19, 37, 50), XN, nullptr, rep ? 0.f : 1.f);
        PH_END
        PH_BEGIN(pb + 5)
            pg8::Gemm g{XN - 2 * 4096, (const bf16*)(ws + wffn), 65 * 256, 2 * DFF, 4096, 254}; pg8::StaticOrder S; S.init(65 * 256, 2 * DFF, G, bx);
            pg8::EpiConvGeglu E{(bf16*)(ws + WS_ACT), SEL(10, 21, 39, 52), SEL(11, 22, 40, 53), ldsl + 131072, DFF, SEQ};
          for (int rep = 0; rep < REP_FFN1; ++rep)
            pg8::gemm_phase<pg8::EpiConvGeglu, pg8::StaticOrder, true, true>(ldsl, g, S, E);
        PH_END
        PH_BEGIN(pb + 7)
            pg8::Gemm g{(const bf16*)(ws + WS_ACT), (const bf16*)(ws + wffn + W_FFN_OUT), SEQ, 4096, DFF}; pg8::StaticOrder S; S.init(SEQ, 4096, G, bx);
            pg8::EpiBf16B E{TMPF, 4096, nullptr};
          for (int rep = 0; rep < REP_FFN2; ++rep)
            pg8::gemm_phase<pg8::EpiBf16B, pg8::StaticOrder, true, true>(ldsl, g, S, E);
        PH_END
        PH_BEGIN(pb + 8)
          for (int rep = 0; rep < REP_NORM; ++rep)
            norm_phase(gw, ngw, lane, TMPF, SEL(13, 24, 42, 55), out, out, L == 3 ? nullptr : SEL(14, 25, 43, 43), (L == 1 || L == 3) ? nullptr : XN, L == 1 ? (float*)(ws + WS_S5_U) : nullptr, rep ? 0.f : 1.f);
        PH_END
    }
    { constexpr int L = 1;

        const int type = L == 3 ? 0 : L, pb = 1 + 9 * L;
        const size_t wffn = W_FFN + (size_t)L * W_FFN_STRIDE;

        PH_BEGIN(pb + 0)
            if (type == 0) {
                pg8::Gemm g{XN, (const bf16*)(ws + (L == 0 ? W_L0_QKV : W_L3_QKV)), SEQ, 5120, 4096}; pg8::StaticOrder S; S.init(SEQ, 5120, G, bx);
                pg8::EpiBf16B E{(bf16*)(ws + WS_SWA_QKV), 5120, L == 0 ? IN(3) : IN(45)};
                for (int rep = 0; rep < REP_MIXG; ++rep) pg8::gemm_phase<pg8::EpiBf16B, pg8::StaticOrder, true, true>(ldsl, g, S, E);
            } else if (type == 1) {
                pg8::Gemm g{XN, (const bf16*)(ws + W_L1_QKVF), SEQ, 12544, 4096}; pg8::StaticOrder S; S.init(SEQ, 12544, G, bx);
                pg8::EpiFox E{(bf16*)(ws + WS_FOX_QKV), (float*)(ws + WS_FOX_LOGF), IN(16)};
                for (int rep = 0; rep < REP_MIXG; ++rep) pg8::gemm_phase<pg8::EpiFox, pg8::StaticOrder, true, true>(ldsl, g, S, E);
            } else {
              for (int rep = 0; rep < REP_MIX; ++rep)
                s5::s5_phase(ldsg, (const float*)(ws + WS_S5_U), IN(26), IN(27), IN(28), IN(29), IN(30), IN(31), IN(32), IN(33),
                             (bf16*)(ws + WS_S5_G), vcu, G);
            }
        PH_END
        if (type != 2) {
        PH_BEGIN(pb + 1)
          for (int rep = 0; rep < REP_MIX; ++rep) {
            if (type == 0) swa::swa_attn_phase(ldsg, (const bf16*)(ws + WS_SWA_QKV), L == 0 ? IN(4) : IN(46), cosT, sinT, (bf16*)(ws + WS_SWA_O), vcu, G);
            else { fox_cumsum_phase(ldsg, (const float*)(ws + WS_FOX_LOGF), (float*)(ws + WS_FOX_CNEG), vcu, G, tid);
                   if (G > 64) { if (vcu >= 32) fox_norms_phase((const bf16*)(ws + WS_FOX_QKV), (unsigned*)(ws + WS_CTL + CTL_NRM2), (vcu - 32) * NWAVES + wave, (G - 32) * NWAVES, lane); }
                   else fox_norms_phase((const bf16*)(ws + WS_FOX_QKV), (unsigned*)(ws + WS_CTL + CTL_NRM2), gw, ngw, lane); }
          }
        PH_END
        }
        if (type == 1) {
        PH_BEGIN(pb + 2)
            const bf16* q = (const bf16*)(ws + WS_FOX_QKV);
            fox::fox_attn_phase(ldsg, q, q + (size_t)32 * SEQ * 128, q + (size_t)64 * SEQ * 128, (const float*)(ws + WS_FOX_CNEG), (const unsigned*)(ws + WS_CTL + CTL_NRM2), (unsigned*)(ws + WS_CTL + CTL_QCTR), (bf16*)(ws + WS_FOX_O));
#if REP_FOX > 1
            __syncthreads();
            fox::fox_attn_phase(ldsg, q, q + (size_t)32 * SEQ * 128, q + (size_t)64 * SEQ * 128, (const float*)(ws + WS_FOX_CNEG), (const unsigned*)(ws + WS_CTL + CTL_NRM2), (unsigned*)(ws + WS_CTL + CTL_QCTR) + 64, (bf16*)(ws + WS_FOX_O));
#endif
        PH_END
        }
        PH_BEGIN(pb + 3)
            if (type == 2) {
                pg8::Gemm g{(const bf16*)(ws + WS_S5_G), (const bf16*)(ws + W_L2_GLU), SEQ, 8192, 4096}; pg8::StaticOrder S; S.init(SEQ, 8192, G, bx);
                pg8::EpiGlu E{TMPM, IN(35)};
                for (int rep = 0; rep < REP_MIXG; ++rep) pg8::gemm_phase<pg8::EpiGlu, pg8::StaticOrder, true, true>(ldsl, g, S, E);
            } else {
                pg8::Gemm g{(const bf16*)(ws + (type == 0 ? WS_SWA_O : WS_FOX_O)), (const bf16*)(ws + (L == 0 ? W_L0_O : L == 1 ? W_L1_O : W_L3_O)), SEQ, 4096, 4096};
                pg8::StaticOrder S; S.init(SEQ, 4096, G, bx);
                pg8::EpiBf16B E{TMPM, 4096, L == 0 ? IN(6) : L == 3 ? IN(48) : nullptr};
                for (int rep = 0; rep < REP_MIXG; ++rep) pg8::gemm_phase<pg8::EpiBf16B, pg8::StaticOrder, true, true>(ldsl, g, S, E);
            }
        PH_END
        PH_BEGIN(pb + 4)
          for (int rep = 0; rep < REP_NORM; ++rep)
            norm_phase(gw, ngw, lane, TMPM, SEL(7, 18, 36, 49), (L == 0 && rep == 0) ? IN(0) : out, out, SEL(8, 19, 37, 50), XN, nullptr, rep ? 0.f : 1.f);
        PH_END
        PH_BEGIN(pb + 5)
            pg8::Gemm g{XN - 2 * 4096, (const bf16*)(ws + wffn), 65 * 256, 2 * DFF, 4096, 254}; pg8::StaticOrder S; S.init(65 * 256, 2 * DFF, G, bx);
            pg8::EpiConvGeglu E{(bf16*)(ws + WS_ACT), SEL(10, 21, 39, 52), SEL(11, 22, 40, 53), ldsl + 131072, DFF, SEQ};
          for (int rep = 0; rep < REP_FFN1; ++rep)
            pg8::gemm_phase<pg8::EpiConvGeglu, pg8::StaticOrder, true, true>(ldsl, g, S, E);
        PH_END
        PH_BEGIN(pb + 7)
            pg8::Gemm g{(const bf16*)(ws + WS_ACT), (const bf16*)(ws + wffn + W_FFN_OUT), SEQ, 4096, DFF}; pg8::StaticOrder S; S.init(SEQ, 4096, G, bx);
            pg8::EpiBf16B E{TMPF, 4096, nullptr};
          for (int rep = 0; rep < REP_FFN2; ++rep)
            pg8::gemm_phase<pg8::EpiBf16B, pg8::StaticOrder, true, true>(ldsl, g, S, E);
        PH_END
        PH_BEGIN(pb + 8)
          for (int rep = 0; rep < REP_NORM; ++rep)
            norm_phase(gw, ngw, lane, TMPF, SEL(13, 24, 42, 55), out, out, L == 3 ? nullptr : SEL(14, 25, 43, 43), (L == 1 || L == 3) ? nullptr : XN, L == 1 ? (float*)(ws + WS_S5_U) : nullptr, rep ? 0.f : 1.f);
        PH_END
    }
    { constexpr int L = 2;

        const int type = L == 3 ? 0 : L, pb = 1 + 9 * L;
        const size_t wffn = W_FFN + (size_t)L * W_FFN_STRIDE;

        PH_BEGIN(pb + 0)
            if (type == 0) {
                pg8::Gemm g{XN, (const bf16*)(ws + (L == 0 ? W_L0_QKV : W_L3_QKV)), SEQ, 5120, 4096}; pg8::StaticOrder S; S.init(SEQ, 5120, G, bx);
                pg8::EpiBf16B E{(bf16*)(ws + WS_SWA_QKV), 5120, L == 0 ? IN(3) : IN(45)};
                for (int rep = 0; rep < REP_MIXG; ++rep) pg8::gemm_phase<pg8::EpiBf16B, pg8::StaticOrder, true, true>(ldsl, g, S, E);
            } else if (type == 1) {
                pg8::Gemm g{XN, (const bf16*)(ws + W_L1_QKVF), SEQ, 12544, 4096}; pg8::StaticOrder S; S.init(SEQ, 12544, G, bx);
                pg8::EpiFox E{(bf16*)(ws + WS_FOX_QKV), (float*)(ws + WS_FOX_LOGF), IN(16)};
                for (int rep = 0; rep < REP_MIXG; ++rep) pg8::gemm_phase<pg8::EpiFox, pg8::StaticOrder, true, true>(ldsl, g, S, E);
            } else {
              for (int rep = 0; rep < REP_MIX; ++rep)
                s5::s5_phase(ldsg, (const float*)(ws + WS_S5_U), IN(26), IN(27), IN(28), IN(29), IN(30), IN(31), IN(32), IN(33),
                             (bf16*)(ws + WS_S5_G), vcu, G);
            }
        PH_END
        if (type != 2) {
        PH_BEGIN(pb + 1)
          for (int rep = 0; rep < REP_MIX; ++rep) {
            if (type == 0) swa::swa_attn_phase(ldsg, (const bf16*)(ws + WS_SWA_QKV), L == 0 ? IN(4) : IN(46), cosT, sinT, (bf16*)(ws + WS_SWA_O), vcu, G);
            else { fox_cumsum_phase(ldsg, (const float*)(ws + WS_FOX_LOGF), (float*)(ws + WS_FOX_CNEG), vcu, G, tid);
                   if (G > 64) { if (vcu >= 32) fox_norms_phase((const bf16*)(ws + WS_FOX_QKV), (unsigned*)(ws + WS_CTL + CTL_NRM2), (vcu - 32) * NWAVES + wave, (G - 32) * NWAVES, lane); }
                   else fox_norms_phase((const bf16*)(ws + WS_FOX_QKV), (unsigned*)(ws + WS_CTL + CTL_NRM2), gw, ngw, lane); }
          }
        PH_END
        }
        if (type == 1) {
        PH_BEGIN(pb + 2)
            const bf16* q = (const bf16*)(ws + WS_FOX_QKV);
            fox::fox_attn_phase(ldsg, q, q + (size_t)32 * SEQ * 128, q + (size_t)64 * SEQ * 128, (const float*)(ws + WS_FOX_CNEG), (const unsigned*)(ws + WS_CTL + CTL_NRM2), (unsigned*)(ws + WS_CTL + CTL_QCTR), (bf16*)(ws + WS_FOX_O));
#if REP_FOX > 1
            __syncthreads();
            fox::fox_attn_phase(ldsg, q, q + (size_t)32 * SEQ * 128, q + (size_t)64 * SEQ * 128, (const float*)(ws + WS_FOX_CNEG), (const unsigned*)(ws + WS_CTL + CTL_NRM2), (unsigned*)(ws + WS_CTL + CTL_QCTR) + 64, (bf16*)(ws + WS_FOX_O));
#endif
        PH_END
        }
        PH_BEGIN(pb + 3)
            if (type == 2) {
                pg8::Gemm g{(const bf16*)(ws + WS_S5_G), (const bf16*)(ws + W_L2_GLU), SEQ, 8192, 4096}; pg8::StaticOrder S; S.init(SEQ, 8192, G, bx);
                pg8::EpiGlu E{TMPM, IN(35)};
                for (int rep = 0; rep < REP_MIXG; ++rep) pg8::gemm_phase<pg8::EpiGlu, pg8::StaticOrder, true, true>(ldsl, g, S, E);
            } else {
                pg8::Gemm g{(const bf16*)(ws + (type == 0 ? WS_SWA_O : WS_FOX_O)), (const bf16*)(ws + (L == 0 ? W_L0_O : L == 1 ? W_L1_O : W_L3_O)), SEQ, 4096, 4096};
                pg8::StaticOrder S; S.init(SEQ, 4096, G, bx);
                pg8::EpiBf16B E{TMPM, 4096, L == 0 ? IN(6) : L == 3 ? IN(48) : nullptr};
                for (int rep = 0; rep < REP_MIXG; ++rep) pg8::gemm_phase<pg8::EpiBf16B, pg8::StaticOrder, true, true>(ldsl, g, S, E);
            }
        PH_END
        PH_BEGIN(pb + 4)
          for (int rep = 0; rep < REP_NORM; ++rep)
            norm_phase(gw, ngw, lane, TMPM, SEL(7, 18, 36, 49), (L == 0 && rep == 0) ? IN(0) : out, out, SEL(8, 19, 37, 50), XN, nullptr, rep ? 0.f : 1.f);
        PH_END
        PH_BEGIN(pb + 5)
            pg8::Gemm g{XN - 2 * 4096, (const bf16*)(ws + wffn), 65 * 256, 2 * DFF, 4096, 254}; pg8::StaticOrder S; S.init(65 * 256, 2 * DFF, G, bx);
            pg8::EpiConvGeglu E{(bf16*)(ws + WS_ACT), SEL(10, 21, 39, 52), SEL(11, 22, 40, 53), ldsl + 131072, DFF, SEQ};
          for (int rep = 0; rep < REP_FFN1; ++rep)
            pg8::gemm_phase<pg8::EpiConvGeglu, pg8::StaticOrder, true, true>(ldsl, g, S, E);
        PH_END
        PH_BEGIN(pb + 7)
            pg8::Gemm g{(const bf16*)(ws + WS_ACT), (const bf16*)(ws + wffn + W_FFN_OUT), SEQ, 4096, DFF}; pg8::StaticOrder S; S.init(SEQ, 4096, G, bx);
            pg8::EpiBf16B E{TMPF, 4096, nullptr};
          for (int rep = 0; rep < REP_FFN2; ++rep)
            pg8::gemm_phase<pg8::EpiBf16B, pg8::StaticOrder, true, true>(ldsl, g, S, E);
        PH_END
        PH_BEGIN(pb + 8)
          for (int rep = 0; rep < REP_NORM; ++rep)
            norm_phase(gw, ngw, lane, TMPF, SEL(13, 24, 42, 55), out, out, L == 3 ? nullptr : SEL(14, 25, 43, 43), (L == 1 || L == 3) ? nullptr : XN, L == 1 ? (float*)(ws + WS_S5_U) : nullptr, rep ? 0.f : 1.f);
        PH_END
    }
    { constexpr int L = 3;

        const int type = L == 3 ? 0 : L, pb = 1 + 9 * L;
        const size_t wffn = W_FFN + (size_t)L * W_FFN_STRIDE;

        PH_BEGIN(pb + 0)
            if (type == 0) {
                pg8::Gemm g{XN, (const bf16*)(ws + (L == 0 ? W_L0_QKV : W_L3_QKV)), SEQ, 5120, 4096}; pg8::StaticOrder S; S.init(SEQ, 5120, G, bx);
                pg8::EpiBf16B E{(bf16*)(ws + WS_SWA_QKV), 5120, L == 0 ? IN(3) : IN(45)};
                for (int rep = 0; rep < REP_MIXG; ++rep) pg8::gemm_phase<pg8::EpiBf16B, pg8::StaticOrder, true, true>(ldsl, g, S, E);
            } else if (type == 1) {
                pg8::Gemm g{XN, (const bf16*)(ws + W_L1_QKVF), SEQ, 12544, 4096}; pg8::StaticOrder S; S.init(SEQ, 12544, G, bx);
                pg8::EpiFox E{(bf16*)(ws + WS_FOX_QKV), (float*)(ws + WS_FOX_LOGF), IN(16)};
                for (int rep = 0; rep < REP_MIXG; ++rep) pg8::gemm_phase<pg8::EpiFox, pg8::StaticOrder, true, true>(ldsl, g, S, E);
            } else {
              for (int rep = 0; rep < REP_MIX; ++rep)
                s5::s5_phase(ldsg, (const float*)(ws + WS_S5_U), IN(26), IN(27), IN(28), IN(29), IN(30), IN(31), IN(32), IN(33),
                             (bf16*)(ws + WS_S5_G), vcu, G);
            }
        PH_END
        if (type != 2) {
        PH_BEGIN(pb + 1)
          for (int rep = 0; rep < REP_MIX; ++rep) {
            if (type == 0) swa::swa_attn_phase(ldsg, (const bf16*)(ws + WS_SWA_QKV), L == 0 ? IN(4) : IN(46), cosT, sinT, (bf16*)(ws + WS_SWA_O), vcu, G);
            else { fox_cumsum_phase(ldsg, (const float*)(ws + WS_FOX_LOGF), (float*)(ws + WS_FOX_CNEG), vcu, G, tid);
                   if (G > 64) { if (vcu >= 32) fox_norms_phase((const bf16*)(ws + WS_FOX_QKV), (unsigned*)(ws + WS_CTL + CTL_NRM2), (vcu - 32) * NWAVES + wave, (G - 32) * NWAVES, lane); }
                   else fox_norms_phase((const bf16*)(ws + WS_FOX_QKV), (unsigned*)(ws + WS_CTL + CTL_NRM2), gw, ngw, lane); }
          }
        PH_END
        }
        if (type == 1) {
        PH_BEGIN(pb + 2)
            const bf16* q = (const bf16*)(ws + WS_FOX_QKV);
            fox::fox_attn_phase(ldsg, q, q + (size_t)32 * SEQ * 128, q + (size_t)64 * SEQ * 128, (const float*)(ws + WS_FOX_CNEG), (const unsigned*)(ws + WS_CTL + CTL_NRM2), (unsigned*)(ws + WS_CTL + CTL_QCTR), (bf16*)(ws + WS_FOX_O));
#if REP_FOX > 1
            __syncthreads();
            fox::fox_attn_phase(ldsg, q, q + (size_t)32 * SEQ * 128, q + (size_t)64 * SEQ * 128, (const float*)(ws + WS_FOX_CNEG), (const unsigned*)(ws + WS_CTL + CTL_NRM2), (unsigned*)(ws + WS_CTL + CTL_QCTR) + 64, (bf16*)(ws + WS_FOX_O));
#endif
        PH_END
        }
        PH_BEGIN(pb + 3)
            if (type == 2) {
                pg8::Gemm g{(const bf16*)(ws + WS_S5_G), (const bf16*)(ws + W_L2_GLU), SEQ, 8192, 4096}; pg8::StaticOrder S; S.init(SEQ, 8192, G, bx);
                pg8::EpiGlu E{TMPM, IN(35)};
                for (int rep = 0; rep < REP_MIXG; ++rep) pg8::gemm_phase<pg8::EpiGlu, pg8::StaticOrder, true, true>(ldsl, g, S, E);
            } else {
                pg8::Gemm g{(const bf16*)(ws + (type == 0 ? WS_SWA_O : WS_FOX_O)), (const bf16*)(ws + (L == 0 ? W_L0_O : L == 1 ? W_L1_O : W_L3_O)), SEQ, 4096, 4096};
                pg8::StaticOrder S; S.init(SEQ, 4096, G, bx);
                pg8::EpiBf16B E{TMPM, 4096, L == 0 ? IN(6) : L == 3 ? IN(48) : nullptr};
                for (int rep = 0; rep < REP_MIXG; ++rep) pg8::gemm_phase<pg8::EpiBf16B, pg8::StaticOrder, true, true>(ldsl, g, S, E);
            }
        PH_END
        PH_BEGIN(pb + 4)
          for (int rep = 0; rep < REP_NORM; ++rep)
            norm_phase(gw, ngw, lane, TMPM, SEL(7, 18, 36, 49), (L == 0 && rep == 0) ? IN(0) : out, out, SEL(8, 19, 37, 50), XN, nullptr, rep ? 0.f : 1.f);
        PH_END
        PH_BEGIN(pb + 5)
            pg8::Gemm g{XN - 2 * 4096, (const bf16*)(ws + wffn), 65 * 256, 2 * DFF, 4096, 254}; pg8::StaticOrder S; S.init(65 * 256, 2 * DFF, G, bx);
            pg8::EpiConvGeglu E{(bf16*)(ws + WS_ACT), SEL(10, 21, 39, 52), SEL(11, 22, 40, 53), ldsl + 131072, DFF, SEQ};
          for (int rep = 0; rep < REP_FFN1; ++rep)
            pg8::gemm_phase<pg8::EpiConvGeglu, pg8::StaticOrder, true, true>(ldsl, g, S, E);
        PH_END
        PH_BEGIN(pb + 7)
            pg8::Gemm g{(const bf16*)(ws + WS_ACT), (const bf16*)(ws + wffn + W_FFN_OUT), SEQ, 4096, DFF}; pg8::StaticOrder S; S.init(SEQ, 4096, G, bx);
            pg8::EpiBf16B E{TMPF, 4096, nullptr};
          for (int rep = 0; rep < REP_FFN2; ++rep)
            pg8::gemm_phase<pg8::EpiBf16B, pg8::StaticOrder, true, true>(ldsl, g, S, E);
        PH_END
        PH_BEGIN(pb + 8)
          for (int rep = 0; rep < REP_NORM; ++rep)
            norm_phase(gw, ngw, lane, TMPF, SEL(13, 24, 42, 55), out, out, L == 3 ? nullptr : SEL(14, 25, 43, 43), (L == 1 || L == 3) ? nullptr : XN, L == 1 ? (float*)(ws + WS_S5_U) : nullptr, rep ? 0.f : 1.f);
        PH_END
    }
#undef SEL
#undef PH_BEGIN
#undef PH_END
#undef IN
}

extern "C" void kernel_launch(void* const* d_in, const int* in_sizes, int n_in, void* d_out, int out_size, void* d_ws, size_t ws_size, hipStream_t stream) {
    static int grid = 0;
    if (grid == 0) {
        if (n_in != 56 || in_sizes[0] != SEQ * DM || out_size != SEQ * DM || ws_size < WS_END) {
            fprintf(stderr, "kernel_launch: built for 56 inputs, x/out of %d floats, >= %zu bytes of workspace; got n_in %d, in0 %d, out %d, ws %zu; nothing launched\n", SEQ * DM, (size_t)WS_END, n_in, n_in > 0 ? in_sizes[0] : -1, out_size, ws_size);
            grid = -1; return; }
        int dev = 0, cus = 0, per_cu = 0;
        if (hipGetDevice(&dev) != hipSuccess || hipDeviceGetAttribute(&cus, hipDeviceAttributeMultiprocessorCount, dev) != hipSuccess) { fprintf(stderr, "kernel_launch: device query failed\n"); grid = -1; return; }
        if (hipFuncSetAttribute((const void*)mk_fwd, hipFuncAttributeMaxDynamicSharedMemorySize, LDS_BYTES) != hipSuccess) { fprintf(stderr, "kernel_launch: hipFuncSetAttribute failed\n"); grid = -1; return; }
        if (hipOccupancyMaxActiveBlocksPerMultiprocessor(&per_cu, (const void*)mk_fwd, NTHR, LDS_BYTES) != hipSuccess || per_cu < 1) { fprintf(stderr, "kernel_launch: occupancy query says %d workgroups per CU\n", per_cu); (void)hipGetLastError(); }
        grid = cus;
    }
    if (grid < 0) return;
    if (hipMemsetAsync((char*)d_ws + WS_CTL, 0, CTL_ZERO_BYTES, stream) != hipSuccess) { fprintf(stderr, "kernel_launch: memset failed\n"); return; }
    Args a{};
    for (int i = 0; i < 56; ++i) a.in[i] = (const float*)d_in[i];
    a.out = (float*)d_out; a.ws = (unsigned char*)d_ws;
    { const float lt = (float)(-std::log(500000.0)); for (int i = 0; i < 8; ++i) { float v = lt * (float)i; v = v * 0.125f; a.inv_freq[i] = (float)std::exp((double)v); } }
#if MK_SPLIT_LAUNCHES
    for (int ph = 0; ph < 37; ++ph) {
        const int L = (ph - 1) / 9, slot = (ph - 1) % 9, type = L == 3 ? 0 : L;
        if (ph > 0 && ((slot == 1 && type == 2) || (slot == 2 && type != 1) || slot == 6)) continue;
        a.ph_lo = ph; a.ph_hi = ph + 1;
        hipLaunchKernelGGL(mk_fwd, dim3(grid), dim3(NTHR), LDS_BYTES, stream, a);
    }
#else
    a.ph_lo = 0; a.ph_hi = 37;
    hipLaunchKernelGGL(mk_fwd, dim3(grid), dim3(NTHR), LDS_BYTES, stream, a);
#endif
    const hipError_t le = hipPeekAtLastError();
    if (le != hipSuccess) fprintf(stderr, "kernel_launch: launch failed: %s (grid %d x %d threads, %d B LDS)\n", hipGetErrorName(le), grid, NTHR, LDS_BYTES);
}
```

```cpp
#include <hip/hip_runtime.h>
#include <cstdio>
#include <cstdint>
#include <cmath>

#ifndef MK_SPLIT_LAUNCHES
#define MK_SPLIT_LAUNCHES 0
#endif

__device__ __forceinline__ int mk_tid() { int t = threadIdx.x; asm volatile("" : "+v"(t)); return t; }
__device__ __forceinline__ int launder_s(int v) { asm volatile("" : "+s"(v)); return v; }

#ifndef PROBE_COPY
#define PROBE_COPY 0
#endif
#ifndef PROBE_T
#define PROBE_T u32x2
#endif
#define PROBE_LD(p) (*(p))
#define PROBE_ST(v, p) (*(p) = (v))
#ifndef REP_PRO
#define REP_PRO 1
#endif
#ifndef REP_FFN1
#define REP_FFN1 1
#endif
#ifndef REP_FFN2
#define REP_FFN2 1
#endif
#ifndef REP_NORM
#define REP_NORM 1
#endif
#ifndef REP_BAR
#define REP_BAR 1
#endif
#ifndef REP_FOX
#define REP_FOX 1
#endif
#ifndef REP_MIXG
#define REP_MIXG 1
#endif
#ifndef REP_MIX
#define REP_MIX 1
#endif

namespace pg8 {
#define PG8_LAS __attribute__((address_space(3)))
typedef unsigned short bf16_t;
typedef short bf16x8 __attribute__((ext_vector_type(8)));
typedef float f32x4 __attribute__((ext_vector_type(4)));
typedef unsigned u32x4 __attribute__((ext_vector_type(4)));
typedef unsigned u32x2 __attribute__((ext_vector_type(2)));
constexpr int BM = 256, BK = 64, HALF = 128, HTB = HALF * BK * 2  , STAGE_BYTES = 8 * HTB, NXCD = 8, WGM = 8;

__host__ __device__ __forceinline__ int lds_byte(int r, int c) { const int st = (r >> 4) * 2 + (c >> 5), rr = r & 15, cc = c & 31, ob = rr * 64 + cc * 2; return st * 1024 + (ob ^ (((ob >> 9) & 1) << 5)); }
__host__ __device__ __forceinline__ void stage_rc(int b, int& R, int& C) { const int st = b / 1024, sb = b % 1024, swz = sb ^ (((sb >> 9) & 1) << 5); R = (st >> 1) * 16 + swz / 64; C = (st & 1) * 32 + (swz % 64) / 2; }
__host__ __device__ __forceinline__ int perm32(int rho) { const int n = rho >> 4, i = rho & 15; return 8 * (i >> 2) + 4 * n + (i & 3); }

struct Unit { int pm, pn; };
struct Gemm { const bf16_t* A; const bf16_t* Bt; int M, N, K; int apr = 256; };

struct StaticOrder {
    int nM, nN, nwg, G, c;
    __host__ __device__ void init(int M, int N, int G_, int c_) { nM = M / BM; nN = N / BM; nwg = nM * nN; G = G_; c = c_; }
    __host__ __device__ bool next(int i, Unit& u) const {
        const long L = (long)i * G + c; if (L >= nwg) return false;
        int wgid = (int)L; { const int q = nwg / NXCD, r = nwg % NXCD, xcd = wgid % NXCD, off = wgid / NXCD; wgid = (xcd < r ? xcd * (q + 1) : r * (q + 1) + (xcd - r) * q) + off; }
        const int nig = WGM * nN, gid = wgid / nig, fm = gid * WGM, gsz = (nM - fm) < WGM ? (nM - fm) : WGM;
        u.pm = fm + ((wgid % nig) % gsz); u.pn = (wgid % nig) / gsz; return true;
    }
    __device__ __forceinline__ void a_ready(const Unit&) const {}
    __device__ __forceinline__ void done(const Unit&) const {}
};

__device__ __forceinline__ unsigned cvt_pk_bf16(float lo, float hi) { unsigned r; asm volatile("v_cvt_pk_bf16_f32 %0, %1, %2" : "=v"(r) : "v"(lo), "v"(hi)); return r; }

struct EpiF32B {
    static constexpr bool PERM = false, AFTER_DRAIN = false, APERM = false;
    float* C; int ldc; const float* bias;
    __device__ __forceinline__ void operator()(const f32x4 (&acc)[2][2][4][2], const Unit& u, int wr, int wc, int fr, int fq) const {
        const int row0 = u.pm * BM + wr * 64 + fr, col0 = u.pn * BM + wc * 32 + 4 * fq;
        f32x4 bv[2][2];
#pragma unroll
        for (int bj = 0; bj < 2; ++bj)
#pragma unroll
            for (int n = 0; n < 2; ++n) bv[bj][n] = bias ? *(const f32x4*)(bias + col0 + bj * HALF + n * 16) : (f32x4){0.f, 0.f, 0.f, 0.f};
#pragma unroll
        for (int ai = 0; ai < 2; ++ai)
#pragma unroll
            for (int m = 0; m < 4; ++m) { float* rowp = C + (size_t)(row0 + ai * HALF + m * 16) * ldc + col0;
#pragma unroll
                for (int bj = 0; bj < 2; ++bj)
#pragma unroll
                    for (int n = 0; n < 2; ++n) *(f32x4*)(rowp + bj * HALF + n * 16) = acc[ai][bj][m][n] + bv[bj][n]; }
    }
};
struct EpiBf16B {
    static constexpr bool PERM = true, AFTER_DRAIN = false, APERM = false;
    bf16_t* O; int ldc; const float* bias;
    __device__ __forceinline__ void operator()(const f32x4 (&acc)[2][2][4][2], const Unit& u, int wr, int wc, int fr, int fq) const {
        const int row0 = u.pm * BM + wr * 64 + fr; const int col0 = u.pn * BM + wc * 32 + 8 * fq;
        f32x4 bv[2][2];
#pragma unroll
        for (int bj = 0; bj < 2; ++bj)
#pragma unroll
            for (int n = 0; n < 2; ++n) bv[bj][n] = bias ? *(const f32x4*)(bias + col0 + bj * HALF + 4 * n) : (f32x4){0.f, 0.f, 0.f, 0.f};
#pragma unroll
        for (int ai = 0; ai < 2; ++ai)
#pragma unroll
            for (int m = 0; m < 4; ++m) { bf16_t* rowp = O + (size_t)(row0 + ai * HALF + m * 16) * ldc + col0;
#pragma unroll
                for (int bj = 0; bj < 2; ++bj) { const f32x4 v0 = acc[ai][bj][m][0] + bv[bj][0], v1 = acc[ai][bj][m][1] + bv[bj][1];
                    u32x4 w; w.x = cvt_pk_bf16(v0[0], v0[1]); w.y = cvt_pk_bf16(v0[2], v0[3]); w.z = cvt_pk_bf16(v1[0], v1[1]); w.w = cvt_pk_bf16(v1[2], v1[3]);
                    *(u32x4*)(rowp + bj * HALF) = w; } }
    }
};
struct EpiFox {
    static constexpr bool PERM = true, AFTER_DRAIN = false, APERM = false;
    bf16_t* QKV; float* logf; const float* bfg;
    __device__ __forceinline__ void operator()(const f32x4 (&acc)[2][2][4][2], const Unit& u, int wr, int wc, int fr, int fq) const {
        const int row0 = u.pm * BM + wr * 64 + fr;
        if (u.pn < 48) {
            const int t3 = u.pn >> 4, hp = u.pn & 15;
#pragma unroll
            for (int bj = 0; bj < 2; ++bj) { bf16_t* base = QKV + ((size_t)(t3 * 32 + 2 * hp + bj) * 16384) * 128 + wc * 32 + 8 * fq;
#pragma unroll
                for (int ai = 0; ai < 2; ++ai)
#pragma unroll
                    for (int m = 0; m < 4; ++m) { const f32x4 v0 = acc[ai][bj][m][0], v1 = acc[ai][bj][m][1];
                        u32x4 w; w.x = cvt_pk_bf16(v0[0], v0[1]); w.y = cvt_pk_bf16(v0[2], v0[3]); w.z = cvt_pk_bf16(v1[0], v1[1]); w.w = cvt_pk_bf16(v1[2], v1[3]);
                        *(u32x4*)(base + (size_t)(row0 + ai * HALF + m * 16) * 128) = w; } }
        } else if (wc == 0) {
            const f32x4 b0 = *(const f32x4*)(bfg + 8 * fq), b1 = *(const f32x4*)(bfg + 8 * fq + 4);
#pragma unroll
            for (int ai = 0; ai < 2; ++ai)
#pragma unroll
                for (int m = 0; m < 4; ++m) { float* rowp = logf + (size_t)(row0 + ai * HALF + m * 16) * 32 + 8 * fq;
#pragma unroll
                    for (int n = 0; n < 2; ++n) { const f32x4 z = acc[ai][0][m][n] + (n ? b1 : b0); f32x4 o;
#pragma unroll
                        for (int i = 0; i < 4; ++i) o[i] = fminf(z[i], 0.f) - log1pf(expf(-fabsf(z[i])));
                        *(f32x4*)(rowp + 4 * n) = o; } }
        }
    }
};
struct EpiGlu {
    static constexpr bool PERM = false, AFTER_DRAIN = false, APERM = false;
    bf16_t* C; const float* bias;
    __device__ __forceinline__ void operator()(const f32x4 (&acc)[2][2][4][2], const Unit& u, int wr, int wc, int fr, int fq) const {
        const int row0 = u.pm * BM + wr * 64 + fr, col0 = u.pn * HALF + wc * 32 + 4 * fq;
        f32x4 bv[2], bg[2];
#pragma unroll
        for (int n = 0; n < 2; ++n) { bv[n] = *(const f32x4*)(bias + col0 + n * 16); bg[n] = *(const f32x4*)(bias + 4096 + col0 + n * 16); }
#pragma unroll
        for (int ai = 0; ai < 2; ++ai)
#pragma unroll
            for (int m = 0; m < 4; ++m) { bf16_t* rowp = C + (size_t)(row0 + ai * HALF + m * 16) * 4096 + col0;
#pragma unroll
                for (int n = 0; n < 2; ++n) { const f32x4 zv = acc[ai][0][m][n] + bv[n], zg = acc[ai][1][m][n] + bg[n]; f32x4 o;
#pragma unroll
                    for (int i = 0; i < 4; ++i) o[i] = zv[i] * __builtin_amdgcn_rcpf(1.0f + __builtin_amdgcn_exp2f(-1.4426950408889634f * zg[i]));
                    u32x2 w; w.x = cvt_pk_bf16(o[0], o[1]); w.y = cvt_pk_bf16(o[2], o[3]); *(u32x2*)(rowp + n * 16) = w; } }
    }
};

struct EpiConvGeglu {
    static constexpr bool PERM = true, AFTER_DRAIN = false, APERM = true;
    bf16_t* ACT; const float* cw; const float* cb; PG8_LAS unsigned char* xl; int dff, nrows;
    static __device__ __forceinline__ float shr1(float old, float src) {
        return __builtin_bit_cast(float, __builtin_amdgcn_update_dpp(__builtin_bit_cast(int, old), __builtin_bit_cast(int, src), 0x111, 0xf, 0xf, false)); }
    static __device__ __forceinline__ float gelu_t(float x) { const float t = 0.7978845608028654f * (x + 0.044715f * x * x * x); return x * __builtin_amdgcn_rcpf(1.0f + __builtin_amdgcn_exp2f(-2.8853900817779268f * t)); }
    __device__ __forceinline__ void operator()(const f32x4 (&acc)[2][2][4][2], const Unit& u, int wr, int wc, int fr, int fq) const {
#define XOFF(ai_, w_, rr_, bj_, n_) ((((((ai_) * 2 + (w_)) * 2 + (rr_)) * 2 + (bj_)) * 4 + wc) * 128 + fq * 32 + (n_) * 16)
        f32x4 wv[8];
        { const int gc = u.pn * HALF + wc * 32 + 8 * fq;
            wv[0] = *(const f32x4*)(cw + gc); wv[1] = *(const f32x4*)(cw + 2 * dff + gc); wv[2] = *(const f32x4*)(cw + 4 * dff + gc); wv[3] = *(const f32x4*)(cb + gc);
            wv[4] = *(const f32x4*)(cw + dff + gc); wv[5] = *(const f32x4*)(cw + 3 * dff + gc); wv[6] = *(const f32x4*)(cw + 5 * dff + gc); wv[7] = *(const f32x4*)(cb + dff + gc); }
        if (fr == 15) {
#pragma unroll
            for (int ai = 0; ai < 2; ++ai)
#pragma unroll
                for (int bj = 0; bj < 2; ++bj)
#pragma unroll
                    for (int n = 0; n < 2; ++n) { *(PG8_LAS f32x4*)(xl + XOFF(ai, wr, 0, bj, n)) = acc[ai][bj][2][n]; *(PG8_LAS f32x4*)(xl + XOFF(ai, wr, 1, bj, n)) = acc[ai][bj][3][n]; }
        }
        asm volatile("s_waitcnt lgkmcnt(0)" ::: "memory"); __builtin_amdgcn_s_barrier(); asm volatile("" ::: "memory");
#pragma unroll
        for (int n = 0; n < 2; ++n) {
            const int gcol = u.pn * HALF + wc * 32 + 8 * fq + 4 * n;
            if (n) { wv[0] = *(const f32x4*)(cw + gcol); wv[1] = *(const f32x4*)(cw + 2 * dff + gcol); wv[2] = *(const f32x4*)(cw + 4 * dff + gcol); wv[3] = *(const f32x4*)(cb + gcol);
                     wv[4] = *(const f32x4*)(cw + dff + gcol); wv[5] = *(const f32x4*)(cw + 3 * dff + gcol); wv[6] = *(const f32x4*)(cw + 5 * dff + gcol); wv[7] = *(const f32x4*)(cb + dff + gcol); }
            const f32x4 wg0 = wv[0], wg1 = wv[1], wg2 = wv[2], bg = wv[3], wu0 = wv[4], wu1 = wv[5], wu2 = wv[6], bu = wv[7];
#pragma unroll
            for (int ai = 0; ai < 2; ++ai) {
                f32x4 Xg2 = {0.f, 0.f, 0.f, 0.f}, Xg3 = Xg2, Xu2 = Xg2, Xu3 = Xg2;
                if (ai + wr > 0) { const int pa = wr ? ai : ai - 1, pw = wr ? 0 : 1;
                    Xg2 = *(const PG8_LAS f32x4*)(xl + XOFF(pa, pw, 0, 0, n)); Xg3 = *(const PG8_LAS f32x4*)(xl + XOFF(pa, pw, 1, 0, n));
                    Xu2 = *(const PG8_LAS f32x4*)(xl + XOFF(pa, pw, 0, 1, n)); Xu3 = *(const PG8_LAS f32x4*)(xl + XOFF(pa, pw, 1, 1, n)); }
                float o[4][4];
#pragma unroll
                for (int i = 0; i < 4; ++i) {
                    const float g0 = acc[ai][0][0][n][i], g1 = acc[ai][0][1][n][i], g2 = acc[ai][0][2][n][i], g3 = acc[ai][0][3][n][i];
                    const float u0 = acc[ai][1][0][n][i], u1 = acc[ai][1][1][n][i], u2 = acc[ai][1][2][n][i], u3 = acc[ai][1][3][n][i];
                    const float gm1 = shr1(Xg3[i], g3), gm2 = shr1(Xg2[i], g2), um1 = shr1(Xu3[i], u3), um2 = shr1(Xu2[i], u2);
                    const float zg0 = ((bg[i] + wg2[i] * g0) + wg1[i] * gm1) + wg0[i] * gm2, zu0 = ((bu[i] + wu2[i] * u0) + wu1[i] * um1) + wu0[i] * um2;
                    const float zg1 = ((bg[i] + wg2[i] * g1) + wg1[i] * g0) + wg0[i] * gm1, zu1 = ((bu[i] + wu2[i] * u1) + wu1[i] * u0) + wu0[i] * um1;
                    const float zg2 = ((bg[i] + wg2[i] * g2) + wg1[i] * g1) + wg0[i] * g0, zu2 = ((bu[i] + wu2[i] * u2) + wu1[i] * u1) + wu0[i] * u0;
                    const float zg3 = ((bg[i] + wg2[i] * g3) + wg1[i] * g2) + wg0[i] * g1, zu3 = ((bu[i] + wu2[i] * u3) + wu1[i] * u2) + wu0[i] * u1;
                    o[0][i] = gelu_t(zg0) * zu0; o[1][i] = gelu_t(zg1) * zu1; o[2][i] = gelu_t(zg2) * zu2; o[3][i] = gelu_t(zg3) * zu3; }
#pragma unroll
                for (int m = 0; m < 4; ++m) { const int it = ai * HALF + wr * 64 + 4 * fr + m, grow = u.pm * 254 - 2 + it;
                    if (it >= 2 && grow < nrows) { u32x2 w; w.x = cvt_pk_bf16(o[m][0], o[m][1]); w.y = cvt_pk_bf16(o[m][2], o[m][3]); *(u32x2*)(ACT + (size_t)grow * dff + gcol) = w; } }
            }
        }
#undef XOFF
    }
};

template <class Epi, class Sched, bool ALIGN_EPI = false, bool SP2 = false>
__device__ __forceinline__ void gemm_phase(PG8_LAS unsigned char* lds, const Gemm g, const Sched& S, const Epi& E) {
    const int tid = mk_tid(), wid = __builtin_amdgcn_readfirstlane(tid >> 6), lane = tid & 63, wr = wid >> 2, wc = wid & 3, fr = lane & 15, fq = lane >> 4;
    const int K = g.K, nt = K / BK;
    unsigned voffA[2], voffB[2];
#pragma unroll
    for (int i = 0; i < 2; ++i) { int R, C; stage_rc(tid * 16 + i * 8192, R, C); const int Rb = Epi::PERM ? ((R & ~31) + perm32(R & 31)) : R;
        const int Ra = Epi::APERM ? ((R & ~63) + 4 * (R & 15) + ((R >> 4) & 3)) : R;
        voffA[i] = (unsigned)(Ra * K + C) * 2u; voffB[i] = (unsigned)(Rb * K + C) * 2u; }
    const size_t kstep = (size_t)(BK * 2);
    const size_t hstep = (size_t)HALF * K * 2;
    const size_t tstep = 2 * hstep;
    const size_t tstepA = (size_t)g.apr * K * 2;
    const unsigned ldsw = (unsigned)wid * 1024u;
    const int aoff = lds_byte(wr * 64 + fr, fq * 8), boff = lds_byte(wc * 32 + fr, fq * 8);
#define PG8_SA(b, h) (((b) * 2 + (h)) * HTB)
#define PG8_SB(b, h) ((4 + (b) * 2 + (h)) * HTB)
#define PG8_STAGE(bufoff, gbase, voff) do { _Pragma("unroll") for (int _i = 0; _i < 2; ++_i) \
        __builtin_amdgcn_global_load_lds((const unsigned*)((const char*)(gbase) + (voff)[_i]), (PG8_LAS unsigned*)(lds + (bufoff) + ldsw + _i * 8192), 16, 0, 0); } while (0)
#define PG8_LDA(dst, b, h) do { _Pragma("unroll") for (int m = 0; m < 4; ++m) _Pragma("unroll") for (int k = 0; k < 2; ++k) dst[m][k] = *(const PG8_LAS bf16x8*)(lds + PG8_SA(b, h) + aoff + m * 2048 + k * 1024); } while (0)
#define PG8_LDB(dst, b, h) do { _Pragma("unroll") for (int n = 0; n < 2; ++n) _Pragma("unroll") for (int k = 0; k < 2; ++k) dst[n][k] = *(const PG8_LAS bf16x8*)(lds + PG8_SB(b, h) + boff + n * 2048 + k * 1024); } while (0)
#define PG8_MMA(ai, bj, At, Bt) do { __builtin_amdgcn_s_setprio(1); _Pragma("unroll") for (int m = 0; m < 4; ++m) _Pragma("unroll") for (int n = 0; n < 2; ++n) _Pragma("unroll") for (int k = 0; k < 2; ++k) \
        acc[ai][bj][m][n] = __builtin_amdgcn_mfma_f32_16x16x32_bf16(Bt[n][k], At[m][k], acc[ai][bj][m][n], 0, 0, 0); __builtin_amdgcn_s_setprio(0); } while (0)
#define PG8_WAIT_V(n) asm volatile("s_waitcnt vmcnt(" #n ")" ::: "memory")
#define PG8_WAIT_L(n) asm volatile("s_waitcnt lgkmcnt(" #n ")" ::: "memory")
#define PG8_BAR __builtin_amdgcn_s_barrier()
#define PG8_SCHED __builtin_amdgcn_sched_barrier(0)
    Unit cur, nxt; int ui = 0;
    if (!S.next(0, cur)) return;
    f32x4 acc[2][2][4][2];
#pragma unroll
    for (int a = 0; a < 2; ++a)
#pragma unroll
        for (int b = 0; b < 2; ++b)
#pragma unroll
            for (int m = 0; m < 4; ++m)
#pragma unroll
                for (int n = 0; n < 2; ++n) acc[a][b][m][n] = (f32x4){0.f, 0.f, 0.f, 0.f};
    bf16x8 At[4][2], B0[2][2], B1[2][2];
    const char* cA = (const char*)g.A + (size_t)cur.pm * tstepA; const char* cB = (const char*)g.Bt + (size_t)cur.pn * tstep;
    S.a_ready(cur);
    if constexpr (SP2) {
        PG8_STAGE(PG8_SB(0, 0), cB, voffB); PG8_STAGE(PG8_SB(0, 1), cB + hstep, voffB); PG8_STAGE(PG8_SA(0, 0), cA, voffA); PG8_STAGE(PG8_SA(0, 1), cA + hstep, voffA);
        if (wr == 1) PG8_BAR;
        PG8_WAIT_V(2); PG8_BAR;
        PG8_STAGE(PG8_SB(1, 0), cB + kstep, voffB); PG8_STAGE(PG8_SA(1, 0), cA + kstep, voffA); PG8_STAGE(PG8_SB(1, 1), cB + hstep + kstep, voffB);
        PG8_WAIT_V(6); PG8_BAR;
    } else {
        PG8_STAGE(PG8_SB(0, 0), cB, voffB); PG8_STAGE(PG8_SA(0, 0), cA, voffA); PG8_STAGE(PG8_SB(0, 1), cB + hstep, voffB); PG8_STAGE(PG8_SA(0, 1), cA + hstep, voffA);
        if (wr == 1) PG8_BAR;
        PG8_WAIT_V(4); PG8_BAR;
        PG8_STAGE(PG8_SB(1, 0), cB + kstep, voffB); PG8_STAGE(PG8_SA(1, 0), cA + kstep, voffA); PG8_STAGE(PG8_SB(1, 1), cB + hstep + kstep, voffB);
        PG8_WAIT_V(6); PG8_BAR;
    }
    for (;;) {
        const bool has_next = S.next(ui + 1, nxt);
        const char* nA = has_next ? (const char*)g.A + (size_t)nxt.pm * tstepA : cA; const char* nB = has_next ? (const char*)g.Bt + (size_t)nxt.pn * tstep : cB;
        for (int t = 0; t < nt; t += 2) {
            const bool last = (t == nt - 2);
            const char* a1 = cA + (size_t)(t + 1) * kstep;
            const char* a2 = last ? nA : cA + (size_t)(t + 2) * kstep; const char* b2 = last ? nB : cB + (size_t)(t + 2) * kstep;
            const char* a3 = a2 + kstep; const char* b3 = b2 + kstep;
            if (last && has_next) S.a_ready(nxt);
            if constexpr (SP2) {
            PG8_LDB(B0, 0, 0); PG8_LDB(B1, 0, 1); PG8_SCHED; PG8_LDA(At, 0, 0); PG8_STAGE(PG8_SA(1, 1), a1 + hstep, voffA);
            PG8_WAIT_V(8); PG8_WAIT_L(0); PG8_BAR; PG8_MMA(0, 0, At, B0); PG8_MMA(0, 1, At, B1); PG8_BAR; PG8_SCHED;
            PG8_LDA(At, 0, 1); PG8_STAGE(PG8_SB(0, 0), b2, voffB); PG8_STAGE(PG8_SB(0, 1), b2 + hstep, voffB); PG8_STAGE(PG8_SA(0, 0), a2, voffA);
            PG8_WAIT_V(8); PG8_WAIT_L(0); PG8_BAR; PG8_MMA(1, 0, At, B0); PG8_MMA(1, 1, At, B1); PG8_BAR; PG8_SCHED;
            PG8_LDB(B0, 1, 0); PG8_LDB(B1, 1, 1); PG8_SCHED; PG8_LDA(At, 1, 0); PG8_STAGE(PG8_SA(0, 1), a2 + hstep, voffA);
            PG8_WAIT_V(8); PG8_WAIT_L(0); PG8_BAR; PG8_MMA(0, 0, At, B0); PG8_MMA(0, 1, At, B1); PG8_BAR; PG8_SCHED;
            PG8_LDA(At, 1, 1); PG8_STAGE(PG8_SB(1, 0), b3, voffB); PG8_STAGE(PG8_SB(1, 1), b3 + hstep, voffB); PG8_STAGE(PG8_SA(1, 0), a3, voffA);
            PG8_WAIT_V(8); PG8_WAIT_L(0); PG8_BAR; PG8_MMA(1, 0, At, B0); PG8_MMA(1, 1, At, B1); PG8_BAR; PG8_SCHED;
            } else {
            PG8_LDB(B0, 0, 0); PG8_SCHED; PG8_LDA(At, 0, 0); PG8_STAGE(PG8_SA(1, 1), a1 + hstep, voffA);
            PG8_WAIT_L(8); PG8_BAR; PG8_WAIT_L(0); PG8_MMA(0, 0, At, B0); PG8_BAR; PG8_SCHED;
            PG8_LDB(B1, 0, 1); PG8_STAGE(PG8_SB(0, 0), b2, voffB);
            PG8_BAR; PG8_WAIT_L(0); PG8_MMA(0, 1, At, B1); PG8_BAR;
            PG8_LDA(At, 0, 1); PG8_STAGE(PG8_SA(0, 0), a2, voffA);
            PG8_BAR; PG8_WAIT_L(0); PG8_MMA(1, 0, At, B0); PG8_BAR; PG8_SCHED;
            PG8_STAGE(PG8_SB(0, 1), b2 + hstep, voffB);
            PG8_WAIT_V(6); PG8_BAR; PG8_MMA(1, 1, At, B1); PG8_BAR;
            PG8_LDB(B0, 1, 0); PG8_SCHED; PG8_LDA(At, 1, 0); PG8_STAGE(PG8_SA(0, 1), a2 + hstep, voffA);
            PG8_WAIT_L(8); PG8_BAR; PG8_WAIT_L(0); PG8_MMA(0, 0, At, B0); PG8_BAR; PG8_SCHED;
            PG8_LDB(B1, 1, 1); PG8_STAGE(PG8_SB(1, 0), b3, voffB);
            PG8_BAR; PG8_WAIT_L(0); PG8_MMA(0, 1, At, B1); PG8_BAR;
            PG8_LDA(At, 1, 1); PG8_STAGE(PG8_SA(1, 0), a3, voffA);
            PG8_BAR; PG8_WAIT_L(0); PG8_MMA(1, 0, At, B0); PG8_BAR; PG8_SCHED;
            PG8_STAGE(PG8_SB(1, 1), b3 + hstep, voffB);
            PG8_WAIT_V(6); PG8_BAR; PG8_MMA(1, 1, At, B1); PG8_BAR;
            }
        }
        if constexpr (ALIGN_EPI) { if (wr == 0) PG8_BAR; }
        if constexpr (!Epi::AFTER_DRAIN) { E(acc, cur, wr, wc, fr, fq); S.done(cur); }
        if (!has_next) break;
#pragma unroll
        for (int a = 0; a < 2; ++a)
#pragma unroll
            for (int b = 0; b < 2; ++b)
#pragma unroll
                for (int m = 0; m < 4; ++m)
#pragma unroll
                    for (int n = 0; n < 2; ++n) acc[a][b][m][n] = (f32x4){0.f, 0.f, 0.f, 0.f};
        cur = nxt; cA = nA; cB = nB; ++ui;
        if constexpr (ALIGN_EPI) { if (wr == 1) PG8_BAR; }
    }
    PG8_WAIT_V(0);
    if constexpr (!ALIGN_EPI) { if (wr == 0) PG8_BAR; }
    PG8_BAR;
    if constexpr (Epi::AFTER_DRAIN) { E.fused(acc, cur, wr, wc, fr, fq, lds, wid, lane); S.done(cur); }
#undef PG8_SA
#undef PG8_SB
#undef PG8_STAGE
#undef PG8_LDA
#undef PG8_LDB
#undef PG8_MMA
#undef PG8_WAIT_V
#undef PG8_WAIT_L
#undef PG8_BAR
#undef PG8_SCHED
}
}

namespace fox {
#define LAS3 __attribute__((address_space(3)))
constexpr int D = 128, SEQ = 16384, NH = 32, OPITCH = 4096;
constexpr float SCALE = 0.08838834764831845f;
constexpr float THR = 8.f;
constexpr int NW = 8, QBLK = 32, KVBLK = 64, QB = NW * QBLK;
constexpr int SHM_V = KVBLK * D * 2, SHM_K = KVBLK * D * 2;
constexpr int OFF_WS = 2 * SHM_V + 2 * SHM_K, OFF_BIAS = OFF_WS + NW * 64 * 4, OFF_QW = OFF_BIAS + 2 * 64 * 4, OFF_JLO = OFF_QW + 16, LDS_BYTES = OFF_JLO + 2048;
constexpr float SKIP_T = 30.f;
typedef unsigned short bf16;
typedef short bf16x8 __attribute__((ext_vector_type(8)));
typedef short s16x4 __attribute__((ext_vector_type(4)));
typedef float f32x16 __attribute__((ext_vector_type(16)));
typedef float f32x4 __attribute__((ext_vector_type(4)));
typedef unsigned u32x4 __attribute__((ext_vector_type(4)));

#define KSWZ(row, colB) ((row) * 256 + ((colB) ^ (((row) & 7) << 4)))
#define SBAR() __builtin_amdgcn_sched_barrier(0)
__device__ __forceinline__ int v_st(int k, int c) { const int kk = (k & ~0xC) | ((k & 4) << 1) | ((k & 8) >> 1); return ((kk >> 3) * 4 + (c >> 5)) * 512 + ((kk & 7) * 32 + (c & 31)) * 2; }
__device__ __forceinline__ int v_rd_base(int lane) { return ((lane & 3) << 3) | (((lane >> 2) & 3) << 6) | (((lane >> 4) & 1) << 5) | (((lane >> 5) & 1) << 8); }
constexpr int v_rd_off(int d0, int ks, int half) { return d0 * 512 + ks * 4096 + half * 2048; }
__device__ __forceinline__ int crow(int r, int hi) { return (r & 3) + 8 * (r >> 2) + 4 * hi; }
__device__ __forceinline__ unsigned cvtpk(float lo, float hi) { unsigned r; asm volatile("v_cvt_pk_bf16_f32 %0, %1, %2" : "=v"(r) : "v"(lo), "v"(hi)); return r; }
__device__ __forceinline__ bf16x8 load8(const bf16* p) { return *reinterpret_cast<const bf16x8*>(p); }
__device__ __forceinline__ void mask_tile(f32x16& p0, f32x16& p1, int dq) {
    const float NEG = -__builtin_inff();
#pragma unroll
    for (int r = 0; r < 16; ++r) {
        const int c = (r & 3) + 8 * (r >> 2);
        if (dq - c < 0) p0[r] = NEG;
        if (dq - c - 32 < 0) p1[r] = NEG;
    }
}
__device__ __forceinline__ void partialSM(f32x16& p0, f32x16& p1, float& m_reg, float& mn, float& alpha) {
    float pmax = p0[0]; for (int r = 1; r < 16; ++r) pmax = fmaxf(pmax, p0[r]); for (int r = 0; r < 16; ++r) pmax = fmaxf(pmax, p1[r]);
    { auto rr = __builtin_amdgcn_permlane32_swap(__float_as_uint(pmax), __float_as_uint(pmax), false, false);
      pmax = fmaxf(__uint_as_float(rr[0]), __uint_as_float(rr[1])); }
    constexpr float C2 = 1.4426950408889634f * SCALE;
    if (__builtin_expect(__all((pmax - m_reg) * SCALE <= THR), 1)) { mn = m_reg; alpha = 1.f; }
    else { mn = fmaxf(m_reg, pmax); alpha = __builtin_amdgcn_exp2f((m_reg - mn) * C2); m_reg = mn; }
    const float mnL = -mn * C2;
    for (int r = 0; r < 16; ++r) p0[r] = fmaf(p0[r], C2, mnL); for (int r = 0; r < 16; ++r) p1[r] = fmaf(p1[r], C2, mnL);
    for (int r = 0; r < 16; ++r) p0[r] = __builtin_amdgcn_exp2f(p0[r]);
}
__device__ __forceinline__ void finishSM(f32x16& p0, f32x16& p1, float alpha, float& l_reg, bf16x8& pa0, bf16x8& pa1, bf16x8& pa2, bf16x8& pa3) {
    for (int r = 0; r < 16; ++r) p1[r] = __builtin_amdgcn_exp2f(p1[r]);
    float ps = 0; for (int r = 0; r < 16; ++r) ps += p0[r]; for (int r = 0; r < 16; ++r) ps += p1[r];
    { auto rr = __builtin_amdgcn_permlane32_swap(__float_as_uint(ps), __float_as_uint(ps), false, false);
      ps = __uint_as_float(rr[0]) + __uint_as_float(rr[1]); }
    l_reg = l_reg * alpha + ps;
#define PK4(P, B_, OUT) do { unsigned a0 = cvtpk(P[B_+0], P[B_+1]), a1 = cvtpk(P[B_+2], P[B_+3]);                          \
        unsigned b0 = cvtpk(P[B_+4], P[B_+5]), b1 = cvtpk(P[B_+6], P[B_+7]);                                             \
        auto r0 = __builtin_amdgcn_permlane32_swap(a0, b0, false, false); auto r1 = __builtin_amdgcn_permlane32_swap(a1, b1, false, false); \
        u32x4 w = {r0[0], r1[0], r0[1], r1[1]}; OUT = *reinterpret_cast<bf16x8*>(&w); } while (0)
    PK4(p0, 0, pa0); PK4(p0, 8, pa1); PK4(p1, 0, pa2); PK4(p1, 8, pa3);
}
template <int KB>
__device__ __forceinline__ void qkt(f32x16& p0, f32x16& p1, const char* K_lds, const char* B_lds, int r32, int hi, const bf16x8* qr) {
    const float* bl = (const float*)B_lds + KB * 64 + 4 * hi;
#pragma unroll
    for (int g = 0; g < 4; ++g) { const f32x4 a = *(const f32x4*)(bl + 8 * g), b = *(const f32x4*)(bl + 32 + 8 * g);
        p0[4 * g + 0] = a[0]; p0[4 * g + 1] = a[1]; p0[4 * g + 2] = a[2]; p0[4 * g + 3] = a[3];
        p1[4 * g + 0] = b[0]; p1[4 * g + 1] = b[1]; p1[4 * g + 2] = b[2]; p1[4 * g + 3] = b[3]; }
    const char* kb[4];
#pragma unroll
    for (int dd = 0; dd < 4; ++dd) kb[dd] = K_lds + KB * SHM_K + KSWZ(r32, (dd * 16 + hi * 8) * 2);
#pragma unroll
    for (int d0 = 0; d0 < 8; ++d0) { const char* a = kb[d0 & 3] + (d0 >> 2) * 128;
        bf16x8 b0 = *reinterpret_cast<const bf16x8*>(a);
        bf16x8 b1 = *reinterpret_cast<const bf16x8*>(a + 32 * 256);
        p0 = __builtin_amdgcn_mfma_f32_32x32x16_bf16(b0, qr[d0], p0, 0, 0, 0);
        p1 = __builtin_amdgcn_mfma_f32_32x32x16_bf16(b1, qr[d0], p1, 0, 0, 0); }
}
template <int VB>
__device__ __forceinline__ void pv_tile(f32x16* o, int vb0, bf16x8 pa0, bf16x8 pa1, bf16x8 pa2, bf16x8 pa3) {
#define TRRD(dst, off) asm volatile("ds_read_b64_tr_b16 %0, %1 offset:%2" : "=&v"(dst) : "v"(vb0), "i"(off) : "memory")
#define PV_D0(d0) do { s16x4 l0, l1, l2, l3, h0, h1, h2, h3; constexpr int b_ = VB * SHM_V + v_rd_off(d0, 0, 0);     \
        TRRD(l0, b_); TRRD(h0, b_ + 2048); TRRD(l1, b_ + 4096); TRRD(h1, b_ + 6144); TRRD(l2, b_ + 8192); TRRD(h2, b_ + 10240); TRRD(l3, b_ + 12288); TRRD(h3, b_ + 14336); \
        asm volatile("s_waitcnt lgkmcnt(0)" ::: "memory"); SBAR();                                                                              \
        o[d0] = __builtin_amdgcn_mfma_f32_32x32x16_bf16(pa0, (bf16x8){l0[0], l0[1], l0[2], l0[3], h0[0], h0[1], h0[2], h0[3]}, o[d0], 0, 0, 0);   \
        o[d0] = __builtin_amdgcn_mfma_f32_32x32x16_bf16(pa1, (bf16x8){l1[0], l1[1], l1[2], l1[3], h1[0], h1[1], h1[2], h1[3]}, o[d0], 0, 0, 0);   \
        o[d0] = __builtin_amdgcn_mfma_f32_32x32x16_bf16(pa2, (bf16x8){l2[0], l2[1], l2[2], l2[3], h2[0], h2[1], h2[2], h2[3]}, o[d0], 0, 0, 0);   \
        o[d0] = __builtin_amdgcn_mfma_f32_32x32x16_bf16(pa3, (bf16x8){l3[0], l3[1], l3[2], l3[3], h3[0], h3[1], h3[2], h3[3]}, o[d0], 0, 0, 0); } while (0)
    PV_D0(0); PV_D0(1); PV_D0(2); PV_D0(3);
#undef PV_D0
#undef TRRD
}

struct BlockRef { const bf16* Q; const bf16* K; const bf16* V; const float* C; bf16* O; int P0; int jlo; };
struct Seam {
    bf16x8 qr[8];
    bf16x8 st_v0, st_v1, st_k0, st_k1; float st_b;
};
#define ROW(p, k0, rr) ((p) + (size_t)((k0) + (rr)) * D + sc)
#define VMW() asm volatile("s_waitcnt vmcnt(0)" ::: "memory")
#define VMWN(n) asm volatile("s_waitcnt vmcnt(%0)" :: "i"(n) : "memory")
#define SLOAD_H(Kp, Vp, Cp, k0) do { S.st_v0 = load8(ROW(Vp, k0, sr)); S.st_v1 = load8(ROW(Vp, k0, 32 + sr));              \
                         S.st_k0 = load8(ROW(Kp, k0, sr)); S.st_k1 = load8(ROW(Kp, k0, 32 + sr)); if (tid < 64) S.st_b = (Cp)[(k0) + tid]; } while (0)
#define SWRITE_HK(bf, cr) do { *(bf16x8*)(K_lds + (bf) * SHM_K + kws) = S.st_k0; *(bf16x8*)(K_lds + (bf) * SHM_K + kws + 32 * 256) = S.st_k1; \
                         if (tid < 64) ((float*)B_lds)[(bf) * 64 + tid] = S.st_b - (cr); } while (0)
#define SWRITE_HV(bf) do { *(bf16x8*)(V_lds + (bf) * SHM_V + vst0) = S.st_v0; *(bf16x8*)(V_lds + (bf) * SHM_V + vst1) = S.st_v1; } while (0)
#define SWRITE_H(bf, cr) do { SWRITE_HV(bf); SWRITE_HK(bf, cr); } while (0)
__device__ __forceinline__ void fox_prime(const BlockRef& cur, char* lds, Seam& S) {
    const int tid = mk_tid(), wid = __builtin_amdgcn_readfirstlane(tid >> 6), lane = tid & 63, r32 = lane & 31, hi = lane >> 5;
    const int sr = tid >> 4, sc = (tid & 15) * 8, kws = KSWZ(sr, sc * 2); char* K_lds = lds + 2 * SHM_V; char* B_lds = lds + OFF_BIAS;
    const float cref = __uint_as_float(__builtin_amdgcn_readfirstlane(__float_as_uint(cur.C[cur.P0])));
    for (int d0 = 0; d0 < 8; ++d0) S.qr[d0] = load8(cur.Q + (size_t)(wid * QBLK + r32) * D + d0 * 16 + hi * 8);
    SLOAD_H(cur.K, cur.V, cur.C, cur.jlo * KVBLK); VMW(); SWRITE_HK(0, cref);
    __syncthreads();
}
template <class NextFn> __device__ __forceinline__ BlockRef fox_block(const BlockRef& cur, char* lds, Seam& S, unsigned* qctr, const NextFn& mkref, bool& has_next) {
    const int tid = mk_tid(), wid = __builtin_amdgcn_readfirstlane(tid >> 6), lane = tid & 63, r32 = lane & 31, hi = lane >> 5;
    const int j_lo = cur.jlo, NT = (cur.P0 + QB - 1) / KVBLK + 1 - j_lo;
    unsigned qv = 0u; if (tid == 0) qv = __hip_atomic_fetch_add(qctr, 1u, __ATOMIC_RELAXED, __HIP_MEMORY_SCOPE_AGENT);
    const int qlo = cur.P0 + wid * QBLK, qm = qlo + r32 - 4 * hi;
    char* V_lds = lds; char* K_lds = lds + 2 * SHM_V; char* B_lds = lds + OFF_BIAS;
    float* ws = (float*)(lds + OFF_WS) + wid * 64; float* li_l = ws, * al_l = ws + 32;
    float m_reg = -1e30f, l_reg = 0; f32x16 o[4] = {};
    const int sr = tid >> 4, sc = (tid & 15) * 8, vst0 = v_st(sr, sc), vst1 = v_st(32 + sr, sc), kws = KSWZ(sr, sc * 2);
    const int vb0 = (int)(uintptr_t)V_lds + v_rd_base(lane);
    const bf16* Kh = cur.K; const bf16* Vh = cur.V; const float* Ch = cur.C;
    const float cref = __uint_as_float(__builtin_amdgcn_readfirstlane(__float_as_uint(cur.C[cur.P0])));
#define RESC(a) do { if (__any((a) < 1.f)) { if (hi == 0) al_l[r32] = (a); asm volatile("s_waitcnt lgkmcnt(0)" ::: "memory");              \
                     for (int d_ = 0; d_ < 4; ++d_) for (int r = 0; r < 16; ++r) o[d_][r] *= al_l[crow(r, hi)]; } } while (0)
#define KBASE(t) ((j_lo + (t)) * KVBLK)
#define MASKT(P0_, P1_, t) do { const int kb_ = KBASE(t); if (kb_ + KVBLK - 1 > qlo) mask_tile(P0_, P1_, qm - kb_); } while (0)
    constexpr int NQL = 8;
#define SEAM_K0() do { VMWN(NQL); SWRITE_HK(0, crefn); SBAR(); } while (0)
    f32x16 pA0, pA1, pB0, pB1; float mnA, mnB, alA, alB; bf16x8 pa0, pa1, pa2, pa3;
    SWRITE_HV(0); SBAR();
    if (NT > 1) { SLOAD_H(Kh, Vh, Ch, KBASE(1)); }
    SBAR(); qkt<0>(pA0, pA1, K_lds, B_lds, r32, hi, S.qr);
    MASKT(pA0, pA1, 0); partialSM(pA0, pA1, m_reg, mnA, alA);
    if (NT > 1) { VMW(); SWRITE_H(1, cref); }
    if (tid == 0) *(volatile LAS3 unsigned*)(lds + OFF_QW) = qv;
    __syncthreads();
    const unsigned inext = (unsigned)__builtin_amdgcn_readfirstlane((int)*(volatile LAS3 unsigned*)(lds + OFF_QW)); has_next = inext < (unsigned)(NH * (SEQ / QB));
    const BlockRef nxt = has_next ? mkref((int)inext) : cur;
    const float crefn = __uint_as_float(__builtin_amdgcn_readfirstlane(__float_as_uint(nxt.C[nxt.P0]))); const int kbn = nxt.jlo * KVBLK;
#define HALF_STEP(PX0, PX1, mnX, alX, PY0, PY1, alY, t, KB, VB, SB) do {                                                      \
        SBAR(); qkt<KB>(PX0, PX1, K_lds, B_lds, r32, hi, S.qr);                                                               \
        finishSM(PY0, PY1, alY, l_reg, pa0, pa1, pa2, pa3); SBAR();                                                           \
        if ((t) + 1 < NT) { SLOAD_H(Kh, Vh, Ch, KBASE((t) + 1)); SBAR(); }                                                    \
        pv_tile<VB>(o, vb0, pa0, pa1, pa2, pa3); MASKT(PX0, PX1, (t)); partialSM(PX0, PX1, m_reg, mnX, alX);                  \
        __syncthreads();                                                                                                      \
        if ((t) + 1 < NT) { VMW(); SWRITE_H(SB, cref); }                                                                      \
        RESC(alX); __syncthreads(); } while (0)
    for (int t = 1; t + 1 < NT; t += 2) {
        HALF_STEP(pB0, pB1, mnB, alB, pA0, pA1, alA, t, 1, 0, 0);
        HALF_STEP(pA0, pA1, mnA, alA, pB0, pB1, alB, t + 1, 0, 1, 1);
    }
    const bool even = (NT & 1) == 0;
    if (even) { SBAR(); qkt<1>(pB0, pB1, K_lds, B_lds, r32, hi, S.qr); SBAR(); }
    SLOAD_H(nxt.K, nxt.V, nxt.C, kbn); SBAR();
#pragma unroll
    for (int d0 = 0; d0 < 8; ++d0) S.qr[d0] = load8(nxt.Q + (size_t)(wid * QBLK + r32) * D + d0 * 16 + hi * 8);
    SBAR();
    finishSM(pA0, pA1, alA, l_reg, pa0, pa1, pa2, pa3); SBAR();
    pv_tile<0>(o, vb0, pa0, pa1, pa2, pa3);
    if (even) { MASKT(pB0, pB1, NT - 1); partialSM(pB0, pB1, m_reg, mnB, alB); __syncthreads(); RESC(alB);
        finishSM(pB0, pB1, alB, l_reg, pa0, pa1, pa2, pa3); SBAR(); pv_tile<1>(o, vb0, pa0, pa1, pa2, pa3); }
    SBAR(); SEAM_K0();
    if (hi == 0) li_l[r32] = l_reg; asm volatile("s_waitcnt lgkmcnt(0)" ::: "memory");
    float rli[16];
#pragma unroll
    for (int r = 0; r < 16; ++r) rli[r] = __builtin_amdgcn_rcpf(li_l[crow(r, hi)]);
    bf16* Ow = cur.O + (size_t)(wid * QBLK) * OPITCH;
#pragma unroll
    for (int r = 0; r < 16; ++r) { const int orow = crow(r, hi);
#pragma unroll
        for (int d0 = 0; d0 < 4; ++d0) { const float v = o[d0][r] * rli[r];
            const float vn = __shfl_xor(v, 1);
            if ((r32 & 1) == 0) *(unsigned*)(Ow + (size_t)orow * OPITCH + d0 * 32 + r32) = cvtpk(v, vn); } }
    __syncthreads();
    return nxt;
#undef RESC
#undef KBASE
#undef MASKT
#undef SEAM_K0
#undef HALF_STEP
}
#undef ROW
#undef VMW
#undef VMWN
#undef SLOAD_H
#undef SWRITE_HK
#undef SWRITE_HV
#undef SWRITE_H
#undef PK4

__device__ __forceinline__ BlockRef fox_ref(int item, const bf16* Q, const bf16* K, const bf16* V, const float* Cn, bf16* O, const char* lds) {
    const int qb = SEQ / QB - 1 - (item >> 5), bh = item & 31;
    BlockRef r; r.Q = Q + ((size_t)bh * SEQ + (size_t)qb * QB) * D; r.K = K + (size_t)bh * SEQ * D; r.V = V + (size_t)bh * SEQ * D; r.C = Cn + (size_t)bh * SEQ;
    r.O = O + (size_t)(qb * QB) * OPITCH + bh * D; r.P0 = qb * QB; r.jlo = (int)((const unsigned char*)(lds + OFF_JLO))[bh * 64 + qb]; return r;
}
__device__ __forceinline__ void fox_attn_phase(char* lds, const bf16* Q, const bf16* K, const bf16* V, const float* Cn, const unsigned* nrm2, unsigned* qctr, bf16* O) {
    const int tid = mk_tid();
    {
        int lo[4], hi[4]; float thr[4]; const float* Cb[4];
#pragma unroll
        for (int k = 0; k < 4; ++k) { const int e = tid + 512 * k, bh = e >> 6, qb = e & 63, P0 = qb * QB; Cb[k] = Cn + (size_t)bh * SEQ;
            const float qn2 = __uint_as_float(nrm2[bh]), kn2 = __uint_as_float(nrm2[32 + bh]);
            const float Dh = SKIP_T * (1.0f / SCALE) + 2.04f * sqrtf(qn2 * kn2) + 1.0f;
            thr[k] = Cb[k][P0] - Dh; lo[k] = 0; hi[k] = P0 / KVBLK; }
#pragma unroll 1
        for (int it = 0; it < 8; ++it) {
            float v[4]; int mid[4];
#pragma unroll
            for (int k = 0; k < 4; ++k) { mid[k] = (lo[k] + hi[k]) >> 1; v[k] = Cb[k][mid[k] * KVBLK + KVBLK - 1]; }
#pragma unroll
            for (int k = 0; k < 4; ++k) if (lo[k] < hi[k]) { if (v[k] < thr[k]) lo[k] = mid[k] + 1; else hi[k] = mid[k]; }
        }
#pragma unroll
        for (int k = 0; k < 4; ++k) ((unsigned char*)(lds + OFF_JLO))[tid + 512 * k] = (unsigned char)lo[k];
    }
    if (tid == 0) *(volatile LAS3 unsigned*)(lds + OFF_QW) = __hip_atomic_fetch_add(qctr, 1u, __ATOMIC_RELAXED, __HIP_MEMORY_SCOPE_AGENT);
    __syncthreads();
    const unsigned i0 = (unsigned)__builtin_amdgcn_readfirstlane((int)*(volatile LAS3 unsigned*)(lds + OFF_QW));
    if (i0 >= (unsigned)(NH * (SEQ / QB))) return;
    __syncthreads();
    auto mk = [=](int item) { return fox_ref(item, Q, K, V, Cn, O, lds); };
    BlockRef cur = mk((int)i0);
    Seam S;
    fox_prime(cur, lds, S);
    for (;;) { bool has_next; const BlockRef nxt = fox_block(cur, lds, S, qctr, mk, has_next); if (!has_next) break; cur = nxt; }
}
#undef LAS3
#undef KSWZ
#undef SBAR
}

namespace swa {
constexpr int SEQ = 16384, QKVP = 5120, OP = 4096;
constexpr int K_OFF = 0, VT_OFF = 32768, VT_PITCH = 528, LI_OFF = VT_OFF + 64 * VT_PITCH, LDS_BYTES = LI_OFF + 8 * 32 * 4;
typedef unsigned short bf16;
typedef short bf16x8 __attribute__((ext_vector_type(8)));
typedef float f32x16 __attribute__((ext_vector_type(16)));
typedef float f32x4 __attribute__((ext_vector_type(4)));
typedef unsigned u32x4 __attribute__((ext_vector_type(4)));
__device__ __forceinline__ int crow(int r, int hi) { return (r & 3) + 8 * (r >> 2) + 4 * hi; }
__device__ __forceinline__ unsigned cvtpk(float lo, float hi) { unsigned r; asm volatile("v_cvt_pk_bf16_f32 %0, %1, %2" : "=v"(r) : "v"(lo), "v"(hi)); return r; }
__device__ __forceinline__ float bf2f(short b) { return __uint_as_float(((unsigned)(unsigned short)b) << 16); }
__device__ __forceinline__ bf16x8 pack8(const float* v) { u32x4 w = {cvtpk(v[0], v[1]), cvtpk(v[2], v[3]), cvtpk(v[4], v[5]), cvtpk(v[6], v[7])}; return *reinterpret_cast<bf16x8*>(&w); }
#define SWA_PK4(P, B_, OUT) do { unsigned a0 = cvtpk(P[B_+0], P[B_+1]), a1 = cvtpk(P[B_+2], P[B_+3]);                          \
        unsigned b0 = cvtpk(P[B_+4], P[B_+5]), b1 = cvtpk(P[B_+6], P[B_+7]);                                             \
        auto r0 = __builtin_amdgcn_permlane32_swap(a0, b0, false, false); auto r1 = __builtin_amdgcn_permlane32_swap(a1, b1, false, false); \
        u32x4 w = {r0[0], r1[0], r0[1], r1[1]}; OUT = *reinterpret_cast<bf16x8*>(&w); } while (0)

__device__ __forceinline__ void swa_attn_phase(char* lds, const bf16* QKV, const float* sinks, const float* cosT, const float* sinT, bf16* O, int wg, int G) {
    const int tid = mk_tid(), wid = __builtin_amdgcn_readfirstlane(tid >> 6), lane = tid & 63, r32 = lane & 31, hi = lane >> 5;
    float* li_l = (float*)(lds + LI_OFF) + wid * 32;
    for (int L = wg; L < 1024; L += G) {
        const int g = L & 7, n = L >> 3;
        __syncthreads();
        {
            const int row = tid >> 1, half = tid & 1, kpos = 128 * (n - 1) + row;
            bf16x8 kc[4], vc[4];
            if (kpos >= 0) {
                const bf16* kp = QKV + (size_t)kpos * QKVP + 4096 + g * 64 + half * 32; const bf16* vp = kp + 512;
#pragma unroll
                for (int c = 0; c < 4; ++c) { kc[c] = *(const bf16x8*)(kp + 8 * c); vc[c] = *(const bf16x8*)(vp + 8 * c); }
                if (half == 0) {
                    const f32x4 c0 = *(const f32x4*)(cosT + (size_t)kpos * 8), c1 = *(const f32x4*)(cosT + (size_t)kpos * 8 + 4);
                    const f32x4 s0 = *(const f32x4*)(sinT + (size_t)kpos * 8), s1 = *(const f32x4*)(sinT + (size_t)kpos * 8 + 4);
                    float o1[8], o2[8];
#pragma unroll
                    for (int i = 0; i < 8; ++i) { const float cs = i < 4 ? c0[i & 3] : c1[i & 3], sn = i < 4 ? s0[i & 3] : s1[i & 3];
                        const float x1 = bf2f(kc[0][i]), x2 = bf2f(kc[1][i]); o1[i] = x1 * cs - x2 * sn; o2[i] = x2 * cs + x1 * sn; }
                    kc[0] = pack8(o1); kc[1] = pack8(o2);
                }
            } else {
#pragma unroll
                for (int c = 0; c < 4; ++c) { kc[c] = (bf16x8){0, 0, 0, 0, 0, 0, 0, 0}; vc[c] = (bf16x8){0, 0, 0, 0, 0, 0, 0, 0}; }
            }
#pragma unroll
            for (int c = 0; c < 4; ++c) { const int chunk = half * 4 + c;
                *(bf16x8*)(lds + K_OFF + row * 128 + ((chunk ^ ((row >> 1) & 7)) << 4)) = kc[c];
#pragma unroll
                for (int j = 0; j < 8; ++j) *(short*)(lds + VT_OFF + (half * 32 + c * 8 + j) * VT_PITCH + row * 2) = vc[c][j]; }
        }
        __syncthreads();
        const int hq = g * 8 + wid; const float sink = sinks[hq];
        for (int a = 0; a < 4; ++a) {
            const int t = 128 * n + 32 * a + r32;
            const bf16* qp = QKV + (size_t)t * QKVP + hq * 64;
            bf16x8 qr[4];
#pragma unroll
            for (int d0 = 0; d0 < 4; ++d0) qr[d0] = *(const bf16x8*)(qp + 16 * d0 + 8 * hi);
            {
                const bf16x8 pr = *(const bf16x8*)(qp + 8 * (1 - hi));
                const f32x4 c0 = *(const f32x4*)(cosT + (size_t)t * 8), c1 = *(const f32x4*)(cosT + (size_t)t * 8 + 4);
                const f32x4 s0 = *(const f32x4*)(sinT + (size_t)t * 8), s1 = *(const f32x4*)(sinT + (size_t)t * 8 + 4);
                float ov[8];
#pragma unroll
                for (int i = 0; i < 8; ++i) { const float cs = i < 4 ? c0[i & 3] : c1[i & 3], sn = i < 4 ? s0[i & 3] : s1[i & 3];
                    const float own = bf2f(qr[0][i]), par = bf2f(pr[i]); ov[i] = own * cs + (hi ? par : -par) * sn; }
                qr[0] = pack8(ov);
            }
            f32x16 p[5];
#pragma unroll
            for (int bi = 0; bi < 5; ++bi) { const int row = 32 * (a + bi) + r32; const char* kb = lds + K_OFF + row * 128; const int sw = (row >> 1) & 7;
                f32x16 acc = {};
#pragma unroll
                for (int d0 = 0; d0 < 4; ++d0) { const bf16x8 kf = *(const bf16x8*)(kb + (((2 * d0 + hi) ^ sw) << 4)); acc = __builtin_amdgcn_mfma_f32_32x32x16_bf16(kf, qr[d0], acc, 0, 0, 0); }
                p[bi] = acc; }
            const float NEG = -__builtin_inff();
#pragma unroll
            for (int r = 0; r < 16; ++r) { const int c = crow(r, hi); if (!(c > r32)) p[0][r] = NEG; if (!(c <= r32)) p[4][r] = NEG; }
            if (n == 0) {
#pragma unroll
                for (int bi = 0; bi < 4; ++bi) if (a + bi < 4) {
#pragma unroll
                    for (int r = 0; r < 16; ++r) p[bi][r] = NEG; }
            }
            float mx = NEG;
#pragma unroll
            for (int bi = 0; bi < 5; ++bi)
#pragma unroll
                for (int r = 0; r < 16; ++r) mx = fmaxf(mx, p[bi][r]);
            { auto rr = __builtin_amdgcn_permlane32_swap(__float_as_uint(mx), __float_as_uint(mx), false, false); mx = fmaxf(__uint_as_float(rr[0]), __uint_as_float(rr[1])); }
            const float m = fmaxf(mx * 0.125f, sink);
            constexpr float LOG2E = 1.4426950408889634f, C2 = 0.125f * LOG2E;
            const float mL = -m * LOG2E;
            float ps = 0.f;
#pragma unroll
            for (int bi = 0; bi < 5; ++bi)
#pragma unroll
                for (int r = 0; r < 16; ++r) { const float e = __builtin_amdgcn_exp2f(fmaf(p[bi][r], C2, mL)); p[bi][r] = e; ps += e; }
            { auto rr = __builtin_amdgcn_permlane32_swap(__float_as_uint(ps), __float_as_uint(ps), false, false); ps = __uint_as_float(rr[0]) + __uint_as_float(rr[1]); }
            const float l = ps + __builtin_amdgcn_exp2f(fmaf(sink, LOG2E, mL));
            f32x16 o[2] = {};
#pragma unroll
            for (int bi = 0; bi < 5; ++bi) { bf16x8 pa[2]; SWA_PK4(p[bi], 0, pa[0]); SWA_PK4(p[bi], 8, pa[1]);
#pragma unroll
                for (int ks = 0; ks < 2; ++ks)
#pragma unroll
                    for (int db = 0; db < 2; ++db) { const bf16x8 vf = *(const bf16x8*)(lds + VT_OFF + (32 * db + r32) * VT_PITCH + (32 * (a + bi) + 16 * ks + 8 * hi) * 2);
                        o[db] = __builtin_amdgcn_mfma_f32_32x32x16_bf16(pa[ks], vf, o[db], 0, 0, 0); } }
            if (hi == 0) li_l[r32] = l; asm volatile("s_waitcnt lgkmcnt(0)" ::: "memory");
            bf16* Ow = O + (size_t)(128 * n + 32 * a) * OP + hq * 64;
#pragma unroll
            for (int r = 0; r < 16; ++r) { const int orow = crow(r, hi); const float rl = __builtin_amdgcn_rcpf(li_l[orow]);
#pragma unroll
                for (int db = 0; db < 2; ++db) { const float v = o[db][r] * rl; const float vn = __shfl_xor(v, 1);
                    if ((r32 & 1) == 0) *(unsigned*)(Ow + (size_t)orow * OP + db * 32 + r32) = cvtpk(v, vn); } }
            asm volatile("s_waitcnt lgkmcnt(0)" ::: "memory");
        }
    }
    __syncthreads();
}
#undef SWA_PK4
}

#define LAS __attribute__((address_space(3)))
#define GAS __attribute__((address_space(1)))
typedef unsigned short bf16;
typedef float f32x4 __attribute__((ext_vector_type(4)));
typedef unsigned u32x4 __attribute__((ext_vector_type(4)));
typedef unsigned u32x2 __attribute__((ext_vector_type(2)));
typedef short bf16x8 __attribute__((ext_vector_type(8)));
constexpr int SEQ = 16384, DM = 4096, DFF = 11008;
constexpr float NORM_EPS = 1e-6f;
__device__ __forceinline__ unsigned cvtpk(float lo, float hi) { unsigned r; asm volatile("v_cvt_pk_bf16_f32 %0, %1, %2" : "=v"(r) : "v"(lo), "v"(hi)); return r; }
__device__ __forceinline__ float bf_lo(unsigned w) { return __uint_as_float(w << 16); }
__device__ __forceinline__ float bf_hi(unsigned w) { return __uint_as_float(w & 0xffff0000u); }
__device__ __forceinline__ float wave_sum(float v) {
#pragma unroll
    for (int o = 1; o < 64; o <<= 1) v += __shfl_xor(v, o);
    return v;
}
__device__ __forceinline__ float gelu_tanh(float x) {
    const float u = 0.7978845608028654f * (x + 0.044715f * x * x * x);
    return x * __builtin_amdgcn_rcpf(1.0f + __builtin_amdgcn_exp2f(-2.8853900817779268f * u));
}
__device__ __forceinline__ void sincos_d(double a, double& s, double& c) {
    const double k = rint(a * 0.15915494309189535);
    double r = fma(-k, 6.283185307179586, a); r = fma(-k, 2.4492935982947064e-16, r);
    const double r2 = r * r; double ss = 1.0, cc = 1.0;
#pragma unroll
    for (int n = 29; n >= 3; n -= 2) ss = fma(-ss * r2, 1.0 / (double)(n * (n - 1)), 1.0);
#pragma unroll
    for (int n = 28; n >= 2; n -= 2) cc = fma(-cc * r2, 1.0 / (double)(n * (n - 1)), 1.0);
    s = r * ss; c = cc;
}
__device__ __forceinline__ double exp_d(double x) {
    const double k = rint(x * 1.4426950408889634);
    double r = fma(-k, 0.6931471803691238, x); r = fma(-k, 1.9082149292705877e-10, r);
    double p = 1.0;
#pragma unroll
    for (int n = 16; n >= 1; --n) p = fma(p * r, 1.0 / (double)n, 1.0);
    return ldexp(p, (int)k);
}

__device__ __forceinline__ void transpose_item(const float* __restrict__ W, int K, int N, bf16* __restrict__ WT, int mode, LAS unsigned* scr, int item, int lane) {
    const int nblk = (N + 63) / 64, kb = item / nblk, nb = item - kb * nblk, k0 = 128 * kb, n0 = 64 * nb;
    int r0 = n0; if (mode == 1) { const int bj = n0 >> 12, rem = n0 & 4095; r0 = ((rem >> 7) << 8) + (bj << 7) + (rem & 127); }
    if (mode == 2) { const int bj = n0 >= DFF ? 1 : 0, rem = n0 - bj * DFF; r0 = ((rem >> 7) << 8) + (bj << 7) + (rem & 127); }
    const int c = lane & 15, kq = lane >> 4;
    const bool ok = n0 + 4 * c < N;
    const float* src = W + (size_t)(k0 + 2 * kq) * N + n0 + 4 * c;
    LAS unsigned* sw = scr + (4 * c) * 65 + kq;
#pragma unroll
    for (int half = 0; half < 2; ++half) {
        f32x4 a[8], b[8]; const f32x4 z = {0.f, 0.f, 0.f, 0.f};
#pragma unroll
        for (int p = 0; p < 8; ++p) { const float* s = src + (size_t)(8 * (8 * half + p)) * N;
            a[p] = ok ? __builtin_nontemporal_load((const f32x4*)s) : z; b[p] = ok ? __builtin_nontemporal_load((const f32x4*)(s + N)) : z; }
#pragma unroll
        for (int p = 0; p < 8; ++p)
#pragma unroll
            for (int q = 0; q < 4; ++q) sw[q * 65 + 4 * (8 * half + p)] = cvtpk(a[p][q], b[p][q]);
    }
    asm volatile("s_waitcnt lgkmcnt(0)" ::: "memory");
#pragma unroll
    for (int j = 0; j < 16; ++j) { const int n = 4 * j + kq; const LAS unsigned* s = scr + n * 65 + 4 * c;
        u32x4 o; o.x = s[0]; o.y = s[1]; o.z = s[2]; o.w = s[3];
        if (n0 + n < N) *(u32x4*)(WT + (size_t)(r0 + n) * K + k0 + 8 * c) = o; }
    asm volatile("s_waitcnt lgkmcnt(0)" ::: "memory");
}

__device__ __forceinline__ void norm_phase(int gw, int ngw, int lane, LAS unsigned char* stg, const bf16* tmp, const float* gpost, const float* hin, float* hout, const float* gpre, bf16* xn, float* U, float tscale = 1.0f) {
    for (int m = gw; m < SEQ; m += ngw) {
        f32x4 h[16];
        const f32x4* hr = (const f32x4*)(hin + (size_t)m * DM) + lane;
        if (tmp) {
            const u32x4* tr = (const u32x4*)(tmp + (size_t)m * DM) + lane; u32x4 tq[8]; float ss = 0.f;
#pragma unroll
            for (int j = 0; j < 8; ++j) tq[j] = __builtin_nontemporal_load(tr + 64 * j);
#pragma unroll
            for (int j = 0; j < 16; ++j) h[j] = __builtin_nontemporal_load(hr + 64 * j);
#pragma unroll
            for (int j = 0; j < 8; ++j) {
#pragma unroll
                for (int q = 0; q < 4; ++q) { const float a = bf_lo(tq[j][q]), b = bf_hi(tq[j][q]); ss += a * a + b * b; }
                *(LAS u32x4*)(stg + 1024 * j + 16 * lane) = tq[j]; }
            asm volatile("" ::: "memory");
            const float r = tscale / sqrtf(wave_sum(ss) * (1.0f / DM) + NORM_EPS);
            f32x4* ho = (f32x4*)(hout + (size_t)m * DM) + lane; const f32x4* gp = (const f32x4*)gpost + lane;
#pragma unroll
            for (int j = 0; j < 16; ++j) { const u32x2 w = *(const LAS u32x2*)(stg + 512 * j + 8 * lane); const f32x4 t = {bf_lo(w.x), bf_hi(w.x), bf_lo(w.y), bf_hi(w.y)};
                h[j] = h[j] + (t * r) * gp[64 * j]; __builtin_nontemporal_store(h[j], ho + 64 * j); }
        } else {
#pragma unroll
            for (int j = 0; j < 16; ++j) h[j] = hr[64 * j];
        }
        if (gpre) {
            float ss = 0.f;
#pragma unroll
            for (int j = 0; j < 16; ++j) ss += (h[j].x * h[j].x + h[j].y * h[j].y) + (h[j].z * h[j].z + h[j].w * h[j].w);
            const float r = 1.0f / sqrtf(wave_sum(ss) * (1.0f / DM) + NORM_EPS);
            const f32x4* gp = (const f32x4*)gpre + lane;
            if (xn) { u32x4* o16 = (u32x4*)(xn + (size_t)m * DM) + lane;
                asm volatile("" ::: "memory");
#pragma unroll
                for (int j = 0; j < 16; ++j) { const f32x4 v = (h[j] * r) * gp[64 * j]; u32x2 w; w.x = cvtpk(v.x, v.y); w.y = cvtpk(v.z, v.w); *(LAS u32x2*)(stg + 512 * j + 8 * lane) = w; }
                asm volatile("" ::: "memory");
#pragma unroll
                for (int j = 0; j < 8; ++j) o16[64 * j] = *(const LAS u32x4*)(stg + 1024 * j + 16 * lane);
                asm volatile("" ::: "memory"); }
            if (U) {
#pragma unroll
                for (int j = 0; j < 16; ++j) { const f32x4 v = (h[j] * r) * gp[64 * j];
                    *(f32x4*)(U + ((size_t)((lane >> 2) + 16 * j) * SEQ + m) * 16 + 4 * (lane & 3)) = v; } }
        }
    }
}

__device__ __forceinline__ void fox_cumsum_phase(char* lds, const float* __restrict__ logf, float* __restrict__ cneg, int wg, int G, int tid) {
    double* wtot = (double*)lds; const int lane = tid & 63, wid = tid >> 6;
    for (int h = wg; h < 32; h += G) {
        float v[32]; double s = 0.0;
#pragma unroll
        for (int j = 0; j < 32; ++j) { v[j] = logf[(size_t)(32 * tid + j) * 32 + h]; s += (double)v[j]; }
        double inc = s;
#pragma unroll
        for (int o = 1; o < 64; o <<= 1) { const double t = __shfl_up(inc, o); if (lane >= o) inc += t; }
        __syncthreads();
        if (lane == 63) wtot[wid] = inc;
        __syncthreads();
        double run = inc - s;
#pragma unroll
        for (int w = 0; w < 8; ++w) if (w < wid) run += wtot[w];
#pragma unroll
        for (int j = 0; j < 32; ++j) { run += (double)v[j]; cneg[(size_t)h * SEQ + 32 * tid + j] = (float)(-run * 11.313708498984761); }
    }
}

__device__ __forceinline__ void fox_norms_phase(const bf16* __restrict__ QK, unsigned* nrm2, int gw, int ngw, int lane) {
    for (int base = gw * 128; base < 64 * SEQ; base += ngw * 128) {
        const u32x4* p = (const u32x4*)(QK + (size_t)base * 128) + lane; float mx = 0.f;
#pragma unroll 8
        for (int i = 0; i < 32; ++i) { const u32x4 w = p[(size_t)i * 64]; float s = 0.f;
#pragma unroll
            for (int q = 0; q < 4; ++q) { const float a = bf_lo(w[q]), b = bf_hi(w[q]); s = fmaf(a, a, s); s = fmaf(b, b, s); }
            s += __shfl_xor(s, 1); s += __shfl_xor(s, 2); s += __shfl_xor(s, 4); s += __shfl_xor(s, 8); mx = fmaxf(mx, s); }
        mx = fmaxf(mx, __shfl_xor(mx, 16)); mx = fmaxf(mx, __shfl_xor(mx, 32));
        if (lane == 0) __hip_atomic_fetch_max(nrm2 + base / SEQ, __float_as_uint(mx), __ATOMIC_RELAXED, __HIP_MEMORY_SCOPE_AGENT);
    }
}

namespace s5 {
typedef float f32x16 __attribute__((ext_vector_type(16)));
constexpr int NG = 256, SEGL = 2048, XP = 272, WAVE_BYTES = 2048 + 32 * XP, E_OFF = 8 * WAVE_BYTES, LDS_BYTES = E_OFF + 8 * 128 * 4;
__device__ __forceinline__ bf16x8 pack8(f32x4 a, f32x4 b) { u32x4 w = {cvtpk(a[0], a[1]), cvtpk(a[2], a[3]), cvtpk(b[0], b[1]), cvtpk(b[2], b[3])}; return *reinterpret_cast<bf16x8*>(&w); }
__device__ __forceinline__ void state_consts(float lam_re_raw, float lam_im_raw, double dt, double& lbr, double& lbi, double& cfr, double& cfi, double& lre_o, double& lim_o) {
    const double lre = (double)fminf(lam_re_raw, -1e-4f), lim = (double)lam_im_raw; double sn, cs; sincos_d(lim * dt, sn, cs); const double er = exp_d(lre * dt);
    lbr = er * cs; lbi = er * sn; const double a = lbr - 1.0, b = lbi, den = 1.0 / (lre * lre + lim * lim); cfr = (a * lre + b * lim) * den; cfi = (b * lre - a * lim) * den; lre_o = lre; lim_o = lim;
}
__device__ __forceinline__ void s5_phase(char* lds, const float* __restrict__ U, const float* __restrict__ lam_re, const float* __restrict__ lam_im, const float* __restrict__ log_dt,
                                         const float* __restrict__ b_re, const float* __restrict__ b_im, const float* __restrict__ c_re, const float* __restrict__ c_im,
                                         const float* __restrict__ dskip, bf16* __restrict__ Gout, int wg, int G) {
    const int tid = mk_tid(), wid = __builtin_amdgcn_readfirstlane(tid >> 6), lane = tid & 63, r32 = lane & 31, hi = lane >> 5, l15 = lane & 15, q4 = lane >> 4;
    float* ublk = (float*)(lds + wid * WAVE_BYTES); char* xblk = lds + wid * WAVE_BYTES + 2048; float* Ebuf = (float*)(lds + E_OFF);
    for (int g = wg; g < NG; g += G) {
        float lr, li, l2r, l2i; bf16x8 Bf[4], Cf[4]; const float dsk = dskip[16 * g + l15];
        {
            const double dt = exp_d((double)log_dt[g]);
            { double lbr, lbi, cfr, cfi, lre, lim; state_consts(lam_re[g * 64 + lane], lam_im[g * 64 + lane], dt, lbr, lbi, cfr, cfi, lre, lim); lr = (float)lbr; li = (float)lbi;
              double sn2, cs2; sincos_d(lim * dt * (double)SEGL, sn2, cs2); const double e2 = exp_d(lre * dt * (double)SEGL); l2r = (float)(e2 * cs2); l2i = (float)(e2 * sn2); }
#pragma unroll
            for (int sb = 0; sb < 2; ++sb) { const int st = 32 * sb + r32; double lbr, lbi, cfr, cfi, lre, lim; state_consts(lam_re[g * 64 + st], lam_im[g * 64 + st], dt, lbr, lbi, cfr, cfi, lre, lim);
                const f32x4* br = (const f32x4*)(b_re + ((size_t)g * 64 + st) * 16 + 8 * hi); const f32x4* bi = (const f32x4*)(b_im + ((size_t)g * 64 + st) * 16 + 8 * hi);
                const f32x4 vr0 = br[0], vr1 = br[1], vi0 = bi[0], vi1 = bi[1]; f32x4 or0, or1, oi0, oi1;
#pragma unroll
                for (int i = 0; i < 4; ++i) { or0[i] = (float)(cfr * (double)vr0[i] - cfi * (double)vi0[i]); or1[i] = (float)(cfr * (double)vr1[i] - cfi * (double)vi1[i]);
                                              oi0[i] = (float)(cfr * (double)vi0[i] + cfi * (double)vr0[i]); oi1[i] = (float)(cfr * (double)vi1[i] + cfi * (double)vr1[i]); }
                Bf[sb] = pack8(or0, or1); Bf[2 + sb] = pack8(oi0, oi1); }
#pragma unroll
            for (int kk = 0; kk < 4; ++kk) { const float* cp = (kk < 2 ? c_re : c_im) + ((size_t)g * 16 + l15) * 64 + 32 * (kk & 1) + 8 * q4; const float sg = kk < 2 ? 1.f : -1.f;
                const f32x4 v0 = *(const f32x4*)cp, v1 = *(const f32x4*)(cp + 4); Cf[kk] = pack8(v0 * sg, v1 * sg); }
        }
        const float* Ug = U + ((size_t)g * SEQ + (size_t)wid * SEGL) * 16;
        float xr = 0.f, xi = 0.f;
#pragma unroll 1
        for (int pass = 0; pass < 2; ++pass) {
            f32x4 ua0, ua1; { const f32x4* up = (const f32x4*)(Ug + (size_t)r32 * 16 + 8 * hi); ua0 = up[0]; ua1 = up[1]; }
#pragma unroll 1
            for (int blk = 0; blk < SEGL / 32; ++blk) {
                f32x4 un0 = ua0, un1 = ua1;
                if (blk + 1 < SEGL / 32) { const f32x4* up = (const f32x4*)(Ug + ((size_t)(blk + 1) * 32 + r32) * 16 + 8 * hi); un0 = up[0]; un1 = up[1]; }
                const bf16x8 af = pack8(ua0, ua1);
                if (pass) { *(f32x4*)(ublk + r32 * 16 + 8 * hi) = ua0; *(f32x4*)(ublk + r32 * 16 + 8 * hi + 4) = ua1; }
                f32x16 a0 = {}, a1 = {}, a2 = {}, a3 = {};
                a0 = __builtin_amdgcn_mfma_f32_32x32x16_bf16(af, Bf[0], a0, 0, 0, 0); a1 = __builtin_amdgcn_mfma_f32_32x32x16_bf16(af, Bf[1], a1, 0, 0, 0);
                a2 = __builtin_amdgcn_mfma_f32_32x32x16_bf16(af, Bf[2], a2, 0, 0, 0); a3 = __builtin_amdgcn_mfma_f32_32x32x16_bf16(af, Bf[3], a3, 0, 0, 0);
#pragma unroll
                for (int r = 0; r < 16; ++r) { auto t0 = __builtin_amdgcn_permlane32_swap(__float_as_uint(a0[r]), __float_as_uint(a1[r]), false, false); a0[r] = __uint_as_float(t0[0]); a1[r] = __uint_as_float(t0[1]);
                                               auto t1 = __builtin_amdgcn_permlane32_swap(__float_as_uint(a2[r]), __float_as_uint(a3[r]), false, false); a2[r] = __uint_as_float(t1[0]); a3[r] = __uint_as_float(t1[1]); }
#pragma unroll
                for (int s = 0; s < 32; ++s) { const int h = (s >> 2) & 1, r = (s & 3) + 4 * (s >> 3); const float bre = h ? a1[r] : a0[r], bim = h ? a3[r] : a2[r];
                    const float nr = fmaf(lr, xr, fmaf(-li, xi, bre)), ni = fmaf(lr, xi, fmaf(li, xr, bim)); xr = nr; xi = ni;
                    if (pass) { const unsigned pk = cvtpk(xr, xi); *(unsigned short*)(xblk + s * XP + lane * 2) = (unsigned short)pk; *(unsigned short*)(xblk + s * XP + 128 + lane * 2) = (unsigned short)(pk >> 16); } }
                if (pass) {
#pragma unroll
                    for (int rb = 0; rb < 2; ++rb) { f32x4 acc = {0.f, 0.f, 0.f, 0.f};
#pragma unroll
                        for (int kk = 0; kk < 4; ++kk) { const bf16x8 xa = *(const bf16x8*)(xblk + (16 * rb + l15) * XP + (32 * kk + 8 * q4) * 2); acc = __builtin_amdgcn_mfma_f32_16x16x32_bf16(xa, Cf[kk], acc, 0, 0, 0); }
#pragma unroll
                        for (int i = 0; i < 4; ++i) { const int sl = 16 * rb + 4 * q4 + i; const float uv = ublk[sl * 16 + l15];
                            const float v = gelu_tanh(acc[i] + dsk * uv); const float vn = __shfl_xor(v, 1);
                            if ((l15 & 1) == 0) *(unsigned*)(Gout + ((size_t)wid * SEGL + blk * 32 + sl) * DM + 16 * g + l15) = cvtpk(v, vn); } }
                }
                ua0 = un0; ua1 = un1;
            }
            if (pass == 0) {
                Ebuf[wid * 128 + lane] = xr; Ebuf[wid * 128 + 64 + lane] = xi;
                __syncthreads();
                float sr = 0.f, si = 0.f;
                for (int v = 0; v < wid; ++v) { const float er = Ebuf[v * 128 + lane], ei = Ebuf[v * 128 + 64 + lane];
                    const float nr = fmaf(l2r, sr, fmaf(-l2i, si, er)), ni = fmaf(l2r, si, fmaf(l2i, sr, ei)); sr = nr; si = ni; }
                xr = sr; xi = si;
            }
        }
        __syncthreads();
    }
}
}
#define XB_TMO      128
#define XB_XCNT(j)  (256  + 64 * (j))
#define XB_XSUB(j)  (1280 + 64 * (j))
#define XB_XGEN(j)  (2304 + 64 * (j))
#define XB_TOP      3328
#define XB_TOPGEN   3392
#define XCD_BAR_WORDS 3456
#define XB_SPIN_CAP (1u << 18)

__device__ __forceinline__ unsigned xb_ld(unsigned* p)              { return __hip_atomic_load(p, __ATOMIC_RELAXED, __HIP_MEMORY_SCOPE_AGENT); }
__device__ __forceinline__ unsigned xb_add(unsigned* p, unsigned v) { return __hip_atomic_fetch_add(p, v, __ATOMIC_RELAXED, __HIP_MEMORY_SCOPE_AGENT); }
__device__ __forceinline__ unsigned xb_xcc_id() { return (unsigned)__builtin_amdgcn_s_getreg((3 << 11) | 20) & 0xFu; }
#define XB_SPIN(cond, bar) do { unsigned _sp = 0; while (cond) { __builtin_amdgcn_s_sleep(1); \
    if ((++_sp & 255u) == 0u) { if (xb_ld(&(bar)[XB_TMO])) break; if (_sp > XB_SPIN_CAP) { atomicAdd(&(bar)[XB_TMO], 1u); break; } } } } while (0)

struct XcdBarrier {
    unsigned* bar; unsigned x;
    volatile LAS unsigned* st;
};

__device__ __forceinline__ XcdBarrier xcd_barrier_post(unsigned* bar, volatile LAS unsigned* st) {
    XcdBarrier b; b.bar = bar; b.x = xb_xcc_id(); b.st = st;
    if (threadIdx.x == 0) (void)xb_add(&bar[XB_XCNT(b.x)], 1u);
    return b;
}
__device__ __forceinline__ void xcd_barrier_complete(unsigned* bar, unsigned x, unsigned& nloc, unsigned& nx) {
    const unsigned G = gridDim.x * gridDim.y * gridDim.z;
    unsigned sum, cnt, mine, sp = 0u;
    for (;;) {
        sum = 0u; cnt = 0u; mine = 0u;
#pragma unroll
        for (unsigned j = 0; j < 16; ++j) { const unsigned c = xb_ld(&bar[XB_XCNT(j)]); sum += c; cnt += (c > 0u) ? 1u : 0u; mine = (j == x) ? c : mine; }
        if (sum == G) break;
        __builtin_amdgcn_s_sleep(1);
        if ((++sp & 255u) == 0u) { if (xb_ld(&bar[XB_TMO])) break; if (sp > XB_SPIN_CAP) { atomicAdd(&bar[XB_TMO], 1u); break; } }
    }
    nloc = mine > 0u ? mine : 1u; nx = cnt > 0u ? cnt : 1u;
}

__device__ __forceinline__ void xcd_barrier(const XcdBarrier& b) {
    asm volatile("s_waitcnt vmcnt(0)" ::: "memory");
    __syncthreads();
    if (threadIdx.x == 0) {
        unsigned* bar = b.bar;
        __builtin_amdgcn_s_waitcnt(0);
        unsigned nloc = b.st[0], nx = b.st[1];
        if (nloc == 0u) { xcd_barrier_complete(bar, b.x, nloc, nx); b.st[0] = nloc; b.st[1] = nx; }
        const unsigned old = xb_add(&bar[XB_XSUB(b.x)], 1u);
        const unsigned gen = old / nloc;
        if (old + 1u == (gen + 1u) * nloc) {
            __builtin_amdgcn_fence(__ATOMIC_RELEASE, "agent");
            asm volatile("s_waitcnt vmcnt(0)" ::: "memory");
            const unsigned og = xb_add(&bar[XB_TOP], 1u);
            const unsigned tg = og / nx;
            if (og + 1u == (tg + 1u) * nx) xb_add(&bar[XB_TOPGEN], 1u);
            else XB_SPIN(xb_ld(&bar[XB_TOPGEN]) == tg, bar);
            __builtin_amdgcn_fence(__ATOMIC_ACQUIRE, "agent");
            xb_add(&bar[XB_XGEN(b.x)], 1u);
            asm volatile("s_waitcnt vmcnt(0)" ::: "memory");
        } else {
            XB_SPIN(xb_ld(&bar[XB_XGEN(b.x)]) == gen, bar);
            __builtin_amdgcn_fence(__ATOMIC_ACQUIRE, "agent");
            asm volatile("s_waitcnt vmcnt(0)" ::: "memory");
        }
    }
    __syncthreads();
}

constexpr size_t MiB = (size_t)1 << 20;
constexpr int NTHR = 512, NWAVES = 8;
constexpr int LDS_BYTES = 147456;
constexpr int LDS_MISC = LDS_BYTES - 1024;
__device__ __forceinline__ const float* uptr(const LAS unsigned long long* tab, int i) {
    const unsigned long long v = tab[i]; const unsigned lo = __builtin_amdgcn_readfirstlane((unsigned)v), hi = __builtin_amdgcn_readfirstlane((unsigned)(v >> 32));
    return (const float*)(const GAS float*)(((unsigned long long)hi << 32) | lo);
}
template <class T> __device__ __forceinline__ LAS T* launder_l(LAS T* p) { asm volatile("" : "+s"(p)); return p; }
template <class T> __device__ __forceinline__ T* launder(T* p) { GAS T* q = (GAS T*)p; asm volatile("" : "+s"(q)); return (T*)q; }
static_assert(pg8::STAGE_BYTES <= LDS_MISC && fox::LDS_BYTES <= LDS_MISC && swa::LDS_BYTES <= LDS_MISC && s5::LDS_BYTES <= LDS_MISC, "LDS map");
constexpr size_t WS_CTL = 0, CTL_ZERO_BYTES = 64 * 1024;
constexpr size_t CTL_QCTR = 16384, CTL_NRM2 = 20480;
constexpr size_t WS_ROPE = 1 * MiB;
constexpr size_t WS_W = 2 * MiB;
constexpr size_t W_L0_QKV = WS_W, W_L0_O = W_L0_QKV + 40 * MiB, W_L1_QKVF = W_L0_O + 32 * MiB, W_L1_O = W_L1_QKVF + 98 * MiB, W_L2_GLU = W_L1_O + 32 * MiB,
                 W_L3_QKV = W_L2_GLU + 64 * MiB, W_L3_O = W_L3_QKV + 40 * MiB, W_FFN = W_L3_O + 32 * MiB, W_FFN_STRIDE = 258 * MiB, W_FFN_OUT = 172 * MiB;
constexpr size_t WS_XN = W_FFN + 4 * W_FFN_STRIDE;
constexpr size_t WS_BIG = WS_XN + 129 * MiB;
constexpr size_t WS_Z = WS_BIG, WS_ACT = WS_BIG + 688 * MiB, WS_TMPF = WS_BIG, WS_TMPM = WS_BIG + 688 * MiB;
constexpr size_t WS_SWA_QKV = WS_BIG, WS_SWA_O = WS_BIG + 160 * MiB;
constexpr size_t WS_FOX_QKV = WS_BIG, WS_FOX_O = WS_BIG + 384 * MiB, WS_FOX_LOGF = WS_BIG + 512 * MiB, WS_FOX_CNEG = WS_BIG + 514 * MiB;
constexpr size_t WS_S5_U = WS_BIG + 256 * MiB, WS_S5_G = WS_BIG + 512 * MiB;
constexpr size_t WS_END = WS_BIG + 1032 * MiB;
static_assert((size_t)SEQ * 2 * DFF * 2 == 688 * MiB && (size_t)SEQ * DFF * 2 == 344 * MiB && (size_t)12544 * 4096 * 2 == 98 * MiB && (size_t)22016 * 4096 * 2 == 172 * MiB, "sizes");

struct Args { const float* in[56]; float* out; unsigned char* ws; float inv_freq[8]; int ph_lo, ph_hi; };

__global__ void __launch_bounds__(NTHR, 2) mk_fwd(Args args) {
    extern __shared__ __attribute__((aligned(16))) unsigned char lds[];
    if (threadIdx.x < 16) ((LAS unsigned*)((LAS unsigned char*)lds + LDS_MISC))[threadIdx.x] = 0u;
    if (threadIdx.x == 64) { LAS unsigned long long* ptab0 = (LAS unsigned long long*)((LAS unsigned char*)lds + LDS_MISC + 64);
#pragma unroll
        for (int i = 0; i < 56; ++i) ptab0[i] = (unsigned long long)args.in[i]; }
#define IN(i) uptr(ptab, (i))
    __syncthreads();
    XcdBarrier bar = xcd_barrier_post((unsigned*)(args.ws + WS_CTL), (volatile LAS unsigned*)((LAS unsigned char*)lds + LDS_MISC));
    int need_bar = 0;
#define PH_BEGIN(id) if (args.ph_lo <= (id) && (id) < args.ph_hi) { \
        if (need_bar) { XcdBarrier b2; b2.bar = launder(bar.bar); b2.x = (unsigned)launder_s((int)bar.x); b2.st = bar.st; for (int rb_ = 0; rb_ < REP_BAR; ++rb_) xcd_barrier(b2); } need_bar = 1; \
        unsigned char* const ws = launder(args.ws); float* const out = launder(args.out); (void)out; \
        LAS unsigned char* const ldsl = launder_l((LAS unsigned char*)lds); char* const ldsg = (char*)ldsl; (void)ldsg; const LAS unsigned long long* const ptab = (const LAS unsigned long long*)(ldsl + LDS_MISC + 64); \
        const int tid = mk_tid(), lane = tid & 63, wave = __builtin_amdgcn_readfirstlane(tid >> 6); (void)lane; (void)wave; \
        const int G = launder_s((int)gridDim.x), bx = launder_s((int)blockIdx.x), vcu = (G % 8 == 0) ? (bx % 8) * (G / 8) + bx / 8 : bx, gw = vcu * NWAVES + wave, ngw = G * NWAVES; (void)gw; (void)ngw; \
        bf16* const XN = (bf16*)(ws + WS_XN + 16384); float* const cosT = (float*)(ws + WS_ROPE); float* const sinT = cosT + SEQ * 8; bf16* const TMPM = (bf16*)(ws + WS_TMPM); bf16* const TMPF = (bf16*)(ws + WS_TMPF); \
        (void)XN; (void)cosT; (void)sinT; (void)TMPM; (void)TMPF;
#define PH_END }

    PH_BEGIN(0)
#if PROBE_COPY > 0
      for (int rep = 0; rep < PROBE_COPY; ++rep) {
        typedef PROBE_T pv_t; constexpr int PU = 128 / sizeof(pv_t);
        const pv_t* src = (const pv_t*)(ws + WS_BIG); pv_t* dst = (pv_t*)(ws + WS_BIG + 516 * MiB);
        const size_t n = 512 * MiB / sizeof(pv_t), stride = (size_t)G * NTHR;
        for (size_t i = (size_t)vcu * NTHR + tid; i < n; i += PU * stride) {
            pv_t v[PU];
#pragma unroll
            for (int u = 0; u < PU; ++u) v[u] = PROBE_LD(src + i + u * stride);
#pragma unroll
            for (int u = 0; u < PU; ++u) PROBE_ST(v[u], dst + i + u * stride);
        }
      }
#endif
      for (int rep = 0; rep < REP_PRO; ++rep) {
        LAS unsigned* scr = (LAS unsigned*)(ldsl + wave * 16640);
        constexpr int I_QKV = 32 * 80, I_O = 32 * 64, I_QKVF = 32 * 193, I_GLU = 32 * 128, I_IN = 32 * 344, I_OUT = 86 * 64;
        constexpr int NITEMS = 2 * (I_QKV + I_O) + I_QKVF + I_O + I_GLU + 4 * (I_IN + I_OUT);
        for (int it = gw; it < NITEMS; it += ngw) {
            int r = it;
#define TR(cnt, src, K_, N_, dstoff, mode) if (r < (cnt)) { transpose_item(IN(src), K_, N_, (bf16*)(ws + (dstoff)), mode, scr, r, lane); continue; } r -= (cnt);
            TR(I_QKV, 2, 4096, 5120, W_L0_QKV, 0)
            TR(I_O, 5, 4096, 4096, W_L0_O, 0)
            TR(I_IN, 9, 4096, 22016, W_FFN, 2)
            TR(I_OUT, 12, 11008, 4096, W_FFN + W_FFN_OUT, 0)
            TR(I_QKVF, 15, 4096, 12320, W_L1_QKVF, 0)
            TR(I_O, 17, 4096, 4096, W_L1_O, 0)
            TR(I_IN, 20, 4096, 22016, W_FFN + W_FFN_STRIDE, 2)
            TR(I_OUT, 23, 11008, 4096, W_FFN + W_FFN_STRIDE + W_FFN_OUT, 0)
            TR(I_GLU, 34, 4096, 8192, W_L2_GLU, 1)
            TR(I_IN, 38, 4096, 22016, W_FFN + 2 * W_FFN_STRIDE, 2)
            TR(I_OUT, 41, 11008, 4096, W_FFN + 2 * W_FFN_STRIDE + W_FFN_OUT, 0)
            TR(I_QKV, 44, 4096, 5120, W_L3_QKV, 0)
            TR(I_O, 47, 4096, 4096, W_L3_O, 0)
            TR(I_IN, 51, 4096, 22016, W_FFN + 3 * W_FFN_STRIDE, 2)
            TR(I_OUT, 54, 11008, 4096, W_FFN + 3 * W_FFN_STRIDE + W_FFN_OUT, 0)
#undef TR
        }
        if (vcu == 0) { u32x4* zh = (u32x4*)(ws + WS_XN); const u32x4 zero = {0u, 0u, 0u, 0u}; for (int i = tid; i < 1024; i += NTHR) zh[i] = zero; }
        {
            u32x4* z = (u32x4*)(ws + W_L1_QKVF + (size_t)12320 * 4096 * 2); const u32x4 zero = {0u, 0u, 0u, 0u};
            for (int i = vcu * NTHR + tid; i < 224 * 4096 * 2 / 16; i += G * NTHR) z[i] = zero;
        }
        for (int i = vcu * NTHR + tid; i < SEQ * 8; i += G * NTHR) {
            const int f = i & 7;
            const float fr = f == 0 ? args.inv_freq[0] : f == 1 ? args.inv_freq[1] : f == 2 ? args.inv_freq[2] : f == 3 ? args.inv_freq[3] : f == 4 ? args.inv_freq[4] : f == 5 ? args.inv_freq[5] : f == 6 ? args.inv_freq[6] : args.inv_freq[7];
            const float ang = (float)(i >> 3) * fr; double s, c; sincos_d((double)ang, s, c); cosT[i] = (float)c; sinT[i] = (float)s;
        }
        norm_phase(gw, ngw, lane, ldsl + wave * 16640, nullptr, nullptr, IN(0), nullptr, IN(1), XN, nullptr);
      }
    PH_END

#define SEL(a, b, c, d) IN(L == 0 ? (a) : L == 1 ? (b) : L == 2 ? (c) : (d))
    { constexpr int L = 0;

        const int type = L == 3 ? 0 : L, pb = 1 + 9 * L;
        const size_t wffn = W_FFN + (size_t)L * W_FFN_STRIDE;

        PH_BEGIN(pb + 0)
            if (type == 0) {
                pg8::Gemm g{XN, (const bf16*)(ws + (L == 0 ? W_L0_QKV : W_L3_QKV)), SEQ, 5120, 4096}; pg8::StaticOrder S; S.init(SEQ, 5120, G, bx);
                pg8::EpiBf16B E{(bf16*)(ws + WS_SWA_QKV), 5120, L == 0 ? IN(3) : IN(45)};
                for (int rep = 0; rep < REP_MIXG; ++rep) pg8::gemm_phase<pg8::EpiBf16B, pg8::StaticOrder, true, true>(ldsl, g, S, E);
            } else if (type == 1) {
                pg8::Gemm g{XN, (const bf16*)(ws + W_L1_QKVF), SEQ, 12544, 4096}; pg8::StaticOrder S; S.init(SEQ, 12544, G, bx);
                pg8::EpiFox E{(bf16*)(ws + WS_FOX_QKV), (float*)(ws + WS_FOX_LOGF), IN(16)};
                for (int rep = 0; rep < REP_MIXG; ++rep) pg8::gemm_phase<pg8::EpiFox, pg8::StaticOrder, true, true>(ldsl, g, S, E);
            } else {
              for (int rep = 0; rep < REP_MIX; ++rep)
                s5::s5_phase(ldsg, (const float*)(ws + WS_S5_U), IN(26), IN(27), IN(28), IN(29), IN(30), IN(31), IN(32), IN(33),
                             (bf16*)(ws + WS_S5_G), vcu, G);
            }
        PH_END
        if (type != 2) {
        PH_BEGIN(pb + 1)
          for (int rep = 0; rep < REP_MIX; ++rep) {
            if (type == 0) swa::swa_attn_phase(ldsg, (const bf16*)(ws + WS_SWA_QKV), L == 0 ? IN(4) : IN(46), cosT, sinT, (bf16*)(ws + WS_SWA_O), vcu, G);
            else { fox_cumsum_phase(ldsg, (const float*)(ws + WS_FOX_LOGF), (float*)(ws + WS_FOX_CNEG), vcu, G, tid);
                   if (G > 64) { if (vcu >= 32) fox_norms_phase((const bf16*)(ws + WS_FOX_QKV), (unsigned*)(ws + WS_CTL + CTL_NRM2), (vcu - 32) * NWAVES + wave, (G - 32) * NWAVES, lane); }
                   else fox_norms_phase((const bf16*)(ws + WS_FOX_QKV), (unsigned*)(ws + WS_CTL + CTL_NRM2), gw, ngw, lane); }
          }
        PH_END
        }
        if (type == 1) {
        PH_BEGIN(pb + 2)
            const bf16* q = (const bf16*)(ws + WS_FOX_QKV);
            fox::fox_attn_phase(ldsg, q, q + (size_t)32 * SEQ * 128, q + (size_t)64 * SEQ * 128, (const float*)(ws + WS_FOX_CNEG), (const unsigned*)(ws + WS_CTL + CTL_NRM2), (unsigned*)(ws + WS_CTL + CTL_QCTR), (bf16*)(ws + WS_FOX_O));
#if REP_FOX > 1
            __syncthreads();
            fox::fox_attn_phase(ldsg, q, q + (size_t)32 * SEQ * 128, q + (size_t)64 * SEQ * 128, (const float*)(ws + WS_FOX_CNEG), (const unsigned*)(ws + WS_CTL + CTL_NRM2), (unsigned*)(ws + WS_CTL + CTL_QCTR) + 64, (bf16*)(ws + WS_FOX_O));
#endif
        PH_END
        }
        PH_BEGIN(pb + 3)
            if (type == 2) {
                pg8::Gemm g{(const bf16*)(ws + WS_S5_G), (const bf16*)(ws + W_L2_GLU), SEQ, 8192, 4096}; pg8::StaticOrder S; S.init(SEQ, 8192, G, bx);
                pg8::EpiGlu E{TMPM, IN(35)};
                for (int rep = 0; rep < REP_MIXG; ++rep) pg8::gemm_phase<pg8::EpiGlu, pg8::StaticOrder, true, true>(ldsl, g, S, E);
            } else {
                pg8::Gemm g{(const bf16*)(ws + (type == 0 ? WS_SWA_O : WS_FOX_O)), (const bf16*)(ws + (L == 0 ? W_L0_O : L == 1 ? W_L1_O : W_L3_O)), SEQ, 4096, 4096};
                pg8::StaticOrder S; S.init(SEQ, 4096, G, bx);
                pg8::EpiBf16B E{TMPM, 4096, L == 0 ? IN(6) : L == 3 ? IN(48) : nullptr};
                for (int rep = 0; rep < REP_MIXG; ++rep) pg8::gemm_phase<pg8::EpiBf16B, pg8::StaticOrder, true, true>(ldsl, g, S, E);
            }
        PH_END
        PH_BEGIN(pb + 4)
          for (int rep = 0; rep < REP_NORM; ++rep)
            norm_phase(gw, ngw, lane, ldsl + wave * 16640, TMPM, SEL(7, 18, 36, 49), (L == 0 && rep == 0) ? IN(0) : out, out, SEL(8, 19, 37, 50), XN, nullptr, rep ? 0.f : 1.f);
        PH_END
        PH_BEGIN(pb + 5)
            pg8::Gemm g{XN - 2 * 4096, (const bf16*)(ws + wffn), 65 * 256, 2 * DFF, 4096, 254}; pg8::StaticOrder S; S.init(65 * 256, 2 * DFF, G, bx);
            pg8::EpiConvGeglu E{(bf16*)(ws + WS_ACT), SEL(10, 21, 39, 52), SEL(11, 22, 40, 53), ldsl + 131072, DFF, SEQ};
          for (int rep = 0; rep < REP_FFN1; ++rep)
            pg8::gemm_phase<pg8::EpiConvGeglu, pg8::StaticOrder, true, true>(ldsl, g, S, E);
        PH_END
        PH_BEGIN(pb + 7)
            pg8::Gemm g{(const bf16*)(ws + WS_ACT), (const bf16*)(ws + wffn + W_FFN_OUT), SEQ, 4096, DFF}; pg8::StaticOrder S; S.init(SEQ, 4096, G, bx);
            pg8::EpiBf16B E{TMPF, 4096, nullptr};
          for (int rep = 0; rep < REP_FFN2; ++rep)
            pg8::gemm_phase<pg8::EpiBf16B, pg8::StaticOrder, true, true>(ldsl, g, S, E);
        PH_END
        PH_BEGIN(pb + 8)
          for (int rep = 0; rep < REP_NORM; ++rep)
            norm_phase(gw, ngw, lane, ldsl + wave * 16640, TMPF, SEL(13, 24, 42, 55), out, out, L == 3 ? nullptr : SEL(14, 25, 43, 43), (L == 1 || L == 3) ? nullptr : XN, L == 1 ? (float*)(ws + WS_S5_U) : nullptr, rep ? 0.f : 1.f);
        PH_END
    }
    { constexpr int L = 1;

        const int type = L == 3 ? 0 : L, pb = 1 + 9 * L;
        const size_t wffn = W_FFN + (size_t)L * W_FFN_STRIDE;

        PH_BEGIN(pb + 0)
            if (type == 0) {
                pg8::Gemm g{XN, (const bf16*)(ws + (L == 0 ? W_L0_QKV : W_L3_QKV)), SEQ, 5120, 4096}; pg8::StaticOrder S; S.init(SEQ, 5120, G, bx);
                pg8::EpiBf16B E{(bf16*)(ws + WS_SWA_QKV), 5120, L == 0 ? IN(3) : IN(45)};
                for (int rep = 0; rep < REP_MIXG; ++rep) pg8::gemm_phase<pg8::EpiBf16B, pg8::StaticOrder, true, true>(ldsl, g, S, E);
            } else if (type == 1) {
                pg8::Gemm g{XN, (const bf16*)(ws + W_L1_QKVF), SEQ, 12544, 4096}; pg8::StaticOrder S; S.init(SEQ, 12544, G, bx);
                pg8::EpiFox E{(bf16*)(ws + WS_FOX_QKV), (float*)(ws + WS_FOX_LOGF), IN(16)};
                for (int rep = 0; rep < REP_MIXG; ++rep) pg8::gemm_phase<pg8::EpiFox, pg8::StaticOrder, true, true>(ldsl, g, S, E);
            } else {
              for (int rep = 0; rep < REP_MIX; ++rep)
                s5::s5_phase(ldsg, (const float*)(ws + WS_S5_U), IN(26), IN(27), IN(28), IN(29), IN(30), IN(31), IN(32), IN(33),
                             (bf16*)(ws + WS_S5_G), vcu, G);
            }
        PH_END
        if (type != 2) {
        PH_BEGIN(pb + 1)
          for (int rep = 0; rep < REP_MIX; ++rep) {
            if (type == 0) swa::swa_attn_phase(ldsg, (const bf16*)(ws + WS_SWA_QKV), L == 0 ? IN(4) : IN(46), cosT, sinT, (bf16*)(ws + WS_SWA_O), vcu, G);
            else { fox_cumsum_phase(ldsg, (const float*)(ws + WS_FOX_LOGF), (float*)(ws + WS_FOX_CNEG), vcu, G, tid);
                   if (G > 64) { if (vcu >= 32) fox_norms_phase((const bf16*)(ws + WS_FOX_QKV), (unsigned*)(ws + WS_CTL + CTL_NRM2), (vcu - 32) * NWAVES + wave, (G - 32) * NWAVES, lane); }
                   else fox_norms_phase((const bf16*)(ws + WS_FOX_QKV), (unsigned*)(ws + WS_CTL + CTL_NRM2), gw, ngw, lane); }
          }
        PH_END
        }
        if (type == 1) {
        PH_BEGIN(pb + 2)
            const bf16* q = (const bf16*)(ws + WS_FOX_QKV);
            fox::fox_attn_phase(ldsg, q, q + (size_t)32 * SEQ * 128, q + (size_t)64 * SEQ * 128, (const float*)(ws + WS_FOX_CNEG), (const unsigned*)(ws + WS_CTL + CTL_NRM2), (unsigned*)(ws + WS_CTL + CTL_QCTR), (bf16*)(ws + WS_FOX_O));
#if REP_FOX > 1
            __syncthreads();
            fox::fox_attn_phase(ldsg, q, q + (size_t)32 * SEQ * 128, q + (size_t)64 * SEQ * 128, (const float*)(ws + WS_FOX_CNEG), (const unsigned*)(ws + WS_CTL + CTL_NRM2), (unsigned*)(ws + WS_CTL + CTL_QCTR) + 64, (bf16*)(ws + WS_FOX_O));
#endif
        PH_END
        }
        PH_BEGIN(pb + 3)
            if (type == 2) {
                pg8::Gemm g{(const bf16*)(ws + WS_S5_G), (const bf16*)(ws + W_L2_GLU), SEQ, 8192, 4096}; pg8::StaticOrder S; S.init(SEQ, 8192, G, bx);
                pg8::EpiGlu E{TMPM, IN(35)};
                for (int rep = 0; rep < REP_MIXG; ++rep) pg8::gemm_phase<pg8::EpiGlu, pg8::StaticOrder, true, true>(ldsl, g, S, E);
            } else {
                pg8::Gemm g{(const bf16*)(ws + (type == 0 ? WS_SWA_O : WS_FOX_O)), (const bf16*)(ws + (L == 0 ? W_L0_O : L == 1 ? W_L1_O : W_L3_O)), SEQ, 4096, 4096};
                pg8::StaticOrder S; S.init(SEQ, 4096, G, bx);
                pg8::EpiBf16B E{TMPM, 4096, L == 0 ? IN(6) : L == 3 ? IN(48) : nullptr};
                for (int rep = 0; rep < REP_MIXG; ++rep) pg8::gemm_phase<pg8::EpiBf16B, pg8::StaticOrder, true, true>(ldsl, g, S, E);
            }
        PH_END
        PH_BEGIN(pb + 4)
          for (int rep = 0; rep < REP_NORM; ++rep)
            norm_phase(gw, ngw, lane, ldsl + wave * 16640, TMPM, SEL(7, 18, 36, 49), (L == 0 && rep == 0) ? IN(0) : out, out, SEL(8, 19, 37, 50), XN, nullptr, rep ? 0.f : 1.f);
        PH_END
        PH_BEGIN(pb + 5)
            pg8::Gemm g{XN - 2 * 4096, (const bf16*)(ws + wffn), 65 * 256, 2 * DFF, 4096, 254}; pg8::StaticOrder S; S.init(65 * 256, 2 * DFF, G, bx);
            pg8::EpiConvGeglu E{(bf16*)(ws + WS_ACT), SEL(10, 21, 39, 52), SEL(11, 22, 40, 53), ldsl + 131072, DFF, SEQ};
          for (int rep = 0; rep < REP_FFN1; ++rep)
            pg8::gemm_phase<pg8::EpiConvGeglu, pg8::StaticOrder, true, true>(ldsl, g, S, E);
        PH_END
        PH_BEGIN(pb + 7)
            pg8::Gemm g{(const bf16*)(ws + WS_ACT), (const bf16*)(ws + wffn + W_FFN_OUT), SEQ, 4096, DFF}; pg8::StaticOrder S; S.init(SEQ, 4096, G, bx);
            pg8::EpiBf16B E{TMPF, 4096, nullptr};
          for (int rep = 0; rep < REP_FFN2; ++rep)
            pg8::gemm_phase<pg8::EpiBf16B, pg8::StaticOrder, true, true>(ldsl, g, S, E);
        PH_END
        PH_BEGIN(pb + 8)
          for (int rep = 0; rep < REP_NORM; ++rep)
            norm_phase(gw, ngw, lane, ldsl + wave * 16640, TMPF, SEL(13, 24, 42, 55), out, out, L == 3 ? nullptr : SEL(14, 25, 43, 43), (L == 1 || L == 3) ? nullptr : XN, L == 1 ? (float*)(ws + WS_S5_U) : nullptr, rep ? 0.f : 1.f);
        PH_END
    }
    { constexpr int L = 2;

        const int type = L == 3 ? 0 : L, pb = 1 + 9 * L;
        const size_t wffn = W_FFN + (size_t)L * W_FFN_STRIDE;

        PH_BEGIN(pb + 0)
            if (type == 0) {
                pg8::Gemm g{XN, (const bf16*)(ws + (L == 0 ? W_L0_QKV : W_L3_QKV)), SEQ, 5120, 4096}; pg8::StaticOrder S; S.init(SEQ, 5120, G, bx);
                pg8::EpiBf16B E{(bf16*)(ws + WS_SWA_QKV), 5120, L == 0 ? IN(3) : IN(45)};
                for (int rep = 0; rep < REP_MIXG; ++rep) pg8::gemm_phase<pg8::EpiBf16B, pg8::StaticOrder, true, true>(ldsl, g, S, E);
            } else if (type == 1) {
                pg8::Gemm g{XN, (const bf16*)(ws + W_L1_QKVF), SEQ, 12544, 4096}; pg8::StaticOrder S; S.init(SEQ, 12544, G, bx);
                pg8::EpiFox E{(bf16*)(ws + WS_FOX_QKV), (float*)(ws + WS_FOX_LOGF), IN(16)};
                for (int rep = 0; rep < REP_MIXG; ++rep) pg8::gemm_phase<pg8::EpiFox, pg8::StaticOrder, true, true>(ldsl, g, S, E);
            } else {
              for (int rep = 0; rep < REP_MIX; ++rep)
                s5::s5_phase(ldsg, (const float*)(ws + WS_S5_U), IN(26), IN(27), IN(28), IN(29), IN(30), IN(31), IN(32), IN(33),
                             (bf16*)(ws + WS_S5_G), vcu, G);
            }
        PH_END
        if (type != 2) {
        PH_BEGIN(pb + 1)
          for (int rep = 0; rep < REP_MIX; ++rep) {
            if (type == 0) swa::swa_attn_phase(ldsg, (const bf16*)(ws + WS_SWA_QKV), L == 0 ? IN(4) : IN(46), cosT, sinT, (bf16*)(ws + WS_SWA_O), vcu, G);
            else { fox_cumsum_phase(ldsg, (const float*)(ws + WS_FOX_LOGF), (float*)(ws + WS_FOX_CNEG), vcu, G, tid);
                   if (G > 64) { if (vcu >= 32) fox_norms_phase((const bf16*)(ws + WS_FOX_QKV), (unsigned*)(ws + WS_CTL + CTL_NRM2), (vcu - 32) * NWAVES + wave, (G - 32) * NWAVES, lane); }
                   else fox_norms_phase((const bf16*)(ws + WS_FOX_QKV), (unsigned*)(ws + WS_CTL + CTL_NRM2), gw, ngw, lane); }
          }
        PH_END
        }
        if (type == 1) {
        PH_BEGIN(pb + 2)
            const bf16* q = (const bf16*)(ws + WS_FOX_QKV);
            fox::fox_attn_phase(ldsg, q, q + (size_t)32 * SEQ * 128, q + (size_t)64 * SEQ * 128, (const float*)(ws + WS_FOX_CNEG), (const unsigned*)(ws + WS_CTL + CTL_NRM2), (unsigned*)(ws + WS_CTL + CTL_QCTR), (bf16*)(ws + WS_FOX_O));
#if REP_FOX > 1
            __syncthreads();
            fox::fox_attn_phase(ldsg, q, q + (size_t)32 * SEQ * 128, q + (size_t)64 * SEQ * 128, (const float*)(ws + WS_FOX_CNEG), (const unsigned*)(ws + WS_CTL + CTL_NRM2), (unsigned*)(ws + WS_CTL + CTL_QCTR) + 64, (bf16*)(ws + WS_FOX_O));
#endif
        PH_END
        }
        PH_BEGIN(pb + 3)
            if (type == 2) {
                pg8::Gemm g{(const bf16*)(ws + WS_S5_G), (const bf16*)(ws + W_L2_GLU), SEQ, 8192, 4096}; pg8::StaticOrder S; S.init(SEQ, 8192, G, bx);
                pg8::EpiGlu E{TMPM, IN(35)};
                for (int rep = 0; rep < REP_MIXG; ++rep) pg8::gemm_phase<pg8::EpiGlu, pg8::StaticOrder, true, true>(ldsl, g, S, E);
            } else {
                pg8::Gemm g{(const bf16*)(ws + (type == 0 ? WS_SWA_O : WS_FOX_O)), (const bf16*)(ws + (L == 0 ? W_L0_O : L == 1 ? W_L1_O : W_L3_O)), SEQ, 4096, 4096};
                pg8::StaticOrder S; S.init(SEQ, 4096, G, bx);
                pg8::EpiBf16B E{TMPM, 4096, L == 0 ? IN(6) : L == 3 ? IN(48) : nullptr};
                for (int rep = 0; rep < REP_MIXG; ++rep) pg8::gemm_phase<pg8::EpiBf16B, pg8::StaticOrder, true, true>(ldsl, g, S, E);
            }
        PH_END
        PH_BEGIN(pb + 4)
          for (int rep = 0; rep < REP_NORM; ++rep)
            norm_phase(gw, ngw, lane, ldsl + wave * 16640, TMPM, SEL(7, 18, 36, 49), (L == 0 && rep == 0) ? IN(0) : out, out, SEL(8, 19, 37, 50), XN, nullptr, rep ? 0.f : 1.f);
        PH_END
        PH_BEGIN(pb + 5)
            pg8::Gemm g{XN - 2 * 4096, (const bf16*)(ws + wffn), 65 * 256, 2 * DFF, 4096, 254}; pg8::StaticOrder S; S.init(65 * 256, 2 * DFF, G, bx);
            pg8::EpiConvGeglu E{(bf16*)(ws + WS_ACT), SEL(10, 21, 39, 52), SEL(11, 22, 40, 53), ldsl + 131072, DFF, SEQ};
          for (int rep = 0; rep < REP_FFN1; ++rep)
            pg8::gemm_phase<pg8::EpiConvGeglu, pg8::StaticOrder, true, true>(ldsl, g, S, E);
        PH_END
        PH_BEGIN(pb + 7)
            pg8::Gemm g{(const bf16*)(ws + WS_ACT), (const bf16*)(ws + wffn + W_FFN_OUT), SEQ, 4096, DFF}; pg8::StaticOrder S; S.init(SEQ, 4096, G, bx);
            pg8::EpiBf16B E{TMPF, 4096, nullptr};
          for (int rep = 0; rep < REP_FFN2; ++rep)
            pg8::gemm_phase<pg8::EpiBf16B, pg8::StaticOrder, true, true>(ldsl, g, S, E);
        PH_END
        PH_BEGIN(pb + 8)
          for (int rep = 0; rep < REP_NORM; ++rep)
            norm_phase(gw, ngw, lane, ldsl + wave * 16640, TMPF, SEL(13, 24, 42, 55), out, out, L == 3 ? nullptr : SEL(14, 25, 43, 43), (L == 1 || L == 3) ? nullptr : XN, L == 1 ? (float*)(ws + WS_S5_U) : nullptr, rep ? 0.f : 1.f);
        PH_END
    }
    { constexpr int L = 3;

        const int type = L == 3 ? 0 : L, pb = 1 + 9 * L;
        const size_t wffn = W_FFN + (size_t)L * W_FFN_STRIDE;

        PH_BEGIN(pb + 0)
            if (type == 0) {
                pg8::Gemm g{XN, (const bf16*)(ws + (L == 0 ? W_L0_QKV : W_L3_QKV)), SEQ, 5120, 4096}; pg8::StaticOrder S; S.init(SEQ, 5120, G, bx);
                pg8::EpiBf16B E{(bf16*)(ws + WS_SWA_QKV), 5120, L == 0 ? IN(3) : IN(45)};
                for (int rep = 0; rep < REP_MIXG; ++rep) pg8::gemm_phase<pg8::EpiBf16B, pg8::StaticOrder, true, true>(ldsl, g, S, E);
            } else if (type == 1) {
                pg8::Gemm g{XN, (const bf16*)(ws + W_L1_QKVF), SEQ, 12544, 4096}; pg8::StaticOrder S; S.init(SEQ, 12544, G, bx);
                pg8::EpiFox E{(bf16*)(ws + WS_FOX_QKV), (float*)(ws + WS_FOX_LOGF), IN(16)};
                for (int rep = 0; rep < REP_MIXG; ++rep) pg8::gemm_phase<pg8::EpiFox, pg8::StaticOrder, true, true>(ldsl, g, S, E);
            } else {
              for (int rep = 0; rep < REP_MIX; ++rep)
                s5::s5_phase(ldsg, (const float*)(ws + WS_S5_U), IN(26), IN(27), IN(28), IN(29), IN(30), IN(31), IN(32), IN(33),
                             (bf16*)(ws + WS_S5_G), vcu, G);
            }
        PH_END
        if (type != 2) {
        PH_BEGIN(pb + 1)
          for (int rep = 0; rep < REP_MIX; ++rep) {
            if (type == 0) swa::swa_attn_phase(ldsg, (const bf16*)(ws + WS_SWA_QKV), L == 0 ? IN(4) : IN(46), cosT, sinT, (bf16*)(ws + WS_SWA_O), vcu, G);
            else { fox_cumsum_phase(ldsg, (const float*)(ws + WS_FOX_LOGF), (float*)(ws + WS_FOX_CNEG), vcu, G, tid);
                   if (G > 64) { if (vcu >= 32) fox_norms_phase((const bf16*)(ws + WS_FOX_QKV), (unsigned*)(ws + WS_CTL + CTL_NRM2), (vcu - 32) * NWAVES + wave, (G - 32) * NWAVES, lane); }
                   else fox_norms_phase((const bf16*)(ws + WS_FOX_QKV), (unsigned*)(ws + WS_CTL + CTL_NRM2), gw, ngw, lane); }
          }
        PH_END
        }
        if (type == 1) {
        PH_BEGIN(pb + 2)
            const bf16* q = (const bf16*)(ws + WS_FOX_QKV);
            fox::fox_attn_phase(ldsg, q, q + (size_t)32 * SEQ * 128, q + (size_t)64 * SEQ * 128, (const float*)(ws + WS_FOX_CNEG), (const unsigned*)(ws + WS_CTL + CTL_NRM2), (unsigned*)(ws + WS_CTL + CTL_QCTR), (bf16*)(ws + WS_FOX_O));
#if REP_FOX > 1
            __syncthreads();
            fox::fox_attn_phase(ldsg, q, q + (size_t)32 * SEQ * 128, q + (size_t)64 * SEQ * 128, (const float*)(ws + WS_FOX_CNEG), (const unsigned*)(ws + WS_CTL + CTL_NRM2), (unsigned*)(ws + WS_CTL + CTL_QCTR) + 64, (bf16*)(ws + WS_FOX_O));
#endif
        PH_END
        }
        PH_BEGIN(pb + 3)
            if (type == 2) {
                pg8::Gemm g{(const bf16*)(ws + WS_S5_G), (const bf16*)(ws + W_L2_GLU), SEQ, 8192, 4096}; pg8::StaticOrder S; S.init(SEQ, 8192, G, bx);
                pg8::EpiGlu E{TMPM, IN(35)};
                for (int rep = 0; rep < REP_MIXG; ++rep) pg8::gemm_phase<pg8::EpiGlu, pg8::StaticOrder, true, true>(ldsl, g, S, E);
            } else {
                pg8::Gemm g{(const bf16*)(ws + (type == 0 ? WS_SWA_O : WS_FOX_O)), (const bf16*)(ws + (L == 0 ? W_L0_O : L == 1 ? W_L1_O : W_L3_O)), SEQ, 4096, 4096};
                pg8::StaticOrder S; S.init(SEQ, 4096, G, bx);
                pg8::EpiBf16B E{TMPM, 4096, L == 0 ? IN(6) : L == 3 ? IN(48) : nullptr};
                for (int rep = 0; rep < REP_MIXG; ++rep) pg8::gemm_phase<pg8::EpiBf16B, pg8::StaticOrder, true, true>(ldsl, g, S, E);
            }
        PH_END
        PH_BEGIN(pb + 4)
          for (int rep = 0; rep < REP_NORM; ++rep)
            norm_phase(gw, ngw, lane, ldsl + wave * 16640, TMPM, SEL(7, 18, 36, 49), (L == 0 && rep == 0) ? IN(0) : out, out, SEL(8, 19, 37, 50), XN, nullptr, rep ? 0.f : 1.f);
        PH_END
        PH_BEGIN(pb + 5)
            pg8::Gemm g{XN - 2 * 4096, (const bf16*)(ws + wffn), 65 * 256, 2 * DFF, 4096, 254}; pg8::StaticOrder S; S.init(65 * 256, 2 * DFF, G, bx);
            pg8::EpiConvGeglu E{(bf16*)(ws + WS_ACT), SEL(10, 21, 39, 52), SEL(11, 22, 40, 53), ldsl + 131072, DFF, SEQ};
          for (int rep = 0; rep < REP_FFN1; ++rep)
            pg8::gemm_phase<pg8::EpiConvGeglu, pg8::StaticOrder, true, true>(ldsl, g, S, E);
        PH_END
        PH_BEGIN(pb + 7)
            pg8::Gemm g{(const bf16*)(ws + WS_ACT), (const bf16*)(ws + wffn + W_FFN_OUT), SEQ, 4096, DFF}; pg8::StaticOrder S; S.init(SEQ, 4096, G, bx);
            pg8::EpiBf16B E{TMPF, 4096, nullptr};
          for (int rep = 0; rep < REP_FFN2; ++rep)
            pg8::gemm_phase<pg8::EpiBf16B, pg8::StaticOrder, true, true>(ldsl, g, S, E);
        PH_END
        PH_BEGIN(pb + 8)
          for (int rep = 0; rep < REP_NORM; ++rep)
            norm_phase(gw, ngw, lane, ldsl + wave * 16640, TMPF, SEL(13, 24, 42, 55), out, out, L == 3 ? nullptr : SEL(14, 25, 43, 43), (L == 1 || L == 3) ? nullptr : XN, L == 1 ? (float*)(ws + WS_S5_U) : nullptr, rep ? 0.f : 1.f);
        PH_END
    }
#undef SEL
#undef PH_BEGIN
#undef PH_END
#undef IN
}

extern "C" void kernel_launch(void* const* d_in, const int* in_sizes, int n_in, void* d_out, int out_size, void* d_ws, size_t ws_size, hipStream_t stream) {
    static int grid = 0;
    if (grid == 0) {
        if (n_in != 56 || in_sizes[0] != SEQ * DM || out_size != SEQ * DM || ws_size < WS_END) {
            fprintf(stderr, "kernel_launch: built for 56 inputs, x/out of %d floats, >= %zu bytes of workspace; got n_in %d, in0 %d, out %d, ws %zu; nothing launched\n", SEQ * DM, (size_t)WS_END, n_in, n_in > 0 ? in_sizes[0] : -1, out_size, ws_size);
            grid = -1; return; }
        int dev = 0, cus = 0, per_cu = 0;
        if (hipGetDevice(&dev) != hipSuccess || hipDeviceGetAttribute(&cus, hipDeviceAttributeMultiprocessorCount, dev) != hipSuccess) { fprintf(stderr, "kernel_launch: device query failed\n"); grid = -1; return; }
        if (hipFuncSetAttribute((const void*)mk_fwd, hipFuncAttributeMaxDynamicSharedMemorySize, LDS_BYTES) != hipSuccess) { fprintf(stderr, "kernel_launch: hipFuncSetAttribute failed\n"); grid = -1; return; }
        if (hipOccupancyMaxActiveBlocksPerMultiprocessor(&per_cu, (const void*)mk_fwd, NTHR, LDS_BYTES) != hipSuccess || per_cu < 1) { fprintf(stderr, "kernel_launch: occupancy query says %d workgroups per CU\n", per_cu); (void)hipGetLastError(); }
        grid = cus;
    }
    if (grid < 0) return;
    if (hipMemsetAsync((char*)d_ws + WS_CTL, 0, CTL_ZERO_BYTES, stream) != hipSuccess) { fprintf(stderr, "kernel_launch: memset failed\n"); return; }
    Args a{};
    for (int i = 0; i < 56; ++i) a.in[i] = (const float*)d_in[i];
    a.out = (float*)d_out; a.ws = (unsigned char*)d_ws;
    { const float lt = (float)(-std::log(500000.0)); for (int i = 0; i < 8; ++i) { float v = lt * (float)i; v = v * 0.125f; a.inv_freq[i] = (float)std::exp((double)v); } }
#if MK_SPLIT_LAUNCHES
    for (int ph = 0; ph < 37; ++ph) {
        const int L = (ph - 1) / 9, slot = (ph - 1) % 9, type = L == 3 ? 0 : L;
        if (ph > 0 && ((slot == 1 && type == 2) || (slot == 2 && type != 1) || slot == 6)) continue;
        a.ph_lo = ph; a.ph_hi = ph + 1;
        hipLaunchKernelGGL(mk_fwd, dim3(grid), dim3(NTHR), LDS_BYTES, stream, a);
    }
#else
    a.ph_lo = 0; a.ph_hi = 37;
    hipLaunchKernelGGL(mk_fwd, dim3(grid), dim3(NTHR), LDS_BYTES, stream, a);
#endif
    const hipError_t le = hipPeekAtLastError();
    if (le != hipSuccess) fprintf(stderr, "kernel_launch: launch failed: %s (grid %d x %d threads, %d B LDS)\n", hipGetErrorName(le), grid, NTHR, LDS_BYTES);
}
```

```cpp
#include <hip/hip_runtime.h>
#include <cstdio>
#include <cstdint>
#include <cmath>

#ifndef MK_SPLIT_LAUNCHES
#define MK_SPLIT_LAUNCHES 0
#endif

__device__ __forceinline__ int mk_tid() { int t = threadIdx.x; asm volatile("" : "+v"(t)); return t; }
__device__ __forceinline__ int launder_s(int v) { asm volatile("" : "+s"(v)); return v; }

#ifndef PROBE_COPY
#define PROBE_COPY 0
#endif
#ifndef PROBE_T
#define PROBE_T u32x2
#endif
#define PROBE_LD(p) (*(p))
#define PROBE_ST(v, p) (*(p) = (v))
#ifndef REP_PRO
#define REP_PRO 1
#endif
#ifndef REP_FFN1
#define REP_FFN1 1
#endif
#ifndef REP_FFN2
#define REP_FFN2 1
#endif
#ifndef REP_NORM
#define REP_NORM 1
#endif
#ifndef REP_BAR
#define REP_BAR 1
#endif
#ifndef REP_FOX
#define REP_FOX 1
#endif
#ifndef REP_MIXG
#define REP_MIXG 1
#endif
#ifndef REP_MIX
#define REP_MIX 1
#endif

namespace pg8 {
#define PG8_LAS __attribute__((address_space(3)))
typedef unsigned short bf16_t;
typedef short bf16x8 __attribute__((ext_vector_type(8)));
typedef float f32x4 __attribute__((ext_vector_type(4)));
typedef unsigned u32x4 __attribute__((ext_vector_type(4)));
typedef unsigned u32x2 __attribute__((ext_vector_type(2)));
constexpr int BM = 256, BK = 64, HALF = 128, HTB = HALF * BK * 2  , STAGE_BYTES = 8 * HTB, NXCD = 8, WGM = 8;

__host__ __device__ __forceinline__ int lds_byte(int r, int c) { const int st = (r >> 4) * 2 + (c >> 5), rr = r & 15, cc = c & 31, ob = rr * 64 + cc * 2; return st * 1024 + (ob ^ (((ob >> 9) & 1) << 5)); }
__host__ __device__ __forceinline__ void stage_rc(int b, int& R, int& C) { const int st = b / 1024, sb = b % 1024, swz = sb ^ (((sb >> 9) & 1) << 5); R = (st >> 1) * 16 + swz / 64; C = (st & 1) * 32 + (swz % 64) / 2; }
__host__ __device__ __forceinline__ int perm32(int rho) { const int n = rho >> 4, i = rho & 15; return 8 * (i >> 2) + 4 * n + (i & 3); }

struct Unit { int pm, pn; };
struct Gemm { const bf16_t* A; const bf16_t* Bt; int M, N, K; int apr = 256; };

struct StaticOrder {
    int nM, nN, nwg, G, c;
    __host__ __device__ void init(int M, int N, int G_, int c_) { nM = M / BM; nN = N / BM; nwg = nM * nN; G = G_; c = c_; }
    __host__ __device__ bool next(int i, Unit& u) const {
        const long L = (long)i * G + c; if (L >= nwg) return false;
        int wgid = (int)L; { const int q = nwg / NXCD, r = nwg % NXCD, xcd = wgid % NXCD, off = wgid / NXCD; wgid = (xcd < r ? xcd * (q + 1) : r * (q + 1) + (xcd - r) * q) + off; }
        const int nig = WGM * nN, gid = wgid / nig, fm = gid * WGM, gsz = (nM - fm) < WGM ? (nM - fm) : WGM;
        u.pm = fm + ((wgid % nig) % gsz); u.pn = (wgid % nig) / gsz; return true;
    }
    __device__ __forceinline__ void a_ready(const Unit&) const {}
    __device__ __forceinline__ void done(const Unit&) const {}
};

__device__ __forceinline__ unsigned cvt_pk_bf16(float lo, float hi) { unsigned r; asm volatile("v_cvt_pk_bf16_f32 %0, %1, %2" : "=v"(r) : "v"(lo), "v"(hi)); return r; }

struct EpiF32B {
    static constexpr bool PERM = false, AFTER_DRAIN = false, APERM = false;
    float* C; int ldc; const float* bias;
    __device__ __forceinline__ void operator()(const f32x4 (&acc)[2][2][4][2], const Unit& u, int wr, int wc, int fr, int fq) const {
        const int row0 = u.pm * BM + wr * 64 + fr, col0 = u.pn * BM + wc * 32 + 4 * fq;
        f32x4 bv[2][2];
#pragma unroll
        for (int bj = 0; bj < 2; ++bj)
#pragma unroll
            for (int n = 0; n < 2; ++n) bv[bj][n] = bias ? *(const f32x4*)(bias + col0 + bj * HALF + n * 16) : (f32x4){0.f, 0.f, 0.f, 0.f};
#pragma unroll
        for (int ai = 0; ai < 2; ++ai)
#pragma unroll
            for (int m = 0; m < 4; ++m) { float* rowp = C + (size_t)(row0 + ai * HALF + m * 16) * ldc + col0;
#pragma unroll
                for (int bj = 0; bj < 2; ++bj)
#pragma unroll
                    for (int n = 0; n < 2; ++n) *(f32x4*)(rowp + bj * HALF + n * 16) = acc[ai][bj][m][n] + bv[bj][n]; }
    }
};
struct EpiBf16B {
    static constexpr bool PERM = true, AFTER_DRAIN = false, APERM = false;
    bf16_t* O; int ldc; const float* bias;
    __device__ __forceinline__ void operator()(const f32x4 (&acc)[2][2][4][2], const Unit& u, int wr, int wc, int fr, int fq) const {
        const int row0 = u.pm * BM + wr * 64 + fr; const int col0 = u.pn * BM + wc * 32 + 8 * fq;
        f32x4 bv[2][2];
#pragma unroll
        for (int bj = 0; bj < 2; ++bj)
#pragma unroll
            for (int n = 0; n < 2; ++n) bv[bj][n] = bias ? *(const f32x4*)(bias + col0 + bj * HALF + 4 * n) : (f32x4){0.f, 0.f, 0.f, 0.f};
#pragma unroll
        for (int ai = 0; ai < 2; ++ai)
#pragma unroll
            for (int m = 0; m < 4; ++m) { bf16_t* rowp = O + (size_t)(row0 + ai * HALF + m * 16) * ldc + col0;
#pragma unroll
                for (int bj = 0; bj < 2; ++bj) { const f32x4 v0 = acc[ai][bj][m][0] + bv[bj][0], v1 = acc[ai][bj][m][1] + bv[bj][1];
                    u32x4 w; w.x = cvt_pk_bf16(v0[0], v0[1]); w.y = cvt_pk_bf16(v0[2], v0[3]); w.z = cvt_pk_bf16(v1[0], v1[1]); w.w = cvt_pk_bf16(v1[2], v1[3]);
                    *(u32x4*)(rowp + bj * HALF) = w; } }
    }
};
struct EpiFox {
    static constexpr bool PERM = true, AFTER_DRAIN = false, APERM = false;
    bf16_t* QKV; float* logf; const float* bfg;
    __device__ __forceinline__ void operator()(const f32x4 (&acc)[2][2][4][2], const Unit& u, int wr, int wc, int fr, int fq) const {
        const int row0 = u.pm * BM + wr * 64 + fr;
        if (u.pn < 48) {
            const int t3 = u.pn >> 4, hp = u.pn & 15;
#pragma unroll
            for (int bj = 0; bj < 2; ++bj) { bf16_t* base = QKV + ((size_t)(t3 * 32 + 2 * hp + bj) * 16384) * 128 + wc * 32 + 8 * fq;
#pragma unroll
                for (int ai = 0; ai < 2; ++ai)
#pragma unroll
                    for (int m = 0; m < 4; ++m) { const f32x4 v0 = acc[ai][bj][m][0], v1 = acc[ai][bj][m][1];
                        u32x4 w; w.x = cvt_pk_bf16(v0[0], v0[1]); w.y = cvt_pk_bf16(v0[2], v0[3]); w.z = cvt_pk_bf16(v1[0], v1[1]); w.w = cvt_pk_bf16(v1[2], v1[3]);
                        *(u32x4*)(base + (size_t)(row0 + ai * HALF + m * 16) * 128) = w; } }
        } else if (wc == 0) {
            const f32x4 b0 = *(const f32x4*)(bfg + 8 * fq), b1 = *(const f32x4*)(bfg + 8 * fq + 4);
#pragma unroll
            for (int ai = 0; ai < 2; ++ai)
#pragma unroll
                for (int m = 0; m < 4; ++m) { float* rowp = logf + (size_t)(row0 + ai * HALF + m * 16) * 32 + 8 * fq;
#pragma unroll
                    for (int n = 0; n < 2; ++n) { const f32x4 z = acc[ai][0][m][n] + (n ? b1 : b0); f32x4 o;
#pragma unroll
                        for (int i = 0; i < 4; ++i) o[i] = fminf(z[i], 0.f) - log1pf(expf(-fabsf(z[i])));
                        *(f32x4*)(rowp + 4 * n) = o; } }
        }
    }
};
struct EpiGlu {
    static constexpr bool PERM = true, AFTER_DRAIN = false, APERM = false;
    bf16_t* C; const float* bias;
    __device__ __forceinline__ void operator()(const f32x4 (&acc)[2][2][4][2], const Unit& u, int wr, int wc, int fr, int fq) const {
        const int row0 = u.pm * BM + wr * 64 + fr, col0 = u.pn * HALF + wc * 32 + 8 * fq;
        f32x4 bv[2], bg[2];
#pragma unroll
        for (int n = 0; n < 2; ++n) { bv[n] = *(const f32x4*)(bias + col0 + 4 * n); bg[n] = *(const f32x4*)(bias + 4096 + col0 + 4 * n); }
#pragma unroll
        for (int ai = 0; ai < 2; ++ai)
#pragma unroll
            for (int m = 0; m < 4; ++m) { bf16_t* rowp = C + (size_t)(row0 + ai * HALF + m * 16) * 4096 + col0; u32x4 w;
#pragma unroll
                for (int n = 0; n < 2; ++n) { const f32x4 zv = acc[ai][0][m][n] + bv[n], zg = acc[ai][1][m][n] + bg[n]; f32x4 o;
#pragma unroll
                    for (int i = 0; i < 4; ++i) o[i] = zv[i] * __builtin_amdgcn_rcpf(1.0f + __builtin_amdgcn_exp2f(-1.4426950408889634f * zg[i]));
                    if (n == 0) { w.x = cvt_pk_bf16(o[0], o[1]); w.y = cvt_pk_bf16(o[2], o[3]); } else { w.z = cvt_pk_bf16(o[0], o[1]); w.w = cvt_pk_bf16(o[2], o[3]); } }
                *(u32x4*)rowp = w; }
    }
};

struct EpiConvGeglu {
    static constexpr bool PERM = true, AFTER_DRAIN = false, APERM = true;
    bf16_t* ACT; const float* cw; const float* cb; PG8_LAS unsigned char* xl; int dff, nrows;
    static __device__ __forceinline__ float shr1(float old, float src) {
        return __builtin_bit_cast(float, __builtin_amdgcn_update_dpp(__builtin_bit_cast(int, old), __builtin_bit_cast(int, src), 0x111, 0xf, 0xf, false)); }
    static __device__ __forceinline__ float gelu_t(float x) { const float t = 0.7978845608028654f * (x + 0.044715f * x * x * x); return x * __builtin_amdgcn_rcpf(1.0f + __builtin_amdgcn_exp2f(-2.8853900817779268f * t)); }
    __device__ __forceinline__ void operator()(const f32x4 (&acc)[2][2][4][2], const Unit& u, int wr, int wc, int fr, int fq) const {
#define XOFF(ai_, w_, rr_, bj_, n_) ((((((ai_) * 2 + (w_)) * 2 + (rr_)) * 2 + (bj_)) * 4 + wc) * 128 + fq * 32 + (n_) * 16)
        f32x4 wv[8];
        { const int gc = u.pn * HALF + wc * 32 + 8 * fq;
            wv[0] = *(const f32x4*)(cw + gc); wv[1] = *(const f32x4*)(cw + 2 * dff + gc); wv[2] = *(const f32x4*)(cw + 4 * dff + gc); wv[3] = *(const f32x4*)(cb + gc);
            wv[4] = *(const f32x4*)(cw + dff + gc); wv[5] = *(const f32x4*)(cw + 3 * dff + gc); wv[6] = *(const f32x4*)(cw + 5 * dff + gc); wv[7] = *(const f32x4*)(cb + dff + gc); }
        if (fr == 15) {
#pragma unroll
            for (int ai = 0; ai < 2; ++ai)
#pragma unroll
                for (int bj = 0; bj < 2; ++bj)
#pragma unroll
                    for (int n = 0; n < 2; ++n) { *(PG8_LAS f32x4*)(xl + XOFF(ai, wr, 0, bj, n)) = acc[ai][bj][2][n]; *(PG8_LAS f32x4*)(xl + XOFF(ai, wr, 1, bj, n)) = acc[ai][bj][3][n]; }
        }
        asm volatile("s_waitcnt lgkmcnt(0)" ::: "memory"); __builtin_amdgcn_s_barrier(); asm volatile("" ::: "memory");
        u32x2 keep[2][4];
#pragma unroll
        for (int n = 0; n < 2; ++n) {
            const int gcol = u.pn * HALF + wc * 32 + 8 * fq + 4 * n;
            if (n) { wv[0] = *(const f32x4*)(cw + gcol); wv[1] = *(const f32x4*)(cw + 2 * dff + gcol); wv[2] = *(const f32x4*)(cw + 4 * dff + gcol); wv[3] = *(const f32x4*)(cb + gcol);
                     wv[4] = *(const f32x4*)(cw + dff + gcol); wv[5] = *(const f32x4*)(cw + 3 * dff + gcol); wv[6] = *(const f32x4*)(cw + 5 * dff + gcol); wv[7] = *(const f32x4*)(cb + dff + gcol); }
            const f32x4 wg0 = wv[0], wg1 = wv[1], wg2 = wv[2], bg = wv[3], wu0 = wv[4], wu1 = wv[5], wu2 = wv[6], bu = wv[7];
#pragma unroll
            for (int ai = 0; ai < 2; ++ai) {
                f32x4 Xg2 = {0.f, 0.f, 0.f, 0.f}, Xg3 = Xg2, Xu2 = Xg2, Xu3 = Xg2;
                if (ai + wr > 0) { const int pa = wr ? ai : ai - 1, pw = wr ? 0 : 1;
                    Xg2 = *(const PG8_LAS f32x4*)(xl + XOFF(pa, pw, 0, 0, n)); Xg3 = *(const PG8_LAS f32x4*)(xl + XOFF(pa, pw, 1, 0, n));
                    Xu2 = *(const PG8_LAS f32x4*)(xl + XOFF(pa, pw, 0, 1, n)); Xu3 = *(const PG8_LAS f32x4*)(xl + XOFF(pa, pw, 1, 1, n)); }
                float o[4][4];
#pragma unroll
                for (int i = 0; i < 4; ++i) {
                    const float g0 = acc[ai][0][0][n][i], g1 = acc[ai][0][1][n][i], g2 = acc[ai][0][2][n][i], g3 = acc[ai][0][3][n][i];
                    const float u0 = acc[ai][1][0][n][i], u1 = acc[ai][1][1][n][i], u2 = acc[ai][1][2][n][i], u3 = acc[ai][1][3][n][i];
                    const float gm1 = shr1(Xg3[i], g3), gm2 = shr1(Xg2[i], g2), um1 = shr1(Xu3[i], u3), um2 = shr1(Xu2[i], u2);
                    const float zg0 = ((bg[i] + wg2[i] * g0) + wg1[i] * gm1) + wg0[i] * gm2, zu0 = ((bu[i] + wu2[i] * u0) + wu1[i] * um1) + wu0[i] * um2;
                    const float zg1 = ((bg[i] + wg2[i] * g1) + wg1[i] * g0) + wg0[i] * gm1, zu1 = ((bu[i] + wu2[i] * u1) + wu1[i] * u0) + wu0[i] * um1;
                    const float zg2 = ((bg[i] + wg2[i] * g2) + wg1[i] * g1) + wg0[i] * g0, zu2 = ((bu[i] + wu2[i] * u2) + wu1[i] * u1) + wu0[i] * u0;
                    const float zg3 = ((bg[i] + wg2[i] * g3) + wg1[i] * g2) + wg0[i] * g1, zu3 = ((bu[i] + wu2[i] * u3) + wu1[i] * u2) + wu0[i] * u1;
                    o[0][i] = gelu_t(zg0) * zu0; o[1][i] = gelu_t(zg1) * zu1; o[2][i] = gelu_t(zg2) * zu2; o[3][i] = gelu_t(zg3) * zu3; }
#pragma unroll
                for (int m = 0; m < 4; ++m) { const int it = ai * HALF + wr * 64 + 4 * fr + m, grow = u.pm * 254 - 2 + it;
                    u32x2 w; w.x = cvt_pk_bf16(o[m][0], o[m][1]); w.y = cvt_pk_bf16(o[m][2], o[m][3]);
                    if (n == 0) keep[ai][m] = w;
                    else if (it >= 2 && grow < nrows) { u32x4 ww; ww.x = keep[ai][m].x; ww.y = keep[ai][m].y; ww.z = w.x; ww.w = w.y; *(u32x4*)(ACT + (size_t)grow * dff + gcol - 4) = ww; } }
            }
        }
#undef XOFF
    }
};

template <class Epi, class Sched, bool ALIGN_EPI = false, bool SP2 = false>
__device__ __forceinline__ void gemm_phase(PG8_LAS unsigned char* lds, const Gemm g, const Sched& S, const Epi& E) {
    const int tid = mk_tid(), wid = __builtin_amdgcn_readfirstlane(tid >> 6), lane = tid & 63, wr = wid >> 2, wc = wid & 3, fr = lane & 15, fq = lane >> 4;
    const int K = g.K, nt = K / BK;
    unsigned voffA[2], voffB[2];
#pragma unroll
    for (int i = 0; i < 2; ++i) { int R, C; stage_rc(tid * 16 + i * 8192, R, C); const int Rb = Epi::PERM ? ((R & ~31) + perm32(R & 31)) : R;
        const int Ra = Epi::APERM ? ((R & ~63) + 4 * (R & 15) + ((R >> 4) & 3)) : R;
        voffA[i] = (unsigned)(Ra * K + C) * 2u; voffB[i] = (unsigned)(Rb * K + C) * 2u; }
    const size_t kstep = (size_t)(BK * 2);
    const size_t hstep = (size_t)HALF * K * 2;
    const size_t tstep = 2 * hstep;
    const size_t tstepA = (size_t)g.apr * K * 2;
    const unsigned ldsw = (unsigned)wid * 1024u;
    const int aoff = lds_byte(wr * 64 + fr, fq * 8), boff = lds_byte(wc * 32 + fr, fq * 8);
#define PG8_SA(b, h) (((b) * 2 + (h)) * HTB)
#define PG8_SB(b, h) ((4 + (b) * 2 + (h)) * HTB)
#define PG8_STAGE(bufoff, gbase, voff) do { _Pragma("unroll") for (int _i = 0; _i < 2; ++_i) \
        __builtin_amdgcn_global_load_lds((const unsigned*)((const char*)(gbase) + (voff)[_i]), (PG8_LAS unsigned*)(lds + (bufoff) + ldsw + _i * 8192), 16, 0, 0); } while (0)
#define PG8_LDA(dst, b, h) do { _Pragma("unroll") for (int m = 0; m < 4; ++m) _Pragma("unroll") for (int k = 0; k < 2; ++k) dst[m][k] = *(const PG8_LAS bf16x8*)(lds + PG8_SA(b, h) + aoff + m * 2048 + k * 1024); } while (0)
#define PG8_LDB(dst, b, h) do { _Pragma("unroll") for (int n = 0; n < 2; ++n) _Pragma("unroll") for (int k = 0; k < 2; ++k) dst[n][k] = *(const PG8_LAS bf16x8*)(lds + PG8_SB(b, h) + boff + n * 2048 + k * 1024); } while (0)
#define PG8_MMA(ai, bj, At, Bt) do { __builtin_amdgcn_s_setprio(1); _Pragma("unroll") for (int m = 0; m < 4; ++m) _Pragma("unroll") for (int n = 0; n < 2; ++n) _Pragma("unroll") for (int k = 0; k < 2; ++k) \
        acc[ai][bj][m][n] = __builtin_amdgcn_mfma_f32_16x16x32_bf16(Bt[n][k], At[m][k], acc[ai][bj][m][n], 0, 0, 0); __builtin_amdgcn_s_setprio(0); } while (0)
#define PG8_WAIT_V(n) asm volatile("s_waitcnt vmcnt(" #n ")" ::: "memory")
#define PG8_WAIT_L(n) asm volatile("s_waitcnt lgkmcnt(" #n ")" ::: "memory")
#define PG8_BAR __builtin_amdgcn_s_barrier()
#define PG8_SCHED __builtin_amdgcn_sched_barrier(0)
    Unit cur, nxt; int ui = 0;
    if (!S.next(0, cur)) return;
    f32x4 acc[2][2][4][2];
#pragma unroll
    for (int a = 0; a < 2; ++a)
#pragma unroll
        for (int b = 0; b < 2; ++b)
#pragma unroll
            for (int m = 0; m < 4; ++m)
#pragma unroll
                for (int n = 0; n < 2; ++n) acc[a][b][m][n] = (f32x4){0.f, 0.f, 0.f, 0.f};
    bf16x8 At[4][2], B0[2][2], B1[2][2];
    const char* cA = (const char*)g.A + (size_t)cur.pm * tstepA; const char* cB = (const char*)g.Bt + (size_t)cur.pn * tstep;
    S.a_ready(cur);
    if constexpr (SP2) {
        PG8_STAGE(PG8_SB(0, 0), cB, voffB); PG8_STAGE(PG8_SB(0, 1), cB + hstep, voffB); PG8_STAGE(PG8_SA(0, 0), cA, voffA); PG8_STAGE(PG8_SA(0, 1), cA + hstep, voffA);
        if (wr == 1) PG8_BAR;
        PG8_WAIT_V(2); PG8_BAR;
        PG8_STAGE(PG8_SB(1, 0), cB + kstep, voffB); PG8_STAGE(PG8_SA(1, 0), cA + kstep, voffA); PG8_STAGE(PG8_SB(1, 1), cB + hstep + kstep, voffB);
        PG8_WAIT_V(6); PG8_BAR;
    } else {
        PG8_STAGE(PG8_SB(0, 0), cB, voffB); PG8_STAGE(PG8_SA(0, 0), cA, voffA); PG8_STAGE(PG8_SB(0, 1), cB + hstep, voffB); PG8_STAGE(PG8_SA(0, 1), cA + hstep, voffA);
        if (wr == 1) PG8_BAR;
        PG8_WAIT_V(4); PG8_BAR;
        PG8_STAGE(PG8_SB(1, 0), cB + kstep, voffB); PG8_STAGE(PG8_SA(1, 0), cA + kstep, voffA); PG8_STAGE(PG8_SB(1, 1), cB + hstep + kstep, voffB);
        PG8_WAIT_V(6); PG8_BAR;
    }
    for (;;) {
        const bool has_next = S.next(ui + 1, nxt);
        const char* nA = has_next ? (const char*)g.A + (size_t)nxt.pm * tstepA : cA; const char* nB = has_next ? (const char*)g.Bt + (size_t)nxt.pn * tstep : cB;
        for (int t = 0; t < nt; t += 2) {
            const bool last = (t == nt - 2);
            const char* a1 = cA + (size_t)(t + 1) * kstep;
            const char* a2 = last ? nA : cA + (size_t)(t + 2) * kstep; const char* b2 = last ? nB : cB + (size_t)(t + 2) * kstep;
            const char* a3 = a2 + kstep; const char* b3 = b2 + kstep;
            if (last && has_next) S.a_ready(nxt);
            if constexpr (SP2) {
            PG8_LDB(B0, 0, 0); PG8_LDB(B1, 0, 1); PG8_SCHED; PG8_LDA(At, 0, 0); PG8_STAGE(PG8_SA(1, 1), a1 + hstep, voffA);
            PG8_WAIT_V(8); PG8_WAIT_L(0); PG8_BAR; PG8_MMA(0, 0, At, B0); PG8_MMA(0, 1, At, B1); PG8_BAR; PG8_SCHED;
            PG8_LDA(At, 0, 1); PG8_STAGE(PG8_SB(0, 0), b2, voffB); PG8_STAGE(PG8_SB(0, 1), b2 + hstep, voffB); PG8_STAGE(PG8_SA(0, 0), a2, voffA);
            PG8_WAIT_V(8); PG8_WAIT_L(0); PG8_BAR; PG8_MMA(1, 0, At, B0); PG8_MMA(1, 1, At, B1); PG8_BAR; PG8_SCHED;
            PG8_LDB(B0, 1, 0); PG8_LDB(B1, 1, 1); PG8_SCHED; PG8_LDA(At, 1, 0); PG8_STAGE(PG8_SA(0, 1), a2 + hstep, voffA);
            PG8_WAIT_V(8); PG8_WAIT_L(0); PG8_BAR; PG8_MMA(0, 0, At, B0); PG8_MMA(0, 1, At, B1); PG8_BAR; PG8_SCHED;
            PG8_LDA(At, 1, 1); PG8_STAGE(PG8_SB(1, 0), b3, voffB); PG8_STAGE(PG8_SB(1, 1), b3 + hstep, voffB); PG8_STAGE(PG8_SA(1, 0), a3, voffA);
            PG8_WAIT_V(8); PG8_WAIT_L(0); PG8_BAR; PG8_MMA(1, 0, At, B0); PG8_MMA(1, 1, At, B1); PG8_BAR; PG8_SCHED;
            } else {
            PG8_LDB(B0, 0, 0); PG8_SCHED; PG8_LDA(At, 0, 0); PG8_STAGE(PG8_SA(1, 1), a1 + hstep, voffA);
            PG8_WAIT_L(8); PG8_BAR; PG8_WAIT_L(0); PG8_MMA(0, 0, At, B0); PG8_BAR; PG8_SCHED;
            PG8_LDB(B1, 0, 1); PG8_STAGE(PG8_SB(0, 0), b2, voffB);
            PG8_BAR; PG8_WAIT_L(0); PG8_MMA(0, 1, At, B1); PG8_BAR;
            PG8_LDA(At, 0, 1); PG8_STAGE(PG8_SA(0, 0), a2, voffA);
            PG8_BAR; PG8_WAIT_L(0); PG8_MMA(1, 0, At, B0); PG8_BAR; PG8_SCHED;
            PG8_STAGE(PG8_SB(0, 1), b2 + hstep, voffB);
            PG8_WAIT_V(6); PG8_BAR; PG8_MMA(1, 1, At, B1); PG8_BAR;
            PG8_LDB(B0, 1, 0); PG8_SCHED; PG8_LDA(At, 1, 0); PG8_STAGE(PG8_SA(0, 1), a2 + hstep, voffA);
            PG8_WAIT_L(8); PG8_BAR; PG8_WAIT_L(0); PG8_MMA(0, 0, At, B0); PG8_BAR; PG8_SCHED;
            PG8_LDB(B1, 1, 1); PG8_STAGE(PG8_SB(1, 0), b3, voffB);
            PG8_BAR; PG8_WAIT_L(0); PG8_MMA(0, 1, At, B1); PG8_BAR;
            PG8_LDA(At, 1, 1); PG8_STAGE(PG8_SA(1, 0), a3, voffA);
            PG8_BAR; PG8_WAIT_L(0); PG8_MMA(1, 0, At, B0); PG8_BAR; PG8_SCHED;
            PG8_STAGE(PG8_SB(1, 1), b3 + hstep, voffB);
            PG8_WAIT_V(6); PG8_BAR; PG8_MMA(1, 1, At, B1); PG8_BAR;
            }
        }
        if constexpr (ALIGN_EPI) { if (wr == 0) PG8_BAR; }
        if constexpr (!Epi::AFTER_DRAIN) { E(acc, cur, wr, wc, fr, fq); S.done(cur); }
        if (!has_next) break;
#pragma unroll
        for (int a = 0; a < 2; ++a)
#pragma unroll
            for (int b = 0; b < 2; ++b)
#pragma unroll
                for (int m = 0; m < 4; ++m)
#pragma unroll
                    for (int n = 0; n < 2; ++n) acc[a][b][m][n] = (f32x4){0.f, 0.f, 0.f, 0.f};
        cur = nxt; cA = nA; cB = nB; ++ui;
        if constexpr (ALIGN_EPI) { if (wr == 1) PG8_BAR; }
    }
    PG8_WAIT_V(0);
    if constexpr (!ALIGN_EPI) { if (wr == 0) PG8_BAR; }
    PG8_BAR;
    if constexpr (Epi::AFTER_DRAIN) { E.fused(acc, cur, wr, wc, fr, fq, lds, wid, lane); S.done(cur); }
#undef PG8_SA
#undef PG8_SB
#undef PG8_STAGE
#undef PG8_LDA
#undef PG8_LDB
#undef PG8_MMA
#undef PG8_WAIT_V
#undef PG8_WAIT_L
#undef PG8_BAR
#undef PG8_SCHED
}
}

namespace fox {
#define LAS3 __attribute__((address_space(3)))
constexpr int D = 128, SEQ = 16384, NH = 32, OPITCH = 4096;
constexpr float SCALE = 0.08838834764831845f;
constexpr float THR = 8.f;
constexpr int NW = 8, QBLK = 32, KVBLK = 64, QB = NW * QBLK;
constexpr int SHM_V = KVBLK * D * 2, SHM_K = KVBLK * D * 2;
constexpr int OFF_WS = 2 * SHM_V + 2 * SHM_K, OFF_BIAS = OFF_WS + NW * 64 * 4, OFF_QW = OFF_BIAS + 2 * 64 * 4, OFF_JLO = OFF_QW + 16, LDS_BYTES = OFF_JLO + 2048;
constexpr float SKIP_T = 30.f;
typedef unsigned short bf16;
typedef short bf16x8 __attribute__((ext_vector_type(8)));
typedef short s16x4 __attribute__((ext_vector_type(4)));
typedef float f32x16 __attribute__((ext_vector_type(16)));
typedef float f32x4 __attribute__((ext_vector_type(4)));
typedef unsigned u32x4 __attribute__((ext_vector_type(4)));

#define KSWZ(row, colB) ((row) * 256 + ((colB) ^ (((row) & 7) << 4)))
#define SBAR() __builtin_amdgcn_sched_barrier(0)
__device__ __forceinline__ int v_st(int k, int c) { const int kk = (k & ~0xC) | ((k & 4) << 1) | ((k & 8) >> 1); return ((kk >> 3) * 4 + (c >> 5)) * 512 + ((kk & 7) * 32 + (c & 31)) * 2; }
__device__ __forceinline__ int v_rd_base(int lane) { return ((lane & 3) << 3) | (((lane >> 2) & 3) << 6) | (((lane >> 4) & 1) << 5) | (((lane >> 5) & 1) << 8); }
constexpr int v_rd_off(int d0, int ks, int half) { return d0 * 512 + ks * 4096 + half * 2048; }
__device__ __forceinline__ int crow(int r, int hi) { return (r & 3) + 8 * (r >> 2) + 4 * hi; }
__device__ __forceinline__ unsigned cvtpk(float lo, float hi) { unsigned r; asm volatile("v_cvt_pk_bf16_f32 %0, %1, %2" : "=v"(r) : "v"(lo), "v"(hi)); return r; }
__device__ __forceinline__ bf16x8 load8(const bf16* p) { return *reinterpret_cast<const bf16x8*>(p); }
__device__ __forceinline__ void mask_tile(f32x16& p0, f32x16& p1, int dq) {
    const float NEG = -__builtin_inff();
#pragma unroll
    for (int r = 0; r < 16; ++r) {
        const int c = (r & 3) + 8 * (r >> 2);
        if (dq - c < 0) p0[r] = NEG;
        if (dq - c - 32 < 0) p1[r] = NEG;
    }
}
__device__ __forceinline__ void partialSM(f32x16& p0, f32x16& p1, float& m_reg, float& mn, float& alpha) {
    float pmax = p0[0]; for (int r = 1; r < 16; ++r) pmax = fmaxf(pmax, p0[r]); for (int r = 0; r < 16; ++r) pmax = fmaxf(pmax, p1[r]);
    { auto rr = __builtin_amdgcn_permlane32_swap(__float_as_uint(pmax), __float_as_uint(pmax), false, false);
      pmax = fmaxf(__uint_as_float(rr[0]), __uint_as_float(rr[1])); }
    constexpr float C2 = 1.4426950408889634f * SCALE;
    if (__builtin_expect(__all((pmax - m_reg) * SCALE <= THR), 1)) { mn = m_reg; alpha = 1.f; }
    else { mn = fmaxf(m_reg, pmax); alpha = __builtin_amdgcn_exp2f((m_reg - mn) * C2); m_reg = mn; }
    const float mnL = -mn * C2;
    for (int r = 0; r < 16; ++r) p0[r] = fmaf(p0[r], C2, mnL); for (int r = 0; r < 16; ++r) p1[r] = fmaf(p1[r], C2, mnL);
    for (int r = 0; r < 16; ++r) p0[r] = __builtin_amdgcn_exp2f(p0[r]);
}
__device__ __forceinline__ void finishSM(f32x16& p0, f32x16& p1, float alpha, float& l_reg, bf16x8& pa0, bf16x8& pa1, bf16x8& pa2, bf16x8& pa3) {
    for (int r = 0; r < 16; ++r) p1[r] = __builtin_amdgcn_exp2f(p1[r]);
    float ps = 0; for (int r = 0; r < 16; ++r) ps += p0[r]; for (int r = 0; r < 16; ++r) ps += p1[r];
    { auto rr = __builtin_amdgcn_permlane32_swap(__float_as_uint(ps), __float_as_uint(ps), false, false);
      ps = __uint_as_float(rr[0]) + __uint_as_float(rr[1]); }
    l_reg = l_reg * alpha + ps;
#define PK4(P, B_, OUT) do { unsigned a0 = cvtpk(P[B_+0], P[B_+1]), a1 = cvtpk(P[B_+2], P[B_+3]);                          \
        unsigned b0 = cvtpk(P[B_+4], P[B_+5]), b1 = cvtpk(P[B_+6], P[B_+7]);                                             \
        auto r0 = __builtin_amdgcn_permlane32_swap(a0, b0, false, false); auto r1 = __builtin_amdgcn_permlane32_swap(a1, b1, false, false); \
        u32x4 w = {r0[0], r1[0], r0[1], r1[1]}; OUT = *reinterpret_cast<bf16x8*>(&w); } while (0)
    PK4(p0, 0, pa0); PK4(p0, 8, pa1); PK4(p1, 0, pa2); PK4(p1, 8, pa3);
}
template <int KB>
__device__ __forceinline__ void qkt(f32x16& p0, f32x16& p1, const char* K_lds, const char* B_lds, int r32, int hi, const bf16x8* qr) {
    const float* bl = (const float*)B_lds + KB * 64 + 4 * hi;
#pragma unroll
    for (int g = 0; g < 4; ++g) { const f32x4 a = *(const f32x4*)(bl + 8 * g), b = *(const f32x4*)(bl + 32 + 8 * g);
        p0[4 * g + 0] = a[0]; p0[4 * g + 1] = a[1]; p0[4 * g + 2] = a[2]; p0[4 * g + 3] = a[3];
        p1[4 * g + 0] = b[0]; p1[4 * g + 1] = b[1]; p1[4 * g + 2] = b[2]; p1[4 * g + 3] = b[3]; }
    const char* kb[4];
#pragma unroll
    for (int dd = 0; dd < 4; ++dd) kb[dd] = K_lds + KB * SHM_K + KSWZ(r32, (dd * 16 + hi * 8) * 2);
#pragma unroll
    for (int d0 = 0; d0 < 8; ++d0) { const char* a = kb[d0 & 3] + (d0 >> 2) * 128;
        bf16x8 b0 = *reinterpret_cast<const bf16x8*>(a);
        bf16x8 b1 = *reinterpret_cast<const bf16x8*>(a + 32 * 256);
        p0 = __builtin_amdgcn_mfma_f32_32x32x16_bf16(b0, qr[d0], p0, 0, 0, 0);
        p1 = __builtin_amdgcn_mfma_f32_32x32x16_bf16(b1, qr[d0], p1, 0, 0, 0); }
}
template <int VB>
__device__ __forceinline__ void pv_tile(f32x16* o, int vb0, bf16x8 pa0, bf16x8 pa1, bf16x8 pa2, bf16x8 pa3) {
#define TRRD(dst, off) asm volatile("ds_read_b64_tr_b16 %0, %1 offset:%2" : "=&v"(dst) : "v"(vb0), "i"(off) : "memory")
#define PV_D0(d0) do { s16x4 l0, l1, l2, l3, h0, h1, h2, h3; constexpr int b_ = VB * SHM_V + v_rd_off(d0, 0, 0);     \
        TRRD(l0, b_); TRRD(h0, b_ + 2048); TRRD(l1, b_ + 4096); TRRD(h1, b_ + 6144); TRRD(l2, b_ + 8192); TRRD(h2, b_ + 10240); TRRD(l3, b_ + 12288); TRRD(h3, b_ + 14336); \
        asm volatile("s_waitcnt lgkmcnt(0)" ::: "memory"); SBAR();                                                                              \
        o[d0] = __builtin_amdgcn_mfma_f32_32x32x16_bf16((bf16x8){l0[0], l0[1], l0[2], l0[3], h0[0], h0[1], h0[2], h0[3]}, pa0, o[d0], 0, 0, 0);   \
        o[d0] = __builtin_amdgcn_mfma_f32_32x32x16_bf16((bf16x8){l1[0], l1[1], l1[2], l1[3], h1[0], h1[1], h1[2], h1[3]}, pa1, o[d0], 0, 0, 0);   \
        o[d0] = __builtin_amdgcn_mfma_f32_32x32x16_bf16((bf16x8){l2[0], l2[1], l2[2], l2[3], h2[0], h2[1], h2[2], h2[3]}, pa2, o[d0], 0, 0, 0);   \
        o[d0] = __builtin_amdgcn_mfma_f32_32x32x16_bf16((bf16x8){l3[0], l3[1], l3[2], l3[3], h3[0], h3[1], h3[2], h3[3]}, pa3, o[d0], 0, 0, 0); } while (0)
    PV_D0(0); PV_D0(1); PV_D0(2); PV_D0(3);
#undef PV_D0
#undef TRRD
}

struct BlockRef { const bf16* Q; const bf16* K; const bf16* V; const float* C; bf16* O; int P0; int jlo; };
struct Seam {
    bf16x8 qr[8];
    bf16x8 st_v0, st_v1, st_k0, st_k1; float st_b;
};
#define ROW(p, k0, rr) ((p) + (size_t)((k0) + (rr)) * D + sc)
#define VMW() asm volatile("s_waitcnt vmcnt(0)" ::: "memory")
#define VMWN(n) asm volatile("s_waitcnt vmcnt(%0)" :: "i"(n) : "memory")
#define SLOAD_H(Kp, Vp, Cp, k0) do { S.st_v0 = load8(ROW(Vp, k0, sr)); S.st_v1 = load8(ROW(Vp, k0, 32 + sr));              \
                         S.st_k0 = load8(ROW(Kp, k0, sr)); S.st_k1 = load8(ROW(Kp, k0, 32 + sr)); if (tid < 64) S.st_b = (Cp)[(k0) + tid]; } while (0)
#define SWRITE_HK(bf, cr) do { *(bf16x8*)(K_lds + (bf) * SHM_K + kws) = S.st_k0; *(bf16x8*)(K_lds + (bf) * SHM_K + kws + 32 * 256) = S.st_k1; \
                         if (tid < 64) ((float*)B_lds)[(bf) * 64 + tid] = S.st_b - (cr); } while (0)
#define SWRITE_HV(bf) do { *(bf16x8*)(V_lds + (bf) * SHM_V + vst0) = S.st_v0; *(bf16x8*)(V_lds + (bf) * SHM_V + vst1) = S.st_v1; } while (0)
#define SWRITE_H(bf, cr) do { SWRITE_HV(bf); SWRITE_HK(bf, cr); } while (0)
__device__ __forceinline__ void fox_prime(const BlockRef& cur, char* lds, Seam& S) {
    const int tid = mk_tid(), wid = __builtin_amdgcn_readfirstlane(tid >> 6), lane = tid & 63, r32 = lane & 31, hi = lane >> 5;
    const int sr = tid >> 4, sc = (tid & 15) * 8, kws = KSWZ(sr, sc * 2); char* K_lds = lds + 2 * SHM_V; char* B_lds = lds + OFF_BIAS;
    const float cref = __uint_as_float(__builtin_amdgcn_readfirstlane(__float_as_uint(cur.C[cur.P0])));
    for (int d0 = 0; d0 < 8; ++d0) S.qr[d0] = load8(cur.Q + (size_t)(wid * QBLK + r32) * D + d0 * 16 + hi * 8);
    SLOAD_H(cur.K, cur.V, cur.C, cur.jlo * KVBLK); VMW(); SWRITE_HK(0, cref);
    __syncthreads();
}
template <class NextFn> __device__ __forceinline__ BlockRef fox_block(const BlockRef& cur, char* lds, Seam& S, unsigned* qctr, const NextFn& mkref, bool& has_next) {
    const int tid = mk_tid(), wid = __builtin_amdgcn_readfirstlane(tid >> 6), lane = tid & 63, r32 = lane & 31, hi = lane >> 5;
    const int j_lo = cur.jlo, NT = (cur.P0 + QB - 1) / KVBLK + 1 - j_lo;
    unsigned qv = 0u; if (tid == 0) qv = __hip_atomic_fetch_add(qctr, 1u, __ATOMIC_RELAXED, __HIP_MEMORY_SCOPE_AGENT);
    const int qlo = cur.P0 + wid * QBLK, qm = qlo + r32 - 4 * hi;
    char* V_lds = lds; char* K_lds = lds + 2 * SHM_V; char* B_lds = lds + OFF_BIAS;
    float m_reg = -1e30f, l_reg = 0; f32x16 o[4] = {};
    const int sr = tid >> 4, sc = (tid & 15) * 8, vst0 = v_st(sr, sc), vst1 = v_st(32 + sr, sc), kws = KSWZ(sr, sc * 2);
    const int vb0 = (int)(uintptr_t)V_lds + v_rd_base(lane);
    const bf16* Kh = cur.K; const bf16* Vh = cur.V; const float* Ch = cur.C;
    const float cref = __uint_as_float(__builtin_amdgcn_readfirstlane(__float_as_uint(cur.C[cur.P0])));
#define RESC(a) do { if (__any((a) < 1.f)) { for (int d_ = 0; d_ < 4; ++d_) for (int r = 0; r < 16; ++r) o[d_][r] *= (a); } } while (0)
#define KBASE(t) ((j_lo + (t)) * KVBLK)
#define MASKT(P0_, P1_, t) do { const int kb_ = KBASE(t); if (kb_ + KVBLK - 1 > qlo) mask_tile(P0_, P1_, qm - kb_); } while (0)
    constexpr int NQL = 8;
#define SEAM_K0() do { VMWN(NQL); SWRITE_HK(0, crefn); SBAR(); } while (0)
    f32x16 pA0, pA1, pB0, pB1; float mnA, mnB, alA, alB; bf16x8 pa0, pa1, pa2, pa3;
    SWRITE_HV(0); SBAR();
    if (NT > 1) { SLOAD_H(Kh, Vh, Ch, KBASE(1)); }
    SBAR(); qkt<0>(pA0, pA1, K_lds, B_lds, r32, hi, S.qr);
    MASKT(pA0, pA1, 0); partialSM(pA0, pA1, m_reg, mnA, alA);
    if (NT > 1) { VMW(); SWRITE_H(1, cref); }
    if (tid == 0) *(volatile LAS3 unsigned*)(lds + OFF_QW) = qv;
    __syncthreads();
    const unsigned inext = (unsigned)__builtin_amdgcn_readfirstlane((int)*(volatile LAS3 unsigned*)(lds + OFF_QW)); has_next = inext < (unsigned)(NH * (SEQ / QB));
    const BlockRef nxt = has_next ? mkref((int)inext) : cur;
    const float crefn = __uint_as_float(__builtin_amdgcn_readfirstlane(__float_as_uint(nxt.C[nxt.P0]))); const int kbn = nxt.jlo * KVBLK;
#define HALF_STEP(PX0, PX1, mnX, alX, PY0, PY1, alY, t, KB, VB, SB) do {                                                      \
        SBAR(); qkt<KB>(PX0, PX1, K_lds, B_lds, r32, hi, S.qr);                                                               \
        finishSM(PY0, PY1, alY, l_reg, pa0, pa1, pa2, pa3); SBAR();                                                           \
        if ((t) + 1 < NT) { SLOAD_H(Kh, Vh, Ch, KBASE((t) + 1)); SBAR(); }                                                    \
        pv_tile<VB>(o, vb0, pa0, pa1, pa2, pa3); MASKT(PX0, PX1, (t)); partialSM(PX0, PX1, m_reg, mnX, alX);                  \
        __syncthreads();                                                                                                      \
        if ((t) + 1 < NT) { VMW(); SWRITE_H(SB, cref); }                                                                      \
        RESC(alX); __syncthreads(); } while (0)
    for (int t = 1; t + 1 < NT; t += 2) {
        HALF_STEP(pB0, pB1, mnB, alB, pA0, pA1, alA, t, 1, 0, 0);
        HALF_STEP(pA0, pA1, mnA, alA, pB0, pB1, alB, t + 1, 0, 1, 1);
    }
    const bool even = (NT & 1) == 0;
    if (even) { SBAR(); qkt<1>(pB0, pB1, K_lds, B_lds, r32, hi, S.qr); SBAR(); }
    SLOAD_H(nxt.K, nxt.V, nxt.C, kbn); SBAR();
#pragma unroll
    for (int d0 = 0; d0 < 8; ++d0) S.qr[d0] = load8(nxt.Q + (size_t)(wid * QBLK + r32) * D + d0 * 16 + hi * 8);
    SBAR();
    finishSM(pA0, pA1, alA, l_reg, pa0, pa1, pa2, pa3); SBAR();
    pv_tile<0>(o, vb0, pa0, pa1, pa2, pa3);
    if (even) { MASKT(pB0, pB1, NT - 1); partialSM(pB0, pB1, m_reg, mnB, alB); __syncthreads(); RESC(alB);
        finishSM(pB0, pB1, alB, l_reg, pa0, pa1, pa2, pa3); SBAR(); pv_tile<1>(o, vb0, pa0, pa1, pa2, pa3); }
    SBAR(); SEAM_K0();
    {
        const float rl = __builtin_amdgcn_rcpf(l_reg);
        bf16* Ow = cur.O + (size_t)(wid * QBLK + r32) * OPITCH + 8 * hi;
#pragma unroll
        for (int d0 = 0; d0 < 4; ++d0)
#pragma unroll
            for (int gp = 0; gp < 2; ++gp) { const int b_ = 8 * gp;
                const unsigned a0 = cvtpk(o[d0][b_ + 0] * rl, o[d0][b_ + 1] * rl), a1 = cvtpk(o[d0][b_ + 2] * rl, o[d0][b_ + 3] * rl);
                const unsigned b0 = cvtpk(o[d0][b_ + 4] * rl, o[d0][b_ + 5] * rl), b1 = cvtpk(o[d0][b_ + 6] * rl, o[d0][b_ + 7] * rl);
                auto r0 = __builtin_amdgcn_permlane32_swap(a0, b0, false, false); auto r1 = __builtin_amdgcn_permlane32_swap(a1, b1, false, false);
                u32x4 w = {r0[0], r1[0], r0[1], r1[1]}; *(u32x4*)(Ow + d0 * 32 + 16 * gp) = w; }
    }
    __syncthreads();
    return nxt;
#undef RESC
#undef KBASE
#undef MASKT
#undef SEAM_K0
#undef HALF_STEP
}
#undef ROW
#undef VMW
#undef VMWN
#undef SLOAD_H
#undef SWRITE_HK
#undef SWRITE_HV
#undef SWRITE_H
#undef PK4

__device__ __forceinline__ BlockRef fox_ref(int item, const bf16* Q, const bf16* K, const bf16* V, const float* Cn, bf16* O, const char* lds) {
    const int qb = SEQ / QB - 1 - (item >> 5), bh = item & 31;
    BlockRef r; r.Q = Q + ((size_t)bh * SEQ + (size_t)qb * QB) * D; r.K = K + (size_t)bh * SEQ * D; r.V = V + (size_t)bh * SEQ * D; r.C = Cn + (size_t)bh * SEQ;
    r.O = O + (size_t)(qb * QB) * OPITCH + bh * D; r.P0 = qb * QB; r.jlo = (int)((const unsigned char*)(lds + OFF_JLO))[bh * 64 + qb]; return r;
}
__device__ __forceinline__ void fox_attn_phase(char* lds, const bf16* Q, const bf16* K, const bf16* V, const float* Cn, const unsigned* nrm2, unsigned* qctr, bf16* O) {
    const int tid = mk_tid();
    {
        int lo[4], hi[4]; float thr[4]; const float* Cb[4];
#pragma unroll
        for (int k = 0; k < 4; ++k) { const int e = tid + 512 * k, bh = e >> 6, qb = e & 63, P0 = qb * QB; Cb[k] = Cn + (size_t)bh * SEQ;
            const float qn2 = __uint_as_float(nrm2[bh]), kn2 = __uint_as_float(nrm2[32 + bh]);
            const float Dh = SKIP_T * (1.0f / SCALE) + 2.04f * sqrtf(qn2 * kn2) + 1.0f;
            thr[k] = Cb[k][P0] - Dh; lo[k] = 0; hi[k] = P0 / KVBLK; }
#pragma unroll 1
        for (int it = 0; it < 8; ++it) {
            float v[4]; int mid[4];
#pragma unroll
            for (int k = 0; k < 4; ++k) { mid[k] = (lo[k] + hi[k]) >> 1; v[k] = Cb[k][mid[k] * KVBLK + KVBLK - 1]; }
#pragma unroll
            for (int k = 0; k < 4; ++k) if (lo[k] < hi[k]) { if (v[k] < thr[k]) lo[k] = mid[k] + 1; else hi[k] = mid[k]; }
        }
#pragma unroll
        for (int k = 0; k < 4; ++k) ((unsigned char*)(lds + OFF_JLO))[tid + 512 * k] = (unsigned char)lo[k];
    }
    if (tid == 0) *(volatile LAS3 unsigned*)(lds + OFF_QW) = __hip_atomic_fetch_add(qctr, 1u, __ATOMIC_RELAXED, __HIP_MEMORY_SCOPE_AGENT);
    __syncthreads();
    const unsigned i0 = (unsigned)__builtin_amdgcn_readfirstlane((int)*(volatile LAS3 unsigned*)(lds + OFF_QW));
    if (i0 >= (unsigned)(NH * (SEQ / QB))) return;
    __syncthreads();
    auto mk = [=](int item) { return fox_ref(item, Q, K, V, Cn, O, lds); };
    BlockRef cur = mk((int)i0);
    Seam S;
    fox_prime(cur, lds, S);
    for (;;) { bool has_next; const BlockRef nxt = fox_block(cur, lds, S, qctr, mk, has_next); if (!has_next) break; cur = nxt; }
}
#undef LAS3
#undef KSWZ
#undef SBAR
}

namespace swa {
constexpr int SEQ = 16384, QKVP = 5120, OP = 4096;
constexpr int K_OFF = 0, VT_OFF = 32768, VT_PITCH = 528, LI_OFF = VT_OFF + 64 * VT_PITCH, LDS_BYTES = LI_OFF + 8 * 32 * 4;
typedef unsigned short bf16;
typedef short bf16x8 __attribute__((ext_vector_type(8)));
typedef float f32x16 __attribute__((ext_vector_type(16)));
typedef float f32x4 __attribute__((ext_vector_type(4)));
typedef unsigned u32x4 __attribute__((ext_vector_type(4)));
__device__ __forceinline__ int crow(int r, int hi) { return (r & 3) + 8 * (r >> 2) + 4 * hi; }
__device__ __forceinline__ unsigned cvtpk(float lo, float hi) { unsigned r; asm volatile("v_cvt_pk_bf16_f32 %0, %1, %2" : "=v"(r) : "v"(lo), "v"(hi)); return r; }
__device__ __forceinline__ float bf2f(short b) { return __uint_as_float(((unsigned)(unsigned short)b) << 16); }
__device__ __forceinline__ bf16x8 pack8(const float* v) { u32x4 w = {cvtpk(v[0], v[1]), cvtpk(v[2], v[3]), cvtpk(v[4], v[5]), cvtpk(v[6], v[7])}; return *reinterpret_cast<bf16x8*>(&w); }
#define SWA_PK4(P, B_, OUT) do { unsigned a0 = cvtpk(P[B_+0], P[B_+1]), a1 = cvtpk(P[B_+2], P[B_+3]);                          \
        unsigned b0 = cvtpk(P[B_+4], P[B_+5]), b1 = cvtpk(P[B_+6], P[B_+7]);                                             \
        auto r0 = __builtin_amdgcn_permlane32_swap(a0, b0, false, false); auto r1 = __builtin_amdgcn_permlane32_swap(a1, b1, false, false); \
        u32x4 w = {r0[0], r1[0], r0[1], r1[1]}; OUT = *reinterpret_cast<bf16x8*>(&w); } while (0)

__device__ __forceinline__ void swa_attn_phase(char* lds, const bf16* QKV, const float* sinks, const float* cosT, const float* sinT, bf16* O, int wg, int G) {
    const int tid = mk_tid(), wid = __builtin_amdgcn_readfirstlane(tid >> 6), lane = tid & 63, r32 = lane & 31, hi = lane >> 5;
    for (int L = wg; L < 1024; L += G) {
        const int g = L & 7, n = L >> 3;
        __syncthreads();
        {
            const int row = tid >> 1, half = tid & 1, kpos = 128 * (n - 1) + row;
            bf16x8 kc[4], vc[4];
            if (kpos >= 0) {
                const bf16* kp = QKV + (size_t)kpos * QKVP + 4096 + g * 64 + half * 32; const bf16* vp = kp + 512;
#pragma unroll
                for (int c = 0; c < 4; ++c) { kc[c] = *(const bf16x8*)(kp + 8 * c); vc[c] = *(const bf16x8*)(vp + 8 * c); }
                if (half == 0) {
                    const f32x4 c0 = *(const f32x4*)(cosT + (size_t)kpos * 8), c1 = *(const f32x4*)(cosT + (size_t)kpos * 8 + 4);
                    const f32x4 s0 = *(const f32x4*)(sinT + (size_t)kpos * 8), s1 = *(const f32x4*)(sinT + (size_t)kpos * 8 + 4);
                    float o1[8], o2[8];
#pragma unroll
                    for (int i = 0; i < 8; ++i) { const float cs = i < 4 ? c0[i & 3] : c1[i & 3], sn = i < 4 ? s0[i & 3] : s1[i & 3];
                        const float x1 = bf2f(kc[0][i]), x2 = bf2f(kc[1][i]); o1[i] = x1 * cs - x2 * sn; o2[i] = x2 * cs + x1 * sn; }
                    kc[0] = pack8(o1); kc[1] = pack8(o2);
                }
            } else {
#pragma unroll
                for (int c = 0; c < 4; ++c) { kc[c] = (bf16x8){0, 0, 0, 0, 0, 0, 0, 0}; vc[c] = (bf16x8){0, 0, 0, 0, 0, 0, 0, 0}; }
            }
#pragma unroll
            for (int c = 0; c < 4; ++c) { const int chunk = half * 4 + c;
                *(bf16x8*)(lds + K_OFF + row * 128 + ((chunk ^ ((row >> 1) & 7)) << 4)) = kc[c];
#pragma unroll
                for (int j = 0; j < 8; ++j) *(short*)(lds + VT_OFF + (half * 32 + c * 8 + j) * VT_PITCH + row * 2) = vc[c][j]; }
        }
        __syncthreads();
        const int hq = g * 8 + wid; const float sink = sinks[hq];
        for (int a = 0; a < 4; ++a) {
            const int t = 128 * n + 32 * a + r32;
            const bf16* qp = QKV + (size_t)t * QKVP + hq * 64;
            bf16x8 qr[4];
#pragma unroll
            for (int d0 = 0; d0 < 4; ++d0) qr[d0] = *(const bf16x8*)(qp + 16 * d0 + 8 * hi);
            {
                const bf16x8 pr = *(const bf16x8*)(qp + 8 * (1 - hi));
                const f32x4 c0 = *(const f32x4*)(cosT + (size_t)t * 8), c1 = *(const f32x4*)(cosT + (size_t)t * 8 + 4);
                const f32x4 s0 = *(const f32x4*)(sinT + (size_t)t * 8), s1 = *(const f32x4*)(sinT + (size_t)t * 8 + 4);
                float ov[8];
#pragma unroll
                for (int i = 0; i < 8; ++i) { const float cs = i < 4 ? c0[i & 3] : c1[i & 3], sn = i < 4 ? s0[i & 3] : s1[i & 3];
                    const float own = bf2f(qr[0][i]), par = bf2f(pr[i]); ov[i] = own * cs + (hi ? par : -par) * sn; }
                qr[0] = pack8(ov);
            }
            f32x16 p[5];
#pragma unroll
            for (int bi = 0; bi < 5; ++bi) { const int row = 32 * (a + bi) + r32; const char* kb = lds + K_OFF + row * 128; const int sw = (row >> 1) & 7;
                f32x16 acc = {};
#pragma unroll
                for (int d0 = 0; d0 < 4; ++d0) { const bf16x8 kf = *(const bf16x8*)(kb + (((2 * d0 + hi) ^ sw) << 4)); acc = __builtin_amdgcn_mfma_f32_32x32x16_bf16(kf, qr[d0], acc, 0, 0, 0); }
                p[bi] = acc; }
            const float NEG = -__builtin_inff();
#pragma unroll
            for (int r = 0; r < 16; ++r) { const int c = crow(r, hi); if (!(c > r32)) p[0][r] = NEG; if (!(c <= r32)) p[4][r] = NEG; }
            if (n == 0) {
#pragma unroll
                for (int bi = 0; bi < 4; ++bi) if (a + bi < 4) {
#pragma unroll
                    for (int r = 0; r < 16; ++r) p[bi][r] = NEG; }
            }
            float mx = NEG;
#pragma unroll
            for (int bi = 0; bi < 5; ++bi)
#pragma unroll
                for (int r = 0; r < 16; ++r) mx = fmaxf(mx, p[bi][r]);
            { auto rr = __builtin_amdgcn_permlane32_swap(__float_as_uint(mx), __float_as_uint(mx), false, false); mx = fmaxf(__uint_as_float(rr[0]), __uint_as_float(rr[1])); }
            const float m = fmaxf(mx * 0.125f, sink);
            constexpr float LOG2E = 1.4426950408889634f, C2 = 0.125f * LOG2E;
            const float mL = -m * LOG2E;
            float ps = 0.f;
#pragma unroll
            for (int bi = 0; bi < 5; ++bi)
#pragma unroll
                for (int r = 0; r < 16; ++r) { const float e = __builtin_amdgcn_exp2f(fmaf(p[bi][r], C2, mL)); p[bi][r] = e; ps += e; }
            { auto rr = __builtin_amdgcn_permlane32_swap(__float_as_uint(ps), __float_as_uint(ps), false, false); ps = __uint_as_float(rr[0]) + __uint_as_float(rr[1]); }
            const float l = ps + __builtin_amdgcn_exp2f(fmaf(sink, LOG2E, mL));
            f32x16 o[2] = {};
#pragma unroll
            for (int bi = 0; bi < 5; ++bi) { bf16x8 pa[2]; SWA_PK4(p[bi], 0, pa[0]); SWA_PK4(p[bi], 8, pa[1]);
#pragma unroll
                for (int ks = 0; ks < 2; ++ks)
#pragma unroll
                    for (int db = 0; db < 2; ++db) { const bf16x8 vf = *(const bf16x8*)(lds + VT_OFF + (32 * db + r32) * VT_PITCH + (32 * (a + bi) + 16 * ks + 8 * hi) * 2);
                        o[db] = __builtin_amdgcn_mfma_f32_32x32x16_bf16(vf, pa[ks], o[db], 0, 0, 0); } }
            const float rl = __builtin_amdgcn_rcpf(l);
            bf16* Ow = O + (size_t)(128 * n + 32 * a + r32) * OP + hq * 64 + 8 * hi;
#pragma unroll
            for (int db = 0; db < 2; ++db)
#pragma unroll
                for (int gp = 0; gp < 2; ++gp) { const int b_ = 8 * gp;
                    const unsigned a0 = cvtpk(o[db][b_ + 0] * rl, o[db][b_ + 1] * rl), a1 = cvtpk(o[db][b_ + 2] * rl, o[db][b_ + 3] * rl);
                    const unsigned b0 = cvtpk(o[db][b_ + 4] * rl, o[db][b_ + 5] * rl), b1 = cvtpk(o[db][b_ + 6] * rl, o[db][b_ + 7] * rl);
                    auto r0 = __builtin_amdgcn_permlane32_swap(a0, b0, false, false); auto r1 = __builtin_amdgcn_permlane32_swap(a1, b1, false, false);
                    u32x4 w = {r0[0], r1[0], r0[1], r1[1]}; *(u32x4*)(Ow + db * 32 + 16 * gp) = w; }
        }
    }
    __syncthreads();
}
#undef SWA_PK4
}

#define LAS __attribute__((address_space(3)))
#define GAS __attribute__((address_space(1)))
typedef unsigned short bf16;
typedef float f32x4 __attribute__((ext_vector_type(4)));
typedef unsigned u32x4 __attribute__((ext_vector_type(4)));
typedef unsigned u32x2 __attribute__((ext_vector_type(2)));
typedef short bf16x8 __attribute__((ext_vector_type(8)));
constexpr int SEQ = 16384, DM = 4096, DFF = 11008;
constexpr float NORM_EPS = 1e-6f;
__device__ __forceinline__ unsigned cvtpk(float lo, float hi) { unsigned r; asm volatile("v_cvt_pk_bf16_f32 %0, %1, %2" : "=v"(r) : "v"(lo), "v"(hi)); return r; }
__device__ __forceinline__ float bf_lo(unsigned w) { return __uint_as_float(w << 16); }
__device__ __forceinline__ float bf_hi(unsigned w) { return __uint_as_float(w & 0xffff0000u); }
__device__ __forceinline__ float wave_sum(float v) {
#pragma unroll
    for (int o = 1; o < 64; o <<= 1) v += __shfl_xor(v, o);
    return v;
}
__device__ __forceinline__ float gelu_tanh(float x) {
    const float u = 0.7978845608028654f * (x + 0.044715f * x * x * x);
    return x * __builtin_amdgcn_rcpf(1.0f + __builtin_amdgcn_exp2f(-2.8853900817779268f * u));
}
__device__ __forceinline__ void sincos_d(double a, double& s, double& c) {
    const double k = rint(a * 0.15915494309189535);
    double r = fma(-k, 6.283185307179586, a); r = fma(-k, 2.4492935982947064e-16, r);
    const double r2 = r * r; double ss = 1.0, cc = 1.0;
#pragma unroll
    for (int n = 29; n >= 3; n -= 2) ss = fma(-ss * r2, 1.0 / (double)(n * (n - 1)), 1.0);
#pragma unroll
    for (int n = 28; n >= 2; n -= 2) cc = fma(-cc * r2, 1.0 / (double)(n * (n - 1)), 1.0);
    s = r * ss; c = cc;
}
__device__ __forceinline__ double exp_d(double x) {
    const double k = rint(x * 1.4426950408889634);
    double r = fma(-k, 0.6931471803691238, x); r = fma(-k, 1.9082149292705877e-10, r);
    double p = 1.0;
#pragma unroll
    for (int n = 16; n >= 1; --n) p = fma(p * r, 1.0 / (double)n, 1.0);
    return ldexp(p, (int)k);
}

__device__ __forceinline__ void transpose_item(const float* __restrict__ W, int K, int N, bf16* __restrict__ WT, int mode, LAS unsigned* scr, int item, int lane) {
    const int nblk = (N + 63) / 64, kb = item / nblk, nb = item - kb * nblk, k0 = 128 * kb, n0 = 64 * nb;
    int r0 = n0; if (mode == 1) { const int bj = n0 >> 12, rem = n0 & 4095; r0 = ((rem >> 7) << 8) + (bj << 7) + (rem & 127); }
    if (mode == 2) { const int bj = n0 >= DFF ? 1 : 0, rem = n0 - bj * DFF; r0 = ((rem >> 7) << 8) + (bj << 7) + (rem & 127); }
    const int c = lane & 15, kq = lane >> 4;
    const bool ok = n0 + 4 * c < N;
    const float* src = W + (size_t)(k0 + 2 * kq) * N + n0 + 4 * c;
    LAS unsigned* sw = scr + (4 * c) * 65 + kq;
#pragma unroll
    for (int half = 0; half < 2; ++half) {
        f32x4 a[8], b[8]; const f32x4 z = {0.f, 0.f, 0.f, 0.f};
#pragma unroll
        for (int p = 0; p < 8; ++p) { const float* s = src + (size_t)(8 * (8 * half + p)) * N;
            a[p] = ok ? __builtin_nontemporal_load((const f32x4*)s) : z; b[p] = ok ? __builtin_nontemporal_load((const f32x4*)(s + N)) : z; }
#pragma unroll
        for (int p = 0; p < 8; ++p)
#pragma unroll
            for (int q = 0; q < 4; ++q) sw[q * 65 + 4 * (8 * half + p)] = cvtpk(a[p][q], b[p][q]);
    }
    asm volatile("s_waitcnt lgkmcnt(0)" ::: "memory");
#pragma unroll
    for (int j = 0; j < 16; ++j) { const int n = 4 * j + kq; const LAS unsigned* s = scr + n * 65 + 4 * c;
        u32x4 o; o.x = s[0]; o.y = s[1]; o.z = s[2]; o.w = s[3];
        if (n0 + n < N) *(u32x4*)(WT + (size_t)(r0 + n) * K + k0 + 8 * c) = o; }
    asm volatile("s_waitcnt lgkmcnt(0)" ::: "memory");
}

__device__ __forceinline__ void norm_phase(int gw, int ngw, int lane, LAS unsigned char* stg, const bf16* tmp, const float* gpost, const float* hin, float* hout, const float* gpre, bf16* xn, float* U, float tscale = 1.0f) {
    for (int m = gw; m < SEQ; m += ngw) {
        f32x4 h[16];
        const f32x4* hr = (const f32x4*)(hin + (size_t)m * DM) + lane;
        if (tmp) {
            const u32x4* tr = (const u32x4*)(tmp + (size_t)m * DM) + lane; u32x4 tq[8]; float ss = 0.f;
#pragma unroll
            for (int j = 0; j < 8; ++j) tq[j] = __builtin_nontemporal_load(tr + 64 * j);
#pragma unroll
            for (int j = 0; j < 16; ++j) h[j] = __builtin_nontemporal_load(hr + 64 * j);
#pragma unroll
            for (int j = 0; j < 8; ++j) {
#pragma unroll
                for (int q = 0; q < 4; ++q) { const float a = bf_lo(tq[j][q]), b = bf_hi(tq[j][q]); ss += a * a + b * b; }
                *(LAS u32x4*)(stg + 1024 * j + 16 * lane) = tq[j]; }
            asm volatile("" ::: "memory");
            const float r = tscale / sqrtf(wave_sum(ss) * (1.0f / DM) + NORM_EPS);
            f32x4* ho = (f32x4*)(hout + (size_t)m * DM) + lane; const f32x4* gp = (const f32x4*)gpost + lane;
#pragma unroll
            for (int j = 0; j < 16; ++j) { const u32x2 w = *(const LAS u32x2*)(stg + 512 * j + 8 * lane); const f32x4 t = {bf_lo(w.x), bf_hi(w.x), bf_lo(w.y), bf_hi(w.y)};
                h[j] = h[j] + (t * r) * gp[64 * j]; __builtin_nontemporal_store(h[j], ho + 64 * j); }
        } else {
#pragma unroll
            for (int j = 0; j < 16; ++j) h[j] = hr[64 * j];
        }
        if (gpre) {
            float ss = 0.f;
#pragma unroll
            for (int j = 0; j < 16; ++j) ss += (h[j].x * h[j].x + h[j].y * h[j].y) + (h[j].z * h[j].z + h[j].w * h[j].w);
            const float r = 1.0f / sqrtf(wave_sum(ss) * (1.0f / DM) + NORM_EPS);
            const f32x4* gp = (const f32x4*)gpre + lane;
            if (xn) { u32x4* o16 = (u32x4*)(xn + (size_t)m * DM) + lane;
                asm volatile("" ::: "memory");
#pragma unroll
                for (int j = 0; j < 16; ++j) { const f32x4 v = (h[j] * r) * gp[64 * j]; u32x2 w; w.x = cvtpk(v.x, v.y); w.y = cvtpk(v.z, v.w); *(LAS u32x2*)(stg + 512 * j + 8 * lane) = w; }
                asm volatile("" ::: "memory");
#pragma unroll
                for (int j = 0; j < 8; ++j) o16[64 * j] = *(const LAS u32x4*)(stg + 1024 * j + 16 * lane);
                asm volatile("" ::: "memory"); }
            if (U) {
#pragma unroll
                for (int j = 0; j < 16; ++j) { const f32x4 v = (h[j] * r) * gp[64 * j];
                    *(f32x4*)(U + ((size_t)((lane >> 2) + 16 * j) * SEQ + m) * 16 + 4 * (lane & 3)) = v; } }
        }
    }
}

__device__ __forceinline__ void fox_cumsum_phase(char* lds, const float* __restrict__ logf, float* __restrict__ cneg, int wg, int G, int tid) {
    double* wtot = (double*)lds; const int lane = tid & 63, wid = tid >> 6;
    for (int h = wg; h < 32; h += G) {
        float v[32]; double s = 0.0;
#pragma unroll
        for (int j = 0; j < 32; ++j) { v[j] = logf[(size_t)(32 * tid + j) * 32 + h]; s += (double)v[j]; }
        double inc = s;
#pragma unroll
        for (int o = 1; o < 64; o <<= 1) { const double t = __shfl_up(inc, o); if (lane >= o) inc += t; }
        __syncthreads();
        if (lane == 63) wtot[wid] = inc;
        __syncthreads();
        double run = inc - s;
#pragma unroll
        for (int w = 0; w < 8; ++w) if (w < wid) run += wtot[w];
#pragma unroll
        for (int j = 0; j < 32; ++j) { run += (double)v[j]; cneg[(size_t)h * SEQ + 32 * tid + j] = (float)(-run * 11.313708498984761); }
    }
}

__device__ __forceinline__ void fox_norms_phase(const bf16* __restrict__ QK, unsigned* nrm2, int gw, int ngw, int lane) {
    for (int base = gw * 128; base < 64 * SEQ; base += ngw * 128) {
        const u32x4* p = (const u32x4*)(QK + (size_t)base * 128) + lane; float mx = 0.f;
#pragma unroll 8
        for (int i = 0; i < 32; ++i) { const u32x4 w = p[(size_t)i * 64]; float s = 0.f;
#pragma unroll
            for (int q = 0; q < 4; ++q) { const float a = bf_lo(w[q]), b = bf_hi(w[q]); s = fmaf(a, a, s); s = fmaf(b, b, s); }
            s += __shfl_xor(s, 1); s += __shfl_xor(s, 2); s += __shfl_xor(s, 4); s += __shfl_xor(s, 8); mx = fmaxf(mx, s); }
        mx = fmaxf(mx, __shfl_xor(mx, 16)); mx = fmaxf(mx, __shfl_xor(mx, 32));
        if (lane == 0) __hip_atomic_fetch_max(nrm2 + base / SEQ, __float_as_uint(mx), __ATOMIC_RELAXED, __HIP_MEMORY_SCOPE_AGENT);
    }
}

namespace s5 {
typedef float f32x16 __attribute__((ext_vector_type(16)));
constexpr int NG = 256, SEGL = 2048, XP = 272, WAVE_BYTES = 2048 + 32 * XP, E_OFF = 8 * WAVE_BYTES, LDS_BYTES = E_OFF + 8 * 128 * 4;
__device__ __forceinline__ bf16x8 pack8(f32x4 a, f32x4 b) { u32x4 w = {cvtpk(a[0], a[1]), cvtpk(a[2], a[3]), cvtpk(b[0], b[1]), cvtpk(b[2], b[3])}; return *reinterpret_cast<bf16x8*>(&w); }
__device__ __forceinline__ void state_consts(float lam_re_raw, float lam_im_raw, double dt, double& lbr, double& lbi, double& cfr, double& cfi, double& lre_o, double& lim_o) {
    const double lre = (double)fminf(lam_re_raw, -1e-4f), lim = (double)lam_im_raw; double sn, cs; sincos_d(lim * dt, sn, cs); const double er = exp_d(lre * dt);
    lbr = er * cs; lbi = er * sn; const double a = lbr - 1.0, b = lbi, den = 1.0 / (lre * lre + lim * lim); cfr = (a * lre + b * lim) * den; cfi = (b * lre - a * lim) * den; lre_o = lre; lim_o = lim;
}
__device__ __forceinline__ void s5_phase(char* lds, const float* __restrict__ U, const float* __restrict__ lam_re, const float* __restrict__ lam_im, const float* __restrict__ log_dt,
                                         const float* __restrict__ b_re, const float* __restrict__ b_im, const float* __restrict__ c_re, const float* __restrict__ c_im,
                                         const float* __restrict__ dskip, bf16* __restrict__ Gout, int wg, int G) {
    const int tid = mk_tid(), wid = __builtin_amdgcn_readfirstlane(tid >> 6), lane = tid & 63, r32 = lane & 31, hi = lane >> 5, l15 = lane & 15, q4 = lane >> 4;
    float* ublk = (float*)(lds + wid * WAVE_BYTES); char* xblk = lds + wid * WAVE_BYTES + 2048; float* Ebuf = (float*)(lds + E_OFF);
    for (int g = wg; g < NG; g += G) {
        float lr, li, l2r, l2i; bf16x8 Bf[4], Cf[4]; const float dsk = dskip[16 * g + l15];
        {
            const double dt = exp_d((double)log_dt[g]);
            { double lbr, lbi, cfr, cfi, lre, lim; state_consts(lam_re[g * 64 + lane], lam_im[g * 64 + lane], dt, lbr, lbi, cfr, cfi, lre, lim); lr = (float)lbr; li = (float)lbi;
              double sn2, cs2; sincos_d(lim * dt * (double)SEGL, sn2, cs2); const double e2 = exp_d(lre * dt * (double)SEGL); l2r = (float)(e2 * cs2); l2i = (float)(e2 * sn2); }
#pragma unroll
            for (int sb = 0; sb < 2; ++sb) { const int st = 32 * sb + r32; double lbr, lbi, cfr, cfi, lre, lim; state_consts(lam_re[g * 64 + st], lam_im[g * 64 + st], dt, lbr, lbi, cfr, cfi, lre, lim);
                const f32x4* br = (const f32x4*)(b_re + ((size_t)g * 64 + st) * 16 + 8 * hi); const f32x4* bi = (const f32x4*)(b_im + ((size_t)g * 64 + st) * 16 + 8 * hi);
                const f32x4 vr0 = br[0], vr1 = br[1], vi0 = bi[0], vi1 = bi[1]; f32x4 or0, or1, oi0, oi1;
#pragma unroll
                for (int i = 0; i < 4; ++i) { or0[i] = (float)(cfr * (double)vr0[i] - cfi * (double)vi0[i]); or1[i] = (float)(cfr * (double)vr1[i] - cfi * (double)vi1[i]);
                                              oi0[i] = (float)(cfr * (double)vi0[i] + cfi * (double)vr0[i]); oi1[i] = (float)(cfr * (double)vi1[i] + cfi * (double)vr1[i]); }
                Bf[sb] = pack8(or0, or1); Bf[2 + sb] = pack8(oi0, oi1); }
#pragma unroll
            for (int kk = 0; kk < 4; ++kk) { const float* cp = (kk < 2 ? c_re : c_im) + ((size_t)g * 16 + l15) * 64 + 32 * (kk & 1) + 8 * q4; const float sg = kk < 2 ? 1.f : -1.f;
                const f32x4 v0 = *(const f32x4*)cp, v1 = *(const f32x4*)(cp + 4); Cf[kk] = pack8(v0 * sg, v1 * sg); }
        }
        const float* Ug = U + ((size_t)g * SEQ + (size_t)wid * SEGL) * 16;
        float xr = 0.f, xi = 0.f;
#pragma unroll 1
        for (int pass = 0; pass < 2; ++pass) {
            f32x4 ua0, ua1; { const f32x4* up = (const f32x4*)(Ug + (size_t)r32 * 16 + 8 * hi); ua0 = up[0]; ua1 = up[1]; }
#pragma unroll 1
            for (int blk = 0; blk < SEGL / 32; ++blk) {
                f32x4 un0 = ua0, un1 = ua1;
                if (blk + 1 < SEGL / 32) { const f32x4* up = (const f32x4*)(Ug + ((size_t)(blk + 1) * 32 + r32) * 16 + 8 * hi); un0 = up[0]; un1 = up[1]; }
                const bf16x8 af = pack8(ua0, ua1);
                if (pass) { *(f32x4*)(ublk + r32 * 16 + 8 * hi) = ua0; *(f32x4*)(ublk + r32 * 16 + 8 * hi + 4) = ua1; }
                f32x16 a0 = {}, a1 = {}, a2 = {}, a3 = {};
                a0 = __builtin_amdgcn_mfma_f32_32x32x16_bf16(af, Bf[0], a0, 0, 0, 0); a1 = __builtin_amdgcn_mfma_f32_32x32x16_bf16(af, Bf[1], a1, 0, 0, 0);
                a2 = __builtin_amdgcn_mfma_f32_32x32x16_bf16(af, Bf[2], a2, 0, 0, 0); a3 = __builtin_amdgcn_mfma_f32_32x32x16_bf16(af, Bf[3], a3, 0, 0, 0);
#pragma unroll
                for (int r = 0; r < 16; ++r) { auto t0 = __builtin_amdgcn_permlane32_swap(__float_as_uint(a0[r]), __float_as_uint(a1[r]), false, false); a0[r] = __uint_as_float(t0[0]); a1[r] = __uint_as_float(t0[1]);
                                               auto t1 = __builtin_amdgcn_permlane32_swap(__float_as_uint(a2[r]), __float_as_uint(a3[r]), false, false); a2[r] = __uint_as_float(t1[0]); a3[r] = __uint_as_float(t1[1]); }
#pragma unroll
                for (int s = 0; s < 32; ++s) { const int h = (s >> 2) & 1, r = (s & 3) + 4 * (s >> 3); const float bre = h ? a1[r] : a0[r], bim = h ? a3[r] : a2[r];
                    const float nr = fmaf(lr, xr, fmaf(-li, xi, bre)), ni = fmaf(lr, xi, fmaf(li, xr, bim)); xr = nr; xi = ni;
                    if (pass) { const unsigned pk = cvtpk(xr, xi); *(unsigned short*)(xblk + s * XP + lane * 2) = (unsigned short)pk; *(unsigned short*)(xblk + s * XP + 128 + lane * 2) = (unsigned short)(pk >> 16); } }
                if (pass) {
#pragma unroll
                    for (int rb = 0; rb < 2; ++rb) { f32x4 acc = {0.f, 0.f, 0.f, 0.f};
#pragma unroll
                        for (int kk = 0; kk < 4; ++kk) { const bf16x8 xa = *(const bf16x8*)(xblk + (16 * rb + l15) * XP + (32 * kk + 8 * q4) * 2); acc = __builtin_amdgcn_mfma_f32_16x16x32_bf16(xa, Cf[kk], acc, 0, 0, 0); }
#pragma unroll
                        for (int i = 0; i < 4; ++i) { const int sl = 16 * rb + 4 * q4 + i; const float uv = ublk[sl * 16 + l15];
                            const float v = gelu_tanh(acc[i] + dsk * uv); const float vn = __shfl_xor(v, 1);
                            if ((l15 & 1) == 0) *(unsigned*)(Gout + ((size_t)wid * SEGL + blk * 32 + sl) * DM + 16 * g + l15) = cvtpk(v, vn); } }
                }
                ua0 = un0; ua1 = un1;
            }
            if (pass == 0) {
                Ebuf[wid * 128 + lane] = xr; Ebuf[wid * 128 + 64 + lane] = xi;
                __syncthreads();
                float sr = 0.f, si = 0.f;
                for (int v = 0; v < wid; ++v) { const float er = Ebuf[v * 128 + lane], ei = Ebuf[v * 128 + 64 + lane];
                    const float nr = fmaf(l2r, sr, fmaf(-l2i, si, er)), ni = fmaf(l2r, si, fmaf(l2i, sr, ei)); sr = nr; si = ni; }
                xr = sr; xi = si;
            }
        }
        __syncthreads();
    }
}
}
#define XB_TMO      128
#define XB_XCNT(j)  (256  + 64 * (j))
#define XB_XSUB(j)  (1280 + 64 * (j))
#define XB_XGEN(j)  (2304 + 64 * (j))
#define XB_TOP      3328
#define XB_TOPGEN   3392
#define XCD_BAR_WORDS 3456
#define XB_SPIN_CAP (1u << 18)

__device__ __forceinline__ unsigned xb_ld(unsigned* p)              { return __hip_atomic_load(p, __ATOMIC_RELAXED, __HIP_MEMORY_SCOPE_AGENT); }
__device__ __forceinline__ unsigned xb_add(unsigned* p, unsigned v) { return __hip_atomic_fetch_add(p, v, __ATOMIC_RELAXED, __HIP_MEMORY_SCOPE_AGENT); }
__device__ __forceinline__ unsigned xb_xcc_id() { return (unsigned)__builtin_amdgcn_s_getreg((3 << 11) | 20) & 0xFu; }
#define XB_SPIN(cond, bar) do { unsigned _sp = 0; while (cond) { __builtin_amdgcn_s_sleep(1); \
    if ((++_sp & 255u) == 0u) { if (xb_ld(&(bar)[XB_TMO])) break; if (_sp > XB_SPIN_CAP) { atomicAdd(&(bar)[XB_TMO], 1u); break; } } } } while (0)

struct XcdBarrier {
    unsigned* bar; unsigned x;
    volatile LAS unsigned* st;
};

__device__ __forceinline__ XcdBarrier xcd_barrier_post(unsigned* bar, volatile LAS unsigned* st) {
    XcdBarrier b; b.bar = bar; b.x = xb_xcc_id(); b.st = st;
    if (threadIdx.x == 0) (void)xb_add(&bar[XB_XCNT(b.x)], 1u);
    return b;
}
__device__ __forceinline__ void xcd_barrier_complete(unsigned* bar, unsigned x, unsigned& nloc, unsigned& nx) {
    const unsigned G = gridDim.x * gridDim.y * gridDim.z;
    unsigned sum, cnt, mine, sp = 0u;
    for (;;) {
        sum = 0u; cnt = 0u; mine = 0u;
#pragma unroll
        for (unsigned j = 0; j < 16; ++j) { const unsigned c = xb_ld(&bar[XB_XCNT(j)]); sum += c; cnt += (c > 0u) ? 1u : 0u; mine = (j == x) ? c : mine; }
        if (sum == G) break;
        __builtin_amdgcn_s_sleep(1);
        if ((++sp & 255u) == 0u) { if (xb_ld(&bar[XB_TMO])) break; if (sp > XB_SPIN_CAP) { atomicAdd(&bar[XB_TMO], 1u); break; } }
    }
    nloc = mine > 0u ? mine : 1u; nx = cnt > 0u ? cnt : 1u;
}

__device__ __forceinline__ void xcd_barrier(const XcdBarrier& b) {
    asm volatile("s_waitcnt vmcnt(0)" ::: "memory");
    __syncthreads();
    if (threadIdx.x == 0) {
        unsigned* bar = b.bar;
        __builtin_amdgcn_s_waitcnt(0);
        unsigned nloc = b.st[0], nx = b.st[1];
        if (nloc == 0u) { xcd_barrier_complete(bar, b.x, nloc, nx); b.st[0] = nloc; b.st[1] = nx; }
        const unsigned old = xb_add(&bar[XB_XSUB(b.x)], 1u);
        const unsigned gen = old / nloc;
        if (old + 1u == (gen + 1u) * nloc) {
            __builtin_amdgcn_fence(__ATOMIC_RELEASE, "agent");
            asm volatile("s_waitcnt vmcnt(0)" ::: "memory");
            const unsigned og = xb_add(&bar[XB_TOP], 1u);
            const unsigned tg = og / nx;
            if (og + 1u == (tg + 1u) * nx) xb_add(&bar[XB_TOPGEN], 1u);
            else XB_SPIN(xb_ld(&bar[XB_TOPGEN]) == tg, bar);
            __builtin_amdgcn_fence(__ATOMIC_ACQUIRE, "agent");
            xb_add(&bar[XB_XGEN(b.x)], 1u);
            asm volatile("s_waitcnt vmcnt(0)" ::: "memory");
        } else {
            XB_SPIN(xb_ld(&bar[XB_XGEN(b.x)]) == gen, bar);
            __builtin_amdgcn_fence(__ATOMIC_ACQUIRE, "agent");
            asm volatile("s_waitcnt vmcnt(0)" ::: "memory");
        }
    }
    __syncthreads();
}

constexpr size_t MiB = (size_t)1 << 20;
constexpr int NTHR = 512, NWAVES = 8;
constexpr int LDS_BYTES = 147456;
constexpr int LDS_MISC = LDS_BYTES - 1024;
__device__ __forceinline__ const float* uptr(const LAS unsigned long long* tab, int i) {
    const unsigned long long v = tab[i]; const unsigned lo = __builtin_amdgcn_readfirstlane((unsigned)v), hi = __builtin_amdgcn_readfirstlane((unsigned)(v >> 32));
    return (const float*)(const GAS float*)(((unsigned long long)hi << 32) | lo);
}
template <class T> __device__ __forceinline__ LAS T* launder_l(LAS T* p) { asm volatile("" : "+s"(p)); return p; }
template <class T> __device__ __forceinline__ T* launder(T* p) { GAS T* q = (GAS T*)p; asm volatile("" : "+s"(q)); return (T*)q; }
static_assert(pg8::STAGE_BYTES <= LDS_MISC && fox::LDS_BYTES <= LDS_MISC && swa::LDS_BYTES <= LDS_MISC && s5::LDS_BYTES <= LDS_MISC, "LDS map");
constexpr size_t WS_CTL = 0, CTL_ZERO_BYTES = 64 * 1024;
constexpr size_t CTL_QCTR = 16384, CTL_NRM2 = 20480;
constexpr size_t WS_ROPE = 1 * MiB;
constexpr size_t WS_W = 2 * MiB;
constexpr size_t W_L0_QKV = WS_W, W_L0_O = W_L0_QKV + 40 * MiB, W_L1_QKVF = W_L0_O + 32 * MiB, W_L1_O = W_L1_QKVF + 98 * MiB, W_L2_GLU = W_L1_O + 32 * MiB,
                 W_L3_QKV = W_L2_GLU + 64 * MiB, W_L3_O = W_L3_QKV + 40 * MiB, W_FFN = W_L3_O + 32 * MiB, W_FFN_STRIDE = 258 * MiB, W_FFN_OUT = 172 * MiB;
constexpr size_t WS_XN = W_FFN + 4 * W_FFN_STRIDE;
constexpr size_t WS_BIG = WS_XN + 129 * MiB;
constexpr size_t WS_Z = WS_BIG, WS_ACT = WS_BIG + 688 * MiB, WS_TMPF = WS_BIG, WS_TMPM = WS_BIG + 688 * MiB;
constexpr size_t WS_SWA_QKV = WS_BIG, WS_SWA_O = WS_BIG + 160 * MiB;
constexpr size_t WS_FOX_QKV = WS_BIG, WS_FOX_O = WS_BIG + 384 * MiB, WS_FOX_LOGF = WS_BIG + 512 * MiB, WS_FOX_CNEG = WS_BIG + 514 * MiB;
constexpr size_t WS_S5_U = WS_BIG + 256 * MiB, WS_S5_G = WS_BIG + 512 * MiB;
constexpr size_t WS_END = WS_BIG + 1032 * MiB;
static_assert((size_t)SEQ * 2 * DFF * 2 == 688 * MiB && (size_t)SEQ * DFF * 2 == 344 * MiB && (size_t)12544 * 4096 * 2 == 98 * MiB && (size_t)22016 * 4096 * 2 == 172 * MiB, "sizes");

struct Args { const float* in[56]; float* out; unsigned char* ws; float inv_freq[8]; int ph_lo, ph_hi; };

__global__ void __launch_bounds__(NTHR, 2) mk_fwd(Args args) {
    extern __shared__ __attribute__((aligned(16))) unsigned char lds[];
    if (threadIdx.x < 16) ((LAS unsigned*)((LAS unsigned char*)lds + LDS_MISC))[threadIdx.x] = 0u;
    if (threadIdx.x == 64) { LAS unsigned long long* ptab0 = (LAS unsigned long long*)((LAS unsigned char*)lds + LDS_MISC + 64);
#pragma unroll
        for (int i = 0; i < 56; ++i) ptab0[i] = (unsigned long long)args.in[i]; }
#define IN(i) uptr(ptab, (i))
    __syncthreads();
    XcdBarrier bar = xcd_barrier_post((unsigned*)(args.ws + WS_CTL), (volatile LAS unsigned*)((LAS unsigned char*)lds + LDS_MISC));
    int need_bar = 0;
#define PH_BEGIN(id) if (args.ph_lo <= (id) && (id) < args.ph_hi) { \
        if (need_bar) { XcdBarrier b2; b2.bar = launder(bar.bar); b2.x = (unsigned)launder_s((int)bar.x); b2.st = bar.st; for (int rb_ = 0; rb_ < REP_BAR; ++rb_) xcd_barrier(b2); } need_bar = 1; \
        unsigned char* const ws = launder(args.ws); float* const out = launder(args.out); (void)out; \
        LAS unsigned char* const ldsl = launder_l((LAS unsigned char*)lds); char* const ldsg = (char*)ldsl; (void)ldsg; const LAS unsigned long long* const ptab = (const LAS unsigned long long*)(ldsl + LDS_MISC + 64); \
        const int tid = mk_tid(), lane = tid & 63, wave = __builtin_amdgcn_readfirstlane(tid >> 6); (void)lane; (void)wave; \
        const int G = launder_s((int)gridDim.x), bx = launder_s((int)blockIdx.x), vcu = (G % 8 == 0) ? (bx % 8) * (G / 8) + bx / 8 : bx, gw = vcu * NWAVES + wave, ngw = G * NWAVES; (void)gw; (void)ngw; \
        bf16* const XN = (bf16*)(ws + WS_XN + 16384); float* const cosT = (float*)(ws + WS_ROPE); float* const sinT = cosT + SEQ * 8; bf16* const TMPM = (bf16*)(ws + WS_TMPM); bf16* const TMPF = (bf16*)(ws + WS_TMPF); \
        (void)XN; (void)cosT; (void)sinT; (void)TMPM; (void)TMPF;
#define PH_END }

    PH_BEGIN(0)
#if PROBE_COPY > 0
      for (int rep = 0; rep < PROBE_COPY; ++rep) {
        typedef PROBE_T pv_t; constexpr int PU = 128 / sizeof(pv_t);
        const pv_t* src = (const pv_t*)(ws + WS_BIG); pv_t* dst = (pv_t*)(ws + WS_BIG + 516 * MiB);
        const size_t n = 512 * MiB / sizeof(pv_t), stride = (size_t)G * NTHR;
        for (size_t i = (size_t)vcu * NTHR + tid; i < n; i += PU * stride) {
            pv_t v[PU];
#pragma unroll
            for (int u = 0; u < PU; ++u) v[u] = PROBE_LD(src + i + u * stride);
#pragma unroll
            for (int u = 0; u < PU; ++u) PROBE_ST(v[u], dst + i + u * stride);
        }
      }
#endif
      for (int rep = 0; rep < REP_PRO; ++rep) {
        LAS unsigned* scr = (LAS unsigned*)(ldsl + wave * 16640);
        constexpr int I_QKV = 32 * 80, I_O = 32 * 64, I_QKVF = 32 * 193, I_GLU = 32 * 128, I_IN = 32 * 344, I_OUT = 86 * 64;
        constexpr int NITEMS = 2 * (I_QKV + I_O) + I_QKVF + I_O + I_GLU + 4 * (I_IN + I_OUT);
        for (int it = gw; it < NITEMS; it += ngw) {
            int r = it;
#define TR(cnt, src, K_, N_, dstoff, mode) if (r < (cnt)) { transpose_item(IN(src), K_, N_, (bf16*)(ws + (dstoff)), mode, scr, r, lane); continue; } r -= (cnt);
            TR(I_QKV, 2, 4096, 5120, W_L0_QKV, 0)
            TR(I_O, 5, 4096, 4096, W_L0_O, 0)
            TR(I_IN, 9, 4096, 22016, W_FFN, 2)
            TR(I_OUT, 12, 11008, 4096, W_FFN + W_FFN_OUT, 0)
            TR(I_QKVF, 15, 4096, 12320, W_L1_QKVF, 0)
            TR(I_O, 17, 4096, 4096, W_L1_O, 0)
            TR(I_IN, 20, 4096, 22016, W_FFN + W_FFN_STRIDE, 2)
            TR(I_OUT, 23, 11008, 4096, W_FFN + W_FFN_STRIDE + W_FFN_OUT, 0)
            TR(I_GLU, 34, 4096, 8192, W_L2_GLU, 1)
            TR(I_IN, 38, 4096, 22016, W_FFN + 2 * W_FFN_STRIDE, 2)
            TR(I_OUT, 41, 11008, 4096, W_FFN + 2 * W_FFN_STRIDE + W_FFN_OUT, 0)
            TR(I_QKV, 44, 4096, 5120, W_L3_QKV, 0)
            TR(I_O, 47, 4096, 4096, W_L3_O, 0)
            TR(I_IN, 51, 4096, 22016, W_FFN + 3 * W_FFN_STRIDE, 2)
            TR(I_OUT, 54, 11008, 4096, W_FFN + 3 * W_FFN_STRIDE + W_FFN_OUT, 0)
#undef TR
        }
        if (vcu == 0) { u32x4* zh = (u32x4*)(ws + WS_XN); const u32x4 zero = {0u, 0u, 0u, 0u}; for (int i = tid; i < 1024; i += NTHR) zh[i] = zero; }
        {
            u32x4* z = (u32x4*)(ws + W_L1_QKVF + (size_t)12320 * 4096 * 2); const u32x4 zero = {0u, 0u, 0u, 0u};
            for (int i = vcu * NTHR + tid; i < 224 * 4096 * 2 / 16; i += G * NTHR) z[i] = zero;
        }
        for (int i = vcu * NTHR + tid; i < SEQ * 8; i += G * NTHR) {
            const int f = i & 7;
            const float fr = f == 0 ? args.inv_freq[0] : f == 1 ? args.inv_freq[1] : f == 2 ? args.inv_freq[2] : f == 3 ? args.inv_freq[3] : f == 4 ? args.inv_freq[4] : f == 5 ? args.inv_freq[5] : f == 6 ? args.inv_freq[6] : args.inv_freq[7];
            const float ang = (float)(i >> 3) * fr; double s, c; sincos_d((double)ang, s, c); cosT[i] = (float)c; sinT[i] = (float)s;
        }
        norm_phase(gw, ngw, lane, ldsl + wave * 16640, nullptr, nullptr, IN(0), nullptr, IN(1), XN, nullptr);
      }
    PH_END

#define SEL(a, b, c, d) IN(L == 0 ? (a) : L == 1 ? (b) : L == 2 ? (c) : (d))
    { constexpr int L = 0;

        const int type = L == 3 ? 0 : L, pb = 1 + 9 * L;
        const size_t wffn = W_FFN + (size_t)L * W_FFN_STRIDE;

        PH_BEGIN(pb + 0)
            if (type == 0) {
                pg8::Gemm g{XN, (const bf16*)(ws + (L == 0 ? W_L0_QKV : W_L3_QKV)), SEQ, 5120, 4096}; pg8::StaticOrder S; S.init(SEQ, 5120, G, bx);
                pg8::EpiBf16B E{(bf16*)(ws + WS_SWA_QKV), 5120, L == 0 ? IN(3) : IN(45)};
                for (int rep = 0; rep < REP_MIXG; ++rep) pg8::gemm_phase<pg8::EpiBf16B, pg8::StaticOrder, true, true>(ldsl, g, S, E);
            } else if (type == 1) {
                pg8::Gemm g{XN, (const bf16*)(ws + W_L1_QKVF), SEQ, 12544, 4096}; pg8::StaticOrder S; S.init(SEQ, 12544, G, bx);
                pg8::EpiFox E{(bf16*)(ws + WS_FOX_QKV), (float*)(ws + WS_FOX_LOGF), IN(16)};
                for (int rep = 0; rep < REP_MIXG; ++rep) pg8::gemm_phase<pg8::EpiFox, pg8::StaticOrder, true, true>(ldsl, g, S, E);
            } else {
              for (int rep = 0; rep < REP_MIX; ++rep)
                s5::s5_phase(ldsg, (const float*)(ws + WS_S5_U), IN(26), IN(27), IN(28), IN(29), IN(30), IN(31), IN(32), IN(33),
                             (bf16*)(ws + WS_S5_G), vcu, G);
            }
        PH_END
        if (type != 2) {
        PH_BEGIN(pb + 1)
          for (int rep = 0; rep < REP_MIX; ++rep) {
            if (type == 0) swa::swa_attn_phase(ldsg, (const bf16*)(ws + WS_SWA_QKV), L == 0 ? IN(4) : IN(46), cosT, sinT, (bf16*)(ws + WS_SWA_O), vcu, G);
            else { fox_cumsum_phase(ldsg, (const float*)(ws + WS_FOX_LOGF), (float*)(ws + WS_FOX_CNEG), vcu, G, tid);
                   if (G > 64) { if (vcu >= 32) fox_norms_phase((const bf16*)(ws + WS_FOX_QKV), (unsigned*)(ws + WS_CTL + CTL_NRM2), (vcu - 32) * NWAVES + wave, (G - 32) * NWAVES, lane); }
                   else fox_norms_phase((const bf16*)(ws + WS_FOX_QKV), (unsigned*)(ws + WS_CTL + CTL_NRM2), gw, ngw, lane); }
          }
        PH_END
        }
        if (type == 1) {
        PH_BEGIN(pb + 2)
            const bf16* q = (const bf16*)(ws + WS_FOX_QKV);
            fox::fox_attn_phase(ldsg, q, q + (size_t)32 * SEQ * 128, q + (size_t)64 * SEQ * 128, (const float*)(ws + WS_FOX_CNEG), (const unsigned*)(ws + WS_CTL + CTL_NRM2), (unsigned*)(ws + WS_CTL + CTL_QCTR), (bf16*)(ws + WS_FOX_O));
#if REP_FOX > 1
            __syncthreads();
            fox::fox_attn_phase(ldsg, q, q + (size_t)32 * SEQ * 128, q + (size_t)64 * SEQ * 128, (const float*)(ws + WS_FOX_CNEG), (const unsigned*)(ws + WS_CTL + CTL_NRM2), (unsigned*)(ws + WS_CTL + CTL_QCTR) + 64, (bf16*)(ws + WS_FOX_O));
#endif
        PH_END
        }
        PH_BEGIN(pb + 3)
            if (type == 2) {
                pg8::Gemm g{(const bf16*)(ws + WS_S5_G), (const bf16*)(ws + W_L2_GLU), SEQ, 8192, 4096}; pg8::StaticOrder S; S.init(SEQ, 8192, G, bx);
                pg8::EpiGlu E{TMPM, IN(35)};
                for (int rep = 0; rep < REP_MIXG; ++rep) pg8::gemm_phase<pg8::EpiGlu, pg8::StaticOrder, true, true>(ldsl, g, S, E);
            } else {
                pg8::Gemm g{(const bf16*)(ws + (type == 0 ? WS_SWA_O : WS_FOX_O)), (const bf16*)(ws + (L == 0 ? W_L0_O : L == 1 ? W_L1_O : W_L3_O)), SEQ, 4096, 4096};
                pg8::StaticOrder S; S.init(SEQ, 4096, G, bx);
                pg8::EpiBf16B E{TMPM, 4096, L == 0 ? IN(6) : L == 3 ? IN(48) : nullptr};
                for (int rep = 0; rep < REP_MIXG; ++rep) pg8::gemm_phase<pg8::EpiBf16B, pg8::StaticOrder, true, true>(ldsl, g, S, E);
            }
        PH_END
        PH_BEGIN(pb + 4)
          for (int rep = 0; rep < REP_NORM; ++rep)
            norm_phase(gw, ngw, lane, ldsl + wave * 16640, TMPM, SEL(7, 18, 36, 49), (L == 0 && rep == 0) ? IN(0) : out, out, SEL(8, 19, 37, 50), XN, nullptr, rep ? 0.f : 1.f);
        PH_END
        PH_BEGIN(pb + 5)
            pg8::Gemm g{XN - 2 * 4096, (const bf16*)(ws + wffn), 65 * 256, 2 * DFF, 4096, 254}; pg8::StaticOrder S; S.init(65 * 256, 2 * DFF, G, bx);
            pg8::EpiConvGeglu E{(bf16*)(ws + WS_ACT), SEL(10, 21, 39, 52), SEL(11, 22, 40, 53), ldsl + 131072, DFF, SEQ};
          for (int rep = 0; rep < REP_FFN1; ++rep)
            pg8::gemm_phase<pg8::EpiConvGeglu, pg8::StaticOrder, true, true>(ldsl, g, S, E);
        PH_END
        PH_BEGIN(pb + 7)
            pg8::Gemm g{(const bf16*)(ws + WS_ACT), (const bf16*)(ws + wffn + W_FFN_OUT), SEQ, 4096, DFF}; pg8::StaticOrder S; S.init(SEQ, 4096, G, bx);
            pg8::EpiBf16B E{TMPF, 4096, nullptr};
          for (int rep = 0; rep < REP_FFN2; ++rep)
            pg8::gemm_phase<pg8::EpiBf16B, pg8::StaticOrder, true, true>(ldsl, g, S, E);
        PH_END
        PH_BEGIN(pb + 8)
          for (int rep = 0; rep < REP_NORM; ++rep)
            norm_phase(gw, ngw, lane, ldsl + wave * 16640, TMPF, SEL(13, 24, 42, 55), out, out, L == 3 ? nullptr : SEL(14, 25, 43, 43), (L == 1 || L == 3) ? nullptr : XN, L == 1 ? (float*)(ws + WS_S5_U) : nullptr, rep ? 0.f : 1.f);
        PH_END
    }
    { constexpr int L = 1;

        const int type = L == 3 ? 0 : L, pb = 1 + 9 * L;
        const size_t wffn = W_FFN + (size_t)L * W_FFN_STRIDE;

        PH_BEGIN(pb + 0)
            if (type == 0) {
                pg8::Gemm g{XN, (const bf16*)(ws + (L == 0 ? W_L0_QKV : W_L3_QKV)), SEQ, 5120, 4096}; pg8::StaticOrder S; S.init(SEQ, 5120, G, bx);
                pg8::EpiBf16B E{(bf16*)(ws + WS_SWA_QKV), 5120, L == 0 ? IN(3) : IN(45)};
                for (int rep = 0; rep < REP_MIXG; ++rep) pg8::gemm_phase<pg8::EpiBf16B, pg8::StaticOrder, true, true>(ldsl, g, S, E);
            } else if (type == 1) {
                pg8::Gemm g{XN, (const bf16*)(ws + W_L1_QKVF), SEQ, 12544, 4096}; pg8::StaticOrder S; S.init(SEQ, 12544, G, bx);
                pg8::EpiFox E{(bf16*)(ws + WS_FOX_QKV), (float*)(ws + WS_FOX_LOGF), IN(16)};
                for (int rep = 0; rep < REP_MIXG; ++rep) pg8::gemm_phase<pg8::EpiFox, pg8::StaticOrder, true, true>(ldsl, g, S, E);
            } else {
              for (int rep = 0; rep < REP_MIX; ++rep)
                s5::s5_phase(ldsg, (const float*)(ws + WS_S5_U), IN(26), IN(27), IN(28), IN(29), IN(30), IN(31), IN(32), IN(33),
                             (bf16*)(ws + WS_S5_G), vcu, G);
            }
        PH_END
        if (type != 2) {
        PH_BEGIN(pb + 1)
          for (int rep = 0; rep < REP_MIX; ++rep) {
            if (type == 0) swa::swa_attn_phase(ldsg, (const bf16*)(ws + WS_SWA_QKV), L == 0 ? IN(4) : IN(46), cosT, sinT, (bf16*)(ws + WS_SWA_O), vcu, G);
            else { fox_cumsum_phase(ldsg, (const float*)(ws + WS_FOX_LOGF), (float*)(ws + WS_FOX_CNEG), vcu, G, tid);
                   if (G > 64) { if (vcu >= 32) fox_norms_phase((const bf16*)(ws + WS_FOX_QKV), (unsigned*)(ws + WS_CTL + CTL_NRM2), (vcu - 32) * NWAVES + wave, (G - 32) * NWAVES, lane); }
                   else fox_norms_phase((const bf16*)(ws + WS_FOX_QKV), (unsigned*)(ws + WS_CTL + CTL_NRM2), gw, ngw, lane); }
          }
        PH_END
        }
        if (type == 1) {
        PH_BEGIN(pb + 2)
            const bf16* q = (const bf16*)(ws + WS_FOX_QKV);
            fox::fox_attn_phase(ldsg, q, q + (size_t)32 * SEQ * 128, q + (size_t)64 * SEQ * 128, (const float*)(ws + WS_FOX_CNEG), (const unsigned*)(ws + WS_CTL + CTL_NRM2), (unsigned*)(ws + WS_CTL + CTL_QCTR), (bf16*)(ws + WS_FOX_O));
#if REP_FOX > 1
            __syncthreads();
            fox::fox_attn_phase(ldsg, q, q + (size_t)32 * SEQ * 128, q + (size_t)64 * SEQ * 128, (const float*)(ws + WS_FOX_CNEG), (const unsigned*)(ws + WS_CTL + CTL_NRM2), (unsigned*)(ws + WS_CTL + CTL_QCTR) + 64, (bf16*)(ws + WS_FOX_O));
#endif
        PH_END
        }
        PH_BEGIN(pb + 3)
            if (type == 2) {
                pg8::Gemm g{(const bf16*)(ws + WS_S5_G), (const bf16*)(ws + W_L2_GLU), SEQ, 8192, 4096}; pg8::StaticOrder S; S.init(SEQ, 8192, G, bx);
                pg8::EpiGlu E{TMPM, IN(35)};
                for (int rep = 0; rep < REP_MIXG; ++rep) pg8::gemm_phase<pg8::EpiGlu, pg8::StaticOrder, true, true>(ldsl, g, S, E);
            } else {
                pg8::Gemm g{(const bf16*)(ws + (type == 0 ? WS_SWA_O : WS_FOX_O)), (const bf16*)(ws + (L == 0 ? W_L0_O : L == 1 ? W_L1_O : W_L3_O)), SEQ, 4096, 4096};
                pg8::StaticOrder S; S.init(SEQ, 4096, G, bx);
                pg8::EpiBf16B E{TMPM, 4096, L == 0 ? IN(6) : L == 3 ? IN(48) : nullptr};
                for (int rep = 0; rep < REP_MIXG; ++rep) pg8::gemm_phase<pg8::EpiBf16B, pg8::StaticOrder, true, true>(ldsl, g, S, E);
            }
        PH_END
        PH_BEGIN(pb + 4)
          for (int rep = 0; rep < REP_NORM; ++rep)
            norm_phase(gw, ngw, lane, ldsl + wave * 16640, TMPM, SEL(7, 18, 36, 49), (L == 0 && rep == 0) ? IN(0) : out, out, SEL(8, 19, 37, 50), XN, nullptr, rep ? 0.f : 1.f);
        PH_END
        PH_BEGIN(pb + 5)
            pg8::Gemm g{XN - 2 * 4096, (const bf16*)(ws + wffn), 65 * 256, 2 * DFF, 4096, 254}; pg8::StaticOrder S; S.init(65 * 256, 2 * DFF, G, bx);
            pg8::EpiConvGeglu E{(bf16*)(ws + WS_ACT), SEL(10, 21, 39, 52), SEL(11, 22, 40, 53), ldsl + 131072, DFF, SEQ};
          for (int rep = 0; rep < REP_FFN1; ++rep)
            pg8::gemm_phase<pg8::EpiConvGeglu, pg8::StaticOrder, true, true>(ldsl, g, S, E);
        PH_END
        PH_BEGIN(pb + 7)
            pg8::Gemm g{(const bf16*)(ws + WS_ACT), (const bf16*)(ws + wffn + W_FFN_OUT), SEQ, 4096, DFF}; pg8::StaticOrder S; S.init(SEQ, 4096, G, bx);
            pg8::EpiBf16B E{TMPF, 4096, nullptr};
          for (int rep = 0; rep < REP_FFN2; ++rep)
            pg8::gemm_phase<pg8::EpiBf16B, pg8::StaticOrder, true, true>(ldsl, g, S, E);
        PH_END
        PH_BEGIN(pb + 8)
          for (int rep = 0; rep < REP_NORM; ++rep)
            norm_phase(gw, ngw, lane, ldsl + wave * 16640, TMPF, SEL(13, 24, 42, 55), out, out, L == 3 ? nullptr : SEL(14, 25, 43, 43), (L == 1 || L == 3) ? nullptr : XN, L == 1 ? (float*)(ws + WS_S5_U) : nullptr, rep ? 0.f : 1.f);
        PH_END
    }
    { constexpr int L = 2;

        const int type = L == 3 ? 0 : L, pb = 1 + 9 * L;
        const size_t wffn = W_FFN + (size_t)L * W_FFN_STRIDE;

        PH_BEGIN(pb + 0)
            if (type == 0) {
                pg8::Gemm g{XN, (const bf16*)(ws + (L == 0 ? W_L0_QKV : W_L3_QKV)), SEQ, 5120, 4096}; pg8::StaticOrder S; S.init(SEQ, 5120, G, bx);
                pg8::EpiBf16B E{(bf16*)(ws + WS_SWA_QKV), 5120, L == 0 ? IN(3) : IN(45)};
                for (int rep = 0; rep < REP_MIXG; ++rep) pg8::gemm_phase<pg8::EpiBf16B, pg8::StaticOrder, true, true>(ldsl, g, S, E);
            } else if (type == 1) {
                pg8::Gemm g{XN, (const bf16*)(ws + W_L1_QKVF), SEQ, 12544, 4096}; pg8::StaticOrder S; S.init(SEQ, 12544, G, bx);
                pg8::EpiFox E{(bf16*)(ws + WS_FOX_QKV), (float*)(ws + WS_FOX_LOGF), IN(16)};
                for (int rep = 0; rep < REP_MIXG; ++rep) pg8::gemm_phase<pg8::EpiFox, pg8::StaticOrder, true, true>(ldsl, g, S, E);
            } else {
              for (int rep = 0; rep < REP_MIX; ++rep)
                s5::s5_phase(ldsg, (const float*)(ws + WS_S5_U), IN(26), IN(27), IN(28), IN(29), IN(30), IN(31), IN(32), IN(33),
                             (bf16*)(ws + WS_S5_G), vcu, G);
            }
        PH_END
        if (type != 2) {
        PH_BEGIN(pb + 1)
          for (int rep = 0; rep < REP_MIX; ++rep) {
            if (type == 0) swa::swa_attn_phase(ldsg, (const bf16*)(ws + WS_SWA_QKV), L == 0 ? IN(4) : IN(46), cosT, sinT, (bf16*)(ws + WS_SWA_O), vcu, G);
            else { fox_cumsum_phase(ldsg, (const float*)(ws + WS_FOX_LOGF), (float*)(ws + WS_FOX_CNEG), vcu, G, tid);
                   if (G > 64) { if (vcu >= 32) fox_norms_phase((const bf16*)(ws + WS_FOX_QKV), (unsigned*)(ws + WS_CTL + CTL_NRM2), (vcu - 32) * NWAVES + wave, (G - 32) * NWAVES, lane); }
                   else fox_norms_phase((const bf16*)(ws + WS_FOX_QKV), (unsigned*)(ws + WS_CTL + CTL_NRM2), gw, ngw, lane); }
          }
        PH_END
        }
        if (type == 1) {
        PH_BEGIN(pb + 2)
            const bf16* q = (const bf16*)(ws + WS_FOX_QKV);
            fox::fox_attn_phase(ldsg, q, q + (size_t)32 * SEQ * 128, q + (size_t)64 * SEQ * 128, (const float*)(ws + WS_FOX_CNEG), (const unsigned*)(ws + WS_CTL + CTL_NRM2), (unsigned*)(ws + WS_CTL + CTL_QCTR), (bf16*)(ws + WS_FOX_O));
#if REP_FOX > 1
            __syncthreads();
            fox::fox_attn_phase(ldsg, q, q + (size_t)32 * SEQ * 128, q + (size_t)64 * SEQ * 128, (const float*)(ws + WS_FOX_CNEG), (const unsigned*)(ws + WS_CTL + CTL_NRM2), (unsigned*)(ws + WS_CTL + CTL_QCTR) + 64, (bf16*)(ws + WS_FOX_O));
#endif
        PH_END
        }
        PH_BEGIN(pb + 3)
            if (type == 2) {
                pg8::Gemm g{(const bf16*)(ws + WS_S5_G), (const bf16*)(ws + W_L2_GLU), SEQ, 8192, 4096}; pg8::StaticOrder S; S.init(SEQ, 8192, G, bx);
                pg8::EpiGlu E{TMPM, IN(35)};
                for (int rep = 0; rep < REP_MIXG; ++rep) pg8::gemm_phase<pg8::EpiGlu, pg8::StaticOrder, true, true>(ldsl, g, S, E);
            } else {
                pg8::Gemm g{(const bf16*)(ws + (type == 0 ? WS_SWA_O : WS_FOX_O)), (const bf16*)(ws + (L == 0 ? W_L0_O : L == 1 ? W_L1_O : W_L3_O)), SEQ, 4096, 4096};
                pg8::StaticOrder S; S.init(SEQ, 4096, G, bx);
                pg8::EpiBf16B E{TMPM, 4096, L == 0 ? IN(6) : L == 3 ? IN(48) : nullptr};
                for (int rep = 0; rep < REP_MIXG; ++rep) pg8::gemm_phase<pg8::EpiBf16B, pg8::StaticOrder, true, true>(ldsl, g, S, E);
            }
        PH_END
        PH_BEGIN(pb + 4)
          for (int rep = 0; rep < REP_NORM; ++rep)
            norm_phase(gw, ngw, lane, ldsl + wave * 16640, TMPM, SEL(7, 18, 36, 49), (L == 0 && rep == 0) ? IN(0) : out, out, SEL(8, 19, 37, 50), XN, nullptr, rep ? 0.f : 1.f);
        PH_END
        PH_BEGIN(pb + 5)
            pg8::Gemm g{XN - 2 * 4096, (const bf16*)(ws + wffn), 65 * 256, 2 * DFF, 4096, 254}; pg8::StaticOrder S; S.init(65 * 256, 2 * DFF, G, bx);
            pg8::EpiConvGeglu E{(bf16*)(ws + WS_ACT), SEL(10, 21, 39, 52), SEL(11, 22, 40, 53), ldsl + 131072, DFF, SEQ};
          for (int rep = 0; rep < REP_FFN1; ++rep)
            pg8::gemm_phase<pg8::EpiConvGeglu, pg8::StaticOrder, true, true>(ldsl, g, S, E);
        PH_END
        PH_BEGIN(pb + 7)
            pg8::Gemm g{(const bf16*)(ws + WS_ACT), (const bf16*)(ws + wffn + W_FFN_OUT), SEQ, 4096, DFF}; pg8::StaticOrder S; S.init(SEQ, 4096, G, bx);
            pg8::EpiBf16B E{TMPF, 4096, nullptr};
          for (int rep = 0; rep < REP_FFN2; ++rep)
            pg8::gemm_phase<pg8::EpiBf16B, pg8::StaticOrder, true, true>(ldsl, g, S, E);
        PH_END
        PH_BEGIN(pb + 8)
          for (int rep = 0; rep < REP_NORM; ++rep)
            norm_phase(gw, ngw, lane, ldsl + wave * 16640, TMPF, SEL(13, 24, 42, 55), out, out, L == 3 ? nullptr : SEL(14, 25, 43, 43), (L == 1 || L == 3) ? nullptr : XN, L == 1 ? (float*)(ws + WS_S5_U) : nullptr, rep ? 0.f : 1.f);
        PH_END
    }
    { constexpr int L = 3;

        const int type = L == 3 ? 0 : L, pb = 1 + 9 * L;
        const size_t wffn = W_FFN + (size_t)L * W_FFN_STRIDE;

        PH_BEGIN(pb + 0)
            if (type == 0) {
                pg8::Gemm g{XN, (const bf16*)(ws + (L == 0 ? W_L0_QKV : W_L3_QKV)), SEQ, 5120, 4096}; pg8::StaticOrder S; S.init(SEQ, 5120, G, bx);
                pg8::EpiBf16B E{(bf16*)(ws + WS_SWA_QKV), 5120, L == 0 ? IN(3) : IN(45)};
                for (int rep = 0; rep < REP_MIXG; ++rep) pg8::gemm_phase<pg8::EpiBf16B, pg8::StaticOrder, true, true>(ldsl, g, S, E);
            } else if (type == 1) {
                pg8::Gemm g{XN, (const bf16*)(ws + W_L1_QKVF), SEQ, 12544, 4096}; pg8::StaticOrder S; S.init(SEQ, 12544, G, bx);
                pg8::EpiFox E{(bf16*)(ws + WS_FOX_QKV), (float*)(ws + WS_FOX_LOGF), IN(16)};
                for (int rep = 0; rep < REP_MIXG; ++rep) pg8::gemm_phase<pg8::EpiFox, pg8::StaticOrder, true, true>(ldsl, g, S, E);
            } else {
              for (int rep = 0; rep < REP_MIX; ++rep)
                s5::s5_phase(ldsg, (const float*)(ws + WS_S5_U), IN(26), IN(27), IN(28), IN(29), IN(30), IN(31), IN(32), IN(33),
                             (bf16*)(ws + WS_S5_G), vcu, G);
            }
        PH_END
        if (type != 2) {
        PH_BEGIN(pb + 1)
          for (int rep = 0; rep < REP_MIX; ++rep) {
            if (type == 0) swa::swa_attn_phase(ldsg, (const bf16*)(ws + WS_SWA_QKV), L == 0 ? IN(4) : IN(46), cosT, sinT, (bf16*)(ws + WS_SWA_O), vcu, G);
            else { fox_cumsum_phase(ldsg, (const float*)(ws + WS_FOX_LOGF), (float*)(ws + WS_FOX_CNEG), vcu, G, tid);
                   if (G > 64) { if (vcu >= 32) fox_norms_phase((const bf16*)(ws + WS_FOX_QKV), (unsigned*)(ws + WS_CTL + CTL_NRM2), (vcu - 32) * NWAVES + wave, (G - 32) * NWAVES, lane); }
                   else fox_norms_phase((const bf16*)(ws + WS_FOX_QKV), (unsigned*)(ws + WS_CTL + CTL_NRM2), gw, ngw, lane); }
          }
        PH_END
        }
        if (type == 1) {
        PH_BEGIN(pb + 2)
            const bf16* q = (const bf16*)(ws + WS_FOX_QKV);
            fox::fox_attn_phase(ldsg, q, q + (size_t)32 * SEQ * 128, q + (size_t)64 * SEQ * 128, (const float*)(ws + WS_FOX_CNEG), (const unsigned*)(ws + WS_CTL + CTL_NRM2), (unsigned*)(ws + WS_CTL + CTL_QCTR), (bf16*)(ws + WS_FOX_O));
#if REP_FOX > 1
            __syncthreads();
            fox::fox_attn_phase(ldsg, q, q + (size_t)32 * SEQ * 128, q + (size_t)64 * SEQ * 128, (const float*)(ws + WS_FOX_CNEG), (const unsigned*)(ws + WS_CTL + CTL_NRM2), (unsigned*)(ws + WS_CTL + CTL_QCTR) + 64, (bf16*)(ws + WS_FOX_O));
#endif
        PH_END
        }
        PH_BEGIN(pb + 3)
            if (type == 2) {
                pg8::Gemm g{(const bf16*)(ws + WS_S5_G), (const bf16*)(ws + W_L2_GLU), SEQ, 8192, 4096}; pg8::StaticOrder S; S.init(SEQ, 8192, G, bx);
                pg8::EpiGlu E{TMPM, IN(35)};
                for (int rep = 0; rep < REP_MIXG; ++rep) pg8::gemm_phase<pg8::EpiGlu, pg8::StaticOrder, true, true>(ldsl, g, S, E);
            } else {
                pg8::Gemm g{(const bf16*)(ws + (type == 0 ? WS_SWA_O : WS_FOX_O)), (const bf16*)(ws + (L == 0 ? W_L0_O : L == 1 ? W_L1_O : W_L3_O)), SEQ, 4096, 4096};
                pg8::StaticOrder S; S.init(SEQ, 4096, G, bx);
                pg8::EpiBf16B E{TMPM, 4096, L == 0 ? IN(6) : L == 3 ? IN(48) : nullptr};
                for (int rep = 0; rep < REP_MIXG; ++rep) pg8::gemm_phase<pg8::EpiBf16B, pg8::StaticOrder, true, true>(ldsl, g, S, E);
            }
        PH_END
        PH_BEGIN(pb + 4)
          for (int rep = 0; rep < REP_NORM; ++rep)
            norm_phase(gw, ngw, lane, ldsl + wave * 16640, TMPM, SEL(7, 18, 36, 49), (L == 0 && rep == 0) ? IN(0) : out, out, SEL(8, 19, 37, 50), XN, nullptr, rep ? 0.f : 1.f);
        PH_END
        PH_BEGIN(pb + 5)
            pg8::Gemm g{XN - 2 * 4096, (const bf16*)(ws + wffn), 65 * 256, 2 * DFF, 4096, 254}; pg8::StaticOrder S; S.init(65 * 256, 2 * DFF, G, bx);
            pg8::EpiConvGeglu E{(bf16*)(ws + WS_ACT), SEL(10, 21, 39, 52), SEL(11, 22, 40, 53), ldsl + 131072, DFF, SEQ};
          for (int rep = 0; rep < REP_FFN1; ++rep)
            pg8::gemm_phase<pg8::EpiConvGeglu, pg8::StaticOrder, true, true>(ldsl, g, S, E);
        PH_END
        PH_BEGIN(pb + 7)
            pg8::Gemm g{(const bf16*)(ws + WS_ACT), (const bf16*)(ws + wffn + W_FFN_OUT), SEQ, 4096, DFF}; pg8::StaticOrder S; S.init(SEQ, 4096, G, bx);
            pg8::EpiBf16B E{TMPF, 4096, nullptr};
          for (int rep = 0; rep < REP_FFN2; ++rep)
            pg8::gemm_phase<pg8::EpiBf16B, pg8::StaticOrder, true, true>(ldsl, g, S, E);
        PH_END
        PH_BEGIN(pb + 8)
          for (int rep = 0; rep < REP_NORM; ++rep)
            norm_phase(gw, ngw, lane, ldsl + wave * 16640, TMPF, SEL(13, 24, 42, 55), out, out, L == 3 ? nullptr : SEL(14, 25, 43, 43), (L == 1 || L == 3) ? nullptr : XN, L == 1 ? (float*)(ws + WS_S5_U) : nullptr, rep ? 0.f : 1.f);
        PH_END
    }
#undef SEL
#undef PH_BEGIN
#undef PH_END
#undef IN
}

extern "C" void kernel_launch(void* const* d_in, const int* in_sizes, int n_in, void* d_out, int out_size, void* d_ws, size_t ws_size, hipStream_t stream) {
    static int grid = 0;
    if (grid == 0) {
        if (n_in != 56 || in_sizes[0] != SEQ * DM || out_size != SEQ * DM || ws_size < WS_END) {
            fprintf(stderr, "kernel_launch: built for 56 inputs, x/out of %d floats, >= %zu bytes of workspace; got n_in %d, in0 %d, out %d, ws %zu; nothing launched\n", SEQ * DM, (size_t)WS_END, n_in, n_in > 0 ? in_sizes[0] : -1, out_size, ws_size);
            grid = -1; return; }
        int dev = 0, cus = 0, per_cu = 0;
        if (hipGetDevice(&dev) != hipSuccess || hipDeviceGetAttribute(&cus, hipDeviceAttributeMultiprocessorCount, dev) != hipSuccess) { fprintf(stderr, "kernel_launch: device query failed\n"); grid = -1; return; }
        if (hipFuncSetAttribute((const void*)mk_fwd, hipFuncAttributeMaxDynamicSharedMemorySize, LDS_BYTES) != hipSuccess) { fprintf(stderr, "kernel_launch: hipFuncSetAttribute failed\n"); grid = -1; return; }
        if (hipOccupancyMaxActiveBlocksPerMultiprocessor(&per_cu, (const void*)mk_fwd, NTHR, LDS_BYTES) != hipSuccess || per_cu < 1) { fprintf(stderr, "kernel_launch: occupancy query says %d workgroups per CU\n", per_cu); (void)hipGetLastError(); }
        grid = cus;
    }
    if (grid < 0) return;
    if (hipMemsetAsync((char*)d_ws + WS_CTL, 0, CTL_ZERO_BYTES, stream) != hipSuccess) { fprintf(stderr, "kernel_launch: memset failed\n"); return; }
    Args a{};
    for (int i = 0; i < 56; ++i) a.in[i] = (const float*)d_in[i];
    a.out = (float*)d_out; a.ws = (unsigned char*)d_ws;
    { const float lt = (float)(-std::log(500000.0)); for (int i = 0; i < 8; ++i) { float v = lt * (float)i; v = v * 0.125f; a.inv_freq[i] = (float)std::exp((double)v); } }
#if MK_SPLIT_LAUNCHES
    for (int ph = 0; ph < 37; ++ph) {
        const int L = (ph - 1) / 9, slot = (ph - 1) % 9, type = L == 3 ? 0 : L;
        if (ph > 0 && ((slot == 1 && type == 2) || (slot == 2 && type != 1) || slot == 6)) continue;
        a.ph_lo = ph; a.ph_hi = ph + 1;
        hipLaunchKernelGGL(mk_fwd, dim3(grid), dim3(NTHR), LDS_BYTES, stream, a);
    }
#else
    a.ph_lo = 0; a.ph_hi = 37;
    hipLaunchKernelGGL(mk_fwd, dim3(grid), dim3(NTHR), LDS_BYTES, stream, a);
#endif
    const hipError_t le = hipPeekAtLastError();
    if (le != hipSuccess) fprintf(stderr, "kernel_launch: launch failed: %s (grid %d x %d threads, %d B LDS)\n", hipGetErrorName(le), grid, NTHR, LDS_BYTES);
}
```

```cpp
#include <hip/hip_runtime.h>
#include <cstdio>
#include <cstdint>
#include <cmath>

#ifndef MK_SPLIT_LAUNCHES
#define MK_SPLIT_LAUNCHES 0
#endif

__device__ __forceinline__ int mk_tid() { int t = threadIdx.x; asm volatile("" : "+v"(t)); return t; }
__device__ __forceinline__ int launder_s(int v) { asm volatile("" : "+s"(v)); return v; }

#ifndef PROBE_COPY
#define PROBE_COPY 0
#endif
#ifndef PROBE_T
#define PROBE_T u32x2
#endif
#define PROBE_LD(p) (*(p))
#define PROBE_ST(v, p) (*(p) = (v))
#ifndef REP_PRO
#define REP_PRO 1
#endif
#ifndef REP_FFN1
#define REP_FFN1 1
#endif
#ifndef REP_FFN2
#define REP_FFN2 1
#endif
#ifndef REP_NORM
#define REP_NORM 1
#endif
#ifndef REP_BAR
#define REP_BAR 1
#endif
#ifndef REP_FOX
#define REP_FOX 1
#endif
#ifndef REP_MIXG
#define REP_MIXG 1
#endif
#ifndef REP_MIX
#define REP_MIX 1
#endif

namespace pg8 {
#define PG8_LAS __attribute__((address_space(3)))
typedef unsigned short bf16_t;
typedef short bf16x8 __attribute__((ext_vector_type(8)));
typedef float f32x4 __attribute__((ext_vector_type(4)));
typedef unsigned u32x4 __attribute__((ext_vector_type(4)));
typedef unsigned u32x2 __attribute__((ext_vector_type(2)));
typedef float f32x2 __attribute__((ext_vector_type(2)));
constexpr int BM = 256, BK = 64, HALF = 128, HTB = HALF * BK * 2  , STAGE_BYTES = 8 * HTB, NXCD = 8, WGM = 8;

__host__ __device__ __forceinline__ int lds_byte(int r, int c) { const int st = (r >> 4) * 2 + (c >> 5), rr = r & 15, cc = c & 31, ob = rr * 64 + cc * 2; return st * 1024 + (ob ^ (((ob >> 9) & 1) << 5)); }
__host__ __device__ __forceinline__ void stage_rc(int b, int& R, int& C) { const int st = b / 1024, sb = b % 1024, swz = sb ^ (((sb >> 9) & 1) << 5); R = (st >> 1) * 16 + swz / 64; C = (st & 1) * 32 + (swz % 64) / 2; }
__host__ __device__ __forceinline__ int perm32(int rho) { const int n = rho >> 4, i = rho & 15; return 8 * (i >> 2) + 4 * n + (i & 3); }

struct Unit { int pm, pn; };
struct Gemm { const bf16_t* A; const bf16_t* Bt; int M, N, K; int apr = 256; };

struct StaticOrder {
    int nM, nN, nwg, G, c;
    __host__ __device__ void init(int M, int N, int G_, int c_) { nM = M / BM; nN = N / BM; nwg = nM * nN; G = G_; c = c_; }
    __host__ __device__ bool next(int i, Unit& u) const {
        const long L = (long)i * G + c; if (L >= nwg) return false;
        int wgid = (int)L; { const int q = nwg / NXCD, r = nwg % NXCD, xcd = wgid % NXCD, off = wgid / NXCD; wgid = (xcd < r ? xcd * (q + 1) : r * (q + 1) + (xcd - r) * q) + off; }
        const int nig = WGM * nN, gid = wgid / nig, fm = gid * WGM, gsz = (nM - fm) < WGM ? (nM - fm) : WGM;
        u.pm = fm + ((wgid % nig) % gsz); u.pn = (wgid % nig) / gsz; return true;
    }
    __device__ __forceinline__ void a_ready(const Unit&) const {}
    __device__ __forceinline__ void done(const Unit&) const {}
};

__device__ __forceinline__ unsigned cvt_pk_bf16(float lo, float hi) { unsigned r; asm volatile("v_cvt_pk_bf16_f32 %0, %1, %2" : "=v"(r) : "v"(lo), "v"(hi)); return r; }

struct EpiF32B {
    static constexpr bool PERM = false, AFTER_DRAIN = false, APERM = false;
    float* C; int ldc; const float* bias;
    __device__ __forceinline__ void operator()(const f32x4 (&acc)[2][2][4][2], const Unit& u, int wr, int wc, int fr, int fq) const {
        const int row0 = u.pm * BM + wr * 64 + fr, col0 = u.pn * BM + wc * 32 + 4 * fq;
        f32x4 bv[2][2];
#pragma unroll
        for (int bj = 0; bj < 2; ++bj)
#pragma unroll
            for (int n = 0; n < 2; ++n) bv[bj][n] = bias ? *(const f32x4*)(bias + col0 + bj * HALF + n * 16) : (f32x4){0.f, 0.f, 0.f, 0.f};
#pragma unroll
        for (int ai = 0; ai < 2; ++ai)
#pragma unroll
            for (int m = 0; m < 4; ++m) { float* rowp = C + (size_t)(row0 + ai * HALF + m * 16) * ldc + col0;
#pragma unroll
                for (int bj = 0; bj < 2; ++bj)
#pragma unroll
                    for (int n = 0; n < 2; ++n) *(f32x4*)(rowp + bj * HALF + n * 16) = acc[ai][bj][m][n] + bv[bj][n]; }
    }
};
struct EpiBf16B {
    static constexpr bool PERM = true, AFTER_DRAIN = false, APERM = false;
    bf16_t* O; int ldc; const float* bias;
    __device__ __forceinline__ void operator()(const f32x4 (&acc)[2][2][4][2], const Unit& u, int wr, int wc, int fr, int fq) const {
        const int row0 = u.pm * BM + wr * 64 + fr; const int col0 = u.pn * BM + wc * 32 + 8 * fq;
        f32x4 bv[2][2];
#pragma unroll
        for (int bj = 0; bj < 2; ++bj)
#pragma unroll
            for (int n = 0; n < 2; ++n) bv[bj][n] = bias ? *(const f32x4*)(bias + col0 + bj * HALF + 4 * n) : (f32x4){0.f, 0.f, 0.f, 0.f};
#pragma unroll
        for (int ai = 0; ai < 2; ++ai)
#pragma unroll
            for (int m = 0; m < 4; ++m) { bf16_t* rowp = O + (size_t)(row0 + ai * HALF + m * 16) * ldc + col0;
#pragma unroll
                for (int bj = 0; bj < 2; ++bj) { const f32x4 v0 = acc[ai][bj][m][0] + bv[bj][0], v1 = acc[ai][bj][m][1] + bv[bj][1];
                    u32x4 w; w.x = cvt_pk_bf16(v0[0], v0[1]); w.y = cvt_pk_bf16(v0[2], v0[3]); w.z = cvt_pk_bf16(v1[0], v1[1]); w.w = cvt_pk_bf16(v1[2], v1[3]);
                    *(u32x4*)(rowp + bj * HALF) = w; } }
    }
};
struct EpiFox {
    static constexpr bool PERM = true, AFTER_DRAIN = false, APERM = false;
    bf16_t* QKV; float* logf; const float* bfg;
    __device__ __forceinline__ void operator()(const f32x4 (&acc)[2][2][4][2], const Unit& u, int wr, int wc, int fr, int fq) const {
        const int row0 = u.pm * BM + wr * 64 + fr;
        if (u.pn < 48) {
            const int t3 = u.pn >> 4, hp = u.pn & 15;
#pragma unroll
            for (int bj = 0; bj < 2; ++bj) { bf16_t* base = QKV + ((size_t)(t3 * 32 + 2 * hp + bj) * 16384) * 128 + wc * 32 + 8 * fq;
#pragma unroll
                for (int ai = 0; ai < 2; ++ai)
#pragma unroll
                    for (int m = 0; m < 4; ++m) { const f32x4 v0 = acc[ai][bj][m][0], v1 = acc[ai][bj][m][1];
                        u32x4 w; w.x = cvt_pk_bf16(v0[0], v0[1]); w.y = cvt_pk_bf16(v0[2], v0[3]); w.z = cvt_pk_bf16(v1[0], v1[1]); w.w = cvt_pk_bf16(v1[2], v1[3]);
                        *(u32x4*)(base + (size_t)(row0 + ai * HALF + m * 16) * 128) = w; } }
        } else if (wc == 0) {
            const f32x4 b0 = *(const f32x4*)(bfg + 8 * fq), b1 = *(const f32x4*)(bfg + 8 * fq + 4);
#pragma unroll
            for (int ai = 0; ai < 2; ++ai)
#pragma unroll
                for (int m = 0; m < 4; ++m) { float* rowp = logf + (size_t)(row0 + ai * HALF + m * 16) * 32 + 8 * fq;
#pragma unroll
                    for (int n = 0; n < 2; ++n) { const f32x4 z = acc[ai][0][m][n] + (n ? b1 : b0); f32x4 o;
#pragma unroll
                        for (int i = 0; i < 4; ++i) o[i] = fminf(z[i], 0.f) - log1pf(expf(-fabsf(z[i])));
                        *(f32x4*)(rowp + 4 * n) = o; } }
        }
    }
};
struct EpiGlu {
    static constexpr bool PERM = true, AFTER_DRAIN = false, APERM = false;
    bf16_t* C; const float* bias;
    __device__ __forceinline__ void operator()(const f32x4 (&acc)[2][2][4][2], const Unit& u, int wr, int wc, int fr, int fq) const {
        const int row0 = u.pm * BM + wr * 64 + fr, col0 = u.pn * HALF + wc * 32 + 8 * fq;
        f32x4 bv[2], bg[2];
#pragma unroll
        for (int n = 0; n < 2; ++n) { bv[n] = *(const f32x4*)(bias + col0 + 4 * n); bg[n] = *(const f32x4*)(bias + 4096 + col0 + 4 * n); }
#pragma unroll
        for (int ai = 0; ai < 2; ++ai)
#pragma unroll
            for (int m = 0; m < 4; ++m) { bf16_t* rowp = C + (size_t)(row0 + ai * HALF + m * 16) * 4096 + col0; u32x4 w;
#pragma unroll
                for (int n = 0; n < 2; ++n) { const f32x4 zv = acc[ai][0][m][n] + bv[n], zg = acc[ai][1][m][n] + bg[n]; f32x4 o;
#pragma unroll
                    for (int i = 0; i < 4; ++i) o[i] = zv[i] * __builtin_amdgcn_rcpf(1.0f + __builtin_amdgcn_exp2f(-1.4426950408889634f * zg[i]));
                    if (n == 0) { w.x = cvt_pk_bf16(o[0], o[1]); w.y = cvt_pk_bf16(o[2], o[3]); } else { w.z = cvt_pk_bf16(o[0], o[1]); w.w = cvt_pk_bf16(o[2], o[3]); } }
                *(u32x4*)rowp = w; }
    }
};

struct EpiConvGeglu {
    static constexpr bool PERM = true, AFTER_DRAIN = false, APERM = true;
    bf16_t* ACT; const float* cw; const float* cb; PG8_LAS unsigned char* xl; int dff, nrows;
    static __device__ __forceinline__ float shr1(float old, float src) {
        return __builtin_bit_cast(float, __builtin_amdgcn_update_dpp(__builtin_bit_cast(int, old), __builtin_bit_cast(int, src), 0x111, 0xf, 0xf, false)); }
    static __device__ __forceinline__ float gelu_t(float x) { const float t = 0.7978845608028654f * (x + 0.044715f * x * x * x); return x * __builtin_amdgcn_rcpf(1.0f + __builtin_amdgcn_exp2f(-2.8853900817779268f * t)); }
    __device__ __forceinline__ void operator()(const f32x4 (&acc)[2][2][4][2], const Unit& u, int wr, int wc, int fr, int fq) const {
#define XOFF(ai_, w_, rr_, bj_, n_) ((((((ai_) * 2 + (w_)) * 2 + (rr_)) * 2 + (bj_)) * 4 + wc) * 128 + fq * 32 + (n_) * 16)
        f32x4 wv[8];
        { const int gc = u.pn * HALF + wc * 32 + 8 * fq;
            wv[0] = *(const f32x4*)(cw + gc); wv[1] = *(const f32x4*)(cw + 2 * dff + gc); wv[2] = *(const f32x4*)(cw + 4 * dff + gc); wv[3] = *(const f32x4*)(cb + gc);
            wv[4] = *(const f32x4*)(cw + dff + gc); wv[5] = *(const f32x4*)(cw + 3 * dff + gc); wv[6] = *(const f32x4*)(cw + 5 * dff + gc); wv[7] = *(const f32x4*)(cb + dff + gc); }
        if (fr == 15) {
#pragma unroll
            for (int ai = 0; ai < 2; ++ai)
#pragma unroll
                for (int bj = 0; bj < 2; ++bj)
#pragma unroll
                    for (int n = 0; n < 2; ++n) { *(PG8_LAS f32x4*)(xl + XOFF(ai, wr, 0, bj, n)) = acc[ai][bj][2][n]; *(PG8_LAS f32x4*)(xl + XOFF(ai, wr, 1, bj, n)) = acc[ai][bj][3][n]; }
        }
        asm volatile("s_waitcnt lgkmcnt(0)" ::: "memory"); __builtin_amdgcn_s_barrier(); asm volatile("" ::: "memory");
        u32x2 keep[2][4];
#pragma unroll
        for (int n = 0; n < 2; ++n) {
            const int gcol = u.pn * HALF + wc * 32 + 8 * fq + 4 * n;
            if (n) { wv[0] = *(const f32x4*)(cw + gcol); wv[1] = *(const f32x4*)(cw + 2 * dff + gcol); wv[2] = *(const f32x4*)(cw + 4 * dff + gcol); wv[3] = *(const f32x4*)(cb + gcol);
                     wv[4] = *(const f32x4*)(cw + dff + gcol); wv[5] = *(const f32x4*)(cw + 3 * dff + gcol); wv[6] = *(const f32x4*)(cw + 5 * dff + gcol); wv[7] = *(const f32x4*)(cb + dff + gcol); }
            const f32x4 wg0 = wv[0], wg1 = wv[1], wg2 = wv[2], bg = wv[3], wu0 = wv[4], wu1 = wv[5], wu2 = wv[6], bu = wv[7];
#pragma unroll
            for (int ai = 0; ai < 2; ++ai) {
                f32x4 Xg2 = {0.f, 0.f, 0.f, 0.f}, Xg3 = Xg2, Xu2 = Xg2, Xu3 = Xg2;
                if (ai + wr > 0) { const int pa = wr ? ai : ai - 1, pw = wr ? 0 : 1;
                    Xg2 = *(const PG8_LAS f32x4*)(xl + XOFF(pa, pw, 0, 0, n)); Xg3 = *(const PG8_LAS f32x4*)(xl + XOFF(pa, pw, 1, 0, n));
                    Xu2 = *(const PG8_LAS f32x4*)(xl + XOFF(pa, pw, 0, 1, n)); Xu3 = *(const PG8_LAS f32x4*)(xl + XOFF(pa, pw, 1, 1, n)); }
                float o[4][4];
#pragma unroll
                for (int ip = 0; ip < 2; ++ip) {
                    const int i0 = 2 * ip, i1 = 2 * ip + 1;
#define P2(v) ((f32x2){(v)[i0], (v)[i1]})
                    const f32x2 g0 = P2(acc[ai][0][0][n]), g1 = P2(acc[ai][0][1][n]), g2 = P2(acc[ai][0][2][n]), g3 = P2(acc[ai][0][3][n]);
                    const f32x2 u0 = P2(acc[ai][1][0][n]), u1 = P2(acc[ai][1][1][n]), u2 = P2(acc[ai][1][2][n]), u3 = P2(acc[ai][1][3][n]);
                    const f32x2 gm1 = {shr1(Xg3[i0], g3.x), shr1(Xg3[i1], g3.y)}, gm2 = {shr1(Xg2[i0], g2.x), shr1(Xg2[i1], g2.y)};
                    const f32x2 um1 = {shr1(Xu3[i0], u3.x), shr1(Xu3[i1], u3.y)}, um2 = {shr1(Xu2[i0], u2.x), shr1(Xu2[i1], u2.y)};
                    const f32x2 a2 = P2(wg2), a1 = P2(wg1), a0 = P2(wg0), ab = P2(bg), c2 = P2(wu2), c1 = P2(wu1), c0 = P2(wu0), cb = P2(bu);
#define FMA2(a, b, c) __builtin_elementwise_fma((a), (b), (c))
                    const f32x2 zg[4] = {FMA2(a0, gm2, FMA2(a1, gm1, FMA2(a2, g0, ab))), FMA2(a0, gm1, FMA2(a1, g0, FMA2(a2, g1, ab))), FMA2(a0, g0, FMA2(a1, g1, FMA2(a2, g2, ab))), FMA2(a0, g1, FMA2(a1, g2, FMA2(a2, g3, ab)))};
                    const f32x2 zu[4] = {FMA2(c0, um2, FMA2(c1, um1, FMA2(c2, u0, cb))), FMA2(c0, um1, FMA2(c1, u0, FMA2(c2, u1, cb))), FMA2(c0, u0, FMA2(c1, u1, FMA2(c2, u2, cb))), FMA2(c0, u1, FMA2(c1, u2, FMA2(c2, u3, cb)))};
#pragma unroll
                    for (int m = 0; m < 4; ++m) {
                        const f32x2 x = zg[m], x2 = x * x; const f32x2 kk = {-2.302208198f, -2.302208198f}, k3 = {-2.302208198f * 0.044715f, -2.302208198f * 0.044715f}, one = {1.f, 1.f};
                        const f32x2 a = x * FMA2(x2, k3, kk); const f32x2 e = {__builtin_amdgcn_exp2f(a.x), __builtin_amdgcn_exp2f(a.y)}; const f32x2 d = e + one;
                        const f32x2 r = {__builtin_amdgcn_rcpf(d.x), __builtin_amdgcn_rcpf(d.y)}; const f32x2 ov = (x * zu[m]) * r;
                        o[m][i0] = ov.x; o[m][i1] = ov.y; }
#undef FMA2
#undef P2
                }
#pragma unroll
                for (int m = 0; m < 4; ++m) { const int it = ai * HALF + wr * 64 + 4 * fr + m, grow = u.pm * 254 - 2 + it;
                    u32x2 w; w.x = cvt_pk_bf16(o[m][0], o[m][1]); w.y = cvt_pk_bf16(o[m][2], o[m][3]);
                    if (n == 0) keep[ai][m] = w;
                    else if (it >= 2 && grow < nrows) { u32x4 ww; ww.x = keep[ai][m].x; ww.y = keep[ai][m].y; ww.z = w.x; ww.w = w.y; *(u32x4*)(ACT + (size_t)grow * dff + gcol - 4) = ww; } }
            }
        }
#undef XOFF
    }
};

template <class Epi, class Sched, bool ALIGN_EPI = false, bool SP2 = false>
__device__ __forceinline__ void gemm_phase(PG8_LAS unsigned char* lds, const Gemm g, const Sched& S, const Epi& E) {
    const int tid = mk_tid(), wid = __builtin_amdgcn_readfirstlane(tid >> 6), lane = tid & 63, wr = wid >> 2, wc = wid & 3, fr = lane & 15, fq = lane >> 4;
    const int K = g.K, nt = K / BK;
    unsigned voffA[2], voffB[2];
#pragma unroll
    for (int i = 0; i < 2; ++i) { int R, C; stage_rc(tid * 16 + i * 8192, R, C); const int Rb = Epi::PERM ? ((R & ~31) + perm32(R & 31)) : R;
        const int Ra = Epi::APERM ? ((R & ~63) + 4 * (R & 15) + ((R >> 4) & 3)) : R;
        voffA[i] = (unsigned)(Ra * K + C) * 2u; voffB[i] = (unsigned)(Rb * K + C) * 2u; }
    const size_t kstep = (size_t)(BK * 2);
    const size_t hstep = (size_t)HALF * K * 2;
    const size_t tstep = 2 * hstep;
    const size_t tstepA = (size_t)g.apr * K * 2;
    const unsigned ldsw = (unsigned)wid * 1024u;
    const int aoff = lds_byte(wr * 64 + fr, fq * 8), boff = lds_byte(wc * 32 + fr, fq * 8);
#define PG8_SA(b, h) (((b) * 2 + (h)) * HTB)
#define PG8_SB(b, h) ((4 + (b) * 2 + (h)) * HTB)
#define PG8_STAGE(bufoff, gbase, voff) do { _Pragma("unroll") for (int _i = 0; _i < 2; ++_i) \
        __builtin_amdgcn_global_load_lds((const unsigned*)((const char*)(gbase) + (voff)[_i]), (PG8_LAS unsigned*)(lds + (bufoff) + ldsw + _i * 8192), 16, 0, 0); } while (0)
#define PG8_LDA(dst, b, h) do { _Pragma("unroll") for (int m = 0; m < 4; ++m) _Pragma("unroll") for (int k = 0; k < 2; ++k) dst[m][k] = *(const PG8_LAS bf16x8*)(lds + PG8_SA(b, h) + aoff + m * 2048 + k * 1024); } while (0)
#define PG8_LDB(dst, b, h) do { _Pragma("unroll") for (int n = 0; n < 2; ++n) _Pragma("unroll") for (int k = 0; k < 2; ++k) dst[n][k] = *(const PG8_LAS bf16x8*)(lds + PG8_SB(b, h) + boff + n * 2048 + k * 1024); } while (0)
#define PG8_MMA(ai, bj, At, Bt) do { __builtin_amdgcn_s_setprio(1); _Pragma("unroll") for (int m = 0; m < 4; ++m) _Pragma("unroll") for (int n = 0; n < 2; ++n) _Pragma("unroll") for (int k = 0; k < 2; ++k) \
        acc[ai][bj][m][n] = __builtin_amdgcn_mfma_f32_16x16x32_bf16(Bt[n][k], At[m][k], acc[ai][bj][m][n], 0, 0, 0); __builtin_amdgcn_s_setprio(0); } while (0)
#define PG8_WAIT_V(n) asm volatile("s_waitcnt vmcnt(" #n ")" ::: "memory")
#define PG8_WAIT_L(n) asm volatile("s_waitcnt lgkmcnt(" #n ")" ::: "memory")
#define PG8_BAR __builtin_amdgcn_s_barrier()
#define PG8_SCHED __builtin_amdgcn_sched_barrier(0)
    Unit cur, nxt; int ui = 0;
    if (!S.next(0, cur)) return;
    f32x4 acc[2][2][4][2];
#pragma unroll
    for (int a = 0; a < 2; ++a)
#pragma unroll
        for (int b = 0; b < 2; ++b)
#pragma unroll
            for (int m = 0; m < 4; ++m)
#pragma unroll
                for (int n = 0; n < 2; ++n) acc[a][b][m][n] = (f32x4){0.f, 0.f, 0.f, 0.f};
    bf16x8 At[4][2], B0[2][2], B1[2][2];
    const char* cA = (const char*)g.A + (size_t)cur.pm * tstepA; const char* cB = (const char*)g.Bt + (size_t)cur.pn * tstep;
    S.a_ready(cur);
    if constexpr (SP2) {
        PG8_STAGE(PG8_SB(0, 0), cB, voffB); PG8_STAGE(PG8_SB(0, 1), cB + hstep, voffB); PG8_STAGE(PG8_SA(0, 0), cA, voffA); PG8_STAGE(PG8_SA(0, 1), cA + hstep, voffA);
        if (wr == 1) PG8_BAR;
        PG8_WAIT_V(2); PG8_BAR;
        PG8_STAGE(PG8_SB(1, 0), cB + kstep, voffB); PG8_STAGE(PG8_SA(1, 0), cA + kstep, voffA); PG8_STAGE(PG8_SB(1, 1), cB + hstep + kstep, voffB);
        PG8_WAIT_V(6); PG8_BAR;
    } else {
        PG8_STAGE(PG8_SB(0, 0), cB, voffB); PG8_STAGE(PG8_SA(0, 0), cA, voffA); PG8_STAGE(PG8_SB(0, 1), cB + hstep, voffB); PG8_STAGE(PG8_SA(0, 1), cA + hstep, voffA);
        if (wr == 1) PG8_BAR;
        PG8_WAIT_V(4); PG8_BAR;
        PG8_STAGE(PG8_SB(1, 0), cB + kstep, voffB); PG8_STAGE(PG8_SA(1, 0), cA + kstep, voffA); PG8_STAGE(PG8_SB(1, 1), cB + hstep + kstep, voffB);
        PG8_WAIT_V(6); PG8_BAR;
    }
    for (;;) {
        const bool has_next = S.next(ui + 1, nxt);
        const char* nA = has_next ? (const char*)g.A + (size_t)nxt.pm * tstepA : cA; const char* nB = has_next ? (const char*)g.Bt + (size_t)nxt.pn * tstep : cB;
        for (int t = 0; t < nt; t += 2) {
            const bool last = (t == nt - 2);
            const char* a1 = cA + (size_t)(t + 1) * kstep;
            const char* a2 = last ? nA : cA + (size_t)(t + 2) * kstep; const char* b2 = last ? nB : cB + (size_t)(t + 2) * kstep;
            const char* a3 = a2 + kstep; const char* b3 = b2 + kstep;
            if (last && has_next) S.a_ready(nxt);
            if constexpr (SP2) {
            PG8_LDB(B0, 0, 0); PG8_LDB(B1, 0, 1); PG8_SCHED; PG8_LDA(At, 0, 0); PG8_STAGE(PG8_SA(1, 1), a1 + hstep, voffA);
            PG8_WAIT_V(8); PG8_WAIT_L(0); PG8_BAR; PG8_MMA(0, 0, At, B0); PG8_MMA(0, 1, At, B1); PG8_BAR; PG8_SCHED;
            PG8_LDA(At, 0, 1); PG8_STAGE(PG8_SB(0, 0), b2, voffB); PG8_STAGE(PG8_SB(0, 1), b2 + hstep, voffB); PG8_STAGE(PG8_SA(0, 0), a2, voffA);
            PG8_WAIT_V(8); PG8_WAIT_L(0); PG8_BAR; PG8_MMA(1, 0, At, B0); PG8_MMA(1, 1, At, B1); PG8_BAR; PG8_SCHED;
            PG8_LDB(B0, 1, 0); PG8_LDB(B1, 1, 1); PG8_SCHED; PG8_LDA(At, 1, 0); PG8_STAGE(PG8_SA(0, 1), a2 + hstep, voffA);
            PG8_WAIT_V(8); PG8_WAIT_L(0); PG8_BAR; PG8_MMA(0, 0, At, B0); PG8_MMA(0, 1, At, B1); PG8_BAR; PG8_SCHED;
            PG8_LDA(At, 1, 1); PG8_STAGE(PG8_SB(1, 0), b3, voffB); PG8_STAGE(PG8_SB(1, 1), b3 + hstep, voffB); PG8_STAGE(PG8_SA(1, 0), a3, voffA);
            PG8_WAIT_V(8); PG8_WAIT_L(0); PG8_BAR; PG8_MMA(1, 0, At, B0); PG8_MMA(1, 1, At, B1); PG8_BAR; PG8_SCHED;
            } else {
            PG8_LDB(B0, 0, 0); PG8_SCHED; PG8_LDA(At, 0, 0); PG8_STAGE(PG8_SA(1, 1), a1 + hstep, voffA);
            PG8_WAIT_L(8); PG8_BAR; PG8_WAIT_L(0); PG8_MMA(0, 0, At, B0); PG8_BAR; PG8_SCHED;
            PG8_LDB(B1, 0, 1); PG8_STAGE(PG8_SB(0, 0), b2, voffB);
            PG8_BAR; PG8_WAIT_L(0); PG8_MMA(0, 1, At, B1); PG8_BAR;
            PG8_LDA(At, 0, 1); PG8_STAGE(PG8_SA(0, 0), a2, voffA);
            PG8_BAR; PG8_WAIT_L(0); PG8_MMA(1, 0, At, B0); PG8_BAR; PG8_SCHED;
            PG8_STAGE(PG8_SB(0, 1), b2 + hstep, voffB);
            PG8_WAIT_V(6); PG8_BAR; PG8_MMA(1, 1, At, B1); PG8_BAR;
            PG8_LDB(B0, 1, 0); PG8_SCHED; PG8_LDA(At, 1, 0); PG8_STAGE(PG8_SA(0, 1), a2 + hstep, voffA);
            PG8_WAIT_L(8); PG8_BAR; PG8_WAIT_L(0); PG8_MMA(0, 0, At, B0); PG8_BAR; PG8_SCHED;
            PG8_LDB(B1, 1, 1); PG8_STAGE(PG8_SB(1, 0), b3, voffB);
            PG8_BAR; PG8_WAIT_L(0); PG8_MMA(0, 1, At, B1); PG8_BAR;
            PG8_LDA(At, 1, 1); PG8_STAGE(PG8_SA(1, 0), a3, voffA);
            PG8_BAR; PG8_WAIT_L(0); PG8_MMA(1, 0, At, B0); PG8_BAR; PG8_SCHED;
            PG8_STAGE(PG8_SB(1, 1), b3 + hstep, voffB);
            PG8_WAIT_V(6); PG8_BAR; PG8_MMA(1, 1, At, B1); PG8_BAR;
            }
        }
        if constexpr (ALIGN_EPI) { if (wr == 0) PG8_BAR; }
        if constexpr (!Epi::AFTER_DRAIN) { E(acc, cur, wr, wc, fr, fq); S.done(cur); }
        if (!has_next) break;
#pragma unroll
        for (int a = 0; a < 2; ++a)
#pragma unroll
            for (int b = 0; b < 2; ++b)
#pragma unroll
                for (int m = 0; m < 4; ++m)
#pragma unroll
                    for (int n = 0; n < 2; ++n) acc[a][b][m][n] = (f32x4){0.f, 0.f, 0.f, 0.f};
        cur = nxt; cA = nA; cB = nB; ++ui;
        if constexpr (ALIGN_EPI) { if (wr == 1) PG8_BAR; }
    }
    PG8_WAIT_V(0);
    if constexpr (!ALIGN_EPI) { if (wr == 0) PG8_BAR; }
    PG8_BAR;
    if constexpr (Epi::AFTER_DRAIN) { E.fused(acc, cur, wr, wc, fr, fq, lds, wid, lane); S.done(cur); }
#undef PG8_SA
#undef PG8_SB
#undef PG8_STAGE
#undef PG8_LDA
#undef PG8_LDB
#undef PG8_MMA
#undef PG8_WAIT_V
#undef PG8_WAIT_L
#undef PG8_BAR
#undef PG8_SCHED
}
}

namespace fox {
#define LAS3 __attribute__((address_space(3)))
constexpr int D = 128, SEQ = 16384, NH = 32, OPITCH = 4096;
constexpr float SCALE = 0.08838834764831845f;
constexpr float THR = 8.f;
constexpr int NW = 8, QBLK = 32, KVBLK = 64, QB = NW * QBLK;
constexpr int SHM_V = KVBLK * D * 2, SHM_K = KVBLK * D * 2;
constexpr int OFF_WS = 2 * SHM_V + 2 * SHM_K, OFF_BIAS = OFF_WS + NW * 64 * 4, OFF_QW = OFF_BIAS + 2 * 64 * 4, OFF_JLO = OFF_QW + 16, LDS_BYTES = OFF_JLO + 2048;
constexpr float SKIP_T = 30.f;
typedef unsigned short bf16;
typedef short bf16x8 __attribute__((ext_vector_type(8)));
typedef short s16x4 __attribute__((ext_vector_type(4)));
typedef float f32x16 __attribute__((ext_vector_type(16)));
typedef float f32x4 __attribute__((ext_vector_type(4)));
typedef unsigned u32x4 __attribute__((ext_vector_type(4)));

#define KSWZ(row, colB) ((row) * 256 + ((colB) ^ (((row) & 7) << 4)))
#define SBAR() __builtin_amdgcn_sched_barrier(0)
__device__ __forceinline__ int v_st(int k, int c) { const int kk = (k & ~0xC) | ((k & 4) << 1) | ((k & 8) >> 1); return ((kk >> 3) * 4 + (c >> 5)) * 512 + ((kk & 7) * 32 + (c & 31)) * 2; }
__device__ __forceinline__ int v_rd_base(int lane) { return ((lane & 3) << 3) | (((lane >> 2) & 3) << 6) | (((lane >> 4) & 1) << 5) | (((lane >> 5) & 1) << 8); }
constexpr int v_rd_off(int d0, int ks, int half) { return d0 * 512 + ks * 4096 + half * 2048; }
__device__ __forceinline__ int crow(int r, int hi) { return (r & 3) + 8 * (r >> 2) + 4 * hi; }
__device__ __forceinline__ unsigned cvtpk(float lo, float hi) { unsigned r; asm volatile("v_cvt_pk_bf16_f32 %0, %1, %2" : "=v"(r) : "v"(lo), "v"(hi)); return r; }
__device__ __forceinline__ bf16x8 load8(const bf16* p) { return *reinterpret_cast<const bf16x8*>(p); }
__device__ __forceinline__ void mask_tile(f32x16& p0, f32x16& p1, int dq) {
    const float NEG = -__builtin_inff();
#pragma unroll
    for (int r = 0; r < 16; ++r) {
        const int c = (r & 3) + 8 * (r >> 2);
        if (dq - c < 0) p0[r] = NEG;
        if (dq - c - 32 < 0) p1[r] = NEG;
    }
}
__device__ __forceinline__ void partialSM(f32x16& p0, f32x16& p1, float& m_reg, float& mn, float& alpha) {
    float pmax = p0[0]; for (int r = 1; r < 16; ++r) pmax = fmaxf(pmax, p0[r]); for (int r = 0; r < 16; ++r) pmax = fmaxf(pmax, p1[r]);
    { auto rr = __builtin_amdgcn_permlane32_swap(__float_as_uint(pmax), __float_as_uint(pmax), false, false);
      pmax = fmaxf(__uint_as_float(rr[0]), __uint_as_float(rr[1])); }
    constexpr float C2 = 1.4426950408889634f * SCALE;
    if (__builtin_expect(__all((pmax - m_reg) * SCALE <= THR), 1)) { mn = m_reg; alpha = 1.f; }
    else { mn = fmaxf(m_reg, pmax); alpha = __builtin_amdgcn_exp2f((m_reg - mn) * C2); m_reg = mn; }
    const float mnL = -mn * C2;
    for (int r = 0; r < 16; ++r) p0[r] = fmaf(p0[r], C2, mnL); for (int r = 0; r < 16; ++r) p1[r] = fmaf(p1[r], C2, mnL);
    for (int r = 0; r < 16; ++r) p0[r] = __builtin_amdgcn_exp2f(p0[r]);
}
__device__ __forceinline__ void finishSM(f32x16& p0, f32x16& p1, float alpha, float& l_reg, bf16x8& pa0, bf16x8& pa1, bf16x8& pa2, bf16x8& pa3) {
    for (int r = 0; r < 16; ++r) p1[r] = __builtin_amdgcn_exp2f(p1[r]);
    float ps = 0; for (int r = 0; r < 16; ++r) ps += p0[r]; for (int r = 0; r < 16; ++r) ps += p1[r];
    { auto rr = __builtin_amdgcn_permlane32_swap(__float_as_uint(ps), __float_as_uint(ps), false, false);
      ps = __uint_as_float(rr[0]) + __uint_as_float(rr[1]); }
    l_reg = l_reg * alpha + ps;
#define PK4(P, B_, OUT) do { unsigned a0 = cvtpk(P[B_+0], P[B_+1]), a1 = cvtpk(P[B_+2], P[B_+3]);                          \
        unsigned b0 = cvtpk(P[B_+4], P[B_+5]), b1 = cvtpk(P[B_+6], P[B_+7]);                                             \
        auto r0 = __builtin_amdgcn_permlane32_swap(a0, b0, false, false); auto r1 = __builtin_amdgcn_permlane32_swap(a1, b1, false, false); \
        u32x4 w = {r0[0], r1[0], r0[1], r1[1]}; OUT = *reinterpret_cast<bf16x8*>(&w); } while (0)
    PK4(p0, 0, pa0); PK4(p0, 8, pa1); PK4(p1, 0, pa2); PK4(p1, 8, pa3);
}
template <int KB>
__device__ __forceinline__ void qkt(f32x16& p0, f32x16& p1, const char* K_lds, const char* B_lds, int r32, int hi, const bf16x8* qr) {
    const float* bl = (const float*)B_lds + KB * 64 + 4 * hi;
#pragma unroll
    for (int g = 0; g < 4; ++g) { const f32x4 a = *(const f32x4*)(bl + 8 * g), b = *(const f32x4*)(bl + 32 + 8 * g);
        p0[4 * g + 0] = a[0]; p0[4 * g + 1] = a[1]; p0[4 * g + 2] = a[2]; p0[4 * g + 3] = a[3];
        p1[4 * g + 0] = b[0]; p1[4 * g + 1] = b[1]; p1[4 * g + 2] = b[2]; p1[4 * g + 3] = b[3]; }
    const char* kb[4];
#pragma unroll
    for (int dd = 0; dd < 4; ++dd) kb[dd] = K_lds + KB * SHM_K + KSWZ(r32, (dd * 16 + hi * 8) * 2);
#pragma unroll
    for (int d0 = 0; d0 < 8; ++d0) { const char* a = kb[d0 & 3] + (d0 >> 2) * 128;
        bf16x8 b0 = *reinterpret_cast<const bf16x8*>(a);
        bf16x8 b1 = *reinterpret_cast<const bf16x8*>(a + 32 * 256);
        p0 = __builtin_amdgcn_mfma_f32_32x32x16_bf16(b0, qr[d0], p0, 0, 0, 0);
        p1 = __builtin_amdgcn_mfma_f32_32x32x16_bf16(b1, qr[d0], p1, 0, 0, 0); }
}
template <int VB>
__device__ __forceinline__ void pv_tile(f32x16* o, int vb0, bf16x8 pa0, bf16x8 pa1, bf16x8 pa2, bf16x8 pa3) {
#define TRRD(dst, off) asm volatile("ds_read_b64_tr_b16 %0, %1 offset:%2" : "=&v"(dst) : "v"(vb0), "i"(off) : "memory")
#define PV_D0(d0) do { s16x4 l0, l1, l2, l3, h0, h1, h2, h3; constexpr int b_ = VB * SHM_V + v_rd_off(d0, 0, 0);     \
        TRRD(l0, b_); TRRD(h0, b_ + 2048); TRRD(l1, b_ + 4096); TRRD(h1, b_ + 6144); TRRD(l2, b_ + 8192); TRRD(h2, b_ + 10240); TRRD(l3, b_ + 12288); TRRD(h3, b_ + 14336); \
        asm volatile("s_waitcnt lgkmcnt(0)" ::: "memory"); SBAR();                                                                              \
        o[d0] = __builtin_amdgcn_mfma_f32_32x32x16_bf16((bf16x8){l0[0], l0[1], l0[2], l0[3], h0[0], h0[1], h0[2], h0[3]}, pa0, o[d0], 0, 0, 0);   \
        o[d0] = __builtin_amdgcn_mfma_f32_32x32x16_bf16((bf16x8){l1[0], l1[1], l1[2], l1[3], h1[0], h1[1], h1[2], h1[3]}, pa1, o[d0], 0, 0, 0);   \
        o[d0] = __builtin_amdgcn_mfma_f32_32x32x16_bf16((bf16x8){l2[0], l2[1], l2[2], l2[3], h2[0], h2[1], h2[2], h2[3]}, pa2, o[d0], 0, 0, 0);   \
        o[d0] = __builtin_amdgcn_mfma_f32_32x32x16_bf16((bf16x8){l3[0], l3[1], l3[2], l3[3], h3[0], h3[1], h3[2], h3[3]}, pa3, o[d0], 0, 0, 0); } while (0)
    PV_D0(0); PV_D0(1); PV_D0(2); PV_D0(3);
#undef PV_D0
#undef TRRD
}

struct BlockRef { const bf16* Q; const bf16* K; const bf16* V; const float* C; bf16* O; int P0; int jlo; };
struct Seam {
    bf16x8 qr[8];
    bf16x8 st_v0, st_v1, st_k0, st_k1; float st_b;
};
#define ROW(p, k0, rr) ((p) + (size_t)((k0) + (rr)) * D + sc)
#define VMW() asm volatile("s_waitcnt vmcnt(0)" ::: "memory")
#define VMWN(n) asm volatile("s_waitcnt vmcnt(%0)" :: "i"(n) : "memory")
#define SLOAD_H(Kp, Vp, Cp, k0) do { S.st_v0 = load8(ROW(Vp, k0, sr)); S.st_v1 = load8(ROW(Vp, k0, 32 + sr));              \
                         S.st_k0 = load8(ROW(Kp, k0, sr)); S.st_k1 = load8(ROW(Kp, k0, 32 + sr)); if (tid < 64) S.st_b = (Cp)[(k0) + tid]; } while (0)
#define SWRITE_HK(bf, cr) do { *(bf16x8*)(K_lds + (bf) * SHM_K + kws) = S.st_k0; *(bf16x8*)(K_lds + (bf) * SHM_K + kws + 32 * 256) = S.st_k1; \
                         if (tid < 64) ((float*)B_lds)[(bf) * 64 + tid] = S.st_b - (cr); } while (0)
#define SWRITE_HV(bf) do { *(bf16x8*)(V_lds + (bf) * SHM_V + vst0) = S.st_v0; *(bf16x8*)(V_lds + (bf) * SHM_V + vst1) = S.st_v1; } while (0)
#define SWRITE_H(bf, cr) do { SWRITE_HV(bf); SWRITE_HK(bf, cr); } while (0)
__device__ __forceinline__ void fox_prime(const BlockRef& cur, char* lds, Seam& S) {
    const int tid = mk_tid(), wid = __builtin_amdgcn_readfirstlane(tid >> 6), lane = tid & 63, r32 = lane & 31, hi = lane >> 5;
    const int sr = tid >> 4, sc = (tid & 15) * 8, kws = KSWZ(sr, sc * 2); char* K_lds = lds + 2 * SHM_V; char* B_lds = lds + OFF_BIAS;
    const float cref = __uint_as_float(__builtin_amdgcn_readfirstlane(__float_as_uint(cur.C[cur.P0])));
    for (int d0 = 0; d0 < 8; ++d0) S.qr[d0] = load8(cur.Q + (size_t)(wid * QBLK + r32) * D + d0 * 16 + hi * 8);
    SLOAD_H(cur.K, cur.V, cur.C, cur.jlo * KVBLK); VMW(); SWRITE_HK(0, cref);
    __syncthreads();
}
template <class NextFn> __device__ __forceinline__ BlockRef fox_block(const BlockRef& cur, char* lds, Seam& S, unsigned* qctr, const NextFn& mkref, bool& has_next) {
    const int tid = mk_tid(), wid = __builtin_amdgcn_readfirstlane(tid >> 6), lane = tid & 63, r32 = lane & 31, hi = lane >> 5;
    const int j_lo = cur.jlo, NT = (cur.P0 + QB - 1) / KVBLK + 1 - j_lo;
    unsigned qv = 0u; if (tid == 0) qv = __hip_atomic_fetch_add(qctr, 1u, __ATOMIC_RELAXED, __HIP_MEMORY_SCOPE_AGENT);
    const int qlo = cur.P0 + wid * QBLK, qm = qlo + r32 - 4 * hi;
    char* V_lds = lds; char* K_lds = lds + 2 * SHM_V; char* B_lds = lds + OFF_BIAS;
    float m_reg = -1e30f, l_reg = 0; f32x16 o[4] = {};
    const int sr = tid >> 4, sc = (tid & 15) * 8, vst0 = v_st(sr, sc), vst1 = v_st(32 + sr, sc), kws = KSWZ(sr, sc * 2);
    const int vb0 = (int)(uintptr_t)V_lds + v_rd_base(lane);
    const bf16* Kh = cur.K; const bf16* Vh = cur.V; const float* Ch = cur.C;
    const float cref = __uint_as_float(__builtin_amdgcn_readfirstlane(__float_as_uint(cur.C[cur.P0])));
#define RESC(a) do { if (__any((a) < 1.f)) { for (int d_ = 0; d_ < 4; ++d_) for (int r = 0; r < 16; ++r) o[d_][r] *= (a); } } while (0)
#define KBASE(t) ((j_lo + (t)) * KVBLK)
#define MASKT(P0_, P1_, t) do { const int kb_ = KBASE(t); if (kb_ + KVBLK - 1 > qlo) mask_tile(P0_, P1_, qm - kb_); } while (0)
    constexpr int NQL = 8;
#define SEAM_K0() do { VMWN(NQL); SWRITE_HK(0, crefn); SBAR(); } while (0)
    f32x16 pA0, pA1, pB0, pB1; float mnA, mnB, alA, alB; bf16x8 pa0, pa1, pa2, pa3;
    SWRITE_HV(0); SBAR();
    if (NT > 1) { SLOAD_H(Kh, Vh, Ch, KBASE(1)); }
    SBAR(); qkt<0>(pA0, pA1, K_lds, B_lds, r32, hi, S.qr);
    MASKT(pA0, pA1, 0); partialSM(pA0, pA1, m_reg, mnA, alA);
    if (NT > 1) { VMW(); SWRITE_H(1, cref); }
    if (tid == 0) *(volatile LAS3 unsigned*)(lds + OFF_QW) = qv;
    __syncthreads();
    const unsigned inext = (unsigned)__builtin_amdgcn_readfirstlane((int)*(volatile LAS3 unsigned*)(lds + OFF_QW)); has_next = inext < (unsigned)(NH * (SEQ / QB));
    const BlockRef nxt = has_next ? mkref((int)inext) : cur;
    const float crefn = __uint_as_float(__builtin_amdgcn_readfirstlane(__float_as_uint(nxt.C[nxt.P0]))); const int kbn = nxt.jlo * KVBLK;
#define HALF_STEP(PX0, PX1, mnX, alX, PY0, PY1, alY, t, KB, VB, SB) do {                                                      \
        SBAR(); qkt<KB>(PX0, PX1, K_lds, B_lds, r32, hi, S.qr);                                                               \
        finishSM(PY0, PY1, alY, l_reg, pa0, pa1, pa2, pa3); SBAR();                                                           \
        if ((t) + 1 < NT) { SLOAD_H(Kh, Vh, Ch, KBASE((t) + 1)); SBAR(); }                                                    \
        pv_tile<VB>(o, vb0, pa0, pa1, pa2, pa3); MASKT(PX0, PX1, (t)); partialSM(PX0, PX1, m_reg, mnX, alX);                  \
        __syncthreads();                                                                                                      \
        if ((t) + 1 < NT) { VMW(); SWRITE_H(SB, cref); }                                                                      \
        RESC(alX); __syncthreads(); } while (0)
    for (int t = 1; t + 1 < NT; t += 2) {
        HALF_STEP(pB0, pB1, mnB, alB, pA0, pA1, alA, t, 1, 0, 0);
        HALF_STEP(pA0, pA1, mnA, alA, pB0, pB1, alB, t + 1, 0, 1, 1);
    }
    const bool even = (NT & 1) == 0;
    if (even) { SBAR(); qkt<1>(pB0, pB1, K_lds, B_lds, r32, hi, S.qr); SBAR(); }
    SLOAD_H(nxt.K, nxt.V, nxt.C, kbn); SBAR();
#pragma unroll
    for (int d0 = 0; d0 < 8; ++d0) S.qr[d0] = load8(nxt.Q + (size_t)(wid * QBLK + r32) * D + d0 * 16 + hi * 8);
    SBAR();
    finishSM(pA0, pA1, alA, l_reg, pa0, pa1, pa2, pa3); SBAR();
    pv_tile<0>(o, vb0, pa0, pa1, pa2, pa3);
    if (even) { MASKT(pB0, pB1, NT - 1); partialSM(pB0, pB1, m_reg, mnB, alB); __syncthreads(); RESC(alB);
        finishSM(pB0, pB1, alB, l_reg, pa0, pa1, pa2, pa3); SBAR(); pv_tile<1>(o, vb0, pa0, pa1, pa2, pa3); }
    SBAR(); SEAM_K0();
    {
        const float rl = __builtin_amdgcn_rcpf(l_reg);
        bf16* Ow = cur.O + (size_t)(wid * QBLK + r32) * OPITCH + 8 * hi;
#pragma unroll
        for (int d0 = 0; d0 < 4; ++d0)
#pragma unroll
            for (int gp = 0; gp < 2; ++gp) { const int b_ = 8 * gp;
                const unsigned a0 = cvtpk(o[d0][b_ + 0] * rl, o[d0][b_ + 1] * rl), a1 = cvtpk(o[d0][b_ + 2] * rl, o[d0][b_ + 3] * rl);
                const unsigned b0 = cvtpk(o[d0][b_ + 4] * rl, o[d0][b_ + 5] * rl), b1 = cvtpk(o[d0][b_ + 6] * rl, o[d0][b_ + 7] * rl);
                auto r0 = __builtin_amdgcn_permlane32_swap(a0, b0, false, false); auto r1 = __builtin_amdgcn_permlane32_swap(a1, b1, false, false);
                u32x4 w = {r0[0], r1[0], r0[1], r1[1]}; *(u32x4*)(Ow + d0 * 32 + 16 * gp) = w; }
    }
    __syncthreads();
    return nxt;
#undef RESC
#undef KBASE
#undef MASKT
#undef SEAM_K0
#undef HALF_STEP
}
#undef ROW
#undef VMW
#undef VMWN
#undef SLOAD_H
#undef SWRITE_HK
#undef SWRITE_HV
#undef SWRITE_H
#undef PK4

__device__ __forceinline__ BlockRef fox_ref(int item, const bf16* Q, const bf16* K, const bf16* V, const float* Cn, bf16* O, const char* lds) {
    const int qb = SEQ / QB - 1 - (item >> 5), bh = item & 31;
    BlockRef r; r.Q = Q + ((size_t)bh * SEQ + (size_t)qb * QB) * D; r.K = K + (size_t)bh * SEQ * D; r.V = V + (size_t)bh * SEQ * D; r.C = Cn + (size_t)bh * SEQ;
    r.O = O + (size_t)(qb * QB) * OPITCH + bh * D; r.P0 = qb * QB; r.jlo = (int)((const unsigned char*)(lds + OFF_JLO))[bh * 64 + qb]; return r;
}
__device__ __forceinline__ void fox_attn_phase(char* lds, const bf16* Q, const bf16* K, const bf16* V, const float* Cn, const unsigned* nrm2, unsigned* qctr, bf16* O) {
    const int tid = mk_tid();
    {
        int lo[4], hi[4]; float thr[4]; const float* Cb[4];
#pragma unroll
        for (int k = 0; k < 4; ++k) { const int e = tid + 512 * k, bh = e >> 6, qb = e & 63, P0 = qb * QB; Cb[k] = Cn + (size_t)bh * SEQ;
            const float qn2 = __uint_as_float(nrm2[bh]), kn2 = __uint_as_float(nrm2[32 + bh]);
            const float Dh = SKIP_T * (1.0f / SCALE) + 2.04f * sqrtf(qn2 * kn2) + 1.0f;
            thr[k] = Cb[k][P0] - Dh; lo[k] = 0; hi[k] = P0 / KVBLK; }
#pragma unroll 1
        for (int it = 0; it < 8; ++it) {
            float v[4]; int mid[4];
#pragma unroll
            for (int k = 0; k < 4; ++k) { mid[k] = (lo[k] + hi[k]) >> 1; v[k] = Cb[k][mid[k] * KVBLK + KVBLK - 1]; }
#pragma unroll
            for (int k = 0; k < 4; ++k) if (lo[k] < hi[k]) { if (v[k] < thr[k]) lo[k] = mid[k] + 1; else hi[k] = mid[k]; }
        }
#pragma unroll
        for (int k = 0; k < 4; ++k) ((unsigned char*)(lds + OFF_JLO))[tid + 512 * k] = (unsigned char)lo[k];
    }
    if (tid == 0) *(volatile LAS3 unsigned*)(lds + OFF_QW) = __hip_atomic_fetch_add(qctr, 1u, __ATOMIC_RELAXED, __HIP_MEMORY_SCOPE_AGENT);
    __syncthreads();
    const unsigned i0 = (unsigned)__builtin_amdgcn_readfirstlane((int)*(volatile LAS3 unsigned*)(lds + OFF_QW));
    if (i0 >= (unsigned)(NH * (SEQ / QB))) return;
    __syncthreads();
    auto mk = [=](int item) { return fox_ref(item, Q, K, V, Cn, O, lds); };
    BlockRef cur = mk((int)i0);
    Seam S;
    fox_prime(cur, lds, S);
    for (;;) { bool has_next; const BlockRef nxt = fox_block(cur, lds, S, qctr, mk, has_next); if (!has_next) break; cur = nxt; }
}
#undef LAS3
#undef KSWZ
#undef SBAR
}

namespace swa {
constexpr int SEQ = 16384, QKVP = 5120, OP = 4096;
constexpr int K_OFF = 0, VT_OFF = 32768, VT_PITCH = 528, LI_OFF = VT_OFF + 64 * VT_PITCH, LDS_BYTES = LI_OFF + 8 * 32 * 4;
typedef unsigned short bf16;
typedef short bf16x8 __attribute__((ext_vector_type(8)));
typedef float f32x16 __attribute__((ext_vector_type(16)));
typedef float f32x4 __attribute__((ext_vector_type(4)));
typedef unsigned u32x4 __attribute__((ext_vector_type(4)));
__device__ __forceinline__ int crow(int r, int hi) { return (r & 3) + 8 * (r >> 2) + 4 * hi; }
__device__ __forceinline__ unsigned cvtpk(float lo, float hi) { unsigned r; asm volatile("v_cvt_pk_bf16_f32 %0, %1, %2" : "=v"(r) : "v"(lo), "v"(hi)); return r; }
__device__ __forceinline__ float bf2f(short b) { return __uint_as_float(((unsigned)(unsigned short)b) << 16); }
__device__ __forceinline__ bf16x8 pack8(const float* v) { u32x4 w = {cvtpk(v[0], v[1]), cvtpk(v[2], v[3]), cvtpk(v[4], v[5]), cvtpk(v[6], v[7])}; return *reinterpret_cast<bf16x8*>(&w); }
#define SWA_PK4(P, B_, OUT) do { unsigned a0 = cvtpk(P[B_+0], P[B_+1]), a1 = cvtpk(P[B_+2], P[B_+3]);                          \
        unsigned b0 = cvtpk(P[B_+4], P[B_+5]), b1 = cvtpk(P[B_+6], P[B_+7]);                                             \
        auto r0 = __builtin_amdgcn_permlane32_swap(a0, b0, false, false); auto r1 = __builtin_amdgcn_permlane32_swap(a1, b1, false, false); \
        u32x4 w = {r0[0], r1[0], r0[1], r1[1]}; OUT = *reinterpret_cast<bf16x8*>(&w); } while (0)

__device__ __forceinline__ void swa_attn_phase(char* lds, const bf16* QKV, const float* sinks, const float* cosT, const float* sinT, bf16* O, int wg, int G) {
    const int tid = mk_tid(), wid = __builtin_amdgcn_readfirstlane(tid >> 6), lane = tid & 63, r32 = lane & 31, hi = lane >> 5;
    for (int L = wg; L < 1024; L += G) {
        const int g = L & 7, n = L >> 3;
        __syncthreads();
        {
            const int row = tid >> 1, half = tid & 1, kpos = 128 * (n - 1) + row;
            bf16x8 kc[4], vc[4];
            if (kpos >= 0) {
                const bf16* kp = QKV + (size_t)kpos * QKVP + 4096 + g * 64 + half * 32; const bf16* vp = kp + 512;
#pragma unroll
                for (int c = 0; c < 4; ++c) { kc[c] = *(const bf16x8*)(kp + 8 * c); vc[c] = *(const bf16x8*)(vp + 8 * c); }
                if (half == 0) {
                    const f32x4 c0 = *(const f32x4*)(cosT + (size_t)kpos * 8), c1 = *(const f32x4*)(cosT + (size_t)kpos * 8 + 4);
                    const f32x4 s0 = *(const f32x4*)(sinT + (size_t)kpos * 8), s1 = *(const f32x4*)(sinT + (size_t)kpos * 8 + 4);
                    float o1[8], o2[8];
#pragma unroll
                    for (int i = 0; i < 8; ++i) { const float cs = i < 4 ? c0[i & 3] : c1[i & 3], sn = i < 4 ? s0[i & 3] : s1[i & 3];
                        const float x1 = bf2f(kc[0][i]), x2 = bf2f(kc[1][i]); o1[i] = x1 * cs - x2 * sn; o2[i] = x2 * cs + x1 * sn; }
                    kc[0] = pack8(o1); kc[1] = pack8(o2);
                }
            } else {
#pragma unroll
                for (int c = 0; c < 4; ++c) { kc[c] = (bf16x8){0, 0, 0, 0, 0, 0, 0, 0}; vc[c] = (bf16x8){0, 0, 0, 0, 0, 0, 0, 0}; }
            }
#pragma unroll
            for (int c = 0; c < 4; ++c) { const int chunk = half * 4 + c;
                *(bf16x8*)(lds + K_OFF + row * 128 + ((chunk ^ ((row >> 1) & 7)) << 4)) = kc[c];
#pragma unroll
                for (int j = 0; j < 8; ++j) *(short*)(lds + VT_OFF + (half * 32 + c * 8 + j) * VT_PITCH + row * 2) = vc[c][j]; }
        }
        __syncthreads();
        const int hq = g * 8 + wid; const float sink = sinks[hq];
        for (int a = 0; a < 4; ++a) {
            const int t = 128 * n + 32 * a + r32;
            const bf16* qp = QKV + (size_t)t * QKVP + hq * 64;
            bf16x8 qr[4];
#pragma unroll
            for (int d0 = 0; d0 < 4; ++d0) qr[d0] = *(const bf16x8*)(qp + 16 * d0 + 8 * hi);
            {
                const bf16x8 pr = *(const bf16x8*)(qp + 8 * (1 - hi));
                const f32x4 c0 = *(const f32x4*)(cosT + (size_t)t * 8), c1 = *(const f32x4*)(cosT + (size_t)t * 8 + 4);
                const f32x4 s0 = *(const f32x4*)(sinT + (size_t)t * 8), s1 = *(const f32x4*)(sinT + (size_t)t * 8 + 4);
                float ov[8];
#pragma unroll
                for (int i = 0; i < 8; ++i) { const float cs = i < 4 ? c0[i & 3] : c1[i & 3], sn = i < 4 ? s0[i & 3] : s1[i & 3];
                    const float own = bf2f(qr[0][i]), par = bf2f(pr[i]); ov[i] = own * cs + (hi ? par : -par) * sn; }
                qr[0] = pack8(ov);
            }
            f32x16 p[5];
#pragma unroll
            for (int bi = 0; bi < 5; ++bi) { const int row = 32 * (a + bi) + r32; const char* kb = lds + K_OFF + row * 128; const int sw = (row >> 1) & 7;
                f32x16 acc = {};
#pragma unroll
                for (int d0 = 0; d0 < 4; ++d0) { const bf16x8 kf = *(const bf16x8*)(kb + (((2 * d0 + hi) ^ sw) << 4)); acc = __builtin_amdgcn_mfma_f32_32x32x16_bf16(kf, qr[d0], acc, 0, 0, 0); }
                p[bi] = acc; }
            const float NEG = -__builtin_inff();
#pragma unroll
            for (int r = 0; r < 16; ++r) { const int c = crow(r, hi); if (!(c > r32)) p[0][r] = NEG; if (!(c <= r32)) p[4][r] = NEG; }
            if (n == 0) {
#pragma unroll
                for (int bi = 0; bi < 4; ++bi) if (a + bi < 4) {
#pragma unroll
                    for (int r = 0; r < 16; ++r) p[bi][r] = NEG; }
            }
            float mx = NEG;
#pragma unroll
            for (int bi = 0; bi < 5; ++bi)
#pragma unroll
                for (int r = 0; r < 16; ++r) mx = fmaxf(mx, p[bi][r]);
            { auto rr = __builtin_amdgcn_permlane32_swap(__float_as_uint(mx), __float_as_uint(mx), false, false); mx = fmaxf(__uint_as_float(rr[0]), __uint_as_float(rr[1])); }
            const float m = fmaxf(mx * 0.125f, sink);
            constexpr float LOG2E = 1.4426950408889634f, C2 = 0.125f * LOG2E;
            const float mL = -m * LOG2E;
            float ps = 0.f;
#pragma unroll
            for (int bi = 0; bi < 5; ++bi)
#pragma unroll
                for (int r = 0; r < 16; ++r) { const float e = __builtin_amdgcn_exp2f(fmaf(p[bi][r], C2, mL)); p[bi][r] = e; ps += e; }
            { auto rr = __builtin_amdgcn_permlane32_swap(__float_as_uint(ps), __float_as_uint(ps), false, false); ps = __uint_as_float(rr[0]) + __uint_as_float(rr[1]); }
            const float l = ps + __builtin_amdgcn_exp2f(fmaf(sink, LOG2E, mL));
            f32x16 o[2] = {};
#pragma unroll
            for (int bi = 0; bi < 5; ++bi) { bf16x8 pa[2]; SWA_PK4(p[bi], 0, pa[0]); SWA_PK4(p[bi], 8, pa[1]);
#pragma unroll
                for (int ks = 0; ks < 2; ++ks)
#pragma unroll
                    for (int db = 0; db < 2; ++db) { const bf16x8 vf = *(const bf16x8*)(lds + VT_OFF + (32 * db + r32) * VT_PITCH + (32 * (a + bi) + 16 * ks + 8 * hi) * 2);
                        o[db] = __builtin_amdgcn_mfma_f32_32x32x16_bf16(vf, pa[ks], o[db], 0, 0, 0); } }
            const float rl = __builtin_amdgcn_rcpf(l);
            bf16* Ow = O + (size_t)(128 * n + 32 * a + r32) * OP + hq * 64 + 8 * hi;
#pragma unroll
            for (int db = 0; db < 2; ++db)
#pragma unroll
                for (int gp = 0; gp < 2; ++gp) { const int b_ = 8 * gp;
                    const unsigned a0 = cvtpk(o[db][b_ + 0] * rl, o[db][b_ + 1] * rl), a1 = cvtpk(o[db][b_ + 2] * rl, o[db][b_ + 3] * rl);
                    const unsigned b0 = cvtpk(o[db][b_ + 4] * rl, o[db][b_ + 5] * rl), b1 = cvtpk(o[db][b_ + 6] * rl, o[db][b_ + 7] * rl);
                    auto r0 = __builtin_amdgcn_permlane32_swap(a0, b0, false, false); auto r1 = __builtin_amdgcn_permlane32_swap(a1, b1, false, false);
                    u32x4 w = {r0[0], r1[0], r0[1], r1[1]}; *(u32x4*)(Ow + db * 32 + 16 * gp) = w; }
        }
    }
    __syncthreads();
}
#undef SWA_PK4
}

#define LAS __attribute__((address_space(3)))
#define GAS __attribute__((address_space(1)))
typedef unsigned short bf16;
typedef float f32x4 __attribute__((ext_vector_type(4)));
typedef unsigned u32x4 __attribute__((ext_vector_type(4)));
typedef unsigned u32x2 __attribute__((ext_vector_type(2)));
typedef short bf16x8 __attribute__((ext_vector_type(8)));
constexpr int SEQ = 16384, DM = 4096, DFF = 11008;
constexpr float NORM_EPS = 1e-6f;
__device__ __forceinline__ unsigned cvtpk(float lo, float hi) { unsigned r; asm volatile("v_cvt_pk_bf16_f32 %0, %1, %2" : "=v"(r) : "v"(lo), "v"(hi)); return r; }
__device__ __forceinline__ float bf_lo(unsigned w) { return __uint_as_float(w << 16); }
__device__ __forceinline__ float bf_hi(unsigned w) { return __uint_as_float(w & 0xffff0000u); }
__device__ __forceinline__ float wave_sum(float v) {
#pragma unroll
    for (int o = 1; o < 64; o <<= 1) v += __shfl_xor(v, o);
    return v;
}
__device__ __forceinline__ float gelu_tanh(float x) {
    const float u = 0.7978845608028654f * (x + 0.044715f * x * x * x);
    return x * __builtin_amdgcn_rcpf(1.0f + __builtin_amdgcn_exp2f(-2.8853900817779268f * u));
}
__device__ __forceinline__ void sincos_d(double a, double& s, double& c) {
    const double k = rint(a * 0.15915494309189535);
    double r = fma(-k, 6.283185307179586, a); r = fma(-k, 2.4492935982947064e-16, r);
    const double r2 = r * r; double ss = 1.0, cc = 1.0;
#pragma unroll
    for (int n = 29; n >= 3; n -= 2) ss = fma(-ss * r2, 1.0 / (double)(n * (n - 1)), 1.0);
#pragma unroll
    for (int n = 28; n >= 2; n -= 2) cc = fma(-cc * r2, 1.0 / (double)(n * (n - 1)), 1.0);
    s = r * ss; c = cc;
}
__device__ __forceinline__ double exp_d(double x) {
    const double k = rint(x * 1.4426950408889634);
    double r = fma(-k, 0.6931471803691238, x); r = fma(-k, 1.9082149292705877e-10, r);
    double p = 1.0;
#pragma unroll
    for (int n = 16; n >= 1; --n) p = fma(p * r, 1.0 / (double)n, 1.0);
    return ldexp(p, (int)k);
}

__device__ __forceinline__ void transpose_item(const float* __restrict__ W, int K, int N, bf16* __restrict__ WT, int mode, LAS unsigned* scr, int item, int lane) {
    const int nblk = (N + 63) / 64, kb = item / nblk, nb = item - kb * nblk, k0 = 128 * kb, n0 = 64 * nb;
    int r0 = n0; if (mode == 1) { const int bj = n0 >> 12, rem = n0 & 4095; r0 = ((rem >> 7) << 8) + (bj << 7) + (rem & 127); }
    if (mode == 2) { const int bj = n0 >= DFF ? 1 : 0, rem = n0 - bj * DFF; r0 = ((rem >> 7) << 8) + (bj << 7) + (rem & 127); }
    const int c = lane & 15, kq = lane >> 4;
    const bool ok = n0 + 4 * c < N;
    const float* src = W + (size_t)(k0 + 2 * kq) * N + n0 + 4 * c;
    LAS unsigned* sw = scr + (4 * c) * 65 + kq;
#pragma unroll
    for (int half = 0; half < 2; ++half) {
        f32x4 a[8], b[8]; const f32x4 z = {0.f, 0.f, 0.f, 0.f};
#pragma unroll
        for (int p = 0; p < 8; ++p) { const float* s = src + (size_t)(8 * (8 * half + p)) * N;
            a[p] = ok ? __builtin_nontemporal_load((const f32x4*)s) : z; b[p] = ok ? __builtin_nontemporal_load((const f32x4*)(s + N)) : z; }
#pragma unroll
        for (int p = 0; p < 8; ++p)
#pragma unroll
            for (int q = 0; q < 4; ++q) sw[q * 65 + 4 * (8 * half + p)] = cvtpk(a[p][q], b[p][q]);
    }
    asm volatile("s_waitcnt lgkmcnt(0)" ::: "memory");
#pragma unroll
    for (int j = 0; j < 16; ++j) { const int n = 4 * j + kq; const LAS unsigned* s = scr + n * 65 + 4 * c;
        u32x4 o; o.x = s[0]; o.y = s[1]; o.z = s[2]; o.w = s[3];
        if (n0 + n < N) *(u32x4*)(WT + (size_t)(r0 + n) * K + k0 + 8 * c) = o; }
    asm volatile("s_waitcnt lgkmcnt(0)" ::: "memory");
}

__device__ __forceinline__ void norm_phase(int gw, int ngw, int lane, LAS unsigned char* stg, const bf16* tmp, const float* gpost, const float* hin, float* hout, const float* gpre, bf16* xn, float* U, float tscale = 1.0f) {
    for (int m = gw; m < SEQ; m += ngw) {
        f32x4 h[16];
        const f32x4* hr = (const f32x4*)(hin + (size_t)m * DM) + lane;
        if (tmp) {
            const u32x4* tr = (const u32x4*)(tmp + (size_t)m * DM) + lane; u32x4 tq[8]; float ss = 0.f;
#pragma unroll
            for (int j = 0; j < 8; ++j) tq[j] = __builtin_nontemporal_load(tr + 64 * j);
#pragma unroll
            for (int j = 0; j < 16; ++j) h[j] = __builtin_nontemporal_load(hr + 64 * j);
#pragma unroll
            for (int j = 0; j < 8; ++j) {
#pragma unroll
                for (int q = 0; q < 4; ++q) { const float a = bf_lo(tq[j][q]), b = bf_hi(tq[j][q]); ss += a * a + b * b; }
                *(LAS u32x4*)(stg + 1024 * j + 16 * lane) = tq[j]; }
            asm volatile("" ::: "memory");
            const float r = tscale / sqrtf(wave_sum(ss) * (1.0f / DM) + NORM_EPS);
            f32x4* ho = (f32x4*)(hout + (size_t)m * DM) + lane; const f32x4* gp = (const f32x4*)gpost + lane;
#pragma unroll
            for (int j = 0; j < 16; ++j) { const u32x2 w = *(const LAS u32x2*)(stg + 512 * j + 8 * lane); const f32x4 t = {bf_lo(w.x), bf_hi(w.x), bf_lo(w.y), bf_hi(w.y)};
                h[j] = h[j] + (t * r) * gp[64 * j]; __builtin_nontemporal_store(h[j], ho + 64 * j); }
        } else {
#pragma unroll
            for (int j = 0; j < 16; ++j) h[j] = hr[64 * j];
        }
        if (gpre) {
            float ss = 0.f;
#pragma unroll
            for (int j = 0; j < 16; ++j) ss += (h[j].x * h[j].x + h[j].y * h[j].y) + (h[j].z * h[j].z + h[j].w * h[j].w);
            const float r = 1.0f / sqrtf(wave_sum(ss) * (1.0f / DM) + NORM_EPS);
            const f32x4* gp = (const f32x4*)gpre + lane;
            if (xn) { u32x4* o16 = (u32x4*)(xn + (size_t)m * DM) + lane;
                asm volatile("" ::: "memory");
#pragma unroll
                for (int j = 0; j < 16; ++j) { const f32x4 v = (h[j] * r) * gp[64 * j]; u32x2 w; w.x = cvtpk(v.x, v.y); w.y = cvtpk(v.z, v.w); *(LAS u32x2*)(stg + 512 * j + 8 * lane) = w; }
                asm volatile("" ::: "memory");
#pragma unroll
                for (int j = 0; j < 8; ++j) o16[64 * j] = *(const LAS u32x4*)(stg + 1024 * j + 16 * lane);
                asm volatile("" ::: "memory"); }
            if (U) {
#pragma unroll
                for (int j = 0; j < 16; ++j) { const f32x4 v = (h[j] * r) * gp[64 * j];
                    *(f32x4*)(U + ((size_t)((lane >> 2) + 16 * j) * SEQ + m) * 16 + 4 * (lane & 3)) = v; } }
        }
    }
}

__device__ __forceinline__ void fox_cumsum_phase(char* lds, const float* __restrict__ logf, float* __restrict__ cneg, int wg, int G, int tid) {
    double* wtot = (double*)lds; const int lane = tid & 63, wid = tid >> 6;
    for (int h = wg; h < 32; h += G) {
        float v[32]; double s = 0.0;
#pragma unroll
        for (int j = 0; j < 32; ++j) { v[j] = logf[(size_t)(32 * tid + j) * 32 + h]; s += (double)v[j]; }
        double inc = s;
#pragma unroll
        for (int o = 1; o < 64; o <<= 1) { const double t = __shfl_up(inc, o); if (lane >= o) inc += t; }
        __syncthreads();
        if (lane == 63) wtot[wid] = inc;
        __syncthreads();
        double run = inc - s;
#pragma unroll
        for (int w = 0; w < 8; ++w) if (w < wid) run += wtot[w];
#pragma unroll
        for (int j = 0; j < 32; ++j) { run += (double)v[j]; cneg[(size_t)h * SEQ + 32 * tid + j] = (float)(-run * 11.313708498984761); }
    }
}

__device__ __forceinline__ void fox_norms_phase(const bf16* __restrict__ QK, unsigned* nrm2, int gw, int ngw, int lane) {
    for (int base = gw * 128; base < 64 * SEQ; base += ngw * 128) {
        const u32x4* p = (const u32x4*)(QK + (size_t)base * 128) + lane; float mx = 0.f;
#pragma unroll 8
        for (int i = 0; i < 32; ++i) { const u32x4 w = p[(size_t)i * 64]; float s = 0.f;
#pragma unroll
            for (int q = 0; q < 4; ++q) { const float a = bf_lo(w[q]), b = bf_hi(w[q]); s = fmaf(a, a, s); s = fmaf(b, b, s); }
            s += __shfl_xor(s, 1); s += __shfl_xor(s, 2); s += __shfl_xor(s, 4); s += __shfl_xor(s, 8); mx = fmaxf(mx, s); }
        mx = fmaxf(mx, __shfl_xor(mx, 16)); mx = fmaxf(mx, __shfl_xor(mx, 32));
        if (lane == 0) __hip_atomic_fetch_max(nrm2 + base / SEQ, __float_as_uint(mx), __ATOMIC_RELAXED, __HIP_MEMORY_SCOPE_AGENT);
    }
}

namespace s5 {
typedef float f32x16 __attribute__((ext_vector_type(16)));
constexpr int NG = 256, SEGL = 2048, XP = 272, WAVE_BYTES = 2048 + 32 * XP, E_OFF = 8 * WAVE_BYTES, LDS_BYTES = E_OFF + 8 * 128 * 4;
__device__ __forceinline__ bf16x8 pack8(f32x4 a, f32x4 b) { u32x4 w = {cvtpk(a[0], a[1]), cvtpk(a[2], a[3]), cvtpk(b[0], b[1]), cvtpk(b[2], b[3])}; return *reinterpret_cast<bf16x8*>(&w); }
__device__ __forceinline__ void state_consts(float lam_re_raw, float lam_im_raw, double dt, double& lbr, double& lbi, double& cfr, double& cfi, double& lre_o, double& lim_o) {
    const double lre = (double)fminf(lam_re_raw, -1e-4f), lim = (double)lam_im_raw; double sn, cs; sincos_d(lim * dt, sn, cs); const double er = exp_d(lre * dt);
    lbr = er * cs; lbi = er * sn; const double a = lbr - 1.0, b = lbi, den = 1.0 / (lre * lre + lim * lim); cfr = (a * lre + b * lim) * den; cfi = (b * lre - a * lim) * den; lre_o = lre; lim_o = lim;
}
__device__ __forceinline__ void s5_phase(char* lds, const float* __restrict__ U, const float* __restrict__ lam_re, const float* __restrict__ lam_im, const float* __restrict__ log_dt,
                                         const float* __restrict__ b_re, const float* __restrict__ b_im, const float* __restrict__ c_re, const float* __restrict__ c_im,
                                         const float* __restrict__ dskip, bf16* __restrict__ Gout, int wg, int G) {
    const int tid = mk_tid(), wid = __builtin_amdgcn_readfirstlane(tid >> 6), lane = tid & 63, r32 = lane & 31, hi = lane >> 5, l15 = lane & 15, q4 = lane >> 4;
    float* ublk = (float*)(lds + wid * WAVE_BYTES); char* xblk = lds + wid * WAVE_BYTES + 2048; float* Ebuf = (float*)(lds + E_OFF);
    for (int g = wg; g < NG; g += G) {
        float lr, li, l2r, l2i; bf16x8 Bf[4], Cf[4]; const float dsk = dskip[16 * g + l15];
        {
            const double dt = exp_d((double)log_dt[g]);
            { double lbr, lbi, cfr, cfi, lre, lim; state_consts(lam_re[g * 64 + lane], lam_im[g * 64 + lane], dt, lbr, lbi, cfr, cfi, lre, lim); lr = (float)lbr; li = (float)lbi;
              double sn2, cs2; sincos_d(lim * dt * (double)SEGL, sn2, cs2); const double e2 = exp_d(lre * dt * (double)SEGL); l2r = (float)(e2 * cs2); l2i = (float)(e2 * sn2); }
#pragma unroll
            for (int sb = 0; sb < 2; ++sb) { const int st = 32 * sb + r32; double lbr, lbi, cfr, cfi, lre, lim; state_consts(lam_re[g * 64 + st], lam_im[g * 64 + st], dt, lbr, lbi, cfr, cfi, lre, lim);
                const f32x4* br = (const f32x4*)(b_re + ((size_t)g * 64 + st) * 16 + 8 * hi); const f32x4* bi = (const f32x4*)(b_im + ((size_t)g * 64 + st) * 16 + 8 * hi);
                const f32x4 vr0 = br[0], vr1 = br[1], vi0 = bi[0], vi1 = bi[1]; f32x4 or0, or1, oi0, oi1;
#pragma unroll
                for (int i = 0; i < 4; ++i) { or0[i] = (float)(cfr * (double)vr0[i] - cfi * (double)vi0[i]); or1[i] = (float)(cfr * (double)vr1[i] - cfi * (double)vi1[i]);
                                              oi0[i] = (float)(cfr * (double)vi0[i] + cfi * (double)vr0[i]); oi1[i] = (float)(cfr * (double)vi1[i] + cfi * (double)vr1[i]); }
                Bf[sb] = pack8(or0, or1); Bf[2 + sb] = pack8(oi0, oi1); }
#pragma unroll
            for (int kk = 0; kk < 4; ++kk) { const float* cp = (kk < 2 ? c_re : c_im) + ((size_t)g * 16 + l15) * 64 + 32 * (kk & 1) + 8 * q4; const float sg = kk < 2 ? 1.f : -1.f;
                const f32x4 v0 = *(const f32x4*)cp, v1 = *(const f32x4*)(cp + 4); Cf[kk] = pack8(v0 * sg, v1 * sg); }
        }
        const float* Ug = U + ((size_t)g * SEQ + (size_t)wid * SEGL) * 16;
        float xr = 0.f, xi = 0.f;
#pragma unroll 1
        for (int pass = 0; pass < 2; ++pass) {
            f32x4 ua0, ua1; { const f32x4* up = (const f32x4*)(Ug + (size_t)r32 * 16 + 8 * hi); ua0 = up[0]; ua1 = up[1]; }
#pragma unroll 1
            for (int blk = 0; blk < SEGL / 32; ++blk) {
                f32x4 un0 = ua0, un1 = ua1;
                if (blk + 1 < SEGL / 32) { const f32x4* up = (const f32x4*)(Ug + ((size_t)(blk + 1) * 32 + r32) * 16 + 8 * hi); un0 = up[0]; un1 = up[1]; }
                const bf16x8 af = pack8(ua0, ua1);
                if (pass) { *(f32x4*)(ublk + r32 * 16 + 8 * hi) = ua0; *(f32x4*)(ublk + r32 * 16 + 8 * hi + 4) = ua1; }
                f32x16 a0 = {}, a1 = {}, a2 = {}, a3 = {};
                a0 = __builtin_amdgcn_mfma_f32_32x32x16_bf16(af, Bf[0], a0, 0, 0, 0); a1 = __builtin_amdgcn_mfma_f32_32x32x16_bf16(af, Bf[1], a1, 0, 0, 0);
                a2 = __builtin_amdgcn_mfma_f32_32x32x16_bf16(af, Bf[2], a2, 0, 0, 0); a3 = __builtin_amdgcn_mfma_f32_32x32x16_bf16(af, Bf[3], a3, 0, 0, 0);
#pragma unroll
                for (int r = 0; r < 16; ++r) { auto t0 = __builtin_amdgcn_permlane32_swap(__float_as_uint(a0[r]), __float_as_uint(a1[r]), false, false); a0[r] = __uint_as_float(t0[0]); a1[r] = __uint_as_float(t0[1]);
                                               auto t1 = __builtin_amdgcn_permlane32_swap(__float_as_uint(a2[r]), __float_as_uint(a3[r]), false, false); a2[r] = __uint_as_float(t1[0]); a3[r] = __uint_as_float(t1[1]); }
#pragma unroll
                for (int s = 0; s < 32; ++s) { const int h = (s >> 2) & 1, r = (s & 3) + 4 * (s >> 3); const float bre = h ? a1[r] : a0[r], bim = h ? a3[r] : a2[r];
                    const float nr = fmaf(lr, xr, fmaf(-li, xi, bre)), ni = fmaf(lr, xi, fmaf(li, xr, bim)); xr = nr; xi = ni;
                    if (pass) { const unsigned pk = cvtpk(xr, xi); *(unsigned short*)(xblk + s * XP + lane * 2) = (unsigned short)pk; *(unsigned short*)(xblk + s * XP + 128 + lane * 2) = (unsigned short)(pk >> 16); } }
                if (pass) {
#pragma unroll
                    for (int rb = 0; rb < 2; ++rb) { f32x4 acc = {0.f, 0.f, 0.f, 0.f};
#pragma unroll
                        for (int kk = 0; kk < 4; ++kk) { const bf16x8 xa = *(const bf16x8*)(xblk + (16 * rb + l15) * XP + (32 * kk + 8 * q4) * 2); acc = __builtin_amdgcn_mfma_f32_16x16x32_bf16(xa, Cf[kk], acc, 0, 0, 0); }
#pragma unroll
                        for (int i = 0; i < 4; ++i) { const int sl = 16 * rb + 4 * q4 + i; const float uv = ublk[sl * 16 + l15];
                            const float v = gelu_tanh(acc[i] + dsk * uv); const float vn = __shfl_xor(v, 1);
                            if ((l15 & 1) == 0) *(unsigned*)(Gout + ((size_t)wid * SEGL + blk * 32 + sl) * DM + 16 * g + l15) = cvtpk(v, vn); } }
                }
                ua0 = un0; ua1 = un1;
            }
            if (pass == 0) {
                Ebuf[wid * 128 + lane] = xr; Ebuf[wid * 128 + 64 + lane] = xi;
                __syncthreads();
                float sr = 0.f, si = 0.f;
                for (int v = 0; v < wid; ++v) { const float er = Ebuf[v * 128 + lane], ei = Ebuf[v * 128 + 64 + lane];
                    const float nr = fmaf(l2r, sr, fmaf(-l2i, si, er)), ni = fmaf(l2r, si, fmaf(l2i, sr, ei)); sr = nr; si = ni; }
                xr = sr; xi = si;
            }
        }
        __syncthreads();
    }
}
}
#define XB_TMO      128
#define XB_XCNT(j)  (256  + 64 * (j))
#define XB_XSUB(j)  (1280 + 64 * (j))
#define XB_XGEN(j)  (2304 + 64 * (j))
#define XB_TOP      3328
#define XB_TOPGEN   3392
#define XCD_BAR_WORDS 3456
#define XB_SPIN_CAP (1u << 18)

__device__ __forceinline__ unsigned xb_ld(unsigned* p)              { return __hip_atomic_load(p, __ATOMIC_RELAXED, __HIP_MEMORY_SCOPE_AGENT); }
__device__ __forceinline__ unsigned xb_add(unsigned* p, unsigned v) { return __hip_atomic_fetch_add(p, v, __ATOMIC_RELAXED, __HIP_MEMORY_SCOPE_AGENT); }
__device__ __forceinline__ unsigned xb_xcc_id() { return (unsigned)__builtin_amdgcn_s_getreg((3 << 11) | 20) & 0xFu; }
#define XB_SPIN(cond, bar) do { unsigned _sp = 0; while (cond) { __builtin_amdgcn_s_sleep(1); \
    if ((++_sp & 255u) == 0u) { if (xb_ld(&(bar)[XB_TMO])) break; if (_sp > XB_SPIN_CAP) { atomicAdd(&(bar)[XB_TMO], 1u); break; } } } } while (0)

struct XcdBarrier {
    unsigned* bar; unsigned x;
    volatile LAS unsigned* st;
};

__device__ __forceinline__ XcdBarrier xcd_barrier_post(unsigned* bar, volatile LAS unsigned* st) {
    XcdBarrier b; b.bar = bar; b.x = xb_xcc_id(); b.st = st;
    if (threadIdx.x == 0) (void)xb_add(&bar[XB_XCNT(b.x)], 1u);
    return b;
}
__device__ __forceinline__ void xcd_barrier_complete(unsigned* bar, unsigned x, unsigned& nloc, unsigned& nx) {
    const unsigned G = gridDim.x * gridDim.y * gridDim.z;
    unsigned sum, cnt, mine, sp = 0u;
    for (;;) {
        sum = 0u; cnt = 0u; mine = 0u;
#pragma unroll
        for (unsigned j = 0; j < 16; ++j) { const unsigned c = xb_ld(&bar[XB_XCNT(j)]); sum += c; cnt += (c > 0u) ? 1u : 0u; mine = (j == x) ? c : mine; }
        if (sum == G) break;
        __builtin_amdgcn_s_sleep(1);
        if ((++sp & 255u) == 0u) { if (xb_ld(&bar[XB_TMO])) break; if (sp > XB_SPIN_CAP) { atomicAdd(&bar[XB_TMO], 1u); break; } }
    }
    nloc = mine > 0u ? mine : 1u; nx = cnt > 0u ? cnt : 1u;
}

__device__ __forceinline__ void xcd_barrier(const XcdBarrier& b) {
    asm volatile("s_waitcnt vmcnt(0)" ::: "memory");
    __syncthreads();
    if (threadIdx.x == 0) {
        unsigned* bar = b.bar;
        __builtin_amdgcn_s_waitcnt(0);
        unsigned nloc = b.st[0], nx = b.st[1];
        if (nloc == 0u) { xcd_barrier_complete(bar, b.x, nloc, nx); b.st[0] = nloc; b.st[1] = nx; }
        const unsigned old = xb_add(&bar[XB_XSUB(b.x)], 1u);
        const unsigned gen = old / nloc;
        if (old + 1u == (gen + 1u) * nloc) {
            __builtin_amdgcn_fence(__ATOMIC_RELEASE, "agent");
            asm volatile("s_waitcnt vmcnt(0)" ::: "memory");
            const unsigned og = xb_add(&bar[XB_TOP], 1u);
            const unsigned tg = og / nx;
            if (og + 1u == (tg + 1u) * nx) xb_add(&bar[XB_TOPGEN], 1u);
            else XB_SPIN(xb_ld(&bar[XB_TOPGEN]) == tg, bar);
            __builtin_amdgcn_fence(__ATOMIC_ACQUIRE, "agent");
            xb_add(&bar[XB_XGEN(b.x)], 1u);
            asm volatile("s_waitcnt vmcnt(0)" ::: "memory");
        } else {
            XB_SPIN(xb_ld(&bar[XB_XGEN(b.x)]) == gen, bar);
            __builtin_amdgcn_fence(__ATOMIC_ACQUIRE, "agent");
            asm volatile("s_waitcnt vmcnt(0)" ::: "memory");
        }
    }
    __syncthreads();
}

constexpr size_t MiB = (size_t)1 << 20;
constexpr int NTHR = 512, NWAVES = 8;
constexpr int LDS_BYTES = 147456;
constexpr int LDS_MISC = LDS_BYTES - 1024;
__device__ __forceinline__ const float* uptr(const LAS unsigned long long* tab, int i) {
    const unsigned long long v = tab[i]; const unsigned lo = __builtin_amdgcn_readfirstlane((unsigned)v), hi = __builtin_amdgcn_readfirstlane((unsigned)(v >> 32));
    return (const float*)(const GAS float*)(((unsigned long long)hi << 32) | lo);
}
template <class T> __device__ __forceinline__ LAS T* launder_l(LAS T* p) { asm volatile("" : "+s"(p)); return p; }
template <class T> __device__ __forceinline__ T* launder(T* p) { GAS T* q = (GAS T*)p; asm volatile("" : "+s"(q)); return (T*)q; }
static_assert(pg8::STAGE_BYTES <= LDS_MISC && fox::LDS_BYTES <= LDS_MISC && swa::LDS_BYTES <= LDS_MISC && s5::LDS_BYTES <= LDS_MISC, "LDS map");
constexpr size_t WS_CTL = 0, CTL_ZERO_BYTES = 64 * 1024;
constexpr size_t CTL_QCTR = 16384, CTL_NRM2 = 20480;
constexpr size_t WS_ROPE = 1 * MiB;
constexpr size_t WS_W = 2 * MiB;
constexpr size_t W_L0_QKV = WS_W, W_L0_O = W_L0_QKV + 40 * MiB, W_L1_QKVF = W_L0_O + 32 * MiB, W_L1_O = W_L1_QKVF + 98 * MiB, W_L2_GLU = W_L1_O + 32 * MiB,
                 W_L3_QKV = W_L2_GLU + 64 * MiB, W_L3_O = W_L3_QKV + 40 * MiB, W_FFN = W_L3_O + 32 * MiB, W_FFN_STRIDE = 258 * MiB, W_FFN_OUT = 172 * MiB;
constexpr size_t WS_XN = W_FFN + 4 * W_FFN_STRIDE;
constexpr size_t WS_BIG = WS_XN + 129 * MiB;
constexpr size_t WS_Z = WS_BIG, WS_ACT = WS_BIG + 688 * MiB, WS_TMPF = WS_BIG, WS_TMPM = WS_BIG + 688 * MiB;
constexpr size_t WS_SWA_QKV = WS_BIG, WS_SWA_O = WS_BIG + 160 * MiB;
constexpr size_t WS_FOX_QKV = WS_BIG, WS_FOX_O = WS_BIG + 384 * MiB, WS_FOX_LOGF = WS_BIG + 512 * MiB, WS_FOX_CNEG = WS_BIG + 514 * MiB;
constexpr size_t WS_S5_U = WS_BIG + 256 * MiB, WS_S5_G = WS_BIG + 512 * MiB;
constexpr size_t WS_END = WS_BIG + 1032 * MiB;
static_assert((size_t)SEQ * 2 * DFF * 2 == 688 * MiB && (size_t)SEQ * DFF * 2 == 344 * MiB && (size_t)12544 * 4096 * 2 == 98 * MiB && (size_t)22016 * 4096 * 2 == 172 * MiB, "sizes");

struct Args { const float* in[56]; float* out; unsigned char* ws; float inv_freq[8]; int ph_lo, ph_hi; };

__global__ void __launch_bounds__(NTHR, 2) mk_fwd(Args args) {
    extern __shared__ __attribute__((aligned(16))) unsigned char lds[];
    if (threadIdx.x < 16) ((LAS unsigned*)((LAS unsigned char*)lds + LDS_MISC))[threadIdx.x] = 0u;
    if (threadIdx.x == 64) { LAS unsigned long long* ptab0 = (LAS unsigned long long*)((LAS unsigned char*)lds + LDS_MISC + 64);
#pragma unroll
        for (int i = 0; i < 56; ++i) ptab0[i] = (unsigned long long)args.in[i]; }
#define IN(i) uptr(ptab, (i))
    __syncthreads();
    XcdBarrier bar = xcd_barrier_post((unsigned*)(args.ws + WS_CTL), (volatile LAS unsigned*)((LAS unsigned char*)lds + LDS_MISC));
    int need_bar = 0;
#define PH_BEGIN(id) if (args.ph_lo <= (id) && (id) < args.ph_hi) { \
        if (need_bar) { XcdBarrier b2; b2.bar = launder(bar.bar); b2.x = (unsigned)launder_s((int)bar.x); b2.st = bar.st; for (int rb_ = 0; rb_ < REP_BAR; ++rb_) xcd_barrier(b2); } need_bar = 1; \
        unsigned char* const ws = launder(args.ws); float* const out = launder(args.out); (void)out; \
        LAS unsigned char* const ldsl = launder_l((LAS unsigned char*)lds); char* const ldsg = (char*)ldsl; (void)ldsg; const LAS unsigned long long* const ptab = (const LAS unsigned long long*)(ldsl + LDS_MISC + 64); \
        const int tid = mk_tid(), lane = tid & 63, wave = __builtin_amdgcn_readfirstlane(tid >> 6); (void)lane; (void)wave; \
        const int G = launder_s((int)gridDim.x), bx = launder_s((int)blockIdx.x), vcu = (G % 8 == 0) ? (bx % 8) * (G / 8) + bx / 8 : bx, gw = vcu * NWAVES + wave, ngw = G * NWAVES; (void)gw; (void)ngw; \
        bf16* const XN = (bf16*)(ws + WS_XN + 16384); float* const cosT = (float*)(ws + WS_ROPE); float* const sinT = cosT + SEQ * 8; bf16* const TMPM = (bf16*)(ws + WS_TMPM); bf16* const TMPF = (bf16*)(ws + WS_TMPF); \
        (void)XN; (void)cosT; (void)sinT; (void)TMPM; (void)TMPF;
#define PH_END }

    PH_BEGIN(0)
#if PROBE_COPY > 0
      for (int rep = 0; rep < PROBE_COPY; ++rep) {
        typedef PROBE_T pv_t; constexpr int PU = 128 / sizeof(pv_t);
        const pv_t* src = (const pv_t*)(ws + WS_BIG); pv_t* dst = (pv_t*)(ws + WS_BIG + 516 * MiB);
        const size_t n = 512 * MiB / sizeof(pv_t), stride = (size_t)G * NTHR;
        for (size_t i = (size_t)vcu * NTHR + tid; i < n; i += PU * stride) {
            pv_t v[PU];
#pragma unroll
            for (int u = 0; u < PU; ++u) v[u] = PROBE_LD(src + i + u * stride);
#pragma unroll
            for (int u = 0; u < PU; ++u) PROBE_ST(v[u], dst + i + u * stride);
        }
      }
#endif
      for (int rep = 0; rep < REP_PRO; ++rep) {
        LAS unsigned* scr = (LAS unsigned*)(ldsl + wave * 16640);
        constexpr int I_QKV = 32 * 80, I_O = 32 * 64, I_QKVF = 32 * 193, I_GLU = 32 * 128, I_IN = 32 * 344, I_OUT = 86 * 64;
        constexpr int NITEMS = 2 * (I_QKV + I_O) + I_QKVF + I_O + I_GLU + 4 * (I_IN + I_OUT);
        for (int it = gw; it < NITEMS; it += ngw) {
            int r = it;
#define TR(cnt, src, K_, N_, dstoff, mode) if (r < (cnt)) { transpose_item(IN(src), K_, N_, (bf16*)(ws + (dstoff)), mode, scr, r, lane); continue; } r -= (cnt);
            TR(I_QKV, 2, 4096, 5120, W_L0_QKV, 0)
            TR(I_O, 5, 4096, 4096, W_L0_O, 0)
            TR(I_IN, 9, 4096, 22016, W_FFN, 2)
            TR(I_OUT, 12, 11008, 4096, W_FFN + W_FFN_OUT, 0)
            TR(I_QKVF, 15, 4096, 12320, W_L1_QKVF, 0)
            TR(I_O, 17, 4096, 4096, W_L1_O, 0)
            TR(I_IN, 20, 4096, 22016, W_FFN + W_FFN_STRIDE, 2)
            TR(I_OUT, 23, 11008, 4096, W_FFN + W_FFN_STRIDE + W_FFN_OUT, 0)
            TR(I_GLU, 34, 4096, 8192, W_L2_GLU, 1)
            TR(I_IN, 38, 4096, 22016, W_FFN + 2 * W_FFN_STRIDE, 2)
            TR(I_OUT, 41, 11008, 4096, W_FFN + 2 * W_FFN_STRIDE + W_FFN_OUT, 0)
            TR(I_QKV, 44, 4096, 5120, W_L3_QKV, 0)
            TR(I_O, 47, 4096, 4096, W_L3_O, 0)
            TR(I_IN, 51, 4096, 22016, W_FFN + 3 * W_FFN_STRIDE, 2)
            TR(I_OUT, 54, 11008, 4096, W_FFN + 3 * W_FFN_STRIDE + W_FFN_OUT, 0)
#undef TR
        }
        if (vcu == 0) { u32x4* zh = (u32x4*)(ws + WS_XN); const u32x4 zero = {0u, 0u, 0u, 0u}; for (int i = tid; i < 1024; i += NTHR) zh[i] = zero; }
        {
            u32x4* z = (u32x4*)(ws + W_L1_QKVF + (size_t)12320 * 4096 * 2); const u32x4 zero = {0u, 0u, 0u, 0u};
            for (int i = vcu * NTHR + tid; i < 224 * 4096 * 2 / 16; i += G * NTHR) z[i] = zero;
        }
        for (int i = vcu * NTHR + tid; i < SEQ * 8; i += G * NTHR) {
            const int f = i & 7;
            const float fr = f == 0 ? args.inv_freq[0] : f == 1 ? args.inv_freq[1] : f == 2 ? args.inv_freq[2] : f == 3 ? args.inv_freq[3] : f == 4 ? args.inv_freq[4] : f == 5 ? args.inv_freq[5] : f == 6 ? args.inv_freq[6] : args.inv_freq[7];
            const float ang = (float)(i >> 3) * fr; double s, c; sincos_d((double)ang, s, c); cosT[i] = (float)c; sinT[i] = (float)s;
        }
        norm_phase(gw, ngw, lane, ldsl + wave * 16640, nullptr, nullptr, IN(0), nullptr, IN(1), XN, nullptr);
      }
    PH_END

#define SEL(a, b, c, d) IN(L == 0 ? (a) : L == 1 ? (b) : L == 2 ? (c) : (d))
    { constexpr int L = 0;

        const int type = L == 3 ? 0 : L, pb = 1 + 9 * L;
        const size_t wffn = W_FFN + (size_t)L * W_FFN_STRIDE;

        PH_BEGIN(pb + 0)
            if (type == 0) {
                pg8::Gemm g{XN, (const bf16*)(ws + (L == 0 ? W_L0_QKV : W_L3_QKV)), SEQ, 5120, 4096}; pg8::StaticOrder S; S.init(SEQ, 5120, G, bx);
                pg8::EpiBf16B E{(bf16*)(ws + WS_SWA_QKV), 5120, L == 0 ? IN(3) : IN(45)};
                for (int rep = 0; rep < REP_MIXG; ++rep) pg8::gemm_phase<pg8::EpiBf16B, pg8::StaticOrder, true, true>(ldsl, g, S, E);
            } else if (type == 1) {
                pg8::Gemm g{XN, (const bf16*)(ws + W_L1_QKVF), SEQ, 12544, 4096}; pg8::StaticOrder S; S.init(SEQ, 12544, G, bx);
                pg8::EpiFox E{(bf16*)(ws + WS_FOX_QKV), (float*)(ws + WS_FOX_LOGF), IN(16)};
                for (int rep = 0; rep < REP_MIXG; ++rep) pg8::gemm_phase<pg8::EpiFox, pg8::StaticOrder, true, true>(ldsl, g, S, E);
            } else {
              for (int rep = 0; rep < REP_MIX; ++rep)
                s5::s5_phase(ldsg, (const float*)(ws + WS_S5_U), IN(26), IN(27), IN(28), IN(29), IN(30), IN(31), IN(32), IN(33),
                             (bf16*)(ws + WS_S5_G), vcu, G);
            }
        PH_END
        if (type != 2) {
        PH_BEGIN(pb + 1)
          for (int rep = 0; rep < REP_MIX; ++rep) {
            if (type == 0) swa::swa_attn_phase(ldsg, (const bf16*)(ws + WS_SWA_QKV), L == 0 ? IN(4) : IN(46), cosT, sinT, (bf16*)(ws + WS_SWA_O), vcu, G);
            else { fox_cumsum_phase(ldsg, (const float*)(ws + WS_FOX_LOGF), (float*)(ws + WS_FOX_CNEG), vcu, G, tid);
                   if (G > 64) { if (vcu >= 32) fox_norms_phase((const bf16*)(ws + WS_FOX_QKV), (unsigned*)(ws + WS_CTL + CTL_NRM2), (vcu - 32) * NWAVES + wave, (G - 32) * NWAVES, lane); }
                   else fox_norms_phase((const bf16*)(ws + WS_FOX_QKV), (unsigned*)(ws + WS_CTL + CTL_NRM2), gw, ngw, lane); }
          }
        PH_END
        }
        if (type == 1) {
        PH_BEGIN(pb + 2)
            const bf16* q = (const bf16*)(ws + WS_FOX_QKV);
            fox::fox_attn_phase(ldsg, q, q + (size_t)32 * SEQ * 128, q + (size_t)64 * SEQ * 128, (const float*)(ws + WS_FOX_CNEG), (const unsigned*)(ws + WS_CTL + CTL_NRM2), (unsigned*)(ws + WS_CTL + CTL_QCTR), (bf16*)(ws + WS_FOX_O));
#if REP_FOX > 1
            __syncthreads();
            fox::fox_attn_phase(ldsg, q, q + (size_t)32 * SEQ * 128, q + (size_t)64 * SEQ * 128, (const float*)(ws + WS_FOX_CNEG), (const unsigned*)(ws + WS_CTL + CTL_NRM2), (unsigned*)(ws + WS_CTL + CTL_QCTR) + 64, (bf16*)(ws + WS_FOX_O));
#endif
        PH_END
        }
        PH_BEGIN(pb + 3)
            if (type == 2) {
                pg8::Gemm g{(const bf16*)(ws + WS_S5_G), (const bf16*)(ws + W_L2_GLU), SEQ, 8192, 4096}; pg8::StaticOrder S; S.init(SEQ, 8192, G, bx);
                pg8::EpiGlu E{TMPM, IN(35)};
                for (int rep = 0; rep < REP_MIXG; ++rep) pg8::gemm_phase<pg8::EpiGlu, pg8::StaticOrder, true, true>(ldsl, g, S, E);
            } else {
                pg8::Gemm g{(const bf16*)(ws + (type == 0 ? WS_SWA_O : WS_FOX_O)), (const bf16*)(ws + (L == 0 ? W_L0_O : L == 1 ? W_L1_O : W_L3_O)), SEQ, 4096, 4096};
                pg8::StaticOrder S; S.init(SEQ, 4096, G, bx);
                pg8::EpiBf16B E{TMPM, 4096, L == 0 ? IN(6) : L == 3 ? IN(48) : nullptr};
                for (int rep = 0; rep < REP_MIXG; ++rep) pg8::gemm_phase<pg8::EpiBf16B, pg8::StaticOrder, true, true>(ldsl, g, S, E);
            }
        PH_END
        PH_BEGIN(pb + 4)
          for (int rep = 0; rep < REP_NORM; ++rep)
            norm_phase(gw, ngw, lane, ldsl + wave * 16640, TMPM, SEL(7, 18, 36, 49), (L == 0 && rep == 0) ? IN(0) : out, out, SEL(8, 19, 37, 50), XN, nullptr, rep ? 0.f : 1.f);
        PH_END
        PH_BEGIN(pb + 5)
            pg8::Gemm g{XN - 2 * 4096, (const bf16*)(ws + wffn), 65 * 256, 2 * DFF, 4096, 254}; pg8::StaticOrder S; S.init(65 * 256, 2 * DFF, G, bx);
            pg8::EpiConvGeglu E{(bf16*)(ws + WS_ACT), SEL(10, 21, 39, 52), SEL(11, 22, 40, 53), ldsl + 131072, DFF, SEQ};
          for (int rep = 0; rep < REP_FFN1; ++rep)
            pg8::gemm_phase<pg8::EpiConvGeglu, pg8::StaticOrder, true, true>(ldsl, g, S, E);
        PH_END
        PH_BEGIN(pb + 7)
            pg8::Gemm g{(const bf16*)(ws + WS_ACT), (const bf16*)(ws + wffn + W_FFN_OUT), SEQ, 4096, DFF}; pg8::StaticOrder S; S.init(SEQ, 4096, G, bx);
            pg8::EpiBf16B E{TMPF, 4096, nullptr};
          for (int rep = 0; rep < REP_FFN2; ++rep)
            pg8::gemm_phase<pg8::EpiBf16B, pg8::StaticOrder, true, true>(ldsl, g, S, E);
        PH_END
        PH_BEGIN(pb + 8)
          for (int rep = 0; rep < REP_NORM; ++rep)
            norm_phase(gw, ngw, lane, ldsl + wave * 16640, TMPF, SEL(13, 24, 42, 55), out, out, L == 3 ? nullptr : SEL(14, 25, 43, 43), (L == 1 || L == 3) ? nullptr : XN, L == 1 ? (float*)(ws + WS_S5_U) : nullptr, rep ? 0.f : 1.f);
        PH_END
    }
    { constexpr int L = 1;

        const int type = L == 3 ? 0 : L, pb = 1 + 9 * L;
        const size_t wffn = W_FFN + (size_t)L * W_FFN_STRIDE;

        PH_BEGIN(pb + 0)
            if (type == 0) {
                pg8::Gemm g{XN, (const bf16*)(ws + (L == 0 ? W_L0_QKV : W_L3_QKV)), SEQ, 5120, 4096}; pg8::StaticOrder S; S.init(SEQ, 5120, G, bx);
                pg8::EpiBf16B E{(bf16*)(ws + WS_SWA_QKV), 5120, L == 0 ? IN(3) : IN(45)};
                for (int rep = 0; rep < REP_MIXG; ++rep) pg8::gemm_phase<pg8::EpiBf16B, pg8::StaticOrder, true, true>(ldsl, g, S, E);
            } else if (type == 1) {
                pg8::Gemm g{XN, (const bf16*)(ws + W_L1_QKVF), SEQ, 12544, 4096}; pg8::StaticOrder S; S.init(SEQ, 12544, G, bx);
                pg8::EpiFox E{(bf16*)(ws + WS_FOX_QKV), (float*)(ws + WS_FOX_LOGF), IN(16)};
                for (int rep = 0; rep < REP_MIXG; ++rep) pg8::gemm_phase<pg8::EpiFox, pg8::StaticOrder, true, true>(ldsl, g, S, E);
            } else {
              for (int rep = 0; rep < REP_MIX; ++rep)
                s5::s5_phase(ldsg, (const float*)(ws + WS_S5_U), IN(26), IN(27), IN(28), IN(29), IN(30), IN(31), IN(32), IN(33),
                             (bf16*)(ws + WS_S5_G), vcu, G);
            }
        PH_END
        if (type != 2) {
        PH_BEGIN(pb + 1)
          for (int rep = 0; rep < REP_MIX; ++rep) {
            if (type == 0) swa::swa_attn_phase(ldsg, (const bf16*)(ws + WS_SWA_QKV), L == 0 ? IN(4) : IN(46), cosT, sinT, (bf16*)(ws + WS_SWA_O), vcu, G);
            else { fox_cumsum_phase(ldsg, (const float*)(ws + WS_FOX_LOGF), (float*)(ws + WS_FOX_CNEG), vcu, G, tid);
                   if (G > 64) { if (vcu >= 32) fox_norms_phase((const bf16*)(ws + WS_FOX_QKV), (unsigned*)(ws + WS_CTL + CTL_NRM2), (vcu - 32) * NWAVES + wave, (G - 32) * NWAVES, lane); }
                   else fox_norms_phase((const bf16*)(ws + WS_FOX_QKV), (unsigned*)(ws + WS_CTL + CTL_NRM2), gw, ngw, lane); }
          }
        PH_END
        }
        if (type == 1) {
        PH_BEGIN(pb + 2)
            const bf16* q = (const bf16*)(ws + WS_FOX_QKV);
            fox::fox_attn_phase(ldsg, q, q + (size_t)32 * SEQ * 128, q + (size_t)64 * SEQ * 128, (const float*)(ws + WS_FOX_CNEG), (const unsigned*)(ws + WS_CTL + CTL_NRM2), (unsigned*)(ws + WS_CTL + CTL_QCTR), (bf16*)(ws + WS_FOX_O));
#if REP_FOX > 1
            __syncthreads();
            fox::fox_attn_phase(ldsg, q, q + (size_t)32 * SEQ * 128, q + (size_t)64 * SEQ * 128, (const float*)(ws + WS_FOX_CNEG), (const unsigned*)(ws + WS_CTL + CTL_NRM2), (unsigned*)(ws + WS_CTL + CTL_QCTR) + 64, (bf16*)(ws + WS_FOX_O));
#endif
        PH_END
        }
        PH_BEGIN(pb + 3)
            if (type == 2) {
                pg8::Gemm g{(const bf16*)(ws + WS_S5_G), (const bf16*)(ws + W_L2_GLU), SEQ, 8192, 4096}; pg8::StaticOrder S; S.init(SEQ, 8192, G, bx);
                pg8::EpiGlu E{TMPM, IN(35)};
                for (int rep = 0; rep < REP_MIXG; ++rep) pg8::gemm_phase<pg8::EpiGlu, pg8::StaticOrder, true, true>(ldsl, g, S, E);
            } else {
                pg8::Gemm g{(const bf16*)(ws + (type == 0 ? WS_SWA_O : WS_FOX_O)), (const bf16*)(ws + (L == 0 ? W_L0_O : L == 1 ? W_L1_O : W_L3_O)), SEQ, 4096, 4096};
                pg8::StaticOrder S; S.init(SEQ, 4096, G, bx);
                pg8::EpiBf16B E{TMPM, 4096, L == 0 ? IN(6) : L == 3 ? IN(48) : nullptr};
                for (int rep = 0; rep < REP_MIXG; ++rep) pg8::gemm_phase<pg8::EpiBf16B, pg8::StaticOrder, true, true>(ldsl, g, S, E);
            }
        PH_END
        PH_BEGIN(pb + 4)
          for (int rep = 0; rep < REP_NORM; ++rep)
            norm_phase(gw, ngw, lane, ldsl + wave * 16640, TMPM, SEL(7, 18, 36, 49), (L == 0 && rep == 0) ? IN(0) : out, out, SEL(8, 19, 37, 50), XN, nullptr, rep ? 0.f : 1.f);
        PH_END
        PH_BEGIN(pb + 5)
            pg8::Gemm g{XN - 2 * 4096, (const bf16*)(ws + wffn), 65 * 256, 2 * DFF, 4096, 254}; pg8::StaticOrder S; S.init(65 * 256, 2 * DFF, G, bx);
            pg8::EpiConvGeglu E{(bf16*)(ws + WS_ACT), SEL(10, 21, 39, 52), SEL(11, 22, 40, 53), ldsl + 131072, DFF, SEQ};
          for (int rep = 0; rep < REP_FFN1; ++rep)
            pg8::gemm_phase<pg8::EpiConvGeglu, pg8::StaticOrder, true, true>(ldsl, g, S, E);
        PH_END
        PH_BEGIN(pb + 7)
            pg8::Gemm g{(const bf16*)(ws + WS_ACT), (const bf16*)(ws + wffn + W_FFN_OUT), SEQ, 4096, DFF}; pg8::StaticOrder S; S.init(SEQ, 4096, G, bx);
            pg8::EpiBf16B E{TMPF, 4096, nullptr};
          for (int rep = 0; rep < REP_FFN2; ++rep)
            pg8::gemm_phase<pg8::EpiBf16B, pg8::StaticOrder, true, true>(ldsl, g, S, E);
        PH_END
        PH_BEGIN(pb + 8)
          for (int rep = 0; rep < REP_NORM; ++rep)
            norm_phase(gw, ngw, lane, ldsl + wave * 16640, TMPF, SEL(13, 24, 42, 55), out, out, L == 3 ? nullptr : SEL(14, 25, 43, 43), (L == 1 || L == 3) ? nullptr : XN, L == 1 ? (float*)(ws + WS_S5_U) : nullptr, rep ? 0.f : 1.f);
        PH_END
    }
    { constexpr int L = 2;

        const int type = L == 3 ? 0 : L, pb = 1 + 9 * L;
        const size_t wffn = W_FFN + (size_t)L * W_FFN_STRIDE;

        PH_BEGIN(pb + 0)
            if (type == 0) {
                pg8::Gemm g{XN, (const bf16*)(ws + (L == 0 ? W_L0_QKV : W_L3_QKV)), SEQ, 5120, 4096}; pg8::StaticOrder S; S.init(SEQ, 5120, G, bx);
                pg8::EpiBf16B E{(bf16*)(ws + WS_SWA_QKV), 5120, L == 0 ? IN(3) : IN(45)};
                for (int rep = 0; rep < REP_MIXG; ++rep) pg8::gemm_phase<pg8::EpiBf16B, pg8::StaticOrder, true, true>(ldsl, g, S, E);
            } else if (type == 1) {
                pg8::Gemm g{XN, (const bf16*)(ws + W_L1_QKVF), SEQ, 12544, 4096}; pg8::StaticOrder S; S.init(SEQ, 12544, G, bx);
                pg8::EpiFox E{(bf16*)(ws + WS_FOX_QKV), (float*)(ws + WS_FOX_LOGF), IN(16)};
                for (int rep = 0; rep < REP_MIXG; ++rep) pg8::gemm_phase<pg8::EpiFox, pg8::StaticOrder, true, true>(ldsl, g, S, E);
            } else {
              for (int rep = 0; rep < REP_MIX; ++rep)
                s5::s5_phase(ldsg, (const float*)(ws + WS_S5_U), IN(26), IN(27), IN(28), IN(29), IN(30), IN(31), IN(32), IN(33),
                             (bf16*)(ws + WS_S5_G), vcu, G);
            }
        PH_END
        if (type != 2) {
        PH_BEGIN(pb + 1)
          for (int rep = 0; rep < REP_MIX; ++rep) {
            if (type == 0) swa::swa_attn_phase(ldsg, (const bf16*)(ws + WS_SWA_QKV), L == 0 ? IN(4) : IN(46), cosT, sinT, (bf16*)(ws + WS_SWA_O), vcu, G);
            else { fox_cumsum_phase(ldsg, (const float*)(ws + WS_FOX_LOGF), (float*)(ws + WS_FOX_CNEG), vcu, G, tid);
                   if (G > 64) { if (vcu >= 32) fox_norms_phase((const bf16*)(ws + WS_FOX_QKV), (unsigned*)(ws + WS_CTL + CTL_NRM2), (vcu - 32) * NWAVES + wave, (G - 32) * NWAVES, lane); }
                   else fox_norms_phase((const bf16*)(ws + WS_FOX_QKV), (unsigned*)(ws + WS_CTL + CTL_NRM2), gw, ngw, lane); }
          }
        PH_END
        }
        if (type == 1) {
        PH_BEGIN(pb + 2)
            const bf16* q = (const bf16*)(ws + WS_FOX_QKV);
            fox::fox_attn_phase(ldsg, q, q + (size_t)32 * SEQ * 128, q + (size_t)64 * SEQ * 128, (const float*)(ws + WS_FOX_CNEG), (const unsigned*)(ws + WS_CTL + CTL_NRM2), (unsigned*)(ws + WS_CTL + CTL_QCTR), (bf16*)(ws + WS_FOX_O));
#if REP_FOX > 1
            __syncthreads();
            fox::fox_attn_phase(ldsg, q, q + (size_t)32 * SEQ * 128, q + (size_t)64 * SEQ * 128, (const float*)(ws + WS_FOX_CNEG), (const unsigned*)(ws + WS_CTL + CTL_NRM2), (unsigned*)(ws + WS_CTL + CTL_QCTR) + 64, (bf16*)(ws + WS_FOX_O));
#endif
        PH_END
        }
        PH_BEGIN(pb + 3)
            if (type == 2) {
                pg8::Gemm g{(const bf16*)(ws + WS_S5_G), (const bf16*)(ws + W_L2_GLU), SEQ, 8192, 4096}; pg8::StaticOrder S; S.init(SEQ, 8192, G, bx);
                pg8::EpiGlu E{TMPM, IN(35)};
                for (int rep = 0; rep < REP_MIXG; ++rep) pg8::gemm_phase<pg8::EpiGlu, pg8::StaticOrder, true, true>(ldsl, g, S, E);
            } else {
                pg8::Gemm g{(const bf16*)(ws + (type == 0 ? WS_SWA_O : WS_FOX_O)), (const bf16*)(ws + (L == 0 ? W_L0_O : L == 1 ? W_L1_O : W_L3_O)), SEQ, 4096, 4096};
                pg8::StaticOrder S; S.init(SEQ, 4096, G, bx);
                pg8::EpiBf16B E{TMPM, 4096, L == 0 ? IN(6) : L == 3 ? IN(48) : nullptr};
                for (int rep = 0; rep < REP_MIXG; ++rep) pg8::gemm_phase<pg8::EpiBf16B, pg8::StaticOrder, true, true>(ldsl, g, S, E);
            }
        PH_END
        PH_BEGIN(pb + 4)
          for (int rep = 0; rep < REP_NORM; ++rep)
            norm_phase(gw, ngw, lane, ldsl + wave * 16640, TMPM, SEL(7, 18, 36, 49), (L == 0 && rep == 0) ? IN(0) : out, out, SEL(8, 19, 37, 50), XN, nullptr, rep ? 0.f : 1.f);
        PH_END
        PH_BEGIN(pb + 5)
            pg8::Gemm g{XN - 2 * 4096, (const bf16*)(ws + wffn), 65 * 256, 2 * DFF, 4096, 254}; pg8::StaticOrder S; S.init(65 * 256, 2 * DFF, G, bx);
            pg8::EpiConvGeglu E{(bf16*)(ws + WS_ACT), SEL(10, 21, 39, 52), SEL(11, 22, 40, 53), ldsl + 131072, DFF, SEQ};
          for (int rep = 0; rep < REP_FFN1; ++rep)
            pg8::gemm_phase<pg8::EpiConvGeglu, pg8::StaticOrder, true, true>(ldsl, g, S, E);
        PH_END
        PH_BEGIN(pb + 7)
            pg8::Gemm g{(const bf16*)(ws + WS_ACT), (const bf16*)(ws + wffn + W_FFN_OUT), SEQ, 4096, DFF}; pg8::StaticOrder S; S.init(SEQ, 4096, G, bx);
            pg8::EpiBf16B E{TMPF, 4096, nullptr};
          for (int rep = 0; rep < REP_FFN2; ++rep)
            pg8::gemm_phase<pg8::EpiBf16B, pg8::StaticOrder, true, true>(ldsl, g, S, E);
        PH_END
        PH_BEGIN(pb + 8)
          for (int rep = 0; rep < REP_NORM; ++rep)
            norm_phase(gw, ngw, lane, ldsl + wave * 16640, TMPF, SEL(13, 24, 42, 55), out, out, L == 3 ? nullptr : SEL(14, 25, 43, 43), (L == 1 || L == 3) ? nullptr : XN, L == 1 ? (float*)(ws + WS_S5_U) : nullptr, rep ? 0.f : 1.f);
        PH_END
    }
    { constexpr int L = 3;

        const int type = L == 3 ? 0 : L, pb = 1 + 9 * L;
        const size_t wffn = W_FFN + (size_t)L * W_FFN_STRIDE;

        PH_BEGIN(pb + 0)
            if (type == 0) {
                pg8::Gemm g{XN, (const bf16*)(ws + (L == 0 ? W_L0_QKV : W_L3_QKV)), SEQ, 5120, 4096}; pg8::StaticOrder S; S.init(SEQ, 5120, G, bx);
                pg8::EpiBf16B E{(bf16*)(ws + WS_SWA_QKV), 5120, L == 0 ? IN(3) : IN(45)};
                for (int rep = 0; rep < REP_MIXG; ++rep) pg8::gemm_phase<pg8::EpiBf16B, pg8::StaticOrder, true, true>(ldsl, g, S, E);
            } else if (type == 1) {
                pg8::Gemm g{XN, (const bf16*)(ws + W_L1_QKVF), SEQ, 12544, 4096}; pg8::StaticOrder S; S.init(SEQ, 12544, G, bx);
                pg8::EpiFox E{(bf16*)(ws + WS_FOX_QKV), (float*)(ws + WS_FOX_LOGF), IN(16)};
                for (int rep = 0; rep < REP_MIXG; ++rep) pg8::gemm_phase<pg8::EpiFox, pg8::StaticOrder, true, true>(ldsl, g, S, E);
            } else {
              for (int rep = 0; rep < REP_MIX; ++rep)
                s5::s5_phase(ldsg, (const float*)(ws + WS_S5_U), IN(26), IN(27), IN(28), IN(29), IN(30), IN(31), IN(32), IN(33),
                             (bf16*)(ws + WS_S5_G), vcu, G);
            }
        PH_END
        if (type != 2) {
        PH_BEGIN(pb + 1)
          for (int rep = 0; rep < REP_MIX; ++rep) {
            if (type == 0) swa::swa_attn_phase(ldsg, (const bf16*)(ws + WS_SWA_QKV), L == 0 ? IN(4) : IN(46), cosT, sinT, (bf16*)(ws + WS_SWA_O), vcu, G);
            else { fox_cumsum_phase(ldsg, (const float*)(ws + WS_FOX_LOGF), (float*)(ws + WS_FOX_CNEG), vcu, G, tid);
                   if (G > 64) { if (vcu >= 32) fox_norms_phase((const bf16*)(ws + WS_FOX_QKV), (unsigned*)(ws + WS_CTL + CTL_NRM2), (vcu - 32) * NWAVES + wave, (G - 32) * NWAVES, lane); }
                   else fox_norms_phase((const bf16*)(ws + WS_FOX_QKV), (unsigned*)(ws + WS_CTL + CTL_NRM2), gw, ngw, lane); }
          }
        PH_END
        }
        if (type == 1) {
        PH_BEGIN(pb + 2)
            const bf16* q = (const bf16*)(ws + WS_FOX_QKV);
            fox::fox_attn_phase(ldsg, q, q + (size_t)32 * SEQ * 128, q + (size_t)64 * SEQ * 128, (const float*)(ws + WS_FOX_CNEG), (const unsigned*)(ws + WS_CTL + CTL_NRM2), (unsigned*)(ws + WS_CTL + CTL_QCTR), (bf16*)(ws + WS_FOX_O));
#if REP_FOX > 1
            __syncthreads();
            fox::fox_attn_phase(ldsg, q, q + (size_t)32 * SEQ * 128, q + (size_t)64 * SEQ * 128, (const float*)(ws + WS_FOX_CNEG), (const unsigned*)(ws + WS_CTL + CTL_NRM2), (unsigned*)(ws + WS_CTL + CTL_QCTR) + 64, (bf16*)(ws + WS_FOX_O));
#endif
        PH_END
        }
        PH_BEGIN(pb + 3)
            if (type == 2) {
                pg8::Gemm g{(const bf16*)(ws + WS_S5_G), (const bf16*)(ws + W_L2_GLU), SEQ, 8192, 4096}; pg8::StaticOrder S; S.init(SEQ, 8192, G, bx);
                pg8::EpiGlu E{TMPM, IN(35)};
                for (int rep = 0; rep < REP_MIXG; ++rep) pg8::gemm_phase<pg8::EpiGlu, pg8::StaticOrder, true, true>(ldsl, g, S, E);
            } else {
                pg8::Gemm g{(const bf16*)(ws + (type == 0 ? WS_SWA_O : WS_FOX_O)), (const bf16*)(ws + (L == 0 ? W_L0_O : L == 1 ? W_L1_O : W_L3_O)), SEQ, 4096, 4096};
                pg8::StaticOrder S; S.init(SEQ, 4096, G, bx);
                pg8::EpiBf16B E{TMPM, 4096, L == 0 ? IN(6) : L == 3 ? IN(48) : nullptr};
                for (int rep = 0; rep < REP_MIXG; ++rep) pg8::gemm_phase<pg8::EpiBf16B, pg8::StaticOrder, true, true>(ldsl, g, S, E);
            }
        PH_END
        PH_BEGIN(pb + 4)
          for (int rep = 0; rep < REP_NORM; ++rep)
            norm_phase(gw, ngw, lane, ldsl + wave * 16640, TMPM, SEL(7, 18, 36, 49), (L == 0 && rep == 0) ? IN(0) : out, out, SEL(8, 19, 37, 50), XN, nullptr, rep ? 0.f : 1.f);
        PH_END
        PH_BEGIN(pb + 5)
            pg8::Gemm g{XN - 2 * 4096, (const bf16*)(ws + wffn), 65 * 256, 2 * DFF, 4096, 254}; pg8::StaticOrder S; S.init(65 * 256, 2 * DFF, G, bx);
            pg8::EpiConvGeglu E{(bf16*)(ws + WS_ACT), SEL(10, 21, 39, 52), SEL(11, 22, 40, 53), ldsl + 131072, DFF, SEQ};
          for (int rep = 0; rep < REP_FFN1; ++rep)
            pg8::gemm_phase<pg8::EpiConvGeglu, pg8::StaticOrder, true, true>(ldsl, g, S, E);
        PH_END
        PH_BEGIN(pb + 7)
            pg8::Gemm g{(const bf16*)(ws + WS_ACT), (const bf16*)(ws + wffn + W_FFN_OUT), SEQ, 4096, DFF}; pg8::StaticOrder S; S.init(SEQ, 4096, G, bx);
            pg8::EpiBf16B E{TMPF, 4096, nullptr};
          for (int rep = 0; rep < REP_FFN2; ++rep)
            pg8::gemm_phase<pg8::EpiBf16B, pg8::StaticOrder, true, true>(ldsl, g, S, E);
        PH_END
        PH_BEGIN(pb + 8)
          for (int rep = 0; rep < REP_NORM; ++rep)
            norm_phase(gw, ngw, lane, ldsl + wave * 16640, TMPF, SEL(13, 24, 42, 55), out, out, L == 3 ? nullptr : SEL(14, 25, 43, 43), (L == 1 || L == 3) ? nullptr : XN, L == 1 ? (float*)(ws + WS_S5_U) : nullptr, rep ? 0.f : 1.f);
        PH_END
    }
#undef SEL
#undef PH_BEGIN
#undef PH_END
#undef IN
}

extern "C" void kernel_launch(void* const* d_in, const int* in_sizes, int n_in, void* d_out, int out_size, void* d_ws, size_t ws_size, hipStream_t stream) {
    static int grid = 0;
    if (grid == 0) {
        if (n_in != 56 || in_sizes[0] != SEQ * DM || out_size != SEQ * DM || ws_size < WS_END) {
            fprintf(stderr, "kernel_launch: built for 56 inputs, x/out of %d floats, >= %zu bytes of workspace; got n_in %d, in0 %d, out %d, ws %zu; nothing launched\n", SEQ * DM, (size_t)WS_END, n_in, n_in > 0 ? in_sizes[0] : -1, out_size, ws_size);
            grid = -1; return; }
        int dev = 0, cus = 0, per_cu = 0;
        if (hipGetDevice(&dev) != hipSuccess || hipDeviceGetAttribute(&cus, hipDeviceAttributeMultiprocessorCount, dev) != hipSuccess) { fprintf(stderr, "kernel_launch: device query failed\n"); grid = -1; return; }
        if (hipFuncSetAttribute((const void*)mk_fwd, hipFuncAttributeMaxDynamicSharedMemorySize, LDS_BYTES) != hipSuccess) { fprintf(stderr, "kernel_launch: hipFuncSetAttribute failed\n"); grid = -1; return; }
        if (hipOccupancyMaxActiveBlocksPerMultiprocessor(&per_cu, (const void*)mk_fwd, NTHR, LDS_BYTES) != hipSuccess || per_cu < 1) { fprintf(stderr, "kernel_launch: occupancy query says %d workgroups per CU\n", per_cu); (void)hipGetLastError(); }
        grid = cus;
    }
    if (grid < 0) return;
    if (hipMemsetAsync((char*)d_ws + WS_CTL, 0, CTL_ZERO_BYTES, stream) != hipSuccess) { fprintf(stderr, "kernel_launch: memset failed\n"); return; }
    Args a{};
    for (int i = 0; i < 56; ++i) a.in[i] = (const float*)d_in[i];
    a.out = (float*)d_out; a.ws = (unsigned char*)d_ws;
    { const float lt = (float)(-std::log(500000.0)); for (int i = 0; i < 8; ++i) { float v = lt * (float)i; v = v * 0.125f; a.inv_freq[i] = (float)std::exp((double)v); } }
#if MK_SPLIT_LAUNCHES
    for (int ph = 0; ph < 37; ++ph) {
        const int L = (ph - 1) / 9, slot = (ph - 1) % 9, type = L == 3 ? 0 : L;
        if (ph > 0 && ((slot == 1 && type == 2) || (slot == 2 && type != 1) || slot == 6)) continue;
        a.ph_lo = ph; a.ph_hi = ph + 1;
        hipLaunchKernelGGL(mk_fwd, dim3(grid), dim3(NTHR), LDS_BYTES, stream, a);
    }
#else
    a.ph_lo = 0; a.ph_hi = 37;
    hipLaunchKernelGGL(mk_fwd, dim3(grid), dim3(NTHR), LDS_BYTES, stream, a);
#endif
    const hipError_t le = hipPeekAtLastError();
    if (le != hipSuccess) fprintf(stderr, "kernel_launch: launch failed: %s (grid %d x %d threads, %d B LDS)\n", hipGetErrorName(le), grid, NTHR, LDS_BYTES);
}
```

```cpp
#include <hip/hip_runtime.h>
#include <cstdio>
#include <cstdint>
#include <cmath>

#ifndef MK_SPLIT_LAUNCHES
#define MK_SPLIT_LAUNCHES 0
#endif

__device__ __forceinline__ int mk_tid() { int t = threadIdx.x; asm volatile("" : "+v"(t)); return t; }
__device__ __forceinline__ int launder_s(int v) { asm volatile("" : "+s"(v)); return v; }

#ifndef PROBE_WAIT
#define PROBE_WAIT 0
#endif
#ifndef PROBE_ID
#define PROBE_ID -1
#endif
#ifndef PROBE_MASK
#define PROBE_MASK 0x080
#endif
#ifndef PROBE_WG
#define PROBE_WG -1
#endif
#ifndef PROBE_COPY
#define PROBE_COPY 0
#endif
#ifndef PROBE_T
#define PROBE_T u32x2
#endif
#define PROBE_LD(p) (*(p))
#define PROBE_ST(v, p) (*(p) = (v))
#ifndef REP_PRO
#define REP_PRO 1
#endif
#ifndef REP_FFN1
#define REP_FFN1 1
#endif
#ifndef REP_FFN2
#define REP_FFN2 1
#endif
#ifndef REP_NORM
#define REP_NORM 1
#endif
#ifndef REP_BAR
#define REP_BAR 1
#endif
#ifndef REP_FOX
#define REP_FOX 1
#endif
#ifndef REP_MIXG
#define REP_MIXG 1
#endif
#ifndef REP_MIX
#define REP_MIX 1
#endif

namespace pg8 {
#define PG8_LAS __attribute__((address_space(3)))
typedef unsigned short bf16_t;
typedef short bf16x8 __attribute__((ext_vector_type(8)));
typedef float f32x4 __attribute__((ext_vector_type(4)));
typedef unsigned u32x4 __attribute__((ext_vector_type(4)));
typedef unsigned u32x2 __attribute__((ext_vector_type(2)));
typedef float f32x2 __attribute__((ext_vector_type(2)));
constexpr int BM = 256, BK = 64, HALF = 128, HTB = HALF * BK * 2  , STAGE_BYTES = 8 * HTB, NXCD = 8, WGM = 8;

__host__ __device__ __forceinline__ int lds_byte(int r, int c) { const int st = (r >> 4) * 2 + (c >> 5), rr = r & 15, cc = c & 31, ob = rr * 64 + cc * 2; return st * 1024 + (ob ^ (((ob >> 9) & 1) << 5)); }
__host__ __device__ __forceinline__ void stage_rc(int b, int& R, int& C) { const int st = b / 1024, sb = b % 1024, swz = sb ^ (((sb >> 9) & 1) << 5); R = (st >> 1) * 16 + swz / 64; C = (st & 1) * 32 + (swz % 64) / 2; }
__host__ __device__ __forceinline__ int perm32(int rho) { const int n = rho >> 4, i = rho & 15; return 8 * (i >> 2) + 4 * n + (i & 3); }

struct Unit { int pm, pn; };
struct Gemm { const bf16_t* A; const bf16_t* Bt; int M, N, K; int apr = 256; };

struct StaticOrder {
    int nM, nN, nwg, G, c;
    __host__ __device__ void init(int M, int N, int G_, int c_) { nM = M / BM; nN = N / BM; nwg = nM * nN; G = G_; c = c_; }
    __host__ __device__ bool next(int i, Unit& u) const {
        const long L = (long)i * G + c; if (L >= nwg) return false;
        int wgid = (int)L; { const int q = nwg / NXCD, r = nwg % NXCD, xcd = wgid % NXCD, off = wgid / NXCD; wgid = (xcd < r ? xcd * (q + 1) : r * (q + 1) + (xcd - r) * q) + off; }
        const int nig = WGM * nN, ngf = nM / WGM > 0 ? nM / WGM : 1; int gid = wgid / nig; if (gid >= ngf) gid = ngf - 1;
        const int fm = gid * WGM, gsz = gid == ngf - 1 ? nM - fm : WGM, w = wgid - gid * nig;
        u.pm = fm + (w % gsz); u.pn = w / gsz; return true;
    }
    __device__ __forceinline__ void a_ready(const Unit&) const {}
    __device__ __forceinline__ void done(const Unit&) const {}
};

__device__ __forceinline__ unsigned cvt_pk_bf16(float lo, float hi) { unsigned r; asm volatile("v_cvt_pk_bf16_f32 %0, %1, %2" : "=v"(r) : "v"(lo), "v"(hi)); return r; }

struct EpiF32B {
    static constexpr bool PERM = false, AFTER_DRAIN = false, APERM = false;
    float* C; int ldc; const float* bias;
    __device__ __forceinline__ void operator()(const f32x4 (&acc)[2][2][4][2], const Unit& u, int wr, int wc, int fr, int fq) const {
        const int row0 = u.pm * BM + wr * 64 + fr, col0 = u.pn * BM + wc * 32 + 4 * fq;
        f32x4 bv[2][2];
#pragma unroll
        for (int bj = 0; bj < 2; ++bj)
#pragma unroll
            for (int n = 0; n < 2; ++n) bv[bj][n] = bias ? *(const f32x4*)(bias + col0 + bj * HALF + n * 16) : (f32x4){0.f, 0.f, 0.f, 0.f};
#pragma unroll
        for (int ai = 0; ai < 2; ++ai)
#pragma unroll
            for (int m = 0; m < 4; ++m) { float* rowp = C + (size_t)(row0 + ai * HALF + m * 16) * ldc + col0;
#pragma unroll
                for (int bj = 0; bj < 2; ++bj)
#pragma unroll
                    for (int n = 0; n < 2; ++n) *(f32x4*)(rowp + bj * HALF + n * 16) = acc[ai][bj][m][n] + bv[bj][n]; }
    }
};
struct EpiBf16B {
    static constexpr bool PERM = true, AFTER_DRAIN = false, APERM = false;
    bf16_t* O; int ldc; const float* bias;
    __device__ __forceinline__ void operator()(const f32x4 (&acc)[2][2][4][2], const Unit& u, int wr, int wc, int fr, int fq) const {
        const int row0 = u.pm * BM + wr * 64 + fr; const int col0 = u.pn * BM + wc * 32 + 8 * fq;
        f32x4 bv[2][2];
#pragma unroll
        for (int bj = 0; bj < 2; ++bj)
#pragma unroll
            for (int n = 0; n < 2; ++n) bv[bj][n] = bias ? *(const f32x4*)(bias + col0 + bj * HALF + 4 * n) : (f32x4){0.f, 0.f, 0.f, 0.f};
#pragma unroll
        for (int ai = 0; ai < 2; ++ai)
#pragma unroll
            for (int m = 0; m < 4; ++m) { bf16_t* rowp = O + (size_t)(row0 + ai * HALF + m * 16) * ldc + col0;
#pragma unroll
                for (int bj = 0; bj < 2; ++bj) { const f32x4 v0 = acc[ai][bj][m][0] + bv[bj][0], v1 = acc[ai][bj][m][1] + bv[bj][1];
                    u32x4 w; w.x = cvt_pk_bf16(v0[0], v0[1]); w.y = cvt_pk_bf16(v0[2], v0[3]); w.z = cvt_pk_bf16(v1[0], v1[1]); w.w = cvt_pk_bf16(v1[2], v1[3]);
                    *(u32x4*)(rowp + bj * HALF) = w; } }
    }
};
struct EpiFox {
    static constexpr bool PERM = true, AFTER_DRAIN = false, APERM = false;
    bf16_t* QKV; float* logf; const float* bfg;
    __device__ __forceinline__ void operator()(const f32x4 (&acc)[2][2][4][2], const Unit& u, int wr, int wc, int fr, int fq) const {
        const int row0 = u.pm * BM + wr * 64 + fr;
        if (u.pn < 48) {
            const int t3 = u.pn >> 4, hp = u.pn & 15;
#pragma unroll
            for (int bj = 0; bj < 2; ++bj) { bf16_t* base = QKV + ((size_t)(t3 * 32 + 2 * hp + bj) * 16384) * 128 + wc * 32 + 8 * fq;
#pragma unroll
                for (int ai = 0; ai < 2; ++ai)
#pragma unroll
                    for (int m = 0; m < 4; ++m) { const f32x4 v0 = acc[ai][bj][m][0], v1 = acc[ai][bj][m][1];
                        u32x4 w; w.x = cvt_pk_bf16(v0[0], v0[1]); w.y = cvt_pk_bf16(v0[2], v0[3]); w.z = cvt_pk_bf16(v1[0], v1[1]); w.w = cvt_pk_bf16(v1[2], v1[3]);
                        *(u32x4*)(base + (size_t)(row0 + ai * HALF + m * 16) * 128) = w; } }
        } else if (wc == 0) {
            const f32x4 b0 = *(const f32x4*)(bfg + 8 * fq), b1 = *(const f32x4*)(bfg + 8 * fq + 4);
#pragma unroll
            for (int ai = 0; ai < 2; ++ai)
#pragma unroll
                for (int m = 0; m < 4; ++m) { float* rowp = logf + (size_t)(row0 + ai * HALF + m * 16) * 32 + 8 * fq;
#pragma unroll
                    for (int n = 0; n < 2; ++n) { const f32x4 z = acc[ai][0][m][n] + (n ? b1 : b0); f32x4 o;
#pragma unroll
                        for (int i = 0; i < 4; ++i) o[i] = fminf(z[i], 0.f) - log1pf(expf(-fabsf(z[i])));
                        *(f32x4*)(rowp + 4 * n) = o; } }
        }
    }
};
struct EpiGlu {
    static constexpr bool PERM = true, AFTER_DRAIN = false, APERM = false;
    bf16_t* C; const float* bias;
    __device__ __forceinline__ void operator()(const f32x4 (&acc)[2][2][4][2], const Unit& u, int wr, int wc, int fr, int fq) const {
        const int row0 = u.pm * BM + wr * 64 + fr, col0 = u.pn * HALF + wc * 32 + 8 * fq;
        f32x4 bv[2], bg[2];
#pragma unroll
        for (int n = 0; n < 2; ++n) { bv[n] = *(const f32x4*)(bias + col0 + 4 * n); bg[n] = *(const f32x4*)(bias + 4096 + col0 + 4 * n); }
#pragma unroll
        for (int ai = 0; ai < 2; ++ai)
#pragma unroll
            for (int m = 0; m < 4; ++m) { bf16_t* rowp = C + (size_t)(row0 + ai * HALF + m * 16) * 4096 + col0; u32x4 w;
#pragma unroll
                for (int n = 0; n < 2; ++n) { const f32x4 zv = acc[ai][0][m][n] + bv[n], zg = acc[ai][1][m][n] + bg[n]; f32x4 o;
#pragma unroll
                    for (int i = 0; i < 4; ++i) o[i] = zv[i] * __builtin_amdgcn_rcpf(1.0f + __builtin_amdgcn_exp2f(-1.4426950408889634f * zg[i]));
                    if (n == 0) { w.x = cvt_pk_bf16(o[0], o[1]); w.y = cvt_pk_bf16(o[2], o[3]); } else { w.z = cvt_pk_bf16(o[0], o[1]); w.w = cvt_pk_bf16(o[2], o[3]); } }
                *(u32x4*)rowp = w; }
    }
};

struct EpiConvGeglu {
    static constexpr bool PERM = true, AFTER_DRAIN = false, APERM = true;
    bf16_t* ACT; const float* cw; const float* cb; PG8_LAS unsigned char* xl; int dff, nrows;
    static __device__ __forceinline__ float shr1(float old, float src) {
        return __builtin_bit_cast(float, __builtin_amdgcn_update_dpp(__builtin_bit_cast(int, old), __builtin_bit_cast(int, src), 0x111, 0xf, 0xf, false)); }
    static __device__ __forceinline__ float gelu_t(float x) { const float t = 0.7978845608028654f * (x + 0.044715f * x * x * x); return x * __builtin_amdgcn_rcpf(1.0f + __builtin_amdgcn_exp2f(-2.8853900817779268f * t)); }
    __device__ __forceinline__ void operator()(const f32x4 (&acc)[2][2][4][2], const Unit& u, int wr, int wc, int fr, int fq) const {
#define XOFF(ai_, w_, rr_, bj_, n_) ((((((ai_) * 2 + (w_)) * 2 + (rr_)) * 2 + (bj_)) * 4 + wc) * 128 + fq * 32 + (n_) * 16)
        f32x4 wv[8];
        { const int gc = u.pn * HALF + wc * 32 + 8 * fq;
            wv[0] = *(const f32x4*)(cw + gc); wv[1] = *(const f32x4*)(cw + 2 * dff + gc); wv[2] = *(const f32x4*)(cw + 4 * dff + gc); wv[3] = *(const f32x4*)(cb + gc);
            wv[4] = *(const f32x4*)(cw + dff + gc); wv[5] = *(const f32x4*)(cw + 3 * dff + gc); wv[6] = *(const f32x4*)(cw + 5 * dff + gc); wv[7] = *(const f32x4*)(cb + dff + gc); }
        if (fr == 15) {
#pragma unroll
            for (int ai = 0; ai < 2; ++ai)
#pragma unroll
                for (int bj = 0; bj < 2; ++bj)
#pragma unroll
                    for (int n = 0; n < 2; ++n) { *(PG8_LAS f32x4*)(xl + XOFF(ai, wr, 0, bj, n)) = acc[ai][bj][2][n]; *(PG8_LAS f32x4*)(xl + XOFF(ai, wr, 1, bj, n)) = acc[ai][bj][3][n]; }
        }
        asm volatile("s_waitcnt lgkmcnt(0)" ::: "memory"); __builtin_amdgcn_s_barrier(); asm volatile("" ::: "memory");
        u32x2 keep[2][4];
#pragma unroll
        for (int n = 0; n < 2; ++n) {
            const int gcol = u.pn * HALF + wc * 32 + 8 * fq + 4 * n;
            if (n) { wv[0] = *(const f32x4*)(cw + gcol); wv[1] = *(const f32x4*)(cw + 2 * dff + gcol); wv[2] = *(const f32x4*)(cw + 4 * dff + gcol); wv[3] = *(const f32x4*)(cb + gcol);
                     wv[4] = *(const f32x4*)(cw + dff + gcol); wv[5] = *(const f32x4*)(cw + 3 * dff + gcol); wv[6] = *(const f32x4*)(cw + 5 * dff + gcol); wv[7] = *(const f32x4*)(cb + dff + gcol); }
            const f32x4 wg0 = wv[0], wg1 = wv[1], wg2 = wv[2], bg = wv[3], wu0 = wv[4], wu1 = wv[5], wu2 = wv[6], bu = wv[7];
#pragma unroll
            for (int ai = 0; ai < 2; ++ai) {
                f32x4 Xg2 = {0.f, 0.f, 0.f, 0.f}, Xg3 = Xg2, Xu2 = Xg2, Xu3 = Xg2;
                if (ai + wr > 0) { const int pa = wr ? ai : ai - 1, pw = wr ? 0 : 1;
                    Xg2 = *(const PG8_LAS f32x4*)(xl + XOFF(pa, pw, 0, 0, n)); Xg3 = *(const PG8_LAS f32x4*)(xl + XOFF(pa, pw, 1, 0, n));
                    Xu2 = *(const PG8_LAS f32x4*)(xl + XOFF(pa, pw, 0, 1, n)); Xu3 = *(const PG8_LAS f32x4*)(xl + XOFF(pa, pw, 1, 1, n)); }
                float o[4][4];
#pragma unroll
                for (int ip = 0; ip < 2; ++ip) {
                    const int i0 = 2 * ip, i1 = 2 * ip + 1;
#define P2(v) ((f32x2){(v)[i0], (v)[i1]})
                    const f32x2 g0 = P2(acc[ai][0][0][n]), g1 = P2(acc[ai][0][1][n]), g2 = P2(acc[ai][0][2][n]), g3 = P2(acc[ai][0][3][n]);
                    const f32x2 u0 = P2(acc[ai][1][0][n]), u1 = P2(acc[ai][1][1][n]), u2 = P2(acc[ai][1][2][n]), u3 = P2(acc[ai][1][3][n]);
                    const f32x2 gm1 = {shr1(Xg3[i0], g3.x), shr1(Xg3[i1], g3.y)}, gm2 = {shr1(Xg2[i0], g2.x), shr1(Xg2[i1], g2.y)};
                    const f32x2 um1 = {shr1(Xu3[i0], u3.x), shr1(Xu3[i1], u3.y)}, um2 = {shr1(Xu2[i0], u2.x), shr1(Xu2[i1], u2.y)};
                    const f32x2 a2 = P2(wg2), a1 = P2(wg1), a0 = P2(wg0), ab = P2(bg), c2 = P2(wu2), c1 = P2(wu1), c0 = P2(wu0), cb = P2(bu);
#define FMA2(a, b, c) __builtin_elementwise_fma((a), (b), (c))
                    const f32x2 zg[4] = {FMA2(a0, gm2, FMA2(a1, gm1, FMA2(a2, g0, ab))), FMA2(a0, gm1, FMA2(a1, g0, FMA2(a2, g1, ab))), FMA2(a0, g0, FMA2(a1, g1, FMA2(a2, g2, ab))), FMA2(a0, g1, FMA2(a1, g2, FMA2(a2, g3, ab)))};
                    const f32x2 zu[4] = {FMA2(c0, um2, FMA2(c1, um1, FMA2(c2, u0, cb))), FMA2(c0, um1, FMA2(c1, u0, FMA2(c2, u1, cb))), FMA2(c0, u0, FMA2(c1, u1, FMA2(c2, u2, cb))), FMA2(c0, u1, FMA2(c1, u2, FMA2(c2, u3, cb)))};
#pragma unroll
                    for (int m = 0; m < 4; ++m) {
                        const f32x2 x = zg[m], x2 = x * x; const f32x2 kk = {-2.302208198f, -2.302208198f}, k3 = {-2.302208198f * 0.044715f, -2.302208198f * 0.044715f}, one = {1.f, 1.f};
                        const f32x2 a = x * FMA2(x2, k3, kk); const f32x2 e = {__builtin_amdgcn_exp2f(a.x), __builtin_amdgcn_exp2f(a.y)}; const f32x2 d = e + one;
                        const f32x2 r = {__builtin_amdgcn_rcpf(d.x), __builtin_amdgcn_rcpf(d.y)}; const f32x2 ov = (x * zu[m]) * r;
                        o[m][i0] = ov.x; o[m][i1] = ov.y; }
#undef FMA2
#undef P2
                }
#pragma unroll
                for (int m = 0; m < 4; ++m) { const int it = ai * HALF + wr * 64 + 4 * fr + m, grow = u.pm * 254 - 2 + it;
                    u32x2 w; w.x = cvt_pk_bf16(o[m][0], o[m][1]); w.y = cvt_pk_bf16(o[m][2], o[m][3]);
                    if (n == 0) keep[ai][m] = w;
                    else if (it >= 2 && grow < nrows) { u32x4 ww; ww.x = keep[ai][m].x; ww.y = keep[ai][m].y; ww.z = w.x; ww.w = w.y; *(u32x4*)(ACT + (size_t)grow * dff + gcol - 4) = ww; } }
            }
        }
#undef XOFF
    }
};

template <class Epi, class Sched, bool ALIGN_EPI = false, bool SP2 = false>
__device__ __forceinline__ void gemm_phase(PG8_LAS unsigned char* lds, const Gemm g, const Sched& S, const Epi& E) {
    const int tid = mk_tid(), wid = __builtin_amdgcn_readfirstlane(tid >> 6), lane = tid & 63, wr = wid >> 2, wc = wid & 3, fr = lane & 15, fq = lane >> 4;
    const int K = g.K, nt = K / BK;
    unsigned voffA[2], voffB[2];
#pragma unroll
    for (int i = 0; i < 2; ++i) { int R, C; stage_rc(tid * 16 + i * 8192, R, C); const int Rb = Epi::PERM ? ((R & ~31) + perm32(R & 31)) : R;
        const int Ra = Epi::APERM ? ((R & ~63) + 4 * (R & 15) + ((R >> 4) & 3)) : R;
        voffA[i] = (unsigned)(Ra * K + C) * 2u; voffB[i] = (unsigned)(Rb * K + C) * 2u; }
    const size_t kstep = (size_t)(BK * 2);
    const size_t hstep = (size_t)HALF * K * 2;
    const size_t tstep = 2 * hstep;
    const size_t tstepA = (size_t)g.apr * K * 2;
    const unsigned ldsw = (unsigned)wid * 1024u;
    const int aoff = lds_byte(wr * 64 + fr, fq * 8), boff = lds_byte(wc * 32 + fr, fq * 8);
#define PG8_SA(b, h) (((b) * 2 + (h)) * HTB)
#define PG8_SB(b, h) ((4 + (b) * 2 + (h)) * HTB)
#define PG8_STAGE(bufoff, gbase, voff) do { _Pragma("unroll") for (int _i = 0; _i < 2; ++_i) \
        __builtin_amdgcn_global_load_lds((const unsigned*)((const char*)(gbase) + (voff)[_i]), (PG8_LAS unsigned*)(lds + (bufoff) + ldsw + _i * 8192), 16, 0, 0); } while (0)
#define PG8_LDA(dst, b, h) do { _Pragma("unroll") for (int m = 0; m < 4; ++m) _Pragma("unroll") for (int k = 0; k < 2; ++k) dst[m][k] = *(const PG8_LAS bf16x8*)(lds + PG8_SA(b, h) + aoff + m * 2048 + k * 1024); } while (0)
#define PG8_LDB(dst, b, h) do { _Pragma("unroll") for (int n = 0; n < 2; ++n) _Pragma("unroll") for (int k = 0; k < 2; ++k) dst[n][k] = *(const PG8_LAS bf16x8*)(lds + PG8_SB(b, h) + boff + n * 2048 + k * 1024); } while (0)
#define PG8_MMA(ai, bj, At, Bt) do { __builtin_amdgcn_s_setprio(1); _Pragma("unroll") for (int m = 0; m < 4; ++m) _Pragma("unroll") for (int n = 0; n < 2; ++n) _Pragma("unroll") for (int k = 0; k < 2; ++k) \
        acc[ai][bj][m][n] = __builtin_amdgcn_mfma_f32_16x16x32_bf16(Bt[n][k], At[m][k], acc[ai][bj][m][n], 0, 0, 0); __builtin_amdgcn_s_setprio(0); } while (0)
#define PG8_WAIT_V(n) asm volatile("s_waitcnt vmcnt(" #n ")" ::: "memory")
#define PG8_WAIT_L(n) asm volatile("s_waitcnt lgkmcnt(" #n ")" ::: "memory")
#define PG8_BAR __builtin_amdgcn_s_barrier()
#define PG8_SCHED __builtin_amdgcn_sched_barrier(0)
    Unit cur, nxt; int ui = 0;
    if (!S.next(0, cur)) return;
    f32x4 acc[2][2][4][2];
#pragma unroll
    for (int a = 0; a < 2; ++a)
#pragma unroll
        for (int b = 0; b < 2; ++b)
#pragma unroll
            for (int m = 0; m < 4; ++m)
#pragma unroll
                for (int n = 0; n < 2; ++n) acc[a][b][m][n] = (f32x4){0.f, 0.f, 0.f, 0.f};
    bf16x8 At[4][2], B0[2][2], B1[2][2];
    const char* cA = (const char*)g.A + (size_t)cur.pm * tstepA; const char* cB = (const char*)g.Bt + (size_t)cur.pn * tstep;
    S.a_ready(cur);
    if constexpr (SP2) {
        PG8_STAGE(PG8_SB(0, 0), cB, voffB); PG8_STAGE(PG8_SB(0, 1), cB + hstep, voffB); PG8_STAGE(PG8_SA(0, 0), cA, voffA); PG8_STAGE(PG8_SA(0, 1), cA + hstep, voffA);
        if (wr == 1) PG8_BAR;
        PG8_WAIT_V(2); PG8_BAR;
        PG8_STAGE(PG8_SB(1, 0), cB + kstep, voffB); PG8_STAGE(PG8_SA(1, 0), cA + kstep, voffA); PG8_STAGE(PG8_SB(1, 1), cB + hstep + kstep, voffB);
        PG8_WAIT_V(6); PG8_BAR;
    } else {
        PG8_STAGE(PG8_SB(0, 0), cB, voffB); PG8_STAGE(PG8_SA(0, 0), cA, voffA); PG8_STAGE(PG8_SB(0, 1), cB + hstep, voffB); PG8_STAGE(PG8_SA(0, 1), cA + hstep, voffA);
        if (wr == 1) PG8_BAR;
        PG8_WAIT_V(4); PG8_BAR;
        PG8_STAGE(PG8_SB(1, 0), cB + kstep, voffB); PG8_STAGE(PG8_SA(1, 0), cA + kstep, voffA); PG8_STAGE(PG8_SB(1, 1), cB + hstep + kstep, voffB);
        PG8_WAIT_V(6); PG8_BAR;
    }
    for (;;) {
        const bool has_next = S.next(ui + 1, nxt);
        const char* nA = has_next ? (const char*)g.A + (size_t)nxt.pm * tstepA : cA; const char* nB = has_next ? (const char*)g.Bt + (size_t)nxt.pn * tstep : cB;
        for (int t = 0; t < nt; t += 2) {
            const bool last = (t == nt - 2);
            const char* a1 = cA + (size_t)(t + 1) * kstep;
            const char* a2 = last ? nA : cA + (size_t)(t + 2) * kstep; const char* b2 = last ? nB : cB + (size_t)(t + 2) * kstep;
            const char* a3 = a2 + kstep; const char* b3 = b2 + kstep;
            if (last && has_next) S.a_ready(nxt);
            if constexpr (SP2) {
            PG8_LDB(B0, 0, 0); PG8_LDB(B1, 0, 1); PG8_SCHED; PG8_LDA(At, 0, 0); PG8_STAGE(PG8_SA(1, 1), a1 + hstep, voffA);
            PG8_WAIT_V(8); PG8_WAIT_L(0); PG8_BAR; PG8_MMA(0, 0, At, B0); PG8_MMA(0, 1, At, B1); PG8_BAR; PG8_SCHED;
            PG8_LDA(At, 0, 1); PG8_STAGE(PG8_SB(0, 0), b2, voffB); PG8_STAGE(PG8_SB(0, 1), b2 + hstep, voffB); PG8_STAGE(PG8_SA(0, 0), a2, voffA);
            PG8_WAIT_V(8); PG8_WAIT_L(0); PG8_BAR; PG8_MMA(1, 0, At, B0); PG8_MMA(1, 1, At, B1); PG8_BAR; PG8_SCHED;
            PG8_LDB(B0, 1, 0); PG8_LDB(B1, 1, 1); PG8_SCHED; PG8_LDA(At, 1, 0); PG8_STAGE(PG8_SA(0, 1), a2 + hstep, voffA);
            PG8_WAIT_V(8); PG8_WAIT_L(0); PG8_BAR; PG8_MMA(0, 0, At, B0); PG8_MMA(0, 1, At, B1); PG8_BAR; PG8_SCHED;
            PG8_LDA(At, 1, 1); PG8_STAGE(PG8_SB(1, 0), b3, voffB); PG8_STAGE(PG8_SB(1, 1), b3 + hstep, voffB); PG8_STAGE(PG8_SA(1, 0), a3, voffA);
            PG8_WAIT_V(8); PG8_WAIT_L(0); PG8_BAR; PG8_MMA(1, 0, At, B0); PG8_MMA(1, 1, At, B1); PG8_BAR; PG8_SCHED;
            } else {
            PG8_LDB(B0, 0, 0); PG8_SCHED; PG8_LDA(At, 0, 0); PG8_STAGE(PG8_SA(1, 1), a1 + hstep, voffA);
            PG8_WAIT_L(8); PG8_BAR; PG8_WAIT_L(0); PG8_MMA(0, 0, At, B0); PG8_BAR; PG8_SCHED;
            PG8_LDB(B1, 0, 1); PG8_STAGE(PG8_SB(0, 0), b2, voffB);
            PG8_BAR; PG8_WAIT_L(0); PG8_MMA(0, 1, At, B1); PG8_BAR;
            PG8_LDA(At, 0, 1); PG8_STAGE(PG8_SA(0, 0), a2, voffA);
            PG8_BAR; PG8_WAIT_L(0); PG8_MMA(1, 0, At, B0); PG8_BAR; PG8_SCHED;
            PG8_STAGE(PG8_SB(0, 1), b2 + hstep, voffB);
            PG8_WAIT_V(6); PG8_BAR; PG8_MMA(1, 1, At, B1); PG8_BAR;
            PG8_LDB(B0, 1, 0); PG8_SCHED; PG8_LDA(At, 1, 0); PG8_STAGE(PG8_SA(0, 1), a2 + hstep, voffA);
            PG8_WAIT_L(8); PG8_BAR; PG8_WAIT_L(0); PG8_MMA(0, 0, At, B0); PG8_BAR; PG8_SCHED;
            PG8_LDB(B1, 1, 1); PG8_STAGE(PG8_SB(1, 0), b3, voffB);
            PG8_BAR; PG8_WAIT_L(0); PG8_MMA(0, 1, At, B1); PG8_BAR;
            PG8_LDA(At, 1, 1); PG8_STAGE(PG8_SA(1, 0), a3, voffA);
            PG8_BAR; PG8_WAIT_L(0); PG8_MMA(1, 0, At, B0); PG8_BAR; PG8_SCHED;
            PG8_STAGE(PG8_SB(1, 1), b3 + hstep, voffB);
            PG8_WAIT_V(6); PG8_BAR; PG8_MMA(1, 1, At, B1); PG8_BAR;
            }
        }
        if constexpr (ALIGN_EPI) { if (wr == 0) PG8_BAR; }
        if constexpr (!Epi::AFTER_DRAIN) { E(acc, cur, wr, wc, fr, fq); S.done(cur); }
        if (!has_next) break;
#pragma unroll
        for (int a = 0; a < 2; ++a)
#pragma unroll
            for (int b = 0; b < 2; ++b)
#pragma unroll
                for (int m = 0; m < 4; ++m)
#pragma unroll
                    for (int n = 0; n < 2; ++n) acc[a][b][m][n] = (f32x4){0.f, 0.f, 0.f, 0.f};
        cur = nxt; cA = nA; cB = nB; ++ui;
        if constexpr (ALIGN_EPI) { if (wr == 1) PG8_BAR; }
    }
    PG8_WAIT_V(0);
    if constexpr (!ALIGN_EPI) { if (wr == 0) PG8_BAR; }
    PG8_BAR;
    if constexpr (Epi::AFTER_DRAIN) { E.fused(acc, cur, wr, wc, fr, fq, lds, wid, lane); S.done(cur); }
#undef PG8_SA
#undef PG8_SB
#undef PG8_STAGE
#undef PG8_LDA
#undef PG8_LDB
#undef PG8_MMA
#undef PG8_WAIT_V
#undef PG8_WAIT_L
#undef PG8_BAR
#undef PG8_SCHED
}
}

namespace fox {
#define LAS3 __attribute__((address_space(3)))
constexpr int D = 128, SEQ = 16384, NH = 32, OPITCH = 4096;
constexpr float SCALE = 0.08838834764831845f;
constexpr float THR = 8.f;
constexpr int NW = 8, QBLK = 32, KVBLK = 64, QB = NW * QBLK;
constexpr int SHM_V = KVBLK * D * 2, SHM_K = KVBLK * D * 2;
constexpr int OFF_WS = 2 * SHM_V + 2 * SHM_K, OFF_BIAS = OFF_WS + NW * 64 * 4, OFF_QW = OFF_BIAS + 2 * 64 * 4, OFF_JLO = OFF_QW + 16, OFF_KEY = OFF_JLO + 2048, OFF_ORD = OFF_KEY + 8192, OFF_HSUM = OFF_ORD + 4096, LDS_BYTES = OFF_HSUM + 256;
constexpr float SKIP_T = 30.f;
typedef unsigned short bf16;
typedef short bf16x8 __attribute__((ext_vector_type(8)));
typedef short s16x4 __attribute__((ext_vector_type(4)));
typedef float f32x16 __attribute__((ext_vector_type(16)));
typedef float f32x4 __attribute__((ext_vector_type(4)));
typedef unsigned u32x4 __attribute__((ext_vector_type(4)));

#define KSWZ(row, colB) ((row) * 256 + ((colB) ^ (((row) & 7) << 4)))
#define SBAR() __builtin_amdgcn_sched_barrier(0)
__device__ __forceinline__ int v_st(int k, int c) { const int kk = (k & ~0xC) | ((k & 4) << 1) | ((k & 8) >> 1); return ((kk >> 3) * 4 + (c >> 5)) * 512 + ((kk & 7) * 32 + (c & 31)) * 2; }
__device__ __forceinline__ int v_rd_base(int lane) { return ((lane & 3) << 3) | (((lane >> 2) & 3) << 6) | (((lane >> 4) & 1) << 5) | (((lane >> 5) & 1) << 8); }
constexpr int v_rd_off(int d0, int ks, int half) { return d0 * 512 + ks * 4096 + half * 2048; }
__device__ __forceinline__ int crow(int r, int hi) { return (r & 3) + 8 * (r >> 2) + 4 * hi; }
__device__ __forceinline__ unsigned cvtpk(float lo, float hi) { unsigned r; asm volatile("v_cvt_pk_bf16_f32 %0, %1, %2" : "=v"(r) : "v"(lo), "v"(hi)); return r; }
__device__ __forceinline__ bf16x8 load8(const bf16* p) { return *reinterpret_cast<const bf16x8*>(p); }
__device__ __forceinline__ void mask_tile(f32x16& p0, f32x16& p1, int dq) {
    const float NEG = -__builtin_inff();
#pragma unroll
    for (int r = 0; r < 16; ++r) {
        const int c = (r & 3) + 8 * (r >> 2);
        if (dq - c < 0) p0[r] = NEG;
        if (dq - c - 32 < 0) p1[r] = NEG;
    }
}
__device__ __forceinline__ void partialSM(f32x16& p0, f32x16& p1, float& m_reg, float& mn, float& alpha) {
    float pmax = p0[0]; for (int r = 1; r < 16; ++r) pmax = fmaxf(pmax, p0[r]); for (int r = 0; r < 16; ++r) pmax = fmaxf(pmax, p1[r]);
    { auto rr = __builtin_amdgcn_permlane32_swap(__float_as_uint(pmax), __float_as_uint(pmax), false, false);
      pmax = fmaxf(__uint_as_float(rr[0]), __uint_as_float(rr[1])); }
    constexpr float C2 = 1.4426950408889634f * SCALE;
    if (__builtin_expect(__all((pmax - m_reg) * SCALE <= THR), 1)) { mn = m_reg; alpha = 1.f; }
    else { mn = fmaxf(m_reg, pmax); alpha = __builtin_amdgcn_exp2f((m_reg - mn) * C2); m_reg = mn; }
    const float mnL = -mn * C2;
    for (int r = 0; r < 16; ++r) p0[r] = fmaf(p0[r], C2, mnL); for (int r = 0; r < 16; ++r) p1[r] = fmaf(p1[r], C2, mnL);
    for (int r = 0; r < 16; ++r) p0[r] = __builtin_amdgcn_exp2f(p0[r]);
}
__device__ __forceinline__ void finishSM(f32x16& p0, f32x16& p1, float alpha, float& l_reg, bf16x8& pa0, bf16x8& pa1, bf16x8& pa2, bf16x8& pa3) {
    for (int r = 0; r < 16; ++r) p1[r] = __builtin_amdgcn_exp2f(p1[r]);
    float ps = 0; for (int r = 0; r < 16; ++r) ps += p0[r]; for (int r = 0; r < 16; ++r) ps += p1[r];
    { auto rr = __builtin_amdgcn_permlane32_swap(__float_as_uint(ps), __float_as_uint(ps), false, false);
      ps = __uint_as_float(rr[0]) + __uint_as_float(rr[1]); }
    l_reg = l_reg * alpha + ps;
#define PK4(P, B_, OUT) do { unsigned a0 = cvtpk(P[B_+0], P[B_+1]), a1 = cvtpk(P[B_+2], P[B_+3]);                          \
        unsigned b0 = cvtpk(P[B_+4], P[B_+5]), b1 = cvtpk(P[B_+6], P[B_+7]);                                             \
        auto r0 = __builtin_amdgcn_permlane32_swap(a0, b0, false, false); auto r1 = __builtin_amdgcn_permlane32_swap(a1, b1, false, false); \
        u32x4 w = {r0[0], r1[0], r0[1], r1[1]}; OUT = *reinterpret_cast<bf16x8*>(&w); } while (0)
    PK4(p0, 0, pa0); PK4(p0, 8, pa1); PK4(p1, 0, pa2); PK4(p1, 8, pa3);
}
template <int KB>
__device__ __forceinline__ void qkt(f32x16& p0, f32x16& p1, const char* K_lds, const char* B_lds, int r32, int hi, const bf16x8* qr) {
    const float* bl = (const float*)B_lds + KB * 64 + 4 * hi;
#pragma unroll
    for (int g = 0; g < 4; ++g) { const f32x4 a = *(const f32x4*)(bl + 8 * g), b = *(const f32x4*)(bl + 32 + 8 * g);
        p0[4 * g + 0] = a[0]; p0[4 * g + 1] = a[1]; p0[4 * g + 2] = a[2]; p0[4 * g + 3] = a[3];
        p1[4 * g + 0] = b[0]; p1[4 * g + 1] = b[1]; p1[4 * g + 2] = b[2]; p1[4 * g + 3] = b[3]; }
    const char* kb[4];
#pragma unroll
    for (int dd = 0; dd < 4; ++dd) kb[dd] = K_lds + KB * SHM_K + KSWZ(r32, (dd * 16 + hi * 8) * 2);
#pragma unroll
    for (int d0 = 0; d0 < 8; ++d0) { const char* a = kb[d0 & 3] + (d0 >> 2) * 128;
        bf16x8 b0 = *reinterpret_cast<const bf16x8*>(a);
        bf16x8 b1 = *reinterpret_cast<const bf16x8*>(a + 32 * 256);
        p0 = __builtin_amdgcn_mfma_f32_32x32x16_bf16(b0, qr[d0], p0, 0, 0, 0);
        p1 = __builtin_amdgcn_mfma_f32_32x32x16_bf16(b1, qr[d0], p1, 0, 0, 0); }
}
template <int VB>
__device__ __forceinline__ void pv_tile(f32x16* o, int vb0, bf16x8 pa0, bf16x8 pa1, bf16x8 pa2, bf16x8 pa3) {
#define TRRD(dst, off) asm volatile("ds_read_b64_tr_b16 %0, %1 offset:%2" : "=&v"(dst) : "v"(vb0), "i"(off) : "memory")
#define PV_D0(d0) do { s16x4 l0, l1, l2, l3, h0, h1, h2, h3; constexpr int b_ = VB * SHM_V + v_rd_off(d0, 0, 0);     \
        TRRD(l0, b_); TRRD(h0, b_ + 2048); TRRD(l1, b_ + 4096); TRRD(h1, b_ + 6144); TRRD(l2, b_ + 8192); TRRD(h2, b_ + 10240); TRRD(l3, b_ + 12288); TRRD(h3, b_ + 14336); \
        asm volatile("s_waitcnt lgkmcnt(0)" ::: "memory"); SBAR();                                                                              \
        o[d0] = __builtin_amdgcn_mfma_f32_32x32x16_bf16((bf16x8){l0[0], l0[1], l0[2], l0[3], h0[0], h0[1], h0[2], h0[3]}, pa0, o[d0], 0, 0, 0);   \
        o[d0] = __builtin_amdgcn_mfma_f32_32x32x16_bf16((bf16x8){l1[0], l1[1], l1[2], l1[3], h1[0], h1[1], h1[2], h1[3]}, pa1, o[d0], 0, 0, 0);   \
        o[d0] = __builtin_amdgcn_mfma_f32_32x32x16_bf16((bf16x8){l2[0], l2[1], l2[2], l2[3], h2[0], h2[1], h2[2], h2[3]}, pa2, o[d0], 0, 0, 0);   \
        o[d0] = __builtin_amdgcn_mfma_f32_32x32x16_bf16((bf16x8){l3[0], l3[1], l3[2], l3[3], h3[0], h3[1], h3[2], h3[3]}, pa3, o[d0], 0, 0, 0); } while (0)
    PV_D0(0); PV_D0(1); PV_D0(2); PV_D0(3);
#undef PV_D0
#undef TRRD
}

struct BlockRef { const bf16* Q; const bf16* K; const bf16* V; const float* C; bf16* O; int P0; int jlo; };
struct Seam {
    bf16x8 qr[8];
    bf16x8 st_v0, st_v1, st_k0, st_k1; float st_b;
};
#define ROW(p, k0, rr) ((p) + (size_t)((k0) + (rr)) * D + sc)
#define VMW() asm volatile("s_waitcnt vmcnt(0)" ::: "memory")
#define VMWN(n) asm volatile("s_waitcnt vmcnt(%0)" :: "i"(n) : "memory")
#define SLOAD_H(Kp, Vp, Cp, k0) do { S.st_v0 = load8(ROW(Vp, k0, sr)); S.st_v1 = load8(ROW(Vp, k0, 32 + sr));              \
                         S.st_k0 = load8(ROW(Kp, k0, sr)); S.st_k1 = load8(ROW(Kp, k0, 32 + sr)); if (tid < 64) S.st_b = (Cp)[(k0) + tid]; } while (0)
#define SWRITE_HK(bf, cr) do { *(bf16x8*)(K_lds + (bf) * SHM_K + kws) = S.st_k0; *(bf16x8*)(K_lds + (bf) * SHM_K + kws + 32 * 256) = S.st_k1; \
                         if (tid < 64) ((float*)B_lds)[(bf) * 64 + tid] = S.st_b - (cr); } while (0)
#define SWRITE_HV(bf) do { *(bf16x8*)(V_lds + (bf) * SHM_V + vst0) = S.st_v0; *(bf16x8*)(V_lds + (bf) * SHM_V + vst1) = S.st_v1; } while (0)
#define SWRITE_H(bf, cr) do { SWRITE_HV(bf); SWRITE_HK(bf, cr); } while (0)
__device__ __forceinline__ void fox_prime(const BlockRef& cur, char* lds, Seam& S) {
    const int tid = mk_tid(), wid = __builtin_amdgcn_readfirstlane(tid >> 6), lane = tid & 63, r32 = lane & 31, hi = lane >> 5;
    const int sr = tid >> 4, sc = (tid & 15) * 8, kws = KSWZ(sr, sc * 2); char* K_lds = lds + 2 * SHM_V; char* B_lds = lds + OFF_BIAS;
    const float cref = __uint_as_float(__builtin_amdgcn_readfirstlane(__float_as_uint(cur.C[cur.P0])));
    for (int d0 = 0; d0 < 8; ++d0) S.qr[d0] = load8(cur.Q + (size_t)(wid * QBLK + r32) * D + d0 * 16 + hi * 8);
    SLOAD_H(cur.K, cur.V, cur.C, cur.jlo * KVBLK); VMW(); SWRITE_HK(0, cref);
    __syncthreads();
}
template <class NextFn> __device__ __forceinline__ BlockRef fox_block(const BlockRef& cur, char* lds, Seam& S, unsigned* qctr, const NextFn& mkref, bool& has_next) {
    const int tid = mk_tid(), wid = __builtin_amdgcn_readfirstlane(tid >> 6), lane = tid & 63, r32 = lane & 31, hi = lane >> 5;
    const int j_lo = cur.jlo, NT = (cur.P0 + QB - 1) / KVBLK + 1 - j_lo;
    unsigned qv = 0u; if (tid == 0) qv = __hip_atomic_fetch_add(qctr, 1u, __ATOMIC_RELAXED, __HIP_MEMORY_SCOPE_AGENT);
    const int qlo = cur.P0 + wid * QBLK, qm = qlo + r32 - 4 * hi;
    char* V_lds = lds; char* K_lds = lds + 2 * SHM_V; char* B_lds = lds + OFF_BIAS;
    float m_reg = -1e30f, l_reg = 0; f32x16 o[4] = {};
    const int sr = tid >> 4, sc = (tid & 15) * 8, vst0 = v_st(sr, sc), vst1 = v_st(32 + sr, sc), kws = KSWZ(sr, sc * 2);
    const int vb0 = (int)(uintptr_t)V_lds + v_rd_base(lane);
    const bf16* Kh = cur.K; const bf16* Vh = cur.V; const float* Ch = cur.C;
    const float cref = __uint_as_float(__builtin_amdgcn_readfirstlane(__float_as_uint(cur.C[cur.P0])));
#define RESC(a) do { if (__any((a) < 1.f)) { for (int d_ = 0; d_ < 4; ++d_) for (int r = 0; r < 16; ++r) o[d_][r] *= (a); } } while (0)
#define KBASE(t) ((j_lo + (t)) * KVBLK)
#define MASKT(P0_, P1_, t) do { const int kb_ = KBASE(t); if (kb_ + KVBLK - 1 > qlo) mask_tile(P0_, P1_, qm - kb_); } while (0)
    constexpr int NQL = 8;
#define SEAM_K0() do { VMWN(NQL); SWRITE_HK(0, crefn); SBAR(); } while (0)
    f32x16 pA0, pA1, pB0, pB1; float mnA, mnB, alA, alB; bf16x8 pa0, pa1, pa2, pa3;
    SWRITE_HV(0); SBAR();
    if (NT > 1) { SLOAD_H(Kh, Vh, Ch, KBASE(1)); }
    SBAR(); qkt<0>(pA0, pA1, K_lds, B_lds, r32, hi, S.qr);
    MASKT(pA0, pA1, 0); partialSM(pA0, pA1, m_reg, mnA, alA);
    if (NT > 1) { VMW(); SWRITE_H(1, cref); }
    if (tid == 0) *(volatile LAS3 unsigned*)(lds + OFF_QW) = qv;
    __syncthreads();
    const unsigned inext = (unsigned)__builtin_amdgcn_readfirstlane((int)*(volatile LAS3 unsigned*)(lds + OFF_QW)); has_next = inext < (unsigned)(NH * (SEQ / QB));
    const BlockRef nxt = has_next ? mkref((int)inext) : cur;
    const float crefn = __uint_as_float(__builtin_amdgcn_readfirstlane(__float_as_uint(nxt.C[nxt.P0]))); const int kbn = nxt.jlo * KVBLK;
#define HALF_STEP(PX0, PX1, mnX, alX, PY0, PY1, alY, t, KB, VB, SB) do {                                                      \
        SBAR(); qkt<KB>(PX0, PX1, K_lds, B_lds, r32, hi, S.qr);                                                               \
        finishSM(PY0, PY1, alY, l_reg, pa0, pa1, pa2, pa3); SBAR();                                                           \
        if ((t) + 1 < NT) { SLOAD_H(Kh, Vh, Ch, KBASE((t) + 1)); SBAR(); }                                                    \
        pv_tile<VB>(o, vb0, pa0, pa1, pa2, pa3); MASKT(PX0, PX1, (t)); partialSM(PX0, PX1, m_reg, mnX, alX);                  \
        __syncthreads();                                                                                                      \
        if ((t) + 1 < NT) { VMW(); SWRITE_H(SB, cref); }                                                                      \
        RESC(alX); __syncthreads(); } while (0)
    for (int t = 1; t + 1 < NT; t += 2) {
        HALF_STEP(pB0, pB1, mnB, alB, pA0, pA1, alA, t, 1, 0, 0);
        HALF_STEP(pA0, pA1, mnA, alA, pB0, pB1, alB, t + 1, 0, 1, 1);
    }
    const bool even = (NT & 1) == 0;
    if (even) { SBAR(); qkt<1>(pB0, pB1, K_lds, B_lds, r32, hi, S.qr); SBAR(); }
    SLOAD_H(nxt.K, nxt.V, nxt.C, kbn); SBAR();
#pragma unroll
    for (int d0 = 0; d0 < 8; ++d0) S.qr[d0] = load8(nxt.Q + (size_t)(wid * QBLK + r32) * D + d0 * 16 + hi * 8);
    SBAR();
    finishSM(pA0, pA1, alA, l_reg, pa0, pa1, pa2, pa3); SBAR();
    pv_tile<0>(o, vb0, pa0, pa1, pa2, pa3);
    if (even) { MASKT(pB0, pB1, NT - 1); partialSM(pB0, pB1, m_reg, mnB, alB); __syncthreads(); RESC(alB);
        finishSM(pB0, pB1, alB, l_reg, pa0, pa1, pa2, pa3); SBAR(); pv_tile<1>(o, vb0, pa0, pa1, pa2, pa3); }
    SBAR(); SEAM_K0();
    {
        const float rl = __builtin_amdgcn_rcpf(l_reg);
        bf16* Ow = cur.O + (size_t)(wid * QBLK + r32) * OPITCH + 8 * hi;
#pragma unroll
        for (int d0 = 0; d0 < 4; ++d0)
#pragma unroll
            for (int gp = 0; gp < 2; ++gp) { const int b_ = 8 * gp;
                const unsigned a0 = cvtpk(o[d0][b_ + 0] * rl, o[d0][b_ + 1] * rl), a1 = cvtpk(o[d0][b_ + 2] * rl, o[d0][b_ + 3] * rl);
                const unsigned b0 = cvtpk(o[d0][b_ + 4] * rl, o[d0][b_ + 5] * rl), b1 = cvtpk(o[d0][b_ + 6] * rl, o[d0][b_ + 7] * rl);
                auto r0 = __builtin_amdgcn_permlane32_swap(a0, b0, false, false); auto r1 = __builtin_amdgcn_permlane32_swap(a1, b1, false, false);
                u32x4 w = {r0[0], r1[0], r0[1], r1[1]}; *(u32x4*)(Ow + d0 * 32 + 16 * gp) = w; }
    }
    __syncthreads();
    return nxt;
#undef RESC
#undef KBASE
#undef MASKT
#undef SEAM_K0
#undef HALF_STEP
}
#undef ROW
#undef VMW
#undef VMWN
#undef SLOAD_H
#undef SWRITE_HK
#undef SWRITE_HV
#undef SWRITE_H
#undef PK4

__device__ __forceinline__ BlockRef fox_ref(int item, const bf16* Q, const bf16* K, const bf16* V, const float* Cn, bf16* O, const char* lds) {
    const int e = (int)((const unsigned short*)(lds + OFF_ORD))[item], qb = e & 63, bh = e >> 6;
    BlockRef r; r.Q = Q + ((size_t)bh * SEQ + (size_t)qb * QB) * D; r.K = K + (size_t)bh * SEQ * D; r.V = V + (size_t)bh * SEQ * D; r.C = Cn + (size_t)bh * SEQ;
    r.O = O + (size_t)(qb * QB) * OPITCH + bh * D; r.P0 = qb * QB; r.jlo = (int)((const unsigned char*)(lds + OFF_JLO))[bh * 64 + qb]; return r;
}
__device__ __forceinline__ void fox_attn_phase(char* lds, const bf16* Q, const bf16* K, const bf16* V, const float* Cn, const unsigned* nrm2, unsigned* qctr, bf16* O) {
    const int tid = mk_tid();
    {
        int lo[4], hi[4]; float thr[4]; const float* Cb[4];
#pragma unroll
        for (int k = 0; k < 4; ++k) { const int e = tid + 512 * k, bh = e >> 6, qb = e & 63, P0 = qb * QB; Cb[k] = Cn + (size_t)bh * SEQ;
            const float qn2 = __uint_as_float(nrm2[bh]), kn2 = __uint_as_float(nrm2[32 + bh]);
            const float Dh = SKIP_T * (1.0f / SCALE) + 2.04f * sqrtf(qn2 * kn2) + 1.0f;
            thr[k] = Cb[k][P0] - Dh; lo[k] = 0; hi[k] = P0 / KVBLK; }
#pragma unroll 1
        for (int it = 0; it < 8; ++it) {
            float v[4]; int mid[4];
#pragma unroll
            for (int k = 0; k < 4; ++k) { mid[k] = (lo[k] + hi[k]) >> 1; v[k] = Cb[k][mid[k] * KVBLK + KVBLK - 1]; }
#pragma unroll
            for (int k = 0; k < 4; ++k) if (lo[k] < hi[k]) { if (v[k] < thr[k]) lo[k] = mid[k] + 1; else hi[k] = mid[k]; }
        }
#pragma unroll
        for (int k = 0; k < 4; ++k) ((unsigned char*)(lds + OFF_JLO))[tid + 512 * k] = (unsigned char)lo[k];
        unsigned* hsum = (unsigned*)(lds + OFF_HSUM);
        if (tid < 64) hsum[tid] = 0u;
        __syncthreads();
#pragma unroll
        for (int k = 0; k < 4; ++k) { const int e = tid + 512 * k; atomicAdd(&hsum[e >> 6], (unsigned)(4 * (e & 63) + 4 - lo[k])); }
        __syncthreads();
        if (tid < 32) { const unsigned mine = hsum[tid] * 32u + (unsigned)(31 - tid); unsigned r = 0u; for (int h2 = 0; h2 < 32; ++h2) r += (hsum[h2] * 32u + (unsigned)(31 - h2)) > mine ? 1u : 0u; hsum[32 + tid] = 7u - (r >> 2); }
        __syncthreads();
        unsigned key[4];
#pragma unroll
        for (int k = 0; k < 4; ++k) { const int e = tid + 512 * k, qb = e & 63; key[k] = (hsum[32 + (e >> 6)] << 20) + (unsigned)(4 * qb + 4 - lo[k]) * 2048u + (unsigned)(2047 - e); ((unsigned*)(lds + OFF_KEY))[e] = key[k]; }
        __syncthreads();
        unsigned rank[4] = {0u, 0u, 0u, 0u};
#pragma unroll 4
        for (int j = 0; j < 512; ++j) { const u32x4 kv = ((const u32x4*)(lds + OFF_KEY))[j];
#pragma unroll
            for (int k = 0; k < 4; ++k) rank[k] += (kv.x > key[k] ? 1u : 0u) + (kv.y > key[k] ? 1u : 0u) + (kv.z > key[k] ? 1u : 0u) + (kv.w > key[k] ? 1u : 0u); }
#pragma unroll
        for (int k = 0; k < 4; ++k) ((unsigned short*)(lds + OFF_ORD))[rank[k]] = (unsigned short)(tid + 512 * k);
    }
    if (tid == 0) *(volatile LAS3 unsigned*)(lds + OFF_QW) = __hip_atomic_fetch_add(qctr, 1u, __ATOMIC_RELAXED, __HIP_MEMORY_SCOPE_AGENT);
    __syncthreads();
    const unsigned i0 = (unsigned)__builtin_amdgcn_readfirstlane((int)*(volatile LAS3 unsigned*)(lds + OFF_QW));
    if (i0 >= (unsigned)(NH * (SEQ / QB))) return;
    __syncthreads();
    auto mk = [=](int item) { return fox_ref(item, Q, K, V, Cn, O, lds); };
    BlockRef cur = mk((int)i0);
    Seam S;
    fox_prime(cur, lds, S);
    for (;;) { bool has_next; const BlockRef nxt = fox_block(cur, lds, S, qctr, mk, has_next); if (!has_next) break; cur = nxt; }
}
#undef LAS3
#undef KSWZ
#undef SBAR
}

namespace swa {
constexpr int SEQ = 16384, QKVP = 5120, OP = 4096;
constexpr int K_OFF = 0, VT_OFF = 32768, VT_PITCH = 528, LI_OFF = VT_OFF + 64 * VT_PITCH, LDS_BYTES = LI_OFF + 8 * 32 * 4;
typedef unsigned short bf16;
typedef short bf16x8 __attribute__((ext_vector_type(8)));
typedef float f32x16 __attribute__((ext_vector_type(16)));
typedef float f32x4 __attribute__((ext_vector_type(4)));
typedef unsigned u32x4 __attribute__((ext_vector_type(4)));
__device__ __forceinline__ int crow(int r, int hi) { return (r & 3) + 8 * (r >> 2) + 4 * hi; }
__device__ __forceinline__ unsigned cvtpk(float lo, float hi) { unsigned r; asm volatile("v_cvt_pk_bf16_f32 %0, %1, %2" : "=v"(r) : "v"(lo), "v"(hi)); return r; }
__device__ __forceinline__ float bf2f(short b) { return __uint_as_float(((unsigned)(unsigned short)b) << 16); }
__device__ __forceinline__ bf16x8 pack8(const float* v) { u32x4 w = {cvtpk(v[0], v[1]), cvtpk(v[2], v[3]), cvtpk(v[4], v[5]), cvtpk(v[6], v[7])}; return *reinterpret_cast<bf16x8*>(&w); }
#define SWA_PK4(P, B_, OUT) do { unsigned a0 = cvtpk(P[B_+0], P[B_+1]), a1 = cvtpk(P[B_+2], P[B_+3]);                          \
        unsigned b0 = cvtpk(P[B_+4], P[B_+5]), b1 = cvtpk(P[B_+6], P[B_+7]);                                             \
        auto r0 = __builtin_amdgcn_permlane32_swap(a0, b0, false, false); auto r1 = __builtin_amdgcn_permlane32_swap(a1, b1, false, false); \
        u32x4 w = {r0[0], r1[0], r0[1], r1[1]}; OUT = *reinterpret_cast<bf16x8*>(&w); } while (0)

__device__ __forceinline__ void swa_attn_phase(char* lds, const bf16* QKV, const float* sinks, const float* cosT, const float* sinT, bf16* O, int wg, int G) {
    const int tid = mk_tid(), wid = __builtin_amdgcn_readfirstlane(tid >> 6), lane = tid & 63, r32 = lane & 31, hi = lane >> 5;
    for (int L = wg; L < 1024; L += G) {
        const int g = L & 7, n = L >> 3;
        __syncthreads();
        {
            const int row = tid >> 1, half = tid & 1, kpos = 128 * (n - 1) + row;
            bf16x8 kc[4], vc[4];
            if (kpos >= 0) {
                const bf16* kp = QKV + (size_t)kpos * QKVP + 4096 + g * 64 + half * 32; const bf16* vp = kp + 512;
#pragma unroll
                for (int c = 0; c < 4; ++c) { kc[c] = *(const bf16x8*)(kp + 8 * c); vc[c] = *(const bf16x8*)(vp + 8 * c); }
                if (half == 0) {
                    const f32x4 c0 = *(const f32x4*)(cosT + (size_t)kpos * 8), c1 = *(const f32x4*)(cosT + (size_t)kpos * 8 + 4);
                    const f32x4 s0 = *(const f32x4*)(sinT + (size_t)kpos * 8), s1 = *(const f32x4*)(sinT + (size_t)kpos * 8 + 4);
                    float o1[8], o2[8];
#pragma unroll
                    for (int i = 0; i < 8; ++i) { const float cs = i < 4 ? c0[i & 3] : c1[i & 3], sn = i < 4 ? s0[i & 3] : s1[i & 3];
                        const float x1 = bf2f(kc[0][i]), x2 = bf2f(kc[1][i]); o1[i] = x1 * cs - x2 * sn; o2[i] = x2 * cs + x1 * sn; }
                    kc[0] = pack8(o1); kc[1] = pack8(o2);
                }
            } else {
#pragma unroll
                for (int c = 0; c < 4; ++c) { kc[c] = (bf16x8){0, 0, 0, 0, 0, 0, 0, 0}; vc[c] = (bf16x8){0, 0, 0, 0, 0, 0, 0, 0}; }
            }
#pragma unroll
            for (int c = 0; c < 4; ++c) { const int chunk = half * 4 + c;
                *(bf16x8*)(lds + K_OFF + row * 128 + ((chunk ^ ((row >> 1) & 7)) << 4)) = kc[c];
#pragma unroll
                for (int j = 0; j < 8; ++j) *(short*)(lds + VT_OFF + (half * 32 + c * 8 + j) * VT_PITCH + row * 2) = vc[c][j]; }
        }
        __syncthreads();
        const int hq = g * 8 + wid; const float sink = sinks[hq];
        for (int a = 0; a < 4; ++a) {
            const int t = 128 * n + 32 * a + r32;
            const bf16* qp = QKV + (size_t)t * QKVP + hq * 64;
            bf16x8 qr[4];
#pragma unroll
            for (int d0 = 0; d0 < 4; ++d0) qr[d0] = *(const bf16x8*)(qp + 16 * d0 + 8 * hi);
            {
                const bf16x8 pr = *(const bf16x8*)(qp + 8 * (1 - hi));
                const f32x4 c0 = *(const f32x4*)(cosT + (size_t)t * 8), c1 = *(const f32x4*)(cosT + (size_t)t * 8 + 4);
                const f32x4 s0 = *(const f32x4*)(sinT + (size_t)t * 8), s1 = *(const f32x4*)(sinT + (size_t)t * 8 + 4);
                float ov[8];
#pragma unroll
                for (int i = 0; i < 8; ++i) { const float cs = i < 4 ? c0[i & 3] : c1[i & 3], sn = i < 4 ? s0[i & 3] : s1[i & 3];
                    const float own = bf2f(qr[0][i]), par = bf2f(pr[i]); ov[i] = own * cs + (hi ? par : -par) * sn; }
                qr[0] = pack8(ov);
            }
            f32x16 p[5];
#pragma unroll
            for (int bi = 0; bi < 5; ++bi) { const int row = 32 * (a + bi) + r32; const char* kb = lds + K_OFF + row * 128; const int sw = (row >> 1) & 7;
                f32x16 acc = {};
#pragma unroll
                for (int d0 = 0; d0 < 4; ++d0) { const bf16x8 kf = *(const bf16x8*)(kb + (((2 * d0 + hi) ^ sw) << 4)); acc = __builtin_amdgcn_mfma_f32_32x32x16_bf16(kf, qr[d0], acc, 0, 0, 0); }
                p[bi] = acc; }
            const float NEG = -__builtin_inff();
#pragma unroll
            for (int r = 0; r < 16; ++r) { const int c = crow(r, hi); if (!(c > r32)) p[0][r] = NEG; if (!(c <= r32)) p[4][r] = NEG; }
            if (n == 0) {
#pragma unroll
                for (int bi = 0; bi < 4; ++bi) if (a + bi < 4) {
#pragma unroll
                    for (int r = 0; r < 16; ++r) p[bi][r] = NEG; }
            }
            float mx = NEG;
#pragma unroll
            for (int bi = 0; bi < 5; ++bi)
#pragma unroll
                for (int r = 0; r < 16; ++r) mx = fmaxf(mx, p[bi][r]);
            { auto rr = __builtin_amdgcn_permlane32_swap(__float_as_uint(mx), __float_as_uint(mx), false, false); mx = fmaxf(__uint_as_float(rr[0]), __uint_as_float(rr[1])); }
            const float m = fmaxf(mx * 0.125f, sink);
            constexpr float LOG2E = 1.4426950408889634f, C2 = 0.125f * LOG2E;
            const float mL = -m * LOG2E;
            float ps = 0.f;
#pragma unroll
            for (int bi = 0; bi < 5; ++bi)
#pragma unroll
                for (int r = 0; r < 16; ++r) { const float e = __builtin_amdgcn_exp2f(fmaf(p[bi][r], C2, mL)); p[bi][r] = e; ps += e; }
            { auto rr = __builtin_amdgcn_permlane32_swap(__float_as_uint(ps), __float_as_uint(ps), false, false); ps = __uint_as_float(rr[0]) + __uint_as_float(rr[1]); }
            const float l = ps + __builtin_amdgcn_exp2f(fmaf(sink, LOG2E, mL));
            f32x16 o[2] = {};
#pragma unroll
            for (int bi = 0; bi < 5; ++bi) { bf16x8 pa[2]; SWA_PK4(p[bi], 0, pa[0]); SWA_PK4(p[bi], 8, pa[1]);
#pragma unroll
                for (int ks = 0; ks < 2; ++ks)
#pragma unroll
                    for (int db = 0; db < 2; ++db) { const bf16x8 vf = *(const bf16x8*)(lds + VT_OFF + (32 * db + r32) * VT_PITCH + (32 * (a + bi) + 16 * ks + 8 * hi) * 2);
                        o[db] = __builtin_amdgcn_mfma_f32_32x32x16_bf16(vf, pa[ks], o[db], 0, 0, 0); } }
            const float rl = __builtin_amdgcn_rcpf(l);
            bf16* Ow = O + (size_t)(128 * n + 32 * a + r32) * OP + hq * 64 + 8 * hi;
#pragma unroll
            for (int db = 0; db < 2; ++db)
#pragma unroll
                for (int gp = 0; gp < 2; ++gp) { const int b_ = 8 * gp;
                    const unsigned a0 = cvtpk(o[db][b_ + 0] * rl, o[db][b_ + 1] * rl), a1 = cvtpk(o[db][b_ + 2] * rl, o[db][b_ + 3] * rl);
                    const unsigned b0 = cvtpk(o[db][b_ + 4] * rl, o[db][b_ + 5] * rl), b1 = cvtpk(o[db][b_ + 6] * rl, o[db][b_ + 7] * rl);
                    auto r0 = __builtin_amdgcn_permlane32_swap(a0, b0, false, false); auto r1 = __builtin_amdgcn_permlane32_swap(a1, b1, false, false);
                    u32x4 w = {r0[0], r1[0], r0[1], r1[1]}; *(u32x4*)(Ow + db * 32 + 16 * gp) = w; }
        }
    }
    __syncthreads();
}
#undef SWA_PK4
}

#define LAS __attribute__((address_space(3)))
#define GAS __attribute__((address_space(1)))
typedef unsigned short bf16;
typedef float f32x4 __attribute__((ext_vector_type(4)));
typedef unsigned u32x4 __attribute__((ext_vector_type(4)));
typedef unsigned u32x2 __attribute__((ext_vector_type(2)));
typedef short bf16x8 __attribute__((ext_vector_type(8)));
constexpr int SEQ = 16384, DM = 4096, DFF = 11008;
constexpr float NORM_EPS = 1e-6f;
__device__ __forceinline__ unsigned cvtpk(float lo, float hi) { unsigned r; asm volatile("v_cvt_pk_bf16_f32 %0, %1, %2" : "=v"(r) : "v"(lo), "v"(hi)); return r; }
__device__ __forceinline__ float bf_lo(unsigned w) { return __uint_as_float(w << 16); }
__device__ __forceinline__ float bf_hi(unsigned w) { return __uint_as_float(w & 0xffff0000u); }
__device__ __forceinline__ float wave_sum(float v) {
#pragma unroll
    for (int o = 1; o < 64; o <<= 1) v += __shfl_xor(v, o);
    return v;
}
__device__ __forceinline__ float gelu_tanh(float x) {
    const float u = 0.7978845608028654f * (x + 0.044715f * x * x * x);
    return x * __builtin_amdgcn_rcpf(1.0f + __builtin_amdgcn_exp2f(-2.8853900817779268f * u));
}
__device__ __forceinline__ void sincos_d(double a, double& s, double& c) {
    const double k = rint(a * 0.15915494309189535);
    double r = fma(-k, 6.283185307179586, a); r = fma(-k, 2.4492935982947064e-16, r);
    const double r2 = r * r; double ss = 1.0, cc = 1.0;
#pragma unroll
    for (int n = 29; n >= 3; n -= 2) ss = fma(-ss * r2, 1.0 / (double)(n * (n - 1)), 1.0);
#pragma unroll
    for (int n = 28; n >= 2; n -= 2) cc = fma(-cc * r2, 1.0 / (double)(n * (n - 1)), 1.0);
    s = r * ss; c = cc;
}
__device__ __forceinline__ double exp_d(double x) {
    const double k = rint(x * 1.4426950408889634);
    double r = fma(-k, 0.6931471803691238, x); r = fma(-k, 1.9082149292705877e-10, r);
    double p = 1.0;
#pragma unroll
    for (int n = 16; n >= 1; --n) p = fma(p * r, 1.0 / (double)n, 1.0);
    return ldexp(p, (int)k);
}

__device__ __forceinline__ void transpose_item(const float* __restrict__ W, int K, int N, bf16* __restrict__ WT, int mode, LAS unsigned* scr, int item, int lane) {
    const int nblk = (N + 63) / 64, kb = item / nblk, nb = item - kb * nblk, k0 = 128 * kb, n0 = 64 * nb;
    int r0 = n0; if (mode == 1) { const int bj = n0 >> 12, rem = n0 & 4095; r0 = ((rem >> 7) << 8) + (bj << 7) + (rem & 127); }
    if (mode == 2) { const int bj = n0 >= DFF ? 1 : 0, rem = n0 - bj * DFF; r0 = ((rem >> 7) << 8) + (bj << 7) + (rem & 127); }
    const int c = lane & 15, kq = lane >> 4;
    const bool ok = n0 + 4 * c < N;
    const float* src = W + (size_t)(k0 + 2 * kq) * N + n0 + 4 * c;
    LAS unsigned* sw = scr + (4 * c) * 65 + kq;
#pragma unroll
    for (int half = 0; half < 2; ++half) {
        f32x4 a[8], b[8]; const f32x4 z = {0.f, 0.f, 0.f, 0.f};
#pragma unroll
        for (int p = 0; p < 8; ++p) { const float* s = src + (size_t)(8 * (8 * half + p)) * N;
            a[p] = ok ? __builtin_nontemporal_load((const f32x4*)s) : z; b[p] = ok ? __builtin_nontemporal_load((const f32x4*)(s + N)) : z; }
#pragma unroll
        for (int p = 0; p < 8; ++p)
#pragma unroll
            for (int q = 0; q < 4; ++q) sw[q * 65 + 4 * (8 * half + p)] = cvtpk(a[p][q], b[p][q]);
    }
    asm volatile("s_waitcnt lgkmcnt(0)" ::: "memory");
#pragma unroll
    for (int j = 0; j < 16; ++j) { const int n = 4 * j + kq; const LAS unsigned* s = scr + n * 65 + 4 * c;
        u32x4 o; o.x = s[0]; o.y = s[1]; o.z = s[2]; o.w = s[3];
        if (n0 + n < N) *(u32x4*)(WT + (size_t)(r0 + n) * K + k0 + 8 * c) = o; }
    asm volatile("s_waitcnt lgkmcnt(0)" ::: "memory");
}

struct HPlanes { unsigned char* hi; unsigned char* lo; };
template <int HIN, int HOUT>
__device__ __forceinline__ void norm_phase(int gw, int ngw, int lane, LAS unsigned char* stg, const bf16* tmp, const float* gpost, const float* hin, float* hout, HPlanes hp, const float* gpre, bf16* xn, bf16* U, float tscale = 1.0f) {
    LAS unsigned char* sA = stg;
    for (int m = gw; m < SEQ; m += ngw) {
        f32x4 h[16];
        u32x4 tq[8]; float ss = 0.f;
        if (tmp) { const u32x4* tr = (const u32x4*)(tmp + (size_t)m * DM) + lane;
#pragma unroll
            for (int j = 0; j < 8; ++j) tq[j] = __builtin_nontemporal_load(tr + 64 * j); }
        if constexpr (HIN == 0) {
            const f32x4* hr = (const f32x4*)(hin + (size_t)m * DM) + lane;
#pragma unroll
            for (int j = 0; j < 16; ++j) h[j] = __builtin_nontemporal_load(hr + 64 * j);
        } else {
            const u32x4* hr = (const u32x4*)(hp.hi + (size_t)m * 8192) + lane; const u32x4* lr = (const u32x4*)(hp.lo + (size_t)m * 2048) + lane; u32x4 hq[8], lq[2];
#pragma unroll
            for (int i = 0; i < 8; ++i) hq[i] = __builtin_nontemporal_load(hr + 64 * i);
#pragma unroll
            for (int c = 0; c < 2; ++c) lq[c] = __builtin_nontemporal_load(lr + 64 * c);
#pragma unroll
            for (int j = 0; j < 16; ++j) { const unsigned w0 = hq[j >> 1][2 * (j & 1)], w1 = hq[j >> 1][2 * (j & 1) + 1], lw = lq[j >> 3][(j >> 1) & 3]; const int sh = 16 * (j & 1);
                h[j] = (f32x4){__uint_as_float((w0 << 16) | (((lw >> sh) & 15u) << 12)), __uint_as_float((w0 & 0xffff0000u) | (((lw >> (sh + 4)) & 15u) << 12)),
                               __uint_as_float((w1 << 16) | (((lw >> (sh + 8)) & 15u) << 12)), __uint_as_float((w1 & 0xffff0000u) | (((lw >> (sh + 12)) & 15u) << 12))}; }
        }
        if (tmp) {
#pragma unroll
            for (int j = 0; j < 8; ++j) {
#pragma unroll
                for (int q = 0; q < 4; ++q) { const float a = bf_lo(tq[j][q]), b = bf_hi(tq[j][q]); ss += a * a + b * b; }
                *(LAS u32x4*)(sA + 1024 * j + 16 * lane) = tq[j]; }
            asm volatile("" ::: "memory");
            const float r = tscale / sqrtf(wave_sum(ss) * (1.0f / DM) + NORM_EPS);
            const f32x4* gp = (const f32x4*)gpost + lane; asm volatile("" : "+v"(gp));
#pragma unroll
            for (int j = 0; j < 16; ++j) { const u32x2 w = *(const LAS u32x2*)(sA + 512 * j + 8 * lane); const f32x4 t = {bf_lo(w.x), bf_hi(w.x), bf_lo(w.y), bf_hi(w.y)};
                h[j] = h[j] + (t * r) * gp[64 * j]; }
            asm volatile("" ::: "memory");
            if constexpr (HOUT == 0) { f32x4* ho = (f32x4*)(hout + (size_t)m * DM) + lane;
#pragma unroll
                for (int j = 0; j < 16; ++j) __builtin_nontemporal_store(h[j], ho + 64 * j); }
            if constexpr (HOUT == 1) {
                u32x4* ho = (u32x4*)(hp.hi + (size_t)m * 8192) + lane; u32x4* lo = (u32x4*)(hp.lo + (size_t)m * 2048) + lane; u32x4 lq[2];
#pragma unroll
                for (int i = 0; i < 8; ++i) { u32x4 o; unsigned lw = 0u;
#pragma unroll
                    for (int jj = 0; jj < 2; ++jj) { const int j = 2 * i + jj;
                        const unsigned b0 = __float_as_uint(h[j].x) + 0x800u, b1 = __float_as_uint(h[j].y) + 0x800u, b2 = __float_as_uint(h[j].z) + 0x800u, b3 = __float_as_uint(h[j].w) + 0x800u;
                        o[2 * jj] = __builtin_amdgcn_perm(b1, b0, 0x07060302u); o[2 * jj + 1] = __builtin_amdgcn_perm(b3, b2, 0x07060302u);
                        lw |= (((b0 >> 12) & 15u) | (((b1 >> 12) & 15u) << 4) | (((b2 >> 12) & 15u) << 8) | (((b3 >> 12) & 15u) << 12)) << (16 * jj); }
                    __builtin_nontemporal_store(o, ho + 64 * i); lq[i >> 2][i & 3] = lw; }
#pragma unroll
                for (int c = 0; c < 2; ++c) __builtin_nontemporal_store(lq[c], lo + 64 * c); }
        }
        if (gpre) {
            float s2 = 0.f;
#pragma unroll
            for (int j = 0; j < 16; ++j) s2 += (h[j].x * h[j].x + h[j].y * h[j].y) + (h[j].z * h[j].z + h[j].w * h[j].w);
            const float r = 1.0f / sqrtf(wave_sum(s2) * (1.0f / DM) + NORM_EPS);
            const f32x4* gp = (const f32x4*)gpre + lane; asm volatile("" : "+v"(gp));
            if (xn) { u32x4* o16 = (u32x4*)(xn + (size_t)m * DM) + lane;
                asm volatile("" ::: "memory");
#pragma unroll
                for (int j = 0; j < 16; ++j) { const f32x4 v = (h[j] * r) * gp[64 * j]; u32x2 w; w.x = cvtpk(v.x, v.y); w.y = cvtpk(v.z, v.w); *(LAS u32x2*)(sA + 512 * j + 8 * lane) = w; }
                asm volatile("" ::: "memory");
#pragma unroll
                for (int j = 0; j < 8; ++j) o16[64 * j] = *(const LAS u32x4*)(sA + 1024 * j + 16 * lane);
                asm volatile("" ::: "memory"); }
            if (U) {
#pragma unroll
                for (int j = 0; j < 16; ++j) { const f32x4 v = (h[j] * r) * gp[64 * j]; u32x2 w; w.x = cvtpk(v.x, v.y); w.y = cvtpk(v.z, v.w);
                    *(u32x2*)(U + ((size_t)((lane >> 2) + 16 * j) * SEQ + m) * 16 + 4 * (lane & 3)) = w; } }
        }
    }
}

__device__ __forceinline__ void fox_cumsum_phase(char* lds, const float* __restrict__ logf, float* __restrict__ cneg, int wg, int G, int tid) {
    double* wtot = (double*)lds; const int lane = tid & 63, wid = tid >> 6;
    for (int h = wg; h < 32; h += G) {
        float v[32]; double s = 0.0;
#pragma unroll
        for (int j = 0; j < 32; ++j) { v[j] = logf[(size_t)(32 * tid + j) * 32 + h]; s += (double)v[j]; }
        double inc = s;
#pragma unroll
        for (int o = 1; o < 64; o <<= 1) { const double t = __shfl_up(inc, o); if (lane >= o) inc += t; }
        __syncthreads();
        if (lane == 63) wtot[wid] = inc;
        __syncthreads();
        double run = inc - s;
#pragma unroll
        for (int w = 0; w < 8; ++w) if (w < wid) run += wtot[w];
#pragma unroll
        for (int j = 0; j < 32; ++j) { run += (double)v[j]; cneg[(size_t)h * SEQ + 32 * tid + j] = (float)(-run * 11.313708498984761); }
    }
}

__device__ __forceinline__ void fox_norms_phase(const bf16* __restrict__ QK, unsigned* nrm2, int gw, int ngw, int lane) {
    for (int base = gw * 128; base < 64 * SEQ; base += ngw * 128) {
        const u32x4* p = (const u32x4*)(QK + (size_t)base * 128) + lane; float mx = 0.f;
#pragma unroll 8
        for (int i = 0; i < 32; ++i) { const u32x4 w = p[(size_t)i * 64]; float s = 0.f;
#pragma unroll
            for (int q = 0; q < 4; ++q) { const float a = bf_lo(w[q]), b = bf_hi(w[q]); s = fmaf(a, a, s); s = fmaf(b, b, s); }
            s += __shfl_xor(s, 1); s += __shfl_xor(s, 2); s += __shfl_xor(s, 4); s += __shfl_xor(s, 8); mx = fmaxf(mx, s); }
        mx = fmaxf(mx, __shfl_xor(mx, 16)); mx = fmaxf(mx, __shfl_xor(mx, 32));
        if (lane == 0) __hip_atomic_fetch_max(nrm2 + base / SEQ, __float_as_uint(mx), __ATOMIC_RELAXED, __HIP_MEMORY_SCOPE_AGENT);
    }
}

namespace s5 {
typedef float f32x16 __attribute__((ext_vector_type(16)));
constexpr int NG = 256, SEGL = 2048, XP = 272, WAVE_BYTES = 2048 + 32 * XP, E_OFF = 8 * WAVE_BYTES, LDS_BYTES = E_OFF + 8 * 128 * 4;
__device__ __forceinline__ bf16x8 pack8(f32x4 a, f32x4 b) { u32x4 w = {cvtpk(a[0], a[1]), cvtpk(a[2], a[3]), cvtpk(b[0], b[1]), cvtpk(b[2], b[3])}; return *reinterpret_cast<bf16x8*>(&w); }
__device__ __forceinline__ void state_consts(float lam_re_raw, float lam_im_raw, double dt, double& lbr, double& lbi, double& cfr, double& cfi, double& lre_o, double& lim_o) {
    const double lre = (double)fminf(lam_re_raw, -1e-4f), lim = (double)lam_im_raw; double sn, cs; sincos_d(lim * dt, sn, cs); const double er = exp_d(lre * dt);
    lbr = er * cs; lbi = er * sn; const double a = lbr - 1.0, b = lbi, den = 1.0 / (lre * lre + lim * lim); cfr = (a * lre + b * lim) * den; cfi = (b * lre - a * lim) * den; lre_o = lre; lim_o = lim;
}
__device__ __forceinline__ void s5_phase(char* lds, const bf16* __restrict__ U, const float* __restrict__ lam_re, const float* __restrict__ lam_im, const float* __restrict__ log_dt,
                                         const float* __restrict__ b_re, const float* __restrict__ b_im, const float* __restrict__ c_re, const float* __restrict__ c_im,
                                         const float* __restrict__ dskip, bf16* __restrict__ Gout, int wg, int G) {
    const int tid = mk_tid(), wid = __builtin_amdgcn_readfirstlane(tid >> 6), lane = tid & 63, r32 = lane & 31, hi = lane >> 5, l15 = lane & 15, q4 = lane >> 4;
    float* ublk = (float*)(lds + wid * WAVE_BYTES); char* xblk = lds + wid * WAVE_BYTES + 2048; float* Ebuf = (float*)(lds + E_OFF);
    for (int g = wg; g < NG; g += G) {
        float lr, li, l2r, l2i; bf16x8 Bf[4], Cf[4]; const float dsk = dskip[16 * g + l15];
        {
            const double dt = exp_d((double)log_dt[g]);
            { double lbr, lbi, cfr, cfi, lre, lim; state_consts(lam_re[g * 64 + lane], lam_im[g * 64 + lane], dt, lbr, lbi, cfr, cfi, lre, lim); lr = (float)lbr; li = (float)lbi;
              double sn2, cs2; sincos_d(lim * dt * (double)SEGL, sn2, cs2); const double e2 = exp_d(lre * dt * (double)SEGL); l2r = (float)(e2 * cs2); l2i = (float)(e2 * sn2); }
#pragma unroll
            for (int sb = 0; sb < 2; ++sb) { const int st = 32 * sb + r32; double lbr, lbi, cfr, cfi, lre, lim; state_consts(lam_re[g * 64 + st], lam_im[g * 64 + st], dt, lbr, lbi, cfr, cfi, lre, lim);
                const f32x4* br = (const f32x4*)(b_re + ((size_t)g * 64 + st) * 16 + 8 * hi); const f32x4* bi = (const f32x4*)(b_im + ((size_t)g * 64 + st) * 16 + 8 * hi);
                const f32x4 vr0 = br[0], vr1 = br[1], vi0 = bi[0], vi1 = bi[1]; f32x4 or0, or1, oi0, oi1;
#pragma unroll
                for (int i = 0; i < 4; ++i) { or0[i] = (float)(cfr * (double)vr0[i] - cfi * (double)vi0[i]); or1[i] = (float)(cfr * (double)vr1[i] - cfi * (double)vi1[i]);
                                              oi0[i] = (float)(cfr * (double)vi0[i] + cfi * (double)vr0[i]); oi1[i] = (float)(cfr * (double)vi1[i] + cfi * (double)vr1[i]); }
                Bf[sb] = pack8(or0, or1); Bf[2 + sb] = pack8(oi0, oi1); }
#pragma unroll
            for (int kk = 0; kk < 4; ++kk) { const float* cp = (kk < 2 ? c_re : c_im) + ((size_t)g * 16 + l15) * 64 + 32 * (kk & 1) + 8 * q4; const float sg = kk < 2 ? 1.f : -1.f;
                const f32x4 v0 = *(const f32x4*)cp, v1 = *(const f32x4*)(cp + 4); Cf[kk] = pack8(v0 * sg, v1 * sg); }
        }
        const bf16* Ug = U + ((size_t)g * SEQ + (size_t)wid * SEGL) * 16;
        float xr = 0.f, xi = 0.f;
#pragma unroll 1
        for (int pass = 0; pass < 2; ++pass) {
#define S5_ULOAD(d0, d1, blk_) do { const u32x4 ub_ = *(const u32x4*)(Ug + ((size_t)(blk_) * 32 + r32) * 16 + 8 * hi);                                                     \
                d0 = (f32x4){bf_lo(ub_.x), bf_hi(ub_.x), bf_lo(ub_.y), bf_hi(ub_.y)}; d1 = (f32x4){bf_lo(ub_.z), bf_hi(ub_.z), bf_lo(ub_.w), bf_hi(ub_.w)}; } while (0)
            f32x4 ua0, ua1; S5_ULOAD(ua0, ua1, 0);
#pragma unroll 1
            for (int blk = 0; blk < SEGL / 32; ++blk) {
                f32x4 un0 = ua0, un1 = ua1;
                if (blk + 1 < SEGL / 32) S5_ULOAD(un0, un1, blk + 1);
                const bf16x8 af = pack8(ua0, ua1);
                if (pass) { *(f32x4*)(ublk + r32 * 16 + 8 * hi) = ua0; *(f32x4*)(ublk + r32 * 16 + 8 * hi + 4) = ua1; }
                f32x16 a0 = {}, a1 = {}, a2 = {}, a3 = {};
                a0 = __builtin_amdgcn_mfma_f32_32x32x16_bf16(af, Bf[0], a0, 0, 0, 0); a1 = __builtin_amdgcn_mfma_f32_32x32x16_bf16(af, Bf[1], a1, 0, 0, 0);
                a2 = __builtin_amdgcn_mfma_f32_32x32x16_bf16(af, Bf[2], a2, 0, 0, 0); a3 = __builtin_amdgcn_mfma_f32_32x32x16_bf16(af, Bf[3], a3, 0, 0, 0);
#pragma unroll
                for (int r = 0; r < 16; ++r) { auto t0 = __builtin_amdgcn_permlane32_swap(__float_as_uint(a0[r]), __float_as_uint(a1[r]), false, false); a0[r] = __uint_as_float(t0[0]); a1[r] = __uint_as_float(t0[1]);
                                               auto t1 = __builtin_amdgcn_permlane32_swap(__float_as_uint(a2[r]), __float_as_uint(a3[r]), false, false); a2[r] = __uint_as_float(t1[0]); a3[r] = __uint_as_float(t1[1]); }
#pragma unroll
                for (int s = 0; s < 32; ++s) { const int h = (s >> 2) & 1, r = (s & 3) + 4 * (s >> 3); const float bre = h ? a1[r] : a0[r], bim = h ? a3[r] : a2[r];
                    const float nr = fmaf(lr, xr, fmaf(-li, xi, bre)), ni = fmaf(lr, xi, fmaf(li, xr, bim)); xr = nr; xi = ni;
                    if (pass) { const unsigned pk = cvtpk(xr, xi); *(unsigned short*)(xblk + s * XP + lane * 2) = (unsigned short)pk; *(unsigned short*)(xblk + s * XP + 128 + lane * 2) = (unsigned short)(pk >> 16); } }
                if (pass) {
#pragma unroll
                    for (int rb = 0; rb < 2; ++rb) { f32x4 acc = {0.f, 0.f, 0.f, 0.f};
#pragma unroll
                        for (int kk = 0; kk < 4; ++kk) { const bf16x8 xa = *(const bf16x8*)(xblk + (16 * rb + l15) * XP + (32 * kk + 8 * q4) * 2); acc = __builtin_amdgcn_mfma_f32_16x16x32_bf16(xa, Cf[kk], acc, 0, 0, 0); }
#pragma unroll
                        for (int i = 0; i < 4; ++i) { const int sl = 16 * rb + 4 * q4 + i; const float uv = ublk[sl * 16 + l15];
                            const float v = gelu_tanh(acc[i] + dsk * uv); const float vn = __shfl_xor(v, 1);
                            if ((l15 & 1) == 0) *(unsigned*)(Gout + ((size_t)wid * SEGL + blk * 32 + sl) * DM + 16 * g + l15) = cvtpk(v, vn); } }
                }
                ua0 = un0; ua1 = un1;
            }
            if (pass == 0) {
                Ebuf[wid * 128 + lane] = xr; Ebuf[wid * 128 + 64 + lane] = xi;
                __syncthreads();
                float sr = 0.f, si = 0.f;
                for (int v = 0; v < wid; ++v) { const float er = Ebuf[v * 128 + lane], ei = Ebuf[v * 128 + 64 + lane];
                    const float nr = fmaf(l2r, sr, fmaf(-l2i, si, er)), ni = fmaf(l2r, si, fmaf(l2i, sr, ei)); sr = nr; si = ni; }
                xr = sr; xi = si;
            }
        }
        __syncthreads();
    }
}
#undef S5_ULOAD
}
#define XB_TMO      128
#define XB_XCNT(j)  (256  + 64 * (j))
#define XB_XSUB(j)  (1280 + 64 * (j))
#define XB_XGEN(j)  (2304 + 64 * (j))
#define XB_TOP      3328
#define XB_TOPGEN   3392
#define XCD_BAR_WORDS 3456
#define XB_SPIN_CAP (1u << 18)

__device__ __forceinline__ unsigned xb_ld(unsigned* p)              { return __hip_atomic_load(p, __ATOMIC_RELAXED, __HIP_MEMORY_SCOPE_AGENT); }
__device__ __forceinline__ unsigned xb_add(unsigned* p, unsigned v) { return __hip_atomic_fetch_add(p, v, __ATOMIC_RELAXED, __HIP_MEMORY_SCOPE_AGENT); }
__device__ __forceinline__ unsigned xb_xcc_id() { return (unsigned)__builtin_amdgcn_s_getreg((3 << 11) | 20) & 0xFu; }
#define XB_SPIN(cond, bar) do { unsigned _sp = 0; while (cond) { __builtin_amdgcn_s_sleep(1); \
    if ((++_sp & 255u) == 0u) { if (xb_ld(&(bar)[XB_TMO])) break; if (_sp > XB_SPIN_CAP) { atomicAdd(&(bar)[XB_TMO], 1u); break; } } } } while (0)

struct XcdBarrier {
    unsigned* bar; unsigned x;
    volatile LAS unsigned* st;
};

__device__ __forceinline__ XcdBarrier xcd_barrier_post(unsigned* bar, volatile LAS unsigned* st) {
    XcdBarrier b; b.bar = bar; b.x = xb_xcc_id(); b.st = st;
    if (threadIdx.x == 0) (void)xb_add(&bar[XB_XCNT(b.x)], 1u);
    return b;
}
__device__ __forceinline__ void xcd_barrier_complete(unsigned* bar, unsigned x, unsigned& nloc, unsigned& nx) {
    const unsigned G = gridDim.x * gridDim.y * gridDim.z;
    unsigned sum, cnt, mine, sp = 0u;
    for (;;) {
        sum = 0u; cnt = 0u; mine = 0u;
#pragma unroll
        for (unsigned j = 0; j < 16; ++j) { const unsigned c = xb_ld(&bar[XB_XCNT(j)]); sum += c; cnt += (c > 0u) ? 1u : 0u; mine = (j == x) ? c : mine; }
        if (sum == G) break;
        __builtin_amdgcn_s_sleep(1);
        if ((++sp & 255u) == 0u) { if (xb_ld(&bar[XB_TMO])) break; if (sp > XB_SPIN_CAP) { atomicAdd(&bar[XB_TMO], 1u); break; } }
    }
    nloc = mine > 0u ? mine : 1u; nx = cnt > 0u ? cnt : 1u;
}

__device__ __forceinline__ void xcd_barrier(const XcdBarrier& b) {
    asm volatile("s_waitcnt vmcnt(0)" ::: "memory");
    __syncthreads();
    if (threadIdx.x == 0) {
        unsigned* bar = b.bar;
        __builtin_amdgcn_s_waitcnt(0);
        unsigned nloc = b.st[0], nx = b.st[1];
        if (nloc == 0u) { xcd_barrier_complete(bar, b.x, nloc, nx); b.st[0] = nloc; b.st[1] = nx; }
        const unsigned old = xb_add(&bar[XB_XSUB(b.x)], 1u);
        const unsigned gen = old / nloc;
        if (old + 1u == (gen + 1u) * nloc) {
            __builtin_amdgcn_fence(__ATOMIC_RELEASE, "agent");
            asm volatile("s_waitcnt vmcnt(0)" ::: "memory");
            const unsigned og = xb_add(&bar[XB_TOP], 1u);
            const unsigned tg = og / nx;
            if (og + 1u == (tg + 1u) * nx) xb_add(&bar[XB_TOPGEN], 1u);
            else XB_SPIN(xb_ld(&bar[XB_TOPGEN]) == tg, bar);
            __builtin_amdgcn_fence(__ATOMIC_ACQUIRE, "agent");
            xb_add(&bar[XB_XGEN(b.x)], 1u);
            asm volatile("s_waitcnt vmcnt(0)" ::: "memory");
        } else {
            XB_SPIN(xb_ld(&bar[XB_XGEN(b.x)]) == gen, bar);
            __builtin_amdgcn_fence(__ATOMIC_ACQUIRE, "agent");
            asm volatile("s_waitcnt vmcnt(0)" ::: "memory");
        }
    }
    __syncthreads();
}

constexpr size_t MiB = (size_t)1 << 20;
constexpr int NTHR = 512, NWAVES = 8;
constexpr int LDS_BYTES = 147456;
constexpr int LDS_MISC = LDS_BYTES - 1024;
__device__ __forceinline__ const float* uptr(const LAS unsigned long long* tab, int i) {
    const unsigned long long v = tab[i]; const unsigned lo = __builtin_amdgcn_readfirstlane((unsigned)v), hi = __builtin_amdgcn_readfirstlane((unsigned)(v >> 32));
    return (const float*)(const GAS float*)(((unsigned long long)hi << 32) | lo);
}
template <class T> __device__ __forceinline__ LAS T* launder_l(LAS T* p) { asm volatile("" : "+s"(p)); return p; }
template <class T> __device__ __forceinline__ T* launder(T* p) { GAS T* q = (GAS T*)p; asm volatile("" : "+s"(q)); return (T*)q; }
static_assert(pg8::STAGE_BYTES <= LDS_MISC && fox::LDS_BYTES <= LDS_MISC && swa::LDS_BYTES <= LDS_MISC && s5::LDS_BYTES <= LDS_MISC, "LDS map");
constexpr size_t WS_CTL = 0, CTL_ZERO_BYTES = 64 * 1024;
constexpr size_t CTL_QCTR = 16384, CTL_NRM2 = 20480;
constexpr size_t WS_ROPE = 1 * MiB;
constexpr size_t WS_W = 2 * MiB;
constexpr size_t W_L0_QKV = WS_W, W_L0_O = W_L0_QKV + 40 * MiB, W_L1_QKVF = W_L0_O + 32 * MiB, W_L1_O = W_L1_QKVF + 98 * MiB, W_L2_GLU = W_L1_O + 32 * MiB,
                 W_L3_QKV = W_L2_GLU + 64 * MiB, W_L3_O = W_L3_QKV + 40 * MiB, W_FFN = W_L3_O + 32 * MiB, W_FFN_STRIDE = 258 * MiB, W_FFN_OUT = 172 * MiB;
constexpr size_t WS_XN = W_FFN + 4 * W_FFN_STRIDE;
constexpr size_t WS_BIG = WS_XN + 129 * MiB;
constexpr size_t WS_Z = WS_BIG, WS_ACT = WS_BIG + 688 * MiB, WS_TMPF = WS_BIG, WS_TMPM = WS_BIG + 688 * MiB;
constexpr size_t WS_SWA_QKV = WS_BIG, WS_SWA_O = WS_BIG + 160 * MiB;
constexpr size_t WS_FOX_QKV = WS_BIG, WS_FOX_O = WS_BIG + 384 * MiB, WS_FOX_LOGF = WS_BIG + 512 * MiB, WS_FOX_CNEG = WS_BIG + 514 * MiB;
constexpr size_t WS_S5_U = WS_BIG + 256 * MiB, WS_S5_G = WS_BIG + 512 * MiB;
constexpr size_t WS_HHI = WS_BIG + 1032 * MiB, WS_HLO = WS_HHI + 128 * MiB;
constexpr size_t WS_END = WS_HLO + 32 * MiB;
static_assert((size_t)SEQ * 2 * DFF * 2 == 688 * MiB && (size_t)SEQ * DFF * 2 == 344 * MiB && (size_t)12544 * 4096 * 2 == 98 * MiB && (size_t)22016 * 4096 * 2 == 172 * MiB, "sizes");

struct Args { const float* in[56]; float* out; unsigned char* ws; float inv_freq[8]; int ph_lo, ph_hi; };

__global__ void __launch_bounds__(NTHR, 2) mk_fwd(Args args) {
    extern __shared__ __attribute__((aligned(16))) unsigned char lds[];
    if (threadIdx.x < 16) ((LAS unsigned*)((LAS unsigned char*)lds + LDS_MISC))[threadIdx.x] = 0u;
    if (threadIdx.x == 64) { LAS unsigned long long* ptab0 = (LAS unsigned long long*)((LAS unsigned char*)lds + LDS_MISC + 64);
#pragma unroll
        for (int i = 0; i < 56; ++i) ptab0[i] = (unsigned long long)args.in[i]; }
#define IN(i) uptr(ptab, (i))
    __syncthreads();
    XcdBarrier bar = xcd_barrier_post((unsigned*)(args.ws + WS_CTL), (volatile LAS unsigned*)((LAS unsigned char*)lds + LDS_MISC));
    int need_bar = 0;
#if PROBE_WAIT > 0
    unsigned long long probe_acc = 0, probe_t0 = 0;
#define PROBE_SEL(id) (PROBE_ID >= 0 ? (id) == PROBE_ID : ((PROBE_MASK >> ((id) == 1 ? 9 : ((id) - 1) % 9)) & 1))
#define PROBE_T0(id) do { if (PROBE_SEL(id)) probe_t0 = __builtin_amdgcn_s_memrealtime(); } while (0)
#define PROBE_T1(id) do { if (PROBE_SEL(id)) probe_acc += __builtin_amdgcn_s_memrealtime() - probe_t0; } while (0)
#else
#define PROBE_T0(id) do { } while (0)
#define PROBE_T1(id) do { } while (0)
#endif
#define PH_BEGIN(id) if (args.ph_lo <= (id) && (id) < args.ph_hi) { \
        if (need_bar) { PROBE_T0(id); XcdBarrier b2; b2.bar = launder(bar.bar); b2.x = (unsigned)launder_s((int)bar.x); b2.st = bar.st; for (int rb_ = 0; rb_ < REP_BAR; ++rb_) xcd_barrier(b2); PROBE_T1(id); } need_bar = 1; \
        unsigned char* const ws = launder(args.ws); float* const out = launder(args.out); (void)out; \
        LAS unsigned char* const ldsl = launder_l((LAS unsigned char*)lds); char* const ldsg = (char*)ldsl; (void)ldsg; const LAS unsigned long long* const ptab = (const LAS unsigned long long*)(ldsl + LDS_MISC + 64); \
        const int tid = mk_tid(), lane = tid & 63, wave = __builtin_amdgcn_readfirstlane(tid >> 6); (void)lane; (void)wave; \
        const int G = launder_s((int)gridDim.x), bx = launder_s((int)blockIdx.x), vcu = (G % 8 == 0) ? (bx % 8) * (G / 8) + bx / 8 : bx, gw = vcu * NWAVES + wave, ngw = G * NWAVES; (void)gw; (void)ngw; \
        bf16* const XN = (bf16*)(ws + WS_XN + 16384); float* const cosT = (float*)(ws + WS_ROPE); float* const sinT = cosT + SEQ * 8; bf16* const TMPM = (bf16*)(ws + WS_TMPM); bf16* const TMPF = (bf16*)(ws + WS_TMPF); \
        (void)XN; (void)cosT; (void)sinT; (void)TMPM; (void)TMPF; const HPlanes HP{ws + WS_HHI, ws + WS_HLO}; (void)HP;
#define PH_END }

    PH_BEGIN(0)
#if PROBE_COPY > 0
      for (int rep = 0; rep < PROBE_COPY; ++rep) {
        typedef PROBE_T pv_t; constexpr int PU = 128 / sizeof(pv_t);
        const pv_t* src = (const pv_t*)(ws + WS_BIG); pv_t* dst = (pv_t*)(ws + WS_BIG + 516 * MiB);
        const size_t n = 512 * MiB / sizeof(pv_t), stride = (size_t)G * NTHR;
        for (size_t i = (size_t)vcu * NTHR + tid; i < n; i += PU * stride) {
            pv_t v[PU];
#pragma unroll
            for (int u = 0; u < PU; ++u) v[u] = PROBE_LD(src + i + u * stride);
#pragma unroll
            for (int u = 0; u < PU; ++u) PROBE_ST(v[u], dst + i + u * stride);
        }
      }
#endif
      for (int rep = 0; rep < REP_PRO; ++rep) {
        LAS unsigned* scr = (LAS unsigned*)(ldsl + wave * 16640);
        constexpr int I_QKV = 32 * 80, I_O = 32 * 64, I_QKVF = 32 * 193, I_GLU = 32 * 128, I_IN = 32 * 344, I_OUT = 86 * 64;
        constexpr int NITEMS = 2 * (I_QKV + I_O) + I_QKVF + I_O + I_GLU + 4 * (I_IN + I_OUT);
        for (int it = gw; it < NITEMS; it += ngw) {
            int r = it;
#define TR(cnt, src, K_, N_, dstoff, mode) if (r < (cnt)) { transpose_item(IN(src), K_, N_, (bf16*)(ws + (dstoff)), mode, scr, r, lane); continue; } r -= (cnt);
            TR(I_QKV, 2, 4096, 5120, W_L0_QKV, 0)
            TR(I_O, 5, 4096, 4096, W_L0_O, 0)
            TR(I_IN, 9, 4096, 22016, W_FFN, 2)
            TR(I_OUT, 12, 11008, 4096, W_FFN + W_FFN_OUT, 0)
            TR(I_QKVF, 15, 4096, 12320, W_L1_QKVF, 0)
            TR(I_O, 17, 4096, 4096, W_L1_O, 0)
            TR(I_IN, 20, 4096, 22016, W_FFN + W_FFN_STRIDE, 2)
            TR(I_OUT, 23, 11008, 4096, W_FFN + W_FFN_STRIDE + W_FFN_OUT, 0)
            TR(I_GLU, 34, 4096, 8192, W_L2_GLU, 1)
            TR(I_IN, 38, 4096, 22016, W_FFN + 2 * W_FFN_STRIDE, 2)
            TR(I_OUT, 41, 11008, 4096, W_FFN + 2 * W_FFN_STRIDE + W_FFN_OUT, 0)
            TR(I_QKV, 44, 4096, 5120, W_L3_QKV, 0)
            TR(I_O, 47, 4096, 4096, W_L3_O, 0)
            TR(I_IN, 51, 4096, 22016, W_FFN + 3 * W_FFN_STRIDE, 2)
            TR(I_OUT, 54, 11008, 4096, W_FFN + 3 * W_FFN_STRIDE + W_FFN_OUT, 0)
#undef TR
        }
        if (vcu == 0) { u32x4* zh = (u32x4*)(ws + WS_XN); const u32x4 zero = {0u, 0u, 0u, 0u}; for (int i = tid; i < 1024; i += NTHR) zh[i] = zero; }
        {
            u32x4* z = (u32x4*)(ws + W_L1_QKVF + (size_t)12320 * 4096 * 2); const u32x4 zero = {0u, 0u, 0u, 0u};
            for (int i = vcu * NTHR + tid; i < 224 * 4096 * 2 / 16; i += G * NTHR) z[i] = zero;
        }
        for (int i = vcu * NTHR + tid; i < SEQ * 8; i += G * NTHR) {
            const int f = i & 7;
            const float fr = f == 0 ? args.inv_freq[0] : f == 1 ? args.inv_freq[1] : f == 2 ? args.inv_freq[2] : f == 3 ? args.inv_freq[3] : f == 4 ? args.inv_freq[4] : f == 5 ? args.inv_freq[5] : f == 6 ? args.inv_freq[6] : args.inv_freq[7];
            const float ang = (float)(i >> 3) * fr; double s, c; sincos_d((double)ang, s, c); cosT[i] = (float)c; sinT[i] = (float)s;
        }
        norm_phase<0, 2>(gw, ngw, lane, ldsl + wave * 16640, nullptr, nullptr, IN(0), nullptr, HPlanes{nullptr, nullptr}, IN(1), XN, nullptr);
      }
    PH_END

#define SEL(a, b, c, d) IN(L == 0 ? (a) : L == 1 ? (b) : L == 2 ? (c) : (d))
    { constexpr int L = 0;

        const int type = L == 3 ? 0 : L, pb = 1 + 9 * L;
        const size_t wffn = W_FFN + (size_t)L * W_FFN_STRIDE;

        PH_BEGIN(pb + 0)
            if (type == 0) {
                pg8::Gemm g{XN, (const bf16*)(ws + (L == 0 ? W_L0_QKV : W_L3_QKV)), SEQ, 5120, 4096}; pg8::StaticOrder S; S.init(SEQ, 5120, G, bx);
                pg8::EpiBf16B E{(bf16*)(ws + WS_SWA_QKV), 5120, L == 0 ? IN(3) : IN(45)};
                for (int rep = 0; rep < REP_MIXG; ++rep) pg8::gemm_phase<pg8::EpiBf16B, pg8::StaticOrder, true, true>(ldsl, g, S, E);
            } else if (type == 1) {
                pg8::Gemm g{XN, (const bf16*)(ws + W_L1_QKVF), SEQ, 12544, 4096}; pg8::StaticOrder S; S.init(SEQ, 12544, G, bx);
                pg8::EpiFox E{(bf16*)(ws + WS_FOX_QKV), (float*)(ws + WS_FOX_LOGF), IN(16)};
                for (int rep = 0; rep < REP_MIXG; ++rep) pg8::gemm_phase<pg8::EpiFox, pg8::StaticOrder, true, true>(ldsl, g, S, E);
            } else {
              for (int rep = 0; rep < REP_MIX; ++rep)
                s5::s5_phase(ldsg, (const bf16*)(ws + WS_S5_U), IN(26), IN(27), IN(28), IN(29), IN(30), IN(31), IN(32), IN(33),
                             (bf16*)(ws + WS_S5_G), vcu, G);
            }
        PH_END
        if (type != 2) {
        PH_BEGIN(pb + 1)
          for (int rep = 0; rep < REP_MIX; ++rep) {
            if (type == 0) swa::swa_attn_phase(ldsg, (const bf16*)(ws + WS_SWA_QKV), L == 0 ? IN(4) : IN(46), cosT, sinT, (bf16*)(ws + WS_SWA_O), vcu, G);
            else { fox_cumsum_phase(ldsg, (const float*)(ws + WS_FOX_LOGF), (float*)(ws + WS_FOX_CNEG), vcu, G, tid);
                   if (G > 64) { if (vcu >= 32) fox_norms_phase((const bf16*)(ws + WS_FOX_QKV), (unsigned*)(ws + WS_CTL + CTL_NRM2), (vcu - 32) * NWAVES + wave, (G - 32) * NWAVES, lane); }
                   else fox_norms_phase((const bf16*)(ws + WS_FOX_QKV), (unsigned*)(ws + WS_CTL + CTL_NRM2), gw, ngw, lane); }
          }
        PH_END
        }
        if (type == 1) {
        PH_BEGIN(pb + 2)
            const bf16* q = (const bf16*)(ws + WS_FOX_QKV);
            fox::fox_attn_phase(ldsg, q, q + (size_t)32 * SEQ * 128, q + (size_t)64 * SEQ * 128, (const float*)(ws + WS_FOX_CNEG), (const unsigned*)(ws + WS_CTL + CTL_NRM2), (unsigned*)(ws + WS_CTL + CTL_QCTR), (bf16*)(ws + WS_FOX_O));
#if REP_FOX > 1
            __syncthreads();
            fox::fox_attn_phase(ldsg, q, q + (size_t)32 * SEQ * 128, q + (size_t)64 * SEQ * 128, (const float*)(ws + WS_FOX_CNEG), (const unsigned*)(ws + WS_CTL + CTL_NRM2), (unsigned*)(ws + WS_CTL + CTL_QCTR) + 64, (bf16*)(ws + WS_FOX_O));
#endif
        PH_END
        }
        PH_BEGIN(pb + 3)
            if (type == 2) {
                pg8::Gemm g{(const bf16*)(ws + WS_S5_G), (const bf16*)(ws + W_L2_GLU), SEQ, 8192, 4096}; pg8::StaticOrder S; S.init(SEQ, 8192, G, bx);
                pg8::EpiGlu E{TMPM, IN(35)};
                for (int rep = 0; rep < REP_MIXG; ++rep) pg8::gemm_phase<pg8::EpiGlu, pg8::StaticOrder, true, true>(ldsl, g, S, E);
            } else {
                pg8::Gemm g{(const bf16*)(ws + (type == 0 ? WS_SWA_O : WS_FOX_O)), (const bf16*)(ws + (L == 0 ? W_L0_O : L == 1 ? W_L1_O : W_L3_O)), SEQ, 4096, 4096};
                pg8::StaticOrder S; S.init(SEQ, 4096, G, bx);
                pg8::EpiBf16B E{TMPM, 4096, L == 0 ? IN(6) : L == 3 ? IN(48) : nullptr};
                for (int rep = 0; rep < REP_MIXG; ++rep) pg8::gemm_phase<pg8::EpiBf16B, pg8::StaticOrder, true, true>(ldsl, g, S, E);
            }
        PH_END
        PH_BEGIN(pb + 4)
          for (int rep = 0; rep < REP_NORM; ++rep)
            if (L == 0 && rep == 0) norm_phase<0, 1>(gw, ngw, lane, ldsl + wave * 16640, TMPM, SEL(7, 18, 36, 49), IN(0), nullptr, HP, SEL(8, 19, 37, 50), XN, nullptr, 1.f);
            else norm_phase<1, 1>(gw, ngw, lane, ldsl + wave * 16640, TMPM, SEL(7, 18, 36, 49), nullptr, nullptr, HP, SEL(8, 19, 37, 50), XN, nullptr, rep ? 0.f : 1.f);
        PH_END
        PH_BEGIN(pb + 5)
            pg8::Gemm g{XN - 2 * 4096, (const bf16*)(ws + wffn), 65 * 256, 2 * DFF, 4096, 254}; pg8::StaticOrder S; S.init(65 * 256, 2 * DFF, G, bx);
            pg8::EpiConvGeglu E{(bf16*)(ws + WS_ACT), SEL(10, 21, 39, 52), SEL(11, 22, 40, 53), ldsl + 131072, DFF, SEQ};
          for (int rep = 0; rep < REP_FFN1; ++rep)
            pg8::gemm_phase<pg8::EpiConvGeglu, pg8::StaticOrder, true, true>(ldsl, g, S, E);
        PH_END
        PH_BEGIN(pb + 7)
            pg8::Gemm g{(const bf16*)(ws + WS_ACT), (const bf16*)(ws + wffn + W_FFN_OUT), SEQ, 4096, DFF}; pg8::StaticOrder S; S.init(SEQ, 4096, G, bx);
            pg8::EpiBf16B E{TMPF, 4096, nullptr};
          for (int rep = 0; rep < REP_FFN2; ++rep)
            pg8::gemm_phase<pg8::EpiBf16B, pg8::StaticOrder, true, true>(ldsl, g, S, E);
        PH_END
        PH_BEGIN(pb + 8)
          for (int rep = 0; rep < REP_NORM; ++rep)
            if (L == 3) { if (rep == 0) norm_phase<1, 0>(gw, ngw, lane, ldsl + wave * 16640, TMPF, SEL(13, 24, 42, 55), nullptr, out, HP, nullptr, nullptr, nullptr, 1.f); }
            else norm_phase<1, 1>(gw, ngw, lane, ldsl + wave * 16640, TMPF, SEL(13, 24, 42, 55), nullptr, nullptr, HP, SEL(14, 25, 43, 43), L == 1 ? nullptr : XN, L == 1 ? (bf16*)(ws + WS_S5_U) : nullptr, rep ? 0.f : 1.f);
        PH_END
    }
    { constexpr int L = 1;

        const int type = L == 3 ? 0 : L, pb = 1 + 9 * L;
        const size_t wffn = W_FFN + (size_t)L * W_FFN_STRIDE;

        PH_BEGIN(pb + 0)
            if (type == 0) {
                pg8::Gemm g{XN, (const bf16*)(ws + (L == 0 ? W_L0_QKV : W_L3_QKV)), SEQ, 5120, 4096}; pg8::StaticOrder S; S.init(SEQ, 5120, G, bx);
                pg8::EpiBf16B E{(bf16*)(ws + WS_SWA_QKV), 5120, L == 0 ? IN(3) : IN(45)};
                for (int rep = 0; rep < REP_MIXG; ++rep) pg8::gemm_phase<pg8::EpiBf16B, pg8::StaticOrder, true, true>(ldsl, g, S, E);
            } else if (type == 1) {
                pg8::Gemm g{XN, (const bf16*)(ws + W_L1_QKVF), SEQ, 12544, 4096}; pg8::StaticOrder S; S.init(SEQ, 12544, G, bx);
                pg8::EpiFox E{(bf16*)(ws + WS_FOX_QKV), (float*)(ws + WS_FOX_LOGF), IN(16)};
                for (int rep = 0; rep < REP_MIXG; ++rep) pg8::gemm_phase<pg8::EpiFox, pg8::StaticOrder, true, true>(ldsl, g, S, E);
            } else {
              for (int rep = 0; rep < REP_MIX; ++rep)
                s5::s5_phase(ldsg, (const bf16*)(ws + WS_S5_U), IN(26), IN(27), IN(28), IN(29), IN(30), IN(31), IN(32), IN(33),
                             (bf16*)(ws + WS_S5_G), vcu, G);
            }
        PH_END
        if (type != 2) {
        PH_BEGIN(pb + 1)
          for (int rep = 0; rep < REP_MIX; ++rep) {
            if (type == 0) swa::swa_attn_phase(ldsg, (const bf16*)(ws + WS_SWA_QKV), L == 0 ? IN(4) : IN(46), cosT, sinT, (bf16*)(ws + WS_SWA_O), vcu, G);
            else { fox_cumsum_phase(ldsg, (const float*)(ws + WS_FOX_LOGF), (float*)(ws + WS_FOX_CNEG), vcu, G, tid);
                   if (G > 64) { if (vcu >= 32) fox_norms_phase((const bf16*)(ws + WS_FOX_QKV), (unsigned*)(ws + WS_CTL + CTL_NRM2), (vcu - 32) * NWAVES + wave, (G - 32) * NWAVES, lane); }
                   else fox_norms_phase((const bf16*)(ws + WS_FOX_QKV), (unsigned*)(ws + WS_CTL + CTL_NRM2), gw, ngw, lane); }
          }
        PH_END
        }
        if (type == 1) {
        PH_BEGIN(pb + 2)
            const bf16* q = (const bf16*)(ws + WS_FOX_QKV);
            fox::fox_attn_phase(ldsg, q, q + (size_t)32 * SEQ * 128, q + (size_t)64 * SEQ * 128, (const float*)(ws + WS_FOX_CNEG), (const unsigned*)(ws + WS_CTL + CTL_NRM2), (unsigned*)(ws + WS_CTL + CTL_QCTR), (bf16*)(ws + WS_FOX_O));
#if REP_FOX > 1
            __syncthreads();
            fox::fox_attn_phase(ldsg, q, q + (size_t)32 * SEQ * 128, q + (size_t)64 * SEQ * 128, (const float*)(ws + WS_FOX_CNEG), (const unsigned*)(ws + WS_CTL + CTL_NRM2), (unsigned*)(ws + WS_CTL + CTL_QCTR) + 64, (bf16*)(ws + WS_FOX_O));
#endif
        PH_END
        }
        PH_BEGIN(pb + 3)
            if (type == 2) {
                pg8::Gemm g{(const bf16*)(ws + WS_S5_G), (const bf16*)(ws + W_L2_GLU), SEQ, 8192, 4096}; pg8::StaticOrder S; S.init(SEQ, 8192, G, bx);
                pg8::EpiGlu E{TMPM, IN(35)};
                for (int rep = 0; rep < REP_MIXG; ++rep) pg8::gemm_phase<pg8::EpiGlu, pg8::StaticOrder, true, true>(ldsl, g, S, E);
            } else {
                pg8::Gemm g{(const bf16*)(ws + (type == 0 ? WS_SWA_O : WS_FOX_O)), (const bf16*)(ws + (L == 0 ? W_L0_O : L == 1 ? W_L1_O : W_L3_O)), SEQ, 4096, 4096};
                pg8::StaticOrder S; S.init(SEQ, 4096, G, bx);
                pg8::EpiBf16B E{TMPM, 4096, L == 0 ? IN(6) : L == 3 ? IN(48) : nullptr};
                for (int rep = 0; rep < REP_MIXG; ++rep) pg8::gemm_phase<pg8::EpiBf16B, pg8::StaticOrder, true, true>(ldsl, g, S, E);
            }
        PH_END
        PH_BEGIN(pb + 4)
          for (int rep = 0; rep < REP_NORM; ++rep)
            if (L == 0 && rep == 0) norm_phase<0, 1>(gw, ngw, lane, ldsl + wave * 16640, TMPM, SEL(7, 18, 36, 49), IN(0), nullptr, HP, SEL(8, 19, 37, 50), XN, nullptr, 1.f);
            else norm_phase<1, 1>(gw, ngw, lane, ldsl + wave * 16640, TMPM, SEL(7, 18, 36, 49), nullptr, nullptr, HP, SEL(8, 19, 37, 50), XN, nullptr, rep ? 0.f : 1.f);
        PH_END
        PH_BEGIN(pb + 5)
            pg8::Gemm g{XN - 2 * 4096, (const bf16*)(ws + wffn), 65 * 256, 2 * DFF, 4096, 254}; pg8::StaticOrder S; S.init(65 * 256, 2 * DFF, G, bx);
            pg8::EpiConvGeglu E{(bf16*)(ws + WS_ACT), SEL(10, 21, 39, 52), SEL(11, 22, 40, 53), ldsl + 131072, DFF, SEQ};
          for (int rep = 0; rep < REP_FFN1; ++rep)
            pg8::gemm_phase<pg8::EpiConvGeglu, pg8::StaticOrder, true, true>(ldsl, g, S, E);
        PH_END
        PH_BEGIN(pb + 7)
            pg8::Gemm g{(const bf16*)(ws + WS_ACT), (const bf16*)(ws + wffn + W_FFN_OUT), SEQ, 4096, DFF}; pg8::StaticOrder S; S.init(SEQ, 4096, G, bx);
            pg8::EpiBf16B E{TMPF, 4096, nullptr};
          for (int rep = 0; rep < REP_FFN2; ++rep)
            pg8::gemm_phase<pg8::EpiBf16B, pg8::StaticOrder, true, true>(ldsl, g, S, E);
        PH_END
        PH_BEGIN(pb + 8)
          for (int rep = 0; rep < REP_NORM; ++rep)
            if (L == 3) { if (rep == 0) norm_phase<1, 0>(gw, ngw, lane, ldsl + wave * 16640, TMPF, SEL(13, 24, 42, 55), nullptr, out, HP, nullptr, nullptr, nullptr, 1.f); }
            else norm_phase<1, 1>(gw, ngw, lane, ldsl + wave * 16640, TMPF, SEL(13, 24, 42, 55), nullptr, nullptr, HP, SEL(14, 25, 43, 43), L == 1 ? nullptr : XN, L == 1 ? (bf16*)(ws + WS_S5_U) : nullptr, rep ? 0.f : 1.f);
        PH_END
    }
    { constexpr int L = 2;

        const int type = L == 3 ? 0 : L, pb = 1 + 9 * L;
        const size_t wffn = W_FFN + (size_t)L * W_FFN_STRIDE;

        PH_BEGIN(pb + 0)
            if (type == 0) {
                pg8::Gemm g{XN, (const bf16*)(ws + (L == 0 ? W_L0_QKV : W_L3_QKV)), SEQ, 5120, 4096}; pg8::StaticOrder S; S.init(SEQ, 5120, G, bx);
                pg8::EpiBf16B E{(bf16*)(ws + WS_SWA_QKV), 5120, L == 0 ? IN(3) : IN(45)};
                for (int rep = 0; rep < REP_MIXG; ++rep) pg8::gemm_phase<pg8::EpiBf16B, pg8::StaticOrder, true, true>(ldsl, g, S, E);
            } else if (type == 1) {
                pg8::Gemm g{XN, (const bf16*)(ws + W_L1_QKVF), SEQ, 12544, 4096}; pg8::StaticOrder S; S.init(SEQ, 12544, G, bx);
                pg8::EpiFox E{(bf16*)(ws + WS_FOX_QKV), (float*)(ws + WS_FOX_LOGF), IN(16)};
                for (int rep = 0; rep < REP_MIXG; ++rep) pg8::gemm_phase<pg8::EpiFox, pg8::StaticOrder, true, true>(ldsl, g, S, E);
            } else {
              for (int rep = 0; rep < REP_MIX; ++rep)
                s5::s5_phase(ldsg, (const bf16*)(ws + WS_S5_U), IN(26), IN(27), IN(28), IN(29), IN(30), IN(31), IN(32), IN(33),
                             (bf16*)(ws + WS_S5_G), vcu, G);
            }
        PH_END
        if (type != 2) {
        PH_BEGIN(pb + 1)
          for (int rep = 0; rep < REP_MIX; ++rep) {
            if (type == 0) swa::swa_attn_phase(ldsg, (const bf16*)(ws + WS_SWA_QKV), L == 0 ? IN(4) : IN(46), cosT, sinT, (bf16*)(ws + WS_SWA_O), vcu, G);
            else { fox_cumsum_phase(ldsg, (const float*)(ws + WS_FOX_LOGF), (float*)(ws + WS_FOX_CNEG), vcu, G, tid);
                   if (G > 64) { if (vcu >= 32) fox_norms_phase((const bf16*)(ws + WS_FOX_QKV), (unsigned*)(ws + WS_CTL + CTL_NRM2), (vcu - 32) * NWAVES + wave, (G - 32) * NWAVES, lane); }
                   else fox_norms_phase((const bf16*)(ws + WS_FOX_QKV), (unsigned*)(ws + WS_CTL + CTL_NRM2), gw, ngw, lane); }
          }
        PH_END
        }
        if (type == 1) {
        PH_BEGIN(pb + 2)
            const bf16* q = (const bf16*)(ws + WS_FOX_QKV);
            fox::fox_attn_phase(ldsg, q, q + (size_t)32 * SEQ * 128, q + (size_t)64 * SEQ * 128, (const float*)(ws + WS_FOX_CNEG), (const unsigned*)(ws + WS_CTL + CTL_NRM2), (unsigned*)(ws + WS_CTL + CTL_QCTR), (bf16*)(ws + WS_FOX_O));
#if REP_FOX > 1
            __syncthreads();
            fox::fox_attn_phase(ldsg, q, q + (size_t)32 * SEQ * 128, q + (size_t)64 * SEQ * 128, (const float*)(ws + WS_FOX_CNEG), (const unsigned*)(ws + WS_CTL + CTL_NRM2), (unsigned*)(ws + WS_CTL + CTL_QCTR) + 64, (bf16*)(ws + WS_FOX_O));
#endif
        PH_END
        }
        PH_BEGIN(pb + 3)
            if (type == 2) {
                pg8::Gemm g{(const bf16*)(ws + WS_S5_G), (const bf16*)(ws + W_L2_GLU), SEQ, 8192, 4096}; pg8::StaticOrder S; S.init(SEQ, 8192, G, bx);
                pg8::EpiGlu E{TMPM, IN(35)};
                for (int rep = 0; rep < REP_MIXG; ++rep) pg8::gemm_phase<pg8::EpiGlu, pg8::StaticOrder, true, true>(ldsl, g, S, E);
            } else {
                pg8::Gemm g{(const bf16*)(ws + (type == 0 ? WS_SWA_O : WS_FOX_O)), (const bf16*)(ws + (L == 0 ? W_L0_O : L == 1 ? W_L1_O : W_L3_O)), SEQ, 4096, 4096};
                pg8::StaticOrder S; S.init(SEQ, 4096, G, bx);
                pg8::EpiBf16B E{TMPM, 4096, L == 0 ? IN(6) : L == 3 ? IN(48) : nullptr};
                for (int rep = 0; rep < REP_MIXG; ++rep) pg8::gemm_phase<pg8::EpiBf16B, pg8::StaticOrder, true, true>(ldsl, g, S, E);
            }
        PH_END
        PH_BEGIN(pb + 4)
          for (int rep = 0; rep < REP_NORM; ++rep)
            if (L == 0 && rep == 0) norm_phase<0, 1>(gw, ngw, lane, ldsl + wave * 16640, TMPM, SEL(7, 18, 36, 49), IN(0), nullptr, HP, SEL(8, 19, 37, 50), XN, nullptr, 1.f);
            else norm_phase<1, 1>(gw, ngw, lane, ldsl + wave * 16640, TMPM, SEL(7, 18, 36, 49), nullptr, nullptr, HP, SEL(8, 19, 37, 50), XN, nullptr, rep ? 0.f : 1.f);
        PH_END
        PH_BEGIN(pb + 5)
            pg8::Gemm g{XN - 2 * 4096, (const bf16*)(ws + wffn), 65 * 256, 2 * DFF, 4096, 254}; pg8::StaticOrder S; S.init(65 * 256, 2 * DFF, G, bx);
            pg8::EpiConvGeglu E{(bf16*)(ws + WS_ACT), SEL(10, 21, 39, 52), SEL(11, 22, 40, 53), ldsl + 131072, DFF, SEQ};
          for (int rep = 0; rep < REP_FFN1; ++rep)
            pg8::gemm_phase<pg8::EpiConvGeglu, pg8::StaticOrder, true, true>(ldsl, g, S, E);
        PH_END
        PH_BEGIN(pb + 7)
            pg8::Gemm g{(const bf16*)(ws + WS_ACT), (const bf16*)(ws + wffn + W_FFN_OUT), SEQ, 4096, DFF}; pg8::StaticOrder S; S.init(SEQ, 4096, G, bx);
            pg8::EpiBf16B E{TMPF, 4096, nullptr};
          for (int rep = 0; rep < REP_FFN2; ++rep)
            pg8::gemm_phase<pg8::EpiBf16B, pg8::StaticOrder, true, true>(ldsl, g, S, E);
        PH_END
        PH_BEGIN(pb + 8)
          for (int rep = 0; rep < REP_NORM; ++rep)
            if (L == 3) { if (rep == 0) norm_phase<1, 0>(gw, ngw, lane, ldsl + wave * 16640, TMPF, SEL(13, 24, 42, 55), nullptr, out, HP, nullptr, nullptr, nullptr, 1.f); }
            else norm_phase<1, 1>(gw, ngw, lane, ldsl + wave * 16640, TMPF, SEL(13, 24, 42, 55), nullptr, nullptr, HP, SEL(14, 25, 43, 43), L == 1 ? nullptr : XN, L == 1 ? (bf16*)(ws + WS_S5_U) : nullptr, rep ? 0.f : 1.f);
        PH_END
    }
    { constexpr int L = 3;

        const int type = L == 3 ? 0 : L, pb = 1 + 9 * L;
        const size_t wffn = W_FFN + (size_t)L * W_FFN_STRIDE;

        PH_BEGIN(pb + 0)
            if (type == 0) {
                pg8::Gemm g{XN, (const bf16*)(ws + (L == 0 ? W_L0_QKV : W_L3_QKV)), SEQ, 5120, 4096}; pg8::StaticOrder S; S.init(SEQ, 5120, G, bx);
                pg8::EpiBf16B E{(bf16*)(ws + WS_SWA_QKV), 5120, L == 0 ? IN(3) : IN(45)};
                for (int rep = 0; rep < REP_MIXG; ++rep) pg8::gemm_phase<pg8::EpiBf16B, pg8::StaticOrder, true, true>(ldsl, g, S, E);
            } else if (type == 1) {
                pg8::Gemm g{XN, (const bf16*)(ws + W_L1_QKVF), SEQ, 12544, 4096}; pg8::StaticOrder S; S.init(SEQ, 12544, G, bx);
                pg8::EpiFox E{(bf16*)(ws + WS_FOX_QKV), (float*)(ws + WS_FOX_LOGF), IN(16)};
                for (int rep = 0; rep < REP_MIXG; ++rep) pg8::gemm_phase<pg8::EpiFox, pg8::StaticOrder, true, true>(ldsl, g, S, E);
            } else {
              for (int rep = 0; rep < REP_MIX; ++rep)
                s5::s5_phase(ldsg, (const bf16*)(ws + WS_S5_U), IN(26), IN(27), IN(28), IN(29), IN(30), IN(31), IN(32), IN(33),
                             (bf16*)(ws + WS_S5_G), vcu, G);
            }
        PH_END
        if (type != 2) {
        PH_BEGIN(pb + 1)
          for (int rep = 0; rep < REP_MIX; ++rep) {
            if (type == 0) swa::swa_attn_phase(ldsg, (const bf16*)(ws + WS_SWA_QKV), L == 0 ? IN(4) : IN(46), cosT, sinT, (bf16*)(ws + WS_SWA_O), vcu, G);
            else { fox_cumsum_phase(ldsg, (const float*)(ws + WS_FOX_LOGF), (float*)(ws + WS_FOX_CNEG), vcu, G, tid);
                   if (G > 64) { if (vcu >= 32) fox_norms_phase((const bf16*)(ws + WS_FOX_QKV), (unsigned*)(ws + WS_CTL + CTL_NRM2), (vcu - 32) * NWAVES + wave, (G - 32) * NWAVES, lane); }
                   else fox_norms_phase((const bf16*)(ws + WS_FOX_QKV), (unsigned*)(ws + WS_CTL + CTL_NRM2), gw, ngw, lane); }
          }
        PH_END
        }
        if (type == 1) {
        PH_BEGIN(pb + 2)
            const bf16* q = (const bf16*)(ws + WS_FOX_QKV);
            fox::fox_attn_phase(ldsg, q, q + (size_t)32 * SEQ * 128, q + (size_t)64 * SEQ * 128, (const float*)(ws + WS_FOX_CNEG), (const unsigned*)(ws + WS_CTL + CTL_NRM2), (unsigned*)(ws + WS_CTL + CTL_QCTR), (bf16*)(ws + WS_FOX_O));
#if REP_FOX > 1
            __syncthreads();
            fox::fox_attn_phase(ldsg, q, q + (size_t)32 * SEQ * 128, q + (size_t)64 * SEQ * 128, (const float*)(ws + WS_FOX_CNEG), (const unsigned*)(ws + WS_CTL + CTL_NRM2), (unsigned*)(ws + WS_CTL + CTL_QCTR) + 64, (bf16*)(ws + WS_FOX_O));
#endif
        PH_END
        }
        PH_BEGIN(pb + 3)
            if (type == 2) {
                pg8::Gemm g{(const bf16*)(ws + WS_S5_G), (const bf16*)(ws + W_L2_GLU), SEQ, 8192, 4096}; pg8::StaticOrder S; S.init(SEQ, 8192, G, bx);
                pg8::EpiGlu E{TMPM, IN(35)};
                for (int rep = 0; rep < REP_MIXG; ++rep) pg8::gemm_phase<pg8::EpiGlu, pg8::StaticOrder, true, true>(ldsl, g, S, E);
            } else {
                pg8::Gemm g{(const bf16*)(ws + (type == 0 ? WS_SWA_O : WS_FOX_O)), (const bf16*)(ws + (L == 0 ? W_L0_O : L == 1 ? W_L1_O : W_L3_O)), SEQ, 4096, 4096};
                pg8::StaticOrder S; S.init(SEQ, 4096, G, bx);
                pg8::EpiBf16B E{TMPM, 4096, L == 0 ? IN(6) : L == 3 ? IN(48) : nullptr};
                for (int rep = 0; rep < REP_MIXG; ++rep) pg8::gemm_phase<pg8::EpiBf16B, pg8::StaticOrder, true, true>(ldsl, g, S, E);
            }
        PH_END
        PH_BEGIN(pb + 4)
          for (int rep = 0; rep < REP_NORM; ++rep)
            if (L == 0 && rep == 0) norm_phase<0, 1>(gw, ngw, lane, ldsl + wave * 16640, TMPM, SEL(7, 18, 36, 49), IN(0), nullptr, HP, SEL(8, 19, 37, 50), XN, nullptr, 1.f);
            else norm_phase<1, 1>(gw, ngw, lane, ldsl + wave * 16640, TMPM, SEL(7, 18, 36, 49), nullptr, nullptr, HP, SEL(8, 19, 37, 50), XN, nullptr, rep ? 0.f : 1.f);
        PH_END
        PH_BEGIN(pb + 5)
            pg8::Gemm g{XN - 2 * 4096, (const bf16*)(ws + wffn), 65 * 256, 2 * DFF, 4096, 254}; pg8::StaticOrder S; S.init(65 * 256, 2 * DFF, G, bx);
            pg8::EpiConvGeglu E{(bf16*)(ws + WS_ACT), SEL(10, 21, 39, 52), SEL(11, 22, 40, 53), ldsl + 131072, DFF, SEQ};
          for (int rep = 0; rep < REP_FFN1; ++rep)
            pg8::gemm_phase<pg8::EpiConvGeglu, pg8::StaticOrder, true, true>(ldsl, g, S, E);
        PH_END
        PH_BEGIN(pb + 7)
            pg8::Gemm g{(const bf16*)(ws + WS_ACT), (const bf16*)(ws + wffn + W_FFN_OUT), SEQ, 4096, DFF}; pg8::StaticOrder S; S.init(SEQ, 4096, G, bx);
            pg8::EpiBf16B E{TMPF, 4096, nullptr};
          for (int rep = 0; rep < REP_FFN2; ++rep)
            pg8::gemm_phase<pg8::EpiBf16B, pg8::StaticOrder, true, true>(ldsl, g, S, E);
        PH_END
        PH_BEGIN(pb + 8)
          for (int rep = 0; rep < REP_NORM; ++rep)
            if (L == 3) { if (rep == 0) norm_phase<1, 0>(gw, ngw, lane, ldsl + wave * 16640, TMPF, SEL(13, 24, 42, 55), nullptr, out, HP, nullptr, nullptr, nullptr, 1.f); }
            else norm_phase<1, 1>(gw, ngw, lane, ldsl + wave * 16640, TMPF, SEL(13, 24, 42, 55), nullptr, nullptr, HP, SEL(14, 25, 43, 43), L == 1 ? nullptr : XN, L == 1 ? (bf16*)(ws + WS_S5_U) : nullptr, rep ? 0.f : 1.f);
        PH_END
    }
#if PROBE_WAIT > 0
#if PROBE_WG >= 0
    if ((int)blockIdx.x == PROBE_WG) { const unsigned long long ts = __builtin_amdgcn_s_memrealtime(); while (__builtin_amdgcn_s_memrealtime() - ts < probe_acc * PROBE_WAIT) __builtin_amdgcn_s_sleep(8); }
#elif PROBE_WG == -1
    { const unsigned long long ts = __builtin_amdgcn_s_memrealtime(); while (__builtin_amdgcn_s_memrealtime() - ts < probe_acc * PROBE_WAIT) __builtin_amdgcn_s_sleep(8); }
#else
    { const unsigned long long ts = __builtin_amdgcn_s_memrealtime(); const unsigned long long c = 250000ull, w = probe_acc < c ? c - probe_acc : 0ull; while (__builtin_amdgcn_s_memrealtime() - ts < w * PROBE_WAIT) __builtin_amdgcn_s_sleep(8); }
#endif
#endif
#undef SEL
#undef PH_BEGIN
#undef PH_END
#undef IN
}

extern "C" void kernel_launch(void* const* d_in, const int* in_sizes, int n_in, void* d_out, int out_size, void* d_ws, size_t ws_size, hipStream_t stream) {
    static int grid = 0;
    if (grid == 0) {
        if (n_in != 56 || in_sizes[0] != SEQ * DM || out_size != SEQ * DM || ws_size < WS_END) {
            fprintf(stderr, "kernel_launch: built for 56 inputs, x/out of %d floats, >= %zu bytes of workspace; got n_in %d, in0 %d, out %d, ws %zu; nothing launched\n", SEQ * DM, (size_t)WS_END, n_in, n_in > 0 ? in_sizes[0] : -1, out_size, ws_size);
            grid = -1; return; }
        int dev = 0, cus = 0, per_cu = 0;
        if (hipGetDevice(&dev) != hipSuccess || hipDeviceGetAttribute(&cus, hipDeviceAttributeMultiprocessorCount, dev) != hipSuccess) { fprintf(stderr, "kernel_launch: device query failed\n"); grid = -1; return; }
        if (hipFuncSetAttribute((const void*)mk_fwd, hipFuncAttributeMaxDynamicSharedMemorySize, LDS_BYTES) != hipSuccess) { fprintf(stderr, "kernel_launch: hipFuncSetAttribute failed\n"); grid = -1; return; }
        if (hipOccupancyMaxActiveBlocksPerMultiprocessor(&per_cu, (const void*)mk_fwd, NTHR, LDS_BYTES) != hipSuccess || per_cu < 1) { fprintf(stderr, "kernel_launch: occupancy query says %d workgroups per CU\n", per_cu); (void)hipGetLastError(); }
        grid = cus;
    }
    if (grid < 0) return;
    if (hipMemsetAsync((char*)d_ws + WS_CTL, 0, CTL_ZERO_BYTES, stream) != hipSuccess) { fprintf(stderr, "kernel_launch: memset failed\n"); return; }
    Args a{};
    for (int i = 0; i < 56; ++i) a.in[i] = (const float*)d_in[i];
    a.out = (float*)d_out; a.ws = (unsigned char*)d_ws;
    { const float lt = (float)(-std::log(500000.0)); for (int i = 0; i < 8; ++i) { float v = lt * (float)i; v = v * 0.125f; a.inv_freq[i] = (float)std::exp((double)v); } }
#if MK_SPLIT_LAUNCHES
    for (int ph = 0; ph < 37; ++ph) {
        const int L = (ph - 1) / 9, slot = (ph - 1) % 9, type = L == 3 ? 0 : L;
        if (ph > 0 && ((slot == 1 && type == 2) || (slot == 2 && type != 1) || slot == 6)) continue;
        a.ph_lo = ph; a.ph_hi = ph + 1;
        hipLaunchKernelGGL(mk_fwd, dim3(grid), dim3(NTHR), LDS_BYTES, stream, a);
    }
#else
    a.ph_lo = 0; a.ph_hi = 37;
    hipLaunchKernelGGL(mk_fwd, dim3(grid), dim3(NTHR), LDS_BYTES, stream, a);
#endif
    const hipError_t le = hipPeekAtLastError();
    if (le != hipSuccess) fprintf(stderr, "kernel_launch: launch failed: %s (grid %d x %d threads, %d B LDS)\n", hipGetErrorName(le), grid, NTHR, LDS_BYTES);
}
```

```cpp
#include <hip/hip_runtime.h>
#include <cstdio>
#include <cstdint>
#include <cmath>

#ifndef MK_SPLIT_LAUNCHES
#define MK_SPLIT_LAUNCHES 0
#endif

__device__ __forceinline__ int mk_tid() { int t = threadIdx.x; asm volatile("" : "+v"(t)); return t; }
__device__ __forceinline__ int launder_s(int v) { asm volatile("" : "+s"(v)); return v; }

#ifndef PROBE_WAIT
#define PROBE_WAIT 0
#endif
#ifndef PROBE_ID
#define PROBE_ID -1
#endif
#ifndef PROBE_MASK
#define PROBE_MASK 0x080
#endif
#ifndef PROBE_WG
#define PROBE_WG -1
#endif
#ifndef PROBE_COPY
#define PROBE_COPY 0
#endif
#ifndef PROBE_T
#define PROBE_T u32x2
#endif
#define PROBE_LD(p) (*(p))
#define PROBE_ST(v, p) (*(p) = (v))
#ifndef REP_PRO
#define REP_PRO 1
#endif
#ifndef REP_FFN1
#define REP_FFN1 1
#endif
#ifndef REP_FFN2
#define REP_FFN2 1
#endif
#ifndef REP_NORM
#define REP_NORM 1
#endif
#ifndef REP_BAR
#define REP_BAR 1
#endif
#ifndef REP_FOX
#define REP_FOX 1
#endif
#ifndef REP_MIXG
#define REP_MIXG 1
#endif
#ifndef REP_MIX
#define REP_MIX 1
#endif

namespace pg8 {
#define PG8_LAS __attribute__((address_space(3)))
typedef unsigned short bf16_t;
typedef short bf16x8 __attribute__((ext_vector_type(8)));
typedef float f32x4 __attribute__((ext_vector_type(4)));
typedef unsigned u32x4 __attribute__((ext_vector_type(4)));
typedef unsigned u32x2 __attribute__((ext_vector_type(2)));
typedef float f32x2 __attribute__((ext_vector_type(2)));
typedef int v4i32 __attribute__((ext_vector_type(4)));
constexpr int F8_W_LOG2 = 10, F8_X_LOG2 = 4, F8_SCALE_W = 0x01010101 * (127 - (F8_W_LOG2 + F8_X_LOG2) / 2), F8_SCALE_X = F8_SCALE_W;
static_assert((F8_W_LOG2 + F8_X_LOG2) % 2 == 0, "the two scalings are undone by two equal E8M0 scales");
constexpr int BM = 256, BK = 64, HALF = 128, HTB = HALF * BK * 2  , STAGE_BYTES = 8 * HTB, NXCD = 8, WGM = 8;

__host__ __device__ __forceinline__ int lds_byte(int r, int c) { const int st = (r >> 4) * 2 + (c >> 5), rr = r & 15, cc = c & 31, ob = rr * 64 + cc * 2; return st * 1024 + (ob ^ (((ob >> 9) & 1) << 5)); }
__host__ __device__ __forceinline__ void stage_rc(int b, int& R, int& C) { const int st = b / 1024, sb = b % 1024, swz = sb ^ (((sb >> 9) & 1) << 5); R = (st >> 1) * 16 + swz / 64; C = (st & 1) * 32 + (swz % 64) / 2; }
__host__ __device__ __forceinline__ int perm32(int rho) { const int n = rho >> 4, i = rho & 15; return 8 * (i >> 2) + 4 * n + (i & 3); }

struct Unit { int pm, pn; };
struct Gemm { const bf16_t* A; const bf16_t* Bt; int M, N, K; int apr = 256; };

struct StaticOrder {
    int nM, nN, nwg, G, c;
    __host__ __device__ void init(int M, int N, int G_, int c_) { nM = M / BM; nN = N / BM; nwg = nM * nN; G = G_; c = c_; }
    __host__ __device__ bool next(int i, Unit& u) const {
        const long L = (long)i * G + c; if (L >= nwg) return false;
        int wgid = (int)L; { const int q = nwg / NXCD, r = nwg % NXCD, xcd = wgid % NXCD, off = wgid / NXCD; wgid = (xcd < r ? xcd * (q + 1) : r * (q + 1) + (xcd - r) * q) + off; }
        const int nig = WGM * nN, ngf = nM / WGM > 0 ? nM / WGM : 1; int gid = wgid / nig; if (gid >= ngf) gid = ngf - 1;
        const int fm = gid * WGM, gsz = gid == ngf - 1 ? nM - fm : WGM, w = wgid - gid * nig;
        u.pm = fm + (w % gsz); u.pn = w / gsz; return true;
    }
    __device__ __forceinline__ void a_ready(const Unit&) const {}
    __device__ __forceinline__ void done(const Unit&) const {}
};

__device__ __forceinline__ unsigned cvt_pk_bf16(float lo, float hi) { unsigned r; asm volatile("v_cvt_pk_bf16_f32 %0, %1, %2" : "=v"(r) : "v"(lo), "v"(hi)); return r; }

struct EpiF32B {
    static constexpr bool PERM = false, AFTER_DRAIN = false, APERM = false;
    float* C; int ldc; const float* bias;
    __device__ __forceinline__ void operator()(const f32x4 (&acc)[2][2][4][2], const Unit& u, int wr, int wc, int fr, int fq) const {
        const int row0 = u.pm * BM + wr * 64 + fr, col0 = u.pn * BM + wc * 32 + 4 * fq;
        f32x4 bv[2][2];
#pragma unroll
        for (int bj = 0; bj < 2; ++bj)
#pragma unroll
            for (int n = 0; n < 2; ++n) bv[bj][n] = bias ? *(const f32x4*)(bias + col0 + bj * HALF + n * 16) : (f32x4){0.f, 0.f, 0.f, 0.f};
#pragma unroll
        for (int ai = 0; ai < 2; ++ai)
#pragma unroll
            for (int m = 0; m < 4; ++m) { float* rowp = C + (size_t)(row0 + ai * HALF + m * 16) * ldc + col0;
#pragma unroll
                for (int bj = 0; bj < 2; ++bj)
#pragma unroll
                    for (int n = 0; n < 2; ++n) *(f32x4*)(rowp + bj * HALF + n * 16) = acc[ai][bj][m][n] + bv[bj][n]; }
    }
};
struct EpiBf16B {
    static constexpr bool PERM = true, AFTER_DRAIN = false, APERM = false;
    bf16_t* O; int ldc; const float* bias;
    __device__ __forceinline__ void operator()(const f32x4 (&acc)[2][2][4][2], const Unit& u, int wr, int wc, int fr, int fq) const {
        const int row0 = u.pm * BM + wr * 64 + fr; const int col0 = u.pn * BM + wc * 32 + 8 * fq;
        f32x4 bv[2][2];
#pragma unroll
        for (int bj = 0; bj < 2; ++bj)
#pragma unroll
            for (int n = 0; n < 2; ++n) bv[bj][n] = bias ? *(const f32x4*)(bias + col0 + bj * HALF + 4 * n) : (f32x4){0.f, 0.f, 0.f, 0.f};
#pragma unroll
        for (int ai = 0; ai < 2; ++ai)
#pragma unroll
            for (int m = 0; m < 4; ++m) { bf16_t* rowp = O + (size_t)(row0 + ai * HALF + m * 16) * ldc + col0;
#pragma unroll
                for (int bj = 0; bj < 2; ++bj) { const f32x4 v0 = acc[ai][bj][m][0] + bv[bj][0], v1 = acc[ai][bj][m][1] + bv[bj][1];
                    u32x4 w; w.x = cvt_pk_bf16(v0[0], v0[1]); w.y = cvt_pk_bf16(v0[2], v0[3]); w.z = cvt_pk_bf16(v1[0], v1[1]); w.w = cvt_pk_bf16(v1[2], v1[3]);
                    *(u32x4*)(rowp + bj * HALF) = w; } }
    }
};
struct EpiFox {
    static constexpr bool PERM = true, AFTER_DRAIN = false, APERM = false;
    bf16_t* QKV; float* logf; const float* bfg;
    __device__ __forceinline__ void operator()(const f32x4 (&acc)[2][2][4][2], const Unit& u, int wr, int wc, int fr, int fq) const {
        const int row0 = u.pm * BM + wr * 64 + fr;
        if (u.pn < 48) {
            const int t3 = u.pn >> 4, hp = u.pn & 15;
#pragma unroll
            for (int bj = 0; bj < 2; ++bj) { bf16_t* base = QKV + ((size_t)(t3 * 32 + 2 * hp + bj) * 16384) * 128 + wc * 32 + 8 * fq;
#pragma unroll
                for (int ai = 0; ai < 2; ++ai)
#pragma unroll
                    for (int m = 0; m < 4; ++m) { const f32x4 v0 = acc[ai][bj][m][0], v1 = acc[ai][bj][m][1];
                        u32x4 w; w.x = cvt_pk_bf16(v0[0], v0[1]); w.y = cvt_pk_bf16(v0[2], v0[3]); w.z = cvt_pk_bf16(v1[0], v1[1]); w.w = cvt_pk_bf16(v1[2], v1[3]);
                        *(u32x4*)(base + (size_t)(row0 + ai * HALF + m * 16) * 128) = w; } }
        } else if (wc == 0) {
            const f32x4 b0 = *(const f32x4*)(bfg + 8 * fq), b1 = *(const f32x4*)(bfg + 8 * fq + 4);
#pragma unroll
            for (int ai = 0; ai < 2; ++ai)
#pragma unroll
                for (int m = 0; m < 4; ++m) { float* rowp = logf + (size_t)(row0 + ai * HALF + m * 16) * 32 + 8 * fq;
#pragma unroll
                    for (int n = 0; n < 2; ++n) { const f32x4 z = acc[ai][0][m][n] + (n ? b1 : b0); f32x4 o;
#pragma unroll
                        for (int i = 0; i < 4; ++i) o[i] = fminf(z[i], 0.f) - log1pf(expf(-fabsf(z[i])));
                        *(f32x4*)(rowp + 4 * n) = o; } }
        }
    }
};
struct EpiGlu {
    static constexpr bool PERM = true, AFTER_DRAIN = false, APERM = false;
    bf16_t* C; const float* bias;
    __device__ __forceinline__ void operator()(const f32x4 (&acc)[2][2][4][2], const Unit& u, int wr, int wc, int fr, int fq) const {
        const int row0 = u.pm * BM + wr * 64 + fr, col0 = u.pn * HALF + wc * 32 + 8 * fq;
        f32x4 bv[2], bg[2];
#pragma unroll
        for (int n = 0; n < 2; ++n) { bv[n] = *(const f32x4*)(bias + col0 + 4 * n); bg[n] = *(const f32x4*)(bias + 4096 + col0 + 4 * n); }
#pragma unroll
        for (int ai = 0; ai < 2; ++ai)
#pragma unroll
            for (int m = 0; m < 4; ++m) { bf16_t* rowp = C + (size_t)(row0 + ai * HALF + m * 16) * 4096 + col0; u32x4 w;
#pragma unroll
                for (int n = 0; n < 2; ++n) { const f32x4 zv = acc[ai][0][m][n] + bv[n], zg = acc[ai][1][m][n] + bg[n]; f32x4 o;
#pragma unroll
                    for (int i = 0; i < 4; ++i) o[i] = zv[i] * __builtin_amdgcn_rcpf(1.0f + __builtin_amdgcn_exp2f(-1.4426950408889634f * zg[i]));
                    if (n == 0) { w.x = cvt_pk_bf16(o[0], o[1]); w.y = cvt_pk_bf16(o[2], o[3]); } else { w.z = cvt_pk_bf16(o[0], o[1]); w.w = cvt_pk_bf16(o[2], o[3]); } }
                *(u32x4*)rowp = w; }
    }
};

struct EpiConvGeglu {
    static constexpr bool PERM = true, AFTER_DRAIN = false, APERM = true;
    bf16_t* ACT; const float* cw; const float* cb; PG8_LAS unsigned char* xl; int dff, nrows;
    static __device__ __forceinline__ float shr1(float old, float src) {
        return __builtin_bit_cast(float, __builtin_amdgcn_update_dpp(__builtin_bit_cast(int, old), __builtin_bit_cast(int, src), 0x111, 0xf, 0xf, false)); }
    static __device__ __forceinline__ float gelu_t(float x) { const float t = 0.7978845608028654f * (x + 0.044715f * x * x * x); return x * __builtin_amdgcn_rcpf(1.0f + __builtin_amdgcn_exp2f(-2.8853900817779268f * t)); }
    __device__ __forceinline__ void operator()(const f32x4 (&acc)[2][2][4][2], const Unit& u, int wr, int wc, int fr, int fq) const {
        asm volatile("" : "+v"(fr), "+v"(fq));
#define XOFF(ai_, w_, rr_, bj_, n_) ((((((ai_) * 2 + (w_)) * 2 + (rr_)) * 2 + (bj_)) * 4 + wc) * 128 + fq * 32 + (n_) * 16)
        f32x4 wv[8];
        { const int gc = u.pn * HALF + wc * 32 + 8 * fq;
            wv[0] = *(const f32x4*)(cw + gc); wv[1] = *(const f32x4*)(cw + 2 * dff + gc); wv[2] = *(const f32x4*)(cw + 4 * dff + gc); wv[3] = *(const f32x4*)(cb + gc);
            wv[4] = *(const f32x4*)(cw + dff + gc); wv[5] = *(const f32x4*)(cw + 3 * dff + gc); wv[6] = *(const f32x4*)(cw + 5 * dff + gc); wv[7] = *(const f32x4*)(cb + dff + gc); }
        if (fr == 15) {
#pragma unroll
            for (int ai = 0; ai < 2; ++ai)
#pragma unroll
                for (int bj = 0; bj < 2; ++bj)
#pragma unroll
                    for (int n = 0; n < 2; ++n) { *(PG8_LAS f32x4*)(xl + XOFF(ai, wr, 0, bj, n)) = acc[ai][bj][2][n]; *(PG8_LAS f32x4*)(xl + XOFF(ai, wr, 1, bj, n)) = acc[ai][bj][3][n]; }
        }
        asm volatile("s_waitcnt lgkmcnt(0)" ::: "memory"); __builtin_amdgcn_s_barrier(); asm volatile("" ::: "memory");
        u32x2 keep[2][4];
#pragma unroll
        for (int n = 0; n < 2; ++n) {
            const int gcol = u.pn * HALF + wc * 32 + 8 * fq + 4 * n;
            if (n) { wv[0] = *(const f32x4*)(cw + gcol); wv[1] = *(const f32x4*)(cw + 2 * dff + gcol); wv[2] = *(const f32x4*)(cw + 4 * dff + gcol); wv[3] = *(const f32x4*)(cb + gcol);
                     wv[4] = *(const f32x4*)(cw + dff + gcol); wv[5] = *(const f32x4*)(cw + 3 * dff + gcol); wv[6] = *(const f32x4*)(cw + 5 * dff + gcol); wv[7] = *(const f32x4*)(cb + dff + gcol); }
            const f32x4 wg0 = wv[0], wg1 = wv[1], wg2 = wv[2], bg = wv[3], wu0 = wv[4], wu1 = wv[5], wu2 = wv[6], bu = wv[7];
#pragma unroll
            for (int ai = 0; ai < 2; ++ai) {
                f32x4 Xg2 = {0.f, 0.f, 0.f, 0.f}, Xg3 = Xg2, Xu2 = Xg2, Xu3 = Xg2;
                if (ai + wr > 0) { const int pa = wr ? ai : ai - 1, pw = wr ? 0 : 1;
                    Xg2 = *(const PG8_LAS f32x4*)(xl + XOFF(pa, pw, 0, 0, n)); Xg3 = *(const PG8_LAS f32x4*)(xl + XOFF(pa, pw, 1, 0, n));
                    Xu2 = *(const PG8_LAS f32x4*)(xl + XOFF(pa, pw, 0, 1, n)); Xu3 = *(const PG8_LAS f32x4*)(xl + XOFF(pa, pw, 1, 1, n)); }
                float o[4][4];
#pragma unroll
                for (int ip = 0; ip < 2; ++ip) {
                    const int i0 = 2 * ip, i1 = 2 * ip + 1;
#define P2(v) ((f32x2){(v)[i0], (v)[i1]})
                    const f32x2 g0 = P2(acc[ai][0][0][n]), g1 = P2(acc[ai][0][1][n]), g2 = P2(acc[ai][0][2][n]), g3 = P2(acc[ai][0][3][n]);
                    const f32x2 u0 = P2(acc[ai][1][0][n]), u1 = P2(acc[ai][1][1][n]), u2 = P2(acc[ai][1][2][n]), u3 = P2(acc[ai][1][3][n]);
                    const f32x2 gm1 = {shr1(Xg3[i0], g3.x), shr1(Xg3[i1], g3.y)}, gm2 = {shr1(Xg2[i0], g2.x), shr1(Xg2[i1], g2.y)};
                    const f32x2 um1 = {shr1(Xu3[i0], u3.x), shr1(Xu3[i1], u3.y)}, um2 = {shr1(Xu2[i0], u2.x), shr1(Xu2[i1], u2.y)};
                    const f32x2 a2 = P2(wg2), a1 = P2(wg1), a0 = P2(wg0), ab = P2(bg), c2 = P2(wu2), c1 = P2(wu1), c0 = P2(wu0), cb = P2(bu);
#define FMA2(a, b, c) __builtin_elementwise_fma((a), (b), (c))
                    const f32x2 zg[4] = {FMA2(a0, gm2, FMA2(a1, gm1, FMA2(a2, g0, ab))), FMA2(a0, gm1, FMA2(a1, g0, FMA2(a2, g1, ab))), FMA2(a0, g0, FMA2(a1, g1, FMA2(a2, g2, ab))), FMA2(a0, g1, FMA2(a1, g2, FMA2(a2, g3, ab)))};
                    const f32x2 zu[4] = {FMA2(c0, um2, FMA2(c1, um1, FMA2(c2, u0, cb))), FMA2(c0, um1, FMA2(c1, u0, FMA2(c2, u1, cb))), FMA2(c0, u0, FMA2(c1, u1, FMA2(c2, u2, cb))), FMA2(c0, u1, FMA2(c1, u2, FMA2(c2, u3, cb)))};
#pragma unroll
                    for (int m = 0; m < 4; ++m) {
                        const f32x2 x = zg[m], x2 = x * x; const f32x2 kk = {-2.302208198f, -2.302208198f}, k3 = {-2.302208198f * 0.044715f, -2.302208198f * 0.044715f}, one = {1.f, 1.f};
                        const f32x2 a = x * FMA2(x2, k3, kk); const f32x2 e = {__builtin_amdgcn_exp2f(a.x), __builtin_amdgcn_exp2f(a.y)}; const f32x2 d = e + one;
                        const f32x2 r = {__builtin_amdgcn_rcpf(d.x), __builtin_amdgcn_rcpf(d.y)}; const f32x2 ov = (x * zu[m]) * r;
                        o[m][i0] = ov.x; o[m][i1] = ov.y; }
#undef FMA2
#undef P2
                }
#pragma unroll
                for (int m = 0; m < 4; ++m) { const int it = ai * HALF + wr * 64 + 4 * fr + m, grow = u.pm * 254 - 2 + it;
                    u32x2 w; w.x = cvt_pk_bf16(o[m][0], o[m][1]); w.y = cvt_pk_bf16(o[m][2], o[m][3]);
                    if (n == 0) keep[ai][m] = w;
                    else if (it >= 2 && grow < nrows) { u32x4 ww; ww.x = keep[ai][m].x; ww.y = keep[ai][m].y; ww.z = w.x; ww.w = w.y; *(u32x4*)(ACT + (size_t)grow * dff + gcol - 4) = ww; } }
            }
        }
#undef XOFF
    }
};

template <class Epi, class Sched, bool ALIGN_EPI = false, bool SP2 = false, bool F8 = false>
__device__ __forceinline__ void gemm_phase(PG8_LAS unsigned char* lds, const Gemm g, const Sched& S, const Epi& E) {
    const int tid = mk_tid(), wid = __builtin_amdgcn_readfirstlane(tid >> 6), lane = tid & 63, wr = wid >> 2, wc = wid & 3, fr = lane & 15, fq = lane >> 4;
    const int K = g.K, nt = K / BK;
    unsigned voffA, voffB;
    { int R, C; stage_rc(tid * 16, R, C); const int Rb = Epi::PERM ? ((R & ~31) + perm32(R & 31)) : R;
        const int Ra = Epi::APERM ? ((R & ~63) + 4 * (R & 15) + ((R >> 4) & 3)) : R;
        voffA = (unsigned)(Ra * K + C) * 2u; voffB = (unsigned)(Rb * K + C) * 2u; }
    const size_t r64 = (size_t)64 * K * 2;
    const size_t kstep = (size_t)(BK * 2);
    const size_t hstep = (size_t)HALF * K * 2;
    const size_t tstep = 2 * hstep;
    const size_t tstepA = (size_t)g.apr * K * 2;
    const unsigned ldsw = (unsigned)wid * 1024u;
    const int aoff = lds_byte(wr * 64 + fr, fq * 8), boff = lds_byte(wc * 32 + fr, fq * 8);
#define PG8_SA(b, h) (((b) * 2 + (h)) * HTB)
#define PG8_SB(b, h) ((4 + (b) * 2 + (h)) * HTB)
#define PG8_STAGE(bufoff, gbase, voff) do { _Pragma("unroll") for (int _i = 0; _i < 2; ++_i) \
        __builtin_amdgcn_global_load_lds((const unsigned*)((const char*)(gbase) + (size_t)_i * r64 + (voff)), (PG8_LAS unsigned*)(lds + (bufoff) + ldsw + _i * 8192), 16, 0, 0); } while (0)
#define PG8_LDA(dst, b, h) do { _Pragma("unroll") for (int m = 0; m < 4; ++m) _Pragma("unroll") for (int k = 0; k < 2; ++k) dst[m][k] = *(const PG8_LAS bf16x8*)(lds + PG8_SA(b, h) + aoff + m * 2048 + k * 1024); } while (0)
#define PG8_LDB(dst, b, h) do { _Pragma("unroll") for (int n = 0; n < 2; ++n) _Pragma("unroll") for (int k = 0; k < 2; ++k) dst[n][k] = *(const PG8_LAS bf16x8*)(lds + PG8_SB(b, h) + boff + n * 2048 + k * 1024); } while (0)
#define PG8_CAT(f) __builtin_shufflevector(__builtin_bit_cast(v4i32, (f)[0]), __builtin_bit_cast(v4i32, (f)[1]), 0, 1, 2, 3, 4, 5, 6, 7)
#define PG8_MMA(ai, bj, At, Bt) do { __builtin_amdgcn_s_setprio(1); _Pragma("unroll") for (int m = 0; m < 4; ++m) _Pragma("unroll") for (int n = 0; n < 2; ++n) { \
        if constexpr (F8) acc[ai][bj][m][n] = __builtin_amdgcn_mfma_scale_f32_16x16x128_f8f6f4(PG8_CAT(Bt[n]), PG8_CAT(At[m]), acc[ai][bj][m][n], 0, 0, 0, F8_SCALE_W, 0, F8_SCALE_X); \
        else { _Pragma("unroll") for (int k = 0; k < 2; ++k) acc[ai][bj][m][n] = __builtin_amdgcn_mfma_f32_16x16x32_bf16(Bt[n][k], At[m][k], acc[ai][bj][m][n], 0, 0, 0); } } \
        __builtin_amdgcn_s_setprio(0); } while (0)
#define PG8_WAIT_V(n) asm volatile("s_waitcnt vmcnt(" #n ")" ::: "memory")
#define PG8_WAIT_L(n) asm volatile("s_waitcnt lgkmcnt(" #n ")" ::: "memory")
#define PG8_BAR __builtin_amdgcn_s_barrier()
#define PG8_SCHED __builtin_amdgcn_sched_barrier(0)
    Unit cur, nxt; int ui = 0;
    if (!S.next(0, cur)) return;
    f32x4 acc[2][2][4][2];
#pragma unroll
    for (int a = 0; a < 2; ++a)
#pragma unroll
        for (int b = 0; b < 2; ++b)
#pragma unroll
            for (int m = 0; m < 4; ++m)
#pragma unroll
                for (int n = 0; n < 2; ++n) acc[a][b][m][n] = (f32x4){0.f, 0.f, 0.f, 0.f};
    bf16x8 At[4][2], B0[2][2], B1[2][2];
    const char* cA = (const char*)g.A + (size_t)cur.pm * tstepA; const char* cB = (const char*)g.Bt + (size_t)cur.pn * tstep;
    S.a_ready(cur);
    if constexpr (SP2) {
        PG8_STAGE(PG8_SB(0, 0), cB, voffB); PG8_STAGE(PG8_SB(0, 1), cB + hstep, voffB); PG8_STAGE(PG8_SA(0, 0), cA, voffA); PG8_STAGE(PG8_SA(0, 1), cA + hstep, voffA);
        if (wr == 1) PG8_BAR;
        PG8_WAIT_V(2); PG8_BAR;
        PG8_STAGE(PG8_SB(1, 0), cB + kstep, voffB); PG8_STAGE(PG8_SA(1, 0), cA + kstep, voffA); PG8_STAGE(PG8_SB(1, 1), cB + hstep + kstep, voffB);
        PG8_WAIT_V(6); PG8_BAR;
    } else {
        PG8_STAGE(PG8_SB(0, 0), cB, voffB); PG8_STAGE(PG8_SA(0, 0), cA, voffA); PG8_STAGE(PG8_SB(0, 1), cB + hstep, voffB); PG8_STAGE(PG8_SA(0, 1), cA + hstep, voffA);
        if (wr == 1) PG8_BAR;
        PG8_WAIT_V(4); PG8_BAR;
        PG8_STAGE(PG8_SB(1, 0), cB + kstep, voffB); PG8_STAGE(PG8_SA(1, 0), cA + kstep, voffA); PG8_STAGE(PG8_SB(1, 1), cB + hstep + kstep, voffB);
        PG8_WAIT_V(6); PG8_BAR;
    }
    for (;;) {
        const bool has_next = S.next(ui + 1, nxt);
        const char* nA = has_next ? (const char*)g.A + (size_t)nxt.pm * tstepA : cA; const char* nB = has_next ? (const char*)g.Bt + (size_t)nxt.pn * tstep : cB;
        for (int t = 0; t < nt; t += 2) {
            const bool last = (t == nt - 2);
            const char* a1 = cA + (size_t)(t + 1) * kstep;
            const char* a2 = last ? nA : cA + (size_t)(t + 2) * kstep; const char* b2 = last ? nB : cB + (size_t)(t + 2) * kstep;
            const char* a3 = a2 + kstep; const char* b3 = b2 + kstep;
            if (last && has_next) S.a_ready(nxt);
            if constexpr (SP2) {
            PG8_LDB(B0, 0, 0); PG8_LDB(B1, 0, 1); PG8_SCHED; PG8_LDA(At, 0, 0); PG8_STAGE(PG8_SA(1, 1), a1 + hstep, voffA);
            PG8_WAIT_V(8); PG8_WAIT_L(0); PG8_BAR; PG8_MMA(0, 0, At, B0); PG8_MMA(0, 1, At, B1); PG8_BAR; PG8_SCHED;
            PG8_LDA(At, 0, 1); PG8_STAGE(PG8_SB(0, 0), b2, voffB); PG8_STAGE(PG8_SB(0, 1), b2 + hstep, voffB); PG8_STAGE(PG8_SA(0, 0), a2, voffA);
            PG8_WAIT_V(8); PG8_WAIT_L(0); PG8_BAR; PG8_MMA(1, 0, At, B0); PG8_MMA(1, 1, At, B1); PG8_BAR; PG8_SCHED;
            PG8_LDB(B0, 1, 0); PG8_LDB(B1, 1, 1); PG8_SCHED; PG8_LDA(At, 1, 0); PG8_STAGE(PG8_SA(0, 1), a2 + hstep, voffA);
            PG8_WAIT_V(8); PG8_WAIT_L(0); PG8_BAR; PG8_MMA(0, 0, At, B0); PG8_MMA(0, 1, At, B1); PG8_BAR; PG8_SCHED;
            PG8_LDA(At, 1, 1); PG8_STAGE(PG8_SB(1, 0), b3, voffB); PG8_STAGE(PG8_SB(1, 1), b3 + hstep, voffB); PG8_STAGE(PG8_SA(1, 0), a3, voffA);
            PG8_WAIT_V(8); PG8_WAIT_L(0); PG8_BAR; PG8_MMA(1, 0, At, B0); PG8_MMA(1, 1, At, B1); PG8_BAR; PG8_SCHED;
            } else {
            PG8_LDB(B0, 0, 0); PG8_SCHED; PG8_LDA(At, 0, 0); PG8_STAGE(PG8_SA(1, 1), a1 + hstep, voffA);
            PG8_WAIT_L(8); PG8_BAR; PG8_WAIT_L(0); PG8_MMA(0, 0, At, B0); PG8_BAR; PG8_SCHED;
            PG8_LDB(B1, 0, 1); PG8_STAGE(PG8_SB(0, 0), b2, voffB);
            PG8_BAR; PG8_WAIT_L(0); PG8_MMA(0, 1, At, B1); PG8_BAR;
            PG8_LDA(At, 0, 1); PG8_STAGE(PG8_SA(0, 0), a2, voffA);
            PG8_BAR; PG8_WAIT_L(0); PG8_MMA(1, 0, At, B0); PG8_BAR; PG8_SCHED;
            PG8_STAGE(PG8_SB(0, 1), b2 + hstep, voffB);
            PG8_WAIT_V(6); PG8_BAR; PG8_MMA(1, 1, At, B1); PG8_BAR;
            PG8_LDB(B0, 1, 0); PG8_SCHED; PG8_LDA(At, 1, 0); PG8_STAGE(PG8_SA(0, 1), a2 + hstep, voffA);
            PG8_WAIT_L(8); PG8_BAR; PG8_WAIT_L(0); PG8_MMA(0, 0, At, B0); PG8_BAR; PG8_SCHED;
            PG8_LDB(B1, 1, 1); PG8_STAGE(PG8_SB(1, 0), b3, voffB);
            PG8_BAR; PG8_WAIT_L(0); PG8_MMA(0, 1, At, B1); PG8_BAR;
            PG8_LDA(At, 1, 1); PG8_STAGE(PG8_SA(1, 0), a3, voffA);
            PG8_BAR; PG8_WAIT_L(0); PG8_MMA(1, 0, At, B0); PG8_BAR; PG8_SCHED;
            PG8_STAGE(PG8_SB(1, 1), b3 + hstep, voffB);
            PG8_WAIT_V(6); PG8_BAR; PG8_MMA(1, 1, At, B1); PG8_BAR;
            }
        }
        if constexpr (ALIGN_EPI) { if (wr == 0) PG8_BAR; }
        if constexpr (!Epi::AFTER_DRAIN) { E(acc, cur, wr, wc, fr, fq); S.done(cur); }
        if (!has_next) break;
#pragma unroll
        for (int a = 0; a < 2; ++a)
#pragma unroll
            for (int b = 0; b < 2; ++b)
#pragma unroll
                for (int m = 0; m < 4; ++m)
#pragma unroll
                    for (int n = 0; n < 2; ++n) acc[a][b][m][n] = (f32x4){0.f, 0.f, 0.f, 0.f};
        cur = nxt; cA = nA; cB = nB; ++ui;
        if constexpr (ALIGN_EPI) { if (wr == 1) PG8_BAR; }
    }
    PG8_WAIT_V(0);
    if constexpr (!ALIGN_EPI) { if (wr == 0) PG8_BAR; }
    PG8_BAR;
    if constexpr (Epi::AFTER_DRAIN) { E.fused(acc, cur, wr, wc, fr, fq, lds, wid, lane); S.done(cur); }
#undef PG8_SA
#undef PG8_SB
#undef PG8_STAGE
#undef PG8_LDA
#undef PG8_LDB
#undef PG8_MMA
#undef PG8_CAT
#undef PG8_WAIT_V
#undef PG8_WAIT_L
#undef PG8_BAR
#undef PG8_SCHED
}
}

namespace fox {
#define LAS3 __attribute__((address_space(3)))
constexpr int D = 128, SEQ = 16384, NH = 32, OPITCH = 4096;
constexpr float SCALE = 0.08838834764831845f;
constexpr float THR = 8.f;
constexpr int NW = 8, QBLK = 32, KVBLK = 64, QB = NW * QBLK;
constexpr int SHM_V = KVBLK * D * 2, SHM_K = KVBLK * D * 2;
constexpr int OFF_WS = 2 * SHM_V + 2 * SHM_K, OFF_BIAS = OFF_WS + NW * 64 * 4, OFF_QW = OFF_BIAS + 2 * 64 * 4, OFF_JLO = OFF_QW + 16, OFF_KEY = OFF_JLO + 2048, OFF_ORD = OFF_KEY + 8192, LDS_BYTES = OFF_ORD + 4096;
constexpr float SKIP_T = 30.f;
typedef unsigned short bf16;
typedef short bf16x8 __attribute__((ext_vector_type(8)));
typedef short s16x4 __attribute__((ext_vector_type(4)));
typedef float f32x16 __attribute__((ext_vector_type(16)));
typedef float f32x4 __attribute__((ext_vector_type(4)));
typedef unsigned u32x4 __attribute__((ext_vector_type(4)));

#define KSWZ(row, colB) ((row) * 256 + ((colB) ^ (((row) & 7) << 4)))
#define SBAR() __builtin_amdgcn_sched_barrier(0)
__device__ __forceinline__ int v_st(int k, int c) { const int kk = (k & ~0xC) | ((k & 4) << 1) | ((k & 8) >> 1); return ((kk >> 3) * 4 + (c >> 5)) * 512 + ((kk & 7) * 32 + (c & 31)) * 2; }
__device__ __forceinline__ int v_rd_base(int lane) { return ((lane & 3) << 3) | (((lane >> 2) & 3) << 6) | (((lane >> 4) & 1) << 5) | (((lane >> 5) & 1) << 8); }
constexpr int v_rd_off(int d0, int ks, int half) { return d0 * 512 + ks * 4096 + half * 2048; }
__device__ __forceinline__ int crow(int r, int hi) { return (r & 3) + 8 * (r >> 2) + 4 * hi; }
__device__ __forceinline__ unsigned cvtpk(float lo, float hi) { unsigned r; asm volatile("v_cvt_pk_bf16_f32 %0, %1, %2" : "=v"(r) : "v"(lo), "v"(hi)); return r; }
__device__ __forceinline__ bf16x8 load8(const bf16* p) { return *reinterpret_cast<const bf16x8*>(p); }
__device__ __forceinline__ void mask_tile(f32x16& p0, f32x16& p1, int dq) {
    const float NEG = -__builtin_inff();
#pragma unroll
    for (int r = 0; r < 16; ++r) {
        const int c = (r & 3) + 8 * (r >> 2);
        if (dq - c < 0) p0[r] = NEG;
        if (dq - c - 32 < 0) p1[r] = NEG;
    }
}
__device__ __forceinline__ void partialSM(f32x16& p0, f32x16& p1, float& m_reg, float& mn, float& alpha) {
    float pmax = p0[0]; for (int r = 1; r < 16; ++r) pmax = fmaxf(pmax, p0[r]); for (int r = 0; r < 16; ++r) pmax = fmaxf(pmax, p1[r]);
    { auto rr = __builtin_amdgcn_permlane32_swap(__float_as_uint(pmax), __float_as_uint(pmax), false, false);
      pmax = fmaxf(__uint_as_float(rr[0]), __uint_as_float(rr[1])); }
    constexpr float C2 = 1.4426950408889634f * SCALE;
    if (__builtin_expect(__all((pmax - m_reg) * SCALE <= THR), 1)) { mn = m_reg; alpha = 1.f; }
    else { mn = fmaxf(m_reg, pmax); alpha = __builtin_amdgcn_exp2f((m_reg - mn) * C2); m_reg = mn; }
    const float mnL = -mn * C2;
    for (int r = 0; r < 16; ++r) p0[r] = fmaf(p0[r], C2, mnL); for (int r = 0; r < 16; ++r) p1[r] = fmaf(p1[r], C2, mnL);
    for (int r = 0; r < 16; ++r) p0[r] = __builtin_amdgcn_exp2f(p0[r]);
}
__device__ __forceinline__ void finishSM(f32x16& p0, f32x16& p1, float alpha, float& l_reg, bf16x8& pa0, bf16x8& pa1, bf16x8& pa2, bf16x8& pa3) {
    for (int r = 0; r < 16; ++r) p1[r] = __builtin_amdgcn_exp2f(p1[r]);
    float ps = 0; for (int r = 0; r < 16; ++r) ps += p0[r]; for (int r = 0; r < 16; ++r) ps += p1[r];
    { auto rr = __builtin_amdgcn_permlane32_swap(__float_as_uint(ps), __float_as_uint(ps), false, false);
      ps = __uint_as_float(rr[0]) + __uint_as_float(rr[1]); }
    l_reg = l_reg * alpha + ps;
#define PK4(P, B_, OUT) do { unsigned a0 = cvtpk(P[B_+0], P[B_+1]), a1 = cvtpk(P[B_+2], P[B_+3]);                          \
        unsigned b0 = cvtpk(P[B_+4], P[B_+5]), b1 = cvtpk(P[B_+6], P[B_+7]);                                             \
        auto r0 = __builtin_amdgcn_permlane32_swap(a0, b0, false, false); auto r1 = __builtin_amdgcn_permlane32_swap(a1, b1, false, false); \
        u32x4 w = {r0[0], r1[0], r0[1], r1[1]}; OUT = *reinterpret_cast<bf16x8*>(&w); } while (0)
    PK4(p0, 0, pa0); PK4(p0, 8, pa1); PK4(p1, 0, pa2); PK4(p1, 8, pa3);
}
template <int KB>
__device__ __forceinline__ void qkt(f32x16& p0, f32x16& p1, const char* K_lds, const char* B_lds, int r32, int hi, const bf16x8* qr) {
    const float* bl = (const float*)B_lds + KB * 64 + 4 * hi;
#pragma unroll
    for (int g = 0; g < 4; ++g) { const f32x4 a = *(const f32x4*)(bl + 8 * g), b = *(const f32x4*)(bl + 32 + 8 * g);
        p0[4 * g + 0] = a[0]; p0[4 * g + 1] = a[1]; p0[4 * g + 2] = a[2]; p0[4 * g + 3] = a[3];
        p1[4 * g + 0] = b[0]; p1[4 * g + 1] = b[1]; p1[4 * g + 2] = b[2]; p1[4 * g + 3] = b[3]; }
    const char* kb[4];
#pragma unroll
    for (int dd = 0; dd < 4; ++dd) kb[dd] = K_lds + KB * SHM_K + KSWZ(r32, (dd * 16 + hi * 8) * 2);
#pragma unroll
    for (int d0 = 0; d0 < 8; ++d0) { const char* a = kb[d0 & 3] + (d0 >> 2) * 128;
        bf16x8 b0 = *reinterpret_cast<const bf16x8*>(a);
        bf16x8 b1 = *reinterpret_cast<const bf16x8*>(a + 32 * 256);
        p0 = __builtin_amdgcn_mfma_f32_32x32x16_bf16(b0, qr[d0], p0, 0, 0, 0);
        p1 = __builtin_amdgcn_mfma_f32_32x32x16_bf16(b1, qr[d0], p1, 0, 0, 0); }
}
template <int VB>
__device__ __forceinline__ void pv_tile(f32x16* o, int vb0, bf16x8 pa0, bf16x8 pa1, bf16x8 pa2, bf16x8 pa3) {
#define TRRD(dst, off) asm volatile("ds_read_b64_tr_b16 %0, %1 offset:%2" : "=&v"(dst) : "v"(vb0), "i"(off) : "memory")
#define PV_D0(d0) do { s16x4 l0, l1, l2, l3, h0, h1, h2, h3; constexpr int b_ = VB * SHM_V + v_rd_off(d0, 0, 0);     \
        TRRD(l0, b_); TRRD(h0, b_ + 2048); TRRD(l1, b_ + 4096); TRRD(h1, b_ + 6144); TRRD(l2, b_ + 8192); TRRD(h2, b_ + 10240); TRRD(l3, b_ + 12288); TRRD(h3, b_ + 14336); \
        asm volatile("s_waitcnt lgkmcnt(0)" ::: "memory"); SBAR();                                                                              \
        o[d0] = __builtin_amdgcn_mfma_f32_32x32x16_bf16((bf16x8){l0[0], l0[1], l0[2], l0[3], h0[0], h0[1], h0[2], h0[3]}, pa0, o[d0], 0, 0, 0);   \
        o[d0] = __builtin_amdgcn_mfma_f32_32x32x16_bf16((bf16x8){l1[0], l1[1], l1[2], l1[3], h1[0], h1[1], h1[2], h1[3]}, pa1, o[d0], 0, 0, 0);   \
        o[d0] = __builtin_amdgcn_mfma_f32_32x32x16_bf16((bf16x8){l2[0], l2[1], l2[2], l2[3], h2[0], h2[1], h2[2], h2[3]}, pa2, o[d0], 0, 0, 0);   \
        o[d0] = __builtin_amdgcn_mfma_f32_32x32x16_bf16((bf16x8){l3[0], l3[1], l3[2], l3[3], h3[0], h3[1], h3[2], h3[3]}, pa3, o[d0], 0, 0, 0); } while (0)
    PV_D0(0); PV_D0(1); PV_D0(2); PV_D0(3);
#undef PV_D0
#undef TRRD
}

struct BlockRef { const bf16* Q; const bf16* K; const bf16* V; const float* C; bf16* O; int P0; int jlo; };
struct Seam {
    bf16x8 qr[8];
    bf16x8 st_v0, st_v1, st_k0, st_k1; float st_b;
};
#define ROW(p, k0, rr) ((p) + (size_t)((k0) + (rr)) * D + sc)
#define VMW() asm volatile("s_waitcnt vmcnt(0)" ::: "memory")
#define VMWN(n) asm volatile("s_waitcnt vmcnt(%0)" :: "i"(n) : "memory")
#define SLOAD_H(Kp, Vp, Cp, k0) do { S.st_v0 = load8(ROW(Vp, k0, sr)); S.st_v1 = load8(ROW(Vp, k0, 32 + sr));              \
                         S.st_k0 = load8(ROW(Kp, k0, sr)); S.st_k1 = load8(ROW(Kp, k0, 32 + sr)); if (tid < 64) S.st_b = (Cp)[(k0) + tid]; } while (0)
#define SWRITE_HK(bf, cr) do { *(bf16x8*)(K_lds + (bf) * SHM_K + kws) = S.st_k0; *(bf16x8*)(K_lds + (bf) * SHM_K + kws + 32 * 256) = S.st_k1; \
                         if (tid < 64) ((float*)B_lds)[(bf) * 64 + tid] = S.st_b - (cr); } while (0)
#define SWRITE_HV(bf) do { *(bf16x8*)(V_lds + (bf) * SHM_V + vst0) = S.st_v0; *(bf16x8*)(V_lds + (bf) * SHM_V + vst1) = S.st_v1; } while (0)
#define SWRITE_H(bf, cr) do { SWRITE_HV(bf); SWRITE_HK(bf, cr); } while (0)
__device__ __forceinline__ void fox_prime(const BlockRef& cur, char* lds, Seam& S) {
    const int tid = mk_tid(), wid = __builtin_amdgcn_readfirstlane(tid >> 6), lane = tid & 63, r32 = lane & 31, hi = lane >> 5;
    const int sr = tid >> 4, sc = (tid & 15) * 8, kws = KSWZ(sr, sc * 2); char* K_lds = lds + 2 * SHM_V; char* B_lds = lds + OFF_BIAS;
    const float cref = __uint_as_float(__builtin_amdgcn_readfirstlane(__float_as_uint(cur.C[cur.P0])));
    for (int d0 = 0; d0 < 8; ++d0) S.qr[d0] = load8(cur.Q + (size_t)(wid * QBLK + r32) * D + d0 * 16 + hi * 8);
    SLOAD_H(cur.K, cur.V, cur.C, cur.jlo * KVBLK); VMW(); SWRITE_HK(0, cref);
    __syncthreads();
}
template <class NextFn> __device__ __forceinline__ BlockRef fox_block(const BlockRef& cur, char* lds, Seam& S, unsigned* qctr, const NextFn& mkref, bool& has_next) {
    const int tid = mk_tid(), wid = __builtin_amdgcn_readfirstlane(tid >> 6), lane = tid & 63, r32 = lane & 31, hi = lane >> 5;
    const int j_lo = cur.jlo, NT = (cur.P0 + QB - 1) / KVBLK + 1 - j_lo;
    unsigned qv = 0u; if (tid == 0) qv = __hip_atomic_fetch_add(qctr, 1u, __ATOMIC_RELAXED, __HIP_MEMORY_SCOPE_AGENT);
    const int qlo = cur.P0 + wid * QBLK, qm = qlo + r32 - 4 * hi;
    char* V_lds = lds; char* K_lds = lds + 2 * SHM_V; char* B_lds = lds + OFF_BIAS;
    float m_reg = -1e30f, l_reg = 0; f32x16 o[4] = {};
    const int sr = tid >> 4, sc = (tid & 15) * 8, vst0 = v_st(sr, sc), vst1 = v_st(32 + sr, sc), kws = KSWZ(sr, sc * 2);
    const int vb0 = (int)(uintptr_t)V_lds + v_rd_base(lane);
    const bf16* Kh = cur.K; const bf16* Vh = cur.V; const float* Ch = cur.C;
    const float cref = __uint_as_float(__builtin_amdgcn_readfirstlane(__float_as_uint(cur.C[cur.P0])));
#define RESC(a) do { if (__any((a) < 1.f)) { for (int d_ = 0; d_ < 4; ++d_) for (int r = 0; r < 16; ++r) o[d_][r] *= (a); } } while (0)
#define KBASE(t) ((j_lo + (t)) * KVBLK)
#define MASKT(P0_, P1_, t) do { const int kb_ = KBASE(t); if (kb_ + KVBLK - 1 > qlo) mask_tile(P0_, P1_, qm - kb_); } while (0)
    constexpr int NQL = 8;
#define SEAM_K0() do { VMWN(NQL); SWRITE_HK(0, crefn); SBAR(); } while (0)
    f32x16 pA0, pA1, pB0, pB1; float mnA, mnB, alA, alB; bf16x8 pa0, pa1, pa2, pa3;
    SWRITE_HV(0); SBAR();
    if (NT > 1) { SLOAD_H(Kh, Vh, Ch, KBASE(1)); }
    SBAR(); qkt<0>(pA0, pA1, K_lds, B_lds, r32, hi, S.qr);
    MASKT(pA0, pA1, 0); partialSM(pA0, pA1, m_reg, mnA, alA);
    if (NT > 1) { VMW(); SWRITE_H(1, cref); }
    if (tid == 0) *(volatile LAS3 unsigned*)(lds + OFF_QW) = qv;
    __syncthreads();
    const unsigned inext = (unsigned)__builtin_amdgcn_readfirstlane((int)*(volatile LAS3 unsigned*)(lds + OFF_QW)); has_next = inext < (unsigned)(NH * (SEQ / QB));
    const BlockRef nxt = has_next ? mkref((int)inext) : cur;
    const float crefn = __uint_as_float(__builtin_amdgcn_readfirstlane(__float_as_uint(nxt.C[nxt.P0]))); const int kbn = nxt.jlo * KVBLK;
#define HALF_STEP(PX0, PX1, mnX, alX, PY0, PY1, alY, t, KB, VB, SB) do {                                                      \
        SBAR(); qkt<KB>(PX0, PX1, K_lds, B_lds, r32, hi, S.qr);                                                               \
        finishSM(PY0, PY1, alY, l_reg, pa0, pa1, pa2, pa3); SBAR();                                                           \
        if ((t) + 1 < NT) { SLOAD_H(Kh, Vh, Ch, KBASE((t) + 1)); SBAR(); }                                                    \
        pv_tile<VB>(o, vb0, pa0, pa1, pa2, pa3); MASKT(PX0, PX1, (t)); partialSM(PX0, PX1, m_reg, mnX, alX);                  \
        __syncthreads();                                                                                                      \
        if ((t) + 1 < NT) { VMW(); SWRITE_H(SB, cref); }                                                                      \
        RESC(alX); __syncthreads(); } while (0)
    for (int t = 1; t + 1 < NT; t += 2) {
        HALF_STEP(pB0, pB1, mnB, alB, pA0, pA1, alA, t, 1, 0, 0);
        HALF_STEP(pA0, pA1, mnA, alA, pB0, pB1, alB, t + 1, 0, 1, 1);
    }
    const bool even = (NT & 1) == 0;
    if (even) { SBAR(); qkt<1>(pB0, pB1, K_lds, B_lds, r32, hi, S.qr); SBAR(); }
    SLOAD_H(nxt.K, nxt.V, nxt.C, kbn); SBAR();
#pragma unroll
    for (int d0 = 0; d0 < 8; ++d0) S.qr[d0] = load8(nxt.Q + (size_t)(wid * QBLK + r32) * D + d0 * 16 + hi * 8);
    SBAR();
    finishSM(pA0, pA1, alA, l_reg, pa0, pa1, pa2, pa3); SBAR();
    pv_tile<0>(o, vb0, pa0, pa1, pa2, pa3);
    if (even) { MASKT(pB0, pB1, NT - 1); partialSM(pB0, pB1, m_reg, mnB, alB); __syncthreads(); RESC(alB);
        finishSM(pB0, pB1, alB, l_reg, pa0, pa1, pa2, pa3); SBAR(); pv_tile<1>(o, vb0, pa0, pa1, pa2, pa3); }
    SBAR(); SEAM_K0();
    {
        const float rl = __builtin_amdgcn_rcpf(l_reg);
        bf16* Ow = cur.O + (size_t)(wid * QBLK + r32) * OPITCH + 8 * hi;
#pragma unroll
        for (int d0 = 0; d0 < 4; ++d0)
#pragma unroll
            for (int gp = 0; gp < 2; ++gp) { const int b_ = 8 * gp;
                const unsigned a0 = cvtpk(o[d0][b_ + 0] * rl, o[d0][b_ + 1] * rl), a1 = cvtpk(o[d0][b_ + 2] * rl, o[d0][b_ + 3] * rl);
                const unsigned b0 = cvtpk(o[d0][b_ + 4] * rl, o[d0][b_ + 5] * rl), b1 = cvtpk(o[d0][b_ + 6] * rl, o[d0][b_ + 7] * rl);
                auto r0 = __builtin_amdgcn_permlane32_swap(a0, b0, false, false); auto r1 = __builtin_amdgcn_permlane32_swap(a1, b1, false, false);
                u32x4 w = {r0[0], r1[0], r0[1], r1[1]}; *(u32x4*)(Ow + d0 * 32 + 16 * gp) = w; }
    }
    __syncthreads();
    return nxt;
#undef RESC
#undef KBASE
#undef MASKT
#undef SEAM_K0
#undef HALF_STEP
}
#undef ROW
#undef VMW
#undef VMWN
#undef SLOAD_H
#undef SWRITE_HK
#undef SWRITE_HV
#undef SWRITE_H
#undef PK4

__device__ __forceinline__ BlockRef fox_ref(int item, const bf16* Q, const bf16* K, const bf16* V, const float* Cn, bf16* O, const char* lds) {
    const int e = (int)((const unsigned short*)(lds + OFF_ORD))[item], qb = e & 63, bh = e >> 6;
    BlockRef r; r.Q = Q + ((size_t)bh * SEQ + (size_t)qb * QB) * D; r.K = K + (size_t)bh * SEQ * D; r.V = V + (size_t)bh * SEQ * D; r.C = Cn + (size_t)bh * SEQ;
    r.O = O + (size_t)(qb * QB) * OPITCH + bh * D; r.P0 = qb * QB; r.jlo = (int)((const unsigned char*)(lds + OFF_JLO))[bh * 64 + qb]; return r;
}
__device__ __forceinline__ void fox_attn_phase(char* lds, const bf16* Q, const bf16* K, const bf16* V, const float* Cn, const unsigned* nrm2, unsigned* qctr, bf16* O) {
    const int tid = mk_tid();
    {
        int lo[4], hi[4]; float thr[4]; const float* Cb[4];
#pragma unroll
        for (int k = 0; k < 4; ++k) { const int e = tid + 512 * k, bh = e >> 6, qb = e & 63, P0 = qb * QB; Cb[k] = Cn + (size_t)bh * SEQ;
            const float qn2 = __uint_as_float(nrm2[bh]), kn2 = __uint_as_float(nrm2[32 + bh]);
            const float Dh = SKIP_T * (1.0f / SCALE) + 2.04f * sqrtf(qn2 * kn2) + 1.0f;
            thr[k] = Cb[k][P0] - Dh; lo[k] = 0; hi[k] = P0 / KVBLK; }
#pragma unroll 1
        for (int it = 0; it < 8; ++it) {
            float v[4]; int mid[4];
#pragma unroll
            for (int k = 0; k < 4; ++k) { mid[k] = (lo[k] + hi[k]) >> 1; v[k] = Cb[k][mid[k] * KVBLK + KVBLK - 1]; }
#pragma unroll
            for (int k = 0; k < 4; ++k) if (lo[k] < hi[k]) { if (v[k] < thr[k]) lo[k] = mid[k] + 1; else hi[k] = mid[k]; }
        }
#pragma unroll
        for (int k = 0; k < 4; ++k) ((unsigned char*)(lds + OFF_JLO))[tid + 512 * k] = (unsigned char)lo[k];
        unsigned key[4];
#pragma unroll
        for (int k = 0; k < 4; ++k) { const int e = tid + 512 * k, qb = e & 63; key[k] = (unsigned)(4 * qb + 4 - lo[k]) * 2048u + (unsigned)(2047 - e); ((unsigned*)(lds + OFF_KEY))[e] = key[k]; }
        __syncthreads();
        unsigned rank[4] = {0u, 0u, 0u, 0u};
#pragma unroll 4
        for (int j = 0; j < 512; ++j) { const u32x4 kv = ((const u32x4*)(lds + OFF_KEY))[j];
#pragma unroll
            for (int k = 0; k < 4; ++k) rank[k] += (kv.x > key[k] ? 1u : 0u) + (kv.y > key[k] ? 1u : 0u) + (kv.z > key[k] ? 1u : 0u) + (kv.w > key[k] ? 1u : 0u); }
#pragma unroll
        for (int k = 0; k < 4; ++k) ((unsigned short*)(lds + OFF_ORD))[rank[k]] = (unsigned short)(tid + 512 * k);
    }
    if (tid == 0) *(volatile LAS3 unsigned*)(lds + OFF_QW) = __hip_atomic_fetch_add(qctr, 1u, __ATOMIC_RELAXED, __HIP_MEMORY_SCOPE_AGENT);
    __syncthreads();
    const unsigned i0 = (unsigned)__builtin_amdgcn_readfirstlane((int)*(volatile LAS3 unsigned*)(lds + OFF_QW));
    if (i0 >= (unsigned)(NH * (SEQ / QB))) return;
    __syncthreads();
    auto mk = [=](int item) { return fox_ref(item, Q, K, V, Cn, O, lds); };
    BlockRef cur = mk((int)i0);
    Seam S;
    fox_prime(cur, lds, S);
    for (;;) { bool has_next; const BlockRef nxt = fox_block(cur, lds, S, qctr, mk, has_next); if (!has_next) break; cur = nxt; }
}
#undef LAS3
#undef KSWZ
#undef SBAR
}

namespace swa {
constexpr int SEQ = 16384, QKVP = 5120, OP = 4096;
constexpr int K_OFF = 0, VT_OFF = 32768, VT_PITCH = 528, LI_OFF = VT_OFF + 64 * VT_PITCH, LDS_BYTES = LI_OFF + 8 * 32 * 4;
typedef unsigned short bf16;
typedef short bf16x8 __attribute__((ext_vector_type(8)));
typedef float f32x16 __attribute__((ext_vector_type(16)));
typedef float f32x4 __attribute__((ext_vector_type(4)));
typedef unsigned u32x4 __attribute__((ext_vector_type(4)));
__device__ __forceinline__ int crow(int r, int hi) { return (r & 3) + 8 * (r >> 2) + 4 * hi; }
__device__ __forceinline__ unsigned cvtpk(float lo, float hi) { unsigned r; asm volatile("v_cvt_pk_bf16_f32 %0, %1, %2" : "=v"(r) : "v"(lo), "v"(hi)); return r; }
__device__ __forceinline__ float bf2f(short b) { return __uint_as_float(((unsigned)(unsigned short)b) << 16); }
__device__ __forceinline__ bf16x8 pack8(const float* v) { u32x4 w = {cvtpk(v[0], v[1]), cvtpk(v[2], v[3]), cvtpk(v[4], v[5]), cvtpk(v[6], v[7])}; return *reinterpret_cast<bf16x8*>(&w); }
#define SWA_PK4(P, B_, OUT) do { unsigned a0 = cvtpk(P[B_+0], P[B_+1]), a1 = cvtpk(P[B_+2], P[B_+3]);                          \
        unsigned b0 = cvtpk(P[B_+4], P[B_+5]), b1 = cvtpk(P[B_+6], P[B_+7]);                                             \
        auto r0 = __builtin_amdgcn_permlane32_swap(a0, b0, false, false); auto r1 = __builtin_amdgcn_permlane32_swap(a1, b1, false, false); \
        u32x4 w = {r0[0], r1[0], r0[1], r1[1]}; OUT = *reinterpret_cast<bf16x8*>(&w); } while (0)

__device__ __forceinline__ void swa_attn_phase(char* lds, const bf16* QKV, const float* sinks, const float* cosT, const float* sinT, bf16* O, int wg, int G) {
    const int tid = mk_tid(), wid = __builtin_amdgcn_readfirstlane(tid >> 6), lane = tid & 63, r32 = lane & 31, hi = lane >> 5;
    for (int L = wg; L < 1024; L += G) {
        const int g = L & 7, n = L >> 3;
        __syncthreads();
        {
            const int row = tid >> 1, half = tid & 1, kpos = 128 * (n - 1) + row;
            bf16x8 kc[4], vc[4];
            if (kpos >= 0) {
                const bf16* kp = QKV + (size_t)kpos * QKVP + 4096 + g * 64 + half * 32; const bf16* vp = kp + 512;
#pragma unroll
                for (int c = 0; c < 4; ++c) { kc[c] = *(const bf16x8*)(kp + 8 * c); vc[c] = *(const bf16x8*)(vp + 8 * c); }
                if (half == 0) {
                    const f32x4 c0 = *(const f32x4*)(cosT + (size_t)kpos * 8), c1 = *(const f32x4*)(cosT + (size_t)kpos * 8 + 4);
                    const f32x4 s0 = *(const f32x4*)(sinT + (size_t)kpos * 8), s1 = *(const f32x4*)(sinT + (size_t)kpos * 8 + 4);
                    float o1[8], o2[8];
#pragma unroll
                    for (int i = 0; i < 8; ++i) { const float cs = i < 4 ? c0[i & 3] : c1[i & 3], sn = i < 4 ? s0[i & 3] : s1[i & 3];
                        const float x1 = bf2f(kc[0][i]), x2 = bf2f(kc[1][i]); o1[i] = x1 * cs - x2 * sn; o2[i] = x2 * cs + x1 * sn; }
                    kc[0] = pack8(o1); kc[1] = pack8(o2);
                }
            } else {
#pragma unroll
                for (int c = 0; c < 4; ++c) { kc[c] = (bf16x8){0, 0, 0, 0, 0, 0, 0, 0}; vc[c] = (bf16x8){0, 0, 0, 0, 0, 0, 0, 0}; }
            }
#pragma unroll
            for (int c = 0; c < 4; ++c) { const int chunk = half * 4 + c;
                *(bf16x8*)(lds + K_OFF + row * 128 + ((chunk ^ ((row >> 1) & 7)) << 4)) = kc[c];
#pragma unroll
                for (int j = 0; j < 8; ++j) *(short*)(lds + VT_OFF + (half * 32 + c * 8 + j) * VT_PITCH + row * 2) = vc[c][j]; }
        }
        __syncthreads();
        const int hq = g * 8 + wid; const float sink = sinks[hq];
        for (int a = 0; a < 4; ++a) {
            const int t = 128 * n + 32 * a + r32;
            const bf16* qp = QKV + (size_t)t * QKVP + hq * 64;
            bf16x8 qr[4];
#pragma unroll
            for (int d0 = 0; d0 < 4; ++d0) qr[d0] = *(const bf16x8*)(qp + 16 * d0 + 8 * hi);
            {
                const bf16x8 pr = *(const bf16x8*)(qp + 8 * (1 - hi));
                const f32x4 c0 = *(const f32x4*)(cosT + (size_t)t * 8), c1 = *(const f32x4*)(cosT + (size_t)t * 8 + 4);
                const f32x4 s0 = *(const f32x4*)(sinT + (size_t)t * 8), s1 = *(const f32x4*)(sinT + (size_t)t * 8 + 4);
                float ov[8];
#pragma unroll
                for (int i = 0; i < 8; ++i) { const float cs = i < 4 ? c0[i & 3] : c1[i & 3], sn = i < 4 ? s0[i & 3] : s1[i & 3];
                    const float own = bf2f(qr[0][i]), par = bf2f(pr[i]); ov[i] = own * cs + (hi ? par : -par) * sn; }
                qr[0] = pack8(ov);
            }
            f32x16 p[5];
#pragma unroll
            for (int bi = 0; bi < 5; ++bi) { const int row = 32 * (a + bi) + r32; const char* kb = lds + K_OFF + row * 128; const int sw = (row >> 1) & 7;
                f32x16 acc = {};
#pragma unroll
                for (int d0 = 0; d0 < 4; ++d0) { const bf16x8 kf = *(const bf16x8*)(kb + (((2 * d0 + hi) ^ sw) << 4)); acc = __builtin_amdgcn_mfma_f32_32x32x16_bf16(kf, qr[d0], acc, 0, 0, 0); }
                p[bi] = acc; }
            const float NEG = -__builtin_inff();
#pragma unroll
            for (int r = 0; r < 16; ++r) { const int c = crow(r, hi); if (!(c > r32)) p[0][r] = NEG; if (!(c <= r32)) p[4][r] = NEG; }
            if (n == 0) {
#pragma unroll
                for (int bi = 0; bi < 4; ++bi) if (a + bi < 4) {
#pragma unroll
                    for (int r = 0; r < 16; ++r) p[bi][r] = NEG; }
            }
            float mx = NEG;
#pragma unroll
            for (int bi = 0; bi < 5; ++bi)
#pragma unroll
                for (int r = 0; r < 16; ++r) mx = fmaxf(mx, p[bi][r]);
            { auto rr = __builtin_amdgcn_permlane32_swap(__float_as_uint(mx), __float_as_uint(mx), false, false); mx = fmaxf(__uint_as_float(rr[0]), __uint_as_float(rr[1])); }
            const float m = fmaxf(mx * 0.125f, sink);
            constexpr float LOG2E = 1.4426950408889634f, C2 = 0.125f * LOG2E;
            const float mL = -m * LOG2E;
            float ps = 0.f;
#pragma unroll
            for (int bi = 0; bi < 5; ++bi)
#pragma unroll
                for (int r = 0; r < 16; ++r) { const float e = __builtin_amdgcn_exp2f(fmaf(p[bi][r], C2, mL)); p[bi][r] = e; ps += e; }
            { auto rr = __builtin_amdgcn_permlane32_swap(__float_as_uint(ps), __float_as_uint(ps), false, false); ps = __uint_as_float(rr[0]) + __uint_as_float(rr[1]); }
            const float l = ps + __builtin_amdgcn_exp2f(fmaf(sink, LOG2E, mL));
            f32x16 o[2] = {};
#pragma unroll
            for (int bi = 0; bi < 5; ++bi) { bf16x8 pa[2]; SWA_PK4(p[bi], 0, pa[0]); SWA_PK4(p[bi], 8, pa[1]);
#pragma unroll
                for (int ks = 0; ks < 2; ++ks)
#pragma unroll
                    for (int db = 0; db < 2; ++db) { const bf16x8 vf = *(const bf16x8*)(lds + VT_OFF + (32 * db + r32) * VT_PITCH + (32 * (a + bi) + 16 * ks + 8 * hi) * 2);
                        o[db] = __builtin_amdgcn_mfma_f32_32x32x16_bf16(vf, pa[ks], o[db], 0, 0, 0); } }
            const float rl = __builtin_amdgcn_rcpf(l);
            bf16* Ow = O + (size_t)(128 * n + 32 * a + r32) * OP + hq * 64 + 8 * hi;
#pragma unroll
            for (int db = 0; db < 2; ++db)
#pragma unroll
                for (int gp = 0; gp < 2; ++gp) { const int b_ = 8 * gp;
                    const unsigned a0 = cvtpk(o[db][b_ + 0] * rl, o[db][b_ + 1] * rl), a1 = cvtpk(o[db][b_ + 2] * rl, o[db][b_ + 3] * rl);
                    const unsigned b0 = cvtpk(o[db][b_ + 4] * rl, o[db][b_ + 5] * rl), b1 = cvtpk(o[db][b_ + 6] * rl, o[db][b_ + 7] * rl);
                    auto r0 = __builtin_amdgcn_permlane32_swap(a0, b0, false, false); auto r1 = __builtin_amdgcn_permlane32_swap(a1, b1, false, false);
                    u32x4 w = {r0[0], r1[0], r0[1], r1[1]}; *(u32x4*)(Ow + db * 32 + 16 * gp) = w; }
        }
    }
    __syncthreads();
}
#undef SWA_PK4
}

#define LAS __attribute__((address_space(3)))
#define GAS __attribute__((address_space(1)))
typedef unsigned short bf16;
typedef float f32x4 __attribute__((ext_vector_type(4)));
typedef unsigned u32x4 __attribute__((ext_vector_type(4)));
typedef unsigned u32x2 __attribute__((ext_vector_type(2)));
typedef short bf16x8 __attribute__((ext_vector_type(8)));
constexpr int SEQ = 16384, DM = 4096, DFF = 11008;
constexpr float NORM_EPS = 1e-6f;
__device__ __forceinline__ unsigned cvtpk(float lo, float hi) { unsigned r; asm volatile("v_cvt_pk_bf16_f32 %0, %1, %2" : "=v"(r) : "v"(lo), "v"(hi)); return r; }
__device__ __forceinline__ float bf_lo(unsigned w) { return __uint_as_float(w << 16); }
__device__ __forceinline__ float bf_hi(unsigned w) { return __uint_as_float(w & 0xffff0000u); }
__device__ __forceinline__ float wave_sum(float v) {
#pragma unroll
    for (int o = 1; o < 64; o <<= 1) v += __shfl_xor(v, o);
    return v;
}
__device__ __forceinline__ float gelu_tanh(float x) {
    const float u = 0.7978845608028654f * (x + 0.044715f * x * x * x);
    return x * __builtin_amdgcn_rcpf(1.0f + __builtin_amdgcn_exp2f(-2.8853900817779268f * u));
}
__device__ __forceinline__ void sincos_d(double a, double& s, double& c) {
    const double k = rint(a * 0.15915494309189535);
    double r = fma(-k, 6.283185307179586, a); r = fma(-k, 2.4492935982947064e-16, r);
    const double r2 = r * r; double ss = 1.0, cc = 1.0;
#pragma unroll
    for (int n = 29; n >= 3; n -= 2) ss = fma(-ss * r2, 1.0 / (double)(n * (n - 1)), 1.0);
#pragma unroll
    for (int n = 28; n >= 2; n -= 2) cc = fma(-cc * r2, 1.0 / (double)(n * (n - 1)), 1.0);
    s = r * ss; c = cc;
}
__device__ __forceinline__ double exp_d(double x) {
    const double k = rint(x * 1.4426950408889634);
    double r = fma(-k, 0.6931471803691238, x); r = fma(-k, 1.9082149292705877e-10, r);
    double p = 1.0;
#pragma unroll
    for (int n = 16; n >= 1; --n) p = fma(p * r, 1.0 / (double)n, 1.0);
    return ldexp(p, (int)k);
}

__device__ __forceinline__ void transpose_item(const float* __restrict__ W, int K, int N, bf16* __restrict__ WT, int mode, LAS unsigned* scr, int item, int lane) {
    const int nblk = (N + 63) / 64, kb = item / nblk, nb = item - kb * nblk, k0 = 128 * kb, n0 = 64 * nb;
    int r0 = n0; if (mode == 1) { const int bj = n0 >> 12, rem = n0 & 4095; r0 = ((rem >> 7) << 8) + (bj << 7) + (rem & 127); }
    if (mode == 2) { const int bj = n0 >= DFF ? 1 : 0, rem = n0 - bj * DFF; r0 = ((rem >> 7) << 8) + (bj << 7) + (rem & 127); }
    const int c = lane & 15, kq = lane >> 4;
    const bool ok = n0 + 4 * c < N;
    const float* src = W + (size_t)(k0 + 2 * kq) * N + n0 + 4 * c;
    LAS unsigned* sw = scr + (4 * c) * 65 + kq;
#pragma unroll
    for (int half = 0; half < 2; ++half) {
        f32x4 a[8], b[8]; const f32x4 z = {0.f, 0.f, 0.f, 0.f};
#pragma unroll
        for (int p = 0; p < 8; ++p) { const float* s = src + (size_t)(8 * (8 * half + p)) * N;
            a[p] = ok ? __builtin_nontemporal_load((const f32x4*)s) : z; b[p] = ok ? __builtin_nontemporal_load((const f32x4*)(s + N)) : z; }
#pragma unroll
        for (int p = 0; p < 8; ++p)
#pragma unroll
            for (int q = 0; q < 4; ++q) sw[q * 65 + 4 * (8 * half + p)] = cvtpk(a[p][q], b[p][q]);
    }
    asm volatile("s_waitcnt lgkmcnt(0)" ::: "memory");
#pragma unroll
    for (int j = 0; j < 16; ++j) { const int n = 4 * j + kq; const LAS unsigned* s = scr + n * 65 + 4 * c;
        u32x4 o; o.x = s[0]; o.y = s[1]; o.z = s[2]; o.w = s[3];
        if (n0 + n < N) *(u32x4*)(WT + (size_t)(r0 + n) * K + k0 + 8 * c) = o; }
    asm volatile("s_waitcnt lgkmcnt(0)" ::: "memory");
}

__device__ __forceinline__ float f8_clamp(float v) { return __builtin_fminf(__builtin_fmaxf(v, -448.f), 448.f); }
__device__ __forceinline__ unsigned f8_pack4(float a, float b, float c, float d) {
    int w = 0; w = __builtin_amdgcn_cvt_pk_fp8_f32(f8_clamp(a), f8_clamp(b), w, false); w = __builtin_amdgcn_cvt_pk_fp8_f32(f8_clamp(c), f8_clamp(d), w, true); return (unsigned)w; }
__device__ __forceinline__ void transpose_item_f8(const float* __restrict__ W, int K, int N, unsigned char* __restrict__ WT, int mode, LAS unsigned* scr, int item, int lane, float scale) {
    const int nblk = (N + 63) / 64, kb = item / nblk, nb = item - kb * nblk, k0 = 128 * kb, n0 = 64 * nb;
    int r0 = n0; if (mode == 1) { const int bj = n0 >> 12, rem = n0 & 4095; r0 = ((rem >> 7) << 8) + (bj << 7) + (rem & 127); }
    if (mode == 2) { const int bj = n0 >= DFF ? 1 : 0, rem = n0 - bj * DFF; r0 = ((rem >> 7) << 8) + (bj << 7) + (rem & 127); }
    const int c = lane & 15, kq = lane >> 4;
    const bool ok = n0 + 4 * c < N;
    const float* src = W + (size_t)(k0 + 4 * kq) * N + n0 + 4 * c;
    LAS unsigned* sw = scr + (4 * c) * 33 + kq;
#pragma unroll
    for (int half = 0; half < 2; ++half) {
        f32x4 a[4][4]; const f32x4 z = {0.f, 0.f, 0.f, 0.f};
#pragma unroll
        for (int p = 0; p < 4; ++p)
#pragma unroll
            for (int r = 0; r < 4; ++r) { const float* s = src + (size_t)(16 * (4 * half + p) + r) * N; a[p][r] = ok ? __builtin_nontemporal_load((const f32x4*)s) : z; }
#pragma unroll
        for (int p = 0; p < 4; ++p)
#pragma unroll
            for (int q = 0; q < 4; ++q) sw[q * 33 + 4 * (4 * half + p)] = f8_pack4(a[p][0][q] * scale, a[p][1][q] * scale, a[p][2][q] * scale, a[p][3][q] * scale);
    }
    asm volatile("s_waitcnt lgkmcnt(0)" ::: "memory");
#pragma unroll
    for (int j = 0; j < 8; ++j) { const int n = 8 * j + (lane >> 3), c8 = lane & 7; const LAS unsigned* s = scr + n * 33 + 4 * c8;
        u32x4 o; o.x = s[0]; o.y = s[1]; o.z = s[2]; o.w = s[3];
        if (n0 + n < N) *(u32x4*)(WT + (size_t)(r0 + n) * K + k0 + 16 * c8) = o; }
    asm volatile("s_waitcnt lgkmcnt(0)" ::: "memory");
}

struct HPlanes { unsigned char* hi; unsigned char* lo; };
template <int HIN, int HOUT>
__device__ __forceinline__ void norm_phase(int gw, int ngw, int lane, LAS unsigned char* stg, const bf16* tmp, const float* gpost, const float* hin, float* hout, HPlanes hp, const float* gpre, bf16* xn, bf16* U, float tscale = 1.0f, unsigned char* xn8 = nullptr, float x8scale = 1.0f) {
    LAS unsigned char* sA = stg;
    for (int m = gw; m < SEQ; m += ngw) {
        f32x4 h[16];
        u32x4 tq[8]; float ss = 0.f;
        if (tmp) { const u32x4* tr = (const u32x4*)(tmp + (size_t)m * DM) + lane;
#pragma unroll
            for (int j = 0; j < 8; ++j) tq[j] = __builtin_nontemporal_load(tr + 64 * j); }
        if constexpr (HIN == 0) {
            const f32x4* hr = (const f32x4*)(hin + (size_t)m * DM) + lane;
#pragma unroll
            for (int j = 0; j < 16; ++j) h[j] = __builtin_nontemporal_load(hr + 64 * j);
        } else {
            const u32x4* hr = (const u32x4*)(hp.hi + (size_t)m * 8192) + lane; const u32x4* lr = (const u32x4*)(hp.lo + (size_t)m * 2048) + lane; u32x4 hq[8], lq[2];
#pragma unroll
            for (int i = 0; i < 8; ++i) hq[i] = __builtin_nontemporal_load(hr + 64 * i);
#pragma unroll
            for (int c = 0; c < 2; ++c) lq[c] = __builtin_nontemporal_load(lr + 64 * c);
#pragma unroll
            for (int j = 0; j < 16; ++j) { const unsigned w0 = hq[j >> 1][2 * (j & 1)], w1 = hq[j >> 1][2 * (j & 1) + 1], lw = lq[j >> 3][(j >> 1) & 3]; const int sh = 16 * (j & 1);
                h[j] = (f32x4){__uint_as_float((w0 << 16) | (((lw >> sh) & 15u) << 12)), __uint_as_float((w0 & 0xffff0000u) | (((lw >> (sh + 4)) & 15u) << 12)),
                               __uint_as_float((w1 << 16) | (((lw >> (sh + 8)) & 15u) << 12)), __uint_as_float((w1 & 0xffff0000u) | (((lw >> (sh + 12)) & 15u) << 12))}; }
        }
        if (tmp) {
#pragma unroll
            for (int j = 0; j < 8; ++j) {
#pragma unroll
                for (int q = 0; q < 4; ++q) { const float a = bf_lo(tq[j][q]), b = bf_hi(tq[j][q]); ss += a * a + b * b; }
                *(LAS u32x4*)(sA + 1024 * j + 16 * lane) = tq[j]; }
            asm volatile("" ::: "memory");
            const float r = tscale / sqrtf(wave_sum(ss) * (1.0f / DM) + NORM_EPS);
            const f32x4* gp = (const f32x4*)gpost + lane; asm volatile("" : "+v"(gp));
#pragma unroll
            for (int j = 0; j < 16; ++j) { const u32x2 w = *(const LAS u32x2*)(sA + 512 * j + 8 * lane); const f32x4 t = {bf_lo(w.x), bf_hi(w.x), bf_lo(w.y), bf_hi(w.y)};
                h[j] = h[j] + (t * r) * gp[64 * j]; }
            asm volatile("" ::: "memory");
            if constexpr (HOUT == 0) { f32x4* ho = (f32x4*)(hout + (size_t)m * DM) + lane;
#pragma unroll
                for (int j = 0; j < 16; ++j) __builtin_nontemporal_store(h[j], ho + 64 * j); }
            if constexpr (HOUT == 1) {
                u32x4* ho = (u32x4*)(hp.hi + (size_t)m * 8192) + lane; u32x4* lo = (u32x4*)(hp.lo + (size_t)m * 2048) + lane; u32x4 lq[2];
#pragma unroll
                for (int i = 0; i < 8; ++i) { u32x4 o; unsigned lw = 0u;
#pragma unroll
                    for (int jj = 0; jj < 2; ++jj) { const int j = 2 * i + jj;
                        const unsigned b0 = __float_as_uint(h[j].x) + 0x800u, b1 = __float_as_uint(h[j].y) + 0x800u, b2 = __float_as_uint(h[j].z) + 0x800u, b3 = __float_as_uint(h[j].w) + 0x800u;
                        o[2 * jj] = __builtin_amdgcn_perm(b1, b0, 0x07060302u); o[2 * jj + 1] = __builtin_amdgcn_perm(b3, b2, 0x07060302u);
                        lw |= (((b0 >> 12) & 15u) | (((b1 >> 12) & 15u) << 4) | (((b2 >> 12) & 15u) << 8) | (((b3 >> 12) & 15u) << 12)) << (16 * jj); }
                    __builtin_nontemporal_store(o, ho + 64 * i); lq[i >> 2][i & 3] = lw; }
#pragma unroll
                for (int c = 0; c < 2; ++c) __builtin_nontemporal_store(lq[c], lo + 64 * c); }
        }
        if (gpre) {
            float s2 = 0.f;
#pragma unroll
            for (int j = 0; j < 16; ++j) s2 += (h[j].x * h[j].x + h[j].y * h[j].y) + (h[j].z * h[j].z + h[j].w * h[j].w);
            const float r = 1.0f / sqrtf(wave_sum(s2) * (1.0f / DM) + NORM_EPS);
            const f32x4* gp = (const f32x4*)gpre + lane; asm volatile("" : "+v"(gp));
            if (xn) { u32x4* o16 = (u32x4*)(xn + (size_t)m * DM) + lane;
                asm volatile("" ::: "memory");
#pragma unroll
                for (int j = 0; j < 16; ++j) { const f32x4 v = (h[j] * r) * gp[64 * j]; u32x2 w; w.x = cvtpk(v.x, v.y); w.y = cvtpk(v.z, v.w); *(LAS u32x2*)(sA + 512 * j + 8 * lane) = w; }
                asm volatile("" ::: "memory");
#pragma unroll
                for (int j = 0; j < 8; ++j) o16[64 * j] = *(const LAS u32x4*)(sA + 1024 * j + 16 * lane);
                asm volatile("" ::: "memory"); }
            if (xn8) { u32x4* o16 = (u32x4*)(xn8 + (size_t)m * DM) + lane; const float r8 = r * x8scale;
                asm volatile("" ::: "memory");
#pragma unroll
                for (int j = 0; j < 16; ++j) { const f32x4 v = (h[j] * r8) * gp[64 * j]; *(LAS unsigned*)(sA + 256 * j + 4 * lane) = f8_pack4(v.x, v.y, v.z, v.w); }
                asm volatile("" ::: "memory");
#pragma unroll
                for (int i = 0; i < 4; ++i) o16[64 * i] = *(const LAS u32x4*)(sA + 1024 * i + 16 * lane);
                asm volatile("" ::: "memory"); }
            if (U) {
#pragma unroll
                for (int j = 0; j < 16; ++j) { const f32x4 v = (h[j] * r) * gp[64 * j]; u32x2 w; w.x = cvtpk(v.x, v.y); w.y = cvtpk(v.z, v.w);
                    *(u32x2*)(U + ((size_t)((lane >> 2) + 16 * j) * SEQ + m) * 16 + 4 * (lane & 3)) = w; } }
        }
    }
}

__device__ __forceinline__ void fox_cumsum_phase(char* lds, const float* __restrict__ logf, float* __restrict__ cneg, int wg, int G, int tid) {
    double* wtot = (double*)lds; const int lane = tid & 63, wid = tid >> 6;
    for (int h = wg; h < 32; h += G) {
        float v[32]; double s = 0.0;
#pragma unroll
        for (int j = 0; j < 32; ++j) { v[j] = logf[(size_t)(32 * tid + j) * 32 + h]; s += (double)v[j]; }
        double inc = s;
#pragma unroll
        for (int o = 1; o < 64; o <<= 1) { const double t = __shfl_up(inc, o); if (lane >= o) inc += t; }
        __syncthreads();
        if (lane == 63) wtot[wid] = inc;
        __syncthreads();
        double run = inc - s;
#pragma unroll
        for (int w = 0; w < 8; ++w) if (w < wid) run += wtot[w];
#pragma unroll
        for (int j = 0; j < 32; ++j) { run += (double)v[j]; cneg[(size_t)h * SEQ + 32 * tid + j] = (float)(-run * 11.313708498984761); }
    }
}

__device__ __forceinline__ void fox_norms_phase(const bf16* __restrict__ QK, unsigned* nrm2, int gw, int ngw, int lane) {
    for (int base = gw * 128; base < 64 * SEQ; base += ngw * 128) {
        const u32x4* p = (const u32x4*)(QK + (size_t)base * 128) + lane; float mx = 0.f;
#pragma unroll 8
        for (int i = 0; i < 32; ++i) { const u32x4 w = p[(size_t)i * 64]; float s = 0.f;
#pragma unroll
            for (int q = 0; q < 4; ++q) { const float a = bf_lo(w[q]), b = bf_hi(w[q]); s = fmaf(a, a, s); s = fmaf(b, b, s); }
            s += __shfl_xor(s, 1); s += __shfl_xor(s, 2); s += __shfl_xor(s, 4); s += __shfl_xor(s, 8); mx = fmaxf(mx, s); }
        mx = fmaxf(mx, __shfl_xor(mx, 16)); mx = fmaxf(mx, __shfl_xor(mx, 32));
        if (lane == 0) __hip_atomic_fetch_max(nrm2 + base / SEQ, __float_as_uint(mx), __ATOMIC_RELAXED, __HIP_MEMORY_SCOPE_AGENT);
    }
}

namespace s5 {
typedef float f32x16 __attribute__((ext_vector_type(16)));
constexpr int NG = 256, SEGL = 2048, XP = 272, WAVE_BYTES = 2048 + 32 * XP, E_OFF = 8 * WAVE_BYTES, LDS_BYTES = E_OFF + 8 * 128 * 4;
__device__ __forceinline__ bf16x8 pack8(f32x4 a, f32x4 b) { u32x4 w = {cvtpk(a[0], a[1]), cvtpk(a[2], a[3]), cvtpk(b[0], b[1]), cvtpk(b[2], b[3])}; return *reinterpret_cast<bf16x8*>(&w); }
__device__ __forceinline__ void state_consts(float lam_re_raw, float lam_im_raw, double dt, double& lbr, double& lbi, double& cfr, double& cfi, double& lre_o, double& lim_o) {
    const double lre = (double)fminf(lam_re_raw, -1e-4f), lim = (double)lam_im_raw; double sn, cs; sincos_d(lim * dt, sn, cs); const double er = exp_d(lre * dt);
    lbr = er * cs; lbi = er * sn; const double a = lbr - 1.0, b = lbi, den = 1.0 / (lre * lre + lim * lim); cfr = (a * lre + b * lim) * den; cfi = (b * lre - a * lim) * den; lre_o = lre; lim_o = lim;
}
__device__ __forceinline__ void s5_phase(char* lds, const bf16* __restrict__ U, const float* __restrict__ lam_re, const float* __restrict__ lam_im, const float* __restrict__ log_dt,
                                         const float* __restrict__ b_re, const float* __restrict__ b_im, const float* __restrict__ c_re, const float* __restrict__ c_im,
                                         const float* __restrict__ dskip, bf16* __restrict__ Gout, int wg, int G) {
    const int tid = mk_tid(), wid = __builtin_amdgcn_readfirstlane(tid >> 6), lane = tid & 63, r32 = lane & 31, hi = lane >> 5, l15 = lane & 15, q4 = lane >> 4;
    float* ublk = (float*)(lds + wid * WAVE_BYTES); char* xblk = lds + wid * WAVE_BYTES + 2048; float* Ebuf = (float*)(lds + E_OFF);
    for (int g = wg; g < NG; g += G) {
        float lr, li, l2r, l2i; bf16x8 Bf[4], Cf[4]; const float dsk = dskip[16 * g + l15];
        {
            const double dt = exp_d((double)log_dt[g]);
            { double lbr, lbi, cfr, cfi, lre, lim; state_consts(lam_re[g * 64 + lane], lam_im[g * 64 + lane], dt, lbr, lbi, cfr, cfi, lre, lim); lr = (float)lbr; li = (float)lbi;
              double sn2, cs2; sincos_d(lim * dt * (double)SEGL, sn2, cs2); const double e2 = exp_d(lre * dt * (double)SEGL); l2r = (float)(e2 * cs2); l2i = (float)(e2 * sn2); }
#pragma unroll
            for (int sb = 0; sb < 2; ++sb) { const int st = 32 * sb + r32; double lbr, lbi, cfr, cfi, lre, lim; state_consts(lam_re[g * 64 + st], lam_im[g * 64 + st], dt, lbr, lbi, cfr, cfi, lre, lim);
                const f32x4* br = (const f32x4*)(b_re + ((size_t)g * 64 + st) * 16 + 8 * hi); const f32x4* bi = (const f32x4*)(b_im + ((size_t)g * 64 + st) * 16 + 8 * hi);
                const f32x4 vr0 = br[0], vr1 = br[1], vi0 = bi[0], vi1 = bi[1]; f32x4 or0, or1, oi0, oi1;
#pragma unroll
                for (int i = 0; i < 4; ++i) { or0[i] = (float)(cfr * (double)vr0[i] - cfi * (double)vi0[i]); or1[i] = (float)(cfr * (double)vr1[i] - cfi * (double)vi1[i]);
                                              oi0[i] = (float)(cfr * (double)vi0[i] + cfi * (double)vr0[i]); oi1[i] = (float)(cfr * (double)vi1[i] + cfi * (double)vr1[i]); }
                Bf[sb] = pack8(or0, or1); Bf[2 + sb] = pack8(oi0, oi1); }
#pragma unroll
            for (int kk = 0; kk < 4; ++kk) { const float* cp = (kk < 2 ? c_re : c_im) + ((size_t)g * 16 + l15) * 64 + 32 * (kk & 1) + 8 * q4; const float sg = kk < 2 ? 1.f : -1.f;
                const f32x4 v0 = *(const f32x4*)cp, v1 = *(const f32x4*)(cp + 4); Cf[kk] = pack8(v0 * sg, v1 * sg); }
        }
        const bf16* Ug = U + ((size_t)g * SEQ + (size_t)wid * SEGL) * 16;
        float xr = 0.f, xi = 0.f;
#pragma unroll 1
        for (int pass = 0; pass < 2; ++pass) {
#define S5_ULOAD(d0, d1, blk_) do { const u32x4 ub_ = *(const u32x4*)(Ug + ((size_t)(blk_) * 32 + r32) * 16 + 8 * hi);                                                     \
                d0 = (f32x4){bf_lo(ub_.x), bf_hi(ub_.x), bf_lo(ub_.y), bf_hi(ub_.y)}; d1 = (f32x4){bf_lo(ub_.z), bf_hi(ub_.z), bf_lo(ub_.w), bf_hi(ub_.w)}; } while (0)
            f32x4 ua0, ua1; S5_ULOAD(ua0, ua1, 0);
#pragma unroll 1
            for (int blk = 0; blk < SEGL / 32; ++blk) {
                f32x4 un0 = ua0, un1 = ua1;
                if (blk + 1 < SEGL / 32) S5_ULOAD(un0, un1, blk + 1);
                const bf16x8 af = pack8(ua0, ua1);
                if (pass) { *(f32x4*)(ublk + r32 * 16 + 8 * hi) = ua0; *(f32x4*)(ublk + r32 * 16 + 8 * hi + 4) = ua1; }
                f32x16 a0 = {}, a1 = {}, a2 = {}, a3 = {};
                a0 = __builtin_amdgcn_mfma_f32_32x32x16_bf16(af, Bf[0], a0, 0, 0, 0); a1 = __builtin_amdgcn_mfma_f32_32x32x16_bf16(af, Bf[1], a1, 0, 0, 0);
                a2 = __builtin_amdgcn_mfma_f32_32x32x16_bf16(af, Bf[2], a2, 0, 0, 0); a3 = __builtin_amdgcn_mfma_f32_32x32x16_bf16(af, Bf[3], a3, 0, 0, 0);
#pragma unroll
                for (int r = 0; r < 16; ++r) { auto t0 = __builtin_amdgcn_permlane32_swap(__float_as_uint(a0[r]), __float_as_uint(a1[r]), false, false); a0[r] = __uint_as_float(t0[0]); a1[r] = __uint_as_float(t0[1]);
                                               auto t1 = __builtin_amdgcn_permlane32_swap(__float_as_uint(a2[r]), __float_as_uint(a3[r]), false, false); a2[r] = __uint_as_float(t1[0]); a3[r] = __uint_as_float(t1[1]); }
#pragma unroll
                for (int s = 0; s < 32; ++s) { const int h = (s >> 2) & 1, r = (s & 3) + 4 * (s >> 3); const float bre = h ? a1[r] : a0[r], bim = h ? a3[r] : a2[r];
                    const float nr = fmaf(lr, xr, fmaf(-li, xi, bre)), ni = fmaf(lr, xi, fmaf(li, xr, bim)); xr = nr; xi = ni;
                    if (pass) { const unsigned pk = cvtpk(xr, xi); *(unsigned short*)(xblk + s * XP + lane * 2) = (unsigned short)pk; *(unsigned short*)(xblk + s * XP + 128 + lane * 2) = (unsigned short)(pk >> 16); } }
                if (pass) {
#pragma unroll
                    for (int rb = 0; rb < 2; ++rb) { f32x4 acc = {0.f, 0.f, 0.f, 0.f};
#pragma unroll
                        for (int kk = 0; kk < 4; ++kk) { const bf16x8 xa = *(const bf16x8*)(xblk + (16 * rb + l15) * XP + (32 * kk + 8 * q4) * 2); acc = __builtin_amdgcn_mfma_f32_16x16x32_bf16(xa, Cf[kk], acc, 0, 0, 0); }
#pragma unroll
                        for (int i = 0; i < 4; ++i) { const int sl = 16 * rb + 4 * q4 + i; const float uv = ublk[sl * 16 + l15];
                            const float v = gelu_tanh(acc[i] + dsk * uv); const float vn = __shfl_xor(v, 1);
                            if ((l15 & 1) == 0) *(unsigned*)(Gout + ((size_t)wid * SEGL + blk * 32 + sl) * DM + 16 * g + l15) = cvtpk(v, vn); } }
                }
                ua0 = un0; ua1 = un1;
            }
            if (pass == 0) {
                Ebuf[wid * 128 + lane] = xr; Ebuf[wid * 128 + 64 + lane] = xi;
                __syncthreads();
                float sr = 0.f, si = 0.f;
                for (int v = 0; v < wid; ++v) { const float er = Ebuf[v * 128 + lane], ei = Ebuf[v * 128 + 64 + lane];
                    const float nr = fmaf(l2r, sr, fmaf(-l2i, si, er)), ni = fmaf(l2r, si, fmaf(l2i, sr, ei)); sr = nr; si = ni; }
                xr = sr; xi = si;
            }
        }
        __syncthreads();
    }
}
#undef S5_ULOAD
}
#define XB_TMO      128
#define XB_XCNT(j)  (256  + 64 * (j))
#define XB_XSUB(j)  (1280 + 64 * (j))
#define XB_XGEN(j)  (2304 + 64 * (j))
#define XB_TOP      3328
#define XB_TOPGEN   3392
#define XCD_BAR_WORDS 3456
#define XB_SPIN_CAP (1u << 18)

__device__ __forceinline__ unsigned xb_ld(unsigned* p)              { return __hip_atomic_load(p, __ATOMIC_RELAXED, __HIP_MEMORY_SCOPE_AGENT); }
__device__ __forceinline__ unsigned xb_add(unsigned* p, unsigned v) { return __hip_atomic_fetch_add(p, v, __ATOMIC_RELAXED, __HIP_MEMORY_SCOPE_AGENT); }
__device__ __forceinline__ unsigned xb_xcc_id() { return (unsigned)__builtin_amdgcn_s_getreg((3 << 11) | 20) & 0xFu; }
#define XB_SPIN(cond, bar) do { unsigned _sp = 0; while (cond) { __builtin_amdgcn_s_sleep(1); \
    if ((++_sp & 255u) == 0u) { if (xb_ld(&(bar)[XB_TMO])) break; if (_sp > XB_SPIN_CAP) { atomicAdd(&(bar)[XB_TMO], 1u); break; } } } } while (0)

struct XcdBarrier {
    unsigned* bar; unsigned x;
    volatile LAS unsigned* st;
};

__device__ __forceinline__ XcdBarrier xcd_barrier_post(unsigned* bar, volatile LAS unsigned* st) {
    XcdBarrier b; b.bar = bar; b.x = xb_xcc_id(); b.st = st;
    if (threadIdx.x == 0) (void)xb_add(&bar[XB_XCNT(b.x)], 1u);
    return b;
}
__device__ __forceinline__ void xcd_barrier_complete(unsigned* bar, unsigned x, unsigned& nloc, unsigned& nx) {
    const unsigned G = gridDim.x * gridDim.y * gridDim.z;
    unsigned sum, cnt, mine, sp = 0u;
    for (;;) {
        sum = 0u; cnt = 0u; mine = 0u;
#pragma unroll
        for (unsigned j = 0; j < 16; ++j) { const unsigned c = xb_ld(&bar[XB_XCNT(j)]); sum += c; cnt += (c > 0u) ? 1u : 0u; mine = (j == x) ? c : mine; }
        if (sum == G) break;
        __builtin_amdgcn_s_sleep(1);
        if ((++sp & 255u) == 0u) { if (xb_ld(&bar[XB_TMO])) break; if (sp > XB_SPIN_CAP) { atomicAdd(&bar[XB_TMO], 1u); break; } }
    }
    nloc = mine > 0u ? mine : 1u; nx = cnt > 0u ? cnt : 1u;
}

__device__ __forceinline__ void xcd_barrier(const XcdBarrier& b) {
    asm volatile("s_waitcnt vmcnt(0)" ::: "memory");
    __syncthreads();
    if (threadIdx.x == 0) {
        unsigned* bar = b.bar;
        __builtin_amdgcn_s_waitcnt(0);
        unsigned nloc = b.st[0], nx = b.st[1];
        if (nloc == 0u) { xcd_barrier_complete(bar, b.x, nloc, nx); b.st[0] = nloc; b.st[1] = nx; }
        const unsigned old = xb_add(&bar[XB_XSUB(b.x)], 1u);
        const unsigned gen = old / nloc;
        if (old + 1u == (gen + 1u) * nloc) {
            __builtin_amdgcn_fence(__ATOMIC_RELEASE, "agent");
            asm volatile("s_waitcnt vmcnt(0)" ::: "memory");
            const unsigned og = xb_add(&bar[XB_TOP], 1u);
            const unsigned tg = og / nx;
            if (og + 1u == (tg + 1u) * nx) xb_add(&bar[XB_TOPGEN], 1u);
            else XB_SPIN(xb_ld(&bar[XB_TOPGEN]) == tg, bar);
            __builtin_amdgcn_fence(__ATOMIC_ACQUIRE, "agent");
            xb_add(&bar[XB_XGEN(b.x)], 1u);
            asm volatile("s_waitcnt vmcnt(0)" ::: "memory");
        } else {
            XB_SPIN(xb_ld(&bar[XB_XGEN(b.x)]) == gen, bar);
            __builtin_amdgcn_fence(__ATOMIC_ACQUIRE, "agent");
            asm volatile("s_waitcnt vmcnt(0)" ::: "memory");
        }
    }
    __syncthreads();
}

constexpr size_t MiB = (size_t)1 << 20;
constexpr int NTHR = 512, NWAVES = 8;
constexpr int LDS_BYTES = 147456;
constexpr int LDS_MISC = LDS_BYTES - 1024;
__device__ __forceinline__ const float* uptr(const LAS unsigned long long* tab, int i) {
    const unsigned long long v = tab[i]; const unsigned lo = __builtin_amdgcn_readfirstlane((unsigned)v), hi = __builtin_amdgcn_readfirstlane((unsigned)(v >> 32));
    return (const float*)(const GAS float*)(((unsigned long long)hi << 32) | lo);
}
template <class T> __device__ __forceinline__ LAS T* launder_l(LAS T* p) { asm volatile("" : "+s"(p)); return p; }
template <class T> __device__ __forceinline__ T* launder(T* p) { GAS T* q = (GAS T*)p; asm volatile("" : "+s"(q)); return (T*)q; }
static_assert(pg8::STAGE_BYTES <= LDS_MISC && fox::LDS_BYTES <= LDS_MISC && swa::LDS_BYTES <= LDS_MISC && s5::LDS_BYTES <= LDS_MISC, "LDS map");
constexpr size_t WS_CTL = 0, CTL_ZERO_BYTES = 64 * 1024;
constexpr size_t CTL_QCTR = 16384, CTL_NRM2 = 20480;
constexpr size_t WS_ROPE = 1 * MiB;
constexpr size_t WS_W = 2 * MiB;
constexpr size_t W_L0_QKV = WS_W, W_L0_O = W_L0_QKV + 40 * MiB, W_L1_QKVF = W_L0_O + 32 * MiB, W_L1_O = W_L1_QKVF + 98 * MiB, W_L2_GLU = W_L1_O + 32 * MiB,
                 W_L3_QKV = W_L2_GLU + 64 * MiB, W_L3_O = W_L3_QKV + 40 * MiB, W_FFN = W_L3_O + 32 * MiB, W_FFN_STRIDE = 258 * MiB, W_FFN_OUT = 172 * MiB;
constexpr size_t WS_XN = W_FFN + 4 * W_FFN_STRIDE;
constexpr size_t WS_BIG = WS_XN + 129 * MiB;
constexpr size_t WS_Z = WS_BIG, WS_ACT = WS_BIG + 688 * MiB, WS_TMPF = WS_BIG, WS_TMPM = WS_BIG + 688 * MiB;
constexpr size_t WS_SWA_QKV = WS_BIG, WS_SWA_O = WS_BIG + 160 * MiB;
constexpr size_t WS_FOX_QKV = WS_BIG, WS_FOX_O = WS_BIG + 384 * MiB, WS_FOX_LOGF = WS_BIG + 512 * MiB, WS_FOX_CNEG = WS_BIG + 514 * MiB;
constexpr size_t WS_S5_U = WS_BIG + 256 * MiB, WS_S5_G = WS_BIG + 512 * MiB;
constexpr size_t WS_HHI = WS_BIG + 1032 * MiB, WS_HLO = WS_HHI + 128 * MiB;
constexpr size_t WS_END = WS_HLO + 32 * MiB;
static_assert((size_t)SEQ * 2 * DFF * 2 == 688 * MiB && (size_t)SEQ * DFF * 2 == 344 * MiB && (size_t)12544 * 4096 * 2 == 98 * MiB && (size_t)22016 * 4096 * 2 == 172 * MiB, "sizes");

struct Args { const float* in[56]; float* out; unsigned char* ws; float inv_freq[8]; int ph_lo, ph_hi; };

__global__ void __launch_bounds__(NTHR, 2) mk_fwd(Args args) {
    extern __shared__ __attribute__((aligned(16))) unsigned char lds[];
    if (threadIdx.x < 16) ((LAS unsigned*)((LAS unsigned char*)lds + LDS_MISC))[threadIdx.x] = 0u;
    if (threadIdx.x == 64) { LAS unsigned long long* ptab0 = (LAS unsigned long long*)((LAS unsigned char*)lds + LDS_MISC + 64);
#pragma unroll
        for (int i = 0; i < 56; ++i) ptab0[i] = (unsigned long long)args.in[i]; }
#define IN(i) uptr(ptab, (i))
    __syncthreads();
    XcdBarrier bar = xcd_barrier_post((unsigned*)(args.ws + WS_CTL), (volatile LAS unsigned*)((LAS unsigned char*)lds + LDS_MISC));
    int need_bar = 0;
#if PROBE_WAIT > 0
    unsigned long long probe_acc = 0, probe_t0 = 0;
#define PROBE_SEL(id) (PROBE_ID >= 0 ? (id) == PROBE_ID : ((PROBE_MASK >> ((id) == 1 ? 9 : ((id) - 1) % 9)) & 1))
#define PROBE_T0(id) do { if (PROBE_SEL(id)) probe_t0 = __builtin_amdgcn_s_memrealtime(); } while (0)
#define PROBE_T1(id) do { if (PROBE_SEL(id)) probe_acc += __builtin_amdgcn_s_memrealtime() - probe_t0; } while (0)
#else
#define PROBE_T0(id) do { } while (0)
#define PROBE_T1(id) do { } while (0)
#endif
#define PH_BEGIN(id) if (args.ph_lo <= (id) && (id) < args.ph_hi) { \
        if (need_bar) { PROBE_T0(id); XcdBarrier b2; b2.bar = launder(bar.bar); b2.x = (unsigned)launder_s((int)bar.x); b2.st = bar.st; for (int rb_ = 0; rb_ < REP_BAR; ++rb_) xcd_barrier(b2); PROBE_T1(id); } need_bar = 1; \
        unsigned char* const ws = launder(args.ws); float* const out = launder(args.out); (void)out; \
        LAS unsigned char* const ldsl = launder_l((LAS unsigned char*)lds); char* const ldsg = (char*)ldsl; (void)ldsg; const LAS unsigned long long* const ptab = (const LAS unsigned long long*)(ldsl + LDS_MISC + 64); \
        const int tid = mk_tid(), lane = tid & 63, wave = __builtin_amdgcn_readfirstlane(tid >> 6); (void)lane; (void)wave; \
        const int G = launder_s((int)gridDim.x), bx = launder_s((int)blockIdx.x), vcu = (G % 8 == 0) ? (bx % 8) * (G / 8) + bx / 8 : bx, gw = vcu * NWAVES + wave, ngw = G * NWAVES; (void)gw; (void)ngw; \
        bf16* const XN = (bf16*)(ws + WS_XN + 16384); float* const cosT = (float*)(ws + WS_ROPE); float* const sinT = cosT + SEQ * 8; bf16* const TMPM = (bf16*)(ws + WS_TMPM); bf16* const TMPF = (bf16*)(ws + WS_TMPF); \
        (void)XN; (void)cosT; (void)sinT; (void)TMPM; (void)TMPF; const HPlanes HP{ws + WS_HHI, ws + WS_HLO}; (void)HP;
#define PH_END }

    PH_BEGIN(0)
#if PROBE_COPY > 0
      for (int rep = 0; rep < PROBE_COPY; ++rep) {
        typedef PROBE_T pv_t; constexpr int PU = 128 / sizeof(pv_t);
        const pv_t* src = (const pv_t*)(ws + WS_BIG); pv_t* dst = (pv_t*)(ws + WS_BIG + 516 * MiB);
        const size_t n = 512 * MiB / sizeof(pv_t), stride = (size_t)G * NTHR;
        for (size_t i = (size_t)vcu * NTHR + tid; i < n; i += PU * stride) {
            pv_t v[PU];
#pragma unroll
            for (int u = 0; u < PU; ++u) v[u] = PROBE_LD(src + i + u * stride);
#pragma unroll
            for (int u = 0; u < PU; ++u) PROBE_ST(v[u], dst + i + u * stride);
        }
      }
#endif
      for (int rep = 0; rep < REP_PRO; ++rep) {
        LAS unsigned* scr = (LAS unsigned*)(ldsl + wave * 16640);
        constexpr int I_QKV = 32 * 80, I_O = 32 * 64, I_QKVF = 32 * 193, I_GLU = 32 * 128, I_IN = 32 * 344, I_OUT = 86 * 64;
        constexpr int NITEMS = 2 * (I_QKV + I_O) + I_QKVF + I_O + I_GLU + 4 * (I_IN + I_OUT);
        for (int it = gw; it < NITEMS; it += ngw) {
            int r = it;
#define TR(cnt, src, K_, N_, dstoff, mode) if (r < (cnt)) { transpose_item(IN(src), K_, N_, (bf16*)(ws + (dstoff)), mode, scr, r, lane); continue; } r -= (cnt);
            TR(I_QKV, 2, 4096, 5120, W_L0_QKV, 0)
            TR(I_O, 5, 4096, 4096, W_L0_O, 0)
            TR(I_IN, 9, 4096, 22016, W_FFN, 2)
            TR(I_OUT, 12, 11008, 4096, W_FFN + W_FFN_OUT, 0)
            TR(I_QKVF, 15, 4096, 12320, W_L1_QKVF, 0)
            TR(I_O, 17, 4096, 4096, W_L1_O, 0)
            TR(I_IN, 20, 4096, 22016, W_FFN + W_FFN_STRIDE, 2)
            TR(I_OUT, 23, 11008, 4096, W_FFN + W_FFN_STRIDE + W_FFN_OUT, 0)
            TR(I_GLU, 34, 4096, 8192, W_L2_GLU, 1)
            TR(I_IN, 38, 4096, 22016, W_FFN + 2 * W_FFN_STRIDE, 2)
            TR(I_OUT, 41, 11008, 4096, W_FFN + 2 * W_FFN_STRIDE + W_FFN_OUT, 0)
            TR(I_QKV, 44, 4096, 5120, W_L3_QKV, 0)
            TR(I_O, 47, 4096, 4096, W_L3_O, 0)
            if (r < I_IN) { transpose_item_f8(IN(51), 4096, 22016, ws + W_FFN + 3 * W_FFN_STRIDE, 2, scr, r, lane, (float)(1 << pg8::F8_W_LOG2)); continue; } r -= I_IN;
            TR(I_OUT, 54, 11008, 4096, W_FFN + 3 * W_FFN_STRIDE + W_FFN_OUT, 0)
#undef TR
        }
        if (vcu == 0) { u32x4* zh = (u32x4*)(ws + WS_XN); const u32x4 zero = {0u, 0u, 0u, 0u}; for (int i = tid; i < 1024; i += NTHR) zh[i] = zero; }
        {
            u32x4* z = (u32x4*)(ws + W_L1_QKVF + (size_t)12320 * 4096 * 2); const u32x4 zero = {0u, 0u, 0u, 0u};
            for (int i = vcu * NTHR + tid; i < 224 * 4096 * 2 / 16; i += G * NTHR) z[i] = zero;
        }
        for (int i = vcu * NTHR + tid; i < SEQ * 8; i += G * NTHR) {
            const int f = i & 7;
            const float fr = f == 0 ? args.inv_freq[0] : f == 1 ? args.inv_freq[1] : f == 2 ? args.inv_freq[2] : f == 3 ? args.inv_freq[3] : f == 4 ? args.inv_freq[4] : f == 5 ? args.inv_freq[5] : f == 6 ? args.inv_freq[6] : args.inv_freq[7];
            const float ang = (float)(i >> 3) * fr; double s, c; sincos_d((double)ang, s, c); cosT[i] = (float)c; sinT[i] = (float)s;
        }
        norm_phase<0, 2>(gw, ngw, lane, ldsl + wave * 16640, nullptr, nullptr, IN(0), nullptr, HPlanes{nullptr, nullptr}, IN(1), XN, nullptr);
      }
    PH_END

#define SEL(a, b, c, d) IN(L == 0 ? (a) : L == 1 ? (b) : L == 2 ? (c) : (d))
    { constexpr int L = 0;

        const int type = L == 3 ? 0 : L, pb = 1 + 9 * L;
        const size_t wffn = W_FFN + (size_t)L * W_FFN_STRIDE;

        PH_BEGIN(pb + 0)
            if (type == 0) {
                pg8::Gemm g{XN, (const bf16*)(ws + (L == 0 ? W_L0_QKV : W_L3_QKV)), SEQ, 5120, 4096}; pg8::StaticOrder S; S.init(SEQ, 5120, G, bx);
                pg8::EpiBf16B E{(bf16*)(ws + WS_SWA_QKV), 5120, L == 0 ? IN(3) : IN(45)};
                for (int rep = 0; rep < REP_MIXG; ++rep) pg8::gemm_phase<pg8::EpiBf16B, pg8::StaticOrder, true, true>(ldsl, g, S, E);
            } else if (type == 1) {
                pg8::Gemm g{XN, (const bf16*)(ws + W_L1_QKVF), SEQ, 12544, 4096}; pg8::StaticOrder S; S.init(SEQ, 12544, G, bx);
                pg8::EpiFox E{(bf16*)(ws + WS_FOX_QKV), (float*)(ws + WS_FOX_LOGF), IN(16)};
                for (int rep = 0; rep < REP_MIXG; ++rep) pg8::gemm_phase<pg8::EpiFox, pg8::StaticOrder, true, true>(ldsl, g, S, E);
            } else {
              for (int rep = 0; rep < REP_MIX; ++rep)
                s5::s5_phase(ldsg, (const bf16*)(ws + WS_S5_U), IN(26), IN(27), IN(28), IN(29), IN(30), IN(31), IN(32), IN(33),
                             (bf16*)(ws + WS_S5_G), vcu, G);
            }
        PH_END
        if (type != 2) {
        PH_BEGIN(pb + 1)
          for (int rep = 0; rep < REP_MIX; ++rep) {
            if (type == 0) swa::swa_attn_phase(ldsg, (const bf16*)(ws + WS_SWA_QKV), L == 0 ? IN(4) : IN(46), cosT, sinT, (bf16*)(ws + WS_SWA_O), vcu, G);
            else { fox_cumsum_phase(ldsg, (const float*)(ws + WS_FOX_LOGF), (float*)(ws + WS_FOX_CNEG), vcu, G, tid);
                   if (G > 64) { if (vcu >= 32) fox_norms_phase((const bf16*)(ws + WS_FOX_QKV), (unsigned*)(ws + WS_CTL + CTL_NRM2), (vcu - 32) * NWAVES + wave, (G - 32) * NWAVES, lane); }
                   else fox_norms_phase((const bf16*)(ws + WS_FOX_QKV), (unsigned*)(ws + WS_CTL + CTL_NRM2), gw, ngw, lane); }
          }
        PH_END
        }
        if (type == 1) {
        PH_BEGIN(pb + 2)
            const bf16* q = (const bf16*)(ws + WS_FOX_QKV);
            fox::fox_attn_phase(ldsg, q, q + (size_t)32 * SEQ * 128, q + (size_t)64 * SEQ * 128, (const float*)(ws + WS_FOX_CNEG), (const unsigned*)(ws + WS_CTL + CTL_NRM2), (unsigned*)(ws + WS_CTL + CTL_QCTR), (bf16*)(ws + WS_FOX_O));
#if REP_FOX > 1
            __syncthreads();
            fox::fox_attn_phase(ldsg, q, q + (size_t)32 * SEQ * 128, q + (size_t)64 * SEQ * 128, (const float*)(ws + WS_FOX_CNEG), (const unsigned*)(ws + WS_CTL + CTL_NRM2), (unsigned*)(ws + WS_CTL + CTL_QCTR) + 64, (bf16*)(ws + WS_FOX_O));
#endif
        PH_END
        }
        PH_BEGIN(pb + 3)
            if (type == 2) {
                pg8::Gemm g{(const bf16*)(ws + WS_S5_G), (const bf16*)(ws + W_L2_GLU), SEQ, 8192, 4096}; pg8::StaticOrder S; S.init(SEQ, 8192, G, bx);
                pg8::EpiGlu E{TMPM, IN(35)};
                for (int rep = 0; rep < REP_MIXG; ++rep) pg8::gemm_phase<pg8::EpiGlu, pg8::StaticOrder, true, true>(ldsl, g, S, E);
            } else {
                pg8::Gemm g{(const bf16*)(ws + (type == 0 ? WS_SWA_O : WS_FOX_O)), (const bf16*)(ws + (L == 0 ? W_L0_O : L == 1 ? W_L1_O : W_L3_O)), SEQ, 4096, 4096};
                pg8::StaticOrder S; S.init(SEQ, 4096, G, bx);
                pg8::EpiBf16B E{TMPM, 4096, L == 0 ? IN(6) : L == 3 ? IN(48) : nullptr};
                for (int rep = 0; rep < REP_MIXG; ++rep) pg8::gemm_phase<pg8::EpiBf16B, pg8::StaticOrder, true, true>(ldsl, g, S, E);
            }
        PH_END
        PH_BEGIN(pb + 4)
          for (int rep = 0; rep < REP_NORM; ++rep)
            if (L == 0 && rep == 0) norm_phase<0, 1>(gw, ngw, lane, ldsl + wave * 16640, TMPM, SEL(7, 18, 36, 49), IN(0), nullptr, HP, SEL(8, 19, 37, 50), XN, nullptr, 1.f);
            else norm_phase<1, 1>(gw, ngw, lane, ldsl + wave * 16640, TMPM, SEL(7, 18, 36, 49), nullptr, nullptr, HP, SEL(8, 19, 37, 50), L == 3 ? nullptr : XN, nullptr, rep ? 0.f : 1.f, L == 3 ? (unsigned char*)XN : nullptr, (float)(1 << pg8::F8_X_LOG2));
        PH_END
        PH_BEGIN(pb + 5)
            pg8::Gemm g{L == 3 ? (const bf16*)((const unsigned char*)XN - 2 * 4096) : XN - 2 * 4096, (const bf16*)(ws + wffn), 65 * 256, 2 * DFF, L == 3 ? 2048 : 4096, 254}; pg8::StaticOrder S; S.init(65 * 256, 2 * DFF, G, bx);
            pg8::EpiConvGeglu E{(bf16*)(ws + WS_ACT), SEL(10, 21, 39, 52), SEL(11, 22, 40, 53), ldsl + 131072, DFF, SEQ};
          for (int rep = 0; rep < REP_FFN1; ++rep) {
            if constexpr (L == 3) pg8::gemm_phase<pg8::EpiConvGeglu, pg8::StaticOrder, true, true, true>(ldsl, g, S, E);
            else pg8::gemm_phase<pg8::EpiConvGeglu, pg8::StaticOrder, true, true>(ldsl, g, S, E); }
        PH_END
        PH_BEGIN(pb + 7)
            pg8::Gemm g{(const bf16*)(ws + WS_ACT), (const bf16*)(ws + wffn + W_FFN_OUT), SEQ, 4096, DFF}; pg8::StaticOrder S; S.init(SEQ, 4096, G, bx);
            pg8::EpiBf16B E{TMPF, 4096, nullptr};
          for (int rep = 0; rep < REP_FFN2; ++rep)
            pg8::gemm_phase<pg8::EpiBf16B, pg8::StaticOrder, true, true>(ldsl, g, S, E);
        PH_END
        PH_BEGIN(pb + 8)
          for (int rep = 0; rep < REP_NORM; ++rep)
            if (L == 3) { if (rep == 0) norm_phase<1, 0>(gw, ngw, lane, ldsl + wave * 16640, TMPF, SEL(13, 24, 42, 55), nullptr, out, HP, nullptr, nullptr, nullptr, 1.f); }
            else norm_phase<1, 1>(gw, ngw, lane, ldsl + wave * 16640, TMPF, SEL(13, 24, 42, 55), nullptr, nullptr, HP, SEL(14, 25, 43, 43), L == 1 ? nullptr : XN, L == 1 ? (bf16*)(ws + WS_S5_U) : nullptr, rep ? 0.f : 1.f);
        PH_END
    }
    { constexpr int L = 1;

        const int type = L == 3 ? 0 : L, pb = 1 + 9 * L;
        const size_t wffn = W_FFN + (size_t)L * W_FFN_STRIDE;

        PH_BEGIN(pb + 0)
            if (type == 0) {
                pg8::Gemm g{XN, (const bf16*)(ws + (L == 0 ? W_L0_QKV : W_L3_QKV)), SEQ, 5120, 4096}; pg8::StaticOrder S; S.init(SEQ, 5120, G, bx);
                pg8::EpiBf16B E{(bf16*)(ws + WS_SWA_QKV), 5120, L == 0 ? IN(3) : IN(45)};
                for (int rep = 0; rep < REP_MIXG; ++rep) pg8::gemm_phase<pg8::EpiBf16B, pg8::StaticOrder, true, true>(ldsl, g, S, E);
            } else if (type == 1) {
                pg8::Gemm g{XN, (const bf16*)(ws + W_L1_QKVF), SEQ, 12544, 4096}; pg8::StaticOrder S; S.init(SEQ, 12544, G, bx);
                pg8::EpiFox E{(bf16*)(ws + WS_FOX_QKV), (float*)(ws + WS_FOX_LOGF), IN(16)};
                for (int rep = 0; rep < REP_MIXG; ++rep) pg8::gemm_phase<pg8::EpiFox, pg8::StaticOrder, true, true>(ldsl, g, S, E);
            } else {
              for (int rep = 0; rep < REP_MIX; ++rep)
                s5::s5_phase(ldsg, (const bf16*)(ws + WS_S5_U), IN(26), IN(27), IN(28), IN(29), IN(30), IN(31), IN(32), IN(33),
                             (bf16*)(ws + WS_S5_G), vcu, G);
            }
        PH_END
        if (type != 2) {
        PH_BEGIN(pb + 1)
          for (int rep = 0; rep < REP_MIX; ++rep) {
            if (type == 0) swa::swa_attn_phase(ldsg, (const bf16*)(ws + WS_SWA_QKV), L == 0 ? IN(4) : IN(46), cosT, sinT, (bf16*)(ws + WS_SWA_O), vcu, G);
            else { fox_cumsum_phase(ldsg, (const float*)(ws + WS_FOX_LOGF), (float*)(ws + WS_FOX_CNEG), vcu, G, tid);
                   if (G > 64) { if (vcu >= 32) fox_norms_phase((const bf16*)(ws + WS_FOX_QKV), (unsigned*)(ws + WS_CTL + CTL_NRM2), (vcu - 32) * NWAVES + wave, (G - 32) * NWAVES, lane); }
                   else fox_norms_phase((const bf16*)(ws + WS_FOX_QKV), (unsigned*)(ws + WS_CTL + CTL_NRM2), gw, ngw, lane); }
          }
        PH_END
        }
        if (type == 1) {
        PH_BEGIN(pb + 2)
            const bf16* q = (const bf16*)(ws + WS_FOX_QKV);
            fox::fox_attn_phase(ldsg, q, q + (size_t)32 * SEQ * 128, q + (size_t)64 * SEQ * 128, (const float*)(ws + WS_FOX_CNEG), (const unsigned*)(ws + WS_CTL + CTL_NRM2), (unsigned*)(ws + WS_CTL + CTL_QCTR), (bf16*)(ws + WS_FOX_O));
#if REP_FOX > 1
            __syncthreads();
            fox::fox_attn_phase(ldsg, q, q + (size_t)32 * SEQ * 128, q + (size_t)64 * SEQ * 128, (const float*)(ws + WS_FOX_CNEG), (const unsigned*)(ws + WS_CTL + CTL_NRM2), (unsigned*)(ws + WS_CTL + CTL_QCTR) + 64, (bf16*)(ws + WS_FOX_O));
#endif
        PH_END
        }
        PH_BEGIN(pb + 3)
            if (type == 2) {
                pg8::Gemm g{(const bf16*)(ws + WS_S5_G), (const bf16*)(ws + W_L2_GLU), SEQ, 8192, 4096}; pg8::StaticOrder S; S.init(SEQ, 8192, G, bx);
                pg8::EpiGlu E{TMPM, IN(35)};
                for (int rep = 0; rep < REP_MIXG; ++rep) pg8::gemm_phase<pg8::EpiGlu, pg8::StaticOrder, true, true>(ldsl, g, S, E);
            } else {
                pg8::Gemm g{(const bf16*)(ws + (type == 0 ? WS_SWA_O : WS_FOX_O)), (const bf16*)(ws + (L == 0 ? W_L0_O : L == 1 ? W_L1_O : W_L3_O)), SEQ, 4096, 4096};
                pg8::StaticOrder S; S.init(SEQ, 4096, G, bx);
                pg8::EpiBf16B E{TMPM, 4096, L == 0 ? IN(6) : L == 3 ? IN(48) : nullptr};
                for (int rep = 0; rep < REP_MIXG; ++rep) pg8::gemm_phase<pg8::EpiBf16B, pg8::StaticOrder, true, true>(ldsl, g, S, E);
            }
        PH_END
        PH_BEGIN(pb + 4)
          for (int rep = 0; rep < REP_NORM; ++rep)
            if (L == 0 && rep == 0) norm_phase<0, 1>(gw, ngw, lane, ldsl + wave * 16640, TMPM, SEL(7, 18, 36, 49), IN(0), nullptr, HP, SEL(8, 19, 37, 50), XN, nullptr, 1.f);
            else norm_phase<1, 1>(gw, ngw, lane, ldsl + wave * 16640, TMPM, SEL(7, 18, 36, 49), nullptr, nullptr, HP, SEL(8, 19, 37, 50), L == 3 ? nullptr : XN, nullptr, rep ? 0.f : 1.f, L == 3 ? (unsigned char*)XN : nullptr, (float)(1 << pg8::F8_X_LOG2));
        PH_END
        PH_BEGIN(pb + 5)
            pg8::Gemm g{L == 3 ? (const bf16*)((const unsigned char*)XN - 2 * 4096) : XN - 2 * 4096, (const bf16*)(ws + wffn), 65 * 256, 2 * DFF, L == 3 ? 2048 : 4096, 254}; pg8::StaticOrder S; S.init(65 * 256, 2 * DFF, G, bx);
            pg8::EpiConvGeglu E{(bf16*)(ws + WS_ACT), SEL(10, 21, 39, 52), SEL(11, 22, 40, 53), ldsl + 131072, DFF, SEQ};
          for (int rep = 0; rep < REP_FFN1; ++rep) {
            if constexpr (L == 3) pg8::gemm_phase<pg8::EpiConvGeglu, pg8::StaticOrder, true, true, true>(ldsl, g, S, E);
            else pg8::gemm_phase<pg8::EpiConvGeglu, pg8::StaticOrder, true, true>(ldsl, g, S, E); }
        PH_END
        PH_BEGIN(pb + 7)
            pg8::Gemm g{(const bf16*)(ws + WS_ACT), (const bf16*)(ws + wffn + W_FFN_OUT), SEQ, 4096, DFF}; pg8::StaticOrder S; S.init(SEQ, 4096, G, bx);
            pg8::EpiBf16B E{TMPF, 4096, nullptr};
          for (int rep = 0; rep < REP_FFN2; ++rep)
            pg8::gemm_phase<pg8::EpiBf16B, pg8::StaticOrder, true, true>(ldsl, g, S, E);
        PH_END
        PH_BEGIN(pb + 8)
          for (int rep = 0; rep < REP_NORM; ++rep)
            if (L == 3) { if (rep == 0) norm_phase<1, 0>(gw, ngw, lane, ldsl + wave * 16640, TMPF, SEL(13, 24, 42, 55), nullptr, out, HP, nullptr, nullptr, nullptr, 1.f); }
            else norm_phase<1, 1>(gw, ngw, lane, ldsl + wave * 16640, TMPF, SEL(13, 24, 42, 55), nullptr, nullptr, HP, SEL(14, 25, 43, 43), L == 1 ? nullptr : XN, L == 1 ? (bf16*)(ws + WS_S5_U) : nullptr, rep ? 0.f : 1.f);
        PH_END
    }
    { constexpr int L = 2;

        const int type = L == 3 ? 0 : L, pb = 1 + 9 * L;
        const size_t wffn = W_FFN + (size_t)L * W_FFN_STRIDE;

        PH_BEGIN(pb + 0)
            if (type == 0) {
                pg8::Gemm g{XN, (const bf16*)(ws + (L == 0 ? W_L0_QKV : W_L3_QKV)), SEQ, 5120, 4096}; pg8::StaticOrder S; S.init(SEQ, 5120, G, bx);
                pg8::EpiBf16B E{(bf16*)(ws + WS_SWA_QKV), 5120, L == 0 ? IN(3) : IN(45)};
                for (int rep = 0; rep < REP_MIXG; ++rep) pg8::gemm_phase<pg8::EpiBf16B, pg8::StaticOrder, true, true>(ldsl, g, S, E);
            } else if (type == 1) {
                pg8::Gemm g{XN, (const bf16*)(ws + W_L1_QKVF), SEQ, 12544, 4096}; pg8::StaticOrder S; S.init(SEQ, 12544, G, bx);
                pg8::EpiFox E{(bf16*)(ws + WS_FOX_QKV), (float*)(ws + WS_FOX_LOGF), IN(16)};
                for (int rep = 0; rep < REP_MIXG; ++rep) pg8::gemm_phase<pg8::EpiFox, pg8::StaticOrder, true, true>(ldsl, g, S, E);
            } else {
              for (int rep = 0; rep < REP_MIX; ++rep)
                s5::s5_phase(ldsg, (const bf16*)(ws + WS_S5_U), IN(26), IN(27), IN(28), IN(29), IN(30), IN(31), IN(32), IN(33),
                             (bf16*)(ws + WS_S5_G), vcu, G);
            }
        PH_END
        if (type != 2) {
        PH_BEGIN(pb + 1)
          for (int rep = 0; rep < REP_MIX; ++rep) {
            if (type == 0) swa::swa_attn_phase(ldsg, (const bf16*)(ws + WS_SWA_QKV), L == 0 ? IN(4) : IN(46), cosT, sinT, (bf16*)(ws + WS_SWA_O), vcu, G);
            else { fox_cumsum_phase(ldsg, (const float*)(ws + WS_FOX_LOGF), (float*)(ws + WS_FOX_CNEG), vcu, G, tid);
                   if (G > 64) { if (vcu >= 32) fox_norms_phase((const bf16*)(ws + WS_FOX_QKV), (unsigned*)(ws + WS_CTL + CTL_NRM2), (vcu - 32) * NWAVES + wave, (G - 32) * NWAVES, lane); }
                   else fox_norms_phase((const bf16*)(ws + WS_FOX_QKV), (unsigned*)(ws + WS_CTL + CTL_NRM2), gw, ngw, lane); }
          }
        PH_END
        }
        if (type == 1) {
        PH_BEGIN(pb + 2)
            const bf16* q = (const bf16*)(ws + WS_FOX_QKV);
            fox::fox_attn_phase(ldsg, q, q + (size_t)32 * SEQ * 128, q + (size_t)64 * SEQ * 128, (const float*)(ws + WS_FOX_CNEG), (const unsigned*)(ws + WS_CTL + CTL_NRM2), (unsigned*)(ws + WS_CTL + CTL_QCTR), (bf16*)(ws + WS_FOX_O));
#if REP_FOX > 1
            __syncthreads();
            fox::fox_attn_phase(ldsg, q, q + (size_t)32 * SEQ * 128, q + (size_t)64 * SEQ * 128, (const float*)(ws + WS_FOX_CNEG), (const unsigned*)(ws + WS_CTL + CTL_NRM2), (unsigned*)(ws + WS_CTL + CTL_QCTR) + 64, (bf16*)(ws + WS_FOX_O));
#endif
        PH_END
        }
        PH_BEGIN(pb + 3)
            if (type == 2) {
                pg8::Gemm g{(const bf16*)(ws + WS_S5_G), (const bf16*)(ws + W_L2_GLU), SEQ, 8192, 4096}; pg8::StaticOrder S; S.init(SEQ, 8192, G, bx);
                pg8::EpiGlu E{TMPM, IN(35)};
                for (int rep = 0; rep < REP_MIXG; ++rep) pg8::gemm_phase<pg8::EpiGlu, pg8::StaticOrder, true, true>(ldsl, g, S, E);
            } else {
                pg8::Gemm g{(const bf16*)(ws + (type == 0 ? WS_SWA_O : WS_FOX_O)), (const bf16*)(ws + (L == 0 ? W_L0_O : L == 1 ? W_L1_O : W_L3_O)), SEQ, 4096, 4096};
                pg8::StaticOrder S; S.init(SEQ, 4096, G, bx);
                pg8::EpiBf16B E{TMPM, 4096, L == 0 ? IN(6) : L == 3 ? IN(48) : nullptr};
                for (int rep = 0; rep < REP_MIXG; ++rep) pg8::gemm_phase<pg8::EpiBf16B, pg8::StaticOrder, true, true>(ldsl, g, S, E);
            }
        PH_END
        PH_BEGIN(pb + 4)
          for (int rep = 0; rep < REP_NORM; ++rep)
            if (L == 0 && rep == 0) norm_phase<0, 1>(gw, ngw, lane, ldsl + wave * 16640, TMPM, SEL(7, 18, 36, 49), IN(0), nullptr, HP, SEL(8, 19, 37, 50), XN, nullptr, 1.f);
            else norm_phase<1, 1>(gw, ngw, lane, ldsl + wave * 16640, TMPM, SEL(7, 18, 36, 49), nullptr, nullptr, HP, SEL(8, 19, 37, 50), L == 3 ? nullptr : XN, nullptr, rep ? 0.f : 1.f, L == 3 ? (unsigned char*)XN : nullptr, (float)(1 << pg8::F8_X_LOG2));
        PH_END
        PH_BEGIN(pb + 5)
            pg8::Gemm g{L == 3 ? (const bf16*)((const unsigned char*)XN - 2 * 4096) : XN - 2 * 4096, (const bf16*)(ws + wffn), 65 * 256, 2 * DFF, L == 3 ? 2048 : 4096, 254}; pg8::StaticOrder S; S.init(65 * 256, 2 * DFF, G, bx);
            pg8::EpiConvGeglu E{(bf16*)(ws + WS_ACT), SEL(10, 21, 39, 52), SEL(11, 22, 40, 53), ldsl + 131072, DFF, SEQ};
          for (int rep = 0; rep < REP_FFN1; ++rep) {
            if constexpr (L == 3) pg8::gemm_phase<pg8::EpiConvGeglu, pg8::StaticOrder, true, true, true>(ldsl, g, S, E);
            else pg8::gemm_phase<pg8::EpiConvGeglu, pg8::StaticOrder, true, true>(ldsl, g, S, E); }
        PH_END
        PH_BEGIN(pb + 7)
            pg8::Gemm g{(const bf16*)(ws + WS_ACT), (const bf16*)(ws + wffn + W_FFN_OUT), SEQ, 4096, DFF}; pg8::StaticOrder S; S.init(SEQ, 4096, G, bx);
            pg8::EpiBf16B E{TMPF, 4096, nullptr};
          for (int rep = 0; rep < REP_FFN2; ++rep)
            pg8::gemm_phase<pg8::EpiBf16B, pg8::StaticOrder, true, true>(ldsl, g, S, E);
        PH_END
        PH_BEGIN(pb + 8)
          for (int rep = 0; rep < REP_NORM; ++rep)
            if (L == 3) { if (rep == 0) norm_phase<1, 0>(gw, ngw, lane, ldsl + wave * 16640, TMPF, SEL(13, 24, 42, 55), nullptr, out, HP, nullptr, nullptr, nullptr, 1.f); }
            else norm_phase<1, 1>(gw, ngw, lane, ldsl + wave * 16640, TMPF, SEL(13, 24, 42, 55), nullptr, nullptr, HP, SEL(14, 25, 43, 43), L == 1 ? nullptr : XN, L == 1 ? (bf16*)(ws + WS_S5_U) : nullptr, rep ? 0.f : 1.f);
        PH_END
    }
    { constexpr int L = 3;

        const int type = L == 3 ? 0 : L, pb = 1 + 9 * L;
        const size_t wffn = W_FFN + (size_t)L * W_FFN_STRIDE;

        PH_BEGIN(pb + 0)
            if (type == 0) {
                pg8::Gemm g{XN, (const bf16*)(ws + (L == 0 ? W_L0_QKV : W_L3_QKV)), SEQ, 5120, 4096}; pg8::StaticOrder S; S.init(SEQ, 5120, G, bx);
                pg8::EpiBf16B E{(bf16*)(ws + WS_SWA_QKV), 5120, L == 0 ? IN(3) : IN(45)};
                for (int rep = 0; rep < REP_MIXG; ++rep) pg8::gemm_phase<pg8::EpiBf16B, pg8::StaticOrder, true, true>(ldsl, g, S, E);
            } else if (type == 1) {
                pg8::Gemm g{XN, (const bf16*)(ws + W_L1_QKVF), SEQ, 12544, 4096}; pg8::StaticOrder S; S.init(SEQ, 12544, G, bx);
                pg8::EpiFox E{(bf16*)(ws + WS_FOX_QKV), (float*)(ws + WS_FOX_LOGF), IN(16)};
                for (int rep = 0; rep < REP_MIXG; ++rep) pg8::gemm_phase<pg8::EpiFox, pg8::StaticOrder, true, true>(ldsl, g, S, E);
            } else {
              for (int rep = 0; rep < REP_MIX; ++rep)
                s5::s5_phase(ldsg, (const bf16*)(ws + WS_S5_U), IN(26), IN(27), IN(28), IN(29), IN(30), IN(31), IN(32), IN(33),
                             (bf16*)(ws + WS_S5_G), vcu, G);
            }
        PH_END
        if (type != 2) {
        PH_BEGIN(pb + 1)
          for (int rep = 0; rep < REP_MIX; ++rep) {
            if (type == 0) swa::swa_attn_phase(ldsg, (const bf16*)(ws + WS_SWA_QKV), L == 0 ? IN(4) : IN(46), cosT, sinT, (bf16*)(ws + WS_SWA_O), vcu, G);
            else { fox_cumsum_phase(ldsg, (const float*)(ws + WS_FOX_LOGF), (float*)(ws + WS_FOX_CNEG), vcu, G, tid);
                   if (G > 64) { if (vcu >= 32) fox_norms_phase((const bf16*)(ws + WS_FOX_QKV), (unsigned*)(ws + WS_CTL + CTL_NRM2), (vcu - 32) * NWAVES + wave, (G - 32) * NWAVES, lane); }
                   else fox_norms_phase((const bf16*)(ws + WS_FOX_QKV), (unsigned*)(ws + WS_CTL + CTL_NRM2), gw, ngw, lane); }
          }
        PH_END
        }
        if (type == 1) {
        PH_BEGIN(pb + 2)
            const bf16* q = (const bf16*)(ws + WS_FOX_QKV);
            fox::fox_attn_phase(ldsg, q, q + (size_t)32 * SEQ * 128, q + (size_t)64 * SEQ * 128, (const float*)(ws + WS_FOX_CNEG), (const unsigned*)(ws + WS_CTL + CTL_NRM2), (unsigned*)(ws + WS_CTL + CTL_QCTR), (bf16*)(ws + WS_FOX_O));
#if REP_FOX > 1
            __syncthreads();
            fox::fox_attn_phase(ldsg, q, q + (size_t)32 * SEQ * 128, q + (size_t)64 * SEQ * 128, (const float*)(ws + WS_FOX_CNEG), (const unsigned*)(ws + WS_CTL + CTL_NRM2), (unsigned*)(ws + WS_CTL + CTL_QCTR) + 64, (bf16*)(ws + WS_FOX_O));
#endif
        PH_END
        }
        PH_BEGIN(pb + 3)
            if (type == 2) {
                pg8::Gemm g{(const bf16*)(ws + WS_S5_G), (const bf16*)(ws + W_L2_GLU), SEQ, 8192, 4096}; pg8::StaticOrder S; S.init(SEQ, 8192, G, bx);
                pg8::EpiGlu E{TMPM, IN(35)};
                for (int rep = 0; rep < REP_MIXG; ++rep) pg8::gemm_phase<pg8::EpiGlu, pg8::StaticOrder, true, true>(ldsl, g, S, E);
            } else {
                pg8::Gemm g{(const bf16*)(ws + (type == 0 ? WS_SWA_O : WS_FOX_O)), (const bf16*)(ws + (L == 0 ? W_L0_O : L == 1 ? W_L1_O : W_L3_O)), SEQ, 4096, 4096};
                pg8::StaticOrder S; S.init(SEQ, 4096, G, bx);
                pg8::EpiBf16B E{TMPM, 4096, L == 0 ? IN(6) : L == 3 ? IN(48) : nullptr};
                for (int rep = 0; rep < REP_MIXG; ++rep) pg8::gemm_phase<pg8::EpiBf16B, pg8::StaticOrder, true, true>(ldsl, g, S, E);
            }
        PH_END
        PH_BEGIN(pb + 4)
          for (int rep = 0; rep < REP_NORM; ++rep)
            if (L == 0 && rep == 0) norm_phase<0, 1>(gw, ngw, lane, ldsl + wave * 16640, TMPM, SEL(7, 18, 36, 49), IN(0), nullptr, HP, SEL(8, 19, 37, 50), XN, nullptr, 1.f);
            else norm_phase<1, 1>(gw, ngw, lane, ldsl + wave * 16640, TMPM, SEL(7, 18, 36, 49), nullptr, nullptr, HP, SEL(8, 19, 37, 50), L == 3 ? nullptr : XN, nullptr, rep ? 0.f : 1.f, L == 3 ? (unsigned char*)XN : nullptr, (float)(1 << pg8::F8_X_LOG2));
        PH_END
        PH_BEGIN(pb + 5)
            pg8::Gemm g{L == 3 ? (const bf16*)((const unsigned char*)XN - 2 * 4096) : XN - 2 * 4096, (const bf16*)(ws + wffn), 65 * 256, 2 * DFF, L == 3 ? 2048 : 4096, 254}; pg8::StaticOrder S; S.init(65 * 256, 2 * DFF, G, bx);
            pg8::EpiConvGeglu E{(bf16*)(ws + WS_ACT), SEL(10, 21, 39, 52), SEL(11, 22, 40, 53), ldsl + 131072, DFF, SEQ};
          for (int rep = 0; rep < REP_FFN1; ++rep) {
            if constexpr (L == 3) pg8::gemm_phase<pg8::EpiConvGeglu, pg8::StaticOrder, true, true, true>(ldsl, g, S, E);
            else pg8::gemm_phase<pg8::EpiConvGeglu, pg8::StaticOrder, true, true>(ldsl, g, S, E); }
        PH_END
        PH_BEGIN(pb + 7)
            pg8::Gemm g{(const bf16*)(ws + WS_ACT), (const bf16*)(ws + wffn + W_FFN_OUT), SEQ, 4096, DFF}; pg8::StaticOrder S; S.init(SEQ, 4096, G, bx);
            pg8::EpiBf16B E{TMPF, 4096, nullptr};
          for (int rep = 0; rep < REP_FFN2; ++rep)
            pg8::gemm_phase<pg8::EpiBf16B, pg8::StaticOrder, true, true>(ldsl, g, S, E);
        PH_END
        PH_BEGIN(pb + 8)
          for (int rep = 0; rep < REP_NORM; ++rep)
            if (L == 3) { if (rep == 0) norm_phase<1, 0>(gw, ngw, lane, ldsl + wave * 16640, TMPF, SEL(13, 24, 42, 55), nullptr, out, HP, nullptr, nullptr, nullptr, 1.f); }
            else norm_phase<1, 1>(gw, ngw, lane, ldsl + wave * 16640, TMPF, SEL(13, 24, 42, 55), nullptr, nullptr, HP, SEL(14, 25, 43, 43), L == 1 ? nullptr : XN, L == 1 ? (bf16*)(ws + WS_S5_U) : nullptr, rep ? 0.f : 1.f);
        PH_END
    }
#if PROBE_WAIT > 0
#if PROBE_WG >= 0
    if ((int)blockIdx.x == PROBE_WG) { const unsigned long long ts = __builtin_amdgcn_s_memrealtime(); while (__builtin_amdgcn_s_memrealtime() - ts < probe_acc * PROBE_WAIT) __builtin_amdgcn_s_sleep(8); }
#elif PROBE_WG == -1
    { const unsigned long long ts = __builtin_amdgcn_s_memrealtime(); while (__builtin_amdgcn_s_memrealtime() - ts < probe_acc * PROBE_WAIT) __builtin_amdgcn_s_sleep(8); }
#else
    { const unsigned long long ts = __builtin_amdgcn_s_memrealtime(); const unsigned long long c = 250000ull, w = probe_acc < c ? c - probe_acc : 0ull; while (__builtin_amdgcn_s_memrealtime() - ts < w * PROBE_WAIT) __builtin_amdgcn_s_sleep(8); }
#endif
#endif
#undef SEL
#undef PH_BEGIN
#undef PH_END
#undef IN
}

extern "C" void kernel_launch(void* const* d_in, const int* in_sizes, int n_in, void* d_out, int out_size, void* d_ws, size_t ws_size, hipStream_t stream) {
    static int grid = 0;
    if (grid == 0) {
        if (n_in != 56 || in_sizes[0] != SEQ * DM || out_size != SEQ * DM || ws_size < WS_END) {
            fprintf(stderr, "kernel_launch: built for 56 inputs, x/out of %d floats, >= %zu bytes of workspace; got n_in %d, in0 %d, out %d, ws %zu; nothing launched\n", SEQ * DM, (size_t)WS_END, n_in, n_in > 0 ? in_sizes[0] : -1, out_size, ws_size);
            grid = -1; return; }
        int dev = 0, cus = 0, per_cu = 0;
        if (hipGetDevice(&dev) != hipSuccess || hipDeviceGetAttribute(&cus, hipDeviceAttributeMultiprocessorCount, dev) != hipSuccess) { fprintf(stderr, "kernel_launch: device query failed\n"); grid = -1; return; }
        if (hipFuncSetAttribute((const void*)mk_fwd, hipFuncAttributeMaxDynamicSharedMemorySize, LDS_BYTES) != hipSuccess) { fprintf(stderr, "kernel_launch: hipFuncSetAttribute failed\n"); grid = -1; return; }
        if (hipOccupancyMaxActiveBlocksPerMultiprocessor(&per_cu, (const void*)mk_fwd, NTHR, LDS_BYTES) != hipSuccess || per_cu < 1) { fprintf(stderr, "kernel_launch: occupancy query says %d workgroups per CU\n", per_cu); (void)hipGetLastError(); }
        grid = cus;
    }
    if (grid < 0) return;
    if (hipMemsetAsync((char*)d_ws + WS_CTL, 0, CTL_ZERO_BYTES, stream) != hipSuccess) { fprintf(stderr, "kernel_launch: memset failed\n"); return; }
    Args a{};
    for (int i = 0; i < 56; ++i) a.in[i] = (const float*)d_in[i];
    a.out = (float*)d_out; a.ws = (unsigned char*)d_ws;
    { const float lt = (float)(-std::log(500000.0)); for (int i = 0; i < 8; ++i) { float v = lt * (float)i; v = v * 0.125f; a.inv_freq[i] = (float)std::exp((double)v); } }
#if MK_SPLIT_LAUNCHES
    for (int ph = 0; ph < 37; ++ph) {
        const int L = (ph - 1) / 9, slot = (ph - 1) % 9, type = L == 3 ? 0 : L;
        if (ph > 0 && ((slot == 1 && type == 2) || (slot == 2 && type != 1) || slot == 6)) continue;
        a.ph_lo = ph; a.ph_hi = ph + 1;
        hipLaunchKernelGGL(mk_fwd, dim3(grid), dim3(NTHR), LDS_BYTES, stream, a);
    }
#else
    a.ph_lo = 0; a.ph_hi = 37;
    hipLaunchKernelGGL(mk_fwd, dim3(grid), dim3(NTHR), LDS_BYTES, stream, a);
#endif
    const hipError_t le = hipPeekAtLastError();
    if (le != hipSuccess) fprintf(stderr, "kernel_launch: launch failed: %s (grid %d x %d threads, %d B LDS)\n", hipGetErrorName(le), grid, NTHR, LDS_BYTES);
}
```

```cpp
#include <hip/hip_runtime.h>
#include <cstdio>
#include <cstdint>
#include <cmath>

#ifndef MK_SPLIT_LAUNCHES
#define MK_SPLIT_LAUNCHES 0
#endif

__device__ __forceinline__ int mk_tid() { int t = threadIdx.x; asm volatile("" : "+v"(t)); return t; }
__device__ __forceinline__ int launder_s(int v) { asm volatile("" : "+s"(v)); return v; }

#ifndef PROBE_WAIT
#define PROBE_WAIT 0
#endif
#ifndef PROBE_ID
#define PROBE_ID -1
#endif
#ifndef PROBE_MASK
#define PROBE_MASK 0x080
#endif
#ifndef PROBE_WG
#define PROBE_WG -1
#endif
#ifndef F8_FIRST_LAYER
#define F8_FIRST_LAYER 2
#endif
#ifndef PROBE_COPY
#define PROBE_COPY 0
#endif
#ifndef PROBE_T
#define PROBE_T u32x2
#endif
#define PROBE_LD(p) (*(p))
#define PROBE_ST(v, p) (*(p) = (v))
#ifndef REP_PRO
#define REP_PRO 1
#endif
#ifndef REP_FFN1
#define REP_FFN1 1
#endif
#ifndef REP_FFN2
#define REP_FFN2 1
#endif
#ifndef REP_NORM
#define REP_NORM 1
#endif
#ifndef REP_BAR
#define REP_BAR 1
#endif
#ifndef REP_FOX
#define REP_FOX 1
#endif
#ifndef REP_MIXG
#define REP_MIXG 1
#endif
#ifndef REP_MIX
#define REP_MIX 1
#endif

namespace pg8 {
#define PG8_LAS __attribute__((address_space(3)))
typedef unsigned short bf16_t;
typedef short bf16x8 __attribute__((ext_vector_type(8)));
typedef float f32x4 __attribute__((ext_vector_type(4)));
typedef unsigned u32x4 __attribute__((ext_vector_type(4)));
typedef unsigned u32x2 __attribute__((ext_vector_type(2)));
typedef float f32x2 __attribute__((ext_vector_type(2)));
typedef int v4i32 __attribute__((ext_vector_type(4)));
constexpr int F8_W_LOG2 = 10, F8_X_LOG2 = 4, F8_SCALE_W = 0x01010101 * (127 - (F8_W_LOG2 + F8_X_LOG2) / 2), F8_SCALE_X = F8_SCALE_W;
static_assert((F8_W_LOG2 + F8_X_LOG2) % 2 == 0, "the two scalings are undone by two equal E8M0 scales");
constexpr int BM = 256, BK = 64, HALF = 128, HTB = HALF * BK * 2  , STAGE_BYTES = 8 * HTB, NXCD = 8, WGM = 8;

__host__ __device__ __forceinline__ int lds_byte(int r, int c) { const int st = (r >> 4) * 2 + (c >> 5), rr = r & 15, cc = c & 31, ob = rr * 64 + cc * 2; return st * 1024 + (ob ^ (((ob >> 9) & 1) << 5)); }
__host__ __device__ __forceinline__ void stage_rc(int b, int& R, int& C) { const int st = b / 1024, sb = b % 1024, swz = sb ^ (((sb >> 9) & 1) << 5); R = (st >> 1) * 16 + swz / 64; C = (st & 1) * 32 + (swz % 64) / 2; }
__host__ __device__ __forceinline__ int perm32(int rho) { const int n = rho >> 4, i = rho & 15; return 8 * (i >> 2) + 4 * n + (i & 3); }

struct Unit { int pm, pn; };
struct Gemm { const bf16_t* A; const bf16_t* Bt; int M, N, K; int apr = 256; };

struct StaticOrder {
    int nM, nN, nwg, G, c;
    __host__ __device__ void init(int M, int N, int G_, int c_) { nM = M / BM; nN = N / BM; nwg = nM * nN; G = G_; c = c_; }
    __host__ __device__ bool next(int i, Unit& u) const {
        const long L = (long)i * G + c; if (L >= nwg) return false;
        int wgid = (int)L; { const int q = nwg / NXCD, r = nwg % NXCD, xcd = wgid % NXCD, off = wgid / NXCD; wgid = (xcd < r ? xcd * (q + 1) : r * (q + 1) + (xcd - r) * q) + off; }
        const int nig = WGM * nN, ngf = nM / WGM > 0 ? nM / WGM : 1; int gid = wgid / nig; if (gid >= ngf) gid = ngf - 1;
        const int fm = gid * WGM, gsz = gid == ngf - 1 ? nM - fm : WGM, w = wgid - gid * nig;
        u.pm = fm + (w % gsz); u.pn = w / gsz; return true;
    }
    __device__ __forceinline__ void a_ready(const Unit&) const {}
    __device__ __forceinline__ void done(const Unit&) const {}
};

__device__ __forceinline__ unsigned cvt_pk_bf16(float lo, float hi) { unsigned r; asm volatile("v_cvt_pk_bf16_f32 %0, %1, %2" : "=v"(r) : "v"(lo), "v"(hi)); return r; }

struct EpiF32B {
    static constexpr bool PERM = false, AFTER_DRAIN = false, APERM = false;
    float* C; int ldc; const float* bias;
    __device__ __forceinline__ void operator()(const f32x4 (&acc)[2][2][4][2], const Unit& u, int wr, int wc, int fr, int fq) const {
        const int row0 = u.pm * BM + wr * 64 + fr, col0 = u.pn * BM + wc * 32 + 4 * fq;
        f32x4 bv[2][2];
#pragma unroll
        for (int bj = 0; bj < 2; ++bj)
#pragma unroll
            for (int n = 0; n < 2; ++n) bv[bj][n] = bias ? *(const f32x4*)(bias + col0 + bj * HALF + n * 16) : (f32x4){0.f, 0.f, 0.f, 0.f};
#pragma unroll
        for (int ai = 0; ai < 2; ++ai)
#pragma unroll
            for (int m = 0; m < 4; ++m) { float* rowp = C + (size_t)(row0 + ai * HALF + m * 16) * ldc + col0;
#pragma unroll
                for (int bj = 0; bj < 2; ++bj)
#pragma unroll
                    for (int n = 0; n < 2; ++n) *(f32x4*)(rowp + bj * HALF + n * 16) = acc[ai][bj][m][n] + bv[bj][n]; }
    }
};
struct EpiBf16B {
    static constexpr bool PERM = true, AFTER_DRAIN = false, APERM = false;
    bf16_t* O; int ldc; const float* bias;
    __device__ __forceinline__ void operator()(const f32x4 (&acc)[2][2][4][2], const Unit& u, int wr, int wc, int fr, int fq) const {
        const int row0 = u.pm * BM + wr * 64 + fr; const int col0 = u.pn * BM + wc * 32 + 8 * fq;
        f32x4 bv[2][2];
#pragma unroll
        for (int bj = 0; bj < 2; ++bj)
#pragma unroll
            for (int n = 0; n < 2; ++n) bv[bj][n] = bias ? *(const f32x4*)(bias + col0 + bj * HALF + 4 * n) : (f32x4){0.f, 0.f, 0.f, 0.f};
#pragma unroll
        for (int ai = 0; ai < 2; ++ai)
#pragma unroll
            for (int m = 0; m < 4; ++m) { bf16_t* rowp = O + (size_t)(row0 + ai * HALF + m * 16) * ldc + col0;
#pragma unroll
                for (int bj = 0; bj < 2; ++bj) { const f32x4 v0 = acc[ai][bj][m][0] + bv[bj][0], v1 = acc[ai][bj][m][1] + bv[bj][1];
                    u32x4 w; w.x = cvt_pk_bf16(v0[0], v0[1]); w.y = cvt_pk_bf16(v0[2], v0[3]); w.z = cvt_pk_bf16(v1[0], v1[1]); w.w = cvt_pk_bf16(v1[2], v1[3]);
                    *(u32x4*)(rowp + bj * HALF) = w; } }
    }
};
struct EpiFox {
    static constexpr bool PERM = true, AFTER_DRAIN = false, APERM = false;
    bf16_t* QKV; float* logf; const float* bfg;
    __device__ __forceinline__ void operator()(const f32x4 (&acc)[2][2][4][2], const Unit& u, int wr, int wc, int fr, int fq) const {
        const int row0 = u.pm * BM + wr * 64 + fr;
        if (u.pn < 48) {
            const int t3 = u.pn >> 4, hp = u.pn & 15;
#pragma unroll
            for (int bj = 0; bj < 2; ++bj) { bf16_t* base = QKV + ((size_t)(t3 * 32 + 2 * hp + bj) * 16384) * 128 + wc * 32 + 8 * fq;
#pragma unroll
                for (int ai = 0; ai < 2; ++ai)
#pragma unroll
                    for (int m = 0; m < 4; ++m) { const f32x4 v0 = acc[ai][bj][m][0], v1 = acc[ai][bj][m][1];
                        u32x4 w; w.x = cvt_pk_bf16(v0[0], v0[1]); w.y = cvt_pk_bf16(v0[2], v0[3]); w.z = cvt_pk_bf16(v1[0], v1[1]); w.w = cvt_pk_bf16(v1[2], v1[3]);
                        *(u32x4*)(base + (size_t)(row0 + ai * HALF + m * 16) * 128) = w; } }
        } else if (wc == 0) {
            const f32x4 b0 = *(const f32x4*)(bfg + 8 * fq), b1 = *(const f32x4*)(bfg + 8 * fq + 4);
#pragma unroll
            for (int ai = 0; ai < 2; ++ai)
#pragma unroll
                for (int m = 0; m < 4; ++m) { float* rowp = logf + (size_t)(row0 + ai * HALF + m * 16) * 32 + 8 * fq;
#pragma unroll
                    for (int n = 0; n < 2; ++n) { const f32x4 z = acc[ai][0][m][n] + (n ? b1 : b0); f32x4 o;
#pragma unroll
                        for (int i = 0; i < 4; ++i) o[i] = fminf(z[i], 0.f) - log1pf(expf(-fabsf(z[i])));
                        *(f32x4*)(rowp + 4 * n) = o; } }
        }
    }
};
struct EpiGlu {
    static constexpr bool PERM = true, AFTER_DRAIN = false, APERM = false;
    bf16_t* C; const float* bias;
    __device__ __forceinline__ void operator()(const f32x4 (&acc)[2][2][4][2], const Unit& u, int wr, int wc, int fr, int fq) const {
        const int row0 = u.pm * BM + wr * 64 + fr, col0 = u.pn * HALF + wc * 32 + 8 * fq;
        f32x4 bv[2], bg[2];
#pragma unroll
        for (int n = 0; n < 2; ++n) { bv[n] = *(const f32x4*)(bias + col0 + 4 * n); bg[n] = *(const f32x4*)(bias + 4096 + col0 + 4 * n); }
#pragma unroll
        for (int ai = 0; ai < 2; ++ai)
#pragma unroll
            for (int m = 0; m < 4; ++m) { bf16_t* rowp = C + (size_t)(row0 + ai * HALF + m * 16) * 4096 + col0; u32x4 w;
#pragma unroll
                for (int n = 0; n < 2; ++n) { const f32x4 zv = acc[ai][0][m][n] + bv[n], zg = acc[ai][1][m][n] + bg[n]; f32x4 o;
#pragma unroll
                    for (int i = 0; i < 4; ++i) o[i] = zv[i] * __builtin_amdgcn_rcpf(1.0f + __builtin_amdgcn_exp2f(-1.4426950408889634f * zg[i]));
                    if (n == 0) { w.x = cvt_pk_bf16(o[0], o[1]); w.y = cvt_pk_bf16(o[2], o[3]); } else { w.z = cvt_pk_bf16(o[0], o[1]); w.w = cvt_pk_bf16(o[2], o[3]); } }
                *(u32x4*)rowp = w; }
    }
};

struct EpiConvGeglu {
    static constexpr bool PERM = true, AFTER_DRAIN = false, APERM = true;
    bf16_t* ACT; const float* cw; const float* cb; PG8_LAS unsigned char* xl; int dff, nrows;
    static __device__ __forceinline__ float shr1(float old, float src) {
        return __builtin_bit_cast(float, __builtin_amdgcn_update_dpp(__builtin_bit_cast(int, old), __builtin_bit_cast(int, src), 0x111, 0xf, 0xf, false)); }
    static __device__ __forceinline__ float gelu_t(float x) { const float t = 0.7978845608028654f * (x + 0.044715f * x * x * x); return x * __builtin_amdgcn_rcpf(1.0f + __builtin_amdgcn_exp2f(-2.8853900817779268f * t)); }
    __device__ __forceinline__ void operator()(const f32x4 (&acc)[2][2][4][2], const Unit& u, int wr, int wc, int fr, int fq) const {
        asm volatile("" : "+v"(fr), "+v"(fq));
#define XOFF(ai_, w_, rr_, bj_, n_) ((((((ai_) * 2 + (w_)) * 2 + (rr_)) * 2 + (bj_)) * 4 + wc) * 128 + fq * 32 + (n_) * 16)
        f32x4 wv[8];
        { const int gc = u.pn * HALF + wc * 32 + 8 * fq;
            wv[0] = *(const f32x4*)(cw + gc); wv[1] = *(const f32x4*)(cw + 2 * dff + gc); wv[2] = *(const f32x4*)(cw + 4 * dff + gc); wv[3] = *(const f32x4*)(cb + gc);
            wv[4] = *(const f32x4*)(cw + dff + gc); wv[5] = *(const f32x4*)(cw + 3 * dff + gc); wv[6] = *(const f32x4*)(cw + 5 * dff + gc); wv[7] = *(const f32x4*)(cb + dff + gc); }
        if (fr == 15) {
#pragma unroll
            for (int ai = 0; ai < 2; ++ai)
#pragma unroll
                for (int bj = 0; bj < 2; ++bj)
#pragma unroll
                    for (int n = 0; n < 2; ++n) { *(PG8_LAS f32x4*)(xl + XOFF(ai, wr, 0, bj, n)) = acc[ai][bj][2][n]; *(PG8_LAS f32x4*)(xl + XOFF(ai, wr, 1, bj, n)) = acc[ai][bj][3][n]; }
        }
        asm volatile("s_waitcnt lgkmcnt(0)" ::: "memory"); __builtin_amdgcn_s_barrier(); asm volatile("" ::: "memory");
        u32x2 keep[2][4];
#pragma unroll
        for (int n = 0; n < 2; ++n) {
            const int gcol = u.pn * HALF + wc * 32 + 8 * fq + 4 * n;
            if (n) { wv[0] = *(const f32x4*)(cw + gcol); wv[1] = *(const f32x4*)(cw + 2 * dff + gcol); wv[2] = *(const f32x4*)(cw + 4 * dff + gcol); wv[3] = *(const f32x4*)(cb + gcol);
                     wv[4] = *(const f32x4*)(cw + dff + gcol); wv[5] = *(const f32x4*)(cw + 3 * dff + gcol); wv[6] = *(const f32x4*)(cw + 5 * dff + gcol); wv[7] = *(const f32x4*)(cb + dff + gcol); }
            const f32x4 wg0 = wv[0], wg1 = wv[1], wg2 = wv[2], bg = wv[3], wu0 = wv[4], wu1 = wv[5], wu2 = wv[6], bu = wv[7];
#pragma unroll
            for (int ai = 0; ai < 2; ++ai) {
                f32x4 Xg2 = {0.f, 0.f, 0.f, 0.f}, Xg3 = Xg2, Xu2 = Xg2, Xu3 = Xg2;
                if (ai + wr > 0) { const int pa = wr ? ai : ai - 1, pw = wr ? 0 : 1;
                    Xg2 = *(const PG8_LAS f32x4*)(xl + XOFF(pa, pw, 0, 0, n)); Xg3 = *(const PG8_LAS f32x4*)(xl + XOFF(pa, pw, 1, 0, n));
                    Xu2 = *(const PG8_LAS f32x4*)(xl + XOFF(pa, pw, 0, 1, n)); Xu3 = *(const PG8_LAS f32x4*)(xl + XOFF(pa, pw, 1, 1, n)); }
                float o[4][4];
#pragma unroll
                for (int ip = 0; ip < 2; ++ip) {
                    const int i0 = 2 * ip, i1 = 2 * ip + 1;
#define P2(v) ((f32x2){(v)[i0], (v)[i1]})
                    const f32x2 g0 = P2(acc[ai][0][0][n]), g1 = P2(acc[ai][0][1][n]), g2 = P2(acc[ai][0][2][n]), g3 = P2(acc[ai][0][3][n]);
                    const f32x2 u0 = P2(acc[ai][1][0][n]), u1 = P2(acc[ai][1][1][n]), u2 = P2(acc[ai][1][2][n]), u3 = P2(acc[ai][1][3][n]);
                    const f32x2 gm1 = {shr1(Xg3[i0], g3.x), shr1(Xg3[i1], g3.y)}, gm2 = {shr1(Xg2[i0], g2.x), shr1(Xg2[i1], g2.y)};
                    const f32x2 um1 = {shr1(Xu3[i0], u3.x), shr1(Xu3[i1], u3.y)}, um2 = {shr1(Xu2[i0], u2.x), shr1(Xu2[i1], u2.y)};
                    const f32x2 a2 = P2(wg2), a1 = P2(wg1), a0 = P2(wg0), ab = P2(bg), c2 = P2(wu2), c1 = P2(wu1), c0 = P2(wu0), cb = P2(bu);
#define FMA2(a, b, c) __builtin_elementwise_fma((a), (b), (c))
                    const f32x2 zg[4] = {FMA2(a0, gm2, FMA2(a1, gm1, FMA2(a2, g0, ab))), FMA2(a0, gm1, FMA2(a1, g0, FMA2(a2, g1, ab))), FMA2(a0, g0, FMA2(a1, g1, FMA2(a2, g2, ab))), FMA2(a0, g1, FMA2(a1, g2, FMA2(a2, g3, ab)))};
                    const f32x2 zu[4] = {FMA2(c0, um2, FMA2(c1, um1, FMA2(c2, u0, cb))), FMA2(c0, um1, FMA2(c1, u0, FMA2(c2, u1, cb))), FMA2(c0, u0, FMA2(c1, u1, FMA2(c2, u2, cb))), FMA2(c0, u1, FMA2(c1, u2, FMA2(c2, u3, cb)))};
#pragma unroll
                    for (int m = 0; m < 4; ++m) {
                        const f32x2 x = zg[m], x2 = x * x; const f32x2 kk = {-2.302208198f, -2.302208198f}, k3 = {-2.302208198f * 0.044715f, -2.302208198f * 0.044715f}, one = {1.f, 1.f};
                        const f32x2 a = x * FMA2(x2, k3, kk); const f32x2 e = {__builtin_amdgcn_exp2f(a.x), __builtin_amdgcn_exp2f(a.y)}; const f32x2 d = e + one;
                        const f32x2 r = {__builtin_amdgcn_rcpf(d.x), __builtin_amdgcn_rcpf(d.y)}; const f32x2 ov = (x * zu[m]) * r;
                        o[m][i0] = ov.x; o[m][i1] = ov.y; }
#undef FMA2
#undef P2
                }
#pragma unroll
                for (int m = 0; m < 4; ++m) { const int it = ai * HALF + wr * 64 + 4 * fr + m, grow = u.pm * 254 - 2 + it;
                    u32x2 w; w.x = cvt_pk_bf16(o[m][0], o[m][1]); w.y = cvt_pk_bf16(o[m][2], o[m][3]);
                    if (n == 0) keep[ai][m] = w;
                    else if (it >= 2 && grow < nrows) { u32x4 ww; ww.x = keep[ai][m].x; ww.y = keep[ai][m].y; ww.z = w.x; ww.w = w.y; *(u32x4*)(ACT + (size_t)grow * dff + gcol - 4) = ww; } }
            }
        }
#undef XOFF
    }
};

template <class Epi, class Sched, bool ALIGN_EPI = false, bool SP2 = false, bool F8 = false>
__device__ __forceinline__ void gemm_phase(PG8_LAS unsigned char* lds, const Gemm g, const Sched& S, const Epi& E) {
    const int tid = mk_tid(), wid = __builtin_amdgcn_readfirstlane(tid >> 6), lane = tid & 63, wr = wid >> 2, wc = wid & 3, fr = lane & 15, fq = lane >> 4;
    const int K = g.K, nt = K / BK;
    unsigned voffA, voffB;
    { int R, C; stage_rc(tid * 16, R, C); const int Rb = Epi::PERM ? ((R & ~31) + perm32(R & 31)) : R;
        const int Ra = Epi::APERM ? ((R & ~63) + 4 * (R & 15) + ((R >> 4) & 3)) : R;
        voffA = (unsigned)(Ra * K + C) * 2u; voffB = (unsigned)(Rb * K + C) * 2u; }
    const size_t r64 = (size_t)64 * K * 2;
    const size_t kstep = (size_t)(BK * 2);
    const size_t hstep = (size_t)HALF * K * 2;
    const size_t tstep = 2 * hstep;
    const size_t tstepA = (size_t)g.apr * K * 2;
    const unsigned ldsw = (unsigned)wid * 1024u;
    const int aoff = lds_byte(wr * 64 + fr, fq * 8), boff = lds_byte(wc * 32 + fr, fq * 8);
#define PG8_SA(b, h) (((b) * 2 + (h)) * HTB)
#define PG8_SB(b, h) ((4 + (b) * 2 + (h)) * HTB)
#define PG8_STAGE(bufoff, gbase, voff) do { _Pragma("unroll") for (int _i = 0; _i < 2; ++_i) \
        __builtin_amdgcn_global_load_lds((const unsigned*)((const char*)(gbase) + (size_t)_i * r64 + (voff)), (PG8_LAS unsigned*)(lds + (bufoff) + ldsw + _i * 8192), 16, 0, 0); } while (0)
#define PG8_LDA(dst, b, h) do { _Pragma("unroll") for (int m = 0; m < 4; ++m) _Pragma("unroll") for (int k = 0; k < 2; ++k) dst[m][k] = *(const PG8_LAS bf16x8*)(lds + PG8_SA(b, h) + aoff + m * 2048 + k * 1024); } while (0)
#define PG8_LDB(dst, b, h) do { _Pragma("unroll") for (int n = 0; n < 2; ++n) _Pragma("unroll") for (int k = 0; k < 2; ++k) dst[n][k] = *(const PG8_LAS bf16x8*)(lds + PG8_SB(b, h) + boff + n * 2048 + k * 1024); } while (0)
#define PG8_CAT(f) __builtin_shufflevector(__builtin_bit_cast(v4i32, (f)[0]), __builtin_bit_cast(v4i32, (f)[1]), 0, 1, 2, 3, 4, 5, 6, 7)
#define PG8_MMA(ai, bj, At, Bt) do { __builtin_amdgcn_s_setprio(1); _Pragma("unroll") for (int m = 0; m < 4; ++m) _Pragma("unroll") for (int n = 0; n < 2; ++n) { \
        if constexpr (F8) acc[ai][bj][m][n] = __builtin_amdgcn_mfma_scale_f32_16x16x128_f8f6f4(PG8_CAT(Bt[n]), PG8_CAT(At[m]), acc[ai][bj][m][n], 0, 0, 0, F8_SCALE_W, 0, F8_SCALE_X); \
        else { _Pragma("unroll") for (int k = 0; k < 2; ++k) acc[ai][bj][m][n] = __builtin_amdgcn_mfma_f32_16x16x32_bf16(Bt[n][k], At[m][k], acc[ai][bj][m][n], 0, 0, 0); } } \
        __builtin_amdgcn_s_setprio(0); } while (0)
#define PG8_WAIT_V(n) asm volatile("s_waitcnt vmcnt(" #n ")" ::: "memory")
#define PG8_WAIT_L(n) asm volatile("s_waitcnt lgkmcnt(" #n ")" ::: "memory")
#define PG8_BAR __builtin_amdgcn_s_barrier()
#define PG8_SCHED __builtin_amdgcn_sched_barrier(0)
    Unit cur, nxt; int ui = 0;
    if (!S.next(0, cur)) return;
    f32x4 acc[2][2][4][2];
#pragma unroll
    for (int a = 0; a < 2; ++a)
#pragma unroll
        for (int b = 0; b < 2; ++b)
#pragma unroll
            for (int m = 0; m < 4; ++m)
#pragma unroll
                for (int n = 0; n < 2; ++n) acc[a][b][m][n] = (f32x4){0.f, 0.f, 0.f, 0.f};
    bf16x8 At[4][2], B0[2][2], B1[2][2];
    const char* cA = (const char*)g.A + (size_t)cur.pm * tstepA; const char* cB = (const char*)g.Bt + (size_t)cur.pn * tstep;
    S.a_ready(cur);
    if constexpr (SP2) {
        PG8_STAGE(PG8_SB(0, 0), cB, voffB); PG8_STAGE(PG8_SB(0, 1), cB + hstep, voffB); PG8_STAGE(PG8_SA(0, 0), cA, voffA); PG8_STAGE(PG8_SA(0, 1), cA + hstep, voffA);
        if (wr == 1) PG8_BAR;
        PG8_WAIT_V(2); PG8_BAR;
        PG8_STAGE(PG8_SB(1, 0), cB + kstep, voffB); PG8_STAGE(PG8_SA(1, 0), cA + kstep, voffA); PG8_STAGE(PG8_SB(1, 1), cB + hstep + kstep, voffB);
        PG8_WAIT_V(6); PG8_BAR;
    } else {
        PG8_STAGE(PG8_SB(0, 0), cB, voffB); PG8_STAGE(PG8_SA(0, 0), cA, voffA); PG8_STAGE(PG8_SB(0, 1), cB + hstep, voffB); PG8_STAGE(PG8_SA(0, 1), cA + hstep, voffA);
        if (wr == 1) PG8_BAR;
        PG8_WAIT_V(4); PG8_BAR;
        PG8_STAGE(PG8_SB(1, 0), cB + kstep, voffB); PG8_STAGE(PG8_SA(1, 0), cA + kstep, voffA); PG8_STAGE(PG8_SB(1, 1), cB + hstep + kstep, voffB);
        PG8_WAIT_V(6); PG8_BAR;
    }
    for (;;) {
        const bool has_next = S.next(ui + 1, nxt);
        const char* nA = has_next ? (const char*)g.A + (size_t)nxt.pm * tstepA : cA; const char* nB = has_next ? (const char*)g.Bt + (size_t)nxt.pn * tstep : cB;
        for (int t = 0; t < nt; t += 2) {
            const bool last = (t == nt - 2);
            const char* a1 = cA + (size_t)(t + 1) * kstep;
            const char* a2 = last ? nA : cA + (size_t)(t + 2) * kstep; const char* b2 = last ? nB : cB + (size_t)(t + 2) * kstep;
            const char* a3 = a2 + kstep; const char* b3 = b2 + kstep;
            if (last && has_next) S.a_ready(nxt);
            if constexpr (SP2) {
            PG8_LDB(B0, 0, 0); PG8_LDB(B1, 0, 1); PG8_SCHED; PG8_LDA(At, 0, 0); PG8_STAGE(PG8_SA(1, 1), a1 + hstep, voffA);
            PG8_WAIT_V(8); PG8_WAIT_L(0); PG8_BAR; PG8_MMA(0, 0, At, B0); PG8_MMA(0, 1, At, B1); PG8_BAR; PG8_SCHED;
            PG8_LDA(At, 0, 1); PG8_STAGE(PG8_SB(0, 0), b2, voffB); PG8_STAGE(PG8_SB(0, 1), b2 + hstep, voffB); PG8_STAGE(PG8_SA(0, 0), a2, voffA);
            PG8_WAIT_V(8); PG8_WAIT_L(0); PG8_BAR; PG8_MMA(1, 0, At, B0); PG8_MMA(1, 1, At, B1); PG8_BAR; PG8_SCHED;
            PG8_LDB(B0, 1, 0); PG8_LDB(B1, 1, 1); PG8_SCHED; PG8_LDA(At, 1, 0); PG8_STAGE(PG8_SA(0, 1), a2 + hstep, voffA);
            PG8_WAIT_V(8); PG8_WAIT_L(0); PG8_BAR; PG8_MMA(0, 0, At, B0); PG8_MMA(0, 1, At, B1); PG8_BAR; PG8_SCHED;
            PG8_LDA(At, 1, 1); PG8_STAGE(PG8_SB(1, 0), b3, voffB); PG8_STAGE(PG8_SB(1, 1), b3 + hstep, voffB); PG8_STAGE(PG8_SA(1, 0), a3, voffA);
            PG8_WAIT_V(8); PG8_WAIT_L(0); PG8_BAR; PG8_MMA(1, 0, At, B0); PG8_MMA(1, 1, At, B1); PG8_BAR; PG8_SCHED;
            } else {
            PG8_LDB(B0, 0, 0); PG8_SCHED; PG8_LDA(At, 0, 0); PG8_STAGE(PG8_SA(1, 1), a1 + hstep, voffA);
            PG8_WAIT_L(8); PG8_BAR; PG8_WAIT_L(0); PG8_MMA(0, 0, At, B0); PG8_BAR; PG8_SCHED;
            PG8_LDB(B1, 0, 1); PG8_STAGE(PG8_SB(0, 0), b2, voffB);
            PG8_BAR; PG8_WAIT_L(0); PG8_MMA(0, 1, At, B1); PG8_BAR;
            PG8_LDA(At, 0, 1); PG8_STAGE(PG8_SA(0, 0), a2, voffA);
            PG8_BAR; PG8_WAIT_L(0); PG8_MMA(1, 0, At, B0); PG8_BAR; PG8_SCHED;
            PG8_STAGE(PG8_SB(0, 1), b2 + hstep, voffB);
            PG8_WAIT_V(6); PG8_BAR; PG8_MMA(1, 1, At, B1); PG8_BAR;
            PG8_LDB(B0, 1, 0); PG8_SCHED; PG8_LDA(At, 1, 0); PG8_STAGE(PG8_SA(0, 1), a2 + hstep, voffA);
            PG8_WAIT_L(8); PG8_BAR; PG8_WAIT_L(0); PG8_MMA(0, 0, At, B0); PG8_BAR; PG8_SCHED;
            PG8_LDB(B1, 1, 1); PG8_STAGE(PG8_SB(1, 0), b3, voffB);
            PG8_BAR; PG8_WAIT_L(0); PG8_MMA(0, 1, At, B1); PG8_BAR;
            PG8_LDA(At, 1, 1); PG8_STAGE(PG8_SA(1, 0), a3, voffA);
            PG8_BAR; PG8_WAIT_L(0); PG8_MMA(1, 0, At, B0); PG8_BAR; PG8_SCHED;
            PG8_STAGE(PG8_SB(1, 1), b3 + hstep, voffB);
            PG8_WAIT_V(6); PG8_BAR; PG8_MMA(1, 1, At, B1); PG8_BAR;
            }
        }
        if constexpr (ALIGN_EPI) { if (wr == 0) PG8_BAR; }
        if constexpr (!Epi::AFTER_DRAIN) { E(acc, cur, wr, wc, fr, fq); S.done(cur); }
        if (!has_next) break;
#pragma unroll
        for (int a = 0; a < 2; ++a)
#pragma unroll
            for (int b = 0; b < 2; ++b)
#pragma unroll
                for (int m = 0; m < 4; ++m)
#pragma unroll
                    for (int n = 0; n < 2; ++n) acc[a][b][m][n] = (f32x4){0.f, 0.f, 0.f, 0.f};
        cur = nxt; cA = nA; cB = nB; ++ui;
        if constexpr (ALIGN_EPI) { if (wr == 1) PG8_BAR; }
    }
    PG8_WAIT_V(0);
    if constexpr (!ALIGN_EPI) { if (wr == 0) PG8_BAR; }
    PG8_BAR;
    if constexpr (Epi::AFTER_DRAIN) { E.fused(acc, cur, wr, wc, fr, fq, lds, wid, lane); S.done(cur); }
#undef PG8_SA
#undef PG8_SB
#undef PG8_STAGE
#undef PG8_LDA
#undef PG8_LDB
#undef PG8_MMA
#undef PG8_CAT
#undef PG8_WAIT_V
#undef PG8_WAIT_L
#undef PG8_BAR
#undef PG8_SCHED
}
}

namespace fox {
#define LAS3 __attribute__((address_space(3)))
constexpr int D = 128, SEQ = 16384, NH = 32, OPITCH = 4096;
constexpr float SCALE = 0.08838834764831845f;
constexpr float THR = 8.f;
constexpr int NW = 8, QBLK = 32, KVBLK = 64, QB = NW * QBLK;
constexpr int SHM_V = KVBLK * D * 2, SHM_K = KVBLK * D * 2;
constexpr int OFF_WS = 2 * SHM_V + 2 * SHM_K, OFF_BIAS = OFF_WS + NW * 64 * 4, OFF_QW = OFF_BIAS + 2 * 64 * 4, OFF_JLO = OFF_QW + 16, OFF_KEY = OFF_JLO + 2048, OFF_ORD = OFF_KEY + 8192, LDS_BYTES = OFF_ORD + 4096;
constexpr float SKIP_T = 30.f;
typedef unsigned short bf16;
typedef short bf16x8 __attribute__((ext_vector_type(8)));
typedef short s16x4 __attribute__((ext_vector_type(4)));
typedef float f32x16 __attribute__((ext_vector_type(16)));
typedef float f32x4 __attribute__((ext_vector_type(4)));
typedef unsigned u32x4 __attribute__((ext_vector_type(4)));

#define KSWZ(row, colB) ((row) * 256 + ((colB) ^ (((row) & 7) << 4)))
#define SBAR() __builtin_amdgcn_sched_barrier(0)
__device__ __forceinline__ int v_st(int k, int c) { const int kk = (k & ~0xC) | ((k & 4) << 1) | ((k & 8) >> 1); return ((kk >> 3) * 4 + (c >> 5)) * 512 + ((kk & 7) * 32 + (c & 31)) * 2; }
__device__ __forceinline__ int v_rd_base(int lane) { return ((lane & 3) << 3) | (((lane >> 2) & 3) << 6) | (((lane >> 4) & 1) << 5) | (((lane >> 5) & 1) << 8); }
constexpr int v_rd_off(int d0, int ks, int half) { return d0 * 512 + ks * 4096 + half * 2048; }
__device__ __forceinline__ int crow(int r, int hi) { return (r & 3) + 8 * (r >> 2) + 4 * hi; }
__device__ __forceinline__ unsigned cvtpk(float lo, float hi) { unsigned r; asm volatile("v_cvt_pk_bf16_f32 %0, %1, %2" : "=v"(r) : "v"(lo), "v"(hi)); return r; }
__device__ __forceinline__ bf16x8 load8(const bf16* p) { return *reinterpret_cast<const bf16x8*>(p); }
__device__ __forceinline__ void mask_tile(f32x16& p0, f32x16& p1, int dq) {
    const float NEG = -__builtin_inff();
#pragma unroll
    for (int r = 0; r < 16; ++r) {
        const int c = (r & 3) + 8 * (r >> 2);
        if (dq - c < 0) p0[r] = NEG;
        if (dq - c - 32 < 0) p1[r] = NEG;
    }
}
__device__ __forceinline__ void partialSM(f32x16& p0, f32x16& p1, float& m_reg, float& mn, float& alpha) {
    float pmax = p0[0]; for (int r = 1; r < 16; ++r) pmax = fmaxf(pmax, p0[r]); for (int r = 0; r < 16; ++r) pmax = fmaxf(pmax, p1[r]);
    { auto rr = __builtin_amdgcn_permlane32_swap(__float_as_uint(pmax), __float_as_uint(pmax), false, false);
      pmax = fmaxf(__uint_as_float(rr[0]), __uint_as_float(rr[1])); }
    constexpr float C2 = 1.4426950408889634f * SCALE;
    if (__builtin_expect(__all((pmax - m_reg) * SCALE <= THR), 1)) { mn = m_reg; alpha = 1.f; }
    else { mn = fmaxf(m_reg, pmax); alpha = __builtin_amdgcn_exp2f((m_reg - mn) * C2); m_reg = mn; }
    const float mnL = -mn * C2;
    for (int r = 0; r < 16; ++r) p0[r] = fmaf(p0[r], C2, mnL); for (int r = 0; r < 16; ++r) p1[r] = fmaf(p1[r], C2, mnL);
    for (int r = 0; r < 16; ++r) p0[r] = __builtin_amdgcn_exp2f(p0[r]);
}
__device__ __forceinline__ void finishSM(f32x16& p0, f32x16& p1, float alpha, float& l_reg, bf16x8& pa0, bf16x8& pa1, bf16x8& pa2, bf16x8& pa3) {
    for (int r = 0; r < 16; ++r) p1[r] = __builtin_amdgcn_exp2f(p1[r]);
    float ps = 0; for (int r = 0; r < 16; ++r) ps += p0[r]; for (int r = 0; r < 16; ++r) ps += p1[r];
    { auto rr = __builtin_amdgcn_permlane32_swap(__float_as_uint(ps), __float_as_uint(ps), false, false);
      ps = __uint_as_float(rr[0]) + __uint_as_float(rr[1]); }
    l_reg = l_reg * alpha + ps;
#define PK4(P, B_, OUT) do { unsigned a0 = cvtpk(P[B_+0], P[B_+1]), a1 = cvtpk(P[B_+2], P[B_+3]);                          \
        unsigned b0 = cvtpk(P[B_+4], P[B_+5]), b1 = cvtpk(P[B_+6], P[B_+7]);                                             \
        auto r0 = __builtin_amdgcn_permlane32_swap(a0, b0, false, false); auto r1 = __builtin_amdgcn_permlane32_swap(a1, b1, false, false); \
        u32x4 w = {r0[0], r1[0], r0[1], r1[1]}; OUT = *reinterpret_cast<bf16x8*>(&w); } while (0)
    PK4(p0, 0, pa0); PK4(p0, 8, pa1); PK4(p1, 0, pa2); PK4(p1, 8, pa3);
}
template <int KB>
__device__ __forceinline__ void qkt(f32x16& p0, f32x16& p1, const char* K_lds, const char* B_lds, int r32, int hi, const bf16x8* qr) {
    const float* bl = (const float*)B_lds + KB * 64 + 4 * hi;
#pragma unroll
    for (int g = 0; g < 4; ++g) { const f32x4 a = *(const f32x4*)(bl + 8 * g), b = *(const f32x4*)(bl + 32 + 8 * g);
        p0[4 * g + 0] = a[0]; p0[4 * g + 1] = a[1]; p0[4 * g + 2] = a[2]; p0[4 * g + 3] = a[3];
        p1[4 * g + 0] = b[0]; p1[4 * g + 1] = b[1]; p1[4 * g + 2] = b[2]; p1[4 * g + 3] = b[3]; }
    const char* kb[4];
#pragma unroll
    for (int dd = 0; dd < 4; ++dd) kb[dd] = K_lds + KB * SHM_K + KSWZ(r32, (dd * 16 + hi * 8) * 2);
#pragma unroll
    for (int d0 = 0; d0 < 8; ++d0) { const char* a = kb[d0 & 3] + (d0 >> 2) * 128;
        bf16x8 b0 = *reinterpret_cast<const bf16x8*>(a);
        bf16x8 b1 = *reinterpret_cast<const bf16x8*>(a + 32 * 256);
        p0 = __builtin_amdgcn_mfma_f32_32x32x16_bf16(b0, qr[d0], p0, 0, 0, 0);
        p1 = __builtin_amdgcn_mfma_f32_32x32x16_bf16(b1, qr[d0], p1, 0, 0, 0); }
}
template <int VB>
__device__ __forceinline__ void pv_tile(f32x16* o, int vb0, bf16x8 pa0, bf16x8 pa1, bf16x8 pa2, bf16x8 pa3) {
#define TRRD(dst, off) asm volatile("ds_read_b64_tr_b16 %0, %1 offset:%2" : "=&v"(dst) : "v"(vb0), "i"(off) : "memory")
#define PV_D0(d0) do { s16x4 l0, l1, l2, l3, h0, h1, h2, h3; constexpr int b_ = VB * SHM_V + v_rd_off(d0, 0, 0);     \
        TRRD(l0, b_); TRRD(h0, b_ + 2048); TRRD(l1, b_ + 4096); TRRD(h1, b_ + 6144); TRRD(l2, b_ + 8192); TRRD(h2, b_ + 10240); TRRD(l3, b_ + 12288); TRRD(h3, b_ + 14336); \
        asm volatile("s_waitcnt lgkmcnt(0)" ::: "memory"); SBAR();                                                                              \
        o[d0] = __builtin_amdgcn_mfma_f32_32x32x16_bf16((bf16x8){l0[0], l0[1], l0[2], l0[3], h0[0], h0[1], h0[2], h0[3]}, pa0, o[d0], 0, 0, 0);   \
        o[d0] = __builtin_amdgcn_mfma_f32_32x32x16_bf16((bf16x8){l1[0], l1[1], l1[2], l1[3], h1[0], h1[1], h1[2], h1[3]}, pa1, o[d0], 0, 0, 0);   \
        o[d0] = __builtin_amdgcn_mfma_f32_32x32x16_bf16((bf16x8){l2[0], l2[1], l2[2], l2[3], h2[0], h2[1], h2[2], h2[3]}, pa2, o[d0], 0, 0, 0);   \
        o[d0] = __builtin_amdgcn_mfma_f32_32x32x16_bf16((bf16x8){l3[0], l3[1], l3[2], l3[3], h3[0], h3[1], h3[2], h3[3]}, pa3, o[d0], 0, 0, 0); } while (0)
    PV_D0(0); PV_D0(1); PV_D0(2); PV_D0(3);
#undef PV_D0
#undef TRRD
}

struct BlockRef { const bf16* Q; const bf16* K; const bf16* V; const float* C; bf16* O; int P0; int jlo; };
struct Seam {
    bf16x8 qr[8];
    bf16x8 st_v0, st_v1, st_k0, st_k1; float st_b;
};
#define ROW(p, k0, rr) ((p) + (size_t)((k0) + (rr)) * D + sc)
#define VMW() asm volatile("s_waitcnt vmcnt(0)" ::: "memory")
#define VMWN(n) asm volatile("s_waitcnt vmcnt(%0)" :: "i"(n) : "memory")
#define SLOAD_H(Kp, Vp, Cp, k0) do { S.st_v0 = load8(ROW(Vp, k0, sr)); S.st_v1 = load8(ROW(Vp, k0, 32 + sr));              \
                         S.st_k0 = load8(ROW(Kp, k0, sr)); S.st_k1 = load8(ROW(Kp, k0, 32 + sr)); if (tid < 64) S.st_b = (Cp)[(k0) + tid]; } while (0)
#define SWRITE_HK(bf, cr) do { *(bf16x8*)(K_lds + (bf) * SHM_K + kws) = S.st_k0; *(bf16x8*)(K_lds + (bf) * SHM_K + kws + 32 * 256) = S.st_k1; \
                         if (tid < 64) ((float*)B_lds)[(bf) * 64 + tid] = S.st_b - (cr); } while (0)
#define SWRITE_HV(bf) do { *(bf16x8*)(V_lds + (bf) * SHM_V + vst0) = S.st_v0; *(bf16x8*)(V_lds + (bf) * SHM_V + vst1) = S.st_v1; } while (0)
#define SWRITE_H(bf, cr) do { SWRITE_HV(bf); SWRITE_HK(bf, cr); } while (0)
__device__ __forceinline__ void fox_prime(const BlockRef& cur, char* lds, Seam& S) {
    const int tid = mk_tid(), wid = __builtin_amdgcn_readfirstlane(tid >> 6), lane = tid & 63, r32 = lane & 31, hi = lane >> 5;
    const int sr = tid >> 4, sc = (tid & 15) * 8, kws = KSWZ(sr, sc * 2); char* K_lds = lds + 2 * SHM_V; char* B_lds = lds + OFF_BIAS;
    const float cref = __uint_as_float(__builtin_amdgcn_readfirstlane(__float_as_uint(cur.C[cur.P0])));
    for (int d0 = 0; d0 < 8; ++d0) S.qr[d0] = load8(cur.Q + (size_t)(wid * QBLK + r32) * D + d0 * 16 + hi * 8);
    SLOAD_H(cur.K, cur.V, cur.C, cur.jlo * KVBLK); VMW(); SWRITE_HK(0, cref);
    __syncthreads();
}
template <class NextFn> __device__ __forceinline__ BlockRef fox_block(const BlockRef& cur, char* lds, Seam& S, unsigned* qctr, const NextFn& mkref, bool& has_next) {
    const int tid = mk_tid(), wid = __builtin_amdgcn_readfirstlane(tid >> 6), lane = tid & 63, r32 = lane & 31, hi = lane >> 5;
    const int j_lo = cur.jlo, NT = (cur.P0 + QB - 1) / KVBLK + 1 - j_lo;
    unsigned qv = 0u; if (tid == 0) qv = __hip_atomic_fetch_add(qctr, 1u, __ATOMIC_RELAXED, __HIP_MEMORY_SCOPE_AGENT);
    const int qlo = cur.P0 + wid * QBLK, qm = qlo + r32 - 4 * hi;
    char* V_lds = lds; char* K_lds = lds + 2 * SHM_V; char* B_lds = lds + OFF_BIAS;
    float m_reg = -1e30f, l_reg = 0; f32x16 o[4] = {};
    const int sr = tid >> 4, sc = (tid & 15) * 8, vst0 = v_st(sr, sc), vst1 = v_st(32 + sr, sc), kws = KSWZ(sr, sc * 2);
    const int vb0 = (int)(uintptr_t)V_lds + v_rd_base(lane);
    const bf16* Kh = cur.K; const bf16* Vh = cur.V; const float* Ch = cur.C;
    const float cref = __uint_as_float(__builtin_amdgcn_readfirstlane(__float_as_uint(cur.C[cur.P0])));
#define RESC(a) do { if (__any((a) < 1.f)) { for (int d_ = 0; d_ < 4; ++d_) for (int r = 0; r < 16; ++r) o[d_][r] *= (a); } } while (0)
#define KBASE(t) ((j_lo + (t)) * KVBLK)
#define MASKT(P0_, P1_, t) do { const int kb_ = KBASE(t); if (kb_ + KVBLK - 1 > qlo) mask_tile(P0_, P1_, qm - kb_); } while (0)
    constexpr int NQL = 8;
#define SEAM_K0() do { VMWN(NQL); SWRITE_HK(0, crefn); SBAR(); } while (0)
    f32x16 pA0, pA1, pB0, pB1; float mnA, mnB, alA, alB; bf16x8 pa0, pa1, pa2, pa3;
    SWRITE_HV(0); SBAR();
    if (NT > 1) { SLOAD_H(Kh, Vh, Ch, KBASE(1)); }
    SBAR(); qkt<0>(pA0, pA1, K_lds, B_lds, r32, hi, S.qr);
    MASKT(pA0, pA1, 0); partialSM(pA0, pA1, m_reg, mnA, alA);
    if (NT > 1) { VMW(); SWRITE_H(1, cref); }
    if (tid == 0) *(volatile LAS3 unsigned*)(lds + OFF_QW) = qv;
    __syncthreads();
    const unsigned inext = (unsigned)__builtin_amdgcn_readfirstlane((int)*(volatile LAS3 unsigned*)(lds + OFF_QW)); has_next = inext < (unsigned)(NH * (SEQ / QB));
    const BlockRef nxt = has_next ? mkref((int)inext) : cur;
    const float crefn = __uint_as_float(__builtin_amdgcn_readfirstlane(__float_as_uint(nxt.C[nxt.P0]))); const int kbn = nxt.jlo * KVBLK;
#define HALF_STEP(PX0, PX1, mnX, alX, PY0, PY1, alY, t, KB, VB, SB) do {                                                      \
        SBAR(); qkt<KB>(PX0, PX1, K_lds, B_lds, r32, hi, S.qr);                                                               \
        finishSM(PY0, PY1, alY, l_reg, pa0, pa1, pa2, pa3); SBAR();                                                           \
        if ((t) + 1 < NT) { SLOAD_H(Kh, Vh, Ch, KBASE((t) + 1)); SBAR(); }                                                    \
        pv_tile<VB>(o, vb0, pa0, pa1, pa2, pa3); MASKT(PX0, PX1, (t)); partialSM(PX0, PX1, m_reg, mnX, alX);                  \
        __syncthreads();                                                                                                      \
        if ((t) + 1 < NT) { VMW(); SWRITE_H(SB, cref); }                                                                      \
        RESC(alX); __syncthreads(); } while (0)
    for (int t = 1; t + 1 < NT; t += 2) {
        HALF_STEP(pB0, pB1, mnB, alB, pA0, pA1, alA, t, 1, 0, 0);
        HALF_STEP(pA0, pA1, mnA, alA, pB0, pB1, alB, t + 1, 0, 1, 1);
    }
    const bool even = (NT & 1) == 0;
    if (even) { SBAR(); qkt<1>(pB0, pB1, K_lds, B_lds, r32, hi, S.qr); SBAR(); }
    SLOAD_H(nxt.K, nxt.V, nxt.C, kbn); SBAR();
#pragma unroll
    for (int d0 = 0; d0 < 8; ++d0) S.qr[d0] = load8(nxt.Q + (size_t)(wid * QBLK + r32) * D + d0 * 16 + hi * 8);
    SBAR();
    finishSM(pA0, pA1, alA, l_reg, pa0, pa1, pa2, pa3); SBAR();
    pv_tile<0>(o, vb0, pa0, pa1, pa2, pa3);
    if (even) { MASKT(pB0, pB1, NT - 1); partialSM(pB0, pB1, m_reg, mnB, alB); __syncthreads(); RESC(alB);
        finishSM(pB0, pB1, alB, l_reg, pa0, pa1, pa2, pa3); SBAR(); pv_tile<1>(o, vb0, pa0, pa1, pa2, pa3); }
    SBAR(); SEAM_K0();
    {
        const float rl = __builtin_amdgcn_rcpf(l_reg);
        bf16* Ow = cur.O + (size_t)(wid * QBLK + r32) * OPITCH + 8 * hi;
#pragma unroll
        for (int d0 = 0; d0 < 4; ++d0)
#pragma unroll
            for (int gp = 0; gp < 2; ++gp) { const int b_ = 8 * gp;
                const unsigned a0 = cvtpk(o[d0][b_ + 0] * rl, o[d0][b_ + 1] * rl), a1 = cvtpk(o[d0][b_ + 2] * rl, o[d0][b_ + 3] * rl);
                const unsigned b0 = cvtpk(o[d0][b_ + 4] * rl, o[d0][b_ + 5] * rl), b1 = cvtpk(o[d0][b_ + 6] * rl, o[d0][b_ + 7] * rl);
                auto r0 = __builtin_amdgcn_permlane32_swap(a0, b0, false, false); auto r1 = __builtin_amdgcn_permlane32_swap(a1, b1, false, false);
                u32x4 w = {r0[0], r1[0], r0[1], r1[1]}; *(u32x4*)(Ow + d0 * 32 + 16 * gp) = w; }
    }
    __syncthreads();
    return nxt;
#undef RESC
#undef KBASE
#undef MASKT
#undef SEAM_K0
#undef HALF_STEP
}
#undef ROW
#undef VMW
#undef VMWN
#undef SLOAD_H
#undef SWRITE_HK
#undef SWRITE_HV
#undef SWRITE_H
#undef PK4

__device__ __forceinline__ BlockRef fox_ref(int item, const bf16* Q, const bf16* K, const bf16* V, const float* Cn, bf16* O, const char* lds) {
    const int e = (int)((const unsigned short*)(lds + OFF_ORD))[item], qb = e & 63, bh = e >> 6;
    BlockRef r; r.Q = Q + ((size_t)bh * SEQ + (size_t)qb * QB) * D; r.K = K + (size_t)bh * SEQ * D; r.V = V + (size_t)bh * SEQ * D; r.C = Cn + (size_t)bh * SEQ;
    r.O = O + (size_t)(qb * QB) * OPITCH + bh * D; r.P0 = qb * QB; r.jlo = (int)((const unsigned char*)(lds + OFF_JLO))[bh * 64 + qb]; return r;
}
__device__ __forceinline__ void fox_attn_phase(char* lds, const bf16* Q, const bf16* K, const bf16* V, const float* Cn, const unsigned* nrm2, unsigned* qctr, bf16* O) {
    const int tid = mk_tid();
    {
        int lo[4], hi[4]; float thr[4]; const float* Cb[4];
#pragma unroll
        for (int k = 0; k < 4; ++k) { const int e = tid + 512 * k, bh = e >> 6, qb = e & 63, P0 = qb * QB; Cb[k] = Cn + (size_t)bh * SEQ;
            const float qn2 = __uint_as_float(nrm2[bh]), kn2 = __uint_as_float(nrm2[32 + bh]);
            const float Dh = SKIP_T * (1.0f / SCALE) + 2.04f * sqrtf(qn2 * kn2) + 1.0f;
            thr[k] = Cb[k][P0] - Dh; lo[k] = 0; hi[k] = P0 / KVBLK; }
#pragma unroll 1
        for (int it = 0; it < 8; ++it) {
            float v[4]; int mid[4];
#pragma unroll
            for (int k = 0; k < 4; ++k) { mid[k] = (lo[k] + hi[k]) >> 1; v[k] = Cb[k][mid[k] * KVBLK + KVBLK - 1]; }
#pragma unroll
            for (int k = 0; k < 4; ++k) if (lo[k] < hi[k]) { if (v[k] < thr[k]) lo[k] = mid[k] + 1; else hi[k] = mid[k]; }
        }
#pragma unroll
        for (int k = 0; k < 4; ++k) ((unsigned char*)(lds + OFF_JLO))[tid + 512 * k] = (unsigned char)lo[k];
        unsigned key[4];
#pragma unroll
        for (int k = 0; k < 4; ++k) { const int e = tid + 512 * k, qb = e & 63; key[k] = (unsigned)(4 * qb + 4 - lo[k]) * 2048u + (unsigned)(2047 - e); ((unsigned*)(lds + OFF_KEY))[e] = key[k]; }
        __syncthreads();
        unsigned rank[4] = {0u, 0u, 0u, 0u};
#pragma unroll 4
        for (int j = 0; j < 512; ++j) { const u32x4 kv = ((const u32x4*)(lds + OFF_KEY))[j];
#pragma unroll
            for (int k = 0; k < 4; ++k) rank[k] += (kv.x > key[k] ? 1u : 0u) + (kv.y > key[k] ? 1u : 0u) + (kv.z > key[k] ? 1u : 0u) + (kv.w > key[k] ? 1u : 0u); }
#pragma unroll
        for (int k = 0; k < 4; ++k) ((unsigned short*)(lds + OFF_ORD))[rank[k]] = (unsigned short)(tid + 512 * k);
    }
    if (tid == 0) *(volatile LAS3 unsigned*)(lds + OFF_QW) = __hip_atomic_fetch_add(qctr, 1u, __ATOMIC_RELAXED, __HIP_MEMORY_SCOPE_AGENT);
    __syncthreads();
    const unsigned i0 = (unsigned)__builtin_amdgcn_readfirstlane((int)*(volatile LAS3 unsigned*)(lds + OFF_QW));
    if (i0 >= (unsigned)(NH * (SEQ / QB))) return;
    __syncthreads();
    auto mk = [=](int item) { return fox_ref(item, Q, K, V, Cn, O, lds); };
    BlockRef cur = mk((int)i0);
    Seam S;
    fox_prime(cur, lds, S);
    for (;;) { bool has_next; const BlockRef nxt = fox_block(cur, lds, S, qctr, mk, has_next); if (!has_next) break; cur = nxt; }
}
#undef LAS3
#undef KSWZ
#undef SBAR
}

namespace swa {
constexpr int SEQ = 16384, QKVP = 5120, OP = 4096;
constexpr int K_OFF = 0, VT_OFF = 32768, VT_PITCH = 528, LI_OFF = VT_OFF + 64 * VT_PITCH, LDS_BYTES = LI_OFF + 8 * 32 * 4;
typedef unsigned short bf16;
typedef short bf16x8 __attribute__((ext_vector_type(8)));
typedef float f32x16 __attribute__((ext_vector_type(16)));
typedef float f32x4 __attribute__((ext_vector_type(4)));
typedef unsigned u32x4 __attribute__((ext_vector_type(4)));
__device__ __forceinline__ int crow(int r, int hi) { return (r & 3) + 8 * (r >> 2) + 4 * hi; }
__device__ __forceinline__ unsigned cvtpk(float lo, float hi) { unsigned r; asm volatile("v_cvt_pk_bf16_f32 %0, %1, %2" : "=v"(r) : "v"(lo), "v"(hi)); return r; }
__device__ __forceinline__ float bf2f(short b) { return __uint_as_float(((unsigned)(unsigned short)b) << 16); }
__device__ __forceinline__ bf16x8 pack8(const float* v) { u32x4 w = {cvtpk(v[0], v[1]), cvtpk(v[2], v[3]), cvtpk(v[4], v[5]), cvtpk(v[6], v[7])}; return *reinterpret_cast<bf16x8*>(&w); }
#define SWA_PK4(P, B_, OUT) do { unsigned a0 = cvtpk(P[B_+0], P[B_+1]), a1 = cvtpk(P[B_+2], P[B_+3]);                          \
        unsigned b0 = cvtpk(P[B_+4], P[B_+5]), b1 = cvtpk(P[B_+6], P[B_+7]);                                             \
        auto r0 = __builtin_amdgcn_permlane32_swap(a0, b0, false, false); auto r1 = __builtin_amdgcn_permlane32_swap(a1, b1, false, false); \
        u32x4 w = {r0[0], r1[0], r0[1], r1[1]}; OUT = *reinterpret_cast<bf16x8*>(&w); } while (0)

__device__ __forceinline__ void swa_attn_phase(char* lds, const bf16* QKV, const float* sinks, const float* cosT, const float* sinT, bf16* O, int wg, int G) {
    const int tid = mk_tid(), wid = __builtin_amdgcn_readfirstlane(tid >> 6), lane = tid & 63, r32 = lane & 31, hi = lane >> 5;
    for (int L = wg; L < 1024; L += G) {
        const int g = L & 7, n = L >> 3;
        __syncthreads();
        {
            const int row = tid >> 1, half = tid & 1, kpos = 128 * (n - 1) + row;
            bf16x8 kc[4], vc[4];
            if (kpos >= 0) {
                const bf16* kp = QKV + (size_t)kpos * QKVP + 4096 + g * 64 + half * 32; const bf16* vp = kp + 512;
#pragma unroll
                for (int c = 0; c < 4; ++c) { kc[c] = *(const bf16x8*)(kp + 8 * c); vc[c] = *(const bf16x8*)(vp + 8 * c); }
                if (half == 0) {
                    const f32x4 c0 = *(const f32x4*)(cosT + (size_t)kpos * 8), c1 = *(const f32x4*)(cosT + (size_t)kpos * 8 + 4);
                    const f32x4 s0 = *(const f32x4*)(sinT + (size_t)kpos * 8), s1 = *(const f32x4*)(sinT + (size_t)kpos * 8 + 4);
                    float o1[8], o2[8];
#pragma unroll
                    for (int i = 0; i < 8; ++i) { const float cs = i < 4 ? c0[i & 3] : c1[i & 3], sn = i < 4 ? s0[i & 3] : s1[i & 3];
                        const float x1 = bf2f(kc[0][i]), x2 = bf2f(kc[1][i]); o1[i] = x1 * cs - x2 * sn; o2[i] = x2 * cs + x1 * sn; }
                    kc[0] = pack8(o1); kc[1] = pack8(o2);
                }
            } else {
#pragma unroll
                for (int c = 0; c < 4; ++c) { kc[c] = (bf16x8){0, 0, 0, 0, 0, 0, 0, 0}; vc[c] = (bf16x8){0, 0, 0, 0, 0, 0, 0, 0}; }
            }
#pragma unroll
            for (int c = 0; c < 4; ++c) { const int chunk = half * 4 + c;
                *(bf16x8*)(lds + K_OFF + row * 128 + ((chunk ^ ((row >> 1) & 7)) << 4)) = kc[c];
#pragma unroll
                for (int j = 0; j < 8; ++j) *(short*)(lds + VT_OFF + (half * 32 + c * 8 + j) * VT_PITCH + row * 2) = vc[c][j]; }
        }
        __syncthreads();
        const int hq = g * 8 + wid; const float sink = sinks[hq];
        for (int a = 0; a < 4; ++a) {
            const int t = 128 * n + 32 * a + r32;
            const bf16* qp = QKV + (size_t)t * QKVP + hq * 64;
            bf16x8 qr[4];
#pragma unroll
            for (int d0 = 0; d0 < 4; ++d0) qr[d0] = *(const bf16x8*)(qp + 16 * d0 + 8 * hi);
            {
                const bf16x8 pr = *(const bf16x8*)(qp + 8 * (1 - hi));
                const f32x4 c0 = *(const f32x4*)(cosT + (size_t)t * 8), c1 = *(const f32x4*)(cosT + (size_t)t * 8 + 4);
                const f32x4 s0 = *(const f32x4*)(sinT + (size_t)t * 8), s1 = *(const f32x4*)(sinT + (size_t)t * 8 + 4);
                float ov[8];
#pragma unroll
                for (int i = 0; i < 8; ++i) { const float cs = i < 4 ? c0[i & 3] : c1[i & 3], sn = i < 4 ? s0[i & 3] : s1[i & 3];
                    const float own = bf2f(qr[0][i]), par = bf2f(pr[i]); ov[i] = own * cs + (hi ? par : -par) * sn; }
                qr[0] = pack8(ov);
            }
            f32x16 p[5];
#pragma unroll
            for (int bi = 0; bi < 5; ++bi) { const int row = 32 * (a + bi) + r32; const char* kb = lds + K_OFF + row * 128; const int sw = (row >> 1) & 7;
                f32x16 acc = {};
#pragma unroll
                for (int d0 = 0; d0 < 4; ++d0) { const bf16x8 kf = *(const bf16x8*)(kb + (((2 * d0 + hi) ^ sw) << 4)); acc = __builtin_amdgcn_mfma_f32_32x32x16_bf16(kf, qr[d0], acc, 0, 0, 0); }
                p[bi] = acc; }
            const float NEG = -__builtin_inff();
#pragma unroll
            for (int r = 0; r < 16; ++r) { const int c = crow(r, hi); if (!(c > r32)) p[0][r] = NEG; if (!(c <= r32)) p[4][r] = NEG; }
            if (n == 0) {
#pragma unroll
                for (int bi = 0; bi < 4; ++bi) if (a + bi < 4) {
#pragma unroll
                    for (int r = 0; r < 16; ++r) p[bi][r] = NEG; }
            }
            float mx = NEG;
#pragma unroll
            for (int bi = 0; bi < 5; ++bi)
#pragma unroll
                for (int r = 0; r < 16; ++r) mx = fmaxf(mx, p[bi][r]);
            { auto rr = __builtin_amdgcn_permlane32_swap(__float_as_uint(mx), __float_as_uint(mx), false, false); mx = fmaxf(__uint_as_float(rr[0]), __uint_as_float(rr[1])); }
            const float m = fmaxf(mx * 0.125f, sink);
            constexpr float LOG2E = 1.4426950408889634f, C2 = 0.125f * LOG2E;
            const float mL = -m * LOG2E;
            float ps = 0.f;
#pragma unroll
            for (int bi = 0; bi < 5; ++bi)
#pragma unroll
                for (int r = 0; r < 16; ++r) { const float e = __builtin_amdgcn_exp2f(fmaf(p[bi][r], C2, mL)); p[bi][r] = e; ps += e; }
            { auto rr = __builtin_amdgcn_permlane32_swap(__float_as_uint(ps), __float_as_uint(ps), false, false); ps = __uint_as_float(rr[0]) + __uint_as_float(rr[1]); }
            const float l = ps + __builtin_amdgcn_exp2f(fmaf(sink, LOG2E, mL));
            f32x16 o[2] = {};
#pragma unroll
            for (int bi = 0; bi < 5; ++bi) { bf16x8 pa[2]; SWA_PK4(p[bi], 0, pa[0]); SWA_PK4(p[bi], 8, pa[1]);
#pragma unroll
                for (int ks = 0; ks < 2; ++ks)
#pragma unroll
                    for (int db = 0; db < 2; ++db) { const bf16x8 vf = *(const bf16x8*)(lds + VT_OFF + (32 * db + r32) * VT_PITCH + (32 * (a + bi) + 16 * ks + 8 * hi) * 2);
                        o[db] = __builtin_amdgcn_mfma_f32_32x32x16_bf16(vf, pa[ks], o[db], 0, 0, 0); } }
            const float rl = __builtin_amdgcn_rcpf(l);
            bf16* Ow = O + (size_t)(128 * n + 32 * a + r32) * OP + hq * 64 + 8 * hi;
#pragma unroll
            for (int db = 0; db < 2; ++db)
#pragma unroll
                for (int gp = 0; gp < 2; ++gp) { const int b_ = 8 * gp;
                    const unsigned a0 = cvtpk(o[db][b_ + 0] * rl, o[db][b_ + 1] * rl), a1 = cvtpk(o[db][b_ + 2] * rl, o[db][b_ + 3] * rl);
                    const unsigned b0 = cvtpk(o[db][b_ + 4] * rl, o[db][b_ + 5] * rl), b1 = cvtpk(o[db][b_ + 6] * rl, o[db][b_ + 7] * rl);
                    auto r0 = __builtin_amdgcn_permlane32_swap(a0, b0, false, false); auto r1 = __builtin_amdgcn_permlane32_swap(a1, b1, false, false);
                    u32x4 w = {r0[0], r1[0], r0[1], r1[1]}; *(u32x4*)(Ow + db * 32 + 16 * gp) = w; }
        }
    }
    __syncthreads();
}
#undef SWA_PK4
}

#define LAS __attribute__((address_space(3)))
#define GAS __attribute__((address_space(1)))
typedef unsigned short bf16;
typedef float f32x4 __attribute__((ext_vector_type(4)));
typedef unsigned u32x4 __attribute__((ext_vector_type(4)));
typedef unsigned u32x2 __attribute__((ext_vector_type(2)));
typedef short bf16x8 __attribute__((ext_vector_type(8)));
constexpr int SEQ = 16384, DM = 4096, DFF = 11008;
constexpr float NORM_EPS = 1e-6f;
__device__ __forceinline__ unsigned cvtpk(float lo, float hi) { unsigned r; asm volatile("v_cvt_pk_bf16_f32 %0, %1, %2" : "=v"(r) : "v"(lo), "v"(hi)); return r; }
__device__ __forceinline__ float bf_lo(unsigned w) { return __uint_as_float(w << 16); }
__device__ __forceinline__ float bf_hi(unsigned w) { return __uint_as_float(w & 0xffff0000u); }
__device__ __forceinline__ float wave_sum(float v) {
#pragma unroll
    for (int o = 1; o < 64; o <<= 1) v += __shfl_xor(v, o);
    return v;
}
__device__ __forceinline__ float gelu_tanh(float x) {
    const float u = 0.7978845608028654f * (x + 0.044715f * x * x * x);
    return x * __builtin_amdgcn_rcpf(1.0f + __builtin_amdgcn_exp2f(-2.8853900817779268f * u));
}
__device__ __forceinline__ void sincos_d(double a, double& s, double& c) {
    const double k = rint(a * 0.15915494309189535);
    double r = fma(-k, 6.283185307179586, a); r = fma(-k, 2.4492935982947064e-16, r);
    const double r2 = r * r; double ss = 1.0, cc = 1.0;
#pragma unroll
    for (int n = 29; n >= 3; n -= 2) ss = fma(-ss * r2, 1.0 / (double)(n * (n - 1)), 1.0);
#pragma unroll
    for (int n = 28; n >= 2; n -= 2) cc = fma(-cc * r2, 1.0 / (double)(n * (n - 1)), 1.0);
    s = r * ss; c = cc;
}
__device__ __forceinline__ double exp_d(double x) {
    const double k = rint(x * 1.4426950408889634);
    double r = fma(-k, 0.6931471803691238, x); r = fma(-k, 1.9082149292705877e-10, r);
    double p = 1.0;
#pragma unroll
    for (int n = 16; n >= 1; --n) p = fma(p * r, 1.0 / (double)n, 1.0);
    return ldexp(p, (int)k);
}

__device__ __forceinline__ void transpose_item(const float* __restrict__ W, int K, int N, bf16* __restrict__ WT, int mode, LAS unsigned* scr, int item, int lane) {
    const int nblk = (N + 63) / 64, kb = item / nblk, nb = item - kb * nblk, k0 = 128 * kb, n0 = 64 * nb;
    int r0 = n0; if (mode == 1) { const int bj = n0 >> 12, rem = n0 & 4095; r0 = ((rem >> 7) << 8) + (bj << 7) + (rem & 127); }
    if (mode == 2) { const int bj = n0 >= DFF ? 1 : 0, rem = n0 - bj * DFF; r0 = ((rem >> 7) << 8) + (bj << 7) + (rem & 127); }
    const int c = lane & 15, kq = lane >> 4;
    const bool ok = n0 + 4 * c < N;
    const float* src = W + (size_t)(k0 + 2 * kq) * N + n0 + 4 * c;
    LAS unsigned* sw = scr + (4 * c) * 65 + kq;
#pragma unroll
    for (int half = 0; half < 2; ++half) {
        f32x4 a[8], b[8]; const f32x4 z = {0.f, 0.f, 0.f, 0.f};
#pragma unroll
        for (int p = 0; p < 8; ++p) { const float* s = src + (size_t)(8 * (8 * half + p)) * N;
            a[p] = ok ? __builtin_nontemporal_load((const f32x4*)s) : z; b[p] = ok ? __builtin_nontemporal_load((const f32x4*)(s + N)) : z; }
#pragma unroll
        for (int p = 0; p < 8; ++p)
#pragma unroll
            for (int q = 0; q < 4; ++q) sw[q * 65 + 4 * (8 * half + p)] = cvtpk(a[p][q], b[p][q]);
    }
    asm volatile("s_waitcnt lgkmcnt(0)" ::: "memory");
#pragma unroll
    for (int j = 0; j < 16; ++j) { const int n = 4 * j + kq; const LAS unsigned* s = scr + n * 65 + 4 * c;
        u32x4 o; o.x = s[0]; o.y = s[1]; o.z = s[2]; o.w = s[3];
        if (n0 + n < N) *(u32x4*)(WT + (size_t)(r0 + n) * K + k0 + 8 * c) = o; }
    asm volatile("s_waitcnt lgkmcnt(0)" ::: "memory");
}

__device__ __forceinline__ float f8_clamp(float v) { return __builtin_fminf(__builtin_fmaxf(v, -448.f), 448.f); }
__device__ __forceinline__ unsigned f8_pack4(float a, float b, float c, float d) {
    int w = 0; w = __builtin_amdgcn_cvt_pk_fp8_f32(f8_clamp(a), f8_clamp(b), w, false); w = __builtin_amdgcn_cvt_pk_fp8_f32(f8_clamp(c), f8_clamp(d), w, true); return (unsigned)w; }
__device__ __forceinline__ void transpose_item_f8(const float* __restrict__ W, int K, int N, unsigned char* __restrict__ WT, int mode, LAS unsigned* scr, int item, int lane, float scale) {
    const int nblk = (N + 63) / 64, kb = item / nblk, nb = item - kb * nblk, k0 = 128 * kb, n0 = 64 * nb;
    int r0 = n0; if (mode == 1) { const int bj = n0 >> 12, rem = n0 & 4095; r0 = ((rem >> 7) << 8) + (bj << 7) + (rem & 127); }
    if (mode == 2) { const int bj = n0 >= DFF ? 1 : 0, rem = n0 - bj * DFF; r0 = ((rem >> 7) << 8) + (bj << 7) + (rem & 127); }
    const int c = lane & 15, kq = lane >> 4;
    const bool ok = n0 + 4 * c < N;
    const float* src = W + (size_t)(k0 + 4 * kq) * N + n0 + 4 * c;
    LAS unsigned* sw = scr + (4 * c) * 33 + kq;
#pragma unroll
    for (int half = 0; half < 2; ++half) {
        f32x4 a[4][4]; const f32x4 z = {0.f, 0.f, 0.f, 0.f};
#pragma unroll
        for (int p = 0; p < 4; ++p)
#pragma unroll
            for (int r = 0; r < 4; ++r) { const float* s = src + (size_t)(16 * (4 * half + p) + r) * N; a[p][r] = ok ? __builtin_nontemporal_load((const f32x4*)s) : z; }
#pragma unroll
        for (int p = 0; p < 4; ++p)
#pragma unroll
            for (int q = 0; q < 4; ++q) sw[q * 33 + 4 * (4 * half + p)] = f8_pack4(a[p][0][q] * scale, a[p][1][q] * scale, a[p][2][q] * scale, a[p][3][q] * scale);
    }
    asm volatile("s_waitcnt lgkmcnt(0)" ::: "memory");
#pragma unroll
    for (int j = 0; j < 8; ++j) { const int n = 8 * j + (lane >> 3), c8 = lane & 7; const LAS unsigned* s = scr + n * 33 + 4 * c8;
        u32x4 o; o.x = s[0]; o.y = s[1]; o.z = s[2]; o.w = s[3];
        if (n0 + n < N) *(u32x4*)(WT + (size_t)(r0 + n) * K + k0 + 16 * c8) = o; }
    asm volatile("s_waitcnt lgkmcnt(0)" ::: "memory");
}

struct HPlanes { unsigned char* hi; unsigned char* lo; };
template <int HIN, int HOUT>
__device__ __forceinline__ void norm_phase(int gw, int ngw, int lane, LAS unsigned char* stg, const bf16* tmp, const float* gpost, const float* hin, float* hout, HPlanes hp, const float* gpre, bf16* xn, bf16* U, float tscale = 1.0f, unsigned char* xn8 = nullptr, float x8scale = 1.0f) {
    LAS unsigned char* sA = stg;
    for (int m = gw; m < SEQ; m += ngw) {
        f32x4 h[16];
        u32x4 tq[8]; float ss = 0.f;
        if (tmp) { const u32x4* tr = (const u32x4*)(tmp + (size_t)m * DM) + lane;
#pragma unroll
            for (int j = 0; j < 8; ++j) tq[j] = __builtin_nontemporal_load(tr + 64 * j); }
        if constexpr (HIN == 0) {
            const f32x4* hr = (const f32x4*)(hin + (size_t)m * DM) + lane;
#pragma unroll
            for (int j = 0; j < 16; ++j) h[j] = __builtin_nontemporal_load(hr + 64 * j);
        } else {
            const u32x4* hr = (const u32x4*)(hp.hi + (size_t)m * 8192) + lane; const u32x4* lr = (const u32x4*)(hp.lo + (size_t)m * 2048) + lane; u32x4 hq[8], lq[2];
#pragma unroll
            for (int i = 0; i < 8; ++i) hq[i] = __builtin_nontemporal_load(hr + 64 * i);
#pragma unroll
            for (int c = 0; c < 2; ++c) lq[c] = __builtin_nontemporal_load(lr + 64 * c);
#pragma unroll
            for (int j = 0; j < 16; ++j) { const unsigned w0 = hq[j >> 1][2 * (j & 1)], w1 = hq[j >> 1][2 * (j & 1) + 1], lw = lq[j >> 3][(j >> 1) & 3]; const int sh = 16 * (j & 1);
                h[j] = (f32x4){__uint_as_float((w0 << 16) | (((lw >> sh) & 15u) << 12)), __uint_as_float((w0 & 0xffff0000u) | (((lw >> (sh + 4)) & 15u) << 12)),
                               __uint_as_float((w1 << 16) | (((lw >> (sh + 8)) & 15u) << 12)), __uint_as_float((w1 & 0xffff0000u) | (((lw >> (sh + 12)) & 15u) << 12))}; }
        }
        if (tmp) {
#pragma unroll
            for (int j = 0; j < 8; ++j) {
#pragma unroll
                for (int q = 0; q < 4; ++q) { const float a = bf_lo(tq[j][q]), b = bf_hi(tq[j][q]); ss += a * a + b * b; }
                *(LAS u32x4*)(sA + 1024 * j + 16 * lane) = tq[j]; }
            asm volatile("" ::: "memory");
            const float r = tscale / sqrtf(wave_sum(ss) * (1.0f / DM) + NORM_EPS);
            const f32x4* gp = (const f32x4*)gpost + lane; asm volatile("" : "+v"(gp));
#pragma unroll
            for (int j = 0; j < 16; ++j) { const u32x2 w = *(const LAS u32x2*)(sA + 512 * j + 8 * lane); const f32x4 t = {bf_lo(w.x), bf_hi(w.x), bf_lo(w.y), bf_hi(w.y)};
                h[j] = h[j] + (t * r) * gp[64 * j]; }
            asm volatile("" ::: "memory");
            if constexpr (HOUT == 0) { f32x4* ho = (f32x4*)(hout + (size_t)m * DM) + lane;
#pragma unroll
                for (int j = 0; j < 16; ++j) __builtin_nontemporal_store(h[j], ho + 64 * j); }
            if constexpr (HOUT == 1) {
                u32x4* ho = (u32x4*)(hp.hi + (size_t)m * 8192) + lane; u32x4* lo = (u32x4*)(hp.lo + (size_t)m * 2048) + lane; u32x4 lq[2];
#pragma unroll
                for (int i = 0; i < 8; ++i) { u32x4 o; unsigned lw = 0u;
#pragma unroll
                    for (int jj = 0; jj < 2; ++jj) { const int j = 2 * i + jj;
                        const unsigned b0 = __float_as_uint(h[j].x) + 0x800u, b1 = __float_as_uint(h[j].y) + 0x800u, b2 = __float_as_uint(h[j].z) + 0x800u, b3 = __float_as_uint(h[j].w) + 0x800u;
                        o[2 * jj] = __builtin_amdgcn_perm(b1, b0, 0x07060302u); o[2 * jj + 1] = __builtin_amdgcn_perm(b3, b2, 0x07060302u);
                        lw |= (((b0 >> 12) & 15u) | (((b1 >> 12) & 15u) << 4) | (((b2 >> 12) & 15u) << 8) | (((b3 >> 12) & 15u) << 12)) << (16 * jj); }
                    __builtin_nontemporal_store(o, ho + 64 * i); lq[i >> 2][i & 3] = lw; }
#pragma unroll
                for (int c = 0; c < 2; ++c) __builtin_nontemporal_store(lq[c], lo + 64 * c); }
        }
        if (gpre) {
            float s2 = 0.f;
#pragma unroll
            for (int j = 0; j < 16; ++j) s2 += (h[j].x * h[j].x + h[j].y * h[j].y) + (h[j].z * h[j].z + h[j].w * h[j].w);
            const float r = 1.0f / sqrtf(wave_sum(s2) * (1.0f / DM) + NORM_EPS);
            const f32x4* gp = (const f32x4*)gpre + lane; asm volatile("" : "+v"(gp));
            if (xn) { u32x4* o16 = (u32x4*)(xn + (size_t)m * DM) + lane;
                asm volatile("" ::: "memory");
#pragma unroll
                for (int j = 0; j < 16; ++j) { const f32x4 v = (h[j] * r) * gp[64 * j]; u32x2 w; w.x = cvtpk(v.x, v.y); w.y = cvtpk(v.z, v.w); *(LAS u32x2*)(sA + 512 * j + 8 * lane) = w; }
                asm volatile("" ::: "memory");
#pragma unroll
                for (int j = 0; j < 8; ++j) o16[64 * j] = *(const LAS u32x4*)(sA + 1024 * j + 16 * lane);
                asm volatile("" ::: "memory"); }
            if (xn8) { u32x4* o16 = (u32x4*)(xn8 + (size_t)m * DM) + lane; const float r8 = r * x8scale;
                asm volatile("" ::: "memory");
#pragma unroll
                for (int j = 0; j < 16; ++j) { const f32x4 v = (h[j] * r8) * gp[64 * j]; *(LAS unsigned*)(sA + 256 * j + 4 * lane) = f8_pack4(v.x, v.y, v.z, v.w); }
                asm volatile("" ::: "memory");
#pragma unroll
                for (int i = 0; i < 4; ++i) o16[64 * i] = *(const LAS u32x4*)(sA + 1024 * i + 16 * lane);
                asm volatile("" ::: "memory"); }
            if (U) {
#pragma unroll
                for (int j = 0; j < 16; ++j) { const f32x4 v = (h[j] * r) * gp[64 * j]; u32x2 w; w.x = cvtpk(v.x, v.y); w.y = cvtpk(v.z, v.w);
                    *(u32x2*)(U + ((size_t)((lane >> 2) + 16 * j) * SEQ + m) * 16 + 4 * (lane & 3)) = w; } }
        }
    }
}

__device__ __forceinline__ void fox_cumsum_phase(char* lds, const float* __restrict__ logf, float* __restrict__ cneg, int wg, int G, int tid) {
    double* wtot = (double*)lds; const int lane = tid & 63, wid = tid >> 6;
    for (int h = wg; h < 32; h += G) {
        float v[32]; double s = 0.0;
#pragma unroll
        for (int j = 0; j < 32; ++j) { v[j] = logf[(size_t)(32 * tid + j) * 32 + h]; s += (double)v[j]; }
        double inc = s;
#pragma unroll
        for (int o = 1; o < 64; o <<= 1) { const double t = __shfl_up(inc, o); if (lane >= o) inc += t; }
        __syncthreads();
        if (lane == 63) wtot[wid] = inc;
        __syncthreads();
        double run = inc - s;
#pragma unroll
        for (int w = 0; w < 8; ++w) if (w < wid) run += wtot[w];
#pragma unroll
        for (int j = 0; j < 32; ++j) { run += (double)v[j]; cneg[(size_t)h * SEQ + 32 * tid + j] = (float)(-run * 11.313708498984761); }
    }
}

__device__ __forceinline__ void fox_norms_phase(const bf16* __restrict__ QK, unsigned* nrm2, int gw, int ngw, int lane) {
    for (int base = gw * 128; base < 64 * SEQ; base += ngw * 128) {
        const u32x4* p = (const u32x4*)(QK + (size_t)base * 128) + lane; float mx = 0.f;
#pragma unroll 8
        for (int i = 0; i < 32; ++i) { const u32x4 w = p[(size_t)i * 64]; float s = 0.f;
#pragma unroll
            for (int q = 0; q < 4; ++q) { const float a = bf_lo(w[q]), b = bf_hi(w[q]); s = fmaf(a, a, s); s = fmaf(b, b, s); }
            s += __shfl_xor(s, 1); s += __shfl_xor(s, 2); s += __shfl_xor(s, 4); s += __shfl_xor(s, 8); mx = fmaxf(mx, s); }
        mx = fmaxf(mx, __shfl_xor(mx, 16)); mx = fmaxf(mx, __shfl_xor(mx, 32));
        if (lane == 0) __hip_atomic_fetch_max(nrm2 + base / SEQ, __float_as_uint(mx), __ATOMIC_RELAXED, __HIP_MEMORY_SCOPE_AGENT);
    }
}

namespace s5 {
typedef float f32x16 __attribute__((ext_vector_type(16)));
constexpr int NG = 256, SEGL = 2048, XP = 272, WAVE_BYTES = 2048 + 32 * XP, E_OFF = 8 * WAVE_BYTES, LDS_BYTES = E_OFF + 8 * 128 * 4;
__device__ __forceinline__ bf16x8 pack8(f32x4 a, f32x4 b) { u32x4 w = {cvtpk(a[0], a[1]), cvtpk(a[2], a[3]), cvtpk(b[0], b[1]), cvtpk(b[2], b[3])}; return *reinterpret_cast<bf16x8*>(&w); }
__device__ __forceinline__ void state_consts(float lam_re_raw, float lam_im_raw, double dt, double& lbr, double& lbi, double& cfr, double& cfi, double& lre_o, double& lim_o) {
    const double lre = (double)fminf(lam_re_raw, -1e-4f), lim = (double)lam_im_raw; double sn, cs; sincos_d(lim * dt, sn, cs); const double er = exp_d(lre * dt);
    lbr = er * cs; lbi = er * sn; const double a = lbr - 1.0, b = lbi, den = 1.0 / (lre * lre + lim * lim); cfr = (a * lre + b * lim) * den; cfi = (b * lre - a * lim) * den; lre_o = lre; lim_o = lim;
}
__device__ __forceinline__ void s5_phase(char* lds, const bf16* __restrict__ U, const float* __restrict__ lam_re, const float* __restrict__ lam_im, const float* __restrict__ log_dt,
                                         const float* __restrict__ b_re, const float* __restrict__ b_im, const float* __restrict__ c_re, const float* __restrict__ c_im,
                                         const float* __restrict__ dskip, bf16* __restrict__ Gout, int wg, int G) {
    const int tid = mk_tid(), wid = __builtin_amdgcn_readfirstlane(tid >> 6), lane = tid & 63, r32 = lane & 31, hi = lane >> 5, l15 = lane & 15, q4 = lane >> 4;
    float* ublk = (float*)(lds + wid * WAVE_BYTES); char* xblk = lds + wid * WAVE_BYTES + 2048; float* Ebuf = (float*)(lds + E_OFF);
    for (int g = wg; g < NG; g += G) {
        float lr, li, l2r, l2i; bf16x8 Bf[4], Cf[4]; const float dsk = dskip[16 * g + l15];
        {
            const double dt = exp_d((double)log_dt[g]);
            { double lbr, lbi, cfr, cfi, lre, lim; state_consts(lam_re[g * 64 + lane], lam_im[g * 64 + lane], dt, lbr, lbi, cfr, cfi, lre, lim); lr = (float)lbr; li = (float)lbi;
              double sn2, cs2; sincos_d(lim * dt * (double)SEGL, sn2, cs2); const double e2 = exp_d(lre * dt * (double)SEGL); l2r = (float)(e2 * cs2); l2i = (float)(e2 * sn2); }
#pragma unroll
            for (int sb = 0; sb < 2; ++sb) { const int st = 32 * sb + r32; double lbr, lbi, cfr, cfi, lre, lim; state_consts(lam_re[g * 64 + st], lam_im[g * 64 + st], dt, lbr, lbi, cfr, cfi, lre, lim);
                const f32x4* br = (const f32x4*)(b_re + ((size_t)g * 64 + st) * 16 + 8 * hi); const f32x4* bi = (const f32x4*)(b_im + ((size_t)g * 64 + st) * 16 + 8 * hi);
                const f32x4 vr0 = br[0], vr1 = br[1], vi0 = bi[0], vi1 = bi[1]; f32x4 or0, or1, oi0, oi1;
#pragma unroll
                for (int i = 0; i < 4; ++i) { or0[i] = (float)(cfr * (double)vr0[i] - cfi * (double)vi0[i]); or1[i] = (float)(cfr * (double)vr1[i] - cfi * (double)vi1[i]);
                                              oi0[i] = (float)(cfr * (double)vi0[i] + cfi * (double)vr0[i]); oi1[i] = (float)(cfr * (double)vi1[i] + cfi * (double)vr1[i]); }
                Bf[sb] = pack8(or0, or1); Bf[2 + sb] = pack8(oi0, oi1); }
#pragma unroll
            for (int kk = 0; kk < 4; ++kk) { const float* cp = (kk < 2 ? c_re : c_im) + ((size_t)g * 16 + l15) * 64 + 32 * (kk & 1) + 8 * q4; const float sg = kk < 2 ? 1.f : -1.f;
                const f32x4 v0 = *(const f32x4*)cp, v1 = *(const f32x4*)(cp + 4); Cf[kk] = pack8(v0 * sg, v1 * sg); }
        }
        const bf16* Ug = U + ((size_t)g * SEQ + (size_t)wid * SEGL) * 16;
        float xr = 0.f, xi = 0.f;
#pragma unroll 1
        for (int pass = 0; pass < 2; ++pass) {
#define S5_ULOAD(d0, d1, blk_) do { const u32x4 ub_ = *(const u32x4*)(Ug + ((size_t)(blk_) * 32 + r32) * 16 + 8 * hi);                                                     \
                d0 = (f32x4){bf_lo(ub_.x), bf_hi(ub_.x), bf_lo(ub_.y), bf_hi(ub_.y)}; d1 = (f32x4){bf_lo(ub_.z), bf_hi(ub_.z), bf_lo(ub_.w), bf_hi(ub_.w)}; } while (0)
            f32x4 ua0, ua1; S5_ULOAD(ua0, ua1, 0);
#pragma unroll 1
            for (int blk = 0; blk < SEGL / 32; ++blk) {
                f32x4 un0 = ua0, un1 = ua1;
                if (blk + 1 < SEGL / 32) S5_ULOAD(un0, un1, blk + 1);
                const bf16x8 af = pack8(ua0, ua1);
                if (pass) { *(f32x4*)(ublk + r32 * 16 + 8 * hi) = ua0; *(f32x4*)(ublk + r32 * 16 + 8 * hi + 4) = ua1; }
                f32x16 a0 = {}, a1 = {}, a2 = {}, a3 = {};
                a0 = __builtin_amdgcn_mfma_f32_32x32x16_bf16(af, Bf[0], a0, 0, 0, 0); a1 = __builtin_amdgcn_mfma_f32_32x32x16_bf16(af, Bf[1], a1, 0, 0, 0);
                a2 = __builtin_amdgcn_mfma_f32_32x32x16_bf16(af, Bf[2], a2, 0, 0, 0); a3 = __builtin_amdgcn_mfma_f32_32x32x16_bf16(af, Bf[3], a3, 0, 0, 0);
#pragma unroll
                for (int r = 0; r < 16; ++r) { auto t0 = __builtin_amdgcn_permlane32_swap(__float_as_uint(a0[r]), __float_as_uint(a1[r]), false, false); a0[r] = __uint_as_float(t0[0]); a1[r] = __uint_as_float(t0[1]);
                                               auto t1 = __builtin_amdgcn_permlane32_swap(__float_as_uint(a2[r]), __float_as_uint(a3[r]), false, false); a2[r] = __uint_as_float(t1[0]); a3[r] = __uint_as_float(t1[1]); }
#pragma unroll
                for (int s = 0; s < 32; ++s) { const int h = (s >> 2) & 1, r = (s & 3) + 4 * (s >> 3); const float bre = h ? a1[r] : a0[r], bim = h ? a3[r] : a2[r];
                    const float nr = fmaf(lr, xr, fmaf(-li, xi, bre)), ni = fmaf(lr, xi, fmaf(li, xr, bim)); xr = nr; xi = ni;
                    if (pass) { const unsigned pk = cvtpk(xr, xi); *(unsigned short*)(xblk + s * XP + lane * 2) = (unsigned short)pk; *(unsigned short*)(xblk + s * XP + 128 + lane * 2) = (unsigned short)(pk >> 16); } }
                if (pass) {
#pragma unroll
                    for (int rb = 0; rb < 2; ++rb) { f32x4 acc = {0.f, 0.f, 0.f, 0.f};
#pragma unroll
                        for (int kk = 0; kk < 4; ++kk) { const bf16x8 xa = *(const bf16x8*)(xblk + (16 * rb + l15) * XP + (32 * kk + 8 * q4) * 2); acc = __builtin_amdgcn_mfma_f32_16x16x32_bf16(xa, Cf[kk], acc, 0, 0, 0); }
#pragma unroll
                        for (int i = 0; i < 4; ++i) { const int sl = 16 * rb + 4 * q4 + i; const float uv = ublk[sl * 16 + l15];
                            const float v = gelu_tanh(acc[i] + dsk * uv); const float vn = __shfl_xor(v, 1);
                            if ((l15 & 1) == 0) *(unsigned*)(Gout + ((size_t)wid * SEGL + blk * 32 + sl) * DM + 16 * g + l15) = cvtpk(v, vn); } }
                }
                ua0 = un0; ua1 = un1;
            }
            if (pass == 0) {
                Ebuf[wid * 128 + lane] = xr; Ebuf[wid * 128 + 64 + lane] = xi;
                __syncthreads();
                float sr = 0.f, si = 0.f;
                for (int v = 0; v < wid; ++v) { const float er = Ebuf[v * 128 + lane], ei = Ebuf[v * 128 + 64 + lane];
                    const float nr = fmaf(l2r, sr, fmaf(-l2i, si, er)), ni = fmaf(l2r, si, fmaf(l2i, sr, ei)); sr = nr; si = ni; }
                xr = sr; xi = si;
            }
        }
        __syncthreads();
    }
}
#undef S5_ULOAD
}
#define XB_TMO      128
#define XB_XCNT(j)  (256  + 64 * (j))
#define XB_XSUB(j)  (1280 + 64 * (j))
#define XB_XGEN(j)  (2304 + 64 * (j))
#define XB_TOP      3328
#define XB_TOPGEN   3392
#define XCD_BAR_WORDS 3456
#define XB_SPIN_CAP (1u << 18)

__device__ __forceinline__ unsigned xb_ld(unsigned* p)              { return __hip_atomic_load(p, __ATOMIC_RELAXED, __HIP_MEMORY_SCOPE_AGENT); }
__device__ __forceinline__ unsigned xb_add(unsigned* p, unsigned v) { return __hip_atomic_fetch_add(p, v, __ATOMIC_RELAXED, __HIP_MEMORY_SCOPE_AGENT); }
__device__ __forceinline__ unsigned xb_xcc_id() { return (unsigned)__builtin_amdgcn_s_getreg((3 << 11) | 20) & 0xFu; }
#define XB_SPIN(cond, bar) do { unsigned _sp = 0; while (cond) { __builtin_amdgcn_s_sleep(1); \
    if ((++_sp & 255u) == 0u) { if (xb_ld(&(bar)[XB_TMO])) break; if (_sp > XB_SPIN_CAP) { atomicAdd(&(bar)[XB_TMO], 1u); break; } } } } while (0)

struct XcdBarrier {
    unsigned* bar; unsigned x;
    volatile LAS unsigned* st;
};

__device__ __forceinline__ XcdBarrier xcd_barrier_post(unsigned* bar, volatile LAS unsigned* st) {
    XcdBarrier b; b.bar = bar; b.x = xb_xcc_id(); b.st = st;
    if (threadIdx.x == 0) (void)xb_add(&bar[XB_XCNT(b.x)], 1u);
    return b;
}
__device__ __forceinline__ void xcd_barrier_complete(unsigned* bar, unsigned x, unsigned& nloc, unsigned& nx) {
    const unsigned G = gridDim.x * gridDim.y * gridDim.z;
    unsigned sum, cnt, mine, sp = 0u;
    for (;;) {
        sum = 0u; cnt = 0u; mine = 0u;
#pragma unroll
        for (unsigned j = 0; j < 16; ++j) { const unsigned c = xb_ld(&bar[XB_XCNT(j)]); sum += c; cnt += (c > 0u) ? 1u : 0u; mine = (j == x) ? c : mine; }
        if (sum == G) break;
        __builtin_amdgcn_s_sleep(1);
        if ((++sp & 255u) == 0u) { if (xb_ld(&bar[XB_TMO])) break; if (sp > XB_SPIN_CAP) { atomicAdd(&bar[XB_TMO], 1u); break; } }
    }
    nloc = mine > 0u ? mine : 1u; nx = cnt > 0u ? cnt : 1u;
}

__device__ __forceinline__ void xcd_barrier(const XcdBarrier& b) {
    asm volatile("s_waitcnt vmcnt(0)" ::: "memory");
    __syncthreads();
    if (threadIdx.x == 0) {
        unsigned* bar = b.bar;
        __builtin_amdgcn_s_waitcnt(0);
        unsigned nloc = b.st[0], nx = b.st[1];
        if (nloc == 0u) { xcd_barrier_complete(bar, b.x, nloc, nx); b.st[0] = nloc; b.st[1] = nx; }
        const unsigned old = xb_add(&bar[XB_XSUB(b.x)], 1u);
        const unsigned gen = old / nloc;
        if (old + 1u == (gen + 1u) * nloc) {
            __builtin_amdgcn_fence(__ATOMIC_RELEASE, "agent");
            asm volatile("s_waitcnt vmcnt(0)" ::: "memory");
            const unsigned og = xb_add(&bar[XB_TOP], 1u);
            const unsigned tg = og / nx;
            if (og + 1u == (tg + 1u) * nx) xb_add(&bar[XB_TOPGEN], 1u);
            else XB_SPIN(xb_ld(&bar[XB_TOPGEN]) == tg, bar);
            __builtin_amdgcn_fence(__ATOMIC_ACQUIRE, "agent");
            xb_add(&bar[XB_XGEN(b.x)], 1u);
            asm volatile("s_waitcnt vmcnt(0)" ::: "memory");
        } else {
            XB_SPIN(xb_ld(&bar[XB_XGEN(b.x)]) == gen, bar);
            __builtin_amdgcn_fence(__ATOMIC_ACQUIRE, "agent");
            asm volatile("s_waitcnt vmcnt(0)" ::: "memory");
        }
    }
    __syncthreads();
}

constexpr size_t MiB = (size_t)1 << 20;
constexpr int NTHR = 512, NWAVES = 8;
constexpr int LDS_BYTES = 147456;
constexpr int LDS_MISC = LDS_BYTES - 1024;
__device__ __forceinline__ const float* uptr(const LAS unsigned long long* tab, int i) {
    const unsigned long long v = tab[i]; const unsigned lo = __builtin_amdgcn_readfirstlane((unsigned)v), hi = __builtin_amdgcn_readfirstlane((unsigned)(v >> 32));
    return (const float*)(const GAS float*)(((unsigned long long)hi << 32) | lo);
}
template <class T> __device__ __forceinline__ LAS T* launder_l(LAS T* p) { asm volatile("" : "+s"(p)); return p; }
template <class T> __device__ __forceinline__ T* launder(T* p) { GAS T* q = (GAS T*)p; asm volatile("" : "+s"(q)); return (T*)q; }
static_assert(pg8::STAGE_BYTES <= LDS_MISC && fox::LDS_BYTES <= LDS_MISC && swa::LDS_BYTES <= LDS_MISC && s5::LDS_BYTES <= LDS_MISC, "LDS map");
constexpr size_t WS_CTL = 0, CTL_ZERO_BYTES = 64 * 1024;
constexpr size_t CTL_QCTR = 16384, CTL_NRM2 = 20480;
constexpr size_t WS_ROPE = 1 * MiB;
constexpr size_t WS_W = 2 * MiB;
constexpr size_t W_L0_QKV = WS_W, W_L0_O = W_L0_QKV + 40 * MiB, W_L1_QKVF = W_L0_O + 32 * MiB, W_L1_O = W_L1_QKVF + 98 * MiB, W_L2_GLU = W_L1_O + 32 * MiB,
                 W_L3_QKV = W_L2_GLU + 64 * MiB, W_L3_O = W_L3_QKV + 40 * MiB, W_FFN = W_L3_O + 32 * MiB, W_FFN_STRIDE = 258 * MiB, W_FFN_OUT = 172 * MiB;
constexpr size_t WS_XN = W_FFN + 4 * W_FFN_STRIDE;
constexpr size_t WS_BIG = WS_XN + 129 * MiB;
constexpr size_t WS_Z = WS_BIG, WS_ACT = WS_BIG + 688 * MiB, WS_TMPF = WS_BIG, WS_TMPM = WS_BIG + 688 * MiB;
constexpr size_t WS_SWA_QKV = WS_BIG, WS_SWA_O = WS_BIG + 160 * MiB;
constexpr size_t WS_FOX_QKV = WS_BIG, WS_FOX_O = WS_BIG + 384 * MiB, WS_FOX_LOGF = WS_BIG + 512 * MiB, WS_FOX_CNEG = WS_BIG + 514 * MiB;
constexpr size_t WS_S5_U = WS_BIG + 256 * MiB, WS_S5_G = WS_BIG + 512 * MiB;
constexpr size_t WS_HHI = WS_BIG + 1032 * MiB, WS_HLO = WS_HHI + 128 * MiB;
constexpr size_t WS_END = WS_HLO + 32 * MiB;
static_assert((size_t)SEQ * 2 * DFF * 2 == 688 * MiB && (size_t)SEQ * DFF * 2 == 344 * MiB && (size_t)12544 * 4096 * 2 == 98 * MiB && (size_t)22016 * 4096 * 2 == 172 * MiB, "sizes");

struct Args { const float* in[56]; float* out; unsigned char* ws; float inv_freq[8]; int ph_lo, ph_hi; };

__global__ void __launch_bounds__(NTHR, 2) mk_fwd(Args args) {
    extern __shared__ __attribute__((aligned(16))) unsigned char lds[];
    if (threadIdx.x < 16) ((LAS unsigned*)((LAS unsigned char*)lds + LDS_MISC))[threadIdx.x] = 0u;
    if (threadIdx.x == 64) { LAS unsigned long long* ptab0 = (LAS unsigned long long*)((LAS unsigned char*)lds + LDS_MISC + 64);
#pragma unroll
        for (int i = 0; i < 56; ++i) ptab0[i] = (unsigned long long)args.in[i]; }
#define IN(i) uptr(ptab, (i))
    __syncthreads();
    XcdBarrier bar = xcd_barrier_post((unsigned*)(args.ws + WS_CTL), (volatile LAS unsigned*)((LAS unsigned char*)lds + LDS_MISC));
    int need_bar = 0;
#if PROBE_WAIT > 0
    unsigned long long probe_acc = 0, probe_t0 = 0;
#define PROBE_SEL(id) (PROBE_ID >= 0 ? (id) == PROBE_ID : ((PROBE_MASK >> ((id) == 1 ? 9 : ((id) - 1) % 9)) & 1))
#define PROBE_T0(id) do { if (PROBE_SEL(id)) probe_t0 = __builtin_amdgcn_s_memrealtime(); } while (0)
#define PROBE_T1(id) do { if (PROBE_SEL(id)) probe_acc += __builtin_amdgcn_s_memrealtime() - probe_t0; } while (0)
#else
#define PROBE_T0(id) do { } while (0)
#define PROBE_T1(id) do { } while (0)
#endif
#define PH_BEGIN(id) if (args.ph_lo <= (id) && (id) < args.ph_hi) { \
        if (need_bar) { PROBE_T0(id); XcdBarrier b2; b2.bar = launder(bar.bar); b2.x = (unsigned)launder_s((int)bar.x); b2.st = bar.st; for (int rb_ = 0; rb_ < REP_BAR; ++rb_) xcd_barrier(b2); PROBE_T1(id); } need_bar = 1; \
        unsigned char* const ws = launder(args.ws); float* const out = launder(args.out); (void)out; \
        LAS unsigned char* const ldsl = launder_l((LAS unsigned char*)lds); char* const ldsg = (char*)ldsl; (void)ldsg; const LAS unsigned long long* const ptab = (const LAS unsigned long long*)(ldsl + LDS_MISC + 64); \
        const int tid = mk_tid(), lane = tid & 63, wave = __builtin_amdgcn_readfirstlane(tid >> 6); (void)lane; (void)wave; \
        const int G = launder_s((int)gridDim.x), bx = launder_s((int)blockIdx.x), vcu = (G % 8 == 0) ? (bx % 8) * (G / 8) + bx / 8 : bx, gw = vcu * NWAVES + wave, ngw = G * NWAVES; (void)gw; (void)ngw; \
        bf16* const XN = (bf16*)(ws + WS_XN + 16384); float* const cosT = (float*)(ws + WS_ROPE); float* const sinT = cosT + SEQ * 8; bf16* const TMPM = (bf16*)(ws + WS_TMPM); bf16* const TMPF = (bf16*)(ws + WS_TMPF); \
        (void)XN; (void)cosT; (void)sinT; (void)TMPM; (void)TMPF; const HPlanes HP{ws + WS_HHI, ws + WS_HLO}; (void)HP;
#define PH_END }

    PH_BEGIN(0)
#if PROBE_COPY > 0
      for (int rep = 0; rep < PROBE_COPY; ++rep) {
        typedef PROBE_T pv_t; constexpr int PU = 128 / sizeof(pv_t);
        const pv_t* src = (const pv_t*)(ws + WS_BIG); pv_t* dst = (pv_t*)(ws + WS_BIG + 516 * MiB);
        const size_t n = 512 * MiB / sizeof(pv_t), stride = (size_t)G * NTHR;
        for (size_t i = (size_t)vcu * NTHR + tid; i < n; i += PU * stride) {
            pv_t v[PU];
#pragma unroll
            for (int u = 0; u < PU; ++u) v[u] = PROBE_LD(src + i + u * stride);
#pragma unroll
            for (int u = 0; u < PU; ++u) PROBE_ST(v[u], dst + i + u * stride);
        }
      }
#endif
      for (int rep = 0; rep < REP_PRO; ++rep) {
        LAS unsigned* scr = (LAS unsigned*)(ldsl + wave * 16640);
        constexpr int I_QKV = 32 * 80, I_O = 32 * 64, I_QKVF = 32 * 193, I_GLU = 32 * 128, I_IN = 32 * 344, I_OUT = 86 * 64;
        constexpr int NITEMS = 2 * (I_QKV + I_O) + I_QKVF + I_O + I_GLU + 4 * (I_IN + I_OUT);
        for (int it = gw; it < NITEMS; it += ngw) {
            int r = it;
#define TR(cnt, src, K_, N_, dstoff, mode) if (r < (cnt)) { transpose_item(IN(src), K_, N_, (bf16*)(ws + (dstoff)), mode, scr, r, lane); continue; } r -= (cnt);
            TR(I_QKV, 2, 4096, 5120, W_L0_QKV, 0)
            TR(I_O, 5, 4096, 4096, W_L0_O, 0)
            TR(I_IN, 9, 4096, 22016, W_FFN, 2)
            TR(I_OUT, 12, 11008, 4096, W_FFN + W_FFN_OUT, 0)
            TR(I_QKVF, 15, 4096, 12320, W_L1_QKVF, 0)
            TR(I_O, 17, 4096, 4096, W_L1_O, 0)
            TR(I_IN, 20, 4096, 22016, W_FFN + W_FFN_STRIDE, 2)
            TR(I_OUT, 23, 11008, 4096, W_FFN + W_FFN_STRIDE + W_FFN_OUT, 0)
            TR(I_GLU, 34, 4096, 8192, W_L2_GLU, 1)
            if (F8_FIRST_LAYER <= 2) { if (r < I_IN) { transpose_item_f8(IN(38), 4096, 22016, ws + W_FFN + 2 * W_FFN_STRIDE, 2, scr, r, lane, (float)(1 << pg8::F8_W_LOG2)); continue; } r -= I_IN; }
            else { TR(I_IN, 38, 4096, 22016, W_FFN + 2 * W_FFN_STRIDE, 2) }
            TR(I_OUT, 41, 11008, 4096, W_FFN + 2 * W_FFN_STRIDE + W_FFN_OUT, 0)
            TR(I_QKV, 44, 4096, 5120, W_L3_QKV, 0)
            TR(I_O, 47, 4096, 4096, W_L3_O, 0)
            if (r < I_IN) { transpose_item_f8(IN(51), 4096, 22016, ws + W_FFN + 3 * W_FFN_STRIDE, 2, scr, r, lane, (float)(1 << pg8::F8_W_LOG2)); continue; } r -= I_IN;
            TR(I_OUT, 54, 11008, 4096, W_FFN + 3 * W_FFN_STRIDE + W_FFN_OUT, 0)
#undef TR
        }
        if (vcu == 0) { u32x4* zh = (u32x4*)(ws + WS_XN); const u32x4 zero = {0u, 0u, 0u, 0u}; for (int i = tid; i < 1024; i += NTHR) zh[i] = zero; }
        {
            u32x4* z = (u32x4*)(ws + W_L1_QKVF + (size_t)12320 * 4096 * 2); const u32x4 zero = {0u, 0u, 0u, 0u};
            for (int i = vcu * NTHR + tid; i < 224 * 4096 * 2 / 16; i += G * NTHR) z[i] = zero;
        }
        for (int i = vcu * NTHR + tid; i < SEQ * 8; i += G * NTHR) {
            const int f = i & 7;
            const float fr = f == 0 ? args.inv_freq[0] : f == 1 ? args.inv_freq[1] : f == 2 ? args.inv_freq[2] : f == 3 ? args.inv_freq[3] : f == 4 ? args.inv_freq[4] : f == 5 ? args.inv_freq[5] : f == 6 ? args.inv_freq[6] : args.inv_freq[7];
            const float ang = (float)(i >> 3) * fr; double s, c; sincos_d((double)ang, s, c); cosT[i] = (float)c; sinT[i] = (float)s;
        }
        norm_phase<0, 2>(gw, ngw, lane, ldsl + wave * 16640, nullptr, nullptr, IN(0), nullptr, HPlanes{nullptr, nullptr}, IN(1), XN, nullptr);
      }
    PH_END

#define SEL(a, b, c, d) IN(L == 0 ? (a) : L == 1 ? (b) : L == 2 ? (c) : (d))
    { constexpr int L = 0;

        const int type = L == 3 ? 0 : L, pb = 1 + 9 * L;
        const size_t wffn = W_FFN + (size_t)L * W_FFN_STRIDE;

        PH_BEGIN(pb + 0)
            if (type == 0) {
                pg8::Gemm g{XN, (const bf16*)(ws + (L == 0 ? W_L0_QKV : W_L3_QKV)), SEQ, 5120, 4096}; pg8::StaticOrder S; S.init(SEQ, 5120, G, bx);
                pg8::EpiBf16B E{(bf16*)(ws + WS_SWA_QKV), 5120, L == 0 ? IN(3) : IN(45)};
                for (int rep = 0; rep < REP_MIXG; ++rep) pg8::gemm_phase<pg8::EpiBf16B, pg8::StaticOrder, true, true>(ldsl, g, S, E);
            } else if (type == 1) {
                pg8::Gemm g{XN, (const bf16*)(ws + W_L1_QKVF), SEQ, 12544, 4096}; pg8::StaticOrder S; S.init(SEQ, 12544, G, bx);
                pg8::EpiFox E{(bf16*)(ws + WS_FOX_QKV), (float*)(ws + WS_FOX_LOGF), IN(16)};
                for (int rep = 0; rep < REP_MIXG; ++rep) pg8::gemm_phase<pg8::EpiFox, pg8::StaticOrder, true, true>(ldsl, g, S, E);
            } else {
              for (int rep = 0; rep < REP_MIX; ++rep)
                s5::s5_phase(ldsg, (const bf16*)(ws + WS_S5_U), IN(26), IN(27), IN(28), IN(29), IN(30), IN(31), IN(32), IN(33),
                             (bf16*)(ws + WS_S5_G), vcu, G);
            }
        PH_END
        if (type != 2) {
        PH_BEGIN(pb + 1)
          for (int rep = 0; rep < REP_MIX; ++rep) {
            if (type == 0) swa::swa_attn_phase(ldsg, (const bf16*)(ws + WS_SWA_QKV), L == 0 ? IN(4) : IN(46), cosT, sinT, (bf16*)(ws + WS_SWA_O), vcu, G);
            else { fox_cumsum_phase(ldsg, (const float*)(ws + WS_FOX_LOGF), (float*)(ws + WS_FOX_CNEG), vcu, G, tid);
                   if (G > 64) { if (vcu >= 32) fox_norms_phase((const bf16*)(ws + WS_FOX_QKV), (unsigned*)(ws + WS_CTL + CTL_NRM2), (vcu - 32) * NWAVES + wave, (G - 32) * NWAVES, lane); }
                   else fox_norms_phase((const bf16*)(ws + WS_FOX_QKV), (unsigned*)(ws + WS_CTL + CTL_NRM2), gw, ngw, lane); }
          }
        PH_END
        }
        if (type == 1) {
        PH_BEGIN(pb + 2)
            const bf16* q = (const bf16*)(ws + WS_FOX_QKV);
            fox::fox_attn_phase(ldsg, q, q + (size_t)32 * SEQ * 128, q + (size_t)64 * SEQ * 128, (const float*)(ws + WS_FOX_CNEG), (const unsigned*)(ws + WS_CTL + CTL_NRM2), (unsigned*)(ws + WS_CTL + CTL_QCTR), (bf16*)(ws + WS_FOX_O));
#if REP_FOX > 1
            __syncthreads();
            fox::fox_attn_phase(ldsg, q, q + (size_t)32 * SEQ * 128, q + (size_t)64 * SEQ * 128, (const float*)(ws + WS_FOX_CNEG), (const unsigned*)(ws + WS_CTL + CTL_NRM2), (unsigned*)(ws + WS_CTL + CTL_QCTR) + 64, (bf16*)(ws + WS_FOX_O));
#endif
        PH_END
        }
        PH_BEGIN(pb + 3)
            if (type == 2) {
                pg8::Gemm g{(const bf16*)(ws + WS_S5_G), (const bf16*)(ws + W_L2_GLU), SEQ, 8192, 4096}; pg8::StaticOrder S; S.init(SEQ, 8192, G, bx);
                pg8::EpiGlu E{TMPM, IN(35)};
                for (int rep = 0; rep < REP_MIXG; ++rep) pg8::gemm_phase<pg8::EpiGlu, pg8::StaticOrder, true, true>(ldsl, g, S, E);
            } else {
                pg8::Gemm g{(const bf16*)(ws + (type == 0 ? WS_SWA_O : WS_FOX_O)), (const bf16*)(ws + (L == 0 ? W_L0_O : L == 1 ? W_L1_O : W_L3_O)), SEQ, 4096, 4096};
                pg8::StaticOrder S; S.init(SEQ, 4096, G, bx);
                pg8::EpiBf16B E{TMPM, 4096, L == 0 ? IN(6) : L == 3 ? IN(48) : nullptr};
                for (int rep = 0; rep < REP_MIXG; ++rep) pg8::gemm_phase<pg8::EpiBf16B, pg8::StaticOrder, true, true>(ldsl, g, S, E);
            }
        PH_END
        PH_BEGIN(pb + 4)
          for (int rep = 0; rep < REP_NORM; ++rep)
            if (L == 0 && rep == 0) norm_phase<0, 1>(gw, ngw, lane, ldsl + wave * 16640, TMPM, SEL(7, 18, 36, 49), IN(0), nullptr, HP, SEL(8, 19, 37, 50), XN, nullptr, 1.f);
            else norm_phase<1, 1>(gw, ngw, lane, ldsl + wave * 16640, TMPM, SEL(7, 18, 36, 49), nullptr, nullptr, HP, SEL(8, 19, 37, 50), L >= F8_FIRST_LAYER ? nullptr : XN, nullptr, rep ? 0.f : 1.f, L >= F8_FIRST_LAYER ? (unsigned char*)XN : nullptr, (float)(1 << pg8::F8_X_LOG2));
        PH_END
        PH_BEGIN(pb + 5)
            pg8::Gemm g{L >= F8_FIRST_LAYER ? (const bf16*)((const unsigned char*)XN - 2 * 4096) : XN - 2 * 4096, (const bf16*)(ws + wffn), 65 * 256, 2 * DFF, L >= F8_FIRST_LAYER ? 2048 : 4096, 254}; pg8::StaticOrder S; S.init(65 * 256, 2 * DFF, G, bx);
            pg8::EpiConvGeglu E{(bf16*)(ws + WS_ACT), SEL(10, 21, 39, 52), SEL(11, 22, 40, 53), ldsl + 131072, DFF, SEQ};
          for (int rep = 0; rep < REP_FFN1; ++rep) {
            if constexpr (L >= F8_FIRST_LAYER) pg8::gemm_phase<pg8::EpiConvGeglu, pg8::StaticOrder, true, true, true>(ldsl, g, S, E);
            else pg8::gemm_phase<pg8::EpiConvGeglu, pg8::StaticOrder, true, true>(ldsl, g, S, E); }
        PH_END
        PH_BEGIN(pb + 7)
            pg8::Gemm g{(const bf16*)(ws + WS_ACT), (const bf16*)(ws + wffn + W_FFN_OUT), SEQ, 4096, DFF}; pg8::StaticOrder S; S.init(SEQ, 4096, G, bx);
            pg8::EpiBf16B E{TMPF, 4096, nullptr};
          for (int rep = 0; rep < REP_FFN2; ++rep)
            pg8::gemm_phase<pg8::EpiBf16B, pg8::StaticOrder, true, true>(ldsl, g, S, E);
        PH_END
        PH_BEGIN(pb + 8)
          for (int rep = 0; rep < REP_NORM; ++rep)
            if (L == 3) { if (rep == 0) norm_phase<1, 0>(gw, ngw, lane, ldsl + wave * 16640, TMPF, SEL(13, 24, 42, 55), nullptr, out, HP, nullptr, nullptr, nullptr, 1.f); }
            else norm_phase<1, 1>(gw, ngw, lane, ldsl + wave * 16640, TMPF, SEL(13, 24, 42, 55), nullptr, nullptr, HP, SEL(14, 25, 43, 43), L == 1 ? nullptr : XN, L == 1 ? (bf16*)(ws + WS_S5_U) : nullptr, rep ? 0.f : 1.f);
        PH_END
    }
    { constexpr int L = 1;

        const int type = L == 3 ? 0 : L, pb = 1 + 9 * L;
        const size_t wffn = W_FFN + (size_t)L * W_FFN_STRIDE;

        PH_BEGIN(pb + 0)
            if (type == 0) {
                pg8::Gemm g{XN, (const bf16*)(ws + (L == 0 ? W_L0_QKV : W_L3_QKV)), SEQ, 5120, 4096}; pg8::StaticOrder S; S.init(SEQ, 5120, G, bx);
                pg8::EpiBf16B E{(bf16*)(ws + WS_SWA_QKV), 5120, L == 0 ? IN(3) : IN(45)};
                for (int rep = 0; rep < REP_MIXG; ++rep) pg8::gemm_phase<pg8::EpiBf16B, pg8::StaticOrder, true, true>(ldsl, g, S, E);
            } else if (type == 1) {
                pg8::Gemm g{XN, (const bf16*)(ws + W_L1_QKVF), SEQ, 12544, 4096}; pg8::StaticOrder S; S.init(SEQ, 12544, G, bx);
                pg8::EpiFox E{(bf16*)(ws + WS_FOX_QKV), (float*)(ws + WS_FOX_LOGF), IN(16)};
                for (int rep = 0; rep < REP_MIXG; ++rep) pg8::gemm_phase<pg8::EpiFox, pg8::StaticOrder, true, true>(ldsl, g, S, E);
            } else {
              for (int rep = 0; rep < REP_MIX; ++rep)
                s5::s5_phase(ldsg, (const bf16*)(ws + WS_S5_U), IN(26), IN(27), IN(28), IN(29), IN(30), IN(31), IN(32), IN(33),
                             (bf16*)(ws + WS_S5_G), vcu, G);
            }
        PH_END
        if (type != 2) {
        PH_BEGIN(pb + 1)
          for (int rep = 0; rep < REP_MIX; ++rep) {
            if (type == 0) swa::swa_attn_phase(ldsg, (const bf16*)(ws + WS_SWA_QKV), L == 0 ? IN(4) : IN(46), cosT, sinT, (bf16*)(ws + WS_SWA_O), vcu, G);
            else { fox_cumsum_phase(ldsg, (const float*)(ws + WS_FOX_LOGF), (float*)(ws + WS_FOX_CNEG), vcu, G, tid);
                   if (G > 64) { if (vcu >= 32) fox_norms_phase((const bf16*)(ws + WS_FOX_QKV), (unsigned*)(ws + WS_CTL + CTL_NRM2), (vcu - 32) * NWAVES + wave, (G - 32) * NWAVES, lane); }
                   else fox_norms_phase((const bf16*)(ws + WS_FOX_QKV), (unsigned*)(ws + WS_CTL + CTL_NRM2), gw, ngw, lane); }
          }
        PH_END
        }
        if (type == 1) {
        PH_BEGIN(pb + 2)
            const bf16* q = (const bf16*)(ws + WS_FOX_QKV);
            fox::fox_attn_phase(ldsg, q, q + (size_t)32 * SEQ * 128, q + (size_t)64 * SEQ * 128, (const float*)(ws + WS_FOX_CNEG), (const unsigned*)(ws + WS_CTL + CTL_NRM2), (unsigned*)(ws + WS_CTL + CTL_QCTR), (bf16*)(ws + WS_FOX_O));
#if REP_FOX > 1
            __syncthreads();
            fox::fox_attn_phase(ldsg, q, q + (size_t)32 * SEQ * 128, q + (size_t)64 * SEQ * 128, (const float*)(ws + WS_FOX_CNEG), (const unsigned*)(ws + WS_CTL + CTL_NRM2), (unsigned*)(ws + WS_CTL + CTL_QCTR) + 64, (bf16*)(ws + WS_FOX_O));
#endif
        PH_END
        }
        PH_BEGIN(pb + 3)
            if (type == 2) {
                pg8::Gemm g{(const bf16*)(ws + WS_S5_G), (const bf16*)(ws + W_L2_GLU), SEQ, 8192, 4096}; pg8::StaticOrder S; S.init(SEQ, 8192, G, bx);
                pg8::EpiGlu E{TMPM, IN(35)};
                for (int rep = 0; rep < REP_MIXG; ++rep) pg8::gemm_phase<pg8::EpiGlu, pg8::StaticOrder, true, true>(ldsl, g, S, E);
            } else {
                pg8::Gemm g{(const bf16*)(ws + (type == 0 ? WS_SWA_O : WS_FOX_O)), (const bf16*)(ws + (L == 0 ? W_L0_O : L == 1 ? W_L1_O : W_L3_O)), SEQ, 4096, 4096};
                pg8::StaticOrder S; S.init(SEQ, 4096, G, bx);
                pg8::EpiBf16B E{TMPM, 4096, L == 0 ? IN(6) : L == 3 ? IN(48) : nullptr};
                for (int rep = 0; rep < REP_MIXG; ++rep) pg8::gemm_phase<pg8::EpiBf16B, pg8::StaticOrder, true, true>(ldsl, g, S, E);
            }
        PH_END
        PH_BEGIN(pb + 4)
          for (int rep = 0; rep < REP_NORM; ++rep)
            if (L == 0 && rep == 0) norm_phase<0, 1>(gw, ngw, lane, ldsl + wave * 16640, TMPM, SEL(7, 18, 36, 49), IN(0), nullptr, HP, SEL(8, 19, 37, 50), XN, nullptr, 1.f);
            else norm_phase<1, 1>(gw, ngw, lane, ldsl + wave * 16640, TMPM, SEL(7, 18, 36, 49), nullptr, nullptr, HP, SEL(8, 19, 37, 50), L >= F8_FIRST_LAYER ? nullptr : XN, nullptr, rep ? 0.f : 1.f, L >= F8_FIRST_LAYER ? (unsigned char*)XN : nullptr, (float)(1 << pg8::F8_X_LOG2));
        PH_END
        PH_BEGIN(pb + 5)
            pg8::Gemm g{L >= F8_FIRST_LAYER ? (const bf16*)((const unsigned char*)XN - 2 * 4096) : XN - 2 * 4096, (const bf16*)(ws + wffn), 65 * 256, 2 * DFF, L >= F8_FIRST_LAYER ? 2048 : 4096, 254}; pg8::StaticOrder S; S.init(65 * 256, 2 * DFF, G, bx);
            pg8::EpiConvGeglu E{(bf16*)(ws + WS_ACT), SEL(10, 21, 39, 52), SEL(11, 22, 40, 53), ldsl + 131072, DFF, SEQ};
          for (int rep = 0; rep < REP_FFN1; ++rep) {
            if constexpr (L >= F8_FIRST_LAYER) pg8::gemm_phase<pg8::EpiConvGeglu, pg8::StaticOrder, true, true, true>(ldsl, g, S, E);
            else pg8::gemm_phase<pg8::EpiConvGeglu, pg8::StaticOrder, true, true>(ldsl, g, S, E); }
        PH_END
        PH_BEGIN(pb + 7)
            pg8::Gemm g{(const bf16*)(ws + WS_ACT), (const bf16*)(ws + wffn + W_FFN_OUT), SEQ, 4096, DFF}; pg8::StaticOrder S; S.init(SEQ, 4096, G, bx);
            pg8::EpiBf16B E{TMPF, 4096, nullptr};
          for (int rep = 0; rep < REP_FFN2; ++rep)
            pg8::gemm_phase<pg8::EpiBf16B, pg8::StaticOrder, true, true>(ldsl, g, S, E);
        PH_END
        PH_BEGIN(pb + 8)
          for (int rep = 0; rep < REP_NORM; ++rep)
            if (L == 3) { if (rep == 0) norm_phase<1, 0>(gw, ngw, lane, ldsl + wave * 16640, TMPF, SEL(13, 24, 42, 55), nullptr, out, HP, nullptr, nullptr, nullptr, 1.f); }
            else norm_phase<1, 1>(gw, ngw, lane, ldsl + wave * 16640, TMPF, SEL(13, 24, 42, 55), nullptr, nullptr, HP, SEL(14, 25, 43, 43), L == 1 ? nullptr : XN, L == 1 ? (bf16*)(ws + WS_S5_U) : nullptr, rep ? 0.f : 1.f);
        PH_END
    }
    { constexpr int L = 2;

        const int type = L == 3 ? 0 : L, pb = 1 + 9 * L;
        const size_t wffn = W_FFN + (size_t)L * W_FFN_STRIDE;

        PH_BEGIN(pb + 0)
            if (type == 0) {
                pg8::Gemm g{XN, (const bf16*)(ws + (L == 0 ? W_L0_QKV : W_L3_QKV)), SEQ, 5120, 4096}; pg8::StaticOrder S; S.init(SEQ, 5120, G, bx);
                pg8::EpiBf16B E{(bf16*)(ws + WS_SWA_QKV), 5120, L == 0 ? IN(3) : IN(45)};
                for (int rep = 0; rep < REP_MIXG; ++rep) pg8::gemm_phase<pg8::EpiBf16B, pg8::StaticOrder, true, true>(ldsl, g, S, E);
            } else if (type == 1) {
                pg8::Gemm g{XN, (const bf16*)(ws + W_L1_QKVF), SEQ, 12544, 4096}; pg8::StaticOrder S; S.init(SEQ, 12544, G, bx);
                pg8::EpiFox E{(bf16*)(ws + WS_FOX_QKV), (float*)(ws + WS_FOX_LOGF), IN(16)};
                for (int rep = 0; rep < REP_MIXG; ++rep) pg8::gemm_phase<pg8::EpiFox, pg8::StaticOrder, true, true>(ldsl, g, S, E);
            } else {
              for (int rep = 0; rep < REP_MIX; ++rep)
                s5::s5_phase(ldsg, (const bf16*)(ws + WS_S5_U), IN(26), IN(27), IN(28), IN(29), IN(30), IN(31), IN(32), IN(33),
                             (bf16*)(ws + WS_S5_G), vcu, G);
            }
        PH_END
        if (type != 2) {
        PH_BEGIN(pb + 1)
          for (int rep = 0; rep < REP_MIX; ++rep) {
            if (type == 0) swa::swa_attn_phase(ldsg, (const bf16*)(ws + WS_SWA_QKV), L == 0 ? IN(4) : IN(46), cosT, sinT, (bf16*)(ws + WS_SWA_O), vcu, G);
            else { fox_cumsum_phase(ldsg, (const float*)(ws + WS_FOX_LOGF), (float*)(ws + WS_FOX_CNEG), vcu, G, tid);
                   if (G > 64) { if (vcu >= 32) fox_norms_phase((const bf16*)(ws + WS_FOX_QKV), (unsigned*)(ws + WS_CTL + CTL_NRM2), (vcu - 32) * NWAVES + wave, (G - 32) * NWAVES, lane); }
                   else fox_norms_phase((const bf16*)(ws + WS_FOX_QKV), (unsigned*)(ws + WS_CTL + CTL_NRM2), gw, ngw, lane); }
          }
        PH_END
        }
        if (type == 1) {
        PH_BEGIN(pb + 2)
            const bf16* q = (const bf16*)(ws + WS_FOX_QKV);
            fox::fox_attn_phase(ldsg, q, q + (size_t)32 * SEQ * 128, q + (size_t)64 * SEQ * 128, (const float*)(ws + WS_FOX_CNEG), (const unsigned*)(ws + WS_CTL + CTL_NRM2), (unsigned*)(ws + WS_CTL + CTL_QCTR), (bf16*)(ws + WS_FOX_O));
#if REP_FOX > 1
            __syncthreads();
            fox::fox_attn_phase(ldsg, q, q + (size_t)32 * SEQ * 128, q + (size_t)64 * SEQ * 128, (const float*)(ws + WS_FOX_CNEG), (const unsigned*)(ws + WS_CTL + CTL_NRM2), (unsigned*)(ws + WS_CTL + CTL_QCTR) + 64, (bf16*)(ws + WS_FOX_O));
#endif
        PH_END
        }
        PH_BEGIN(pb + 3)
            if (type == 2) {
                pg8::Gemm g{(const bf16*)(ws + WS_S5_G), (const bf16*)(ws + W_L2_GLU), SEQ, 8192, 4096}; pg8::StaticOrder S; S.init(SEQ, 8192, G, bx);
                pg8::EpiGlu E{TMPM, IN(35)};
                for (int rep = 0; rep < REP_MIXG; ++rep) pg8::gemm_phase<pg8::EpiGlu, pg8::StaticOrder, true, true>(ldsl, g, S, E);
            } else {
                pg8::Gemm g{(const bf16*)(ws + (type == 0 ? WS_SWA_O : WS_FOX_O)), (const bf16*)(ws + (L == 0 ? W_L0_O : L == 1 ? W_L1_O : W_L3_O)), SEQ, 4096, 4096};
                pg8::StaticOrder S; S.init(SEQ, 4096, G, bx);
                pg8::EpiBf16B E{TMPM, 4096, L == 0 ? IN(6) : L == 3 ? IN(48) : nullptr};
                for (int rep = 0; rep < REP_MIXG; ++rep) pg8::gemm_phase<pg8::EpiBf16B, pg8::StaticOrder, true, true>(ldsl, g, S, E);
            }
        PH_END
        PH_BEGIN(pb + 4)
          for (int rep = 0; rep < REP_NORM; ++rep)
            if (L == 0 && rep == 0) norm_phase<0, 1>(gw, ngw, lane, ldsl + wave * 16640, TMPM, SEL(7, 18, 36, 49), IN(0), nullptr, HP, SEL(8, 19, 37, 50), XN, nullptr, 1.f);
            else norm_phase<1, 1>(gw, ngw, lane, ldsl + wave * 16640, TMPM, SEL(7, 18, 36, 49), nullptr, nullptr, HP, SEL(8, 19, 37, 50), L >= F8_FIRST_LAYER ? nullptr : XN, nullptr, rep ? 0.f : 1.f, L >= F8_FIRST_LAYER ? (unsigned char*)XN : nullptr, (float)(1 << pg8::F8_X_LOG2));
        PH_END
        PH_BEGIN(pb + 5)
            pg8::Gemm g{L >= F8_FIRST_LAYER ? (const bf16*)((const unsigned char*)XN - 2 * 4096) : XN - 2 * 4096, (const bf16*)(ws + wffn), 65 * 256, 2 * DFF, L >= F8_FIRST_LAYER ? 2048 : 4096, 254}; pg8::StaticOrder S; S.init(65 * 256, 2 * DFF, G, bx);
            pg8::EpiConvGeglu E{(bf16*)(ws + WS_ACT), SEL(10, 21, 39, 52), SEL(11, 22, 40, 53), ldsl + 131072, DFF, SEQ};
          for (int rep = 0; rep < REP_FFN1; ++rep) {
            if constexpr (L >= F8_FIRST_LAYER) pg8::gemm_phase<pg8::EpiConvGeglu, pg8::StaticOrder, true, true, true>(ldsl, g, S, E);
            else pg8::gemm_phase<pg8::EpiConvGeglu, pg8::StaticOrder, true, true>(ldsl, g, S, E); }
        PH_END
        PH_BEGIN(pb + 7)
            pg8::Gemm g{(const bf16*)(ws + WS_ACT), (const bf16*)(ws + wffn + W_FFN_OUT), SEQ, 4096, DFF}; pg8::StaticOrder S; S.init(SEQ, 4096, G, bx);
            pg8::EpiBf16B E{TMPF, 4096, nullptr};
          for (int rep = 0; rep < REP_FFN2; ++rep)
            pg8::gemm_phase<pg8::EpiBf16B, pg8::StaticOrder, true, true>(ldsl, g, S, E);
        PH_END
        PH_BEGIN(pb + 8)
          for (int rep = 0; rep < REP_NORM; ++rep)
            if (L == 3) { if (rep == 0) norm_phase<1, 0>(gw, ngw, lane, ldsl + wave * 16640, TMPF, SEL(13, 24, 42, 55), nullptr, out, HP, nullptr, nullptr, nullptr, 1.f); }
            else norm_phase<1, 1>(gw, ngw, lane, ldsl + wave * 16640, TMPF, SEL(13, 24, 42, 55), nullptr, nullptr, HP, SEL(14, 25, 43, 43), L == 1 ? nullptr : XN, L == 1 ? (bf16*)(ws + WS_S5_U) : nullptr, rep ? 0.f : 1.f);
        PH_END
    }
    { constexpr int L = 3;

        const int type = L == 3 ? 0 : L, pb = 1 + 9 * L;
        const size_t wffn = W_FFN + (size_t)L * W_FFN_STRIDE;

        PH_BEGIN(pb + 0)
            if (type == 0) {
                pg8::Gemm g{XN, (const bf16*)(ws + (L == 0 ? W_L0_QKV : W_L3_QKV)), SEQ, 5120, 4096}; pg8::StaticOrder S; S.init(SEQ, 5120, G, bx);
                pg8::EpiBf16B E{(bf16*)(ws + WS_SWA_QKV), 5120, L == 0 ? IN(3) : IN(45)};
                for (int rep = 0; rep < REP_MIXG; ++rep) pg8::gemm_phase<pg8::EpiBf16B, pg8::StaticOrder, true, true>(ldsl, g, S, E);
            } else if (type == 1) {
                pg8::Gemm g{XN, (const bf16*)(ws + W_L1_QKVF), SEQ, 12544, 4096}; pg8::StaticOrder S; S.init(SEQ, 12544, G, bx);
                pg8::EpiFox E{(bf16*)(ws + WS_FOX_QKV), (float*)(ws + WS_FOX_LOGF), IN(16)};
                for (int rep = 0; rep < REP_MIXG; ++rep) pg8::gemm_phase<pg8::EpiFox, pg8::StaticOrder, true, true>(ldsl, g, S, E);
            } else {
              for (int rep = 0; rep < REP_MIX; ++rep)
                s5::s5_phase(ldsg, (const bf16*)(ws + WS_S5_U), IN(26), IN(27), IN(28), IN(29), IN(30), IN(31), IN(32), IN(33),
                             (bf16*)(ws + WS_S5_G), vcu, G);
            }
        PH_END
        if (type != 2) {
        PH_BEGIN(pb + 1)
          for (int rep = 0; rep < REP_MIX; ++rep) {
            if (type == 0) swa::swa_attn_phase(ldsg, (const bf16*)(ws + WS_SWA_QKV), L == 0 ? IN(4) : IN(46), cosT, sinT, (bf16*)(ws + WS_SWA_O), vcu, G);
            else { fox_cumsum_phase(ldsg, (const float*)(ws + WS_FOX_LOGF), (float*)(ws + WS_FOX_CNEG), vcu, G, tid);
                   if (G > 64) { if (vcu >= 32) fox_norms_phase((const bf16*)(ws + WS_FOX_QKV), (unsigned*)(ws + WS_CTL + CTL_NRM2), (vcu - 32) * NWAVES + wave, (G - 32) * NWAVES, lane); }
                   else fox_norms_phase((const bf16*)(ws + WS_FOX_QKV), (unsigned*)(ws + WS_CTL + CTL_NRM2), gw, ngw, lane); }
          }
        PH_END
        }
        if (type == 1) {
        PH_BEGIN(pb + 2)
            const bf16* q = (const bf16*)(ws + WS_FOX_QKV);
            fox::fox_attn_phase(ldsg, q, q + (size_t)32 * SEQ * 128, q + (size_t)64 * SEQ * 128, (const float*)(ws + WS_FOX_CNEG), (const unsigned*)(ws + WS_CTL + CTL_NRM2), (unsigned*)(ws + WS_CTL + CTL_QCTR), (bf16*)(ws + WS_FOX_O));
#if REP_FOX > 1
            __syncthreads();
            fox::fox_attn_phase(ldsg, q, q + (size_t)32 * SEQ * 128, q + (size_t)64 * SEQ * 128, (const float*)(ws + WS_FOX_CNEG), (const unsigned*)(ws + WS_CTL + CTL_NRM2), (unsigned*)(ws + WS_CTL + CTL_QCTR) + 64, (bf16*)(ws + WS_FOX_O));
#endif
        PH_END
        }
        PH_BEGIN(pb + 3)
            if (type == 2) {
                pg8::Gemm g{(const bf16*)(ws + WS_S5_G), (const bf16*)(ws + W_L2_GLU), SEQ, 8192, 4096}; pg8::StaticOrder S; S.init(SEQ, 8192, G, bx);
                pg8::EpiGlu E{TMPM, IN(35)};
                for (int rep = 0; rep < REP_MIXG; ++rep) pg8::gemm_phase<pg8::EpiGlu, pg8::StaticOrder, true, true>(ldsl, g, S, E);
            } else {
                pg8::Gemm g{(const bf16*)(ws + (type == 0 ? WS_SWA_O : WS_FOX_O)), (const bf16*)(ws + (L == 0 ? W_L0_O : L == 1 ? W_L1_O : W_L3_O)), SEQ, 4096, 4096};
                pg8::StaticOrder S; S.init(SEQ, 4096, G, bx);
                pg8::EpiBf16B E{TMPM, 4096, L == 0 ? IN(6) : L == 3 ? IN(48) : nullptr};
                for (int rep = 0; rep < REP_MIXG; ++rep) pg8::gemm_phase<pg8::EpiBf16B, pg8::StaticOrder, true, true>(ldsl, g, S, E);
            }
        PH_END
        PH_BEGIN(pb + 4)
          for (int rep = 0; rep < REP_NORM; ++rep)
            if (L == 0 && rep == 0) norm_phase<0, 1>(gw, ngw, lane, ldsl + wave * 16640, TMPM, SEL(7, 18, 36, 49), IN(0), nullptr, HP, SEL(8, 19, 37, 50), XN, nullptr, 1.f);
            else norm_phase<1, 1>(gw, ngw, lane, ldsl + wave * 16640, TMPM, SEL(7, 18, 36, 49), nullptr, nullptr, HP, SEL(8, 19, 37, 50), L >= F8_FIRST_LAYER ? nullptr : XN, nullptr, rep ? 0.f : 1.f, L >= F8_FIRST_LAYER ? (unsigned char*)XN : nullptr, (float)(1 << pg8::F8_X_LOG2));
        PH_END
        PH_BEGIN(pb + 5)
            pg8::Gemm g{L >= F8_FIRST_LAYER ? (const bf16*)((const unsigned char*)XN - 2 * 4096) : XN - 2 * 4096, (const bf16*)(ws + wffn), 65 * 256, 2 * DFF, L >= F8_FIRST_LAYER ? 2048 : 4096, 254}; pg8::StaticOrder S; S.init(65 * 256, 2 * DFF, G, bx);
            pg8::EpiConvGeglu E{(bf16*)(ws + WS_ACT), SEL(10, 21, 39, 52), SEL(11, 22, 40, 53), ldsl + 131072, DFF, SEQ};
          for (int rep = 0; rep < REP_FFN1; ++rep) {
            if constexpr (L >= F8_FIRST_LAYER) pg8::gemm_phase<pg8::EpiConvGeglu, pg8::StaticOrder, true, true, true>(ldsl, g, S, E);
            else pg8::gemm_phase<pg8::EpiConvGeglu, pg8::StaticOrder, true, true>(ldsl, g, S, E); }
        PH_END
        PH_BEGIN(pb + 7)
            pg8::Gemm g{(const bf16*)(ws + WS_ACT), (const bf16*)(ws + wffn + W_FFN_OUT), SEQ, 4096, DFF}; pg8::StaticOrder S; S.init(SEQ, 4096, G, bx);
            pg8::EpiBf16B E{TMPF, 4096, nullptr};
          for (int rep = 0; rep < REP_FFN2; ++rep)
            pg8::gemm_phase<pg8::EpiBf16B, pg8::StaticOrder, true, true>(ldsl, g, S, E);
        PH_END
        PH_BEGIN(pb + 8)
          for (int rep = 0; rep < REP_NORM; ++rep)
            if (L == 3) { if (rep == 0) norm_phase<1, 0>(gw, ngw, lane, ldsl + wave * 16640, TMPF, SEL(13, 24, 42, 55), nullptr, out, HP, nullptr, nullptr, nullptr, 1.f); }
            else norm_phase<1, 1>(gw, ngw, lane, ldsl + wave * 16640, TMPF, SEL(13, 24, 42, 55), nullptr, nullptr, HP, SEL(14, 25, 43, 43), L == 1 ? nullptr : XN, L == 1 ? (bf16*)(ws + WS_S5_U) : nullptr, rep ? 0.f : 1.f);
        PH_END
    }
#if PROBE_WAIT > 0
#if PROBE_WG >= 0
    if ((int)blockIdx.x == PROBE_WG) { const unsigned long long ts = __builtin_amdgcn_s_memrealtime(); while (__builtin_amdgcn_s_memrealtime() - ts < probe_acc * PROBE_WAIT) __builtin_amdgcn_s_sleep(8); }
#elif PROBE_WG == -1
    { const unsigned long long ts = __builtin_amdgcn_s_memrealtime(); while (__builtin_amdgcn_s_memrealtime() - ts < probe_acc * PROBE_WAIT) __builtin_amdgcn_s_sleep(8); }
#else
    { const unsigned long long ts = __builtin_amdgcn_s_memrealtime(); const unsigned long long c = 250000ull, w = probe_acc < c ? c - probe_acc : 0ull; while (__builtin_amdgcn_s_memrealtime() - ts < w * PROBE_WAIT) __builtin_amdgcn_s_sleep(8); }
#endif
#endif
#undef SEL
#undef PH_BEGIN
#undef PH_END
#undef IN
}

extern "C" void kernel_launch(void* const* d_in, const int* in_sizes, int n_in, void* d_out, int out_size, void* d_ws, size_t ws_size, hipStream_t stream) {
    static int grid = 0;
    if (grid == 0) {
        if (n_in != 56 || in_sizes[0] != SEQ * DM || out_size != SEQ * DM || ws_size < WS_END) {
            fprintf(stderr, "kernel_launch: built for 56 inputs, x/out of %d floats, >= %zu bytes of workspace; got n_in %d, in0 %d, out %d, ws %zu; nothing launched\n", SEQ * DM, (size_t)WS_END, n_in, n_in > 0 ? in_sizes[0] : -1, out_size, ws_size);
            grid = -1; return; }
        int dev = 0, cus = 0, per_cu = 0;
        if (hipGetDevice(&dev) != hipSuccess || hipDeviceGetAttribute(&cus, hipDeviceAttributeMultiprocessorCount, dev) != hipSuccess) { fprintf(stderr, "kernel_launch: device query failed\n"); grid = -1; return; }
        if (hipFuncSetAttribute((const void*)mk_fwd, hipFuncAttributeMaxDynamicSharedMemorySize, LDS_BYTES) != hipSuccess) { fprintf(stderr, "kernel_launch: hipFuncSetAttribute failed\n"); grid = -1; return; }
        if (hipOccupancyMaxActiveBlocksPerMultiprocessor(&per_cu, (const void*)mk_fwd, NTHR, LDS_BYTES) != hipSuccess || per_cu < 1) { fprintf(stderr, "kernel_launch: occupancy query says %d workgroups per CU\n", per_cu); (void)hipGetLastError(); }
        grid = cus;
    }
    if (grid < 0) return;
    if (hipMemsetAsync((char*)d_ws + WS_CTL, 0, CTL_ZERO_BYTES, stream) != hipSuccess) { fprintf(stderr, "kernel_launch: memset failed\n"); return; }
    Args a{};
    for (int i = 0; i < 56; ++i) a.in[i] = (const float*)d_in[i];
    a.out = (float*)d_out; a.ws = (unsigned char*)d_ws;
    { const float lt = (float)(-std::log(500000.0)); for (int i = 0; i < 8; ++i) { float v = lt * (float)i; v = v * 0.125f; a.inv_freq[i] = (float)std::exp((double)v); } }
#if MK_SPLIT_LAUNCHES
    for (int ph = 0; ph < 37; ++ph) {
        const int L = (ph - 1) / 9, slot = (ph - 1) % 9, type = L == 3 ? 0 : L;
        if (ph > 0 && ((slot == 1 && type == 2) || (slot == 2 && type != 1) || slot == 6)) continue;
        a.ph_lo = ph; a.ph_hi = ph + 1;
        hipLaunchKernelGGL(mk_fwd, dim3(grid), dim3(NTHR), LDS_BYTES, stream, a);
    }
#else
    a.ph_lo = 0; a.ph_hi = 37;
    hipLaunchKernelGGL(mk_fwd, dim3(grid), dim3(NTHR), LDS_BYTES, stream, a);
#endif
    const hipError_t le = hipPeekAtLastError();
    if (le != hipSuccess) fprintf(stderr, "kernel_launch: launch failed: %s (grid %d x %d threads, %d B LDS)\n", hipGetErrorName(le), grid, NTHR, LDS_BYTES);
}
```

```cpp
#include <hip/hip_runtime.h>
#include <cstdio>
#include <cstdint>
#include <cmath>

#ifndef MK_SPLIT_LAUNCHES
#define MK_SPLIT_LAUNCHES 0
#endif

__device__ __forceinline__ int mk_tid() { int t = threadIdx.x; asm volatile("" : "+v"(t)); return t; }
__device__ __forceinline__ int launder_s(int v) { asm volatile("" : "+s"(v)); return v; }

#ifndef PROBE_WAIT
#define PROBE_WAIT 0
#endif
#ifndef PROBE_ID
#define PROBE_ID -1
#endif
#ifndef PROBE_MASK
#define PROBE_MASK 0x080
#endif
#ifndef PROBE_WG
#define PROBE_WG -1
#endif
#ifndef F8_FIRST_LAYER
#define F8_FIRST_LAYER 2
#endif
#ifndef PROBE_COPY
#define PROBE_COPY 0
#endif
#ifndef PROBE_T
#define PROBE_T u32x2
#endif
#define PROBE_LD(p) (*(p))
#define PROBE_ST(v, p) (*(p) = (v))
#ifndef REP_PRO
#define REP_PRO 1
#endif
#ifndef REP_FFN1
#define REP_FFN1 1
#endif
#ifndef REP_FFN2
#define REP_FFN2 1
#endif
#ifndef REP_NORM
#define REP_NORM 1
#endif
#ifndef REP_BAR
#define REP_BAR 1
#endif
#ifndef REP_FOX
#define REP_FOX 1
#endif
#ifndef REP_MIXG
#define REP_MIXG 1
#endif
#ifndef REP_MIX
#define REP_MIX 1
#endif

namespace pg8 {
#define PG8_LAS __attribute__((address_space(3)))
typedef unsigned short bf16_t;
typedef short bf16x8 __attribute__((ext_vector_type(8)));
typedef float f32x4 __attribute__((ext_vector_type(4)));
typedef unsigned u32x4 __attribute__((ext_vector_type(4)));
typedef unsigned u32x2 __attribute__((ext_vector_type(2)));
typedef float f32x2 __attribute__((ext_vector_type(2)));
typedef int v4i32 __attribute__((ext_vector_type(4)));
constexpr int F8_W_LOG2 = 10, F8_X_LOG2 = 4, F8_SCALE_W = 0x01010101 * (127 - (F8_W_LOG2 + F8_X_LOG2) / 2), F8_SCALE_X = F8_SCALE_W;
constexpr float I8_W_SCALE = 1800.f;
static_assert((F8_W_LOG2 + F8_X_LOG2) % 2 == 0, "the two scalings are undone by two equal E8M0 scales");
constexpr int BM = 256, BK = 64, HALF = 128, HTB = HALF * BK * 2  , STAGE_BYTES = 8 * HTB, NXCD = 8, WGM = 8;

__host__ __device__ __forceinline__ int lds_byte(int r, int c) { const int st = (r >> 4) * 2 + (c >> 5), rr = r & 15, cc = c & 31, ob = rr * 64 + cc * 2; return st * 1024 + (ob ^ (((ob >> 9) & 1) << 5)); }
__host__ __device__ __forceinline__ void stage_rc(int b, int& R, int& C) { const int st = b / 1024, sb = b % 1024, swz = sb ^ (((sb >> 9) & 1) << 5); R = (st >> 1) * 16 + swz / 64; C = (st & 1) * 32 + (swz % 64) / 2; }
__host__ __device__ __forceinline__ int perm32(int rho) { const int n = rho >> 4, i = rho & 15; return 8 * (i >> 2) + 4 * n + (i & 3); }

struct Unit { int pm, pn; };
struct Gemm { const bf16_t* A; const bf16_t* Bt; int M, N, K; int apr = 256; };

struct StaticOrder {
    int nM, nN, nwg, G, c;
    __host__ __device__ void init(int M, int N, int G_, int c_) { nM = M / BM; nN = N / BM; nwg = nM * nN; G = G_; c = c_; }
    __host__ __device__ bool next(int i, Unit& u) const {
        const long L = (long)i * G + c; if (L >= nwg) return false;
        int wgid = (int)L; { const int q = nwg / NXCD, r = nwg % NXCD, xcd = wgid % NXCD, off = wgid / NXCD; wgid = (xcd < r ? xcd * (q + 1) : r * (q + 1) + (xcd - r) * q) + off; }
        const int nig = WGM * nN, ngf = nM / WGM > 0 ? nM / WGM : 1; int gid = wgid / nig; if (gid >= ngf) gid = ngf - 1;
        const int fm = gid * WGM, gsz = gid == ngf - 1 ? nM - fm : WGM, w = wgid - gid * nig;
        u.pm = fm + (w % gsz); u.pn = w / gsz; return true;
    }
    __device__ __forceinline__ void a_ready(const Unit&) const {}
    __device__ __forceinline__ void done(const Unit&) const {}
};

__device__ __forceinline__ unsigned cvt_pk_bf16(float lo, float hi) { unsigned r; asm volatile("v_cvt_pk_bf16_f32 %0, %1, %2" : "=v"(r) : "v"(lo), "v"(hi)); return r; }

struct EpiF32B {
    static constexpr bool PERM = false, AFTER_DRAIN = false, APERM = false;
    float* C; int ldc; const float* bias;
    __device__ __forceinline__ void operator()(const f32x4 (&acc)[2][2][4][2], const Unit& u, int wr, int wc, int fr, int fq) const {
        const int row0 = u.pm * BM + wr * 64 + fr, col0 = u.pn * BM + wc * 32 + 4 * fq;
        f32x4 bv[2][2];
#pragma unroll
        for (int bj = 0; bj < 2; ++bj)
#pragma unroll
            for (int n = 0; n < 2; ++n) bv[bj][n] = bias ? *(const f32x4*)(bias + col0 + bj * HALF + n * 16) : (f32x4){0.f, 0.f, 0.f, 0.f};
#pragma unroll
        for (int ai = 0; ai < 2; ++ai)
#pragma unroll
            for (int m = 0; m < 4; ++m) { float* rowp = C + (size_t)(row0 + ai * HALF + m * 16) * ldc + col0;
#pragma unroll
                for (int bj = 0; bj < 2; ++bj)
#pragma unroll
                    for (int n = 0; n < 2; ++n) *(f32x4*)(rowp + bj * HALF + n * 16) = acc[ai][bj][m][n] + bv[bj][n]; }
    }
};
struct EpiBf16B {
    static constexpr bool PERM = true, AFTER_DRAIN = false, APERM = false;
    bf16_t* O; int ldc; const float* bias;
    __device__ __forceinline__ void operator()(const f32x4 (&acc)[2][2][4][2], const Unit& u, int wr, int wc, int fr, int fq) const {
        const int row0 = u.pm * BM + wr * 64 + fr; const int col0 = u.pn * BM + wc * 32 + 8 * fq;
        f32x4 bv[2][2];
#pragma unroll
        for (int bj = 0; bj < 2; ++bj)
#pragma unroll
            for (int n = 0; n < 2; ++n) bv[bj][n] = bias ? *(const f32x4*)(bias + col0 + bj * HALF + 4 * n) : (f32x4){0.f, 0.f, 0.f, 0.f};
#pragma unroll
        for (int ai = 0; ai < 2; ++ai)
#pragma unroll
            for (int m = 0; m < 4; ++m) { bf16_t* rowp = O + (size_t)(row0 + ai * HALF + m * 16) * ldc + col0;
#pragma unroll
                for (int bj = 0; bj < 2; ++bj) { const f32x4 v0 = acc[ai][bj][m][0] + bv[bj][0], v1 = acc[ai][bj][m][1] + bv[bj][1];
                    u32x4 w; w.x = cvt_pk_bf16(v0[0], v0[1]); w.y = cvt_pk_bf16(v0[2], v0[3]); w.z = cvt_pk_bf16(v1[0], v1[1]); w.w = cvt_pk_bf16(v1[2], v1[3]);
                    *(u32x4*)(rowp + bj * HALF) = w; } }
    }
};
struct EpiFox {
    static constexpr bool PERM = true, AFTER_DRAIN = false, APERM = false;
    bf16_t* QKV; float* logf; const float* bfg;
    __device__ __forceinline__ void operator()(const f32x4 (&acc)[2][2][4][2], const Unit& u, int wr, int wc, int fr, int fq) const {
        const int row0 = u.pm * BM + wr * 64 + fr;
        if (u.pn < 48) {
            const int t3 = u.pn >> 4, hp = u.pn & 15;
#pragma unroll
            for (int bj = 0; bj < 2; ++bj) { bf16_t* base = QKV + ((size_t)(t3 * 32 + 2 * hp + bj) * 16384) * 128 + wc * 32 + 8 * fq;
#pragma unroll
                for (int ai = 0; ai < 2; ++ai)
#pragma unroll
                    for (int m = 0; m < 4; ++m) { const f32x4 v0 = acc[ai][bj][m][0], v1 = acc[ai][bj][m][1];
                        u32x4 w; w.x = cvt_pk_bf16(v0[0], v0[1]); w.y = cvt_pk_bf16(v0[2], v0[3]); w.z = cvt_pk_bf16(v1[0], v1[1]); w.w = cvt_pk_bf16(v1[2], v1[3]);
                        *(u32x4*)(base + (size_t)(row0 + ai * HALF + m * 16) * 128) = w; } }
        } else if (wc == 0) {
            const f32x4 b0 = *(const f32x4*)(bfg + 8 * fq), b1 = *(const f32x4*)(bfg + 8 * fq + 4);
#pragma unroll
            for (int ai = 0; ai < 2; ++ai)
#pragma unroll
                for (int m = 0; m < 4; ++m) { float* rowp = logf + (size_t)(row0 + ai * HALF + m * 16) * 32 + 8 * fq;
#pragma unroll
                    for (int n = 0; n < 2; ++n) { const f32x4 z = acc[ai][0][m][n] + (n ? b1 : b0); f32x4 o;
#pragma unroll
                        for (int i = 0; i < 4; ++i) o[i] = fminf(z[i], 0.f) - log1pf(expf(-fabsf(z[i])));
                        *(f32x4*)(rowp + 4 * n) = o; } }
        }
    }
};
struct EpiGlu {
    static constexpr bool PERM = true, AFTER_DRAIN = false, APERM = false;
    bf16_t* C; const float* bias;
    __device__ __forceinline__ void operator()(const f32x4 (&acc)[2][2][4][2], const Unit& u, int wr, int wc, int fr, int fq) const {
        const int row0 = u.pm * BM + wr * 64 + fr, col0 = u.pn * HALF + wc * 32 + 8 * fq;
        f32x4 bv[2], bg[2];
#pragma unroll
        for (int n = 0; n < 2; ++n) { bv[n] = *(const f32x4*)(bias + col0 + 4 * n); bg[n] = *(const f32x4*)(bias + 4096 + col0 + 4 * n); }
#pragma unroll
        for (int ai = 0; ai < 2; ++ai)
#pragma unroll
            for (int m = 0; m < 4; ++m) { bf16_t* rowp = C + (size_t)(row0 + ai * HALF + m * 16) * 4096 + col0; u32x4 w;
#pragma unroll
                for (int n = 0; n < 2; ++n) { const f32x4 zv = acc[ai][0][m][n] + bv[n], zg = acc[ai][1][m][n] + bg[n]; f32x4 o;
#pragma unroll
                    for (int i = 0; i < 4; ++i) o[i] = zv[i] * __builtin_amdgcn_rcpf(1.0f + __builtin_amdgcn_exp2f(-1.4426950408889634f * zg[i]));
                    if (n == 0) { w.x = cvt_pk_bf16(o[0], o[1]); w.y = cvt_pk_bf16(o[2], o[3]); } else { w.z = cvt_pk_bf16(o[0], o[1]); w.w = cvt_pk_bf16(o[2], o[3]); } }
                *(u32x4*)rowp = w; }
    }
};

struct EpiConvGeglu {
    static constexpr bool PERM = true, AFTER_DRAIN = false, APERM = true;
    bf16_t* ACT; const float* cw; const float* cb; PG8_LAS unsigned char* xl; int dff, nrows; const float* rs; float wsc;
    __device__ __forceinline__ void dequant(f32x4 (&acc)[2][2][4][2], const Unit& u, int wr, int wc, int fr, int fq) const {
#pragma unroll
        for (int ai = 0; ai < 2; ++ai)
#pragma unroll
            for (int m = 0; m < 4; ++m) { int idx = u.pm * 254 + ai * HALF + wr * 64 + 4 * fr + m; idx = idx < nrows + 2 ? idx : nrows + 1; const float sc = rs[idx] * wsc;
#pragma unroll
                for (int bj = 0; bj < 2; ++bj)
#pragma unroll
                    for (int n = 0; n < 2; ++n) { const v4i32 q = __builtin_bit_cast(v4i32, acc[ai][bj][m][n]);
                        acc[ai][bj][m][n] = (f32x4){(float)q[0] * sc, (float)q[1] * sc, (float)q[2] * sc, (float)q[3] * sc}; } }
    }
    static __device__ __forceinline__ float shr1(float old, float src) {
        return __builtin_bit_cast(float, __builtin_amdgcn_update_dpp(__builtin_bit_cast(int, old), __builtin_bit_cast(int, src), 0x111, 0xf, 0xf, false)); }
    static __device__ __forceinline__ float gelu_t(float x) { const float t = 0.7978845608028654f * (x + 0.044715f * x * x * x); return x * __builtin_amdgcn_rcpf(1.0f + __builtin_amdgcn_exp2f(-2.8853900817779268f * t)); }
    __device__ __forceinline__ void operator()(const f32x4 (&acc)[2][2][4][2], const Unit& u, int wr, int wc, int fr, int fq) const {
        asm volatile("" : "+v"(fr), "+v"(fq));
#define XOFF(ai_, w_, rr_, bj_, n_) ((((((ai_) * 2 + (w_)) * 2 + (rr_)) * 2 + (bj_)) * 4 + wc) * 128 + fq * 32 + (n_) * 16)
        f32x4 wv[8];
        { const int gc = u.pn * HALF + wc * 32 + 8 * fq;
            wv[0] = *(const f32x4*)(cw + gc); wv[1] = *(const f32x4*)(cw + 2 * dff + gc); wv[2] = *(const f32x4*)(cw + 4 * dff + gc); wv[3] = *(const f32x4*)(cb + gc);
            wv[4] = *(const f32x4*)(cw + dff + gc); wv[5] = *(const f32x4*)(cw + 3 * dff + gc); wv[6] = *(const f32x4*)(cw + 5 * dff + gc); wv[7] = *(const f32x4*)(cb + dff + gc); }
        if (fr == 15) {
#pragma unroll
            for (int ai = 0; ai < 2; ++ai)
#pragma unroll
                for (int bj = 0; bj < 2; ++bj)
#pragma unroll
                    for (int n = 0; n < 2; ++n) { *(PG8_LAS f32x4*)(xl + XOFF(ai, wr, 0, bj, n)) = acc[ai][bj][2][n]; *(PG8_LAS f32x4*)(xl + XOFF(ai, wr, 1, bj, n)) = acc[ai][bj][3][n]; }
        }
        asm volatile("s_waitcnt lgkmcnt(0)" ::: "memory"); __builtin_amdgcn_s_barrier(); asm volatile("" ::: "memory");
        u32x2 keep[2][4];
#pragma unroll
        for (int n = 0; n < 2; ++n) {
            const int gcol = u.pn * HALF + wc * 32 + 8 * fq + 4 * n;
            if (n) { wv[0] = *(const f32x4*)(cw + gcol); wv[1] = *(const f32x4*)(cw + 2 * dff + gcol); wv[2] = *(const f32x4*)(cw + 4 * dff + gcol); wv[3] = *(const f32x4*)(cb + gcol);
                     wv[4] = *(const f32x4*)(cw + dff + gcol); wv[5] = *(const f32x4*)(cw + 3 * dff + gcol); wv[6] = *(const f32x4*)(cw + 5 * dff + gcol); wv[7] = *(const f32x4*)(cb + dff + gcol); }
            const f32x4 wg0 = wv[0], wg1 = wv[1], wg2 = wv[2], bg = wv[3], wu0 = wv[4], wu1 = wv[5], wu2 = wv[6], bu = wv[7];
#pragma unroll
            for (int ai = 0; ai < 2; ++ai) {
                f32x4 Xg2 = {0.f, 0.f, 0.f, 0.f}, Xg3 = Xg2, Xu2 = Xg2, Xu3 = Xg2;
                if (ai + wr > 0) { const int pa = wr ? ai : ai - 1, pw = wr ? 0 : 1;
                    Xg2 = *(const PG8_LAS f32x4*)(xl + XOFF(pa, pw, 0, 0, n)); Xg3 = *(const PG8_LAS f32x4*)(xl + XOFF(pa, pw, 1, 0, n));
                    Xu2 = *(const PG8_LAS f32x4*)(xl + XOFF(pa, pw, 0, 1, n)); Xu3 = *(const PG8_LAS f32x4*)(xl + XOFF(pa, pw, 1, 1, n)); }
                float o[4][4];
#pragma unroll
                for (int ip = 0; ip < 2; ++ip) {
                    const int i0 = 2 * ip, i1 = 2 * ip + 1;
#define P2(v) ((f32x2){(v)[i0], (v)[i1]})
                    const f32x2 g0 = P2(acc[ai][0][0][n]), g1 = P2(acc[ai][0][1][n]), g2 = P2(acc[ai][0][2][n]), g3 = P2(acc[ai][0][3][n]);
                    const f32x2 u0 = P2(acc[ai][1][0][n]), u1 = P2(acc[ai][1][1][n]), u2 = P2(acc[ai][1][2][n]), u3 = P2(acc[ai][1][3][n]);
                    const f32x2 gm1 = {shr1(Xg3[i0], g3.x), shr1(Xg3[i1], g3.y)}, gm2 = {shr1(Xg2[i0], g2.x), shr1(Xg2[i1], g2.y)};
                    const f32x2 um1 = {shr1(Xu3[i0], u3.x), shr1(Xu3[i1], u3.y)}, um2 = {shr1(Xu2[i0], u2.x), shr1(Xu2[i1], u2.y)};
                    const f32x2 a2 = P2(wg2), a1 = P2(wg1), a0 = P2(wg0), ab = P2(bg), c2 = P2(wu2), c1 = P2(wu1), c0 = P2(wu0), cb = P2(bu);
#define FMA2(a, b, c) __builtin_elementwise_fma((a), (b), (c))
                    const f32x2 zg[4] = {FMA2(a0, gm2, FMA2(a1, gm1, FMA2(a2, g0, ab))), FMA2(a0, gm1, FMA2(a1, g0, FMA2(a2, g1, ab))), FMA2(a0, g0, FMA2(a1, g1, FMA2(a2, g2, ab))), FMA2(a0, g1, FMA2(a1, g2, FMA2(a2, g3, ab)))};
                    const f32x2 zu[4] = {FMA2(c0, um2, FMA2(c1, um1, FMA2(c2, u0, cb))), FMA2(c0, um1, FMA2(c1, u0, FMA2(c2, u1, cb))), FMA2(c0, u0, FMA2(c1, u1, FMA2(c2, u2, cb))), FMA2(c0, u1, FMA2(c1, u2, FMA2(c2, u3, cb)))};
#pragma unroll
                    for (int m = 0; m < 4; ++m) {
                        const f32x2 x = zg[m], x2 = x * x; const f32x2 kk = {-2.302208198f, -2.302208198f}, k3 = {-2.302208198f * 0.044715f, -2.302208198f * 0.044715f}, one = {1.f, 1.f};
                        const f32x2 a = x * FMA2(x2, k3, kk); const f32x2 e = {__builtin_amdgcn_exp2f(a.x), __builtin_amdgcn_exp2f(a.y)}; const f32x2 d = e + one;
                        const f32x2 r = {__builtin_amdgcn_rcpf(d.x), __builtin_amdgcn_rcpf(d.y)}; const f32x2 ov = (x * zu[m]) * r;
                        o[m][i0] = ov.x; o[m][i1] = ov.y; }
#undef FMA2
#undef P2
                }
#pragma unroll
                for (int m = 0; m < 4; ++m) { const int it = ai * HALF + wr * 64 + 4 * fr + m, grow = u.pm * 254 - 2 + it;
                    u32x2 w; w.x = cvt_pk_bf16(o[m][0], o[m][1]); w.y = cvt_pk_bf16(o[m][2], o[m][3]);
                    if (n == 0) keep[ai][m] = w;
                    else if (it >= 2 && grow < nrows) { u32x4 ww; ww.x = keep[ai][m].x; ww.y = keep[ai][m].y; ww.z = w.x; ww.w = w.y; *(u32x4*)(ACT + (size_t)grow * dff + gcol - 4) = ww; } }
            }
        }
#undef XOFF
    }
};

template <class Epi, class Sched, bool ALIGN_EPI = false, bool SP2 = false, int QM = 0>
__device__ __forceinline__ void gemm_phase(PG8_LAS unsigned char* lds, const Gemm g, const Sched& S, const Epi& E) {
    const int tid = mk_tid(), wid = __builtin_amdgcn_readfirstlane(tid >> 6), lane = tid & 63, wr = wid >> 2, wc = wid & 3, fr = lane & 15, fq = lane >> 4;
    const int K = g.K, nt = K / BK;
    unsigned voffA, voffB;
    { int R, C; stage_rc(tid * 16, R, C); const int Rb = Epi::PERM ? ((R & ~31) + perm32(R & 31)) : R;
        const int Ra = Epi::APERM ? ((R & ~63) + 4 * (R & 15) + ((R >> 4) & 3)) : R;
        voffA = (unsigned)(Ra * K + C) * 2u; voffB = (unsigned)(Rb * K + C) * 2u; }
    const size_t r64 = (size_t)64 * K * 2;
    const size_t kstep = (size_t)(BK * 2);
    const size_t hstep = (size_t)HALF * K * 2;
    const size_t tstep = 2 * hstep;
    const size_t tstepA = (size_t)g.apr * K * 2;
    const unsigned ldsw = (unsigned)wid * 1024u;
    const int aoff = lds_byte(wr * 64 + fr, fq * 8), boff = lds_byte(wc * 32 + fr, fq * 8);
#define PG8_SA(b, h) (((b) * 2 + (h)) * HTB)
#define PG8_SB(b, h) ((4 + (b) * 2 + (h)) * HTB)
#define PG8_STAGE(bufoff, gbase, voff) do { _Pragma("unroll") for (int _i = 0; _i < 2; ++_i) \
        __builtin_amdgcn_global_load_lds((const unsigned*)((const char*)(gbase) + (size_t)_i * r64 + (voff)), (PG8_LAS unsigned*)(lds + (bufoff) + ldsw + _i * 8192), 16, 0, 0); } while (0)
#define PG8_LDA(dst, b, h) do { _Pragma("unroll") for (int m = 0; m < 4; ++m) _Pragma("unroll") for (int k = 0; k < 2; ++k) dst[m][k] = *(const PG8_LAS bf16x8*)(lds + PG8_SA(b, h) + aoff + m * 2048 + k * 1024); } while (0)
#define PG8_LDB(dst, b, h) do { _Pragma("unroll") for (int n = 0; n < 2; ++n) _Pragma("unroll") for (int k = 0; k < 2; ++k) dst[n][k] = *(const PG8_LAS bf16x8*)(lds + PG8_SB(b, h) + boff + n * 2048 + k * 1024); } while (0)
#define PG8_CAT(f) __builtin_shufflevector(__builtin_bit_cast(v4i32, (f)[0]), __builtin_bit_cast(v4i32, (f)[1]), 0, 1, 2, 3, 4, 5, 6, 7)
#define PG8_MMA(ai, bj, At, Bt) do { __builtin_amdgcn_s_setprio(1); _Pragma("unroll") for (int m = 0; m < 4; ++m) _Pragma("unroll") for (int n = 0; n < 2; ++n) { \
        if constexpr (QM == 1) acc[ai][bj][m][n] = __builtin_amdgcn_mfma_scale_f32_16x16x128_f8f6f4(PG8_CAT(Bt[n]), PG8_CAT(At[m]), acc[ai][bj][m][n], 0, 0, 0, F8_SCALE_W, 0, F8_SCALE_X); \
        else if constexpr (QM == 2) { _Pragma("unroll") for (int k = 0; k < 2; ++k) acc[ai][bj][m][n] = __builtin_bit_cast(f32x4, __builtin_amdgcn_mfma_i32_16x16x64_i8( \
            __builtin_bit_cast(v4i32, Bt[n][k]), __builtin_bit_cast(v4i32, At[m][k]), __builtin_bit_cast(v4i32, acc[ai][bj][m][n]), 0, 0, 0)); } \
        else { _Pragma("unroll") for (int k = 0; k < 2; ++k) acc[ai][bj][m][n] = __builtin_amdgcn_mfma_f32_16x16x32_bf16(Bt[n][k], At[m][k], acc[ai][bj][m][n], 0, 0, 0); } } \
        __builtin_amdgcn_s_setprio(0); } while (0)
#define PG8_WAIT_V(n) asm volatile("s_waitcnt vmcnt(" #n ")" ::: "memory")
#define PG8_WAIT_L(n) asm volatile("s_waitcnt lgkmcnt(" #n ")" ::: "memory")
#define PG8_BAR __builtin_amdgcn_s_barrier()
#define PG8_SCHED __builtin_amdgcn_sched_barrier(0)
    Unit cur, nxt; int ui = 0;
    if (!S.next(0, cur)) return;
    f32x4 acc[2][2][4][2];
#pragma unroll
    for (int a = 0; a < 2; ++a)
#pragma unroll
        for (int b = 0; b < 2; ++b)
#pragma unroll
            for (int m = 0; m < 4; ++m)
#pragma unroll
                for (int n = 0; n < 2; ++n) acc[a][b][m][n] = (f32x4){0.f, 0.f, 0.f, 0.f};
    bf16x8 At[4][2], B0[2][2], B1[2][2];
    const char* cA = (const char*)g.A + (size_t)cur.pm * tstepA; const char* cB = (const char*)g.Bt + (size_t)cur.pn * tstep;
    S.a_ready(cur);
    if constexpr (SP2) {
        PG8_STAGE(PG8_SB(0, 0), cB, voffB); PG8_STAGE(PG8_SB(0, 1), cB + hstep, voffB); PG8_STAGE(PG8_SA(0, 0), cA, voffA); PG8_STAGE(PG8_SA(0, 1), cA + hstep, voffA);
        if (wr == 1) PG8_BAR;
        PG8_WAIT_V(2); PG8_BAR;
        PG8_STAGE(PG8_SB(1, 0), cB + kstep, voffB); PG8_STAGE(PG8_SA(1, 0), cA + kstep, voffA); PG8_STAGE(PG8_SB(1, 1), cB + hstep + kstep, voffB);
        PG8_WAIT_V(6); PG8_BAR;
    } else {
        PG8_STAGE(PG8_SB(0, 0), cB, voffB); PG8_STAGE(PG8_SA(0, 0), cA, voffA); PG8_STAGE(PG8_SB(0, 1), cB + hstep, voffB); PG8_STAGE(PG8_SA(0, 1), cA + hstep, voffA);
        if (wr == 1) PG8_BAR;
        PG8_WAIT_V(4); PG8_BAR;
        PG8_STAGE(PG8_SB(1, 0), cB + kstep, voffB); PG8_STAGE(PG8_SA(1, 0), cA + kstep, voffA); PG8_STAGE(PG8_SB(1, 1), cB + hstep + kstep, voffB);
        PG8_WAIT_V(6); PG8_BAR;
    }
    for (;;) {
        const bool has_next = S.next(ui + 1, nxt);
        const char* nA = has_next ? (const char*)g.A + (size_t)nxt.pm * tstepA : cA; const char* nB = has_next ? (const char*)g.Bt + (size_t)nxt.pn * tstep : cB;
        for (int t = 0; t < nt; t += 2) {
            const bool last = (t == nt - 2);
            const char* a1 = cA + (size_t)(t + 1) * kstep;
            const char* a2 = last ? nA : cA + (size_t)(t + 2) * kstep; const char* b2 = last ? nB : cB + (size_t)(t + 2) * kstep;
            const char* a3 = a2 + kstep; const char* b3 = b2 + kstep;
            if (last && has_next) S.a_ready(nxt);
            if constexpr (SP2) {
            PG8_LDB(B0, 0, 0); PG8_LDB(B1, 0, 1); PG8_SCHED; PG8_LDA(At, 0, 0); PG8_STAGE(PG8_SA(1, 1), a1 + hstep, voffA);
            PG8_WAIT_V(8); PG8_WAIT_L(0); PG8_BAR; PG8_MMA(0, 0, At, B0); PG8_MMA(0, 1, At, B1); PG8_BAR; PG8_SCHED;
            PG8_LDA(At, 0, 1); PG8_STAGE(PG8_SB(0, 0), b2, voffB); PG8_STAGE(PG8_SB(0, 1), b2 + hstep, voffB); PG8_STAGE(PG8_SA(0, 0), a2, voffA);
            PG8_WAIT_V(8); PG8_WAIT_L(0); PG8_BAR; PG8_MMA(1, 0, At, B0); PG8_MMA(1, 1, At, B1); PG8_BAR; PG8_SCHED;
            PG8_LDB(B0, 1, 0); PG8_LDB(B1, 1, 1); PG8_SCHED; PG8_LDA(At, 1, 0); PG8_STAGE(PG8_SA(0, 1), a2 + hstep, voffA);
            PG8_WAIT_V(8); PG8_WAIT_L(0); PG8_BAR; PG8_MMA(0, 0, At, B0); PG8_MMA(0, 1, At, B1); PG8_BAR; PG8_SCHED;
            PG8_LDA(At, 1, 1); PG8_STAGE(PG8_SB(1, 0), b3, voffB); PG8_STAGE(PG8_SB(1, 1), b3 + hstep, voffB); PG8_STAGE(PG8_SA(1, 0), a3, voffA);
            PG8_WAIT_V(8); PG8_WAIT_L(0); PG8_BAR; PG8_MMA(1, 0, At, B0); PG8_MMA(1, 1, At, B1); PG8_BAR; PG8_SCHED;
            } else {
            PG8_LDB(B0, 0, 0); PG8_SCHED; PG8_LDA(At, 0, 0); PG8_STAGE(PG8_SA(1, 1), a1 + hstep, voffA);
            PG8_WAIT_L(8); PG8_BAR; PG8_WAIT_L(0); PG8_MMA(0, 0, At, B0); PG8_BAR; PG8_SCHED;
            PG8_LDB(B1, 0, 1); PG8_STAGE(PG8_SB(0, 0), b2, voffB);
            PG8_BAR; PG8_WAIT_L(0); PG8_MMA(0, 1, At, B1); PG8_BAR;
            PG8_LDA(At, 0, 1); PG8_STAGE(PG8_SA(0, 0), a2, voffA);
            PG8_BAR; PG8_WAIT_L(0); PG8_MMA(1, 0, At, B0); PG8_BAR; PG8_SCHED;
            PG8_STAGE(PG8_SB(0, 1), b2 + hstep, voffB);
            PG8_WAIT_V(6); PG8_BAR; PG8_MMA(1, 1, At, B1); PG8_BAR;
            PG8_LDB(B0, 1, 0); PG8_SCHED; PG8_LDA(At, 1, 0); PG8_STAGE(PG8_SA(0, 1), a2 + hstep, voffA);
            PG8_WAIT_L(8); PG8_BAR; PG8_WAIT_L(0); PG8_MMA(0, 0, At, B0); PG8_BAR; PG8_SCHED;
            PG8_LDB(B1, 1, 1); PG8_STAGE(PG8_SB(1, 0), b3, voffB);
            PG8_BAR; PG8_WAIT_L(0); PG8_MMA(0, 1, At, B1); PG8_BAR;
            PG8_LDA(At, 1, 1); PG8_STAGE(PG8_SA(1, 0), a3, voffA);
            PG8_BAR; PG8_WAIT_L(0); PG8_MMA(1, 0, At, B0); PG8_BAR; PG8_SCHED;
            PG8_STAGE(PG8_SB(1, 1), b3 + hstep, voffB);
            PG8_WAIT_V(6); PG8_BAR; PG8_MMA(1, 1, At, B1); PG8_BAR;
            }
        }
        if constexpr (ALIGN_EPI) { if (wr == 0) PG8_BAR; }
        if constexpr (QM == 2) E.dequant(acc, cur, wr, wc, fr, fq);
        if constexpr (!Epi::AFTER_DRAIN) { E(acc, cur, wr, wc, fr, fq); S.done(cur); }
        if (!has_next) break;
#pragma unroll
        for (int a = 0; a < 2; ++a)
#pragma unroll
            for (int b = 0; b < 2; ++b)
#pragma unroll
                for (int m = 0; m < 4; ++m)
#pragma unroll
                    for (int n = 0; n < 2; ++n) acc[a][b][m][n] = (f32x4){0.f, 0.f, 0.f, 0.f};
        cur = nxt; cA = nA; cB = nB; ++ui;
        if constexpr (ALIGN_EPI) { if (wr == 1) PG8_BAR; }
    }
    PG8_WAIT_V(0);
    if constexpr (!ALIGN_EPI) { if (wr == 0) PG8_BAR; }
    PG8_BAR;
    if constexpr (Epi::AFTER_DRAIN) { E.fused(acc, cur, wr, wc, fr, fq, lds, wid, lane); S.done(cur); }
#undef PG8_SA
#undef PG8_SB
#undef PG8_STAGE
#undef PG8_LDA
#undef PG8_LDB
#undef PG8_MMA
#undef PG8_CAT
#undef PG8_WAIT_V
#undef PG8_WAIT_L
#undef PG8_BAR
#undef PG8_SCHED
}
}

namespace fox {
#define LAS3 __attribute__((address_space(3)))
constexpr int D = 128, SEQ = 16384, NH = 32, OPITCH = 4096;
constexpr float SCALE = 0.08838834764831845f;
constexpr float THR = 8.f;
constexpr int NW = 8, QBLK = 32, KVBLK = 64, QB = NW * QBLK;
constexpr int SHM_V = KVBLK * D * 2, SHM_K = KVBLK * D * 2;
constexpr int OFF_WS = 2 * SHM_V + 2 * SHM_K, OFF_BIAS = OFF_WS + NW * 64 * 4, OFF_QW = OFF_BIAS + 2 * 64 * 4, OFF_JLO = OFF_QW + 16, OFF_KEY = OFF_JLO + 2048, OFF_ORD = OFF_KEY + 8192, LDS_BYTES = OFF_ORD + 4096;
constexpr float SKIP_T = 30.f;
typedef unsigned short bf16;
typedef short bf16x8 __attribute__((ext_vector_type(8)));
typedef short s16x4 __attribute__((ext_vector_type(4)));
typedef float f32x16 __attribute__((ext_vector_type(16)));
typedef float f32x4 __attribute__((ext_vector_type(4)));
typedef unsigned u32x4 __attribute__((ext_vector_type(4)));

#define KSWZ(row, colB) ((row) * 256 + ((colB) ^ (((row) & 7) << 4)))
#define SBAR() __builtin_amdgcn_sched_barrier(0)
__device__ __forceinline__ int v_st(int k, int c) { const int kk = (k & ~0xC) | ((k & 4) << 1) | ((k & 8) >> 1); return ((kk >> 3) * 4 + (c >> 5)) * 512 + ((kk & 7) * 32 + (c & 31)) * 2; }
__device__ __forceinline__ int v_rd_base(int lane) { return ((lane & 3) << 3) | (((lane >> 2) & 3) << 6) | (((lane >> 4) & 1) << 5) | (((lane >> 5) & 1) << 8); }
constexpr int v_rd_off(int d0, int ks, int half) { return d0 * 512 + ks * 4096 + half * 2048; }
__device__ __forceinline__ int crow(int r, int hi) { return (r & 3) + 8 * (r >> 2) + 4 * hi; }
__device__ __forceinline__ unsigned cvtpk(float lo, float hi) { unsigned r; asm volatile("v_cvt_pk_bf16_f32 %0, %1, %2" : "=v"(r) : "v"(lo), "v"(hi)); return r; }
__device__ __forceinline__ bf16x8 load8(const bf16* p) { return *reinterpret_cast<const bf16x8*>(p); }
__device__ __forceinline__ void mask_tile(f32x16& p0, f32x16& p1, int dq) {
    const float NEG = -__builtin_inff();
#pragma unroll
    for (int r = 0; r < 16; ++r) {
        const int c = (r & 3) + 8 * (r >> 2);
        if (dq - c < 0) p0[r] = NEG;
        if (dq - c - 32 < 0) p1[r] = NEG;
    }
}
__device__ __forceinline__ void partialSM(f32x16& p0, f32x16& p1, float& m_reg, float& mn, float& alpha) {
    float pmax = p0[0]; for (int r = 1; r < 16; ++r) pmax = fmaxf(pmax, p0[r]); for (int r = 0; r < 16; ++r) pmax = fmaxf(pmax, p1[r]);
    { auto rr = __builtin_amdgcn_permlane32_swap(__float_as_uint(pmax), __float_as_uint(pmax), false, false);
      pmax = fmaxf(__uint_as_float(rr[0]), __uint_as_float(rr[1])); }
    constexpr float C2 = 1.4426950408889634f * SCALE;
    if (__builtin_expect(__all((pmax - m_reg) * SCALE <= THR), 1)) { mn = m_reg; alpha = 1.f; }
    else { mn = fmaxf(m_reg, pmax); alpha = __builtin_amdgcn_exp2f((m_reg - mn) * C2); m_reg = mn; }
    const float mnL = -mn * C2;
    for (int r = 0; r < 16; ++r) p0[r] = fmaf(p0[r], C2, mnL); for (int r = 0; r < 16; ++r) p1[r] = fmaf(p1[r], C2, mnL);
    for (int r = 0; r < 16; ++r) p0[r] = __builtin_amdgcn_exp2f(p0[r]);
}
__device__ __forceinline__ void finishSM(f32x16& p0, f32x16& p1, float alpha, float& l_reg, bf16x8& pa0, bf16x8& pa1, bf16x8& pa2, bf16x8& pa3) {
    for (int r = 0; r < 16; ++r) p1[r] = __builtin_amdgcn_exp2f(p1[r]);
    float ps = 0; for (int r = 0; r < 16; ++r) ps += p0[r]; for (int r = 0; r < 16; ++r) ps += p1[r];
    { auto rr = __builtin_amdgcn_permlane32_swap(__float_as_uint(ps), __float_as_uint(ps), false, false);
      ps = __uint_as_float(rr[0]) + __uint_as_float(rr[1]); }
    l_reg = l_reg * alpha + ps;
#define PK4(P, B_, OUT) do { unsigned a0 = cvtpk(P[B_+0], P[B_+1]), a1 = cvtpk(P[B_+2], P[B_+3]);                          \
        unsigned b0 = cvtpk(P[B_+4], P[B_+5]), b1 = cvtpk(P[B_+6], P[B_+7]);                                             \
        auto r0 = __builtin_amdgcn_permlane32_swap(a0, b0, false, false); auto r1 = __builtin_amdgcn_permlane32_swap(a1, b1, false, false); \
        u32x4 w = {r0[0], r1[0], r0[1], r1[1]}; OUT = *reinterpret_cast<bf16x8*>(&w); } while (0)
    PK4(p0, 0, pa0); PK4(p0, 8, pa1); PK4(p1, 0, pa2); PK4(p1, 8, pa3);
}
template <int KB>
__device__ __forceinline__ void qkt(f32x16& p0, f32x16& p1, const char* K_lds, const char* B_lds, int r32, int hi, const bf16x8* qr) {
    const float* bl = (const float*)B_lds + KB * 64 + 4 * hi;
#pragma unroll
    for (int g = 0; g < 4; ++g) { const f32x4 a = *(const f32x4*)(bl + 8 * g), b = *(const f32x4*)(bl + 32 + 8 * g);
        p0[4 * g + 0] = a[0]; p0[4 * g + 1] = a[1]; p0[4 * g + 2] = a[2]; p0[4 * g + 3] = a[3];
        p1[4 * g + 0] = b[0]; p1[4 * g + 1] = b[1]; p1[4 * g + 2] = b[2]; p1[4 * g + 3] = b[3]; }
    const char* kb[4];
#pragma unroll
    for (int dd = 0; dd < 4; ++dd) kb[dd] = K_lds + KB * SHM_K + KSWZ(r32, (dd * 16 + hi * 8) * 2);
#pragma unroll
    for (int d0 = 0; d0 < 8; ++d0) { const char* a = kb[d0 & 3] + (d0 >> 2) * 128;
        bf16x8 b0 = *reinterpret_cast<const bf16x8*>(a);
        bf16x8 b1 = *reinterpret_cast<const bf16x8*>(a + 32 * 256);
        p0 = __builtin_amdgcn_mfma_f32_32x32x16_bf16(b0, qr[d0], p0, 0, 0, 0);
        p1 = __builtin_amdgcn_mfma_f32_32x32x16_bf16(b1, qr[d0], p1, 0, 0, 0); }
}
template <int VB>
__device__ __forceinline__ void pv_tile(f32x16* o, int vb0, bf16x8 pa0, bf16x8 pa1, bf16x8 pa2, bf16x8 pa3) {
#define TRRD(dst, off) asm volatile("ds_read_b64_tr_b16 %0, %1 offset:%2" : "=&v"(dst) : "v"(vb0), "i"(off) : "memory")
#define PV_D0(d0) do { s16x4 l0, l1, l2, l3, h0, h1, h2, h3; constexpr int b_ = VB * SHM_V + v_rd_off(d0, 0, 0);     \
        TRRD(l0, b_); TRRD(h0, b_ + 2048); TRRD(l1, b_ + 4096); TRRD(h1, b_ + 6144); TRRD(l2, b_ + 8192); TRRD(h2, b_ + 10240); TRRD(l3, b_ + 12288); TRRD(h3, b_ + 14336); \
        asm volatile("s_waitcnt lgkmcnt(0)" ::: "memory"); SBAR();                                                                              \
        o[d0] = __builtin_amdgcn_mfma_f32_32x32x16_bf16((bf16x8){l0[0], l0[1], l0[2], l0[3], h0[0], h0[1], h0[2], h0[3]}, pa0, o[d0], 0, 0, 0);   \
        o[d0] = __builtin_amdgcn_mfma_f32_32x32x16_bf16((bf16x8){l1[0], l1[1], l1[2], l1[3], h1[0], h1[1], h1[2], h1[3]}, pa1, o[d0], 0, 0, 0);   \
        o[d0] = __builtin_amdgcn_mfma_f32_32x32x16_bf16((bf16x8){l2[0], l2[1], l2[2], l2[3], h2[0], h2[1], h2[2], h2[3]}, pa2, o[d0], 0, 0, 0);   \
        o[d0] = __builtin_amdgcn_mfma_f32_32x32x16_bf16((bf16x8){l3[0], l3[1], l3[2], l3[3], h3[0], h3[1], h3[2], h3[3]}, pa3, o[d0], 0, 0, 0); } while (0)
    PV_D0(0); PV_D0(1); PV_D0(2); PV_D0(3);
#undef PV_D0
#undef TRRD
}

struct BlockRef { const bf16* Q; const bf16* K; const bf16* V; const float* C; bf16* O; int P0; int jlo; };
struct Seam {
    bf16x8 qr[8];
    bf16x8 st_v0, st_v1, st_k0, st_k1; float st_b;
};
#define ROW(p, k0, rr) ((p) + (size_t)((k0) + (rr)) * D + sc)
#define VMW() asm volatile("s_waitcnt vmcnt(0)" ::: "memory")
#define VMWN(n) asm volatile("s_waitcnt vmcnt(%0)" :: "i"(n) : "memory")
#define SLOAD_H(Kp, Vp, Cp, k0) do { S.st_v0 = load8(ROW(Vp, k0, sr)); S.st_v1 = load8(ROW(Vp, k0, 32 + sr));              \
                         S.st_k0 = load8(ROW(Kp, k0, sr)); S.st_k1 = load8(ROW(Kp, k0, 32 + sr)); if (tid < 64) S.st_b = (Cp)[(k0) + tid]; } while (0)
#define SWRITE_HK(bf, cr) do { *(bf16x8*)(K_lds + (bf) * SHM_K + kws) = S.st_k0; *(bf16x8*)(K_lds + (bf) * SHM_K + kws + 32 * 256) = S.st_k1; \
                         if (tid < 64) ((float*)B_lds)[(bf) * 64 + tid] = S.st_b - (cr); } while (0)
#define SWRITE_HV(bf) do { *(bf16x8*)(V_lds + (bf) * SHM_V + vst0) = S.st_v0; *(bf16x8*)(V_lds + (bf) * SHM_V + vst1) = S.st_v1; } while (0)
#define SWRITE_H(bf, cr) do { SWRITE_HV(bf); SWRITE_HK(bf, cr); } while (0)
__device__ __forceinline__ void fox_prime(const BlockRef& cur, char* lds, Seam& S) {
    const int tid = mk_tid(), wid = __builtin_amdgcn_readfirstlane(tid >> 6), lane = tid & 63, r32 = lane & 31, hi = lane >> 5;
    const int sr = tid >> 4, sc = (tid & 15) * 8, kws = KSWZ(sr, sc * 2); char* K_lds = lds + 2 * SHM_V; char* B_lds = lds + OFF_BIAS;
    const float cref = __uint_as_float(__builtin_amdgcn_readfirstlane(__float_as_uint(cur.C[cur.P0])));
    for (int d0 = 0; d0 < 8; ++d0) S.qr[d0] = load8(cur.Q + (size_t)(wid * QBLK + r32) * D + d0 * 16 + hi * 8);
    SLOAD_H(cur.K, cur.V, cur.C, cur.jlo * KVBLK); VMW(); SWRITE_HK(0, cref);
    __syncthreads();
}
template <class NextFn> __device__ __forceinline__ BlockRef fox_block(const BlockRef& cur, char* lds, Seam& S, unsigned* qctr, const NextFn& mkref, bool& has_next) {
    const int tid = mk_tid(), wid = __builtin_amdgcn_readfirstlane(tid >> 6), lane = tid & 63, r32 = lane & 31, hi = lane >> 5;
    const int j_lo = cur.jlo, NT = (cur.P0 + QB - 1) / KVBLK + 1 - j_lo;
    unsigned qv = 0u; if (tid == 0) qv = __hip_atomic_fetch_add(qctr, 1u, __ATOMIC_RELAXED, __HIP_MEMORY_SCOPE_AGENT);
    const int qlo = cur.P0 + wid * QBLK, qm = qlo + r32 - 4 * hi;
    char* V_lds = lds; char* K_lds = lds + 2 * SHM_V; char* B_lds = lds + OFF_BIAS;
    float m_reg = -1e30f, l_reg = 0; f32x16 o[4] = {};
    const int sr = tid >> 4, sc = (tid & 15) * 8, vst0 = v_st(sr, sc), vst1 = v_st(32 + sr, sc), kws = KSWZ(sr, sc * 2);
    const int vb0 = (int)(uintptr_t)V_lds + v_rd_base(lane);
    const bf16* Kh = cur.K; const bf16* Vh = cur.V; const float* Ch = cur.C;
    const float cref = __uint_as_float(__builtin_amdgcn_readfirstlane(__float_as_uint(cur.C[cur.P0])));
#define RESC(a) do { if (__any((a) < 1.f)) { for (int d_ = 0; d_ < 4; ++d_) for (int r = 0; r < 16; ++r) o[d_][r] *= (a); } } while (0)
#define KBASE(t) ((j_lo + (t)) * KVBLK)
#define MASKT(P0_, P1_, t) do { const int kb_ = KBASE(t); if (kb_ + KVBLK - 1 > qlo) mask_tile(P0_, P1_, qm - kb_); } while (0)
    constexpr int NQL = 8;
#define SEAM_K0() do { VMWN(NQL); SWRITE_HK(0, crefn); SBAR(); } while (0)
    f32x16 pA0, pA1, pB0, pB1; float mnA, mnB, alA, alB; bf16x8 pa0, pa1, pa2, pa3;
    SWRITE_HV(0); SBAR();
    if (NT > 1) { SLOAD_H(Kh, Vh, Ch, KBASE(1)); }
    SBAR(); qkt<0>(pA0, pA1, K_lds, B_lds, r32, hi, S.qr);
    MASKT(pA0, pA1, 0); partialSM(pA0, pA1, m_reg, mnA, alA);
    if (NT > 1) { VMW(); SWRITE_H(1, cref); }
    if (tid == 0) *(volatile LAS3 unsigned*)(lds + OFF_QW) = qv;
    __syncthreads();
    const unsigned inext = (unsigned)__builtin_amdgcn_readfirstlane((int)*(volatile LAS3 unsigned*)(lds + OFF_QW)); has_next = inext < (unsigned)(NH * (SEQ / QB));
    const BlockRef nxt = has_next ? mkref((int)inext) : cur;
    const float crefn = __uint_as_float(__builtin_amdgcn_readfirstlane(__float_as_uint(nxt.C[nxt.P0]))); const int kbn = nxt.jlo * KVBLK;
#define HALF_STEP(PX0, PX1, mnX, alX, PY0, PY1, alY, t, KB, VB, SB) do {                                                      \
        SBAR(); qkt<KB>(PX0, PX1, K_lds, B_lds, r32, hi, S.qr);                                                               \
        finishSM(PY0, PY1, alY, l_reg, pa0, pa1, pa2, pa3); SBAR();                                                           \
        if ((t) + 1 < NT) { SLOAD_H(Kh, Vh, Ch, KBASE((t) + 1)); SBAR(); }                                                    \
        pv_tile<VB>(o, vb0, pa0, pa1, pa2, pa3); MASKT(PX0, PX1, (t)); partialSM(PX0, PX1, m_reg, mnX, alX);                  \
        __syncthreads();                                                                                                      \
        if ((t) + 1 < NT) { VMW(); SWRITE_H(SB, cref); }                                                                      \
        RESC(alX); __syncthreads(); } while (0)
    for (int t = 1; t + 1 < NT; t += 2) {
        HALF_STEP(pB0, pB1, mnB, alB, pA0, pA1, alA, t, 1, 0, 0);
        HALF_STEP(pA0, pA1, mnA, alA, pB0, pB1, alB, t + 1, 0, 1, 1);
    }
    const bool even = (NT & 1) == 0;
    if (even) { SBAR(); qkt<1>(pB0, pB1, K_lds, B_lds, r32, hi, S.qr); SBAR(); }
    SLOAD_H(nxt.K, nxt.V, nxt.C, kbn); SBAR();
#pragma unroll
    for (int d0 = 0; d0 < 8; ++d0) S.qr[d0] = load8(nxt.Q + (size_t)(wid * QBLK + r32) * D + d0 * 16 + hi * 8);
    SBAR();
    finishSM(pA0, pA1, alA, l_reg, pa0, pa1, pa2, pa3); SBAR();
    pv_tile<0>(o, vb0, pa0, pa1, pa2, pa3);
    if (even) { MASKT(pB0, pB1, NT - 1); partialSM(pB0, pB1, m_reg, mnB, alB); __syncthreads(); RESC(alB);
        finishSM(pB0, pB1, alB, l_reg, pa0, pa1, pa2, pa3); SBAR(); pv_tile<1>(o, vb0, pa0, pa1, pa2, pa3); }
    SBAR(); SEAM_K0();
    {
        const float rl = __builtin_amdgcn_rcpf(l_reg);
        bf16* Ow = cur.O + (size_t)(wid * QBLK + r32) * OPITCH + 8 * hi;
#pragma unroll
        for (int d0 = 0; d0 < 4; ++d0)
#pragma unroll
            for (int gp = 0; gp < 2; ++gp) { const int b_ = 8 * gp;
                const unsigned a0 = cvtpk(o[d0][b_ + 0] * rl, o[d0][b_ + 1] * rl), a1 = cvtpk(o[d0][b_ + 2] * rl, o[d0][b_ + 3] * rl);
                const unsigned b0 = cvtpk(o[d0][b_ + 4] * rl, o[d0][b_ + 5] * rl), b1 = cvtpk(o[d0][b_ + 6] * rl, o[d0][b_ + 7] * rl);
                auto r0 = __builtin_amdgcn_permlane32_swap(a0, b0, false, false); auto r1 = __builtin_amdgcn_permlane32_swap(a1, b1, false, false);
                u32x4 w = {r0[0], r1[0], r0[1], r1[1]}; *(u32x4*)(Ow + d0 * 32 + 16 * gp) = w; }
    }
    __syncthreads();
    return nxt;
#undef RESC
#undef KBASE
#undef MASKT
#undef SEAM_K0
#undef HALF_STEP
}
#undef ROW
#undef VMW
#undef VMWN
#undef SLOAD_H
#undef SWRITE_HK
#undef SWRITE_HV
#undef SWRITE_H
#undef PK4

__device__ __forceinline__ BlockRef fox_ref(int item, const bf16* Q, const bf16* K, const bf16* V, const float* Cn, bf16* O, const char* lds) {
    const int e = (int)((const unsigned short*)(lds + OFF_ORD))[item], qb = e & 63, bh = e >> 6;
    BlockRef r; r.Q = Q + ((size_t)bh * SEQ + (size_t)qb * QB) * D; r.K = K + (size_t)bh * SEQ * D; r.V = V + (size_t)bh * SEQ * D; r.C = Cn + (size_t)bh * SEQ;
    r.O = O + (size_t)(qb * QB) * OPITCH + bh * D; r.P0 = qb * QB; r.jlo = (int)((const unsigned char*)(lds + OFF_JLO))[bh * 64 + qb]; return r;
}
__device__ __forceinline__ void fox_attn_phase(char* lds, const bf16* Q, const bf16* K, const bf16* V, const float* Cn, const unsigned* nrm2, unsigned* qctr, bf16* O) {
    const int tid = mk_tid();
    {
        int lo[4], hi[4]; float thr[4]; const float* Cb[4];
#pragma unroll
        for (int k = 0; k < 4; ++k) { const int e = tid + 512 * k, bh = e >> 6, qb = e & 63, P0 = qb * QB; Cb[k] = Cn + (size_t)bh * SEQ;
            const float qn2 = __uint_as_float(nrm2[bh]), kn2 = __uint_as_float(nrm2[32 + bh]);
            const float Dh = SKIP_T * (1.0f / SCALE) + 2.04f * sqrtf(qn2 * kn2) + 1.0f;
            thr[k] = Cb[k][P0] - Dh; lo[k] = 0; hi[k] = P0 / KVBLK; }
#pragma unroll 1
        for (int it = 0; it < 8; ++it) {
            float v[4]; int mid[4];
#pragma unroll
            for (int k = 0; k < 4; ++k) { mid[k] = (lo[k] + hi[k]) >> 1; v[k] = Cb[k][mid[k] * KVBLK + KVBLK - 1]; }
#pragma unroll
            for (int k = 0; k < 4; ++k) if (lo[k] < hi[k]) { if (v[k] < thr[k]) lo[k] = mid[k] + 1; else hi[k] = mid[k]; }
        }
#pragma unroll
        for (int k = 0; k < 4; ++k) ((unsigned char*)(lds + OFF_JLO))[tid + 512 * k] = (unsigned char)lo[k];
        unsigned key[4];
#pragma unroll
        for (int k = 0; k < 4; ++k) { const int e = tid + 512 * k, qb = e & 63; key[k] = (unsigned)(4 * qb + 4 - lo[k]) * 2048u + (unsigned)(2047 - e); ((unsigned*)(lds + OFF_KEY))[e] = key[k]; }
        __syncthreads();
        unsigned rank[4] = {0u, 0u, 0u, 0u};
#pragma unroll 4
        for (int j = 0; j < 512; ++j) { const u32x4 kv = ((const u32x4*)(lds + OFF_KEY))[j];
#pragma unroll
            for (int k = 0; k < 4; ++k) rank[k] += (kv.x > key[k] ? 1u : 0u) + (kv.y > key[k] ? 1u : 0u) + (kv.z > key[k] ? 1u : 0u) + (kv.w > key[k] ? 1u : 0u); }
#pragma unroll
        for (int k = 0; k < 4; ++k) ((unsigned short*)(lds + OFF_ORD))[rank[k]] = (unsigned short)(tid + 512 * k);
    }
    if (tid == 0) *(volatile LAS3 unsigned*)(lds + OFF_QW) = __hip_atomic_fetch_add(qctr, 1u, __ATOMIC_RELAXED, __HIP_MEMORY_SCOPE_AGENT);
    __syncthreads();
    const unsigned i0 = (unsigned)__builtin_amdgcn_readfirstlane((int)*(volatile LAS3 unsigned*)(lds + OFF_QW));
    if (i0 >= (unsigned)(NH * (SEQ / QB))) return;
    __syncthreads();
    auto mk = [=](int item) { return fox_ref(item, Q, K, V, Cn, O, lds); };
    BlockRef cur = mk((int)i0);
    Seam S;
    fox_prime(cur, lds, S);
    for (;;) { bool has_next; const BlockRef nxt = fox_block(cur, lds, S, qctr, mk, has_next); if (!has_next) break; cur = nxt; }
}
#undef LAS3
#undef KSWZ
#undef SBAR
}

namespace swa {
constexpr int SEQ = 16384, QKVP = 5120, OP = 4096;
constexpr int K_OFF = 0, VT_OFF = 32768, VT_PITCH = 528, LI_OFF = VT_OFF + 64 * VT_PITCH, LDS_BYTES = LI_OFF + 8 * 32 * 4;
typedef unsigned short bf16;
typedef short bf16x8 __attribute__((ext_vector_type(8)));
typedef float f32x16 __attribute__((ext_vector_type(16)));
typedef float f32x4 __attribute__((ext_vector_type(4)));
typedef unsigned u32x4 __attribute__((ext_vector_type(4)));
__device__ __forceinline__ int crow(int r, int hi) { return (r & 3) + 8 * (r >> 2) + 4 * hi; }
__device__ __forceinline__ unsigned cvtpk(float lo, float hi) { unsigned r; asm volatile("v_cvt_pk_bf16_f32 %0, %1, %2" : "=v"(r) : "v"(lo), "v"(hi)); return r; }
__device__ __forceinline__ float bf2f(short b) { return __uint_as_float(((unsigned)(unsigned short)b) << 16); }
__device__ __forceinline__ bf16x8 pack8(const float* v) { u32x4 w = {cvtpk(v[0], v[1]), cvtpk(v[2], v[3]), cvtpk(v[4], v[5]), cvtpk(v[6], v[7])}; return *reinterpret_cast<bf16x8*>(&w); }
#define SWA_PK4(P, B_, OUT) do { unsigned a0 = cvtpk(P[B_+0], P[B_+1]), a1 = cvtpk(P[B_+2], P[B_+3]);                          \
        unsigned b0 = cvtpk(P[B_+4], P[B_+5]), b1 = cvtpk(P[B_+6], P[B_+7]);                                             \
        auto r0 = __builtin_amdgcn_permlane32_swap(a0, b0, false, false); auto r1 = __builtin_amdgcn_permlane32_swap(a1, b1, false, false); \
        u32x4 w = {r0[0], r1[0], r0[1], r1[1]}; OUT = *reinterpret_cast<bf16x8*>(&w); } while (0)

__device__ __forceinline__ void swa_attn_phase(char* lds, const bf16* QKV, const float* sinks, const float* cosT, const float* sinT, bf16* O, int wg, int G) {
    const int tid = mk_tid(), wid = __builtin_amdgcn_readfirstlane(tid >> 6), lane = tid & 63, r32 = lane & 31, hi = lane >> 5;
    for (int L = wg; L < 1024; L += G) {
        const int g = L & 7, n = L >> 3;
        __syncthreads();
        {
            const int row = tid >> 1, half = tid & 1, kpos = 128 * (n - 1) + row;
            bf16x8 kc[4], vc[4];
            if (kpos >= 0) {
                const bf16* kp = QKV + (size_t)kpos * QKVP + 4096 + g * 64 + half * 32; const bf16* vp = kp + 512;
#pragma unroll
                for (int c = 0; c < 4; ++c) { kc[c] = *(const bf16x8*)(kp + 8 * c); vc[c] = *(const bf16x8*)(vp + 8 * c); }
                if (half == 0) {
                    const f32x4 c0 = *(const f32x4*)(cosT + (size_t)kpos * 8), c1 = *(const f32x4*)(cosT + (size_t)kpos * 8 + 4);
                    const f32x4 s0 = *(const f32x4*)(sinT + (size_t)kpos * 8), s1 = *(const f32x4*)(sinT + (size_t)kpos * 8 + 4);
                    float o1[8], o2[8];
#pragma unroll
                    for (int i = 0; i < 8; ++i) { const float cs = i < 4 ? c0[i & 3] : c1[i & 3], sn = i < 4 ? s0[i & 3] : s1[i & 3];
                        const float x1 = bf2f(kc[0][i]), x2 = bf2f(kc[1][i]); o1[i] = x1 * cs - x2 * sn; o2[i] = x2 * cs + x1 * sn; }
                    kc[0] = pack8(o1); kc[1] = pack8(o2);
                }
            } else {
#pragma unroll
                for (int c = 0; c < 4; ++c) { kc[c] = (bf16x8){0, 0, 0, 0, 0, 0, 0, 0}; vc[c] = (bf16x8){0, 0, 0, 0, 0, 0, 0, 0}; }
            }
#pragma unroll
            for (int c = 0; c < 4; ++c) { const int chunk = half * 4 + c;
                *(bf16x8*)(lds + K_OFF + row * 128 + ((chunk ^ ((row >> 1) & 7)) << 4)) = kc[c];
#pragma unroll
                for (int j = 0; j < 8; ++j) *(short*)(lds + VT_OFF + (half * 32 + c * 8 + j) * VT_PITCH + row * 2) = vc[c][j]; }
        }
        __syncthreads();
        const int hq = g * 8 + wid; const float sink = sinks[hq];
        for (int a = 0; a < 4; ++a) {
            const int t = 128 * n + 32 * a + r32;
            const bf16* qp = QKV + (size_t)t * QKVP + hq * 64;
            bf16x8 qr[4];
#pragma unroll
            for (int d0 = 0; d0 < 4; ++d0) qr[d0] = *(const bf16x8*)(qp + 16 * d0 + 8 * hi);
            {
                const bf16x8 pr = *(const bf16x8*)(qp + 8 * (1 - hi));
                const f32x4 c0 = *(const f32x4*)(cosT + (size_t)t * 8), c1 = *(const f32x4*)(cosT + (size_t)t * 8 + 4);
                const f32x4 s0 = *(const f32x4*)(sinT + (size_t)t * 8), s1 = *(const f32x4*)(sinT + (size_t)t * 8 + 4);
                float ov[8];
#pragma unroll
                for (int i = 0; i < 8; ++i) { const float cs = i < 4 ? c0[i & 3] : c1[i & 3], sn = i < 4 ? s0[i & 3] : s1[i & 3];
                    const float own = bf2f(qr[0][i]), par = bf2f(pr[i]); ov[i] = own * cs + (hi ? par : -par) * sn; }
                qr[0] = pack8(ov);
            }
            f32x16 p[5];
#pragma unroll
            for (int bi = 0; bi < 5; ++bi) { const int row = 32 * (a + bi) + r32; const char* kb = lds + K_OFF + row * 128; const int sw = (row >> 1) & 7;
                f32x16 acc = {};
#pragma unroll
                for (int d0 = 0; d0 < 4; ++d0) { const bf16x8 kf = *(const bf16x8*)(kb + (((2 * d0 + hi) ^ sw) << 4)); acc = __builtin_amdgcn_mfma_f32_32x32x16_bf16(kf, qr[d0], acc, 0, 0, 0); }
                p[bi] = acc; }
            const float NEG = -__builtin_inff();
#pragma unroll
            for (int r = 0; r < 16; ++r) { const int c = crow(r, hi); if (!(c > r32)) p[0][r] = NEG; if (!(c <= r32)) p[4][r] = NEG; }
            if (n == 0) {
#pragma unroll
                for (int bi = 0; bi < 4; ++bi) if (a + bi < 4) {
#pragma unroll
                    for (int r = 0; r < 16; ++r) p[bi][r] = NEG; }
            }
            float mx = NEG;
#pragma unroll
            for (int bi = 0; bi < 5; ++bi)
#pragma unroll
                for (int r = 0; r < 16; ++r) mx = fmaxf(mx, p[bi][r]);
            { auto rr = __builtin_amdgcn_permlane32_swap(__float_as_uint(mx), __float_as_uint(mx), false, false); mx = fmaxf(__uint_as_float(rr[0]), __uint_as_float(rr[1])); }
            const float m = fmaxf(mx * 0.125f, sink);
            constexpr float LOG2E = 1.4426950408889634f, C2 = 0.125f * LOG2E;
            const float mL = -m * LOG2E;
            float ps = 0.f;
#pragma unroll
            for (int bi = 0; bi < 5; ++bi)
#pragma unroll
                for (int r = 0; r < 16; ++r) { const float e = __builtin_amdgcn_exp2f(fmaf(p[bi][r], C2, mL)); p[bi][r] = e; ps += e; }
            { auto rr = __builtin_amdgcn_permlane32_swap(__float_as_uint(ps), __float_as_uint(ps), false, false); ps = __uint_as_float(rr[0]) + __uint_as_float(rr[1]); }
            const float l = ps + __builtin_amdgcn_exp2f(fmaf(sink, LOG2E, mL));
            f32x16 o[2] = {};
#pragma unroll
            for (int bi = 0; bi < 5; ++bi) { bf16x8 pa[2]; SWA_PK4(p[bi], 0, pa[0]); SWA_PK4(p[bi], 8, pa[1]);
#pragma unroll
                for (int ks = 0; ks < 2; ++ks)
#pragma unroll
                    for (int db = 0; db < 2; ++db) { const bf16x8 vf = *(const bf16x8*)(lds + VT_OFF + (32 * db + r32) * VT_PITCH + (32 * (a + bi) + 16 * ks + 8 * hi) * 2);
                        o[db] = __builtin_amdgcn_mfma_f32_32x32x16_bf16(vf, pa[ks], o[db], 0, 0, 0); } }
            const float rl = __builtin_amdgcn_rcpf(l);
            bf16* Ow = O + (size_t)(128 * n + 32 * a + r32) * OP + hq * 64 + 8 * hi;
#pragma unroll
            for (int db = 0; db < 2; ++db)
#pragma unroll
                for (int gp = 0; gp < 2; ++gp) { const int b_ = 8 * gp;
                    const unsigned a0 = cvtpk(o[db][b_ + 0] * rl, o[db][b_ + 1] * rl), a1 = cvtpk(o[db][b_ + 2] * rl, o[db][b_ + 3] * rl);
                    const unsigned b0 = cvtpk(o[db][b_ + 4] * rl, o[db][b_ + 5] * rl), b1 = cvtpk(o[db][b_ + 6] * rl, o[db][b_ + 7] * rl);
                    auto r0 = __builtin_amdgcn_permlane32_swap(a0, b0, false, false); auto r1 = __builtin_amdgcn_permlane32_swap(a1, b1, false, false);
                    u32x4 w = {r0[0], r1[0], r0[1], r1[1]}; *(u32x4*)(Ow + db * 32 + 16 * gp) = w; }
        }
    }
    __syncthreads();
}
#undef SWA_PK4
}

#define LAS __attribute__((address_space(3)))
#define GAS __attribute__((address_space(1)))
typedef unsigned short bf16;
typedef float f32x4 __attribute__((ext_vector_type(4)));
typedef unsigned u32x4 __attribute__((ext_vector_type(4)));
typedef unsigned u32x2 __attribute__((ext_vector_type(2)));
typedef short bf16x8 __attribute__((ext_vector_type(8)));
constexpr int SEQ = 16384, DM = 4096, DFF = 11008;
constexpr float NORM_EPS = 1e-6f;
__device__ __forceinline__ unsigned cvtpk(float lo, float hi) { unsigned r; asm volatile("v_cvt_pk_bf16_f32 %0, %1, %2" : "=v"(r) : "v"(lo), "v"(hi)); return r; }
__device__ __forceinline__ float bf_lo(unsigned w) { return __uint_as_float(w << 16); }
__device__ __forceinline__ float bf_hi(unsigned w) { return __uint_as_float(w & 0xffff0000u); }
__device__ __forceinline__ float wave_sum(float v) {
#pragma unroll
    for (int o = 1; o < 64; o <<= 1) v += __shfl_xor(v, o);
    return v;
}
__device__ __forceinline__ float gelu_tanh(float x) {
    const float u = 0.7978845608028654f * (x + 0.044715f * x * x * x);
    return x * __builtin_amdgcn_rcpf(1.0f + __builtin_amdgcn_exp2f(-2.8853900817779268f * u));
}
__device__ __forceinline__ void sincos_d(double a, double& s, double& c) {
    const double k = rint(a * 0.15915494309189535);
    double r = fma(-k, 6.283185307179586, a); r = fma(-k, 2.4492935982947064e-16, r);
    const double r2 = r * r; double ss = 1.0, cc = 1.0;
#pragma unroll
    for (int n = 29; n >= 3; n -= 2) ss = fma(-ss * r2, 1.0 / (double)(n * (n - 1)), 1.0);
#pragma unroll
    for (int n = 28; n >= 2; n -= 2) cc = fma(-cc * r2, 1.0 / (double)(n * (n - 1)), 1.0);
    s = r * ss; c = cc;
}
__device__ __forceinline__ double exp_d(double x) {
    const double k = rint(x * 1.4426950408889634);
    double r = fma(-k, 0.6931471803691238, x); r = fma(-k, 1.9082149292705877e-10, r);
    double p = 1.0;
#pragma unroll
    for (int n = 16; n >= 1; --n) p = fma(p * r, 1.0 / (double)n, 1.0);
    return ldexp(p, (int)k);
}

__device__ __forceinline__ void transpose_item(const float* __restrict__ W, int K, int N, bf16* __restrict__ WT, int mode, LAS unsigned* scr, int item, int lane) {
    const int nblk = (N + 63) / 64, kb = item / nblk, nb = item - kb * nblk, k0 = 128 * kb, n0 = 64 * nb;
    int r0 = n0; if (mode == 1) { const int bj = n0 >> 12, rem = n0 & 4095; r0 = ((rem >> 7) << 8) + (bj << 7) + (rem & 127); }
    if (mode == 2) { const int bj = n0 >= DFF ? 1 : 0, rem = n0 - bj * DFF; r0 = ((rem >> 7) << 8) + (bj << 7) + (rem & 127); }
    const int c = lane & 15, kq = lane >> 4;
    const bool ok = n0 + 4 * c < N;
    const float* src = W + (size_t)(k0 + 2 * kq) * N + n0 + 4 * c;
    LAS unsigned* sw = scr + (4 * c) * 65 + kq;
#pragma unroll
    for (int half = 0; half < 2; ++half) {
        f32x4 a[8], b[8]; const f32x4 z = {0.f, 0.f, 0.f, 0.f};
#pragma unroll
        for (int p = 0; p < 8; ++p) { const float* s = src + (size_t)(8 * (8 * half + p)) * N;
            a[p] = ok ? __builtin_nontemporal_load((const f32x4*)s) : z; b[p] = ok ? __builtin_nontemporal_load((const f32x4*)(s + N)) : z; }
#pragma unroll
        for (int p = 0; p < 8; ++p)
#pragma unroll
            for (int q = 0; q < 4; ++q) sw[q * 65 + 4 * (8 * half + p)] = cvtpk(a[p][q], b[p][q]);
    }
    asm volatile("s_waitcnt lgkmcnt(0)" ::: "memory");
#pragma unroll
    for (int j = 0; j < 16; ++j) { const int n = 4 * j + kq; const LAS unsigned* s = scr + n * 65 + 4 * c;
        u32x4 o; o.x = s[0]; o.y = s[1]; o.z = s[2]; o.w = s[3];
        if (n0 + n < N) *(u32x4*)(WT + (size_t)(r0 + n) * K + k0 + 8 * c) = o; }
    asm volatile("s_waitcnt lgkmcnt(0)" ::: "memory");
}

__device__ __forceinline__ float f8_clamp(float v) { return __builtin_fminf(__builtin_fmaxf(v, -448.f), 448.f); }
__device__ __forceinline__ unsigned f8_pack4(float a, float b, float c, float d) {
    int w = 0; w = __builtin_amdgcn_cvt_pk_fp8_f32(f8_clamp(a), f8_clamp(b), w, false); w = __builtin_amdgcn_cvt_pk_fp8_f32(f8_clamp(c), f8_clamp(d), w, true); return (unsigned)w; }
__device__ __forceinline__ unsigned i8_pack4(float a, float b, float c, float d) {
    const int q0 = (int)__builtin_rintf(__builtin_fminf(__builtin_fmaxf(a, -127.f), 127.f)), q1 = (int)__builtin_rintf(__builtin_fminf(__builtin_fmaxf(b, -127.f), 127.f));
    const int q2 = (int)__builtin_rintf(__builtin_fminf(__builtin_fmaxf(c, -127.f), 127.f)), q3 = (int)__builtin_rintf(__builtin_fminf(__builtin_fmaxf(d, -127.f), 127.f));
    return ((unsigned)q0 & 255u) | (((unsigned)q1 & 255u) << 8) | (((unsigned)q2 & 255u) << 16) | ((unsigned)q3 << 24); }
__device__ __forceinline__ float wave_max(float v) {
#pragma unroll
    for (int o = 1; o < 64; o <<= 1) v = fmaxf(v, __shfl_xor(v, o));
    return v;
}
__device__ __forceinline__ void transpose_item_f8(const float* __restrict__ W, int K, int N, unsigned char* __restrict__ WT, int mode, LAS unsigned* scr, int item, int lane, float scale, int qm = 1) {
    const int nblk = (N + 63) / 64, kb = item / nblk, nb = item - kb * nblk, k0 = 128 * kb, n0 = 64 * nb;
    int r0 = n0; if (mode == 1) { const int bj = n0 >> 12, rem = n0 & 4095; r0 = ((rem >> 7) << 8) + (bj << 7) + (rem & 127); }
    if (mode == 2) { const int bj = n0 >= DFF ? 1 : 0, rem = n0 - bj * DFF; r0 = ((rem >> 7) << 8) + (bj << 7) + (rem & 127); }
    const int c = lane & 15, kq = lane >> 4;
    const bool ok = n0 + 4 * c < N;
    const float* src = W + (size_t)(k0 + 4 * kq) * N + n0 + 4 * c;
    LAS unsigned* sw = scr + (4 * c) * 33 + kq;
#pragma unroll
    for (int half = 0; half < 2; ++half) {
        f32x4 a[4][4]; const f32x4 z = {0.f, 0.f, 0.f, 0.f};
#pragma unroll
        for (int p = 0; p < 4; ++p)
#pragma unroll
            for (int r = 0; r < 4; ++r) { const float* s = src + (size_t)(16 * (4 * half + p) + r) * N; a[p][r] = ok ? __builtin_nontemporal_load((const f32x4*)s) : z; }
#pragma unroll
        for (int p = 0; p < 4; ++p)
#pragma unroll
            for (int q = 0; q < 4; ++q) sw[q * 33 + 4 * (4 * half + p)] = qm == 2 ? i8_pack4(a[p][0][q] * scale, a[p][1][q] * scale, a[p][2][q] * scale, a[p][3][q] * scale)
                                                                             : f8_pack4(a[p][0][q] * scale, a[p][1][q] * scale, a[p][2][q] * scale, a[p][3][q] * scale);
    }
    asm volatile("s_waitcnt lgkmcnt(0)" ::: "memory");
#pragma unroll
    for (int j = 0; j < 8; ++j) { const int n = 8 * j + (lane >> 3), c8 = lane & 7; const LAS unsigned* s = scr + n * 33 + 4 * c8;
        u32x4 o; o.x = s[0]; o.y = s[1]; o.z = s[2]; o.w = s[3];
        if (n0 + n < N) *(u32x4*)(WT + (size_t)(r0 + n) * K + k0 + 16 * c8) = o; }
    asm volatile("s_waitcnt lgkmcnt(0)" ::: "memory");
}

struct HPlanes { unsigned char* hi; unsigned char* lo; };
template <int HIN, int HOUT>
__device__ __forceinline__ void norm_phase(int gw, int ngw, int lane, LAS unsigned char* stg, const bf16* tmp, const float* gpost, const float* hin, float* hout, HPlanes hp, const float* gpre, bf16* xn, bf16* U, float tscale = 1.0f, unsigned char* xn8 = nullptr, float x8scale = 1.0f, float* rs8 = nullptr) {
    LAS unsigned char* sA = stg;
    for (int m = gw; m < SEQ; m += ngw) {
        f32x4 h[16];
        u32x4 tq[8]; float ss = 0.f;
        if (tmp) { const u32x4* tr = (const u32x4*)(tmp + (size_t)m * DM) + lane;
#pragma unroll
            for (int j = 0; j < 8; ++j) tq[j] = __builtin_nontemporal_load(tr + 64 * j); }
        if constexpr (HIN == 0) {
            const f32x4* hr = (const f32x4*)(hin + (size_t)m * DM) + lane;
#pragma unroll
            for (int j = 0; j < 16; ++j) h[j] = __builtin_nontemporal_load(hr + 64 * j);
        } else {
            const u32x4* hr = (const u32x4*)(hp.hi + (size_t)m * 8192) + lane; const u32x4* lr = (const u32x4*)(hp.lo + (size_t)m * 2048) + lane; u32x4 hq[8], lq[2];
#pragma unroll
            for (int i = 0; i < 8; ++i) hq[i] = __builtin_nontemporal_load(hr + 64 * i);
#pragma unroll
            for (int c = 0; c < 2; ++c) lq[c] = __builtin_nontemporal_load(lr + 64 * c);
#pragma unroll
            for (int j = 0; j < 16; ++j) { const unsigned w0 = hq[j >> 1][2 * (j & 1)], w1 = hq[j >> 1][2 * (j & 1) + 1], lw = lq[j >> 3][(j >> 1) & 3]; const int sh = 16 * (j & 1);
                h[j] = (f32x4){__uint_as_float((w0 << 16) | (((lw >> sh) & 15u) << 12)), __uint_as_float((w0 & 0xffff0000u) | (((lw >> (sh + 4)) & 15u) << 12)),
                               __uint_as_float((w1 << 16) | (((lw >> (sh + 8)) & 15u) << 12)), __uint_as_float((w1 & 0xffff0000u) | (((lw >> (sh + 12)) & 15u) << 12))}; }
        }
        if (tmp) {
#pragma unroll
            for (int j = 0; j < 8; ++j) {
#pragma unroll
                for (int q = 0; q < 4; ++q) { const float a = bf_lo(tq[j][q]), b = bf_hi(tq[j][q]); ss += a * a + b * b; }
                *(LAS u32x4*)(sA + 1024 * j + 16 * lane) = tq[j]; }
            asm volatile("" ::: "memory");
            const float r = tscale / sqrtf(wave_sum(ss) * (1.0f / DM) + NORM_EPS);
            const f32x4* gp = (const f32x4*)gpost + lane; asm volatile("" : "+v"(gp));
#pragma unroll
            for (int j = 0; j < 16; ++j) { const u32x2 w = *(const LAS u32x2*)(sA + 512 * j + 8 * lane); const f32x4 t = {bf_lo(w.x), bf_hi(w.x), bf_lo(w.y), bf_hi(w.y)};
                h[j] = h[j] + (t * r) * gp[64 * j]; }
            asm volatile("" ::: "memory");
            if constexpr (HOUT == 0) { f32x4* ho = (f32x4*)(hout + (size_t)m * DM) + lane;
#pragma unroll
                for (int j = 0; j < 16; ++j) __builtin_nontemporal_store(h[j], ho + 64 * j); }
            if constexpr (HOUT == 1) {
                u32x4* ho = (u32x4*)(hp.hi + (size_t)m * 8192) + lane; u32x4* lo = (u32x4*)(hp.lo + (size_t)m * 2048) + lane; u32x4 lq[2];
#pragma unroll
                for (int i = 0; i < 8; ++i) { u32x4 o; unsigned lw = 0u;
#pragma unroll
                    for (int jj = 0; jj < 2; ++jj) { const int j = 2 * i + jj;
                        const unsigned b0 = __float_as_uint(h[j].x) + 0x800u, b1 = __float_as_uint(h[j].y) + 0x800u, b2 = __float_as_uint(h[j].z) + 0x800u, b3 = __float_as_uint(h[j].w) + 0x800u;
                        o[2 * jj] = __builtin_amdgcn_perm(b1, b0, 0x07060302u); o[2 * jj + 1] = __builtin_amdgcn_perm(b3, b2, 0x07060302u);
                        lw |= (((b0 >> 12) & 15u) | (((b1 >> 12) & 15u) << 4) | (((b2 >> 12) & 15u) << 8) | (((b3 >> 12) & 15u) << 12)) << (16 * jj); }
                    __builtin_nontemporal_store(o, ho + 64 * i); lq[i >> 2][i & 3] = lw; }
#pragma unroll
                for (int c = 0; c < 2; ++c) __builtin_nontemporal_store(lq[c], lo + 64 * c); }
        }
        if (gpre) {
            float s2 = 0.f;
#pragma unroll
            for (int j = 0; j < 16; ++j) s2 += (h[j].x * h[j].x + h[j].y * h[j].y) + (h[j].z * h[j].z + h[j].w * h[j].w);
            const float r = 1.0f / sqrtf(wave_sum(s2) * (1.0f / DM) + NORM_EPS);
            const f32x4* gp = (const f32x4*)gpre + lane; asm volatile("" : "+v"(gp));
            if (xn) { u32x4* o16 = (u32x4*)(xn + (size_t)m * DM) + lane;
                asm volatile("" ::: "memory");
#pragma unroll
                for (int j = 0; j < 16; ++j) { const f32x4 v = (h[j] * r) * gp[64 * j]; u32x2 w; w.x = cvtpk(v.x, v.y); w.y = cvtpk(v.z, v.w); *(LAS u32x2*)(sA + 512 * j + 8 * lane) = w; }
                asm volatile("" ::: "memory");
#pragma unroll
                for (int j = 0; j < 8; ++j) o16[64 * j] = *(const LAS u32x4*)(sA + 1024 * j + 16 * lane);
                asm volatile("" ::: "memory"); }
            if (xn8) { u32x4* o16 = (u32x4*)(xn8 + (size_t)m * DM) + lane; float r8 = r * x8scale;
                if (rs8) { float amax = 0.f;
#pragma unroll
                    for (int j = 0; j < 16; ++j) { const f32x4 v = (h[j] * r) * gp[64 * j]; amax = fmaxf(fmaxf(amax, fmaxf(fabsf(v.x), fabsf(v.y))), fmaxf(fabsf(v.z), fabsf(v.w))); }
                    amax = wave_max(amax); r8 = amax > 0.f ? r * (127.f / amax) : 0.f;
                    if (lane == 0) { rs8[m + 2] = amax * (1.0f / 127.f); if (m == 0) { rs8[0] = 0.f; rs8[1] = 0.f; } }
                    asm volatile("" : "+v"(gp)); }
                asm volatile("" ::: "memory");
#pragma unroll
                for (int j = 0; j < 16; ++j) { const f32x4 v = (h[j] * r8) * gp[64 * j]; *(LAS unsigned*)(sA + 256 * j + 4 * lane) = rs8 ? i8_pack4(v.x, v.y, v.z, v.w) : f8_pack4(v.x, v.y, v.z, v.w); }
                asm volatile("" ::: "memory");
#pragma unroll
                for (int i = 0; i < 4; ++i) o16[64 * i] = *(const LAS u32x4*)(sA + 1024 * i + 16 * lane);
                asm volatile("" ::: "memory"); }
            if (U) {
#pragma unroll
                for (int j = 0; j < 16; ++j) { const f32x4 v = (h[j] * r) * gp[64 * j]; u32x2 w; w.x = cvtpk(v.x, v.y); w.y = cvtpk(v.z, v.w);
                    *(u32x2*)(U + ((size_t)((lane >> 2) + 16 * j) * SEQ + m) * 16 + 4 * (lane & 3)) = w; } }
        }
    }
}

__device__ __forceinline__ void fox_cumsum_phase(char* lds, const float* __restrict__ logf, float* __restrict__ cneg, int wg, int G, int tid) {
    double* wtot = (double*)lds; const int lane = tid & 63, wid = tid >> 6;
    for (int h = wg; h < 32; h += G) {
        float v[32]; double s = 0.0;
#pragma unroll
        for (int j = 0; j < 32; ++j) { v[j] = logf[(size_t)(32 * tid + j) * 32 + h]; s += (double)v[j]; }
        double inc = s;
#pragma unroll
        for (int o = 1; o < 64; o <<= 1) { const double t = __shfl_up(inc, o); if (lane >= o) inc += t; }
        __syncthreads();
        if (lane == 63) wtot[wid] = inc;
        __syncthreads();
        double run = inc - s;
#pragma unroll
        for (int w = 0; w < 8; ++w) if (w < wid) run += wtot[w];
#pragma unroll
        for (int j = 0; j < 32; ++j) { run += (double)v[j]; cneg[(size_t)h * SEQ + 32 * tid + j] = (float)(-run * 11.313708498984761); }
    }
}

__device__ __forceinline__ void fox_norms_phase(const bf16* __restrict__ QK, unsigned* nrm2, int gw, int ngw, int lane) {
    for (int base = gw * 128; base < 64 * SEQ; base += ngw * 128) {
        const u32x4* p = (const u32x4*)(QK + (size_t)base * 128) + lane; float mx = 0.f;
#pragma unroll 8
        for (int i = 0; i < 32; ++i) { const u32x4 w = p[(size_t)i * 64]; float s = 0.f;
#pragma unroll
            for (int q = 0; q < 4; ++q) { const float a = bf_lo(w[q]), b = bf_hi(w[q]); s = fmaf(a, a, s); s = fmaf(b, b, s); }
            s += __shfl_xor(s, 1); s += __shfl_xor(s, 2); s += __shfl_xor(s, 4); s += __shfl_xor(s, 8); mx = fmaxf(mx, s); }
        mx = fmaxf(mx, __shfl_xor(mx, 16)); mx = fmaxf(mx, __shfl_xor(mx, 32));
        if (lane == 0) __hip_atomic_fetch_max(nrm2 + base / SEQ, __float_as_uint(mx), __ATOMIC_RELAXED, __HIP_MEMORY_SCOPE_AGENT);
    }
}

namespace s5 {
typedef float f32x16 __attribute__((ext_vector_type(16)));
constexpr int NG = 256, SEGL = 2048, XP = 272, WAVE_BYTES = 2048 + 32 * XP, E_OFF = 8 * WAVE_BYTES, LDS_BYTES = E_OFF + 8 * 128 * 4;
__device__ __forceinline__ bf16x8 pack8(f32x4 a, f32x4 b) { u32x4 w = {cvtpk(a[0], a[1]), cvtpk(a[2], a[3]), cvtpk(b[0], b[1]), cvtpk(b[2], b[3])}; return *reinterpret_cast<bf16x8*>(&w); }
__device__ __forceinline__ void state_consts(float lam_re_raw, float lam_im_raw, double dt, double& lbr, double& lbi, double& cfr, double& cfi, double& lre_o, double& lim_o) {
    const double lre = (double)fminf(lam_re_raw, -1e-4f), lim = (double)lam_im_raw; double sn, cs; sincos_d(lim * dt, sn, cs); const double er = exp_d(lre * dt);
    lbr = er * cs; lbi = er * sn; const double a = lbr - 1.0, b = lbi, den = 1.0 / (lre * lre + lim * lim); cfr = (a * lre + b * lim) * den; cfi = (b * lre - a * lim) * den; lre_o = lre; lim_o = lim;
}
__device__ __forceinline__ void s5_phase(char* lds, const bf16* __restrict__ U, const float* __restrict__ lam_re, const float* __restrict__ lam_im, const float* __restrict__ log_dt,
                                         const float* __restrict__ b_re, const float* __restrict__ b_im, const float* __restrict__ c_re, const float* __restrict__ c_im,
                                         const float* __restrict__ dskip, bf16* __restrict__ Gout, int wg, int G) {
    const int tid = mk_tid(), wid = __builtin_amdgcn_readfirstlane(tid >> 6), lane = tid & 63, r32 = lane & 31, hi = lane >> 5, l15 = lane & 15, q4 = lane >> 4;
    float* ublk = (float*)(lds + wid * WAVE_BYTES); char* xblk = lds + wid * WAVE_BYTES + 2048; float* Ebuf = (float*)(lds + E_OFF);
    for (int g = wg; g < NG; g += G) {
        float lr, li, l2r, l2i; bf16x8 Bf[4], Cf[4]; const float dsk = dskip[16 * g + l15];
        {
            const double dt = exp_d((double)log_dt[g]);
            { double lbr, lbi, cfr, cfi, lre, lim; state_consts(lam_re[g * 64 + lane], lam_im[g * 64 + lane], dt, lbr, lbi, cfr, cfi, lre, lim); lr = (float)lbr; li = (float)lbi;
              double sn2, cs2; sincos_d(lim * dt * (double)SEGL, sn2, cs2); const double e2 = exp_d(lre * dt * (double)SEGL); l2r = (float)(e2 * cs2); l2i = (float)(e2 * sn2); }
#pragma unroll
            for (int sb = 0; sb < 2; ++sb) { const int st = 32 * sb + r32; double lbr, lbi, cfr, cfi, lre, lim; state_consts(lam_re[g * 64 + st], lam_im[g * 64 + st], dt, lbr, lbi, cfr, cfi, lre, lim);
                const f32x4* br = (const f32x4*)(b_re + ((size_t)g * 64 + st) * 16 + 8 * hi); const f32x4* bi = (const f32x4*)(b_im + ((size_t)g * 64 + st) * 16 + 8 * hi);
                const f32x4 vr0 = br[0], vr1 = br[1], vi0 = bi[0], vi1 = bi[1]; f32x4 or0, or1, oi0, oi1;
#pragma unroll
                for (int i = 0; i < 4; ++i) { or0[i] = (float)(cfr * (double)vr0[i] - cfi * (double)vi0[i]); or1[i] = (float)(cfr * (double)vr1[i] - cfi * (double)vi1[i]);
                                              oi0[i] = (float)(cfr * (double)vi0[i] + cfi * (double)vr0[i]); oi1[i] = (float)(cfr * (double)vi1[i] + cfi * (double)vr1[i]); }
                Bf[sb] = pack8(or0, or1); Bf[2 + sb] = pack8(oi0, oi1); }
#pragma unroll
            for (int kk = 0; kk < 4; ++kk) { const float* cp = (kk < 2 ? c_re : c_im) + ((size_t)g * 16 + l15) * 64 + 32 * (kk & 1) + 8 * q4; const float sg = kk < 2 ? 1.f : -1.f;
                const f32x4 v0 = *(const f32x4*)cp, v1 = *(const f32x4*)(cp + 4); Cf[kk] = pack8(v0 * sg, v1 * sg); }
        }
        const bf16* Ug = U + ((size_t)g * SEQ + (size_t)wid * SEGL) * 16;
        float xr = 0.f, xi = 0.f;
#pragma unroll 1
        for (int pass = 0; pass < 2; ++pass) {
#define S5_ULOAD(d0, d1, blk_) do { const u32x4 ub_ = *(const u32x4*)(Ug + ((size_t)(blk_) * 32 + r32) * 16 + 8 * hi);                                                     \
                d0 = (f32x4){bf_lo(ub_.x), bf_hi(ub_.x), bf_lo(ub_.y), bf_hi(ub_.y)}; d1 = (f32x4){bf_lo(ub_.z), bf_hi(ub_.z), bf_lo(ub_.w), bf_hi(ub_.w)}; } while (0)
            f32x4 ua0, ua1; S5_ULOAD(ua0, ua1, 0);
#pragma unroll 1
            for (int blk = 0; blk < SEGL / 32; ++blk) {
                f32x4 un0 = ua0, un1 = ua1;
                if (blk + 1 < SEGL / 32) S5_ULOAD(un0, un1, blk + 1);
                const bf16x8 af = pack8(ua0, ua1);
                if (pass) { *(f32x4*)(ublk + r32 * 16 + 8 * hi) = ua0; *(f32x4*)(ublk + r32 * 16 + 8 * hi + 4) = ua1; }
                f32x16 a0 = {}, a1 = {}, a2 = {}, a3 = {};
                a0 = __builtin_amdgcn_mfma_f32_32x32x16_bf16(af, Bf[0], a0, 0, 0, 0); a1 = __builtin_amdgcn_mfma_f32_32x32x16_bf16(af, Bf[1], a1, 0, 0, 0);
                a2 = __builtin_amdgcn_mfma_f32_32x32x16_bf16(af, Bf[2], a2, 0, 0, 0); a3 = __builtin_amdgcn_mfma_f32_32x32x16_bf16(af, Bf[3], a3, 0, 0, 0);
#pragma unroll
                for (int r = 0; r < 16; ++r) { auto t0 = __builtin_amdgcn_permlane32_swap(__float_as_uint(a0[r]), __float_as_uint(a1[r]), false, false); a0[r] = __uint_as_float(t0[0]); a1[r] = __uint_as_float(t0[1]);
                                               auto t1 = __builtin_amdgcn_permlane32_swap(__float_as_uint(a2[r]), __float_as_uint(a3[r]), false, false); a2[r] = __uint_as_float(t1[0]); a3[r] = __uint_as_float(t1[1]); }
#pragma unroll
                for (int s = 0; s < 32; ++s) { const int h = (s >> 2) & 1, r = (s & 3) + 4 * (s >> 3); const float bre = h ? a1[r] : a0[r], bim = h ? a3[r] : a2[r];
                    const float nr = fmaf(lr, xr, fmaf(-li, xi, bre)), ni = fmaf(lr, xi, fmaf(li, xr, bim)); xr = nr; xi = ni;
                    if (pass) { const unsigned pk = cvtpk(xr, xi); *(unsigned short*)(xblk + s * XP + lane * 2) = (unsigned short)pk; *(unsigned short*)(xblk + s * XP + 128 + lane * 2) = (unsigned short)(pk >> 16); } }
                if (pass) {
#pragma unroll
                    for (int rb = 0; rb < 2; ++rb) { f32x4 acc = {0.f, 0.f, 0.f, 0.f};
#pragma unroll
                        for (int kk = 0; kk < 4; ++kk) { const bf16x8 xa = *(const bf16x8*)(xblk + (16 * rb + l15) * XP + (32 * kk + 8 * q4) * 2); acc = __builtin_amdgcn_mfma_f32_16x16x32_bf16(xa, Cf[kk], acc, 0, 0, 0); }
#pragma unroll
                        for (int i = 0; i < 4; ++i) { const int sl = 16 * rb + 4 * q4 + i; const float uv = ublk[sl * 16 + l15];
                            const float v = gelu_tanh(acc[i] + dsk * uv); const float vn = __shfl_xor(v, 1);
                            if ((l15 & 1) == 0) *(unsigned*)(Gout + ((size_t)wid * SEGL + blk * 32 + sl) * DM + 16 * g + l15) = cvtpk(v, vn); } }
                }
                ua0 = un0; ua1 = un1;
            }
            if (pass == 0) {
                Ebuf[wid * 128 + lane] = xr; Ebuf[wid * 128 + 64 + lane] = xi;
                __syncthreads();
                float sr = 0.f, si = 0.f;
                for (int v = 0; v < wid; ++v) { const float er = Ebuf[v * 128 + lane], ei = Ebuf[v * 128 + 64 + lane];
                    const float nr = fmaf(l2r, sr, fmaf(-l2i, si, er)), ni = fmaf(l2r, si, fmaf(l2i, sr, ei)); sr = nr; si = ni; }
                xr = sr; xi = si;
            }
        }
        __syncthreads();
    }
}
#undef S5_ULOAD
}
#define XB_TMO      128
#define XB_XCNT(j)  (256  + 64 * (j))
#define XB_XSUB(j)  (1280 + 64 * (j))
#define XB_XGEN(j)  (2304 + 64 * (j))
#define XB_TOP      3328
#define XB_TOPGEN   3392
#define XCD_BAR_WORDS 3456
#define XB_SPIN_CAP (1u << 18)

__device__ __forceinline__ unsigned xb_ld(unsigned* p)              { return __hip_atomic_load(p, __ATOMIC_RELAXED, __HIP_MEMORY_SCOPE_AGENT); }
__device__ __forceinline__ unsigned xb_add(unsigned* p, unsigned v) { return __hip_atomic_fetch_add(p, v, __ATOMIC_RELAXED, __HIP_MEMORY_SCOPE_AGENT); }
__device__ __forceinline__ unsigned xb_xcc_id() { return (unsigned)__builtin_amdgcn_s_getreg((3 << 11) | 20) & 0xFu; }
#define XB_SPIN(cond, bar) do { unsigned _sp = 0; while (cond) { __builtin_amdgcn_s_sleep(1); \
    if ((++_sp & 255u) == 0u) { if (xb_ld(&(bar)[XB_TMO])) break; if (_sp > XB_SPIN_CAP) { atomicAdd(&(bar)[XB_TMO], 1u); break; } } } } while (0)

struct XcdBarrier {
    unsigned* bar; unsigned x;
    volatile LAS unsigned* st;
};

__device__ __forceinline__ XcdBarrier xcd_barrier_post(unsigned* bar, volatile LAS unsigned* st) {
    XcdBarrier b; b.bar = bar; b.x = xb_xcc_id(); b.st = st;
    if (threadIdx.x == 0) (void)xb_add(&bar[XB_XCNT(b.x)], 1u);
    return b;
}
__device__ __forceinline__ void xcd_barrier_complete(unsigned* bar, unsigned x, unsigned& nloc, unsigned& nx) {
    const unsigned G = gridDim.x * gridDim.y * gridDim.z;
    unsigned sum, cnt, mine, sp = 0u;
    for (;;) {
        sum = 0u; cnt = 0u; mine = 0u;
#pragma unroll
        for (unsigned j = 0; j < 16; ++j) { const unsigned c = xb_ld(&bar[XB_XCNT(j)]); sum += c; cnt += (c > 0u) ? 1u : 0u; mine = (j == x) ? c : mine; }
        if (sum == G) break;
        __builtin_amdgcn_s_sleep(1);
        if ((++sp & 255u) == 0u) { if (xb_ld(&bar[XB_TMO])) break; if (sp > XB_SPIN_CAP) { atomicAdd(&bar[XB_TMO], 1u); break; } }
    }
    nloc = mine > 0u ? mine : 1u; nx = cnt > 0u ? cnt : 1u;
}

__device__ __forceinline__ void xcd_barrier(const XcdBarrier& b) {
    asm volatile("s_waitcnt vmcnt(0)" ::: "memory");
    __syncthreads();
    if (threadIdx.x == 0) {
        unsigned* bar = b.bar;
        __builtin_amdgcn_s_waitcnt(0);
        unsigned nloc = b.st[0], nx = b.st[1];
        if (nloc == 0u) { xcd_barrier_complete(bar, b.x, nloc, nx); b.st[0] = nloc; b.st[1] = nx; }
        const unsigned old = xb_add(&bar[XB_XSUB(b.x)], 1u);
        const unsigned gen = old / nloc;
        if (old + 1u == (gen + 1u) * nloc) {
            __builtin_amdgcn_fence(__ATOMIC_RELEASE, "agent");
            asm volatile("s_waitcnt vmcnt(0)" ::: "memory");
            const unsigned og = xb_add(&bar[XB_TOP], 1u);
            const unsigned tg = og / nx;
            if (og + 1u == (tg + 1u) * nx) xb_add(&bar[XB_TOPGEN], 1u);
            else XB_SPIN(xb_ld(&bar[XB_TOPGEN]) == tg, bar);
            __builtin_amdgcn_fence(__ATOMIC_ACQUIRE, "agent");
            xb_add(&bar[XB_XGEN(b.x)], 1u);
            asm volatile("s_waitcnt vmcnt(0)" ::: "memory");
        } else {
            XB_SPIN(xb_ld(&bar[XB_XGEN(b.x)]) == gen, bar);
            __builtin_amdgcn_fence(__ATOMIC_ACQUIRE, "agent");
            asm volatile("s_waitcnt vmcnt(0)" ::: "memory");
        }
    }
    __syncthreads();
}

constexpr size_t MiB = (size_t)1 << 20;
constexpr int NTHR = 512, NWAVES = 8;
constexpr int LDS_BYTES = 147456;
constexpr int LDS_MISC = LDS_BYTES - 1024;
__device__ __forceinline__ const float* uptr(const LAS unsigned long long* tab, int i) {
    const unsigned long long v = tab[i]; const unsigned lo = __builtin_amdgcn_readfirstlane((unsigned)v), hi = __builtin_amdgcn_readfirstlane((unsigned)(v >> 32));
    return (const float*)(const GAS float*)(((unsigned long long)hi << 32) | lo);
}
template <class T> __device__ __forceinline__ LAS T* launder_l(LAS T* p) { asm volatile("" : "+s"(p)); return p; }
template <class T> __device__ __forceinline__ T* launder(T* p) { GAS T* q = (GAS T*)p; asm volatile("" : "+s"(q)); return (T*)q; }
static_assert(pg8::STAGE_BYTES <= LDS_MISC && fox::LDS_BYTES <= LDS_MISC && swa::LDS_BYTES <= LDS_MISC && s5::LDS_BYTES <= LDS_MISC, "LDS map");
constexpr size_t WS_CTL = 0, CTL_ZERO_BYTES = 64 * 1024;
constexpr size_t CTL_QCTR = 16384, CTL_NRM2 = 20480;
constexpr size_t WS_ROPE = 1 * MiB;
constexpr size_t WS_W = 2 * MiB;
constexpr size_t W_L0_QKV = WS_W, W_L0_O = W_L0_QKV + 40 * MiB, W_L1_QKVF = W_L0_O + 32 * MiB, W_L1_O = W_L1_QKVF + 98 * MiB, W_L2_GLU = W_L1_O + 32 * MiB,
                 W_L3_QKV = W_L2_GLU + 64 * MiB, W_L3_O = W_L3_QKV + 40 * MiB, W_FFN = W_L3_O + 32 * MiB, W_FFN_STRIDE = 258 * MiB, W_FFN_OUT = 172 * MiB;
constexpr size_t WS_XN = W_FFN + 4 * W_FFN_STRIDE;
constexpr size_t WS_BIG = WS_XN + 129 * MiB;
constexpr size_t WS_Z = WS_BIG, WS_ACT = WS_BIG + 688 * MiB, WS_TMPF = WS_BIG, WS_TMPM = WS_BIG + 688 * MiB;
constexpr size_t WS_SWA_QKV = WS_BIG, WS_SWA_O = WS_BIG + 160 * MiB;
constexpr size_t WS_FOX_QKV = WS_BIG, WS_FOX_O = WS_BIG + 384 * MiB, WS_FOX_LOGF = WS_BIG + 512 * MiB, WS_FOX_CNEG = WS_BIG + 514 * MiB;
constexpr size_t WS_S5_U = WS_BIG + 256 * MiB, WS_S5_G = WS_BIG + 512 * MiB;
constexpr size_t WS_HHI = WS_BIG + 1032 * MiB, WS_HLO = WS_HHI + 128 * MiB;
constexpr size_t WS_RS = WS_HLO + 32 * MiB;
constexpr size_t WS_END = WS_RS + 1 * MiB;
static_assert((size_t)SEQ * 2 * DFF * 2 == 688 * MiB && (size_t)SEQ * DFF * 2 == 344 * MiB && (size_t)12544 * 4096 * 2 == 98 * MiB && (size_t)22016 * 4096 * 2 == 172 * MiB, "sizes");

struct Args { const float* in[56]; float* out; unsigned char* ws; float inv_freq[8]; int ph_lo, ph_hi; };

__global__ void __launch_bounds__(NTHR, 2) mk_fwd(Args args) {
    extern __shared__ __attribute__((aligned(16))) unsigned char lds[];
    if (threadIdx.x < 16) ((LAS unsigned*)((LAS unsigned char*)lds + LDS_MISC))[threadIdx.x] = 0u;
    if (threadIdx.x == 64) { LAS unsigned long long* ptab0 = (LAS unsigned long long*)((LAS unsigned char*)lds + LDS_MISC + 64);
#pragma unroll
        for (int i = 0; i < 56; ++i) ptab0[i] = (unsigned long long)args.in[i]; }
#define IN(i) uptr(ptab, (i))
    __syncthreads();
    XcdBarrier bar = xcd_barrier_post((unsigned*)(args.ws + WS_CTL), (volatile LAS unsigned*)((LAS unsigned char*)lds + LDS_MISC));
    int need_bar = 0;
#if PROBE_WAIT > 0
    unsigned long long probe_acc = 0, probe_t0 = 0;
#define PROBE_SEL(id) (PROBE_ID >= 0 ? (id) == PROBE_ID : ((PROBE_MASK >> ((id) == 1 ? 9 : ((id) - 1) % 9)) & 1))
#define PROBE_T0(id) do { if (PROBE_SEL(id)) probe_t0 = __builtin_amdgcn_s_memrealtime(); } while (0)
#define PROBE_T1(id) do { if (PROBE_SEL(id)) probe_acc += __builtin_amdgcn_s_memrealtime() - probe_t0; } while (0)
#else
#define PROBE_T0(id) do { } while (0)
#define PROBE_T1(id) do { } while (0)
#endif
#define PH_BEGIN(id) if (args.ph_lo <= (id) && (id) < args.ph_hi) { \
        if (need_bar) { PROBE_T0(id); XcdBarrier b2; b2.bar = launder(bar.bar); b2.x = (unsigned)launder_s((int)bar.x); b2.st = bar.st; for (int rb_ = 0; rb_ < REP_BAR; ++rb_) xcd_barrier(b2); PROBE_T1(id); } need_bar = 1; \
        unsigned char* const ws = launder(args.ws); float* const out = launder(args.out); (void)out; \
        LAS unsigned char* const ldsl = launder_l((LAS unsigned char*)lds); char* const ldsg = (char*)ldsl; (void)ldsg; const LAS unsigned long long* const ptab = (const LAS unsigned long long*)(ldsl + LDS_MISC + 64); \
        const int tid = mk_tid(), lane = tid & 63, wave = __builtin_amdgcn_readfirstlane(tid >> 6); (void)lane; (void)wave; \
        const int G = launder_s((int)gridDim.x), bx = launder_s((int)blockIdx.x), vcu = (G % 8 == 0) ? (bx % 8) * (G / 8) + bx / 8 : bx, gw = vcu * NWAVES + wave, ngw = G * NWAVES; (void)gw; (void)ngw; \
        bf16* const XN = (bf16*)(ws + WS_XN + 16384); float* const cosT = (float*)(ws + WS_ROPE); float* const sinT = cosT + SEQ * 8; bf16* const TMPM = (bf16*)(ws + WS_TMPM); bf16* const TMPF = (bf16*)(ws + WS_TMPF); \
        (void)XN; (void)cosT; (void)sinT; (void)TMPM; (void)TMPF; const HPlanes HP{ws + WS_HHI, ws + WS_HLO}; (void)HP; float* const RS8 = (float*)(ws + WS_RS); (void)RS8;
#define PH_END }

    PH_BEGIN(0)
#if PROBE_COPY > 0
      for (int rep = 0; rep < PROBE_COPY; ++rep) {
        typedef PROBE_T pv_t; constexpr int PU = 128 / sizeof(pv_t);
        const pv_t* src = (const pv_t*)(ws + WS_BIG); pv_t* dst = (pv_t*)(ws + WS_BIG + 516 * MiB);
        const size_t n = 512 * MiB / sizeof(pv_t), stride = (size_t)G * NTHR;
        for (size_t i = (size_t)vcu * NTHR + tid; i < n; i += PU * stride) {
            pv_t v[PU];
#pragma unroll
            for (int u = 0; u < PU; ++u) v[u] = PROBE_LD(src + i + u * stride);
#pragma unroll
            for (int u = 0; u < PU; ++u) PROBE_ST(v[u], dst + i + u * stride);
        }
      }
#endif
      for (int rep = 0; rep < REP_PRO; ++rep) {
        LAS unsigned* scr = (LAS unsigned*)(ldsl + wave * 16640);
        constexpr int I_QKV = 32 * 80, I_O = 32 * 64, I_QKVF = 32 * 193, I_GLU = 32 * 128, I_IN = 32 * 344, I_OUT = 86 * 64;
        constexpr int NITEMS = 2 * (I_QKV + I_O) + I_QKVF + I_O + I_GLU + 4 * (I_IN + I_OUT);
        for (int it = gw; it < NITEMS; it += ngw) {
            int r = it;
#define TR(cnt, src, K_, N_, dstoff, mode) if (r < (cnt)) { transpose_item(IN(src), K_, N_, (bf16*)(ws + (dstoff)), mode, scr, r, lane); continue; } r -= (cnt);
            TR(I_QKV, 2, 4096, 5120, W_L0_QKV, 0)
            TR(I_O, 5, 4096, 4096, W_L0_O, 0)
            if (r < I_IN) { transpose_item_f8(IN(9), 4096, 22016, ws + W_FFN, 2, scr, r, lane, pg8::I8_W_SCALE, 2); continue; } r -= I_IN;
            TR(I_OUT, 12, 11008, 4096, W_FFN + W_FFN_OUT, 0)
            TR(I_QKVF, 15, 4096, 12320, W_L1_QKVF, 0)
            TR(I_O, 17, 4096, 4096, W_L1_O, 0)
            if (r < I_IN) { transpose_item_f8(IN(20), 4096, 22016, ws + W_FFN + W_FFN_STRIDE, 2, scr, r, lane, pg8::I8_W_SCALE, 2); continue; } r -= I_IN;
            TR(I_OUT, 23, 11008, 4096, W_FFN + W_FFN_STRIDE + W_FFN_OUT, 0)
            TR(I_GLU, 34, 4096, 8192, W_L2_GLU, 1)
            if (r < I_IN) { transpose_item_f8(IN(38), 4096, 22016, ws + W_FFN + 2 * W_FFN_STRIDE, 2, scr, r, lane, pg8::I8_W_SCALE, 2); continue; } r -= I_IN;
            TR(I_OUT, 41, 11008, 4096, W_FFN + 2 * W_FFN_STRIDE + W_FFN_OUT, 0)
            TR(I_QKV, 44, 4096, 5120, W_L3_QKV, 0)
            TR(I_O, 47, 4096, 4096, W_L3_O, 0)
            if (r < I_IN) { transpose_item_f8(IN(51), 4096, 22016, ws + W_FFN + 3 * W_FFN_STRIDE, 2, scr, r, lane, pg8::I8_W_SCALE, 2); continue; } r -= I_IN;
            TR(I_OUT, 54, 11008, 4096, W_FFN + 3 * W_FFN_STRIDE + W_FFN_OUT, 0)
#undef TR
        }
        if (vcu == 0) { u32x4* zh = (u32x4*)(ws + WS_XN); const u32x4 zero = {0u, 0u, 0u, 0u}; for (int i = tid; i < 1024; i += NTHR) zh[i] = zero; }
        {
            u32x4* z = (u32x4*)(ws + W_L1_QKVF + (size_t)12320 * 4096 * 2); const u32x4 zero = {0u, 0u, 0u, 0u};
            for (int i = vcu * NTHR + tid; i < 224 * 4096 * 2 / 16; i += G * NTHR) z[i] = zero;
        }
        for (int i = vcu * NTHR + tid; i < SEQ * 8; i += G * NTHR) {
            const int f = i & 7;
            const float fr = f == 0 ? args.inv_freq[0] : f == 1 ? args.inv_freq[1] : f == 2 ? args.inv_freq[2] : f == 3 ? args.inv_freq[3] : f == 4 ? args.inv_freq[4] : f == 5 ? args.inv_freq[5] : f == 6 ? args.inv_freq[6] : args.inv_freq[7];
            const float ang = (float)(i >> 3) * fr; double s, c; sincos_d((double)ang, s, c); cosT[i] = (float)c; sinT[i] = (float)s;
        }
        norm_phase<0, 2>(gw, ngw, lane, ldsl + wave * 16640, nullptr, nullptr, IN(0), nullptr, HPlanes{nullptr, nullptr}, IN(1), XN, nullptr);
      }
    PH_END

#define SEL(a, b, c, d) IN(L == 0 ? (a) : L == 1 ? (b) : L == 2 ? (c) : (d))
    { constexpr int L = 0;

        const int type = L == 3 ? 0 : L, pb = 1 + 9 * L;
        const size_t wffn = W_FFN + (size_t)L * W_FFN_STRIDE;

        PH_BEGIN(pb + 0)
            if (type == 0) {
                pg8::Gemm g{XN, (const bf16*)(ws + (L == 0 ? W_L0_QKV : W_L3_QKV)), SEQ, 5120, 4096}; pg8::StaticOrder S; S.init(SEQ, 5120, G, bx);
                pg8::EpiBf16B E{(bf16*)(ws + WS_SWA_QKV), 5120, L == 0 ? IN(3) : IN(45)};
                for (int rep = 0; rep < REP_MIXG; ++rep) pg8::gemm_phase<pg8::EpiBf16B, pg8::StaticOrder, true, true>(ldsl, g, S, E);
            } else if (type == 1) {
                pg8::Gemm g{XN, (const bf16*)(ws + W_L1_QKVF), SEQ, 12544, 4096}; pg8::StaticOrder S; S.init(SEQ, 12544, G, bx);
                pg8::EpiFox E{(bf16*)(ws + WS_FOX_QKV), (float*)(ws + WS_FOX_LOGF), IN(16)};
                for (int rep = 0; rep < REP_MIXG; ++rep) pg8::gemm_phase<pg8::EpiFox, pg8::StaticOrder, true, true>(ldsl, g, S, E);
            } else {
              for (int rep = 0; rep < REP_MIX; ++rep)
                s5::s5_phase(ldsg, (const bf16*)(ws + WS_S5_U), IN(26), IN(27), IN(28), IN(29), IN(30), IN(31), IN(32), IN(33),
                             (bf16*)(ws + WS_S5_G), vcu, G);
            }
        PH_END
        if (type != 2) {
        PH_BEGIN(pb + 1)
          for (int rep = 0; rep < REP_MIX; ++rep) {
            if (type == 0) swa::swa_attn_phase(ldsg, (const bf16*)(ws + WS_SWA_QKV), L == 0 ? IN(4) : IN(46), cosT, sinT, (bf16*)(ws + WS_SWA_O), vcu, G);
            else { fox_cumsum_phase(ldsg, (const float*)(ws + WS_FOX_LOGF), (float*)(ws + WS_FOX_CNEG), vcu, G, tid);
                   if (G > 64) { if (vcu >= 32) fox_norms_phase((const bf16*)(ws + WS_FOX_QKV), (unsigned*)(ws + WS_CTL + CTL_NRM2), (vcu - 32) * NWAVES + wave, (G - 32) * NWAVES, lane); }
                   else fox_norms_phase((const bf16*)(ws + WS_FOX_QKV), (unsigned*)(ws + WS_CTL + CTL_NRM2), gw, ngw, lane); }
          }
        PH_END
        }
        if (type == 1) {
        PH_BEGIN(pb + 2)
            const bf16* q = (const bf16*)(ws + WS_FOX_QKV);
            fox::fox_attn_phase(ldsg, q, q + (size_t)32 * SEQ * 128, q + (size_t)64 * SEQ * 128, (const float*)(ws + WS_FOX_CNEG), (const unsigned*)(ws + WS_CTL + CTL_NRM2), (unsigned*)(ws + WS_CTL + CTL_QCTR), (bf16*)(ws + WS_FOX_O));
#if REP_FOX > 1
            __syncthreads();
            fox::fox_attn_phase(ldsg, q, q + (size_t)32 * SEQ * 128, q + (size_t)64 * SEQ * 128, (const float*)(ws + WS_FOX_CNEG), (const unsigned*)(ws + WS_CTL + CTL_NRM2), (unsigned*)(ws + WS_CTL + CTL_QCTR) + 64, (bf16*)(ws + WS_FOX_O));
#endif
        PH_END
        }
        PH_BEGIN(pb + 3)
            if (type == 2) {
                pg8::Gemm g{(const bf16*)(ws + WS_S5_G), (const bf16*)(ws + W_L2_GLU), SEQ, 8192, 4096}; pg8::StaticOrder S; S.init(SEQ, 8192, G, bx);
                pg8::EpiGlu E{TMPM, IN(35)};
                for (int rep = 0; rep < REP_MIXG; ++rep) pg8::gemm_phase<pg8::EpiGlu, pg8::StaticOrder, true, true>(ldsl, g, S, E);
            } else {
                pg8::Gemm g{(const bf16*)(ws + (type == 0 ? WS_SWA_O : WS_FOX_O)), (const bf16*)(ws + (L == 0 ? W_L0_O : L == 1 ? W_L1_O : W_L3_O)), SEQ, 4096, 4096};
                pg8::StaticOrder S; S.init(SEQ, 4096, G, bx);
                pg8::EpiBf16B E{TMPM, 4096, L == 0 ? IN(6) : L == 3 ? IN(48) : nullptr};
                for (int rep = 0; rep < REP_MIXG; ++rep) pg8::gemm_phase<pg8::EpiBf16B, pg8::StaticOrder, true, true>(ldsl, g, S, E);
            }
        PH_END
        PH_BEGIN(pb + 4)
          for (int rep = 0; rep < REP_NORM; ++rep)
            if (L == 0 && rep == 0) norm_phase<0, 1>(gw, ngw, lane, ldsl + wave * 16640, TMPM, SEL(7, 18, 36, 49), IN(0), nullptr, HP, SEL(8, 19, 37, 50), nullptr, nullptr, 1.f, (unsigned char*)XN, 1.f, RS8);
            else norm_phase<1, 1>(gw, ngw, lane, ldsl + wave * 16640, TMPM, SEL(7, 18, 36, 49), nullptr, nullptr, HP, SEL(8, 19, 37, 50), nullptr, nullptr, rep ? 0.f : 1.f, (unsigned char*)XN, 1.f, RS8);
        PH_END
        PH_BEGIN(pb + 5)
            pg8::Gemm g{(const bf16*)((const unsigned char*)XN - 2 * 4096), (const bf16*)(ws + wffn), 65 * 256, 2 * DFF, 2048, 254}; pg8::StaticOrder S; S.init(65 * 256, 2 * DFF, G, bx);
            pg8::EpiConvGeglu E{(bf16*)(ws + WS_ACT), SEL(10, 21, 39, 52), SEL(11, 22, 40, 53), ldsl + 131072, DFF, SEQ, RS8, 1.0f / pg8::I8_W_SCALE};
          for (int rep = 0; rep < REP_FFN1; ++rep)
            pg8::gemm_phase<pg8::EpiConvGeglu, pg8::StaticOrder, true, true, 2>(ldsl, g, S, E);
        PH_END
        PH_BEGIN(pb + 7)
            pg8::Gemm g{(const bf16*)(ws + WS_ACT), (const bf16*)(ws + wffn + W_FFN_OUT), SEQ, 4096, DFF}; pg8::StaticOrder S; S.init(SEQ, 4096, G, bx);
            pg8::EpiBf16B E{TMPF, 4096, nullptr};
          for (int rep = 0; rep < REP_FFN2; ++rep)
            pg8::gemm_phase<pg8::EpiBf16B, pg8::StaticOrder, true, true>(ldsl, g, S, E);
        PH_END
        PH_BEGIN(pb + 8)
          for (int rep = 0; rep < REP_NORM; ++rep)
            if (L == 3) { if (rep == 0) norm_phase<1, 0>(gw, ngw, lane, ldsl + wave * 16640, TMPF, SEL(13, 24, 42, 55), nullptr, out, HP, nullptr, nullptr, nullptr, 1.f); }
            else norm_phase<1, 1>(gw, ngw, lane, ldsl + wave * 16640, TMPF, SEL(13, 24, 42, 55), nullptr, nullptr, HP, SEL(14, 25, 43, 43), L == 1 ? nullptr : XN, L == 1 ? (bf16*)(ws + WS_S5_U) : nullptr, rep ? 0.f : 1.f);
        PH_END
    }
    { constexpr int L = 1;

        const int type = L == 3 ? 0 : L, pb = 1 + 9 * L;
        const size_t wffn = W_FFN + (size_t)L * W_FFN_STRIDE;

        PH_BEGIN(pb + 0)
            if (type == 0) {
                pg8::Gemm g{XN, (const bf16*)(ws + (L == 0 ? W_L0_QKV : W_L3_QKV)), SEQ, 5120, 4096}; pg8::StaticOrder S; S.init(SEQ, 5120, G, bx);
                pg8::EpiBf16B E{(bf16*)(ws + WS_SWA_QKV), 5120, L == 0 ? IN(3) : IN(45)};
                for (int rep = 0; rep < REP_MIXG; ++rep) pg8::gemm_phase<pg8::EpiBf16B, pg8::StaticOrder, true, true>(ldsl, g, S, E);
            } else if (type == 1) {
                pg8::Gemm g{XN, (const bf16*)(ws + W_L1_QKVF), SEQ, 12544, 4096}; pg8::StaticOrder S; S.init(SEQ, 12544, G, bx);
                pg8::EpiFox E{(bf16*)(ws + WS_FOX_QKV), (float*)(ws + WS_FOX_LOGF), IN(16)};
                for (int rep = 0; rep < REP_MIXG; ++rep) pg8::gemm_phase<pg8::EpiFox, pg8::StaticOrder, true, true>(ldsl, g, S, E);
            } else {
              for (int rep = 0; rep < REP_MIX; ++rep)
                s5::s5_phase(ldsg, (const bf16*)(ws + WS_S5_U), IN(26), IN(27), IN(28), IN(29), IN(30), IN(31), IN(32), IN(33),
                             (bf16*)(ws + WS_S5_G), vcu, G);
            }
        PH_END
        if (type != 2) {
        PH_BEGIN(pb + 1)
          for (int rep = 0; rep < REP_MIX; ++rep) {
            if (type == 0) swa::swa_attn_phase(ldsg, (const bf16*)(ws + WS_SWA_QKV), L == 0 ? IN(4) : IN(46), cosT, sinT, (bf16*)(ws + WS_SWA_O), vcu, G);
            else { fox_cumsum_phase(ldsg, (const float*)(ws + WS_FOX_LOGF), (float*)(ws + WS_FOX_CNEG), vcu, G, tid);
                   if (G > 64) { if (vcu >= 32) fox_norms_phase((const bf16*)(ws + WS_FOX_QKV), (unsigned*)(ws + WS_CTL + CTL_NRM2), (vcu - 32) * NWAVES + wave, (G - 32) * NWAVES, lane); }
                   else fox_norms_phase((const bf16*)(ws + WS_FOX_QKV), (unsigned*)(ws + WS_CTL + CTL_NRM2), gw, ngw, lane); }
          }
        PH_END
        }
        if (type == 1) {
        PH_BEGIN(pb + 2)
            const bf16* q = (const bf16*)(ws + WS_FOX_QKV);
            fox::fox_attn_phase(ldsg, q, q + (size_t)32 * SEQ * 128, q + (size_t)64 * SEQ * 128, (const float*)(ws + WS_FOX_CNEG), (const unsigned*)(ws + WS_CTL + CTL_NRM2), (unsigned*)(ws + WS_CTL + CTL_QCTR), (bf16*)(ws + WS_FOX_O));
#if REP_FOX > 1
            __syncthreads();
            fox::fox_attn_phase(ldsg, q, q + (size_t)32 * SEQ * 128, q + (size_t)64 * SEQ * 128, (const float*)(ws + WS_FOX_CNEG), (const unsigned*)(ws + WS_CTL + CTL_NRM2), (unsigned*)(ws + WS_CTL + CTL_QCTR) + 64, (bf16*)(ws + WS_FOX_O));
#endif
        PH_END
        }
        PH_BEGIN(pb + 3)
            if (type == 2) {
                pg8::Gemm g{(const bf16*)(ws + WS_S5_G), (const bf16*)(ws + W_L2_GLU), SEQ, 8192, 4096}; pg8::StaticOrder S; S.init(SEQ, 8192, G, bx);
                pg8::EpiGlu E{TMPM, IN(35)};
                for (int rep = 0; rep < REP_MIXG; ++rep) pg8::gemm_phase<pg8::EpiGlu, pg8::StaticOrder, true, true>(ldsl, g, S, E);
            } else {
                pg8::Gemm g{(const bf16*)(ws + (type == 0 ? WS_SWA_O : WS_FOX_O)), (const bf16*)(ws + (L == 0 ? W_L0_O : L == 1 ? W_L1_O : W_L3_O)), SEQ, 4096, 4096};
                pg8::StaticOrder S; S.init(SEQ, 4096, G, bx);
                pg8::EpiBf16B E{TMPM, 4096, L == 0 ? IN(6) : L == 3 ? IN(48) : nullptr};
                for (int rep = 0; rep < REP_MIXG; ++rep) pg8::gemm_phase<pg8::EpiBf16B, pg8::StaticOrder, true, true>(ldsl, g, S, E);
            }
        PH_END
        PH_BEGIN(pb + 4)
          for (int rep = 0; rep < REP_NORM; ++rep)
            if (L == 0 && rep == 0) norm_phase<0, 1>(gw, ngw, lane, ldsl + wave * 16640, TMPM, SEL(7, 18, 36, 49), IN(0), nullptr, HP, SEL(8, 19, 37, 50), nullptr, nullptr, 1.f, (unsigned char*)XN, 1.f, RS8);
            else norm_phase<1, 1>(gw, ngw, lane, ldsl + wave * 16640, TMPM, SEL(7, 18, 36, 49), nullptr, nullptr, HP, SEL(8, 19, 37, 50), nullptr, nullptr, rep ? 0.f : 1.f, (unsigned char*)XN, 1.f, RS8);
        PH_END
        PH_BEGIN(pb + 5)
            pg8::Gemm g{(const bf16*)((const unsigned char*)XN - 2 * 4096), (const bf16*)(ws + wffn), 65 * 256, 2 * DFF, 2048, 254}; pg8::StaticOrder S; S.init(65 * 256, 2 * DFF, G, bx);
            pg8::EpiConvGeglu E{(bf16*)(ws + WS_ACT), SEL(10, 21, 39, 52), SEL(11, 22, 40, 53), ldsl + 131072, DFF, SEQ, RS8, 1.0f / pg8::I8_W_SCALE};
          for (int rep = 0; rep < REP_FFN1; ++rep)
            pg8::gemm_phase<pg8::EpiConvGeglu, pg8::StaticOrder, true, true, 2>(ldsl, g, S, E);
        PH_END
        PH_BEGIN(pb + 7)
            pg8::Gemm g{(const bf16*)(ws + WS_ACT), (const bf16*)(ws + wffn + W_FFN_OUT), SEQ, 4096, DFF}; pg8::StaticOrder S; S.init(SEQ, 4096, G, bx);
            pg8::EpiBf16B E{TMPF, 4096, nullptr};
          for (int rep = 0; rep < REP_FFN2; ++rep)
            pg8::gemm_phase<pg8::EpiBf16B, pg8::StaticOrder, true, true>(ldsl, g, S, E);
        PH_END
        PH_BEGIN(pb + 8)
          for (int rep = 0; rep < REP_NORM; ++rep)
            if (L == 3) { if (rep == 0) norm_phase<1, 0>(gw, ngw, lane, ldsl + wave * 16640, TMPF, SEL(13, 24, 42, 55), nullptr, out, HP, nullptr, nullptr, nullptr, 1.f); }
            else norm_phase<1, 1>(gw, ngw, lane, ldsl + wave * 16640, TMPF, SEL(13, 24, 42, 55), nullptr, nullptr, HP, SEL(14, 25, 43, 43), L == 1 ? nullptr : XN, L == 1 ? (bf16*)(ws + WS_S5_U) : nullptr, rep ? 0.f : 1.f);
        PH_END
    }
    { constexpr int L = 2;

        const int type = L == 3 ? 0 : L, pb = 1 + 9 * L;
        const size_t wffn = W_FFN + (size_t)L * W_FFN_STRIDE;

        PH_BEGIN(pb + 0)
            if (type == 0) {
                pg8::Gemm g{XN, (const bf16*)(ws + (L == 0 ? W_L0_QKV : W_L3_QKV)), SEQ, 5120, 4096}; pg8::StaticOrder S; S.init(SEQ, 5120, G, bx);
                pg8::EpiBf16B E{(bf16*)(ws + WS_SWA_QKV), 5120, L == 0 ? IN(3) : IN(45)};
                for (int rep = 0; rep < REP_MIXG; ++rep) pg8::gemm_phase<pg8::EpiBf16B, pg8::StaticOrder, true, true>(ldsl, g, S, E);
            } else if (type == 1) {
                pg8::Gemm g{XN, (const bf16*)(ws + W_L1_QKVF), SEQ, 12544, 4096}; pg8::StaticOrder S; S.init(SEQ, 12544, G, bx);
                pg8::EpiFox E{(bf16*)(ws + WS_FOX_QKV), (float*)(ws + WS_FOX_LOGF), IN(16)};
                for (int rep = 0; rep < REP_MIXG; ++rep) pg8::gemm_phase<pg8::EpiFox, pg8::StaticOrder, true, true>(ldsl, g, S, E);
            } else {
              for (int rep = 0; rep < REP_MIX; ++rep)
                s5::s5_phase(ldsg, (const bf16*)(ws + WS_S5_U), IN(26), IN(27), IN(28), IN(29), IN(30), IN(31), IN(32), IN(33),
                             (bf16*)(ws + WS_S5_G), vcu, G);
            }
        PH_END
        if (type != 2) {
        PH_BEGIN(pb + 1)
          for (int rep = 0; rep < REP_MIX; ++rep) {
            if (type == 0) swa::swa_attn_phase(ldsg, (const bf16*)(ws + WS_SWA_QKV), L == 0 ? IN(4) : IN(46), cosT, sinT, (bf16*)(ws + WS_SWA_O), vcu, G);
            else { fox_cumsum_phase(ldsg, (const float*)(ws + WS_FOX_LOGF), (float*)(ws + WS_FOX_CNEG), vcu, G, tid);
                   if (G > 64) { if (vcu >= 32) fox_norms_phase((const bf16*)(ws + WS_FOX_QKV), (unsigned*)(ws + WS_CTL + CTL_NRM2), (vcu - 32) * NWAVES + wave, (G - 32) * NWAVES, lane); }
                   else fox_norms_phase((const bf16*)(ws + WS_FOX_QKV), (unsigned*)(ws + WS_CTL + CTL_NRM2), gw, ngw, lane); }
          }
        PH_END
        }
        if (type == 1) {
        PH_BEGIN(pb + 2)
            const bf16* q = (const bf16*)(ws + WS_FOX_QKV);
            fox::fox_attn_phase(ldsg, q, q + (size_t)32 * SEQ * 128, q + (size_t)64 * SEQ * 128, (const float*)(ws + WS_FOX_CNEG), (const unsigned*)(ws + WS_CTL + CTL_NRM2), (unsigned*)(ws + WS_CTL + CTL_QCTR), (bf16*)(ws + WS_FOX_O));
#if REP_FOX > 1
            __syncthreads();
            fox::fox_attn_phase(ldsg, q, q + (size_t)32 * SEQ * 128, q + (size_t)64 * SEQ * 128, (const float*)(ws + WS_FOX_CNEG), (const unsigned*)(ws + WS_CTL + CTL_NRM2), (unsigned*)(ws + WS_CTL + CTL_QCTR) + 64, (bf16*)(ws + WS_FOX_O));
#endif
        PH_END
        }
        PH_BEGIN(pb + 3)
            if (type == 2) {
                pg8::Gemm g{(const bf16*)(ws + WS_S5_G), (const bf16*)(ws + W_L2_GLU), SEQ, 8192, 4096}; pg8::StaticOrder S; S.init(SEQ, 8192, G, bx);
                pg8::EpiGlu E{TMPM, IN(35)};
                for (int rep = 0; rep < REP_MIXG; ++rep) pg8::gemm_phase<pg8::EpiGlu, pg8::StaticOrder, true, true>(ldsl, g, S, E);
            } else {
                pg8::Gemm g{(const bf16*)(ws + (type == 0 ? WS_SWA_O : WS_FOX_O)), (const bf16*)(ws + (L == 0 ? W_L0_O : L == 1 ? W_L1_O : W_L3_O)), SEQ, 4096, 4096};
                pg8::StaticOrder S; S.init(SEQ, 4096, G, bx);
                pg8::EpiBf16B E{TMPM, 4096, L == 0 ? IN(6) : L == 3 ? IN(48) : nullptr};
                for (int rep = 0; rep < REP_MIXG; ++rep) pg8::gemm_phase<pg8::EpiBf16B, pg8::StaticOrder, true, true>(ldsl, g, S, E);
            }
        PH_END
        PH_BEGIN(pb + 4)
          for (int rep = 0; rep < REP_NORM; ++rep)
            if (L == 0 && rep == 0) norm_phase<0, 1>(gw, ngw, lane, ldsl + wave * 16640, TMPM, SEL(7, 18, 36, 49), IN(0), nullptr, HP, SEL(8, 19, 37, 50), nullptr, nullptr, 1.f, (unsigned char*)XN, 1.f, RS8);
            else norm_phase<1, 1>(gw, ngw, lane, ldsl + wave * 16640, TMPM, SEL(7, 18, 36, 49), nullptr, nullptr, HP, SEL(8, 19, 37, 50), nullptr, nullptr, rep ? 0.f : 1.f, (unsigned char*)XN, 1.f, RS8);
        PH_END
        PH_BEGIN(pb + 5)
            pg8::Gemm g{(const bf16*)((const unsigned char*)XN - 2 * 4096), (const bf16*)(ws + wffn), 65 * 256, 2 * DFF, 2048, 254}; pg8::StaticOrder S; S.init(65 * 256, 2 * DFF, G, bx);
            pg8::EpiConvGeglu E{(bf16*)(ws + WS_ACT), SEL(10, 21, 39, 52), SEL(11, 22, 40, 53), ldsl + 131072, DFF, SEQ, RS8, 1.0f / pg8::I8_W_SCALE};
          for (int rep = 0; rep < REP_FFN1; ++rep)
            pg8::gemm_phase<pg8::EpiConvGeglu, pg8::StaticOrder, true, true, 2>(ldsl, g, S, E);
        PH_END
        PH_BEGIN(pb + 7)
            pg8::Gemm g{(const bf16*)(ws + WS_ACT), (const bf16*)(ws + wffn + W_FFN_OUT), SEQ, 4096, DFF}; pg8::StaticOrder S; S.init(SEQ, 4096, G, bx);
            pg8::EpiBf16B E{TMPF, 4096, nullptr};
          for (int rep = 0; rep < REP_FFN2; ++rep)
            pg8::gemm_phase<pg8::EpiBf16B, pg8::StaticOrder, true, true>(ldsl, g, S, E);
        PH_END
        PH_BEGIN(pb + 8)
          for (int rep = 0; rep < REP_NORM; ++rep)
            if (L == 3) { if (rep == 0) norm_phase<1, 0>(gw, ngw, lane, ldsl + wave * 16640, TMPF, SEL(13, 24, 42, 55), nullptr, out, HP, nullptr, nullptr, nullptr, 1.f); }
            else norm_phase<1, 1>(gw, ngw, lane, ldsl + wave * 16640, TMPF, SEL(13, 24, 42, 55), nullptr, nullptr, HP, SEL(14, 25, 43, 43), L == 1 ? nullptr : XN, L == 1 ? (bf16*)(ws + WS_S5_U) : nullptr, rep ? 0.f : 1.f);
        PH_END
    }
    { constexpr int L = 3;

        const int type = L == 3 ? 0 : L, pb = 1 + 9 * L;
        const size_t wffn = W_FFN + (size_t)L * W_FFN_STRIDE;

        PH_BEGIN(pb + 0)
            if (type == 0) {
                pg8::Gemm g{XN, (const bf16*)(ws + (L == 0 ? W_L0_QKV : W_L3_QKV)), SEQ, 5120, 4096}; pg8::StaticOrder S; S.init(SEQ, 5120, G, bx);
                pg8::EpiBf16B E{(bf16*)(ws + WS_SWA_QKV), 5120, L == 0 ? IN(3) : IN(45)};
                for (int rep = 0; rep < REP_MIXG; ++rep) pg8::gemm_phase<pg8::EpiBf16B, pg8::StaticOrder, true, true>(ldsl, g, S, E);
            } else if (type == 1) {
                pg8::Gemm g{XN, (const bf16*)(ws + W_L1_QKVF), SEQ, 12544, 4096}; pg8::StaticOrder S; S.init(SEQ, 12544, G, bx);
                pg8::EpiFox E{(bf16*)(ws + WS_FOX_QKV), (float*)(ws + WS_FOX_LOGF), IN(16)};
                for (int rep = 0; rep < REP_MIXG; ++rep) pg8::gemm_phase<pg8::EpiFox, pg8::StaticOrder, true, true>(ldsl, g, S, E);
            } else {
              for (int rep = 0; rep < REP_MIX; ++rep)
                s5::s5_phase(ldsg, (const bf16*)(ws + WS_S5_U), IN(26), IN(27), IN(28), IN(29), IN(30), IN(31), IN(32), IN(33),
                             (bf16*)(ws + WS_S5_G), vcu, G);
            }
        PH_END
        if (type != 2) {
        PH_BEGIN(pb + 1)
          for (int rep = 0; rep < REP_MIX; ++rep) {
            if (type == 0) swa::swa_attn_phase(ldsg, (const bf16*)(ws + WS_SWA_QKV), L == 0 ? IN(4) : IN(46), cosT, sinT, (bf16*)(ws + WS_SWA_O), vcu, G);
            else { fox_cumsum_phase(ldsg, (const float*)(ws + WS_FOX_LOGF), (float*)(ws + WS_FOX_CNEG), vcu, G, tid);
                   if (G > 64) { if (vcu >= 32) fox_norms_phase((const bf16*)(ws + WS_FOX_QKV), (unsigned*)(ws + WS_CTL + CTL_NRM2), (vcu - 32) * NWAVES + wave, (G - 32) * NWAVES, lane); }
                   else fox_norms_phase((const bf16*)(ws + WS_FOX_QKV), (unsigned*)(ws + WS_CTL + CTL_NRM2), gw, ngw, lane); }
          }
        PH_END
        }
        if (type == 1) {
        PH_BEGIN(pb + 2)
            const bf16* q = (const bf16*)(ws + WS_FOX_QKV);
            fox::fox_attn_phase(ldsg, q, q + (size_t)32 * SEQ * 128, q + (size_t)64 * SEQ * 128, (const float*)(ws + WS_FOX_CNEG), (const unsigned*)(ws + WS_CTL + CTL_NRM2), (unsigned*)(ws + WS_CTL + CTL_QCTR), (bf16*)(ws + WS_FOX_O));
#if REP_FOX > 1
            __syncthreads();
            fox::fox_attn_phase(ldsg, q, q + (size_t)32 * SEQ * 128, q + (size_t)64 * SEQ * 128, (const float*)(ws + WS_FOX_CNEG), (const unsigned*)(ws + WS_CTL + CTL_NRM2), (unsigned*)(ws + WS_CTL + CTL_QCTR) + 64, (bf16*)(ws + WS_FOX_O));
#endif
        PH_END
        }
        PH_BEGIN(pb + 3)
            if (type == 2) {
                pg8::Gemm g{(const bf16*)(ws + WS_S5_G), (const bf16*)(ws + W_L2_GLU), SEQ, 8192, 4096}; pg8::StaticOrder S; S.init(SEQ, 8192, G, bx);
                pg8::EpiGlu E{TMPM, IN(35)};
                for (int rep = 0; rep < REP_MIXG; ++rep) pg8::gemm_phase<pg8::EpiGlu, pg8::StaticOrder, true, true>(ldsl, g, S, E);
            } else {
                pg8::Gemm g{(const bf16*)(ws + (type == 0 ? WS_SWA_O : WS_FOX_O)), (const bf16*)(ws + (L == 0 ? W_L0_O : L == 1 ? W_L1_O : W_L3_O)), SEQ, 4096, 4096};
                pg8::StaticOrder S; S.init(SEQ, 4096, G, bx);
                pg8::EpiBf16B E{TMPM, 4096, L == 0 ? IN(6) : L == 3 ? IN(48) : nullptr};
                for (int rep = 0; rep < REP_MIXG; ++rep) pg8::gemm_phase<pg8::EpiBf16B, pg8::StaticOrder, true, true>(ldsl, g, S, E);
            }
        PH_END
        PH_BEGIN(pb + 4)
          for (int rep = 0; rep < REP_NORM; ++rep)
            if (L == 0 && rep == 0) norm_phase<0, 1>(gw, ngw, lane, ldsl + wave * 16640, TMPM, SEL(7, 18, 36, 49), IN(0), nullptr, HP, SEL(8, 19, 37, 50), nullptr, nullptr, 1.f, (unsigned char*)XN, 1.f, RS8);
            else norm_phase<1, 1>(gw, ngw, lane, ldsl + wave * 16640, TMPM, SEL(7, 18, 36, 49), nullptr, nullptr, HP, SEL(8, 19, 37, 50), nullptr, nullptr, rep ? 0.f : 1.f, (unsigned char*)XN, 1.f, RS8);
        PH_END
        PH_BEGIN(pb + 5)
            pg8::Gemm g{(const bf16*)((const unsigned char*)XN - 2 * 4096), (const bf16*)(ws + wffn), 65 * 256, 2 * DFF, 2048, 254}; pg8::StaticOrder S; S.init(65 * 256, 2 * DFF, G, bx);
            pg8::EpiConvGeglu E{(bf16*)(ws + WS_ACT), SEL(10, 21, 39, 52), SEL(11, 22, 40, 53), ldsl + 131072, DFF, SEQ, RS8, 1.0f / pg8::I8_W_SCALE};
          for (int rep = 0; rep < REP_FFN1; ++rep)
            pg8::gemm_phase<pg8::EpiConvGeglu, pg8::StaticOrder, true, true, 2>(ldsl, g, S, E);
        PH_END
        PH_BEGIN(pb + 7)
            pg8::Gemm g{(const bf16*)(ws + WS_ACT), (const bf16*)(ws + wffn + W_FFN_OUT), SEQ, 4096, DFF}; pg8::StaticOrder S; S.init(SEQ, 4096, G, bx);
            pg8::EpiBf16B E{TMPF, 4096, nullptr};
          for (int rep = 0; rep < REP_FFN2; ++rep)
            pg8::gemm_phase<pg8::EpiBf16B, pg8::StaticOrder, true, true>(ldsl, g, S, E);
        PH_END
        PH_BEGIN(pb + 8)
          for (int rep = 0; rep < REP_NORM; ++rep)
            if (L == 3) { if (rep == 0) norm_phase<1, 0>(gw, ngw, lane, ldsl + wave * 16640, TMPF, SEL(13, 24, 42, 55), nullptr, out, HP, nullptr, nullptr, nullptr, 1.f); }
            else norm_phase<1, 1>(gw, ngw, lane, ldsl + wave * 16640, TMPF, SEL(13, 24, 42, 55), nullptr, nullptr, HP, SEL(14, 25, 43, 43), L == 1 ? nullptr : XN, L == 1 ? (bf16*)(ws + WS_S5_U) : nullptr, rep ? 0.f : 1.f);
        PH_END
    }
#if PROBE_WAIT > 0
#if PROBE_WG >= 0
    if ((int)blockIdx.x == PROBE_WG) { const unsigned long long ts = __builtin_amdgcn_s_memrealtime(); while (__builtin_amdgcn_s_memrealtime() - ts < probe_acc * PROBE_WAIT) __builtin_amdgcn_s_sleep(8); }
#elif PROBE_WG == -1
    { const unsigned long long ts = __builtin_amdgcn_s_memrealtime(); while (__builtin_amdgcn_s_memrealtime() - ts < probe_acc * PROBE_WAIT) __builtin_amdgcn_s_sleep(8); }
#else
    { const unsigned long long ts = __builtin_amdgcn_s_memrealtime(); const unsigned long long c = 250000ull, w = probe_acc < c ? c - probe_acc : 0ull; while (__builtin_amdgcn_s_memrealtime() - ts < w * PROBE_WAIT) __builtin_amdgcn_s_sleep(8); }
#endif
#endif
#undef SEL
#undef PH_BEGIN
#undef PH_END
#undef IN
}

extern "C" void kernel_launch(void* const* d_in, const int* in_sizes, int n_in, void* d_out, int out_size, void* d_ws, size_t ws_size, hipStream_t stream) {
    static int grid = 0;
    if (grid == 0) {
        if (n_in != 56 || in_sizes[0] != SEQ * DM || out_size != SEQ * DM || ws_size < WS_END) {
            fprintf(stderr, "kernel_launch: built for 56 inputs, x/out of %d floats, >= %zu bytes of workspace; got n_in %d, in0 %d, out %d, ws %zu; nothing launched\n", SEQ * DM, (size_t)WS_END, n_in, n_in > 0 ? in_sizes[0] : -1, out_size, ws_size);
            grid = -1; return; }
        int dev = 0, cus = 0, per_cu = 0;
        if (hipGetDevice(&dev) != hipSuccess || hipDeviceGetAttribute(&cus, hipDeviceAttributeMultiprocessorCount, dev) != hipSuccess) { fprintf(stderr, "kernel_launch: device query failed\n"); grid = -1; return; }
        if (hipFuncSetAttribute((const void*)mk_fwd, hipFuncAttributeMaxDynamicSharedMemorySize, LDS_BYTES) != hipSuccess) { fprintf(stderr, "kernel_launch: hipFuncSetAttribute failed\n"); grid = -1; return; }
        if (hipOccupancyMaxActiveBlocksPerMultiprocessor(&per_cu, (const void*)mk_fwd, NTHR, LDS_BYTES) != hipSuccess || per_cu < 1) { fprintf(stderr, "kernel_launch: occupancy query says %d workgroups per CU\n", per_cu); (void)hipGetLastError(); }
        grid = cus;
    }
    if (grid < 0) return;
    if (hipMemsetAsync((char*)d_ws + WS_CTL, 0, CTL_ZERO_BYTES, stream) != hipSuccess) { fprintf(stderr, "kernel_launch: memset failed\n"); return; }
    Args a{};
    for (int i = 0; i < 56; ++i) a.in[i] = (const float*)d_in[i];
    a.out = (float*)d_out; a.ws = (unsigned char*)d_ws;
    { const float lt = (float)(-std::log(500000.0)); for (int i = 0; i < 8; ++i) { float v = lt * (float)i; v = v * 0.125f; a.inv_freq[i] = (float)std::exp((double)v); } }
#if MK_SPLIT_LAUNCHES
    for (int ph = 0; ph < 37; ++ph) {
        const int L = (ph - 1) / 9, slot = (ph - 1) % 9, type = L == 3 ? 0 : L;
        if (ph > 0 && ((slot == 1 && type == 2) || (slot == 2 && type != 1) || slot == 6)) continue;
        a.ph_lo = ph; a.ph_hi = ph + 1;
        hipLaunchKernelGGL(mk_fwd, dim3(grid), dim3(NTHR), LDS_BYTES, stream, a);
    }
#else
    a.ph_lo = 0; a.ph_hi = 37;
    hipLaunchKernelGGL(mk_fwd, dim3(grid), dim3(NTHR), LDS_BYTES, stream, a);
#endif
    const hipError_t le = hipPeekAtLastError();
    if (le != hipSuccess) fprintf(stderr, "kernel_launch: launch failed: %s (grid %d x %d threads, %d B LDS)\n", hipGetErrorName(le), grid, NTHR, LDS_BYTES);
}
```

```cpp
#include <hip/hip_runtime.h>
#include <cstdio>
#include <cstdint>
#include <cmath>

#ifndef MK_SPLIT_LAUNCHES
#define MK_SPLIT_LAUNCHES 0
#endif

__device__ __forceinline__ int mk_tid() { int t = threadIdx.x; asm volatile("" : "+v"(t)); return t; }
__device__ __forceinline__ int launder_s(int v) { asm volatile("" : "+s"(v)); return v; }

#ifndef PROBE_WAIT
#define PROBE_WAIT 0
#endif
#ifndef PROBE_ID
#define PROBE_ID -1
#endif
#ifndef PROBE_MASK
#define PROBE_MASK 0x080
#endif
#ifndef PROBE_WG
#define PROBE_WG -1
#endif
#ifndef F8_FIRST_LAYER
#define F8_FIRST_LAYER 2
#endif
#ifndef PROBE_COPY
#define PROBE_COPY 0
#endif
#ifndef PROBE_T
#define PROBE_T u32x2
#endif
#define PROBE_LD(p) (*(p))
#define PROBE_ST(v, p) (*(p) = (v))
#ifndef REP_PRO
#define REP_PRO 1
#endif
#ifndef REP_FFN1
#define REP_FFN1 1
#endif
#ifndef REP_FFN2
#define REP_FFN2 1
#endif
#ifndef REP_NORM
#define REP_NORM 1
#endif
#ifndef REP_BAR
#define REP_BAR 1
#endif
#ifndef REP_FOX
#define REP_FOX 1
#endif
#ifndef REP_MIXG
#define REP_MIXG 1
#endif
#ifndef REP_MIX
#define REP_MIX 1
#endif

namespace pg8 {
#define PG8_LAS __attribute__((address_space(3)))
typedef unsigned short bf16_t;
typedef short bf16x8 __attribute__((ext_vector_type(8)));
typedef float f32x4 __attribute__((ext_vector_type(4)));
typedef unsigned u32x4 __attribute__((ext_vector_type(4)));
typedef unsigned u32x2 __attribute__((ext_vector_type(2)));
typedef float f32x2 __attribute__((ext_vector_type(2)));
typedef int v4i32 __attribute__((ext_vector_type(4)));
constexpr int F8_W_LOG2 = 10, F8_X_LOG2 = 4, F8_SCALE_W = 0x01010101 * (127 - (F8_W_LOG2 + F8_X_LOG2) / 2), F8_SCALE_X = F8_SCALE_W;
constexpr float I8_W_SCALE = 1800.f;
static_assert((F8_W_LOG2 + F8_X_LOG2) % 2 == 0, "the two scalings are undone by two equal E8M0 scales");
constexpr int BM = 256, BK = 64, HALF = 128, HTB = HALF * BK * 2  , STAGE_BYTES = 8 * HTB, NXCD = 8, WGM = 8;

__host__ __device__ __forceinline__ int lds_byte(int r, int c) { const int st = (r >> 4) * 2 + (c >> 5), rr = r & 15, cc = c & 31, ob = rr * 64 + cc * 2; return st * 1024 + (ob ^ (((ob >> 9) & 1) << 5)); }
__host__ __device__ __forceinline__ void stage_rc(int b, int& R, int& C) { const int st = b / 1024, sb = b % 1024, swz = sb ^ (((sb >> 9) & 1) << 5); R = (st >> 1) * 16 + swz / 64; C = (st & 1) * 32 + (swz % 64) / 2; }
__host__ __device__ __forceinline__ int perm32(int rho) { const int n = rho >> 4, i = rho & 15; return 8 * (i >> 2) + 4 * n + (i & 3); }

struct Unit { int pm, pn; };
struct Gemm { const bf16_t* A; const bf16_t* Bt; int M, N, K; int apr = 256; };

struct StaticOrder {
    int nM, nN, nwg, G, c;
    __host__ __device__ void init(int M, int N, int G_, int c_) { nM = M / BM; nN = N / BM; nwg = nM * nN; G = G_; c = c_; }
    __host__ __device__ bool next(int i, Unit& u) const {
        const long L = (long)i * G + c; if (L >= nwg) return false;
        int wgid = (int)L; { const int q = nwg / NXCD, r = nwg % NXCD, xcd = wgid % NXCD, off = wgid / NXCD; wgid = (xcd < r ? xcd * (q + 1) : r * (q + 1) + (xcd - r) * q) + off; }
        const int nig = WGM * nN, ngf = nM / WGM > 0 ? nM / WGM : 1; int gid = wgid / nig; if (gid >= ngf) gid = ngf - 1;
        const int fm = gid * WGM, gsz = gid == ngf - 1 ? nM - fm : WGM, w = wgid - gid * nig;
        u.pm = fm + (w % gsz); u.pn = w / gsz; return true;
    }
    __device__ __forceinline__ void a_ready(const Unit&) const {}
    __device__ __forceinline__ void done(const Unit&) const {}
};

__device__ __forceinline__ unsigned cvt_pk_bf16(float lo, float hi) { unsigned r; asm volatile("v_cvt_pk_bf16_f32 %0, %1, %2" : "=v"(r) : "v"(lo), "v"(hi)); return r; }

struct EpiF32B {
    static constexpr bool PERM = false, AFTER_DRAIN = false, APERM = false;
    float* C; int ldc; const float* bias;
    __device__ __forceinline__ void operator()(const f32x4 (&acc)[2][2][4][2], const Unit& u, int wr, int wc, int fr, int fq) const {
        const int row0 = u.pm * BM + wr * 64 + fr, col0 = u.pn * BM + wc * 32 + 4 * fq;
        f32x4 bv[2][2];
#pragma unroll
        for (int bj = 0; bj < 2; ++bj)
#pragma unroll
            for (int n = 0; n < 2; ++n) bv[bj][n] = bias ? *(const f32x4*)(bias + col0 + bj * HALF + n * 16) : (f32x4){0.f, 0.f, 0.f, 0.f};
#pragma unroll
        for (int ai = 0; ai < 2; ++ai)
#pragma unroll
            for (int m = 0; m < 4; ++m) { float* rowp = C + (size_t)(row0 + ai * HALF + m * 16) * ldc + col0;
#pragma unroll
                for (int bj = 0; bj < 2; ++bj)
#pragma unroll
                    for (int n = 0; n < 2; ++n) *(f32x4*)(rowp + bj * HALF + n * 16) = acc[ai][bj][m][n] + bv[bj][n]; }
    }
};
struct EpiBf16B {
    static constexpr bool PERM = true, AFTER_DRAIN = false, APERM = false;
    bf16_t* O; int ldc; const float* bias;
    __device__ __forceinline__ void operator()(const f32x4 (&acc)[2][2][4][2], const Unit& u, int wr, int wc, int fr, int fq) const {
        const int row0 = u.pm * BM + wr * 64 + fr; const int col0 = u.pn * BM + wc * 32 + 8 * fq;
        f32x4 bv[2][2];
#pragma unroll
        for (int bj = 0; bj < 2; ++bj)
#pragma unroll
            for (int n = 0; n < 2; ++n) bv[bj][n] = bias ? *(const f32x4*)(bias + col0 + bj * HALF + 4 * n) : (f32x4){0.f, 0.f, 0.f, 0.f};
#pragma unroll
        for (int ai = 0; ai < 2; ++ai)
#pragma unroll
            for (int m = 0; m < 4; ++m) { bf16_t* rowp = O + (size_t)(row0 + ai * HALF + m * 16) * ldc + col0;
#pragma unroll
                for (int bj = 0; bj < 2; ++bj) { const f32x4 v0 = acc[ai][bj][m][0] + bv[bj][0], v1 = acc[ai][bj][m][1] + bv[bj][1];
                    u32x4 w; w.x = cvt_pk_bf16(v0[0], v0[1]); w.y = cvt_pk_bf16(v0[2], v0[3]); w.z = cvt_pk_bf16(v1[0], v1[1]); w.w = cvt_pk_bf16(v1[2], v1[3]);
                    *(u32x4*)(rowp + bj * HALF) = w; } }
    }
};
struct EpiFox {
    static constexpr bool PERM = true, AFTER_DRAIN = false, APERM = false;
    bf16_t* QKV; float* logf; const float* bfg; const float* rs = nullptr; float wsc = 1.f;
    __device__ __forceinline__ void dequant(f32x4 (&acc)[2][2][4][2], const Unit& u, int wr, int wc, int fr, int fq) const {
#pragma unroll
        for (int ai = 0; ai < 2; ++ai)
#pragma unroll
            for (int m = 0; m < 4; ++m) { const float sc = rs[u.pm * BM + wr * 64 + fr + ai * HALF + m * 16 + 2] * wsc;
#pragma unroll
                for (int bj = 0; bj < 2; ++bj)
#pragma unroll
                    for (int n = 0; n < 2; ++n) { const v4i32 q = __builtin_bit_cast(v4i32, acc[ai][bj][m][n]);
                        acc[ai][bj][m][n] = (f32x4){(float)q[0] * sc, (float)q[1] * sc, (float)q[2] * sc, (float)q[3] * sc}; } }
    }
    __device__ __forceinline__ void operator()(const f32x4 (&acc)[2][2][4][2], const Unit& u, int wr, int wc, int fr, int fq) const {
        const int row0 = u.pm * BM + wr * 64 + fr;
        if (u.pn < 48) {
            const int t3 = u.pn >> 4, hp = u.pn & 15;
#pragma unroll
            for (int bj = 0; bj < 2; ++bj) { bf16_t* base = QKV + ((size_t)(t3 * 32 + 2 * hp + bj) * 16384) * 128 + wc * 32 + 8 * fq;
#pragma unroll
                for (int ai = 0; ai < 2; ++ai)
#pragma unroll
                    for (int m = 0; m < 4; ++m) { const f32x4 v0 = acc[ai][bj][m][0], v1 = acc[ai][bj][m][1];
                        u32x4 w; w.x = cvt_pk_bf16(v0[0], v0[1]); w.y = cvt_pk_bf16(v0[2], v0[3]); w.z = cvt_pk_bf16(v1[0], v1[1]); w.w = cvt_pk_bf16(v1[2], v1[3]);
                        *(u32x4*)(base + (size_t)(row0 + ai * HALF + m * 16) * 128) = w; } }
        } else if (wc == 0) {
            const f32x4 b0 = *(const f32x4*)(bfg + 8 * fq), b1 = *(const f32x4*)(bfg + 8 * fq + 4);
#pragma unroll
            for (int ai = 0; ai < 2; ++ai)
#pragma unroll
                for (int m = 0; m < 4; ++m) { float* rowp = logf + (size_t)(row0 + ai * HALF + m * 16) * 32 + 8 * fq;
#pragma unroll
                    for (int n = 0; n < 2; ++n) { const f32x4 z = acc[ai][0][m][n] + (n ? b1 : b0); f32x4 o;
#pragma unroll
                        for (int i = 0; i < 4; ++i) o[i] = fminf(z[i], 0.f) - log1pf(expf(-fabsf(z[i])));
                        *(f32x4*)(rowp + 4 * n) = o; } }
        }
    }
};
struct EpiGlu {
    static constexpr bool PERM = true, AFTER_DRAIN = false, APERM = false;
    bf16_t* C; const float* bias;
    __device__ __forceinline__ void operator()(const f32x4 (&acc)[2][2][4][2], const Unit& u, int wr, int wc, int fr, int fq) const {
        const int row0 = u.pm * BM + wr * 64 + fr, col0 = u.pn * HALF + wc * 32 + 8 * fq;
        f32x4 bv[2], bg[2];
#pragma unroll
        for (int n = 0; n < 2; ++n) { bv[n] = *(const f32x4*)(bias + col0 + 4 * n); bg[n] = *(const f32x4*)(bias + 4096 + col0 + 4 * n); }
#pragma unroll
        for (int ai = 0; ai < 2; ++ai)
#pragma unroll
            for (int m = 0; m < 4; ++m) { bf16_t* rowp = C + (size_t)(row0 + ai * HALF + m * 16) * 4096 + col0; u32x4 w;
#pragma unroll
                for (int n = 0; n < 2; ++n) { const f32x4 zv = acc[ai][0][m][n] + bv[n], zg = acc[ai][1][m][n] + bg[n]; f32x4 o;
#pragma unroll
                    for (int i = 0; i < 4; ++i) o[i] = zv[i] * __builtin_amdgcn_rcpf(1.0f + __builtin_amdgcn_exp2f(-1.4426950408889634f * zg[i]));
                    if (n == 0) { w.x = cvt_pk_bf16(o[0], o[1]); w.y = cvt_pk_bf16(o[2], o[3]); } else { w.z = cvt_pk_bf16(o[0], o[1]); w.w = cvt_pk_bf16(o[2], o[3]); } }
                *(u32x4*)rowp = w; }
    }
};

struct EpiConvGeglu {
    static constexpr bool PERM = true, AFTER_DRAIN = false, APERM = true;
    bf16_t* ACT; const float* cw; const float* cb; PG8_LAS unsigned char* xl; int dff, nrows; const float* rs; float wsc;
    __device__ __forceinline__ void dequant(f32x4 (&acc)[2][2][4][2], const Unit& u, int wr, int wc, int fr, int fq) const {
#pragma unroll
        for (int ai = 0; ai < 2; ++ai)
#pragma unroll
            for (int m = 0; m < 4; ++m) { int idx = u.pm * 254 + ai * HALF + wr * 64 + 4 * fr + m; idx = idx < nrows + 2 ? idx : nrows + 1; const float sc = rs[idx] * wsc;
#pragma unroll
                for (int bj = 0; bj < 2; ++bj)
#pragma unroll
                    for (int n = 0; n < 2; ++n) { const v4i32 q = __builtin_bit_cast(v4i32, acc[ai][bj][m][n]);
                        acc[ai][bj][m][n] = (f32x4){(float)q[0] * sc, (float)q[1] * sc, (float)q[2] * sc, (float)q[3] * sc}; } }
    }
    static __device__ __forceinline__ float shr1(float old, float src) {
        return __builtin_bit_cast(float, __builtin_amdgcn_update_dpp(__builtin_bit_cast(int, old), __builtin_bit_cast(int, src), 0x111, 0xf, 0xf, false)); }
    static __device__ __forceinline__ float gelu_t(float x) { const float t = 0.7978845608028654f * (x + 0.044715f * x * x * x); return x * __builtin_amdgcn_rcpf(1.0f + __builtin_amdgcn_exp2f(-2.8853900817779268f * t)); }
    __device__ __forceinline__ void operator()(const f32x4 (&acc)[2][2][4][2], const Unit& u, int wr, int wc, int fr, int fq) const {
        asm volatile("" : "+v"(fr), "+v"(fq));
#define XOFF(ai_, w_, rr_, bj_, n_) ((((((ai_) * 2 + (w_)) * 2 + (rr_)) * 2 + (bj_)) * 4 + wc) * 128 + fq * 32 + (n_) * 16)
        f32x4 wv[8];
        { const int gc = u.pn * HALF + wc * 32 + 8 * fq;
            wv[0] = *(const f32x4*)(cw + gc); wv[1] = *(const f32x4*)(cw + 2 * dff + gc); wv[2] = *(const f32x4*)(cw + 4 * dff + gc); wv[3] = *(const f32x4*)(cb + gc);
            wv[4] = *(const f32x4*)(cw + dff + gc); wv[5] = *(const f32x4*)(cw + 3 * dff + gc); wv[6] = *(const f32x4*)(cw + 5 * dff + gc); wv[7] = *(const f32x4*)(cb + dff + gc); }
        if (fr == 15) {
#pragma unroll
            for (int ai = 0; ai < 2; ++ai)
#pragma unroll
                for (int bj = 0; bj < 2; ++bj)
#pragma unroll
                    for (int n = 0; n < 2; ++n) { *(PG8_LAS f32x4*)(xl + XOFF(ai, wr, 0, bj, n)) = acc[ai][bj][2][n]; *(PG8_LAS f32x4*)(xl + XOFF(ai, wr, 1, bj, n)) = acc[ai][bj][3][n]; }
        }
        asm volatile("s_waitcnt lgkmcnt(0)" ::: "memory"); __builtin_amdgcn_s_barrier(); asm volatile("" ::: "memory");
        u32x2 keep[2][4];
#pragma unroll
        for (int n = 0; n < 2; ++n) {
            const int gcol = u.pn * HALF + wc * 32 + 8 * fq + 4 * n;
            if (n) { wv[0] = *(const f32x4*)(cw + gcol); wv[1] = *(const f32x4*)(cw + 2 * dff + gcol); wv[2] = *(const f32x4*)(cw + 4 * dff + gcol); wv[3] = *(const f32x4*)(cb + gcol);
                     wv[4] = *(const f32x4*)(cw + dff + gcol); wv[5] = *(const f32x4*)(cw + 3 * dff + gcol); wv[6] = *(const f32x4*)(cw + 5 * dff + gcol); wv[7] = *(const f32x4*)(cb + dff + gcol); }
            const f32x4 wg0 = wv[0], wg1 = wv[1], wg2 = wv[2], bg = wv[3], wu0 = wv[4], wu1 = wv[5], wu2 = wv[6], bu = wv[7];
#pragma unroll
            for (int ai = 0; ai < 2; ++ai) {
                f32x4 Xg2 = {0.f, 0.f, 0.f, 0.f}, Xg3 = Xg2, Xu2 = Xg2, Xu3 = Xg2;
                if (ai + wr > 0) { const int pa = wr ? ai : ai - 1, pw = wr ? 0 : 1;
                    Xg2 = *(const PG8_LAS f32x4*)(xl + XOFF(pa, pw, 0, 0, n)); Xg3 = *(const PG8_LAS f32x4*)(xl + XOFF(pa, pw, 1, 0, n));
                    Xu2 = *(const PG8_LAS f32x4*)(xl + XOFF(pa, pw, 0, 1, n)); Xu3 = *(const PG8_LAS f32x4*)(xl + XOFF(pa, pw, 1, 1, n)); }
                float o[4][4];
#pragma unroll
                for (int ip = 0; ip < 2; ++ip) {
                    const int i0 = 2 * ip, i1 = 2 * ip + 1;
#define P2(v) ((f32x2){(v)[i0], (v)[i1]})
                    const f32x2 g0 = P2(acc[ai][0][0][n]), g1 = P2(acc[ai][0][1][n]), g2 = P2(acc[ai][0][2][n]), g3 = P2(acc[ai][0][3][n]);
                    const f32x2 u0 = P2(acc[ai][1][0][n]), u1 = P2(acc[ai][1][1][n]), u2 = P2(acc[ai][1][2][n]), u3 = P2(acc[ai][1][3][n]);
                    const f32x2 gm1 = {shr1(Xg3[i0], g3.x), shr1(Xg3[i1], g3.y)}, gm2 = {shr1(Xg2[i0], g2.x), shr1(Xg2[i1], g2.y)};
                    const f32x2 um1 = {shr1(Xu3[i0], u3.x), shr1(Xu3[i1], u3.y)}, um2 = {shr1(Xu2[i0], u2.x), shr1(Xu2[i1], u2.y)};
                    const f32x2 a2 = P2(wg2), a1 = P2(wg1), a0 = P2(wg0), ab = P2(bg), c2 = P2(wu2), c1 = P2(wu1), c0 = P2(wu0), cb = P2(bu);
#define FMA2(a, b, c) __builtin_elementwise_fma((a), (b), (c))
                    const f32x2 zg[4] = {FMA2(a0, gm2, FMA2(a1, gm1, FMA2(a2, g0, ab))), FMA2(a0, gm1, FMA2(a1, g0, FMA2(a2, g1, ab))), FMA2(a0, g0, FMA2(a1, g1, FMA2(a2, g2, ab))), FMA2(a0, g1, FMA2(a1, g2, FMA2(a2, g3, ab)))};
                    const f32x2 zu[4] = {FMA2(c0, um2, FMA2(c1, um1, FMA2(c2, u0, cb))), FMA2(c0, um1, FMA2(c1, u0, FMA2(c2, u1, cb))), FMA2(c0, u0, FMA2(c1, u1, FMA2(c2, u2, cb))), FMA2(c0, u1, FMA2(c1, u2, FMA2(c2, u3, cb)))};
#pragma unroll
                    for (int m = 0; m < 4; ++m) {
                        const f32x2 x = zg[m], x2 = x * x; const f32x2 kk = {-2.302208198f, -2.302208198f}, k3 = {-2.302208198f * 0.044715f, -2.302208198f * 0.044715f}, one = {1.f, 1.f};
                        const f32x2 a = x * FMA2(x2, k3, kk); const f32x2 e = {__builtin_amdgcn_exp2f(a.x), __builtin_amdgcn_exp2f(a.y)}; const f32x2 d = e + one;
                        const f32x2 r = {__builtin_amdgcn_rcpf(d.x), __builtin_amdgcn_rcpf(d.y)}; const f32x2 ov = (x * zu[m]) * r;
                        o[m][i0] = ov.x; o[m][i1] = ov.y; }
#undef FMA2
#undef P2
                }
#pragma unroll
                for (int m = 0; m < 4; ++m) { const int it = ai * HALF + wr * 64 + 4 * fr + m, grow = u.pm * 254 - 2 + it;
                    u32x2 w; w.x = cvt_pk_bf16(o[m][0], o[m][1]); w.y = cvt_pk_bf16(o[m][2], o[m][3]);
                    if (n == 0) keep[ai][m] = w;
                    else if (it >= 2 && grow < nrows) { u32x4 ww; ww.x = keep[ai][m].x; ww.y = keep[ai][m].y; ww.z = w.x; ww.w = w.y; *(u32x4*)(ACT + (size_t)grow * dff + gcol - 4) = ww; } }
            }
        }
#undef XOFF
    }
};

template <class Epi, class Sched, bool ALIGN_EPI = false, bool SP2 = false, int QM = 0>
__device__ __forceinline__ void gemm_phase(PG8_LAS unsigned char* lds, const Gemm g, const Sched& S, const Epi& E) {
    const int tid = mk_tid(), wid = __builtin_amdgcn_readfirstlane(tid >> 6), lane = tid & 63, wr = wid >> 2, wc = wid & 3, fr = lane & 15, fq = lane >> 4;
    const int K = g.K, nt = K / BK;
    unsigned voffA, voffB;
    { int R, C; stage_rc(tid * 16, R, C); const int Rb = Epi::PERM ? ((R & ~31) + perm32(R & 31)) : R;
        const int Ra = Epi::APERM ? ((R & ~63) + 4 * (R & 15) + ((R >> 4) & 3)) : R;
        voffA = (unsigned)(Ra * K + C) * 2u; voffB = (unsigned)(Rb * K + C) * 2u; }
    const size_t r64 = (size_t)64 * K * 2;
    const size_t kstep = (size_t)(BK * 2);
    const size_t hstep = (size_t)HALF * K * 2;
    const size_t tstep = 2 * hstep;
    const size_t tstepA = (size_t)g.apr * K * 2;
    const unsigned ldsw = (unsigned)wid * 1024u;
    const int aoff = lds_byte(wr * 64 + fr, fq * 8), boff = lds_byte(wc * 32 + fr, fq * 8);
#define PG8_SA(b, h) (((b) * 2 + (h)) * HTB)
#define PG8_SB(b, h) ((4 + (b) * 2 + (h)) * HTB)
#define PG8_STAGE(bufoff, gbase, voff) do { _Pragma("unroll") for (int _i = 0; _i < 2; ++_i) \
        __builtin_amdgcn_global_load_lds((const unsigned*)((const char*)(gbase) + (size_t)_i * r64 + (voff)), (PG8_LAS unsigned*)(lds + (bufoff) + ldsw + _i * 8192), 16, 0, 0); } while (0)
#define PG8_LDA(dst, b, h) do { _Pragma("unroll") for (int m = 0; m < 4; ++m) _Pragma("unroll") for (int k = 0; k < 2; ++k) dst[m][k] = *(const PG8_LAS bf16x8*)(lds + PG8_SA(b, h) + aoff + m * 2048 + k * 1024); } while (0)
#define PG8_LDB(dst, b, h) do { _Pragma("unroll") for (int n = 0; n < 2; ++n) _Pragma("unroll") for (int k = 0; k < 2; ++k) dst[n][k] = *(const PG8_LAS bf16x8*)(lds + PG8_SB(b, h) + boff + n * 2048 + k * 1024); } while (0)
#define PG8_CAT(f) __builtin_shufflevector(__builtin_bit_cast(v4i32, (f)[0]), __builtin_bit_cast(v4i32, (f)[1]), 0, 1, 2, 3, 4, 5, 6, 7)
#define PG8_MMA(ai, bj, At, Bt) do { __builtin_amdgcn_s_setprio(1); _Pragma("unroll") for (int m = 0; m < 4; ++m) _Pragma("unroll") for (int n = 0; n < 2; ++n) { \
        if constexpr (QM == 1) acc[ai][bj][m][n] = __builtin_amdgcn_mfma_scale_f32_16x16x128_f8f6f4(PG8_CAT(Bt[n]), PG8_CAT(At[m]), acc[ai][bj][m][n], 0, 0, 0, F8_SCALE_W, 0, F8_SCALE_X); \
        else if constexpr (QM == 2) { _Pragma("unroll") for (int k = 0; k < 2; ++k) acc[ai][bj][m][n] = __builtin_bit_cast(f32x4, __builtin_amdgcn_mfma_i32_16x16x64_i8( \
            __builtin_bit_cast(v4i32, Bt[n][k]), __builtin_bit_cast(v4i32, At[m][k]), __builtin_bit_cast(v4i32, acc[ai][bj][m][n]), 0, 0, 0)); } \
        else { _Pragma("unroll") for (int k = 0; k < 2; ++k) acc[ai][bj][m][n] = __builtin_amdgcn_mfma_f32_16x16x32_bf16(Bt[n][k], At[m][k], acc[ai][bj][m][n], 0, 0, 0); } } \
        __builtin_amdgcn_s_setprio(0); } while (0)
#define PG8_WAIT_V(n) asm volatile("s_waitcnt vmcnt(" #n ")" ::: "memory")
#define PG8_WAIT_L(n) asm volatile("s_waitcnt lgkmcnt(" #n ")" ::: "memory")
#define PG8_BAR __builtin_amdgcn_s_barrier()
#define PG8_SCHED __builtin_amdgcn_sched_barrier(0)
    Unit cur, nxt; int ui = 0;
    if (!S.next(0, cur)) return;
    f32x4 acc[2][2][4][2];
#pragma unroll
    for (int a = 0; a < 2; ++a)
#pragma unroll
        for (int b = 0; b < 2; ++b)
#pragma unroll
            for (int m = 0; m < 4; ++m)
#pragma unroll
                for (int n = 0; n < 2; ++n) acc[a][b][m][n] = (f32x4){0.f, 0.f, 0.f, 0.f};
    bf16x8 At[4][2], B0[2][2], B1[2][2];
    const char* cA = (const char*)g.A + (size_t)cur.pm * tstepA; const char* cB = (const char*)g.Bt + (size_t)cur.pn * tstep;
    S.a_ready(cur);
    if constexpr (SP2) {
        PG8_STAGE(PG8_SB(0, 0), cB, voffB); PG8_STAGE(PG8_SB(0, 1), cB + hstep, voffB); PG8_STAGE(PG8_SA(0, 0), cA, voffA); PG8_STAGE(PG8_SA(0, 1), cA + hstep, voffA);
        if (wr == 1) PG8_BAR;
        PG8_WAIT_V(2); PG8_BAR;
        PG8_STAGE(PG8_SB(1, 0), cB + kstep, voffB); PG8_STAGE(PG8_SA(1, 0), cA + kstep, voffA); PG8_STAGE(PG8_SB(1, 1), cB + hstep + kstep, voffB);
        PG8_WAIT_V(6); PG8_BAR;
    } else {
        PG8_STAGE(PG8_SB(0, 0), cB, voffB); PG8_STAGE(PG8_SA(0, 0), cA, voffA); PG8_STAGE(PG8_SB(0, 1), cB + hstep, voffB); PG8_STAGE(PG8_SA(0, 1), cA + hstep, voffA);
        if (wr == 1) PG8_BAR;
        PG8_WAIT_V(4); PG8_BAR;
        PG8_STAGE(PG8_SB(1, 0), cB + kstep, voffB); PG8_STAGE(PG8_SA(1, 0), cA + kstep, voffA); PG8_STAGE(PG8_SB(1, 1), cB + hstep + kstep, voffB);
        PG8_WAIT_V(6); PG8_BAR;
    }
    for (;;) {
        const bool has_next = S.next(ui + 1, nxt);
        const char* nA = has_next ? (const char*)g.A + (size_t)nxt.pm * tstepA : cA; const char* nB = has_next ? (const char*)g.Bt + (size_t)nxt.pn * tstep : cB;
        for (int t = 0; t < nt; t += 2) {
            const bool last = (t == nt - 2);
            const char* a1 = cA + (size_t)(t + 1) * kstep;
            const char* a2 = last ? nA : cA + (size_t)(t + 2) * kstep; const char* b2 = last ? nB : cB + (size_t)(t + 2) * kstep;
            const char* a3 = a2 + kstep; const char* b3 = b2 + kstep;
            if (last && has_next) S.a_ready(nxt);
            if constexpr (SP2) {
            PG8_LDB(B0, 0, 0); PG8_LDB(B1, 0, 1); PG8_SCHED; PG8_LDA(At, 0, 0); PG8_STAGE(PG8_SA(1, 1), a1 + hstep, voffA);
            PG8_WAIT_V(8); PG8_WAIT_L(0); PG8_BAR; PG8_MMA(0, 0, At, B0); PG8_MMA(0, 1, At, B1); PG8_BAR; PG8_SCHED;
            PG8_LDA(At, 0, 1); PG8_STAGE(PG8_SB(0, 0), b2, voffB); PG8_STAGE(PG8_SB(0, 1), b2 + hstep, voffB); PG8_STAGE(PG8_SA(0, 0), a2, voffA);
            PG8_WAIT_V(8); PG8_WAIT_L(0); PG8_BAR; PG8_MMA(1, 0, At, B0); PG8_MMA(1, 1, At, B1); PG8_BAR; PG8_SCHED;
            PG8_LDB(B0, 1, 0); PG8_LDB(B1, 1, 1); PG8_SCHED; PG8_LDA(At, 1, 0); PG8_STAGE(PG8_SA(0, 1), a2 + hstep, voffA);
            PG8_WAIT_V(8); PG8_WAIT_L(0); PG8_BAR; PG8_MMA(0, 0, At, B0); PG8_MMA(0, 1, At, B1); PG8_BAR; PG8_SCHED;
            PG8_LDA(At, 1, 1); PG8_STAGE(PG8_SB(1, 0), b3, voffB); PG8_STAGE(PG8_SB(1, 1), b3 + hstep, voffB); PG8_STAGE(PG8_SA(1, 0), a3, voffA);
            PG8_WAIT_V(8); PG8_WAIT_L(0); PG8_BAR; PG8_MMA(1, 0, At, B0); PG8_MMA(1, 1, At, B1); PG8_BAR; PG8_SCHED;
            } else {
            PG8_LDB(B0, 0, 0); PG8_SCHED; PG8_LDA(At, 0, 0); PG8_STAGE(PG8_SA(1, 1), a1 + hstep, voffA);
            PG8_WAIT_L(8); PG8_BAR; PG8_WAIT_L(0); PG8_MMA(0, 0, At, B0); PG8_BAR; PG8_SCHED;
            PG8_LDB(B1, 0, 1); PG8_STAGE(PG8_SB(0, 0), b2, voffB);
            PG8_BAR; PG8_WAIT_L(0); PG8_MMA(0, 1, At, B1); PG8_BAR;
            PG8_LDA(At, 0, 1); PG8_STAGE(PG8_SA(0, 0), a2, voffA);
            PG8_BAR; PG8_WAIT_L(0); PG8_MMA(1, 0, At, B0); PG8_BAR; PG8_SCHED;
            PG8_STAGE(PG8_SB(0, 1), b2 + hstep, voffB);
            PG8_WAIT_V(6); PG8_BAR; PG8_MMA(1, 1, At, B1); PG8_BAR;
            PG8_LDB(B0, 1, 0); PG8_SCHED; PG8_LDA(At, 1, 0); PG8_STAGE(PG8_SA(0, 1), a2 + hstep, voffA);
            PG8_WAIT_L(8); PG8_BAR; PG8_WAIT_L(0); PG8_MMA(0, 0, At, B0); PG8_BAR; PG8_SCHED;
            PG8_LDB(B1, 1, 1); PG8_STAGE(PG8_SB(1, 0), b3, voffB);
            PG8_BAR; PG8_WAIT_L(0); PG8_MMA(0, 1, At, B1); PG8_BAR;
            PG8_LDA(At, 1, 1); PG8_STAGE(PG8_SA(1, 0), a3, voffA);
            PG8_BAR; PG8_WAIT_L(0); PG8_MMA(1, 0, At, B0); PG8_BAR; PG8_SCHED;
            PG8_STAGE(PG8_SB(1, 1), b3 + hstep, voffB);
            PG8_WAIT_V(6); PG8_BAR; PG8_MMA(1, 1, At, B1); PG8_BAR;
            }
        }
        if constexpr (ALIGN_EPI) { if (wr == 0) PG8_BAR; }
        if constexpr (QM == 2) E.dequant(acc, cur, wr, wc, fr, fq);
        if constexpr (!Epi::AFTER_DRAIN) { E(acc, cur, wr, wc, fr, fq); S.done(cur); }
        if (!has_next) break;
#pragma unroll
        for (int a = 0; a < 2; ++a)
#pragma unroll
            for (int b = 0; b < 2; ++b)
#pragma unroll
                for (int m = 0; m < 4; ++m)
#pragma unroll
                    for (int n = 0; n < 2; ++n) acc[a][b][m][n] = (f32x4){0.f, 0.f, 0.f, 0.f};
        cur = nxt; cA = nA; cB = nB; ++ui;
        if constexpr (ALIGN_EPI) { if (wr == 1) PG8_BAR; }
    }
    PG8_WAIT_V(0);
    if constexpr (!ALIGN_EPI) { if (wr == 0) PG8_BAR; }
    PG8_BAR;
    if constexpr (Epi::AFTER_DRAIN) { E.fused(acc, cur, wr, wc, fr, fq, lds, wid, lane); S.done(cur); }
#undef PG8_SA
#undef PG8_SB
#undef PG8_STAGE
#undef PG8_LDA
#undef PG8_LDB
#undef PG8_MMA
#undef PG8_CAT
#undef PG8_WAIT_V
#undef PG8_WAIT_L
#undef PG8_BAR
#undef PG8_SCHED
}
}

namespace fox {
#define LAS3 __attribute__((address_space(3)))
constexpr int D = 128, SEQ = 16384, NH = 32, OPITCH = 4096;
constexpr float SCALE = 0.08838834764831845f;
constexpr float THR = 8.f;
constexpr int NW = 8, QBLK = 32, KVBLK = 64, QB = NW * QBLK;
constexpr int SHM_V = KVBLK * D * 2, SHM_K = KVBLK * D * 2;
constexpr int OFF_WS = 2 * SHM_V + 2 * SHM_K, OFF_BIAS = OFF_WS + NW * 64 * 4, OFF_QW = OFF_BIAS + 2 * 64 * 4, OFF_JLO = OFF_QW + 16, OFF_KEY = OFF_JLO + 2048, OFF_ORD = OFF_KEY + 8192, LDS_BYTES = OFF_ORD + 4096;
constexpr float SKIP_T = 30.f;
typedef unsigned short bf16;
typedef short bf16x8 __attribute__((ext_vector_type(8)));
typedef short s16x4 __attribute__((ext_vector_type(4)));
typedef float f32x16 __attribute__((ext_vector_type(16)));
typedef float f32x4 __attribute__((ext_vector_type(4)));
typedef unsigned u32x4 __attribute__((ext_vector_type(4)));

#define KSWZ(row, colB) ((row) * 256 + ((colB) ^ (((row) & 7) << 4)))
#define SBAR() __builtin_amdgcn_sched_barrier(0)
__device__ __forceinline__ int v_st(int k, int c) { const int kk = (k & ~0xC) | ((k & 4) << 1) | ((k & 8) >> 1); return ((kk >> 3) * 4 + (c >> 5)) * 512 + ((kk & 7) * 32 + (c & 31)) * 2; }
__device__ __forceinline__ int v_rd_base(int lane) { return ((lane & 3) << 3) | (((lane >> 2) & 3) << 6) | (((lane >> 4) & 1) << 5) | (((lane >> 5) & 1) << 8); }
constexpr int v_rd_off(int d0, int ks, int half) { return d0 * 512 + ks * 4096 + half * 2048; }
__device__ __forceinline__ int crow(int r, int hi) { return (r & 3) + 8 * (r >> 2) + 4 * hi; }
__device__ __forceinline__ unsigned cvtpk(float lo, float hi) { unsigned r; asm volatile("v_cvt_pk_bf16_f32 %0, %1, %2" : "=v"(r) : "v"(lo), "v"(hi)); return r; }
__device__ __forceinline__ bf16x8 load8(const bf16* p) { return *reinterpret_cast<const bf16x8*>(p); }
__device__ __forceinline__ void mask_tile(f32x16& p0, f32x16& p1, int dq) {
    const float NEG = -__builtin_inff();
#pragma unroll
    for (int r = 0; r < 16; ++r) {
        const int c = (r & 3) + 8 * (r >> 2);
        if (dq - c < 0) p0[r] = NEG;
        if (dq - c - 32 < 0) p1[r] = NEG;
    }
}
__device__ __forceinline__ void partialSM(f32x16& p0, f32x16& p1, float& m_reg, float& mn, float& alpha) {
    float pmax = p0[0]; for (int r = 1; r < 16; ++r) pmax = fmaxf(pmax, p0[r]); for (int r = 0; r < 16; ++r) pmax = fmaxf(pmax, p1[r]);
    { auto rr = __builtin_amdgcn_permlane32_swap(__float_as_uint(pmax), __float_as_uint(pmax), false, false);
      pmax = fmaxf(__uint_as_float(rr[0]), __uint_as_float(rr[1])); }
    constexpr float C2 = 1.4426950408889634f * SCALE;
    if (__builtin_expect(__all((pmax - m_reg) * SCALE <= THR), 1)) { mn = m_reg; alpha = 1.f; }
    else { mn = fmaxf(m_reg, pmax); alpha = __builtin_amdgcn_exp2f((m_reg - mn) * C2); m_reg = mn; }
    const float mnL = -mn * C2;
    for (int r = 0; r < 16; ++r) p0[r] = fmaf(p0[r], C2, mnL); for (int r = 0; r < 16; ++r) p1[r] = fmaf(p1[r], C2, mnL);
    for (int r = 0; r < 16; ++r) p0[r] = __builtin_amdgcn_exp2f(p0[r]);
}
__device__ __forceinline__ void finishSM(f32x16& p0, f32x16& p1, float alpha, float& l_reg, bf16x8& pa0, bf16x8& pa1, bf16x8& pa2, bf16x8& pa3) {
    for (int r = 0; r < 16; ++r) p1[r] = __builtin_amdgcn_exp2f(p1[r]);
    float ps = 0; for (int r = 0; r < 16; ++r) ps += p0[r]; for (int r = 0; r < 16; ++r) ps += p1[r];
    { auto rr = __builtin_amdgcn_permlane32_swap(__float_as_uint(ps), __float_as_uint(ps), false, false);
      ps = __uint_as_float(rr[0]) + __uint_as_float(rr[1]); }
    l_reg = l_reg * alpha + ps;
#define PK4(P, B_, OUT) do { unsigned a0 = cvtpk(P[B_+0], P[B_+1]), a1 = cvtpk(P[B_+2], P[B_+3]);                          \
        unsigned b0 = cvtpk(P[B_+4], P[B_+5]), b1 = cvtpk(P[B_+6], P[B_+7]);                                             \
        auto r0 = __builtin_amdgcn_permlane32_swap(a0, b0, false, false); auto r1 = __builtin_amdgcn_permlane32_swap(a1, b1, false, false); \
        u32x4 w = {r0[0], r1[0], r0[1], r1[1]}; OUT = *reinterpret_cast<bf16x8*>(&w); } while (0)
    PK4(p0, 0, pa0); PK4(p0, 8, pa1); PK4(p1, 0, pa2); PK4(p1, 8, pa3);
}
template <int KB>
__device__ __forceinline__ void qkt(f32x16& p0, f32x16& p1, const char* K_lds, const char* B_lds, int r32, int hi, const bf16x8* qr) {
    const float* bl = (const float*)B_lds + KB * 64 + 4 * hi;
#pragma unroll
    for (int g = 0; g < 4; ++g) { const f32x4 a = *(const f32x4*)(bl + 8 * g), b = *(const f32x4*)(bl + 32 + 8 * g);
        p0[4 * g + 0] = a[0]; p0[4 * g + 1] = a[1]; p0[4 * g + 2] = a[2]; p0[4 * g + 3] = a[3];
        p1[4 * g + 0] = b[0]; p1[4 * g + 1] = b[1]; p1[4 * g + 2] = b[2]; p1[4 * g + 3] = b[3]; }
    const char* kb[4];
#pragma unroll
    for (int dd = 0; dd < 4; ++dd) kb[dd] = K_lds + KB * SHM_K + KSWZ(r32, (dd * 16 + hi * 8) * 2);
#pragma unroll
    for (int d0 = 0; d0 < 8; ++d0) { const char* a = kb[d0 & 3] + (d0 >> 2) * 128;
        bf16x8 b0 = *reinterpret_cast<const bf16x8*>(a);
        bf16x8 b1 = *reinterpret_cast<const bf16x8*>(a + 32 * 256);
        p0 = __builtin_amdgcn_mfma_f32_32x32x16_bf16(b0, qr[d0], p0, 0, 0, 0);
        p1 = __builtin_amdgcn_mfma_f32_32x32x16_bf16(b1, qr[d0], p1, 0, 0, 0); }
}
template <int VB>
__device__ __forceinline__ void pv_tile(f32x16* o, int vb0, bf16x8 pa0, bf16x8 pa1, bf16x8 pa2, bf16x8 pa3) {
#define TRRD(dst, off) asm volatile("ds_read_b64_tr_b16 %0, %1 offset:%2" : "=&v"(dst) : "v"(vb0), "i"(off) : "memory")
#define PV_D0(d0) do { s16x4 l0, l1, l2, l3, h0, h1, h2, h3; constexpr int b_ = VB * SHM_V + v_rd_off(d0, 0, 0);     \
        TRRD(l0, b_); TRRD(h0, b_ + 2048); TRRD(l1, b_ + 4096); TRRD(h1, b_ + 6144); TRRD(l2, b_ + 8192); TRRD(h2, b_ + 10240); TRRD(l3, b_ + 12288); TRRD(h3, b_ + 14336); \
        asm volatile("s_waitcnt lgkmcnt(0)" ::: "memory"); SBAR();                                                                              \
        o[d0] = __builtin_amdgcn_mfma_f32_32x32x16_bf16((bf16x8){l0[0], l0[1], l0[2], l0[3], h0[0], h0[1], h0[2], h0[3]}, pa0, o[d0], 0, 0, 0);   \
        o[d0] = __builtin_amdgcn_mfma_f32_32x32x16_bf16((bf16x8){l1[0], l1[1], l1[2], l1[3], h1[0], h1[1], h1[2], h1[3]}, pa1, o[d0], 0, 0, 0);   \
        o[d0] = __builtin_amdgcn_mfma_f32_32x32x16_bf16((bf16x8){l2[0], l2[1], l2[2], l2[3], h2[0], h2[1], h2[2], h2[3]}, pa2, o[d0], 0, 0, 0);   \
        o[d0] = __builtin_amdgcn_mfma_f32_32x32x16_bf16((bf16x8){l3[0], l3[1], l3[2], l3[3], h3[0], h3[1], h3[2], h3[3]}, pa3, o[d0], 0, 0, 0); } while (0)
    PV_D0(0); PV_D0(1); PV_D0(2); PV_D0(3);
#undef PV_D0
#undef TRRD
}

struct BlockRef { const bf16* Q; const bf16* K; const bf16* V; const float* C; bf16* O; int P0; int jlo; };
struct Seam {
    bf16x8 qr[8];
    bf16x8 st_v0, st_v1, st_k0, st_k1; float st_b;
};
#define ROW(p, k0, rr) ((p) + (size_t)((k0) + (rr)) * D + sc)
#define VMW() asm volatile("s_waitcnt vmcnt(0)" ::: "memory")
#define VMWN(n) asm volatile("s_waitcnt vmcnt(%0)" :: "i"(n) : "memory")
#define SLOAD_H(Kp, Vp, Cp, k0) do { S.st_v0 = load8(ROW(Vp, k0, sr)); S.st_v1 = load8(ROW(Vp, k0, 32 + sr));              \
                         S.st_k0 = load8(ROW(Kp, k0, sr)); S.st_k1 = load8(ROW(Kp, k0, 32 + sr)); if (tid < 64) S.st_b = (Cp)[(k0) + tid]; } while (0)
#define SWRITE_HK(bf, cr) do { *(bf16x8*)(K_lds + (bf) * SHM_K + kws) = S.st_k0; *(bf16x8*)(K_lds + (bf) * SHM_K + kws + 32 * 256) = S.st_k1; \
                         if (tid < 64) ((float*)B_lds)[(bf) * 64 + tid] = S.st_b - (cr); } while (0)
#define SWRITE_HV(bf) do { *(bf16x8*)(V_lds + (bf) * SHM_V + vst0) = S.st_v0; *(bf16x8*)(V_lds + (bf) * SHM_V + vst1) = S.st_v1; } while (0)
#define SWRITE_H(bf, cr) do { SWRITE_HV(bf); SWRITE_HK(bf, cr); } while (0)
__device__ __forceinline__ void fox_prime(const BlockRef& cur, char* lds, Seam& S) {
    const int tid = mk_tid(), wid = __builtin_amdgcn_readfirstlane(tid >> 6), lane = tid & 63, r32 = lane & 31, hi = lane >> 5;
    const int sr = tid >> 4, sc = (tid & 15) * 8, kws = KSWZ(sr, sc * 2); char* K_lds = lds + 2 * SHM_V; char* B_lds = lds + OFF_BIAS;
    const float cref = __uint_as_float(__builtin_amdgcn_readfirstlane(__float_as_uint(cur.C[cur.P0])));
    for (int d0 = 0; d0 < 8; ++d0) S.qr[d0] = load8(cur.Q + (size_t)(wid * QBLK + r32) * D + d0 * 16 + hi * 8);
    SLOAD_H(cur.K, cur.V, cur.C, cur.jlo * KVBLK); VMW(); SWRITE_HK(0, cref);
    __syncthreads();
}
template <class NextFn> __device__ __forceinline__ BlockRef fox_block(const BlockRef& cur, char* lds, Seam& S, unsigned* qctr, const NextFn& mkref, bool& has_next) {
    const int tid = mk_tid(), wid = __builtin_amdgcn_readfirstlane(tid >> 6), lane = tid & 63, r32 = lane & 31, hi = lane >> 5;
    const int j_lo = cur.jlo, NT = (cur.P0 + QB - 1) / KVBLK + 1 - j_lo;
    unsigned qv = 0u; if (tid == 0) qv = __hip_atomic_fetch_add(qctr, 1u, __ATOMIC_RELAXED, __HIP_MEMORY_SCOPE_AGENT);
    const int qlo = cur.P0 + wid * QBLK, qm = qlo + r32 - 4 * hi;
    char* V_lds = lds; char* K_lds = lds + 2 * SHM_V; char* B_lds = lds + OFF_BIAS;
    float m_reg = -1e30f, l_reg = 0; f32x16 o[4] = {};
    const int sr = tid >> 4, sc = (tid & 15) * 8, vst0 = v_st(sr, sc), vst1 = v_st(32 + sr, sc), kws = KSWZ(sr, sc * 2);
    const int vb0 = (int)(uintptr_t)V_lds + v_rd_base(lane);
    const bf16* Kh = cur.K; const bf16* Vh = cur.V; const float* Ch = cur.C;
    const float cref = __uint_as_float(__builtin_amdgcn_readfirstlane(__float_as_uint(cur.C[cur.P0])));
#define RESC(a) do { if (__any((a) < 1.f)) { for (int d_ = 0; d_ < 4; ++d_) for (int r = 0; r < 16; ++r) o[d_][r] *= (a); } } while (0)
#define KBASE(t) ((j_lo + (t)) * KVBLK)
#define MASKT(P0_, P1_, t) do { const int kb_ = KBASE(t); if (kb_ + KVBLK - 1 > qlo) mask_tile(P0_, P1_, qm - kb_); } while (0)
    constexpr int NQL = 8;
#define SEAM_K0() do { VMWN(NQL); SWRITE_HK(0, crefn); SBAR(); } while (0)
    f32x16 pA0, pA1, pB0, pB1; float mnA, mnB, alA, alB; bf16x8 pa0, pa1, pa2, pa3;
    SWRITE_HV(0); SBAR();
    if (NT > 1) { SLOAD_H(Kh, Vh, Ch, KBASE(1)); }
    SBAR(); qkt<0>(pA0, pA1, K_lds, B_lds, r32, hi, S.qr);
    MASKT(pA0, pA1, 0); partialSM(pA0, pA1, m_reg, mnA, alA);
    if (NT > 1) { VMW(); SWRITE_H(1, cref); }
    if (tid == 0) *(volatile LAS3 unsigned*)(lds + OFF_QW) = qv;
    __syncthreads();
    const unsigned inext = (unsigned)__builtin_amdgcn_readfirstlane((int)*(volatile LAS3 unsigned*)(lds + OFF_QW)); has_next = inext < (unsigned)(NH * (SEQ / QB));
    const BlockRef nxt = has_next ? mkref((int)inext) : cur;
    const float crefn = __uint_as_float(__builtin_amdgcn_readfirstlane(__float_as_uint(nxt.C[nxt.P0]))); const int kbn = nxt.jlo * KVBLK;
#define HALF_STEP(PX0, PX1, mnX, alX, PY0, PY1, alY, t, KB, VB, SB) do {                                                      \
        SBAR(); qkt<KB>(PX0, PX1, K_lds, B_lds, r32, hi, S.qr);                                                               \
        finishSM(PY0, PY1, alY, l_reg, pa0, pa1, pa2, pa3); SBAR();                                                           \
        if ((t) + 1 < NT) { SLOAD_H(Kh, Vh, Ch, KBASE((t) + 1)); SBAR(); }                                                    \
        pv_tile<VB>(o, vb0, pa0, pa1, pa2, pa3); MASKT(PX0, PX1, (t)); partialSM(PX0, PX1, m_reg, mnX, alX);                  \
        __syncthreads();                                                                                                      \
        if ((t) + 1 < NT) { VMW(); SWRITE_H(SB, cref); }                                                                      \
        RESC(alX); __syncthreads(); } while (0)
    for (int t = 1; t + 1 < NT; t += 2) {
        HALF_STEP(pB0, pB1, mnB, alB, pA0, pA1, alA, t, 1, 0, 0);
        HALF_STEP(pA0, pA1, mnA, alA, pB0, pB1, alB, t + 1, 0, 1, 1);
    }
    const bool even = (NT & 1) == 0;
    if (even) { SBAR(); qkt<1>(pB0, pB1, K_lds, B_lds, r32, hi, S.qr); SBAR(); }
    SLOAD_H(nxt.K, nxt.V, nxt.C, kbn); SBAR();
#pragma unroll
    for (int d0 = 0; d0 < 8; ++d0) S.qr[d0] = load8(nxt.Q + (size_t)(wid * QBLK + r32) * D + d0 * 16 + hi * 8);
    SBAR();
    finishSM(pA0, pA1, alA, l_reg, pa0, pa1, pa2, pa3); SBAR();
    pv_tile<0>(o, vb0, pa0, pa1, pa2, pa3);
    if (even) { MASKT(pB0, pB1, NT - 1); partialSM(pB0, pB1, m_reg, mnB, alB); __syncthreads(); RESC(alB);
        finishSM(pB0, pB1, alB, l_reg, pa0, pa1, pa2, pa3); SBAR(); pv_tile<1>(o, vb0, pa0, pa1, pa2, pa3); }
    SBAR(); SEAM_K0();
    {
        const float rl = __builtin_amdgcn_rcpf(l_reg);
        bf16* Ow = cur.O + (size_t)(wid * QBLK + r32) * OPITCH + 8 * hi;
#pragma unroll
        for (int d0 = 0; d0 < 4; ++d0)
#pragma unroll
            for (int gp = 0; gp < 2; ++gp) { const int b_ = 8 * gp;
                const unsigned a0 = cvtpk(o[d0][b_ + 0] * rl, o[d0][b_ + 1] * rl), a1 = cvtpk(o[d0][b_ + 2] * rl, o[d0][b_ + 3] * rl);
                const unsigned b0 = cvtpk(o[d0][b_ + 4] * rl, o[d0][b_ + 5] * rl), b1 = cvtpk(o[d0][b_ + 6] * rl, o[d0][b_ + 7] * rl);
                auto r0 = __builtin_amdgcn_permlane32_swap(a0, b0, false, false); auto r1 = __builtin_amdgcn_permlane32_swap(a1, b1, false, false);
                u32x4 w = {r0[0], r1[0], r0[1], r1[1]}; *(u32x4*)(Ow + d0 * 32 + 16 * gp) = w; }
    }
    __syncthreads();
    return nxt;
#undef RESC
#undef KBASE
#undef MASKT
#undef SEAM_K0
#undef HALF_STEP
}
#undef ROW
#undef VMW
#undef VMWN
#undef SLOAD_H
#undef SWRITE_HK
#undef SWRITE_HV
#undef SWRITE_H
#undef PK4

__device__ __forceinline__ BlockRef fox_ref(int item, const bf16* Q, const bf16* K, const bf16* V, const float* Cn, bf16* O, const char* lds) {
    const int e = (int)((const unsigned short*)(lds + OFF_ORD))[item], qb = e & 63, bh = e >> 6;
    BlockRef r; r.Q = Q + ((size_t)bh * SEQ + (size_t)qb * QB) * D; r.K = K + (size_t)bh * SEQ * D; r.V = V + (size_t)bh * SEQ * D; r.C = Cn + (size_t)bh * SEQ;
    r.O = O + (size_t)(qb * QB) * OPITCH + bh * D; r.P0 = qb * QB; r.jlo = (int)((const unsigned char*)(lds + OFF_JLO))[bh * 64 + qb]; return r;
}
__device__ __forceinline__ void fox_attn_phase(char* lds, const bf16* Q, const bf16* K, const bf16* V, const float* Cn, const unsigned* nrm2, unsigned* qctr, bf16* O) {
    const int tid = mk_tid();
    {
        int lo[4], hi[4]; float thr[4]; const float* Cb[4];
#pragma unroll
        for (int k = 0; k < 4; ++k) { const int e = tid + 512 * k, bh = e >> 6, qb = e & 63, P0 = qb * QB; Cb[k] = Cn + (size_t)bh * SEQ;
            const float qn2 = __uint_as_float(nrm2[bh]), kn2 = __uint_as_float(nrm2[32 + bh]);
            const float Dh = SKIP_T * (1.0f / SCALE) + 2.04f * sqrtf(qn2 * kn2) + 1.0f;
            thr[k] = Cb[k][P0] - Dh; lo[k] = 0; hi[k] = P0 / KVBLK; }
#pragma unroll 1
        for (int it = 0; it < 8; ++it) {
            float v[4]; int mid[4];
#pragma unroll
            for (int k = 0; k < 4; ++k) { mid[k] = (lo[k] + hi[k]) >> 1; v[k] = Cb[k][mid[k] * KVBLK + KVBLK - 1]; }
#pragma unroll
            for (int k = 0; k < 4; ++k) if (lo[k] < hi[k]) { if (v[k] < thr[k]) lo[k] = mid[k] + 1; else hi[k] = mid[k]; }
        }
#pragma unroll
        for (int k = 0; k < 4; ++k) ((unsigned char*)(lds + OFF_JLO))[tid + 512 * k] = (unsigned char)lo[k];
        unsigned key[4];
#pragma unroll
        for (int k = 0; k < 4; ++k) { const int e = tid + 512 * k, qb = e & 63; key[k] = (unsigned)(4 * qb + 4 - lo[k]) * 2048u + (unsigned)(2047 - e); ((unsigned*)(lds + OFF_KEY))[e] = key[k]; }
        __syncthreads();
        unsigned rank[4] = {0u, 0u, 0u, 0u};
#pragma unroll 4
        for (int j = 0; j < 512; ++j) { const u32x4 kv = ((const u32x4*)(lds + OFF_KEY))[j];
#pragma unroll
            for (int k = 0; k < 4; ++k) rank[k] += (kv.x > key[k] ? 1u : 0u) + (kv.y > key[k] ? 1u : 0u) + (kv.z > key[k] ? 1u : 0u) + (kv.w > key[k] ? 1u : 0u); }
#pragma unroll
        for (int k = 0; k < 4; ++k) ((unsigned short*)(lds + OFF_ORD))[rank[k]] = (unsigned short)(tid + 512 * k);
    }
    if (tid == 0) *(volatile LAS3 unsigned*)(lds + OFF_QW) = __hip_atomic_fetch_add(qctr, 1u, __ATOMIC_RELAXED, __HIP_MEMORY_SCOPE_AGENT);
    __syncthreads();
    const unsigned i0 = (unsigned)__builtin_amdgcn_readfirstlane((int)*(volatile LAS3 unsigned*)(lds + OFF_QW));
    if (i0 >= (unsigned)(NH * (SEQ / QB))) return;
    __syncthreads();
    auto mk = [=](int item) { return fox_ref(item, Q, K, V, Cn, O, lds); };
    BlockRef cur = mk((int)i0);
    Seam S;
    fox_prime(cur, lds, S);
    for (;;) { bool has_next; const BlockRef nxt = fox_block(cur, lds, S, qctr, mk, has_next); if (!has_next) break; cur = nxt; }
}
#undef LAS3
#undef KSWZ
#undef SBAR
}

namespace swa {
constexpr int SEQ = 16384, QKVP = 5120, OP = 4096;
constexpr int K_OFF = 0, VT_OFF = 32768, VT_PITCH = 528, LI_OFF = VT_OFF + 64 * VT_PITCH, LDS_BYTES = LI_OFF + 8 * 32 * 4;
typedef unsigned short bf16;
typedef short bf16x8 __attribute__((ext_vector_type(8)));
typedef float f32x16 __attribute__((ext_vector_type(16)));
typedef float f32x4 __attribute__((ext_vector_type(4)));
typedef unsigned u32x4 __attribute__((ext_vector_type(4)));
__device__ __forceinline__ int crow(int r, int hi) { return (r & 3) + 8 * (r >> 2) + 4 * hi; }
__device__ __forceinline__ unsigned cvtpk(float lo, float hi) { unsigned r; asm volatile("v_cvt_pk_bf16_f32 %0, %1, %2" : "=v"(r) : "v"(lo), "v"(hi)); return r; }
__device__ __forceinline__ float bf2f(short b) { return __uint_as_float(((unsigned)(unsigned short)b) << 16); }
__device__ __forceinline__ bf16x8 pack8(const float* v) { u32x4 w = {cvtpk(v[0], v[1]), cvtpk(v[2], v[3]), cvtpk(v[4], v[5]), cvtpk(v[6], v[7])}; return *reinterpret_cast<bf16x8*>(&w); }
#define SWA_PK4(P, B_, OUT) do { unsigned a0 = cvtpk(P[B_+0], P[B_+1]), a1 = cvtpk(P[B_+2], P[B_+3]);                          \
        unsigned b0 = cvtpk(P[B_+4], P[B_+5]), b1 = cvtpk(P[B_+6], P[B_+7]);                                             \
        auto r0 = __builtin_amdgcn_permlane32_swap(a0, b0, false, false); auto r1 = __builtin_amdgcn_permlane32_swap(a1, b1, false, false); \
        u32x4 w = {r0[0], r1[0], r0[1], r1[1]}; OUT = *reinterpret_cast<bf16x8*>(&w); } while (0)

__device__ __forceinline__ void swa_attn_phase(char* lds, const bf16* QKV, const float* sinks, const float* cosT, const float* sinT, bf16* O, int wg, int G) {
    const int tid = mk_tid(), wid = __builtin_amdgcn_readfirstlane(tid >> 6), lane = tid & 63, r32 = lane & 31, hi = lane >> 5;
    for (int L = wg; L < 1024; L += G) {
        const int g = L & 7, n = L >> 3;
        __syncthreads();
        {
            const int row = tid >> 1, half = tid & 1, kpos = 128 * (n - 1) + row;
            bf16x8 kc[4], vc[4];
            if (kpos >= 0) {
                const bf16* kp = QKV + (size_t)kpos * QKVP + 4096 + g * 64 + half * 32; const bf16* vp = kp + 512;
#pragma unroll
                for (int c = 0; c < 4; ++c) { kc[c] = *(const bf16x8*)(kp + 8 * c); vc[c] = *(const bf16x8*)(vp + 8 * c); }
                if (half == 0) {
                    const f32x4 c0 = *(const f32x4*)(cosT + (size_t)kpos * 8), c1 = *(const f32x4*)(cosT + (size_t)kpos * 8 + 4);
                    const f32x4 s0 = *(const f32x4*)(sinT + (size_t)kpos * 8), s1 = *(const f32x4*)(sinT + (size_t)kpos * 8 + 4);
                    float o1[8], o2[8];
#pragma unroll
                    for (int i = 0; i < 8; ++i) { const float cs = i < 4 ? c0[i & 3] : c1[i & 3], sn = i < 4 ? s0[i & 3] : s1[i & 3];
                        const float x1 = bf2f(kc[0][i]), x2 = bf2f(kc[1][i]); o1[i] = x1 * cs - x2 * sn; o2[i] = x2 * cs + x1 * sn; }
                    kc[0] = pack8(o1); kc[1] = pack8(o2);
                }
            } else {
#pragma unroll
                for (int c = 0; c < 4; ++c) { kc[c] = (bf16x8){0, 0, 0, 0, 0, 0, 0, 0}; vc[c] = (bf16x8){0, 0, 0, 0, 0, 0, 0, 0}; }
            }
#pragma unroll
            for (int c = 0; c < 4; ++c) { const int chunk = half * 4 + c;
                *(bf16x8*)(lds + K_OFF + row * 128 + ((chunk ^ ((row >> 1) & 7)) << 4)) = kc[c];
#pragma unroll
                for (int j = 0; j < 8; ++j) *(short*)(lds + VT_OFF + (half * 32 + c * 8 + j) * VT_PITCH + row * 2) = vc[c][j]; }
        }
        __syncthreads();
        const int hq = g * 8 + wid; const float sink = sinks[hq];
        for (int a = 0; a < 4; ++a) {
            const int t = 128 * n + 32 * a + r32;
            const bf16* qp = QKV + (size_t)t * QKVP + hq * 64;
            bf16x8 qr[4];
#pragma unroll
            for (int d0 = 0; d0 < 4; ++d0) qr[d0] = *(const bf16x8*)(qp + 16 * d0 + 8 * hi);
            {
                const bf16x8 pr = *(const bf16x8*)(qp + 8 * (1 - hi));
                const f32x4 c0 = *(const f32x4*)(cosT + (size_t)t * 8), c1 = *(const f32x4*)(cosT + (size_t)t * 8 + 4);
                const f32x4 s0 = *(const f32x4*)(sinT + (size_t)t * 8), s1 = *(const f32x4*)(sinT + (size_t)t * 8 + 4);
                float ov[8];
#pragma unroll
                for (int i = 0; i < 8; ++i) { const float cs = i < 4 ? c0[i & 3] : c1[i & 3], sn = i < 4 ? s0[i & 3] : s1[i & 3];
                    const float own = bf2f(qr[0][i]), par = bf2f(pr[i]); ov[i] = own * cs + (hi ? par : -par) * sn; }
                qr[0] = pack8(ov);
            }
            f32x16 p[5];
#pragma unroll
            for (int bi = 0; bi < 5; ++bi) { const int row = 32 * (a + bi) + r32; const char* kb = lds + K_OFF + row * 128; const int sw = (row >> 1) & 7;
                f32x16 acc = {};
#pragma unroll
                for (int d0 = 0; d0 < 4; ++d0) { const bf16x8 kf = *(const bf16x8*)(kb + (((2 * d0 + hi) ^ sw) << 4)); acc = __builtin_amdgcn_mfma_f32_32x32x16_bf16(kf, qr[d0], acc, 0, 0, 0); }
                p[bi] = acc; }
            const float NEG = -__builtin_inff();
#pragma unroll
            for (int r = 0; r < 16; ++r) { const int c = crow(r, hi); if (!(c > r32)) p[0][r] = NEG; if (!(c <= r32)) p[4][r] = NEG; }
            if (n == 0) {
#pragma unroll
                for (int bi = 0; bi < 4; ++bi) if (a + bi < 4) {
#pragma unroll
                    for (int r = 0; r < 16; ++r) p[bi][r] = NEG; }
            }
            float mx = NEG;
#pragma unroll
            for (int bi = 0; bi < 5; ++bi)
#pragma unroll
                for (int r = 0; r < 16; ++r) mx = fmaxf(mx, p[bi][r]);
            { auto rr = __builtin_amdgcn_permlane32_swap(__float_as_uint(mx), __float_as_uint(mx), false, false); mx = fmaxf(__uint_as_float(rr[0]), __uint_as_float(rr[1])); }
            const float m = fmaxf(mx * 0.125f, sink);
            constexpr float LOG2E = 1.4426950408889634f, C2 = 0.125f * LOG2E;
            const float mL = -m * LOG2E;
            float ps = 0.f;
#pragma unroll
            for (int bi = 0; bi < 5; ++bi)
#pragma unroll
                for (int r = 0; r < 16; ++r) { const float e = __builtin_amdgcn_exp2f(fmaf(p[bi][r], C2, mL)); p[bi][r] = e; ps += e; }
            { auto rr = __builtin_amdgcn_permlane32_swap(__float_as_uint(ps), __float_as_uint(ps), false, false); ps = __uint_as_float(rr[0]) + __uint_as_float(rr[1]); }
            const float l = ps + __builtin_amdgcn_exp2f(fmaf(sink, LOG2E, mL));
            f32x16 o[2] = {};
#pragma unroll
            for (int bi = 0; bi < 5; ++bi) { bf16x8 pa[2]; SWA_PK4(p[bi], 0, pa[0]); SWA_PK4(p[bi], 8, pa[1]);
#pragma unroll
                for (int ks = 0; ks < 2; ++ks)
#pragma unroll
                    for (int db = 0; db < 2; ++db) { const bf16x8 vf = *(const bf16x8*)(lds + VT_OFF + (32 * db + r32) * VT_PITCH + (32 * (a + bi) + 16 * ks + 8 * hi) * 2);
                        o[db] = __builtin_amdgcn_mfma_f32_32x32x16_bf16(vf, pa[ks], o[db], 0, 0, 0); } }
            const float rl = __builtin_amdgcn_rcpf(l);
            bf16* Ow = O + (size_t)(128 * n + 32 * a + r32) * OP + hq * 64 + 8 * hi;
#pragma unroll
            for (int db = 0; db < 2; ++db)
#pragma unroll
                for (int gp = 0; gp < 2; ++gp) { const int b_ = 8 * gp;
                    const unsigned a0 = cvtpk(o[db][b_ + 0] * rl, o[db][b_ + 1] * rl), a1 = cvtpk(o[db][b_ + 2] * rl, o[db][b_ + 3] * rl);
                    const unsigned b0 = cvtpk(o[db][b_ + 4] * rl, o[db][b_ + 5] * rl), b1 = cvtpk(o[db][b_ + 6] * rl, o[db][b_ + 7] * rl);
                    auto r0 = __builtin_amdgcn_permlane32_swap(a0, b0, false, false); auto r1 = __builtin_amdgcn_permlane32_swap(a1, b1, false, false);
                    u32x4 w = {r0[0], r1[0], r0[1], r1[1]}; *(u32x4*)(Ow + db * 32 + 16 * gp) = w; }
        }
    }
    __syncthreads();
}
#undef SWA_PK4
}

#define LAS __attribute__((address_space(3)))
#define GAS __attribute__((address_space(1)))
typedef unsigned short bf16;
typedef float f32x4 __attribute__((ext_vector_type(4)));
typedef unsigned u32x4 __attribute__((ext_vector_type(4)));
typedef unsigned u32x2 __attribute__((ext_vector_type(2)));
typedef short bf16x8 __attribute__((ext_vector_type(8)));
constexpr int SEQ = 16384, DM = 4096, DFF = 11008;
constexpr float NORM_EPS = 1e-6f;
__device__ __forceinline__ unsigned cvtpk(float lo, float hi) { unsigned r; asm volatile("v_cvt_pk_bf16_f32 %0, %1, %2" : "=v"(r) : "v"(lo), "v"(hi)); return r; }
__device__ __forceinline__ float bf_lo(unsigned w) { return __uint_as_float(w << 16); }
__device__ __forceinline__ float bf_hi(unsigned w) { return __uint_as_float(w & 0xffff0000u); }
__device__ __forceinline__ float wave_sum(float v) {
#pragma unroll
    for (int o = 1; o < 64; o <<= 1) v += __shfl_xor(v, o);
    return v;
}
__device__ __forceinline__ float gelu_tanh(float x) {
    const float u = 0.7978845608028654f * (x + 0.044715f * x * x * x);
    return x * __builtin_amdgcn_rcpf(1.0f + __builtin_amdgcn_exp2f(-2.8853900817779268f * u));
}
__device__ __forceinline__ void sincos_d(double a, double& s, double& c) {
    const double k = rint(a * 0.15915494309189535);
    double r = fma(-k, 6.283185307179586, a); r = fma(-k, 2.4492935982947064e-16, r);
    const double r2 = r * r; double ss = 1.0, cc = 1.0;
#pragma unroll
    for (int n = 29; n >= 3; n -= 2) ss = fma(-ss * r2, 1.0 / (double)(n * (n - 1)), 1.0);
#pragma unroll
    for (int n = 28; n >= 2; n -= 2) cc = fma(-cc * r2, 1.0 / (double)(n * (n - 1)), 1.0);
    s = r * ss; c = cc;
}
__device__ __forceinline__ double exp_d(double x) {
    const double k = rint(x * 1.4426950408889634);
    double r = fma(-k, 0.6931471803691238, x); r = fma(-k, 1.9082149292705877e-10, r);
    double p = 1.0;
#pragma unroll
    for (int n = 16; n >= 1; --n) p = fma(p * r, 1.0 / (double)n, 1.0);
    return ldexp(p, (int)k);
}

__device__ __forceinline__ void transpose_item(const float* __restrict__ W, int K, int N, bf16* __restrict__ WT, int mode, LAS unsigned* scr, int item, int lane) {
    const int nblk = (N + 63) / 64, kb = item / nblk, nb = item - kb * nblk, k0 = 128 * kb, n0 = 64 * nb;
    int r0 = n0; if (mode == 1) { const int bj = n0 >> 12, rem = n0 & 4095; r0 = ((rem >> 7) << 8) + (bj << 7) + (rem & 127); }
    if (mode == 2) { const int bj = n0 >= DFF ? 1 : 0, rem = n0 - bj * DFF; r0 = ((rem >> 7) << 8) + (bj << 7) + (rem & 127); }
    const int c = lane & 15, kq = lane >> 4;
    const bool ok = n0 + 4 * c < N;
    const float* src = W + (size_t)(k0 + 2 * kq) * N + n0 + 4 * c;
    LAS unsigned* sw = scr + (4 * c) * 65 + kq;
#pragma unroll
    for (int half = 0; half < 2; ++half) {
        f32x4 a[8], b[8]; const f32x4 z = {0.f, 0.f, 0.f, 0.f};
#pragma unroll
        for (int p = 0; p < 8; ++p) { const float* s = src + (size_t)(8 * (8 * half + p)) * N;
            a[p] = ok ? __builtin_nontemporal_load((const f32x4*)s) : z; b[p] = ok ? __builtin_nontemporal_load((const f32x4*)(s + N)) : z; }
#pragma unroll
        for (int p = 0; p < 8; ++p)
#pragma unroll
            for (int q = 0; q < 4; ++q) sw[q * 65 + 4 * (8 * half + p)] = cvtpk(a[p][q], b[p][q]);
    }
    asm volatile("s_waitcnt lgkmcnt(0)" ::: "memory");
#pragma unroll
    for (int j = 0; j < 16; ++j) { const int n = 4 * j + kq; const LAS unsigned* s = scr + n * 65 + 4 * c;
        u32x4 o; o.x = s[0]; o.y = s[1]; o.z = s[2]; o.w = s[3];
        if (n0 + n < N) *(u32x4*)(WT + (size_t)(r0 + n) * K + k0 + 8 * c) = o; }
    asm volatile("s_waitcnt lgkmcnt(0)" ::: "memory");
}

__device__ __forceinline__ float f8_clamp(float v) { return __builtin_fminf(__builtin_fmaxf(v, -448.f), 448.f); }
__device__ __forceinline__ unsigned f8_pack4(float a, float b, float c, float d) {
    int w = 0; w = __builtin_amdgcn_cvt_pk_fp8_f32(f8_clamp(a), f8_clamp(b), w, false); w = __builtin_amdgcn_cvt_pk_fp8_f32(f8_clamp(c), f8_clamp(d), w, true); return (unsigned)w; }
__device__ __forceinline__ unsigned i8_pack4(float a, float b, float c, float d) {
    const int q0 = (int)__builtin_rintf(__builtin_fminf(__builtin_fmaxf(a, -127.f), 127.f)), q1 = (int)__builtin_rintf(__builtin_fminf(__builtin_fmaxf(b, -127.f), 127.f));
    const int q2 = (int)__builtin_rintf(__builtin_fminf(__builtin_fmaxf(c, -127.f), 127.f)), q3 = (int)__builtin_rintf(__builtin_fminf(__builtin_fmaxf(d, -127.f), 127.f));
    return ((unsigned)q0 & 255u) | (((unsigned)q1 & 255u) << 8) | (((unsigned)q2 & 255u) << 16) | ((unsigned)q3 << 24); }
__device__ __forceinline__ float wave_max(float v) {
#pragma unroll
    for (int o = 1; o < 64; o <<= 1) v = fmaxf(v, __shfl_xor(v, o));
    return v;
}
__device__ __forceinline__ void transpose_item_f8(const float* __restrict__ W, int K, int N, unsigned char* __restrict__ WT, int mode, LAS unsigned* scr, int item, int lane, float scale, int qm = 1) {
    const int nblk = (N + 63) / 64, kb = item / nblk, nb = item - kb * nblk, k0 = 128 * kb, n0 = 64 * nb;
    int r0 = n0; if (mode == 1) { const int bj = n0 >> 12, rem = n0 & 4095; r0 = ((rem >> 7) << 8) + (bj << 7) + (rem & 127); }
    if (mode == 2) { const int bj = n0 >= DFF ? 1 : 0, rem = n0 - bj * DFF; r0 = ((rem >> 7) << 8) + (bj << 7) + (rem & 127); }
    const int c = lane & 15, kq = lane >> 4;
    const bool ok = n0 + 4 * c < N;
    const float* src = W + (size_t)(k0 + 4 * kq) * N + n0 + 4 * c;
    LAS unsigned* sw = scr + (4 * c) * 33 + kq;
#pragma unroll
    for (int half = 0; half < 2; ++half) {
        f32x4 a[4][4]; const f32x4 z = {0.f, 0.f, 0.f, 0.f};
#pragma unroll
        for (int p = 0; p < 4; ++p)
#pragma unroll
            for (int r = 0; r < 4; ++r) { const float* s = src + (size_t)(16 * (4 * half + p) + r) * N; a[p][r] = ok ? __builtin_nontemporal_load((const f32x4*)s) : z; }
#pragma unroll
        for (int p = 0; p < 4; ++p)
#pragma unroll
            for (int q = 0; q < 4; ++q) sw[q * 33 + 4 * (4 * half + p)] = qm == 2 ? i8_pack4(a[p][0][q] * scale, a[p][1][q] * scale, a[p][2][q] * scale, a[p][3][q] * scale)
                                                                             : f8_pack4(a[p][0][q] * scale, a[p][1][q] * scale, a[p][2][q] * scale, a[p][3][q] * scale);
    }
    asm volatile("s_waitcnt lgkmcnt(0)" ::: "memory");
#pragma unroll
    for (int j = 0; j < 8; ++j) { const int n = 8 * j + (lane >> 3), c8 = lane & 7; const LAS unsigned* s = scr + n * 33 + 4 * c8;
        u32x4 o; o.x = s[0]; o.y = s[1]; o.z = s[2]; o.w = s[3];
        if (n0 + n < N) *(u32x4*)(WT + (size_t)(r0 + n) * K + k0 + 16 * c8) = o; }
    asm volatile("s_waitcnt lgkmcnt(0)" ::: "memory");
}

struct HPlanes { unsigned char* hi; unsigned char* lo; };
template <int HIN, int HOUT>
__device__ __forceinline__ void norm_phase(int gw, int ngw, int lane, LAS unsigned char* stg, const bf16* tmp, const float* gpost, const float* hin, float* hout, HPlanes hp, const float* gpre, bf16* xn, bf16* U, float tscale = 1.0f, unsigned char* xn8 = nullptr, float x8scale = 1.0f, float* rs8 = nullptr) {
    LAS unsigned char* sA = stg;
    for (int m = gw; m < SEQ; m += ngw) {
        f32x4 h[16];
        u32x4 tq[8]; float ss = 0.f;
        if (tmp) { const u32x4* tr = (const u32x4*)(tmp + (size_t)m * DM) + lane;
#pragma unroll
            for (int j = 0; j < 8; ++j) tq[j] = __builtin_nontemporal_load(tr + 64 * j); }
        if constexpr (HIN == 0) {
            const f32x4* hr = (const f32x4*)(hin + (size_t)m * DM) + lane;
#pragma unroll
            for (int j = 0; j < 16; ++j) h[j] = __builtin_nontemporal_load(hr + 64 * j);
        } else {
            const u32x4* hr = (const u32x4*)(hp.hi + (size_t)m * 8192) + lane; const u32x4* lr = (const u32x4*)(hp.lo + (size_t)m * 2048) + lane; u32x4 hq[8], lq[2];
#pragma unroll
            for (int i = 0; i < 8; ++i) hq[i] = __builtin_nontemporal_load(hr + 64 * i);
#pragma unroll
            for (int c = 0; c < 2; ++c) lq[c] = __builtin_nontemporal_load(lr + 64 * c);
#pragma unroll
            for (int j = 0; j < 16; ++j) { const unsigned w0 = hq[j >> 1][2 * (j & 1)], w1 = hq[j >> 1][2 * (j & 1) + 1], lw = lq[j >> 3][(j >> 1) & 3]; const int sh = 16 * (j & 1);
                h[j] = (f32x4){__uint_as_float((w0 << 16) | (((lw >> sh) & 15u) << 12)), __uint_as_float((w0 & 0xffff0000u) | (((lw >> (sh + 4)) & 15u) << 12)),
                               __uint_as_float((w1 << 16) | (((lw >> (sh + 8)) & 15u) << 12)), __uint_as_float((w1 & 0xffff0000u) | (((lw >> (sh + 12)) & 15u) << 12))}; }
        }
        if (tmp) {
#pragma unroll
            for (int j = 0; j < 8; ++j) {
#pragma unroll
                for (int q = 0; q < 4; ++q) { const float a = bf_lo(tq[j][q]), b = bf_hi(tq[j][q]); ss += a * a + b * b; }
                *(LAS u32x4*)(sA + 1024 * j + 16 * lane) = tq[j]; }
            asm volatile("" ::: "memory");
            const float r = tscale / sqrtf(wave_sum(ss) * (1.0f / DM) + NORM_EPS);
            const f32x4* gp = (const f32x4*)gpost + lane; asm volatile("" : "+v"(gp));
#pragma unroll
            for (int j = 0; j < 16; ++j) { const u32x2 w = *(const LAS u32x2*)(sA + 512 * j + 8 * lane); const f32x4 t = {bf_lo(w.x), bf_hi(w.x), bf_lo(w.y), bf_hi(w.y)};
                h[j] = h[j] + (t * r) * gp[64 * j]; }
            asm volatile("" ::: "memory");
            if constexpr (HOUT == 0) { f32x4* ho = (f32x4*)(hout + (size_t)m * DM) + lane;
#pragma unroll
                for (int j = 0; j < 16; ++j) __builtin_nontemporal_store(h[j], ho + 64 * j); }
            if constexpr (HOUT == 1) {
                u32x4* ho = (u32x4*)(hp.hi + (size_t)m * 8192) + lane; u32x4* lo = (u32x4*)(hp.lo + (size_t)m * 2048) + lane; u32x4 lq[2];
#pragma unroll
                for (int i = 0; i < 8; ++i) { u32x4 o; unsigned lw = 0u;
#pragma unroll
                    for (int jj = 0; jj < 2; ++jj) { const int j = 2 * i + jj;
                        const unsigned b0 = __float_as_uint(h[j].x) + 0x800u, b1 = __float_as_uint(h[j].y) + 0x800u, b2 = __float_as_uint(h[j].z) + 0x800u, b3 = __float_as_uint(h[j].w) + 0x800u;
                        o[2 * jj] = __builtin_amdgcn_perm(b1, b0, 0x07060302u); o[2 * jj + 1] = __builtin_amdgcn_perm(b3, b2, 0x07060302u);
                        lw |= (((b0 >> 12) & 15u) | (((b1 >> 12) & 15u) << 4) | (((b2 >> 12) & 15u) << 8) | (((b3 >> 12) & 15u) << 12)) << (16 * jj); }
                    __builtin_nontemporal_store(o, ho + 64 * i); lq[i >> 2][i & 3] = lw; }
#pragma unroll
                for (int c = 0; c < 2; ++c) __builtin_nontemporal_store(lq[c], lo + 64 * c); }
        }
        if (gpre) {
            float s2 = 0.f;
#pragma unroll
            for (int j = 0; j < 16; ++j) s2 += (h[j].x * h[j].x + h[j].y * h[j].y) + (h[j].z * h[j].z + h[j].w * h[j].w);
            const float r = 1.0f / sqrtf(wave_sum(s2) * (1.0f / DM) + NORM_EPS);
            const f32x4* gp = (const f32x4*)gpre + lane; asm volatile("" : "+v"(gp));
            if (xn) { u32x4* o16 = (u32x4*)(xn + (size_t)m * DM) + lane;
                asm volatile("" ::: "memory");
#pragma unroll
                for (int j = 0; j < 16; ++j) { const f32x4 v = (h[j] * r) * gp[64 * j]; u32x2 w; w.x = cvtpk(v.x, v.y); w.y = cvtpk(v.z, v.w); *(LAS u32x2*)(sA + 512 * j + 8 * lane) = w; }
                asm volatile("" ::: "memory");
#pragma unroll
                for (int j = 0; j < 8; ++j) o16[64 * j] = *(const LAS u32x4*)(sA + 1024 * j + 16 * lane);
                asm volatile("" ::: "memory"); }
            if (xn8) { u32x4* o16 = (u32x4*)(xn8 + (size_t)m * DM) + lane; float r8 = r * x8scale;
                if (rs8) { float amax = 0.f;
#pragma unroll
                    for (int j = 0; j < 16; ++j) { const f32x4 v = (h[j] * r) * gp[64 * j]; amax = fmaxf(fmaxf(amax, fmaxf(fabsf(v.x), fabsf(v.y))), fmaxf(fabsf(v.z), fabsf(v.w))); }
                    amax = wave_max(amax); r8 = amax > 0.f ? r * (127.f / amax) : 0.f;
                    if (lane == 0) { rs8[m + 2] = amax * (1.0f / 127.f); if (m == 0) { rs8[0] = 0.f; rs8[1] = 0.f; } }
                    asm volatile("" : "+v"(gp)); }
                asm volatile("" ::: "memory");
#pragma unroll
                for (int j = 0; j < 16; ++j) { const f32x4 v = (h[j] * r8) * gp[64 * j]; *(LAS unsigned*)(sA + 256 * j + 4 * lane) = rs8 ? i8_pack4(v.x, v.y, v.z, v.w) : f8_pack4(v.x, v.y, v.z, v.w); }
                asm volatile("" ::: "memory");
#pragma unroll
                for (int i = 0; i < 4; ++i) o16[64 * i] = *(const LAS u32x4*)(sA + 1024 * i + 16 * lane);
                asm volatile("" ::: "memory"); }
            if (U) {
#pragma unroll
                for (int j = 0; j < 16; ++j) { const f32x4 v = (h[j] * r) * gp[64 * j]; u32x2 w; w.x = cvtpk(v.x, v.y); w.y = cvtpk(v.z, v.w);
                    *(u32x2*)(U + ((size_t)((lane >> 2) + 16 * j) * SEQ + m) * 16 + 4 * (lane & 3)) = w; } }
        }
    }
}

__device__ __forceinline__ void fox_cumsum_phase(char* lds, const float* __restrict__ logf, float* __restrict__ cneg, int wg, int G, int tid) {
    double* wtot = (double*)lds; const int lane = tid & 63, wid = tid >> 6;
    for (int h = wg; h < 32; h += G) {
        float v[32]; double s = 0.0;
#pragma unroll
        for (int j = 0; j < 32; ++j) { v[j] = logf[(size_t)(32 * tid + j) * 32 + h]; s += (double)v[j]; }
        double inc = s;
#pragma unroll
        for (int o = 1; o < 64; o <<= 1) { const double t = __shfl_up(inc, o); if (lane >= o) inc += t; }
        __syncthreads();
        if (lane == 63) wtot[wid] = inc;
        __syncthreads();
        double run = inc - s;
#pragma unroll
        for (int w = 0; w < 8; ++w) if (w < wid) run += wtot[w];
#pragma unroll
        for (int j = 0; j < 32; ++j) { run += (double)v[j]; cneg[(size_t)h * SEQ + 32 * tid + j] = (float)(-run * 11.313708498984761); }
    }
}

__device__ __forceinline__ void fox_norms_phase(const bf16* __restrict__ QK, unsigned* nrm2, int gw, int ngw, int lane) {
    for (int base = gw * 128; base < 64 * SEQ; base += ngw * 128) {
        const u32x4* p = (const u32x4*)(QK + (size_t)base * 128) + lane; float mx = 0.f;
#pragma unroll 8
        for (int i = 0; i < 32; ++i) { const u32x4 w = p[(size_t)i * 64]; float s = 0.f;
#pragma unroll
            for (int q = 0; q < 4; ++q) { const float a = bf_lo(w[q]), b = bf_hi(w[q]); s = fmaf(a, a, s); s = fmaf(b, b, s); }
            s += __shfl_xor(s, 1); s += __shfl_xor(s, 2); s += __shfl_xor(s, 4); s += __shfl_xor(s, 8); mx = fmaxf(mx, s); }
        mx = fmaxf(mx, __shfl_xor(mx, 16)); mx = fmaxf(mx, __shfl_xor(mx, 32));
        if (lane == 0) __hip_atomic_fetch_max(nrm2 + base / SEQ, __float_as_uint(mx), __ATOMIC_RELAXED, __HIP_MEMORY_SCOPE_AGENT);
    }
}

namespace s5 {
typedef float f32x16 __attribute__((ext_vector_type(16)));
constexpr int NG = 256, SEGL = 2048, XP = 272, WAVE_BYTES = 2048 + 32 * XP, E_OFF = 8 * WAVE_BYTES, LDS_BYTES = E_OFF + 8 * 128 * 4;
__device__ __forceinline__ bf16x8 pack8(f32x4 a, f32x4 b) { u32x4 w = {cvtpk(a[0], a[1]), cvtpk(a[2], a[3]), cvtpk(b[0], b[1]), cvtpk(b[2], b[3])}; return *reinterpret_cast<bf16x8*>(&w); }
__device__ __forceinline__ void state_consts(float lam_re_raw, float lam_im_raw, double dt, double& lbr, double& lbi, double& cfr, double& cfi, double& lre_o, double& lim_o) {
    const double lre = (double)fminf(lam_re_raw, -1e-4f), lim = (double)lam_im_raw; double sn, cs; sincos_d(lim * dt, sn, cs); const double er = exp_d(lre * dt);
    lbr = er * cs; lbi = er * sn; const double a = lbr - 1.0, b = lbi, den = 1.0 / (lre * lre + lim * lim); cfr = (a * lre + b * lim) * den; cfi = (b * lre - a * lim) * den; lre_o = lre; lim_o = lim;
}
__device__ __forceinline__ void s5_phase(char* lds, const bf16* __restrict__ U, const float* __restrict__ lam_re, const float* __restrict__ lam_im, const float* __restrict__ log_dt,
                                         const float* __restrict__ b_re, const float* __restrict__ b_im, const float* __restrict__ c_re, const float* __restrict__ c_im,
                                         const float* __restrict__ dskip, bf16* __restrict__ Gout, int wg, int G) {
    const int tid = mk_tid(), wid = __builtin_amdgcn_readfirstlane(tid >> 6), lane = tid & 63, r32 = lane & 31, hi = lane >> 5, l15 = lane & 15, q4 = lane >> 4;
    float* ublk = (float*)(lds + wid * WAVE_BYTES); char* xblk = lds + wid * WAVE_BYTES + 2048; float* Ebuf = (float*)(lds + E_OFF);
    for (int g = wg; g < NG; g += G) {
        float lr, li, l2r, l2i; bf16x8 Bf[4], Cf[4]; const float dsk = dskip[16 * g + l15];
        {
            const double dt = exp_d((double)log_dt[g]);
            { double lbr, lbi, cfr, cfi, lre, lim; state_consts(lam_re[g * 64 + lane], lam_im[g * 64 + lane], dt, lbr, lbi, cfr, cfi, lre, lim); lr = (float)lbr; li = (float)lbi;
              double sn2, cs2; sincos_d(lim * dt * (double)SEGL, sn2, cs2); const double e2 = exp_d(lre * dt * (double)SEGL); l2r = (float)(e2 * cs2); l2i = (float)(e2 * sn2); }
#pragma unroll
            for (int sb = 0; sb < 2; ++sb) { const int st = 32 * sb + r32; double lbr, lbi, cfr, cfi, lre, lim; state_consts(lam_re[g * 64 + st], lam_im[g * 64 + st], dt, lbr, lbi, cfr, cfi, lre, lim);
                const f32x4* br = (const f32x4*)(b_re + ((size_t)g * 64 + st) * 16 + 8 * hi); const f32x4* bi = (const f32x4*)(b_im + ((size_t)g * 64 + st) * 16 + 8 * hi);
                const f32x4 vr0 = br[0], vr1 = br[1], vi0 = bi[0], vi1 = bi[1]; f32x4 or0, or1, oi0, oi1;
#pragma unroll
                for (int i = 0; i < 4; ++i) { or0[i] = (float)(cfr * (double)vr0[i] - cfi * (double)vi0[i]); or1[i] = (float)(cfr * (double)vr1[i] - cfi * (double)vi1[i]);
                                              oi0[i] = (float)(cfr * (double)vi0[i] + cfi * (double)vr0[i]); oi1[i] = (float)(cfr * (double)vi1[i] + cfi * (double)vr1[i]); }
                Bf[sb] = pack8(or0, or1); Bf[2 + sb] = pack8(oi0, oi1); }
#pragma unroll
            for (int kk = 0; kk < 4; ++kk) { const float* cp = (kk < 2 ? c_re : c_im) + ((size_t)g * 16 + l15) * 64 + 32 * (kk & 1) + 8 * q4; const float sg = kk < 2 ? 1.f : -1.f;
                const f32x4 v0 = *(const f32x4*)cp, v1 = *(const f32x4*)(cp + 4); Cf[kk] = pack8(v0 * sg, v1 * sg); }
        }
        const bf16* Ug = U + ((size_t)g * SEQ + (size_t)wid * SEGL) * 16;
        float xr = 0.f, xi = 0.f;
#pragma unroll 1
        for (int pass = 0; pass < 2; ++pass) {
#define S5_ULOAD(d0, d1, blk_) do { const u32x4 ub_ = *(const u32x4*)(Ug + ((size_t)(blk_) * 32 + r32) * 16 + 8 * hi);                                                     \
                d0 = (f32x4){bf_lo(ub_.x), bf_hi(ub_.x), bf_lo(ub_.y), bf_hi(ub_.y)}; d1 = (f32x4){bf_lo(ub_.z), bf_hi(ub_.z), bf_lo(ub_.w), bf_hi(ub_.w)}; } while (0)
            f32x4 ua0, ua1; S5_ULOAD(ua0, ua1, 0);
#pragma unroll 1
            for (int blk = 0; blk < SEGL / 32; ++blk) {
                f32x4 un0 = ua0, un1 = ua1;
                if (blk + 1 < SEGL / 32) S5_ULOAD(un0, un1, blk + 1);
                const bf16x8 af = pack8(ua0, ua1);
                if (pass) { *(f32x4*)(ublk + r32 * 16 + 8 * hi) = ua0; *(f32x4*)(ublk + r32 * 16 + 8 * hi + 4) = ua1; }
                f32x16 a0 = {}, a1 = {}, a2 = {}, a3 = {};
                a0 = __builtin_amdgcn_mfma_f32_32x32x16_bf16(af, Bf[0], a0, 0, 0, 0); a1 = __builtin_amdgcn_mfma_f32_32x32x16_bf16(af, Bf[1], a1, 0, 0, 0);
                a2 = __builtin_amdgcn_mfma_f32_32x32x16_bf16(af, Bf[2], a2, 0, 0, 0); a3 = __builtin_amdgcn_mfma_f32_32x32x16_bf16(af, Bf[3], a3, 0, 0, 0);
#pragma unroll
                for (int r = 0; r < 16; ++r) { auto t0 = __builtin_amdgcn_permlane32_swap(__float_as_uint(a0[r]), __float_as_uint(a1[r]), false, false); a0[r] = __uint_as_float(t0[0]); a1[r] = __uint_as_float(t0[1]);
                                               auto t1 = __builtin_amdgcn_permlane32_swap(__float_as_uint(a2[r]), __float_as_uint(a3[r]), false, false); a2[r] = __uint_as_float(t1[0]); a3[r] = __uint_as_float(t1[1]); }
#pragma unroll
                for (int s = 0; s < 32; ++s) { const int h = (s >> 2) & 1, r = (s & 3) + 4 * (s >> 3); const float bre = h ? a1[r] : a0[r], bim = h ? a3[r] : a2[r];
                    const float nr = fmaf(lr, xr, fmaf(-li, xi, bre)), ni = fmaf(lr, xi, fmaf(li, xr, bim)); xr = nr; xi = ni;
                    if (pass) { const unsigned pk = cvtpk(xr, xi); *(unsigned short*)(xblk + s * XP + lane * 2) = (unsigned short)pk; *(unsigned short*)(xblk + s * XP + 128 + lane * 2) = (unsigned short)(pk >> 16); } }
                if (pass) {
#pragma unroll
                    for (int rb = 0; rb < 2; ++rb) { f32x4 acc = {0.f, 0.f, 0.f, 0.f};
#pragma unroll
                        for (int kk = 0; kk < 4; ++kk) { const bf16x8 xa = *(const bf16x8*)(xblk + (16 * rb + l15) * XP + (32 * kk + 8 * q4) * 2); acc = __builtin_amdgcn_mfma_f32_16x16x32_bf16(xa, Cf[kk], acc, 0, 0, 0); }
#pragma unroll
                        for (int i = 0; i < 4; ++i) { const int sl = 16 * rb + 4 * q4 + i; const float uv = ublk[sl * 16 + l15];
                            const float v = gelu_tanh(acc[i] + dsk * uv); const float vn = __shfl_xor(v, 1);
                            if ((l15 & 1) == 0) *(unsigned*)(Gout + ((size_t)wid * SEGL + blk * 32 + sl) * DM + 16 * g + l15) = cvtpk(v, vn); } }
                }
                ua0 = un0; ua1 = un1;
            }
            if (pass == 0) {
                Ebuf[wid * 128 + lane] = xr; Ebuf[wid * 128 + 64 + lane] = xi;
                __syncthreads();
                float sr = 0.f, si = 0.f;
                for (int v = 0; v < wid; ++v) { const float er = Ebuf[v * 128 + lane], ei = Ebuf[v * 128 + 64 + lane];
                    const float nr = fmaf(l2r, sr, fmaf(-l2i, si, er)), ni = fmaf(l2r, si, fmaf(l2i, sr, ei)); sr = nr; si = ni; }
                xr = sr; xi = si;
            }
        }
        __syncthreads();
    }
}
#undef S5_ULOAD
}
#define XB_TMO      128
#define XB_XCNT(j)  (256  + 64 * (j))
#define XB_XSUB(j)  (1280 + 64 * (j))
#define XB_XGEN(j)  (2304 + 64 * (j))
#define XB_TOP      3328
#define XB_TOPGEN   3392
#define XCD_BAR_WORDS 3456
#define XB_SPIN_CAP (1u << 18)

__device__ __forceinline__ unsigned xb_ld(unsigned* p)              { return __hip_atomic_load(p, __ATOMIC_RELAXED, __HIP_MEMORY_SCOPE_AGENT); }
__device__ __forceinline__ unsigned xb_add(unsigned* p, unsigned v) { return __hip_atomic_fetch_add(p, v, __ATOMIC_RELAXED, __HIP_MEMORY_SCOPE_AGENT); }
__device__ __forceinline__ unsigned xb_xcc_id() { return (unsigned)__builtin_amdgcn_s_getreg((3 << 11) | 20) & 0xFu; }
#define XB_SPIN(cond, bar) do { unsigned _sp = 0; while (cond) { __builtin_amdgcn_s_sleep(1); \
    if ((++_sp & 255u) == 0u) { if (xb_ld(&(bar)[XB_TMO])) break; if (_sp > XB_SPIN_CAP) { atomicAdd(&(bar)[XB_TMO], 1u); break; } } } } while (0)

struct XcdBarrier {
    unsigned* bar; unsigned x;
    volatile LAS unsigned* st;
};

__device__ __forceinline__ XcdBarrier xcd_barrier_post(unsigned* bar, volatile LAS unsigned* st) {
    XcdBarrier b; b.bar = bar; b.x = xb_xcc_id(); b.st = st;
    if (threadIdx.x == 0) (void)xb_add(&bar[XB_XCNT(b.x)], 1u);
    return b;
}
__device__ __forceinline__ void xcd_barrier_complete(unsigned* bar, unsigned x, unsigned& nloc, unsigned& nx) {
    const unsigned G = gridDim.x * gridDim.y * gridDim.z;
    unsigned sum, cnt, mine, sp = 0u;
    for (;;) {
        sum = 0u; cnt = 0u; mine = 0u;
#pragma unroll
        for (unsigned j = 0; j < 16; ++j) { const unsigned c = xb_ld(&bar[XB_XCNT(j)]); sum += c; cnt += (c > 0u) ? 1u : 0u; mine = (j == x) ? c : mine; }
        if (sum == G) break;
        __builtin_amdgcn_s_sleep(1);
        if ((++sp & 255u) == 0u) { if (xb_ld(&bar[XB_TMO])) break; if (sp > XB_SPIN_CAP) { atomicAdd(&bar[XB_TMO], 1u); break; } }
    }
    nloc = mine > 0u ? mine : 1u; nx = cnt > 0u ? cnt : 1u;
}

__device__ __forceinline__ void xcd_barrier(const XcdBarrier& b) {
    asm volatile("s_waitcnt vmcnt(0)" ::: "memory");
    __syncthreads();
    if (threadIdx.x == 0) {
        unsigned* bar = b.bar;
        __builtin_amdgcn_s_waitcnt(0);
        unsigned nloc = b.st[0], nx = b.st[1];
        if (nloc == 0u) { xcd_barrier_complete(bar, b.x, nloc, nx); b.st[0] = nloc; b.st[1] = nx; }
        const unsigned old = xb_add(&bar[XB_XSUB(b.x)], 1u);
        const unsigned gen = old / nloc;
        if (old + 1u == (gen + 1u) * nloc) {
            __builtin_amdgcn_fence(__ATOMIC_RELEASE, "agent");
            asm volatile("s_waitcnt vmcnt(0)" ::: "memory");
            const unsigned og = xb_add(&bar[XB_TOP], 1u);
            const unsigned tg = og / nx;
            if (og + 1u == (tg + 1u) * nx) xb_add(&bar[XB_TOPGEN], 1u);
            else XB_SPIN(xb_ld(&bar[XB_TOPGEN]) == tg, bar);
            __builtin_amdgcn_fence(__ATOMIC_ACQUIRE, "agent");
            xb_add(&bar[XB_XGEN(b.x)], 1u);
            asm volatile("s_waitcnt vmcnt(0)" ::: "memory");
        } else {
            XB_SPIN(xb_ld(&bar[XB_XGEN(b.x)]) == gen, bar);
            __builtin_amdgcn_fence(__ATOMIC_ACQUIRE, "agent");
            asm volatile("s_waitcnt vmcnt(0)" ::: "memory");
        }
    }
    __syncthreads();
}

constexpr size_t MiB = (size_t)1 << 20;
constexpr int NTHR = 512, NWAVES = 8;
constexpr int LDS_BYTES = 147456;
constexpr int LDS_MISC = LDS_BYTES - 1024;
__device__ __forceinline__ const float* uptr(const LAS unsigned long long* tab, int i) {
    const unsigned long long v = tab[i]; const unsigned lo = __builtin_amdgcn_readfirstlane((unsigned)v), hi = __builtin_amdgcn_readfirstlane((unsigned)(v >> 32));
    return (const float*)(const GAS float*)(((unsigned long long)hi << 32) | lo);
}
template <class T> __device__ __forceinline__ LAS T* launder_l(LAS T* p) { asm volatile("" : "+s"(p)); return p; }
template <class T> __device__ __forceinline__ T* launder(T* p) { GAS T* q = (GAS T*)p; asm volatile("" : "+s"(q)); return (T*)q; }
static_assert(pg8::STAGE_BYTES <= LDS_MISC && fox::LDS_BYTES <= LDS_MISC && swa::LDS_BYTES <= LDS_MISC && s5::LDS_BYTES <= LDS_MISC, "LDS map");
constexpr size_t WS_CTL = 0, CTL_ZERO_BYTES = 64 * 1024;
constexpr size_t CTL_QCTR = 16384, CTL_NRM2 = 20480;
constexpr size_t WS_ROPE = 1 * MiB;
constexpr size_t WS_W = 2 * MiB;
constexpr size_t W_L0_QKV = WS_W, W_L0_O = W_L0_QKV + 40 * MiB, W_L1_QKVF = W_L0_O + 32 * MiB, W_L1_O = W_L1_QKVF + 98 * MiB, W_L2_GLU = W_L1_O + 32 * MiB,
                 W_L3_QKV = W_L2_GLU + 64 * MiB, W_L3_O = W_L3_QKV + 40 * MiB, W_FFN = W_L3_O + 32 * MiB, W_FFN_STRIDE = 258 * MiB, W_FFN_OUT = 172 * MiB;
constexpr size_t WS_XN = W_FFN + 4 * W_FFN_STRIDE;
constexpr size_t WS_BIG = WS_XN + 129 * MiB;
constexpr size_t WS_Z = WS_BIG, WS_ACT = WS_BIG + 688 * MiB, WS_TMPF = WS_BIG, WS_TMPM = WS_BIG + 688 * MiB;
constexpr size_t WS_SWA_QKV = WS_BIG, WS_SWA_O = WS_BIG + 160 * MiB;
constexpr size_t WS_FOX_QKV = WS_BIG, WS_FOX_O = WS_BIG + 384 * MiB, WS_FOX_LOGF = WS_BIG + 512 * MiB, WS_FOX_CNEG = WS_BIG + 514 * MiB;
constexpr size_t WS_S5_U = WS_BIG + 256 * MiB, WS_S5_G = WS_BIG + 512 * MiB;
constexpr size_t WS_HHI = WS_BIG + 1032 * MiB, WS_HLO = WS_HHI + 128 * MiB;
constexpr size_t WS_RS = WS_HLO + 32 * MiB;
constexpr size_t WS_END = WS_RS + 1 * MiB;
static_assert((size_t)SEQ * 2 * DFF * 2 == 688 * MiB && (size_t)SEQ * DFF * 2 == 344 * MiB && (size_t)12544 * 4096 * 2 == 98 * MiB && (size_t)22016 * 4096 * 2 == 172 * MiB, "sizes");

struct Args { const float* in[56]; float* out; unsigned char* ws; float inv_freq[8]; int ph_lo, ph_hi; };

__global__ void __launch_bounds__(NTHR, 2) mk_fwd(Args args) {
    extern __shared__ __attribute__((aligned(16))) unsigned char lds[];
    if (threadIdx.x < 16) ((LAS unsigned*)((LAS unsigned char*)lds + LDS_MISC))[threadIdx.x] = 0u;
    if (threadIdx.x == 64) { LAS unsigned long long* ptab0 = (LAS unsigned long long*)((LAS unsigned char*)lds + LDS_MISC + 64);
#pragma unroll
        for (int i = 0; i < 56; ++i) ptab0[i] = (unsigned long long)args.in[i]; }
#define IN(i) uptr(ptab, (i))
    __syncthreads();
    XcdBarrier bar = xcd_barrier_post((unsigned*)(args.ws + WS_CTL), (volatile LAS unsigned*)((LAS unsigned char*)lds + LDS_MISC));
    int need_bar = 0;
#if PROBE_WAIT > 0
    unsigned long long probe_acc = 0, probe_t0 = 0;
#define PROBE_SEL(id) (PROBE_ID >= 0 ? (id) == PROBE_ID : ((PROBE_MASK >> ((id) == 1 ? 9 : ((id) - 1) % 9)) & 1))
#define PROBE_T0(id) do { if (PROBE_SEL(id)) probe_t0 = __builtin_amdgcn_s_memrealtime(); } while (0)
#define PROBE_T1(id) do { if (PROBE_SEL(id)) probe_acc += __builtin_amdgcn_s_memrealtime() - probe_t0; } while (0)
#else
#define PROBE_T0(id) do { } while (0)
#define PROBE_T1(id) do { } while (0)
#endif
#define PH_BEGIN(id) if (args.ph_lo <= (id) && (id) < args.ph_hi) { \
        if (need_bar) { PROBE_T0(id); XcdBarrier b2; b2.bar = launder(bar.bar); b2.x = (unsigned)launder_s((int)bar.x); b2.st = bar.st; for (int rb_ = 0; rb_ < REP_BAR; ++rb_) xcd_barrier(b2); PROBE_T1(id); } need_bar = 1; \
        unsigned char* const ws = launder(args.ws); float* const out = launder(args.out); (void)out; \
        LAS unsigned char* const ldsl = launder_l((LAS unsigned char*)lds); char* const ldsg = (char*)ldsl; (void)ldsg; const LAS unsigned long long* const ptab = (const LAS unsigned long long*)(ldsl + LDS_MISC + 64); \
        const int tid = mk_tid(), lane = tid & 63, wave = __builtin_amdgcn_readfirstlane(tid >> 6); (void)lane; (void)wave; \
        const int G = launder_s((int)gridDim.x), bx = launder_s((int)blockIdx.x), vcu = (G % 8 == 0) ? (bx % 8) * (G / 8) + bx / 8 : bx, gw = vcu * NWAVES + wave, ngw = G * NWAVES; (void)gw; (void)ngw; \
        bf16* const XN = (bf16*)(ws + WS_XN + 16384); float* const cosT = (float*)(ws + WS_ROPE); float* const sinT = cosT + SEQ * 8; bf16* const TMPM = (bf16*)(ws + WS_TMPM); bf16* const TMPF = (bf16*)(ws + WS_TMPF); \
        (void)XN; (void)cosT; (void)sinT; (void)TMPM; (void)TMPF; const HPlanes HP{ws + WS_HHI, ws + WS_HLO}; (void)HP; float* const RS8 = (float*)(ws + WS_RS); (void)RS8;
#define PH_END }

    PH_BEGIN(0)
#if PROBE_COPY > 0
      for (int rep = 0; rep < PROBE_COPY; ++rep) {
        typedef PROBE_T pv_t; constexpr int PU = 128 / sizeof(pv_t);
        const pv_t* src = (const pv_t*)(ws + WS_BIG); pv_t* dst = (pv_t*)(ws + WS_BIG + 516 * MiB);
        const size_t n = 512 * MiB / sizeof(pv_t), stride = (size_t)G * NTHR;
        for (size_t i = (size_t)vcu * NTHR + tid; i < n; i += PU * stride) {
            pv_t v[PU];
#pragma unroll
            for (int u = 0; u < PU; ++u) v[u] = PROBE_LD(src + i + u * stride);
#pragma unroll
            for (int u = 0; u < PU; ++u) PROBE_ST(v[u], dst + i + u * stride);
        }
      }
#endif
      for (int rep = 0; rep < REP_PRO; ++rep) {
        LAS unsigned* scr = (LAS unsigned*)(ldsl + wave * 16640);
        constexpr int I_QKV = 32 * 80, I_O = 32 * 64, I_QKVF = 32 * 193, I_GLU = 32 * 128, I_IN = 32 * 344, I_OUT = 86 * 64;
        constexpr int NITEMS = 2 * (I_QKV + I_O) + I_QKVF + I_O + I_GLU + 4 * (I_IN + I_OUT);
        for (int it = gw; it < NITEMS; it += ngw) {
            int r = it;
#define TR(cnt, src, K_, N_, dstoff, mode) if (r < (cnt)) { transpose_item(IN(src), K_, N_, (bf16*)(ws + (dstoff)), mode, scr, r, lane); continue; } r -= (cnt);
            TR(I_QKV, 2, 4096, 5120, W_L0_QKV, 0)
            TR(I_O, 5, 4096, 4096, W_L0_O, 0)
            if (r < I_IN) { transpose_item_f8(IN(9), 4096, 22016, ws + W_FFN, 2, scr, r, lane, pg8::I8_W_SCALE, 2); continue; } r -= I_IN;
            TR(I_OUT, 12, 11008, 4096, W_FFN + W_FFN_OUT, 0)
            if (r < I_QKVF) { transpose_item_f8(IN(15), 4096, 12320, ws + W_L1_QKVF, 0, scr, r, lane, pg8::I8_W_SCALE, 2); continue; } r -= I_QKVF;
            TR(I_O, 17, 4096, 4096, W_L1_O, 0)
            if (r < I_IN) { transpose_item_f8(IN(20), 4096, 22016, ws + W_FFN + W_FFN_STRIDE, 2, scr, r, lane, pg8::I8_W_SCALE, 2); continue; } r -= I_IN;
            TR(I_OUT, 23, 11008, 4096, W_FFN + W_FFN_STRIDE + W_FFN_OUT, 0)
            TR(I_GLU, 34, 4096, 8192, W_L2_GLU, 1)
            if (r < I_IN) { transpose_item_f8(IN(38), 4096, 22016, ws + W_FFN + 2 * W_FFN_STRIDE, 2, scr, r, lane, pg8::I8_W_SCALE, 2); continue; } r -= I_IN;
            TR(I_OUT, 41, 11008, 4096, W_FFN + 2 * W_FFN_STRIDE + W_FFN_OUT, 0)
            TR(I_QKV, 44, 4096, 5120, W_L3_QKV, 0)
            TR(I_O, 47, 4096, 4096, W_L3_O, 0)
            if (r < I_IN) { transpose_item_f8(IN(51), 4096, 22016, ws + W_FFN + 3 * W_FFN_STRIDE, 2, scr, r, lane, pg8::I8_W_SCALE, 2); continue; } r -= I_IN;
            TR(I_OUT, 54, 11008, 4096, W_FFN + 3 * W_FFN_STRIDE + W_FFN_OUT, 0)
#undef TR
        }
        if (vcu == 0) { u32x4* zh = (u32x4*)(ws + WS_XN); const u32x4 zero = {0u, 0u, 0u, 0u}; for (int i = tid; i < 1024; i += NTHR) zh[i] = zero; }
        {
            u32x4* z = (u32x4*)(ws + W_L1_QKVF + (size_t)12320 * 4096); const u32x4 zero = {0u, 0u, 0u, 0u};
            for (int i = vcu * NTHR + tid; i < 224 * 4096 / 16; i += G * NTHR) z[i] = zero;
        }
        for (int i = vcu * NTHR + tid; i < SEQ * 8; i += G * NTHR) {
            const int f = i & 7;
            const float fr = f == 0 ? args.inv_freq[0] : f == 1 ? args.inv_freq[1] : f == 2 ? args.inv_freq[2] : f == 3 ? args.inv_freq[3] : f == 4 ? args.inv_freq[4] : f == 5 ? args.inv_freq[5] : f == 6 ? args.inv_freq[6] : args.inv_freq[7];
            const float ang = (float)(i >> 3) * fr; double s, c; sincos_d((double)ang, s, c); cosT[i] = (float)c; sinT[i] = (float)s;
        }
        norm_phase<0, 2>(gw, ngw, lane, ldsl + wave * 16640, nullptr, nullptr, IN(0), nullptr, HPlanes{nullptr, nullptr}, IN(1), XN, nullptr);
      }
    PH_END

#define SEL(a, b, c, d) IN(L == 0 ? (a) : L == 1 ? (b) : L == 2 ? (c) : (d))
    { constexpr int L = 0;

        const int type = L == 3 ? 0 : L, pb = 1 + 9 * L;
        const size_t wffn = W_FFN + (size_t)L * W_FFN_STRIDE;

        PH_BEGIN(pb + 0)
            if (type == 0) {
                pg8::Gemm g{XN, (const bf16*)(ws + (L == 0 ? W_L0_QKV : W_L3_QKV)), SEQ, 5120, 4096}; pg8::StaticOrder S; S.init(SEQ, 5120, G, bx);
                pg8::EpiBf16B E{(bf16*)(ws + WS_SWA_QKV), 5120, L == 0 ? IN(3) : IN(45)};
                for (int rep = 0; rep < REP_MIXG; ++rep) pg8::gemm_phase<pg8::EpiBf16B, pg8::StaticOrder, true, true>(ldsl, g, S, E);
            } else if (type == 1) {
                pg8::Gemm g{XN, (const bf16*)(ws + W_L1_QKVF), SEQ, 12544, 2048}; pg8::StaticOrder S; S.init(SEQ, 12544, G, bx);
                pg8::EpiFox E{(bf16*)(ws + WS_FOX_QKV), (float*)(ws + WS_FOX_LOGF), IN(16), RS8, 1.0f / pg8::I8_W_SCALE};
                for (int rep = 0; rep < REP_MIXG; ++rep) pg8::gemm_phase<pg8::EpiFox, pg8::StaticOrder, true, true, 2>(ldsl, g, S, E);
            } else {
              for (int rep = 0; rep < REP_MIX; ++rep)
                s5::s5_phase(ldsg, (const bf16*)(ws + WS_S5_U), IN(26), IN(27), IN(28), IN(29), IN(30), IN(31), IN(32), IN(33),
                             (bf16*)(ws + WS_S5_G), vcu, G);
            }
        PH_END
        if (type != 2) {
        PH_BEGIN(pb + 1)
          for (int rep = 0; rep < REP_MIX; ++rep) {
            if (type == 0) swa::swa_attn_phase(ldsg, (const bf16*)(ws + WS_SWA_QKV), L == 0 ? IN(4) : IN(46), cosT, sinT, (bf16*)(ws + WS_SWA_O), vcu, G);
            else { fox_cumsum_phase(ldsg, (const float*)(ws + WS_FOX_LOGF), (float*)(ws + WS_FOX_CNEG), vcu, G, tid);
                   if (G > 64) { if (vcu >= 32) fox_norms_phase((const bf16*)(ws + WS_FOX_QKV), (unsigned*)(ws + WS_CTL + CTL_NRM2), (vcu - 32) * NWAVES + wave, (G - 32) * NWAVES, lane); }
                   else fox_norms_phase((const bf16*)(ws + WS_FOX_QKV), (unsigned*)(ws + WS_CTL + CTL_NRM2), gw, ngw, lane); }
          }
        PH_END
        }
        if (type == 1) {
        PH_BEGIN(pb + 2)
            const bf16* q = (const bf16*)(ws + WS_FOX_QKV);
            fox::fox_attn_phase(ldsg, q, q + (size_t)32 * SEQ * 128, q + (size_t)64 * SEQ * 128, (const float*)(ws + WS_FOX_CNEG), (const unsigned*)(ws + WS_CTL + CTL_NRM2), (unsigned*)(ws + WS_CTL + CTL_QCTR), (bf16*)(ws + WS_FOX_O));
#if REP_FOX > 1
            __syncthreads();
            fox::fox_attn_phase(ldsg, q, q + (size_t)32 * SEQ * 128, q + (size_t)64 * SEQ * 128, (const float*)(ws + WS_FOX_CNEG), (const unsigned*)(ws + WS_CTL + CTL_NRM2), (unsigned*)(ws + WS_CTL + CTL_QCTR) + 64, (bf16*)(ws + WS_FOX_O));
#endif
        PH_END
        }
        PH_BEGIN(pb + 3)
            if (type == 2) {
                pg8::Gemm g{(const bf16*)(ws + WS_S5_G), (const bf16*)(ws + W_L2_GLU), SEQ, 8192, 4096}; pg8::StaticOrder S; S.init(SEQ, 8192, G, bx);
                pg8::EpiGlu E{TMPM, IN(35)};
                for (int rep = 0; rep < REP_MIXG; ++rep) pg8::gemm_phase<pg8::EpiGlu, pg8::StaticOrder, true, true>(ldsl, g, S, E);
            } else {
                pg8::Gemm g{(const bf16*)(ws + (type == 0 ? WS_SWA_O : WS_FOX_O)), (const bf16*)(ws + (L == 0 ? W_L0_O : L == 1 ? W_L1_O : W_L3_O)), SEQ, 4096, 4096};
                pg8::StaticOrder S; S.init(SEQ, 4096, G, bx);
                pg8::EpiBf16B E{TMPM, 4096, L == 0 ? IN(6) : L == 3 ? IN(48) : nullptr};
                for (int rep = 0; rep < REP_MIXG; ++rep) pg8::gemm_phase<pg8::EpiBf16B, pg8::StaticOrder, true, true>(ldsl, g, S, E);
            }
        PH_END
        PH_BEGIN(pb + 4)
          for (int rep = 0; rep < REP_NORM; ++rep)
            if (L == 0 && rep == 0) norm_phase<0, 1>(gw, ngw, lane, ldsl + wave * 16640, TMPM, SEL(7, 18, 36, 49), IN(0), nullptr, HP, SEL(8, 19, 37, 50), nullptr, nullptr, 1.f, (unsigned char*)XN, 1.f, RS8);
            else norm_phase<1, 1>(gw, ngw, lane, ldsl + wave * 16640, TMPM, SEL(7, 18, 36, 49), nullptr, nullptr, HP, SEL(8, 19, 37, 50), nullptr, nullptr, rep ? 0.f : 1.f, (unsigned char*)XN, 1.f, RS8);
        PH_END
        PH_BEGIN(pb + 5)
            pg8::Gemm g{(const bf16*)((const unsigned char*)XN - 2 * 4096), (const bf16*)(ws + wffn), 65 * 256, 2 * DFF, 2048, 254}; pg8::StaticOrder S; S.init(65 * 256, 2 * DFF, G, bx);
            pg8::EpiConvGeglu E{(bf16*)(ws + WS_ACT), SEL(10, 21, 39, 52), SEL(11, 22, 40, 53), ldsl + 131072, DFF, SEQ, RS8, 1.0f / pg8::I8_W_SCALE};
          for (int rep = 0; rep < REP_FFN1; ++rep)
            pg8::gemm_phase<pg8::EpiConvGeglu, pg8::StaticOrder, true, true, 2>(ldsl, g, S, E);
        PH_END
        PH_BEGIN(pb + 7)
            pg8::Gemm g{(const bf16*)(ws + WS_ACT), (const bf16*)(ws + wffn + W_FFN_OUT), SEQ, 4096, DFF}; pg8::StaticOrder S; S.init(SEQ, 4096, G, bx);
            pg8::EpiBf16B E{TMPF, 4096, nullptr};
          for (int rep = 0; rep < REP_FFN2; ++rep)
            pg8::gemm_phase<pg8::EpiBf16B, pg8::StaticOrder, true, true>(ldsl, g, S, E);
        PH_END
        PH_BEGIN(pb + 8)
          for (int rep = 0; rep < REP_NORM; ++rep)
            if (L == 3) { if (rep == 0) norm_phase<1, 0>(gw, ngw, lane, ldsl + wave * 16640, TMPF, SEL(13, 24, 42, 55), nullptr, out, HP, nullptr, nullptr, nullptr, 1.f); }
            else norm_phase<1, 1>(gw, ngw, lane, ldsl + wave * 16640, TMPF, SEL(13, 24, 42, 55), nullptr, nullptr, HP, SEL(14, 25, 43, 43), L == 2 ? XN : nullptr, L == 1 ? (bf16*)(ws + WS_S5_U) : nullptr, rep ? 0.f : 1.f, L == 0 ? (unsigned char*)XN : nullptr, 1.f, L == 0 ? RS8 : nullptr);
        PH_END
    }
    { constexpr int L = 1;

        const int type = L == 3 ? 0 : L, pb = 1 + 9 * L;
        const size_t wffn = W_FFN + (size_t)L * W_FFN_STRIDE;

        PH_BEGIN(pb + 0)
            if (type == 0) {
                pg8::Gemm g{XN, (const bf16*)(ws + (L == 0 ? W_L0_QKV : W_L3_QKV)), SEQ, 5120, 4096}; pg8::StaticOrder S; S.init(SEQ, 5120, G, bx);
                pg8::EpiBf16B E{(bf16*)(ws + WS_SWA_QKV), 5120, L == 0 ? IN(3) : IN(45)};
                for (int rep = 0; rep < REP_MIXG; ++rep) pg8::gemm_phase<pg8::EpiBf16B, pg8::StaticOrder, true, true>(ldsl, g, S, E);
            } else if (type == 1) {
                pg8::Gemm g{XN, (const bf16*)(ws + W_L1_QKVF), SEQ, 12544, 2048}; pg8::StaticOrder S; S.init(SEQ, 12544, G, bx);
                pg8::EpiFox E{(bf16*)(ws + WS_FOX_QKV), (float*)(ws + WS_FOX_LOGF), IN(16), RS8, 1.0f / pg8::I8_W_SCALE};
                for (int rep = 0; rep < REP_MIXG; ++rep) pg8::gemm_phase<pg8::EpiFox, pg8::StaticOrder, true, true, 2>(ldsl, g, S, E);
            } else {
              for (int rep = 0; rep < REP_MIX; ++rep)
                s5::s5_phase(ldsg, (const bf16*)(ws + WS_S5_U), IN(26), IN(27), IN(28), IN(29), IN(30), IN(31), IN(32), IN(33),
                             (bf16*)(ws + WS_S5_G), vcu, G);
            }
        PH_END
        if (type != 2) {
        PH_BEGIN(pb + 1)
          for (int rep = 0; rep < REP_MIX; ++rep) {
            if (type == 0) swa::swa_attn_phase(ldsg, (const bf16*)(ws + WS_SWA_QKV), L == 0 ? IN(4) : IN(46), cosT, sinT, (bf16*)(ws + WS_SWA_O), vcu, G);
            else { fox_cumsum_phase(ldsg, (const float*)(ws + WS_FOX_LOGF), (float*)(ws + WS_FOX_CNEG), vcu, G, tid);
                   if (G > 64) { if (vcu >= 32) fox_norms_phase((const bf16*)(ws + WS_FOX_QKV), (unsigned*)(ws + WS_CTL + CTL_NRM2), (vcu - 32) * NWAVES + wave, (G - 32) * NWAVES, lane); }
                   else fox_norms_phase((const bf16*)(ws + WS_FOX_QKV), (unsigned*)(ws + WS_CTL + CTL_NRM2), gw, ngw, lane); }
          }
        PH_END
        }
        if (type == 1) {
        PH_BEGIN(pb + 2)
            const bf16* q = (const bf16*)(ws + WS_FOX_QKV);
            fox::fox_attn_phase(ldsg, q, q + (size_t)32 * SEQ * 128, q + (size_t)64 * SEQ * 128, (const float*)(ws + WS_FOX_CNEG), (const unsigned*)(ws + WS_CTL + CTL_NRM2), (unsigned*)(ws + WS_CTL + CTL_QCTR), (bf16*)(ws + WS_FOX_O));
#if REP_FOX > 1
            __syncthreads();
            fox::fox_attn_phase(ldsg, q, q + (size_t)32 * SEQ * 128, q + (size_t)64 * SEQ * 128, (const float*)(ws + WS_FOX_CNEG), (const unsigned*)(ws + WS_CTL + CTL_NRM2), (unsigned*)(ws + WS_CTL + CTL_QCTR) + 64, (bf16*)(ws + WS_FOX_O));
#endif
        PH_END
        }
        PH_BEGIN(pb + 3)
            if (type == 2) {
                pg8::Gemm g{(const bf16*)(ws + WS_S5_G), (const bf16*)(ws + W_L2_GLU), SEQ, 8192, 4096}; pg8::StaticOrder S; S.init(SEQ, 8192, G, bx);
                pg8::EpiGlu E{TMPM, IN(35)};
                for (int rep = 0; rep < REP_MIXG; ++rep) pg8::gemm_phase<pg8::EpiGlu, pg8::StaticOrder, true, true>(ldsl, g, S, E);
            } else {
                pg8::Gemm g{(const bf16*)(ws + (type == 0 ? WS_SWA_O : WS_FOX_O)), (const bf16*)(ws + (L == 0 ? W_L0_O : L == 1 ? W_L1_O : W_L3_O)), SEQ, 4096, 4096};
                pg8::StaticOrder S; S.init(SEQ, 4096, G, bx);
                pg8::EpiBf16B E{TMPM, 4096, L == 0 ? IN(6) : L == 3 ? IN(48) : nullptr};
                for (int rep = 0; rep < REP_MIXG; ++rep) pg8::gemm_phase<pg8::EpiBf16B, pg8::StaticOrder, true, true>(ldsl, g, S, E);
            }
        PH_END
        PH_BEGIN(pb + 4)
          for (int rep = 0; rep < REP_NORM; ++rep)
            if (L == 0 && rep == 0) norm_phase<0, 1>(gw, ngw, lane, ldsl + wave * 16640, TMPM, SEL(7, 18, 36, 49), IN(0), nullptr, HP, SEL(8, 19, 37, 50), nullptr, nullptr, 1.f, (unsigned char*)XN, 1.f, RS8);
            else norm_phase<1, 1>(gw, ngw, lane, ldsl + wave * 16640, TMPM, SEL(7, 18, 36, 49), nullptr, nullptr, HP, SEL(8, 19, 37, 50), nullptr, nullptr, rep ? 0.f : 1.f, (unsigned char*)XN, 1.f, RS8);
        PH_END
        PH_BEGIN(pb + 5)
            pg8::Gemm g{(const bf16*)((const unsigned char*)XN - 2 * 4096), (const bf16*)(ws + wffn), 65 * 256, 2 * DFF, 2048, 254}; pg8::StaticOrder S; S.init(65 * 256, 2 * DFF, G, bx);
            pg8::EpiConvGeglu E{(bf16*)(ws + WS_ACT), SEL(10, 21, 39, 52), SEL(11, 22, 40, 53), ldsl + 131072, DFF, SEQ, RS8, 1.0f / pg8::I8_W_SCALE};
          for (int rep = 0; rep < REP_FFN1; ++rep)
            pg8::gemm_phase<pg8::EpiConvGeglu, pg8::StaticOrder, true, true, 2>(ldsl, g, S, E);
        PH_END
        PH_BEGIN(pb + 7)
            pg8::Gemm g{(const bf16*)(ws + WS_ACT), (const bf16*)(ws + wffn + W_FFN_OUT), SEQ, 4096, DFF}; pg8::StaticOrder S; S.init(SEQ, 4096, G, bx);
            pg8::EpiBf16B E{TMPF, 4096, nullptr};
          for (int rep = 0; rep < REP_FFN2; ++rep)
            pg8::gemm_phase<pg8::EpiBf16B, pg8::StaticOrder, true, true>(ldsl, g, S, E);
        PH_END
        PH_BEGIN(pb + 8)
          for (int rep = 0; rep < REP_NORM; ++rep)
            if (L == 3) { if (rep == 0) norm_phase<1, 0>(gw, ngw, lane, ldsl + wave * 16640, TMPF, SEL(13, 24, 42, 55), nullptr, out, HP, nullptr, nullptr, nullptr, 1.f); }
            else norm_phase<1, 1>(gw, ngw, lane, ldsl + wave * 16640, TMPF, SEL(13, 24, 42, 55), nullptr, nullptr, HP, SEL(14, 25, 43, 43), L == 2 ? XN : nullptr, L == 1 ? (bf16*)(ws + WS_S5_U) : nullptr, rep ? 0.f : 1.f, L == 0 ? (unsigned char*)XN : nullptr, 1.f, L == 0 ? RS8 : nullptr);
        PH_END
    }
    { constexpr int L = 2;

        const int type = L == 3 ? 0 : L, pb = 1 + 9 * L;
        const size_t wffn = W_FFN + (size_t)L * W_FFN_STRIDE;

        PH_BEGIN(pb + 0)
            if (type == 0) {
                pg8::Gemm g{XN, (const bf16*)(ws + (L == 0 ? W_L0_QKV : W_L3_QKV)), SEQ, 5120, 4096}; pg8::StaticOrder S; S.init(SEQ, 5120, G, bx);
                pg8::EpiBf16B E{(bf16*)(ws + WS_SWA_QKV), 5120, L == 0 ? IN(3) : IN(45)};
                for (int rep = 0; rep < REP_MIXG; ++rep) pg8::gemm_phase<pg8::EpiBf16B, pg8::StaticOrder, true, true>(ldsl, g, S, E);
            } else if (type == 1) {
                pg8::Gemm g{XN, (const bf16*)(ws + W_L1_QKVF), SEQ, 12544, 2048}; pg8::StaticOrder S; S.init(SEQ, 12544, G, bx);
                pg8::EpiFox E{(bf16*)(ws + WS_FOX_QKV), (float*)(ws + WS_FOX_LOGF), IN(16), RS8, 1.0f / pg8::I8_W_SCALE};
                for (int rep = 0; rep < REP_MIXG; ++rep) pg8::gemm_phase<pg8::EpiFox, pg8::StaticOrder, true, true, 2>(ldsl, g, S, E);
            } else {
              for (int rep = 0; rep < REP_MIX; ++rep)
                s5::s5_phase(ldsg, (const bf16*)(ws + WS_S5_U), IN(26), IN(27), IN(28), IN(29), IN(30), IN(31), IN(32), IN(33),
                             (bf16*)(ws + WS_S5_G), vcu, G);
            }
        PH_END
        if (type != 2) {
        PH_BEGIN(pb + 1)
          for (int rep = 0; rep < REP_MIX; ++rep) {
            if (type == 0) swa::swa_attn_phase(ldsg, (const bf16*)(ws + WS_SWA_QKV), L == 0 ? IN(4) : IN(46), cosT, sinT, (bf16*)(ws + WS_SWA_O), vcu, G);
            else { fox_cumsum_phase(ldsg, (const float*)(ws + WS_FOX_LOGF), (float*)(ws + WS_FOX_CNEG), vcu, G, tid);
                   if (G > 64) { if (vcu >= 32) fox_norms_phase((const bf16*)(ws + WS_FOX_QKV), (unsigned*)(ws + WS_CTL + CTL_NRM2), (vcu - 32) * NWAVES + wave, (G - 32) * NWAVES, lane); }
                   else fox_norms_phase((const bf16*)(ws + WS_FOX_QKV), (unsigned*)(ws + WS_CTL + CTL_NRM2), gw, ngw, lane); }
          }
        PH_END
        }
        if (type == 1) {
        PH_BEGIN(pb + 2)
            const bf16* q = (const bf16*)(ws + WS_FOX_QKV);
            fox::fox_attn_phase(ldsg, q, q + (size_t)32 * SEQ * 128, q + (size_t)64 * SEQ * 128, (const float*)(ws + WS_FOX_CNEG), (const unsigned*)(ws + WS_CTL + CTL_NRM2), (unsigned*)(ws + WS_CTL + CTL_QCTR), (bf16*)(ws + WS_FOX_O));
#if REP_FOX > 1
            __syncthreads();
            fox::fox_attn_phase(ldsg, q, q + (size_t)32 * SEQ * 128, q + (size_t)64 * SEQ * 128, (const float*)(ws + WS_FOX_CNEG), (const unsigned*)(ws + WS_CTL + CTL_NRM2), (unsigned*)(ws + WS_CTL + CTL_QCTR) + 64, (bf16*)(ws + WS_FOX_O));
#endif
        PH_END
        }
        PH_BEGIN(pb + 3)
            if (type == 2) {
                pg8::Gemm g{(const bf16*)(ws + WS_S5_G), (const bf16*)(ws + W_L2_GLU), SEQ, 8192, 4096}; pg8::StaticOrder S; S.init(SEQ, 8192, G, bx);
                pg8::EpiGlu E{TMPM, IN(35)};
                for (int rep = 0; rep < REP_MIXG; ++rep) pg8::gemm_phase<pg8::EpiGlu, pg8::StaticOrder, true, true>(ldsl, g, S, E);
            } else {
                pg8::Gemm g{(const bf16*)(ws + (type == 0 ? WS_SWA_O : WS_FOX_O)), (const bf16*)(ws + (L == 0 ? W_L0_O : L == 1 ? W_L1_O : W_L3_O)), SEQ, 4096, 4096};
                pg8::StaticOrder S; S.init(SEQ, 4096, G, bx);
                pg8::EpiBf16B E{TMPM, 4096, L == 0 ? IN(6) : L == 3 ? IN(48) : nullptr};
                for (int rep = 0; rep < REP_MIXG; ++rep) pg8::gemm_phase<pg8::EpiBf16B, pg8::StaticOrder, true, true>(ldsl, g, S, E);
            }
        PH_END
        PH_BEGIN(pb + 4)
          for (int rep = 0; rep < REP_NORM; ++rep)
            if (L == 0 && rep == 0) norm_phase<0, 1>(gw, ngw, lane, ldsl + wave * 16640, TMPM, SEL(7, 18, 36, 49), IN(0), nullptr, HP, SEL(8, 19, 37, 50), nullptr, nullptr, 1.f, (unsigned char*)XN, 1.f, RS8);
            else norm_phase<1, 1>(gw, ngw, lane, ldsl + wave * 16640, TMPM, SEL(7, 18, 36, 49), nullptr, nullptr, HP, SEL(8, 19, 37, 50), nullptr, nullptr, rep ? 0.f : 1.f, (unsigned char*)XN, 1.f, RS8);
        PH_END
        PH_BEGIN(pb + 5)
            pg8::Gemm g{(const bf16*)((const unsigned char*)XN - 2 * 4096), (const bf16*)(ws + wffn), 65 * 256, 2 * DFF, 2048, 254}; pg8::StaticOrder S; S.init(65 * 256, 2 * DFF, G, bx);
            pg8::EpiConvGeglu E{(bf16*)(ws + WS_ACT), SEL(10, 21, 39, 52), SEL(11, 22, 40, 53), ldsl + 131072, DFF, SEQ, RS8, 1.0f / pg8::I8_W_SCALE};
          for (int rep = 0; rep < REP_FFN1; ++rep)
            pg8::gemm_phase<pg8::EpiConvGeglu, pg8::StaticOrder, true, true, 2>(ldsl, g, S, E);
        PH_END
        PH_BEGIN(pb + 7)
            pg8::Gemm g{(const bf16*)(ws + WS_ACT), (const bf16*)(ws + wffn + W_FFN_OUT), SEQ, 4096, DFF}; pg8::StaticOrder S; S.init(SEQ, 4096, G, bx);
            pg8::EpiBf16B E{TMPF, 4096, nullptr};
          for (int rep = 0; rep < REP_FFN2; ++rep)
            pg8::gemm_phase<pg8::EpiBf16B, pg8::StaticOrder, true, true>(ldsl, g, S, E);
        PH_END
        PH_BEGIN(pb + 8)
          for (int rep = 0; rep < REP_NORM; ++rep)
            if (L == 3) { if (rep == 0) norm_phase<1, 0>(gw, ngw, lane, ldsl + wave * 16640, TMPF, SEL(13, 24, 42, 55), nullptr, out, HP, nullptr, nullptr, nullptr, 1.f); }
            else norm_phase<1, 1>(gw, ngw, lane, ldsl + wave * 16640, TMPF, SEL(13, 24, 42, 55), nullptr, nullptr, HP, SEL(14, 25, 43, 43), L == 2 ? XN : nullptr, L == 1 ? (bf16*)(ws + WS_S5_U) : nullptr, rep ? 0.f : 1.f, L == 0 ? (unsigned char*)XN : nullptr, 1.f, L == 0 ? RS8 : nullptr);
        PH_END
    }
    { constexpr int L = 3;

        const int type = L == 3 ? 0 : L, pb = 1 + 9 * L;
        const size_t wffn = W_FFN + (size_t)L * W_FFN_STRIDE;

        PH_BEGIN(pb + 0)
            if (type == 0) {
                pg8::Gemm g{XN, (const bf16*)(ws + (L == 0 ? W_L0_QKV : W_L3_QKV)), SEQ, 5120, 4096}; pg8::StaticOrder S; S.init(SEQ, 5120, G, bx);
                pg8::EpiBf16B E{(bf16*)(ws + WS_SWA_QKV), 5120, L == 0 ? IN(3) : IN(45)};
                for (int rep = 0; rep < REP_MIXG; ++rep) pg8::gemm_phase<pg8::EpiBf16B, pg8::StaticOrder, true, true>(ldsl, g, S, E);
            } else if (type == 1) {
                pg8::Gemm g{XN, (const bf16*)(ws + W_L1_QKVF), SEQ, 12544, 2048}; pg8::StaticOrder S; S.init(SEQ, 12544, G, bx);
                pg8::EpiFox E{(bf16*)(ws + WS_FOX_QKV), (float*)(ws + WS_FOX_LOGF), IN(16), RS8, 1.0f / pg8::I8_W_SCALE};
                for (int rep = 0; rep < REP_MIXG; ++rep) pg8::gemm_phase<pg8::EpiFox, pg8::StaticOrder, true, true, 2>(ldsl, g, S, E);
            } else {
              for (int rep = 0; rep < REP_MIX; ++rep)
                s5::s5_phase(ldsg, (const bf16*)(ws + WS_S5_U), IN(26), IN(27), IN(28), IN(29), IN(30), IN(31), IN(32), IN(33),
                             (bf16*)(ws + WS_S5_G), vcu, G);
            }
        PH_END
        if (type != 2) {
        PH_BEGIN(pb + 1)
          for (int rep = 0; rep < REP_MIX; ++rep) {
            if (type == 0) swa::swa_attn_phase(ldsg, (const bf16*)(ws + WS_SWA_QKV), L == 0 ? IN(4) : IN(46), cosT, sinT, (bf16*)(ws + WS_SWA_O), vcu, G);
            else { fox_cumsum_phase(ldsg, (const float*)(ws + WS_FOX_LOGF), (float*)(ws + WS_FOX_CNEG), vcu, G, tid);
                   if (G > 64) { if (vcu >= 32) fox_norms_phase((const bf16*)(ws + WS_FOX_QKV), (unsigned*)(ws + WS_CTL + CTL_NRM2), (vcu - 32) * NWAVES + wave, (G - 32) * NWAVES, lane); }
                   else fox_norms_phase((const bf16*)(ws + WS_FOX_QKV), (unsigned*)(ws + WS_CTL + CTL_NRM2), gw, ngw, lane); }
          }
        PH_END
        }
        if (type == 1) {
        PH_BEGIN(pb + 2)
            const bf16* q = (const bf16*)(ws + WS_FOX_QKV);
            fox::fox_attn_phase(ldsg, q, q + (size_t)32 * SEQ * 128, q + (size_t)64 * SEQ * 128, (const float*)(ws + WS_FOX_CNEG), (const unsigned*)(ws + WS_CTL + CTL_NRM2), (unsigned*)(ws + WS_CTL + CTL_QCTR), (bf16*)(ws + WS_FOX_O));
#if REP_FOX > 1
            __syncthreads();
            fox::fox_attn_phase(ldsg, q, q + (size_t)32 * SEQ * 128, q + (size_t)64 * SEQ * 128, (const float*)(ws + WS_FOX_CNEG), (const unsigned*)(ws + WS_CTL + CTL_NRM2), (unsigned*)(ws + WS_CTL + CTL_QCTR) + 64, (bf16*)(ws + WS_FOX_O));
#endif
        PH_END
        }
        PH_BEGIN(pb + 3)
            if (type == 2) {
                pg8::Gemm g{(const bf16*)(ws + WS_S5_G), (const bf16*)(ws + W_L2_GLU), SEQ, 8192, 4096}; pg8::StaticOrder S; S.init(SEQ, 8192, G, bx);
                pg8::EpiGlu E{TMPM, IN(35)};
                for (int rep = 0; rep < REP_MIXG; ++rep) pg8::gemm_phase<pg8::EpiGlu, pg8::StaticOrder, true, true>(ldsl, g, S, E);
            } else {
                pg8::Gemm g{(const bf16*)(ws + (type == 0 ? WS_SWA_O : WS_FOX_O)), (const bf16*)(ws + (L == 0 ? W_L0_O : L == 1 ? W_L1_O : W_L3_O)), SEQ, 4096, 4096};
                pg8::StaticOrder S; S.init(SEQ, 4096, G, bx);
                pg8::EpiBf16B E{TMPM, 4096, L == 0 ? IN(6) : L == 3 ? IN(48) : nullptr};
                for (int rep = 0; rep < REP_MIXG; ++rep) pg8::gemm_phase<pg8::EpiBf16B, pg8::StaticOrder, true, true>(ldsl, g, S, E);
            }
        PH_END
        PH_BEGIN(pb + 4)
          for (int rep = 0; rep < REP_NORM; ++rep)
            if (L == 0 && rep == 0) norm_phase<0, 1>(gw, ngw, lane, ldsl + wave * 16640, TMPM, SEL(7, 18, 36, 49), IN(0), nullptr, HP, SEL(8, 19, 37, 50), nullptr, nullptr, 1.f, (unsigned char*)XN, 1.f, RS8);
            else norm_phase<1, 1>(gw, ngw, lane, ldsl + wave * 16640, TMPM, SEL(7, 18, 36, 49), nullptr, nullptr, HP, SEL(8, 19, 37, 50), nullptr, nullptr, rep ? 0.f : 1.f, (unsigned char*)XN, 1.f, RS8);
        PH_END
        PH_BEGIN(pb + 5)
            pg8::Gemm g{(const bf16*)((const unsigned char*)XN - 2 * 4096), (const bf16*)(ws + wffn), 65 * 256, 2 * DFF, 2048, 254}; pg8::StaticOrder S; S.init(65 * 256, 2 * DFF, G, bx);
            pg8::EpiConvGeglu E{(bf16*)(ws + WS_ACT), SEL(10, 21, 39, 52), SEL(11, 22, 40, 53), ldsl + 131072, DFF, SEQ, RS8, 1.0f / pg8::I8_W_SCALE};
          for (int rep = 0; rep < REP_FFN1; ++rep)
            pg8::gemm_phase<pg8::EpiConvGeglu, pg8::StaticOrder, true, true, 2>(ldsl, g, S, E);
        PH_END
        PH_BEGIN(pb + 7)
            pg8::Gemm g{(const bf16*)(ws + WS_ACT), (const bf16*)(ws + wffn + W_FFN_OUT), SEQ, 4096, DFF}; pg8::StaticOrder S; S.init(SEQ, 4096, G, bx);
            pg8::EpiBf16B E{TMPF, 4096, nullptr};
          for (int rep = 0; rep < REP_FFN2; ++rep)
            pg8::gemm_phase<pg8::EpiBf16B, pg8::StaticOrder, true, true>(ldsl, g, S, E);
        PH_END
        PH_BEGIN(pb + 8)
          for (int rep = 0; rep < REP_NORM; ++rep)
            if (L == 3) { if (rep == 0) norm_phase<1, 0>(gw, ngw, lane, ldsl + wave * 16640, TMPF, SEL(13, 24, 42, 55), nullptr, out, HP, nullptr, nullptr, nullptr, 1.f); }
            else norm_phase<1, 1>(gw, ngw, lane, ldsl + wave * 16640, TMPF, SEL(13, 24, 42, 55), nullptr, nullptr, HP, SEL(14, 25, 43, 43), L == 2 ? XN : nullptr, L == 1 ? (bf16*)(ws + WS_S5_U) : nullptr, rep ? 0.f : 1.f, L == 0 ? (unsigned char*)XN : nullptr, 1.f, L == 0 ? RS8 : nullptr);
        PH_END
    }
#if PROBE_WAIT > 0
#if PROBE_WG >= 0
    if ((int)blockIdx.x == PROBE_WG) { const unsigned long long ts = __builtin_amdgcn_s_memrealtime(); while (__builtin_amdgcn_s_memrealtime() - ts < probe_acc * PROBE_WAIT) __builtin_amdgcn_s_sleep(8); }
#elif PROBE_WG == -1
    { const unsigned long long ts = __builtin_amdgcn_s_memrealtime(); while (__builtin_amdgcn_s_memrealtime() - ts < probe_acc * PROBE_WAIT) __builtin_amdgcn_s_sleep(8); }
#else
    { const unsigned long long ts = __builtin_amdgcn_s_memrealtime(); const unsigned long long c = 250000ull, w = probe_acc < c ? c - probe_acc : 0ull; while (__builtin_amdgcn_s_memrealtime() - ts < w * PROBE_WAIT) __builtin_amdgcn_s_sleep(8); }
#endif
#endif
#undef SEL
#undef PH_BEGIN
#undef PH_END
#undef IN
}

extern "C" void kernel_launch(void* const* d_in, const int* in_sizes, int n_in, void* d_out, int out_size, void* d_ws, size_t ws_size, hipStream_t stream) {
    static int grid = 0;
    if (grid == 0) {
        if (n_in != 56 || in_sizes[0] != SEQ * DM || out_size != SEQ * DM || ws_size < WS_END) {
            fprintf(stderr, "kernel_launch: built for 56 inputs, x/out of %d floats, >= %zu bytes of workspace; got n_in %d, in0 %d, out %d, ws %zu; nothing launched\n", SEQ * DM, (size_t)WS_END, n_in, n_in > 0 ? in_sizes[0] : -1, out_size, ws_size);
            grid = -1; return; }
        int dev = 0, cus = 0, per_cu = 0;
        if (hipGetDevice(&dev) != hipSuccess || hipDeviceGetAttribute(&cus, hipDeviceAttributeMultiprocessorCount, dev) != hipSuccess) { fprintf(stderr, "kernel_launch: device query failed\n"); grid = -1; return; }
        if (hipFuncSetAttribute((const void*)mk_fwd, hipFuncAttributeMaxDynamicSharedMemorySize, LDS_BYTES) != hipSuccess) { fprintf(stderr, "kernel_launch: hipFuncSetAttribute failed\n"); grid = -1; return; }
        if (hipOccupancyMaxActiveBlocksPerMultiprocessor(&per_cu, (const void*)mk_fwd, NTHR, LDS_BYTES) != hipSuccess || per_cu < 1) { fprintf(stderr, "kernel_launch: occupancy query says %d workgroups per CU\n", per_cu); (void)hipGetLastError(); }
        grid = cus;
    }
    if (grid < 0) return;
    if (hipMemsetAsync((char*)d_ws + WS_CTL, 0, CTL_ZERO_BYTES, stream) != hipSuccess) { fprintf(stderr, "kernel_launch: memset failed\n"); return; }
    Args a{};
    for (int i = 0; i < 56; ++i) a.in[i] = (const float*)d_in[i];
    a.out = (float*)d_out; a.ws = (unsigned char*)d_ws;
    { const float lt = (float)(-std::log(500000.0)); for (int i = 0; i < 8; ++i) { float v = lt * (float)i; v = v * 0.125f; a.inv_freq[i] = (float)std::exp((double)v); } }
#if MK_SPLIT_LAUNCHES
    for (int ph = 0; ph < 37; ++ph) {
        const int L = (ph - 1) / 9, slot = (ph - 1) % 9, type = L == 3 ? 0 : L;
        if (ph > 0 && ((slot == 1 && type == 2) || (slot == 2 && type != 1) || slot == 6)) continue;
        a.ph_lo = ph; a.ph_hi = ph + 1;
        hipLaunchKernelGGL(mk_fwd, dim3(grid), dim3(NTHR), LDS_BYTES, stream, a);
    }
#else
    a.ph_lo = 0; a.ph_hi = 37;
    hipLaunchKernelGGL(mk_fwd, dim3(grid), dim3(NTHR), LDS_BYTES, stream, a);
#endif
    const hipError_t le = hipPeekAtLastError();
    if (le != hipSuccess) fprintf(stderr, "kernel_launch: launch failed: %s (grid %d x %d threads, %d B LDS)\n", hipGetErrorName(le), grid, NTHR, LDS_BYTES);
}
```

```cpp
#include <hip/hip_runtime.h>
#include <cstdio>
#include <cstdint>
#include <cmath>

#ifndef MK_SPLIT_LAUNCHES
#define MK_SPLIT_LAUNCHES 0
#endif

__device__ __forceinline__ int mk_tid() { int t = threadIdx.x; asm volatile("" : "+v"(t)); return t; }
__device__ __forceinline__ int launder_s(int v) { asm volatile("" : "+s"(v)); return v; }

#ifndef PROBE_WAIT
#define PROBE_WAIT 0
#endif
#ifndef PROBE_ID
#define PROBE_ID -1
#endif
#ifndef PROBE_MASK
#define PROBE_MASK 0x080
#endif
#ifndef PROBE_WG
#define PROBE_WG -1
#endif
#ifndef F8_FIRST_LAYER
#define F8_FIRST_LAYER 2
#endif
#ifndef PROBE_COPY
#define PROBE_COPY 0
#endif
#ifndef PROBE_T
#define PROBE_T u32x2
#endif
#define PROBE_LD(p) (*(p))
#define PROBE_ST(v, p) (*(p) = (v))
#ifndef REP_PRO
#define REP_PRO 1
#endif
#ifndef REP_FFN1
#define REP_FFN1 1
#endif
#ifndef REP_FFN2
#define REP_FFN2 1
#endif
#ifndef REP_NORM
#define REP_NORM 1
#endif
#ifndef REP_BAR
#define REP_BAR 1
#endif
#ifndef REP_FOX
#define REP_FOX 1
#endif
#ifndef REP_MIXG
#define REP_MIXG 1
#endif
#ifndef REP_MIX
#define REP_MIX 1
#endif

namespace pg8 {
#define PG8_LAS __attribute__((address_space(3)))
typedef unsigned short bf16_t;
typedef short bf16x8 __attribute__((ext_vector_type(8)));
typedef float f32x4 __attribute__((ext_vector_type(4)));
typedef unsigned u32x4 __attribute__((ext_vector_type(4)));
typedef unsigned u32x2 __attribute__((ext_vector_type(2)));
typedef float f32x2 __attribute__((ext_vector_type(2)));
typedef int v4i32 __attribute__((ext_vector_type(4)));
constexpr int F8_W_LOG2 = 10, F8_X_LOG2 = 4, F8_SCALE_W = 0x01010101 * (127 - (F8_W_LOG2 + F8_X_LOG2) / 2), F8_SCALE_X = F8_SCALE_W;
constexpr float I8_W_SCALE = 1800.f;
static_assert((F8_W_LOG2 + F8_X_LOG2) % 2 == 0, "the two scalings are undone by two equal E8M0 scales");
constexpr int BM = 256, BK = 64, HALF = 128, HTB = HALF * BK * 2  , STAGE_BYTES = 8 * HTB, NXCD = 8, WGM = 8;

__host__ __device__ __forceinline__ int lds_byte(int r, int c) { const int st = (r >> 4) * 2 + (c >> 5), rr = r & 15, cc = c & 31, ob = rr * 64 + cc * 2; return st * 1024 + (ob ^ (((ob >> 9) & 1) << 5)); }
__host__ __device__ __forceinline__ void stage_rc(int b, int& R, int& C) { const int st = b / 1024, sb = b % 1024, swz = sb ^ (((sb >> 9) & 1) << 5); R = (st >> 1) * 16 + swz / 64; C = (st & 1) * 32 + (swz % 64) / 2; }
__host__ __device__ __forceinline__ int perm32(int rho) { const int n = rho >> 4, i = rho & 15; return 8 * (i >> 2) + 4 * n + (i & 3); }

struct Unit { int pm, pn; };
struct Gemm { const bf16_t* A; const bf16_t* Bt; int M, N, K; int apr = 256; };

struct StaticOrder {
    int nM, nN, nwg, G, c;
    __host__ __device__ void init(int M, int N, int G_, int c_) { nM = M / BM; nN = N / BM; nwg = nM * nN; G = G_; c = c_; }
    __host__ __device__ bool next(int i, Unit& u) const {
        const long L = (long)i * G + c; if (L >= nwg) return false;
        int wgid = (int)L; { const int q = nwg / NXCD, r = nwg % NXCD, xcd = wgid % NXCD, off = wgid / NXCD; wgid = (xcd < r ? xcd * (q + 1) : r * (q + 1) + (xcd - r) * q) + off; }
        const int nig = WGM * nN, ngf = nM / WGM > 0 ? nM / WGM : 1; int gid = wgid / nig; if (gid >= ngf) gid = ngf - 1;
        const int fm = gid * WGM, gsz = gid == ngf - 1 ? nM - fm : WGM, w = wgid - gid * nig;
        u.pm = fm + (w % gsz); u.pn = w / gsz; return true;
    }
    __device__ __forceinline__ void a_ready(const Unit&) const {}
    __device__ __forceinline__ void done(const Unit&) const {}
};

__device__ __forceinline__ unsigned cvt_pk_bf16(float lo, float hi) { unsigned r; asm volatile("v_cvt_pk_bf16_f32 %0, %1, %2" : "=v"(r) : "v"(lo), "v"(hi)); return r; }

struct EpiF32B {
    static constexpr bool PERM = false, AFTER_DRAIN = false, APERM = false;
    float* C; int ldc; const float* bias;
    __device__ __forceinline__ void operator()(const f32x4 (&acc)[2][2][4][2], const Unit& u, int wr, int wc, int fr, int fq) const {
        const int row0 = u.pm * BM + wr * 64 + fr, col0 = u.pn * BM + wc * 32 + 4 * fq;
        f32x4 bv[2][2];
#pragma unroll
        for (int bj = 0; bj < 2; ++bj)
#pragma unroll
            for (int n = 0; n < 2; ++n) bv[bj][n] = bias ? *(const f32x4*)(bias + col0 + bj * HALF + n * 16) : (f32x4){0.f, 0.f, 0.f, 0.f};
#pragma unroll
        for (int ai = 0; ai < 2; ++ai)
#pragma unroll
            for (int m = 0; m < 4; ++m) { float* rowp = C + (size_t)(row0 + ai * HALF + m * 16) * ldc + col0;
#pragma unroll
                for (int bj = 0; bj < 2; ++bj)
#pragma unroll
                    for (int n = 0; n < 2; ++n) *(f32x4*)(rowp + bj * HALF + n * 16) = acc[ai][bj][m][n] + bv[bj][n]; }
    }
};
struct EpiBf16B {
    static constexpr bool PERM = true, AFTER_DRAIN = false, APERM = false;
    bf16_t* O; int ldc; const float* bias;
    __device__ __forceinline__ void operator()(const f32x4 (&acc)[2][2][4][2], const Unit& u, int wr, int wc, int fr, int fq) const {
        const int row0 = u.pm * BM + wr * 64 + fr; const int col0 = u.pn * BM + wc * 32 + 8 * fq;
        f32x4 bv[2][2];
#pragma unroll
        for (int bj = 0; bj < 2; ++bj)
#pragma unroll
            for (int n = 0; n < 2; ++n) bv[bj][n] = bias ? *(const f32x4*)(bias + col0 + bj * HALF + 4 * n) : (f32x4){0.f, 0.f, 0.f, 0.f};
#pragma unroll
        for (int ai = 0; ai < 2; ++ai)
#pragma unroll
            for (int m = 0; m < 4; ++m) { bf16_t* rowp = O + (size_t)(row0 + ai * HALF + m * 16) * ldc + col0;
#pragma unroll
                for (int bj = 0; bj < 2; ++bj) { const f32x4 v0 = acc[ai][bj][m][0] + bv[bj][0], v1 = acc[ai][bj][m][1] + bv[bj][1];
                    u32x4 w; w.x = cvt_pk_bf16(v0[0], v0[1]); w.y = cvt_pk_bf16(v0[2], v0[3]); w.z = cvt_pk_bf16(v1[0], v1[1]); w.w = cvt_pk_bf16(v1[2], v1[3]);
                    *(u32x4*)(rowp + bj * HALF) = w; } }
    }
};
struct EpiFox {
    static constexpr bool PERM = true, AFTER_DRAIN = false, APERM = false;
    bf16_t* QKV; float* logf; const float* bfg; const float* rs = nullptr; float wsc = 1.f;
    __device__ __forceinline__ void dequant(f32x4 (&acc)[2][2][4][2], const Unit& u, int wr, int wc, int fr, int fq) const {
#pragma unroll
        for (int ai = 0; ai < 2; ++ai)
#pragma unroll
            for (int m = 0; m < 4; ++m) { const float sc = rs[u.pm * BM + wr * 64 + fr + ai * HALF + m * 16 + 2] * wsc;
#pragma unroll
                for (int bj = 0; bj < 2; ++bj)
#pragma unroll
                    for (int n = 0; n < 2; ++n) { const v4i32 q = __builtin_bit_cast(v4i32, acc[ai][bj][m][n]);
                        acc[ai][bj][m][n] = (f32x4){(float)q[0] * sc, (float)q[1] * sc, (float)q[2] * sc, (float)q[3] * sc}; } }
    }
    __device__ __forceinline__ void operator()(const f32x4 (&acc)[2][2][4][2], const Unit& u, int wr, int wc, int fr, int fq) const {
        const int row0 = u.pm * BM + wr * 64 + fr;
        if (u.pn < 48) {
            const int t3 = u.pn >> 4, hp = u.pn & 15;
#pragma unroll
            for (int bj = 0; bj < 2; ++bj) { bf16_t* base = QKV + ((size_t)(t3 * 32 + 2 * hp + bj) * 16384) * 128 + wc * 32 + 8 * fq;
#pragma unroll
                for (int ai = 0; ai < 2; ++ai)
#pragma unroll
                    for (int m = 0; m < 4; ++m) { const f32x4 v0 = acc[ai][bj][m][0], v1 = acc[ai][bj][m][1];
                        u32x4 w; w.x = cvt_pk_bf16(v0[0], v0[1]); w.y = cvt_pk_bf16(v0[2], v0[3]); w.z = cvt_pk_bf16(v1[0], v1[1]); w.w = cvt_pk_bf16(v1[2], v1[3]);
                        *(u32x4*)(base + (size_t)(row0 + ai * HALF + m * 16) * 128) = w; } }
        } else if (wc == 0) {
            const f32x4 b0 = *(const f32x4*)(bfg + 8 * fq), b1 = *(const f32x4*)(bfg + 8 * fq + 4);
#pragma unroll
            for (int ai = 0; ai < 2; ++ai)
#pragma unroll
                for (int m = 0; m < 4; ++m) { float* rowp = logf + (size_t)(row0 + ai * HALF + m * 16) * 32 + 8 * fq;
#pragma unroll
                    for (int n = 0; n < 2; ++n) { const f32x4 z = acc[ai][0][m][n] + (n ? b1 : b0); f32x4 o;
#pragma unroll
                        for (int i = 0; i < 4; ++i) o[i] = fminf(z[i], 0.f) - log1pf(expf(-fabsf(z[i])));
                        *(f32x4*)(rowp + 4 * n) = o; } }
        }
    }
};
struct EpiGlu {
    static constexpr bool PERM = true, AFTER_DRAIN = false, APERM = false;
    bf16_t* C; const float* bias; const float* rs = nullptr; float wsc = 1.f;
    __device__ __forceinline__ void dequant(f32x4 (&acc)[2][2][4][2], const Unit& u, int wr, int wc, int fr, int fq) const {
#pragma unroll
        for (int ai = 0; ai < 2; ++ai)
#pragma unroll
            for (int m = 0; m < 4; ++m) { const float sc = rs[u.pm * BM + wr * 64 + fr + ai * HALF + m * 16 + 2] * wsc;
#pragma unroll
                for (int bj = 0; bj < 2; ++bj)
#pragma unroll
                    for (int n = 0; n < 2; ++n) { const v4i32 q = __builtin_bit_cast(v4i32, acc[ai][bj][m][n]);
                        acc[ai][bj][m][n] = (f32x4){(float)q[0] * sc, (float)q[1] * sc, (float)q[2] * sc, (float)q[3] * sc}; } }
    }
    __device__ __forceinline__ void operator()(const f32x4 (&acc)[2][2][4][2], const Unit& u, int wr, int wc, int fr, int fq) const {
        const int row0 = u.pm * BM + wr * 64 + fr, col0 = u.pn * HALF + wc * 32 + 8 * fq;
        f32x4 bv[2], bg[2];
#pragma unroll
        for (int n = 0; n < 2; ++n) { bv[n] = *(const f32x4*)(bias + col0 + 4 * n); bg[n] = *(const f32x4*)(bias + 4096 + col0 + 4 * n); }
#pragma unroll
        for (int ai = 0; ai < 2; ++ai)
#pragma unroll
            for (int m = 0; m < 4; ++m) { bf16_t* rowp = C + (size_t)(row0 + ai * HALF + m * 16) * 4096 + col0; u32x4 w;
#pragma unroll
                for (int n = 0; n < 2; ++n) { const f32x4 zv = acc[ai][0][m][n] + bv[n], zg = acc[ai][1][m][n] + bg[n]; f32x4 o;
#pragma unroll
                    for (int i = 0; i < 4; ++i) o[i] = zv[i] * __builtin_amdgcn_rcpf(1.0f + __builtin_amdgcn_exp2f(-1.4426950408889634f * zg[i]));
                    if (n == 0) { w.x = cvt_pk_bf16(o[0], o[1]); w.y = cvt_pk_bf16(o[2], o[3]); } else { w.z = cvt_pk_bf16(o[0], o[1]); w.w = cvt_pk_bf16(o[2], o[3]); } }
                *(u32x4*)rowp = w; }
    }
};

struct EpiConvGeglu {
    static constexpr bool PERM = true, AFTER_DRAIN = false, APERM = true;
    bf16_t* ACT; const float* cw; const float* cb; PG8_LAS unsigned char* xl; int dff, nrows; const float* rs; float wsc;
    __device__ __forceinline__ void dequant(f32x4 (&acc)[2][2][4][2], const Unit& u, int wr, int wc, int fr, int fq) const {
#pragma unroll
        for (int ai = 0; ai < 2; ++ai)
#pragma unroll
            for (int m = 0; m < 4; ++m) { int idx = u.pm * 254 + ai * HALF + wr * 64 + 4 * fr + m; idx = idx < nrows + 2 ? idx : nrows + 1; const float sc = rs[idx] * wsc;
#pragma unroll
                for (int bj = 0; bj < 2; ++bj)
#pragma unroll
                    for (int n = 0; n < 2; ++n) { const v4i32 q = __builtin_bit_cast(v4i32, acc[ai][bj][m][n]);
                        acc[ai][bj][m][n] = (f32x4){(float)q[0] * sc, (float)q[1] * sc, (float)q[2] * sc, (float)q[3] * sc}; } }
    }
    static __device__ __forceinline__ float shr1(float old, float src) {
        return __builtin_bit_cast(float, __builtin_amdgcn_update_dpp(__builtin_bit_cast(int, old), __builtin_bit_cast(int, src), 0x111, 0xf, 0xf, false)); }
    static __device__ __forceinline__ float gelu_t(float x) { const float t = 0.7978845608028654f * (x + 0.044715f * x * x * x); return x * __builtin_amdgcn_rcpf(1.0f + __builtin_amdgcn_exp2f(-2.8853900817779268f * t)); }
    __device__ __forceinline__ void operator()(const f32x4 (&acc)[2][2][4][2], const Unit& u, int wr, int wc, int fr, int fq) const {
        asm volatile("" : "+v"(fr), "+v"(fq));
#define XOFF(ai_, w_, rr_, bj_, n_) ((((((ai_) * 2 + (w_)) * 2 + (rr_)) * 2 + (bj_)) * 4 + wc) * 128 + fq * 32 + (n_) * 16)
        f32x4 wv[8];
        { const int gc = u.pn * HALF + wc * 32 + 8 * fq;
            wv[0] = *(const f32x4*)(cw + gc); wv[1] = *(const f32x4*)(cw + 2 * dff + gc); wv[2] = *(const f32x4*)(cw + 4 * dff + gc); wv[3] = *(const f32x4*)(cb + gc);
            wv[4] = *(const f32x4*)(cw + dff + gc); wv[5] = *(const f32x4*)(cw + 3 * dff + gc); wv[6] = *(const f32x4*)(cw + 5 * dff + gc); wv[7] = *(const f32x4*)(cb + dff + gc); }
        if (fr == 15) {
#pragma unroll
            for (int ai = 0; ai < 2; ++ai)
#pragma unroll
                for (int bj = 0; bj < 2; ++bj)
#pragma unroll
                    for (int n = 0; n < 2; ++n) { *(PG8_LAS f32x4*)(xl + XOFF(ai, wr, 0, bj, n)) = acc[ai][bj][2][n]; *(PG8_LAS f32x4*)(xl + XOFF(ai, wr, 1, bj, n)) = acc[ai][bj][3][n]; }
        }
        asm volatile("s_waitcnt lgkmcnt(0)" ::: "memory"); __builtin_amdgcn_s_barrier(); asm volatile("" ::: "memory");
        u32x2 keep[2][4];
#pragma unroll
        for (int n = 0; n < 2; ++n) {
            const int gcol = u.pn * HALF + wc * 32 + 8 * fq + 4 * n;
            if (n) { wv[0] = *(const f32x4*)(cw + gcol); wv[1] = *(const f32x4*)(cw + 2 * dff + gcol); wv[2] = *(const f32x4*)(cw + 4 * dff + gcol); wv[3] = *(const f32x4*)(cb + gcol);
                     wv[4] = *(const f32x4*)(cw + dff + gcol); wv[5] = *(const f32x4*)(cw + 3 * dff + gcol); wv[6] = *(const f32x4*)(cw + 5 * dff + gcol); wv[7] = *(const f32x4*)(cb + dff + gcol); }
            const f32x4 wg0 = wv[0], wg1 = wv[1], wg2 = wv[2], bg = wv[3], wu0 = wv[4], wu1 = wv[5], wu2 = wv[6], bu = wv[7];
#pragma unroll
            for (int ai = 0; ai < 2; ++ai) {
                f32x4 Xg2 = {0.f, 0.f, 0.f, 0.f}, Xg3 = Xg2, Xu2 = Xg2, Xu3 = Xg2;
                if (ai + wr > 0) { const int pa = wr ? ai : ai - 1, pw = wr ? 0 : 1;
                    Xg2 = *(const PG8_LAS f32x4*)(xl + XOFF(pa, pw, 0, 0, n)); Xg3 = *(const PG8_LAS f32x4*)(xl + XOFF(pa, pw, 1, 0, n));
                    Xu2 = *(const PG8_LAS f32x4*)(xl + XOFF(pa, pw, 0, 1, n)); Xu3 = *(const PG8_LAS f32x4*)(xl + XOFF(pa, pw, 1, 1, n)); }
                float o[4][4];
#pragma unroll
                for (int ip = 0; ip < 2; ++ip) {
                    const int i0 = 2 * ip, i1 = 2 * ip + 1;
#define P2(v) ((f32x2){(v)[i0], (v)[i1]})
                    const f32x2 g0 = P2(acc[ai][0][0][n]), g1 = P2(acc[ai][0][1][n]), g2 = P2(acc[ai][0][2][n]), g3 = P2(acc[ai][0][3][n]);
                    const f32x2 u0 = P2(acc[ai][1][0][n]), u1 = P2(acc[ai][1][1][n]), u2 = P2(acc[ai][1][2][n]), u3 = P2(acc[ai][1][3][n]);
                    const f32x2 gm1 = {shr1(Xg3[i0], g3.x), shr1(Xg3[i1], g3.y)}, gm2 = {shr1(Xg2[i0], g2.x), shr1(Xg2[i1], g2.y)};
                    const f32x2 um1 = {shr1(Xu3[i0], u3.x), shr1(Xu3[i1], u3.y)}, um2 = {shr1(Xu2[i0], u2.x), shr1(Xu2[i1], u2.y)};
                    const f32x2 a2 = P2(wg2), a1 = P2(wg1), a0 = P2(wg0), ab = P2(bg), c2 = P2(wu2), c1 = P2(wu1), c0 = P2(wu0), cb = P2(bu);
#define FMA2(a, b, c) __builtin_elementwise_fma((a), (b), (c))
                    const f32x2 zg[4] = {FMA2(a0, gm2, FMA2(a1, gm1, FMA2(a2, g0, ab))), FMA2(a0, gm1, FMA2(a1, g0, FMA2(a2, g1, ab))), FMA2(a0, g0, FMA2(a1, g1, FMA2(a2, g2, ab))), FMA2(a0, g1, FMA2(a1, g2, FMA2(a2, g3, ab)))};
                    const f32x2 zu[4] = {FMA2(c0, um2, FMA2(c1, um1, FMA2(c2, u0, cb))), FMA2(c0, um1, FMA2(c1, u0, FMA2(c2, u1, cb))), FMA2(c0, u0, FMA2(c1, u1, FMA2(c2, u2, cb))), FMA2(c0, u1, FMA2(c1, u2, FMA2(c2, u3, cb)))};
#pragma unroll
                    for (int m = 0; m < 4; ++m) {
                        const f32x2 x = zg[m], x2 = x * x; const f32x2 kk = {-2.302208198f, -2.302208198f}, k3 = {-2.302208198f * 0.044715f, -2.302208198f * 0.044715f}, one = {1.f, 1.f};
                        const f32x2 a = x * FMA2(x2, k3, kk); const f32x2 e = {__builtin_amdgcn_exp2f(a.x), __builtin_amdgcn_exp2f(a.y)}; const f32x2 d = e + one;
                        const f32x2 r = {__builtin_amdgcn_rcpf(d.x), __builtin_amdgcn_rcpf(d.y)}; const f32x2 ov = (x * zu[m]) * r;
                        o[m][i0] = ov.x; o[m][i1] = ov.y; }
#undef FMA2
#undef P2
                }
#pragma unroll
                for (int m = 0; m < 4; ++m) { const int it = ai * HALF + wr * 64 + 4 * fr + m, grow = u.pm * 254 - 2 + it;
                    u32x2 w; w.x = cvt_pk_bf16(o[m][0], o[m][1]); w.y = cvt_pk_bf16(o[m][2], o[m][3]);
                    if (n == 0) keep[ai][m] = w;
                    else if (it >= 2 && grow < nrows) { u32x4 ww; ww.x = keep[ai][m].x; ww.y = keep[ai][m].y; ww.z = w.x; ww.w = w.y; *(u32x4*)(ACT + (size_t)grow * dff + gcol - 4) = ww; } }
            }
        }
#undef XOFF
    }
};

template <class Epi, class Sched, bool ALIGN_EPI = false, bool SP2 = false, int QM = 0>
__device__ __forceinline__ void gemm_phase(PG8_LAS unsigned char* lds, const Gemm g, const Sched& S, const Epi& E) {
    const int tid = mk_tid(), wid = __builtin_amdgcn_readfirstlane(tid >> 6), lane = tid & 63, wr = wid >> 2, wc = wid & 3, fr = lane & 15, fq = lane >> 4;
    const int K = g.K, nt = K / BK;
    unsigned voffA, voffB;
    { int R, C; stage_rc(tid * 16, R, C); const int Rb = Epi::PERM ? ((R & ~31) + perm32(R & 31)) : R;
        const int Ra = Epi::APERM ? ((R & ~63) + 4 * (R & 15) + ((R >> 4) & 3)) : R;
        voffA = (unsigned)(Ra * K + C) * 2u; voffB = (unsigned)(Rb * K + C) * 2u; }
    const size_t r64 = (size_t)64 * K * 2;
    const size_t kstep = (size_t)(BK * 2);
    const size_t hstep = (size_t)HALF * K * 2;
    const size_t tstep = 2 * hstep;
    const size_t tstepA = (size_t)g.apr * K * 2;
    const unsigned ldsw = (unsigned)wid * 1024u;
    const int aoff = lds_byte(wr * 64 + fr, fq * 8), boff = lds_byte(wc * 32 + fr, fq * 8);
#define PG8_SA(b, h) (((b) * 2 + (h)) * HTB)
#define PG8_SB(b, h) ((4 + (b) * 2 + (h)) * HTB)
#define PG8_STAGE(bufoff, gbase, voff) do { _Pragma("unroll") for (int _i = 0; _i < 2; ++_i) \
        __builtin_amdgcn_global_load_lds((const unsigned*)((const char*)(gbase) + (size_t)_i * r64 + (voff)), (PG8_LAS unsigned*)(lds + (bufoff) + ldsw + _i * 8192), 16, 0, 0); } while (0)
#define PG8_LDA(dst, b, h) do { _Pragma("unroll") for (int m = 0; m < 4; ++m) _Pragma("unroll") for (int k = 0; k < 2; ++k) dst[m][k] = *(const PG8_LAS bf16x8*)(lds + PG8_SA(b, h) + aoff + m * 2048 + k * 1024); } while (0)
#define PG8_LDB(dst, b, h) do { _Pragma("unroll") for (int n = 0; n < 2; ++n) _Pragma("unroll") for (int k = 0; k < 2; ++k) dst[n][k] = *(const PG8_LAS bf16x8*)(lds + PG8_SB(b, h) + boff + n * 2048 + k * 1024); } while (0)
#define PG8_CAT(f) __builtin_shufflevector(__builtin_bit_cast(v4i32, (f)[0]), __builtin_bit_cast(v4i32, (f)[1]), 0, 1, 2, 3, 4, 5, 6, 7)
#define PG8_MMA(ai, bj, At, Bt) do { __builtin_amdgcn_s_setprio(1); _Pragma("unroll") for (int m = 0; m < 4; ++m) _Pragma("unroll") for (int n = 0; n < 2; ++n) { \
        if constexpr (QM == 1) acc[ai][bj][m][n] = __builtin_amdgcn_mfma_scale_f32_16x16x128_f8f6f4(PG8_CAT(Bt[n]), PG8_CAT(At[m]), acc[ai][bj][m][n], 0, 0, 0, F8_SCALE_W, 0, F8_SCALE_X); \
        else if constexpr (QM == 2) { _Pragma("unroll") for (int k = 0; k < 2; ++k) acc[ai][bj][m][n] = __builtin_bit_cast(f32x4, __builtin_amdgcn_mfma_i32_16x16x64_i8( \
            __builtin_bit_cast(v4i32, Bt[n][k]), __builtin_bit_cast(v4i32, At[m][k]), __builtin_bit_cast(v4i32, acc[ai][bj][m][n]), 0, 0, 0)); } \
        else { _Pragma("unroll") for (int k = 0; k < 2; ++k) acc[ai][bj][m][n] = __builtin_amdgcn_mfma_f32_16x16x32_bf16(Bt[n][k], At[m][k], acc[ai][bj][m][n], 0, 0, 0); } } \
        __builtin_amdgcn_s_setprio(0); } while (0)
#define PG8_WAIT_V(n) asm volatile("s_waitcnt vmcnt(" #n ")" ::: "memory")
#define PG8_WAIT_L(n) asm volatile("s_waitcnt lgkmcnt(" #n ")" ::: "memory")
#define PG8_BAR __builtin_amdgcn_s_barrier()
#define PG8_SCHED __builtin_amdgcn_sched_barrier(0)
    Unit cur, nxt; int ui = 0;
    if (!S.next(0, cur)) return;
    f32x4 acc[2][2][4][2];
#pragma unroll
    for (int a = 0; a < 2; ++a)
#pragma unroll
        for (int b = 0; b < 2; ++b)
#pragma unroll
            for (int m = 0; m < 4; ++m)
#pragma unroll
                for (int n = 0; n < 2; ++n) acc[a][b][m][n] = (f32x4){0.f, 0.f, 0.f, 0.f};
    bf16x8 At[4][2], B0[2][2], B1[2][2];
    const char* cA = (const char*)g.A + (size_t)cur.pm * tstepA; const char* cB = (const char*)g.Bt + (size_t)cur.pn * tstep;
    S.a_ready(cur);
    if constexpr (SP2) {
        PG8_STAGE(PG8_SB(0, 0), cB, voffB); PG8_STAGE(PG8_SB(0, 1), cB + hstep, voffB); PG8_STAGE(PG8_SA(0, 0), cA, voffA); PG8_STAGE(PG8_SA(0, 1), cA + hstep, voffA);
        if (wr == 1) PG8_BAR;
        PG8_WAIT_V(2); PG8_BAR;
        PG8_STAGE(PG8_SB(1, 0), cB + kstep, voffB); PG8_STAGE(PG8_SA(1, 0), cA + kstep, voffA); PG8_STAGE(PG8_SB(1, 1), cB + hstep + kstep, voffB);
        PG8_WAIT_V(6); PG8_BAR;
    } else {
        PG8_STAGE(PG8_SB(0, 0), cB, voffB); PG8_STAGE(PG8_SA(0, 0), cA, voffA); PG8_STAGE(PG8_SB(0, 1), cB + hstep, voffB); PG8_STAGE(PG8_SA(0, 1), cA + hstep, voffA);
        if (wr == 1) PG8_BAR;
        PG8_WAIT_V(4); PG8_BAR;
        PG8_STAGE(PG8_SB(1, 0), cB + kstep, voffB); PG8_STAGE(PG8_SA(1, 0), cA + kstep, voffA); PG8_STAGE(PG8_SB(1, 1), cB + hstep + kstep, voffB);
        PG8_WAIT_V(6); PG8_BAR;
    }
    for (;;) {
        const bool has_next = S.next(ui + 1, nxt);
        const char* nA = has_next ? (const char*)g.A + (size_t)nxt.pm * tstepA : cA; const char* nB = has_next ? (const char*)g.Bt + (size_t)nxt.pn * tstep : cB;
        for (int t = 0; t < nt; t += 2) {
            const bool last = (t == nt - 2);
            const char* a1 = cA + (size_t)(t + 1) * kstep;
            const char* a2 = last ? nA : cA + (size_t)(t + 2) * kstep; const char* b2 = last ? nB : cB + (size_t)(t + 2) * kstep;
            const char* a3 = a2 + kstep; const char* b3 = b2 + kstep;
            if (last && has_next) S.a_ready(nxt);
            if constexpr (SP2) {
            PG8_LDB(B0, 0, 0); PG8_LDB(B1, 0, 1); PG8_SCHED; PG8_LDA(At, 0, 0); PG8_STAGE(PG8_SA(1, 1), a1 + hstep, voffA);
            PG8_WAIT_V(8); PG8_WAIT_L(0); PG8_BAR; PG8_MMA(0, 0, At, B0); PG8_MMA(0, 1, At, B1); PG8_BAR; PG8_SCHED;
            PG8_LDA(At, 0, 1); PG8_STAGE(PG8_SB(0, 0), b2, voffB); PG8_STAGE(PG8_SB(0, 1), b2 + hstep, voffB); PG8_STAGE(PG8_SA(0, 0), a2, voffA);
            PG8_WAIT_V(8); PG8_WAIT_L(0); PG8_BAR; PG8_MMA(1, 0, At, B0); PG8_MMA(1, 1, At, B1); PG8_BAR; PG8_SCHED;
            PG8_LDB(B0, 1, 0); PG8_LDB(B1, 1, 1); PG8_SCHED; PG8_LDA(At, 1, 0); PG8_STAGE(PG8_SA(0, 1), a2 + hstep, voffA);
            PG8_WAIT_V(8); PG8_WAIT_L(0); PG8_BAR; PG8_MMA(0, 0, At, B0); PG8_MMA(0, 1, At, B1); PG8_BAR; PG8_SCHED;
            PG8_LDA(At, 1, 1); PG8_STAGE(PG8_SB(1, 0), b3, voffB); PG8_STAGE(PG8_SB(1, 1), b3 + hstep, voffB); PG8_STAGE(PG8_SA(1, 0), a3, voffA);
            PG8_WAIT_V(8); PG8_WAIT_L(0); PG8_BAR; PG8_MMA(1, 0, At, B0); PG8_MMA(1, 1, At, B1); PG8_BAR; PG8_SCHED;
            } else {
            PG8_LDB(B0, 0, 0); PG8_SCHED; PG8_LDA(At, 0, 0); PG8_STAGE(PG8_SA(1, 1), a1 + hstep, voffA);
            PG8_WAIT_L(8); PG8_BAR; PG8_WAIT_L(0); PG8_MMA(0, 0, At, B0); PG8_BAR; PG8_SCHED;
            PG8_LDB(B1, 0, 1); PG8_STAGE(PG8_SB(0, 0), b2, voffB);
            PG8_BAR; PG8_WAIT_L(0); PG8_MMA(0, 1, At, B1); PG8_BAR;
            PG8_LDA(At, 0, 1); PG8_STAGE(PG8_SA(0, 0), a2, voffA);
            PG8_BAR; PG8_WAIT_L(0); PG8_MMA(1, 0, At, B0); PG8_BAR; PG8_SCHED;
            PG8_STAGE(PG8_SB(0, 1), b2 + hstep, voffB);
            PG8_WAIT_V(6); PG8_BAR; PG8_MMA(1, 1, At, B1); PG8_BAR;
            PG8_LDB(B0, 1, 0); PG8_SCHED; PG8_LDA(At, 1, 0); PG8_STAGE(PG8_SA(0, 1), a2 + hstep, voffA);
            PG8_WAIT_L(8); PG8_BAR; PG8_WAIT_L(0); PG8_MMA(0, 0, At, B0); PG8_BAR; PG8_SCHED;
            PG8_LDB(B1, 1, 1); PG8_STAGE(PG8_SB(1, 0), b3, voffB);
            PG8_BAR; PG8_WAIT_L(0); PG8_MMA(0, 1, At, B1); PG8_BAR;
            PG8_LDA(At, 1, 1); PG8_STAGE(PG8_SA(1, 0), a3, voffA);
            PG8_BAR; PG8_WAIT_L(0); PG8_MMA(1, 0, At, B0); PG8_BAR; PG8_SCHED;
            PG8_STAGE(PG8_SB(1, 1), b3 + hstep, voffB);
            PG8_WAIT_V(6); PG8_BAR; PG8_MMA(1, 1, At, B1); PG8_BAR;
            }
        }
        if constexpr (ALIGN_EPI) { if (wr == 0) PG8_BAR; }
        if constexpr (QM == 2) E.dequant(acc, cur, wr, wc, fr, fq);
        if constexpr (!Epi::AFTER_DRAIN) { E(acc, cur, wr, wc, fr, fq); S.done(cur); }
        if (!has_next) break;
#pragma unroll
        for (int a = 0; a < 2; ++a)
#pragma unroll
            for (int b = 0; b < 2; ++b)
#pragma unroll
                for (int m = 0; m < 4; ++m)
#pragma unroll
                    for (int n = 0; n < 2; ++n) acc[a][b][m][n] = (f32x4){0.f, 0.f, 0.f, 0.f};
        cur = nxt; cA = nA; cB = nB; ++ui;
        if constexpr (ALIGN_EPI) { if (wr == 1) PG8_BAR; }
    }
    PG8_WAIT_V(0);
    if constexpr (!ALIGN_EPI) { if (wr == 0) PG8_BAR; }
    PG8_BAR;
    if constexpr (Epi::AFTER_DRAIN) { E.fused(acc, cur, wr, wc, fr, fq, lds, wid, lane); S.done(cur); }
#undef PG8_SA
#undef PG8_SB
#undef PG8_STAGE
#undef PG8_LDA
#undef PG8_LDB
#undef PG8_MMA
#undef PG8_CAT
#undef PG8_WAIT_V
#undef PG8_WAIT_L
#undef PG8_BAR
#undef PG8_SCHED
}
}

namespace fox {
#define LAS3 __attribute__((address_space(3)))
constexpr int D = 128, SEQ = 16384, NH = 32, OPITCH = 4096;
constexpr float SCALE = 0.08838834764831845f;
constexpr float THR = 8.f;
constexpr int NW = 8, QBLK = 32, KVBLK = 64, QB = NW * QBLK;
constexpr int SHM_V = KVBLK * D * 2, SHM_K = KVBLK * D * 2;
constexpr int OFF_WS = 2 * SHM_V + 2 * SHM_K, OFF_BIAS = OFF_WS + NW * 64 * 4, OFF_QW = OFF_BIAS + 2 * 64 * 4, OFF_JLO = OFF_QW + 16, OFF_KEY = OFF_JLO + 2048, OFF_ORD = OFF_KEY + 8192, LDS_BYTES = OFF_ORD + 4096;
constexpr float SKIP_T = 30.f;
typedef unsigned short bf16;
typedef short bf16x8 __attribute__((ext_vector_type(8)));
typedef short s16x4 __attribute__((ext_vector_type(4)));
typedef float f32x16 __attribute__((ext_vector_type(16)));
typedef float f32x4 __attribute__((ext_vector_type(4)));
typedef unsigned u32x4 __attribute__((ext_vector_type(4)));

#define KSWZ(row, colB) ((row) * 256 + ((colB) ^ (((row) & 7) << 4)))
#define SBAR() __builtin_amdgcn_sched_barrier(0)
__device__ __forceinline__ int v_st(int k, int c) { const int kk = (k & ~0xC) | ((k & 4) << 1) | ((k & 8) >> 1); return ((kk >> 3) * 4 + (c >> 5)) * 512 + ((kk & 7) * 32 + (c & 31)) * 2; }
__device__ __forceinline__ int v_rd_base(int lane) { return ((lane & 3) << 3) | (((lane >> 2) & 3) << 6) | (((lane >> 4) & 1) << 5) | (((lane >> 5) & 1) << 8); }
constexpr int v_rd_off(int d0, int ks, int half) { return d0 * 512 + ks * 4096 + half * 2048; }
__device__ __forceinline__ int crow(int r, int hi) { return (r & 3) + 8 * (r >> 2) + 4 * hi; }
__device__ __forceinline__ unsigned cvtpk(float lo, float hi) { unsigned r; asm volatile("v_cvt_pk_bf16_f32 %0, %1, %2" : "=v"(r) : "v"(lo), "v"(hi)); return r; }
__device__ __forceinline__ bf16x8 load8(const bf16* p) { return *reinterpret_cast<const bf16x8*>(p); }
__device__ __forceinline__ void mask_tile(f32x16& p0, f32x16& p1, int dq) {
    const float NEG = -__builtin_inff();
#pragma unroll
    for (int r = 0; r < 16; ++r) {
        const int c = (r & 3) + 8 * (r >> 2);
        if (dq - c < 0) p0[r] = NEG;
        if (dq - c - 32 < 0) p1[r] = NEG;
    }
}
__device__ __forceinline__ void partialSM(f32x16& p0, f32x16& p1, float& m_reg, float& mn, float& alpha) {
    float pmax = p0[0]; for (int r = 1; r < 16; ++r) pmax = fmaxf(pmax, p0[r]); for (int r = 0; r < 16; ++r) pmax = fmaxf(pmax, p1[r]);
    { auto rr = __builtin_amdgcn_permlane32_swap(__float_as_uint(pmax), __float_as_uint(pmax), false, false);
      pmax = fmaxf(__uint_as_float(rr[0]), __uint_as_float(rr[1])); }
    constexpr float C2 = 1.4426950408889634f * SCALE;
    if (__builtin_expect(__all((pmax - m_reg) * SCALE <= THR), 1)) { mn = m_reg; alpha = 1.f; }
    else { mn = fmaxf(m_reg, pmax); alpha = __builtin_amdgcn_exp2f((m_reg - mn) * C2); m_reg = mn; }
    const float mnL = -mn * C2;
    for (int r = 0; r < 16; ++r) p0[r] = fmaf(p0[r], C2, mnL); for (int r = 0; r < 16; ++r) p1[r] = fmaf(p1[r], C2, mnL);
    for (int r = 0; r < 16; ++r) p0[r] = __builtin_amdgcn_exp2f(p0[r]);
}
__device__ __forceinline__ void finishSM(f32x16& p0, f32x16& p1, float alpha, float& l_reg, bf16x8& pa0, bf16x8& pa1, bf16x8& pa2, bf16x8& pa3) {
    for (int r = 0; r < 16; ++r) p1[r] = __builtin_amdgcn_exp2f(p1[r]);
    float ps = 0; for (int r = 0; r < 16; ++r) ps += p0[r]; for (int r = 0; r < 16; ++r) ps += p1[r];
    { auto rr = __builtin_amdgcn_permlane32_swap(__float_as_uint(ps), __float_as_uint(ps), false, false);
      ps = __uint_as_float(rr[0]) + __uint_as_float(rr[1]); }
    l_reg = l_reg * alpha + ps;
#define PK4(P, B_, OUT) do { unsigned a0 = cvtpk(P[B_+0], P[B_+1]), a1 = cvtpk(P[B_+2], P[B_+3]);                          \
        unsigned b0 = cvtpk(P[B_+4], P[B_+5]), b1 = cvtpk(P[B_+6], P[B_+7]);                                             \
        auto r0 = __builtin_amdgcn_permlane32_swap(a0, b0, false, false); auto r1 = __builtin_amdgcn_permlane32_swap(a1, b1, false, false); \
        u32x4 w = {r0[0], r1[0], r0[1], r1[1]}; OUT = *reinterpret_cast<bf16x8*>(&w); } while (0)
    PK4(p0, 0, pa0); PK4(p0, 8, pa1); PK4(p1, 0, pa2); PK4(p1, 8, pa3);
}
template <int KB>
__device__ __forceinline__ void qkt(f32x16& p0, f32x16& p1, const char* K_lds, const char* B_lds, int r32, int hi, const bf16x8* qr) {
    const float* bl = (const float*)B_lds + KB * 64 + 4 * hi;
#pragma unroll
    for (int g = 0; g < 4; ++g) { const f32x4 a = *(const f32x4*)(bl + 8 * g), b = *(const f32x4*)(bl + 32 + 8 * g);
        p0[4 * g + 0] = a[0]; p0[4 * g + 1] = a[1]; p0[4 * g + 2] = a[2]; p0[4 * g + 3] = a[3];
        p1[4 * g + 0] = b[0]; p1[4 * g + 1] = b[1]; p1[4 * g + 2] = b[2]; p1[4 * g + 3] = b[3]; }
    const char* kb[4];
#pragma unroll
    for (int dd = 0; dd < 4; ++dd) kb[dd] = K_lds + KB * SHM_K + KSWZ(r32, (dd * 16 + hi * 8) * 2);
#pragma unroll
    for (int d0 = 0; d0 < 8; ++d0) { const char* a = kb[d0 & 3] + (d0 >> 2) * 128;
        bf16x8 b0 = *reinterpret_cast<const bf16x8*>(a);
        bf16x8 b1 = *reinterpret_cast<const bf16x8*>(a + 32 * 256);
        p0 = __builtin_amdgcn_mfma_f32_32x32x16_bf16(b0, qr[d0], p0, 0, 0, 0);
        p1 = __builtin_amdgcn_mfma_f32_32x32x16_bf16(b1, qr[d0], p1, 0, 0, 0); }
}
template <int VB>
__device__ __forceinline__ void pv_tile(f32x16* o, int vb0, bf16x8 pa0, bf16x8 pa1, bf16x8 pa2, bf16x8 pa3) {
#define TRRD(dst, off) asm volatile("ds_read_b64_tr_b16 %0, %1 offset:%2" : "=&v"(dst) : "v"(vb0), "i"(off) : "memory")
#define PV_D0(d0) do { s16x4 l0, l1, l2, l3, h0, h1, h2, h3; constexpr int b_ = VB * SHM_V + v_rd_off(d0, 0, 0);     \
        TRRD(l0, b_); TRRD(h0, b_ + 2048); TRRD(l1, b_ + 4096); TRRD(h1, b_ + 6144); TRRD(l2, b_ + 8192); TRRD(h2, b_ + 10240); TRRD(l3, b_ + 12288); TRRD(h3, b_ + 14336); \
        asm volatile("s_waitcnt lgkmcnt(0)" ::: "memory"); SBAR();                                                                              \
        o[d0] = __builtin_amdgcn_mfma_f32_32x32x16_bf16((bf16x8){l0[0], l0[1], l0[2], l0[3], h0[0], h0[1], h0[2], h0[3]}, pa0, o[d0], 0, 0, 0);   \
        o[d0] = __builtin_amdgcn_mfma_f32_32x32x16_bf16((bf16x8){l1[0], l1[1], l1[2], l1[3], h1[0], h1[1], h1[2], h1[3]}, pa1, o[d0], 0, 0, 0);   \
        o[d0] = __builtin_amdgcn_mfma_f32_32x32x16_bf16((bf16x8){l2[0], l2[1], l2[2], l2[3], h2[0], h2[1], h2[2], h2[3]}, pa2, o[d0], 0, 0, 0);   \
        o[d0] = __builtin_amdgcn_mfma_f32_32x32x16_bf16((bf16x8){l3[0], l3[1], l3[2], l3[3], h3[0], h3[1], h3[2], h3[3]}, pa3, o[d0], 0, 0, 0); } while (0)
    PV_D0(0); PV_D0(1); PV_D0(2); PV_D0(3);
#undef PV_D0
#undef TRRD
}

struct BlockRef { const bf16* Q; const bf16* K; const bf16* V; const float* C; bf16* O; int P0; int jlo; };
struct Seam {
    bf16x8 qr[8];
    bf16x8 st_v0, st_v1, st_k0, st_k1; float st_b;
};
#define ROW(p, k0, rr) ((p) + (size_t)((k0) + (rr)) * D + sc)
#define VMW() asm volatile("s_waitcnt vmcnt(0)" ::: "memory")
#define VMWN(n) asm volatile("s_waitcnt vmcnt(%0)" :: "i"(n) : "memory")
#define SLOAD_H(Kp, Vp, Cp, k0) do { S.st_v0 = load8(ROW(Vp, k0, sr)); S.st_v1 = load8(ROW(Vp, k0, 32 + sr));              \
                         S.st_k0 = load8(ROW(Kp, k0, sr)); S.st_k1 = load8(ROW(Kp, k0, 32 + sr)); if (tid < 64) S.st_b = (Cp)[(k0) + tid]; } while (0)
#define SWRITE_HK(bf, cr) do { *(bf16x8*)(K_lds + (bf) * SHM_K + kws) = S.st_k0; *(bf16x8*)(K_lds + (bf) * SHM_K + kws + 32 * 256) = S.st_k1; \
                         if (tid < 64) ((float*)B_lds)[(bf) * 64 + tid] = S.st_b - (cr); } while (0)
#define SWRITE_HV(bf) do { *(bf16x8*)(V_lds + (bf) * SHM_V + vst0) = S.st_v0; *(bf16x8*)(V_lds + (bf) * SHM_V + vst1) = S.st_v1; } while (0)
#define SWRITE_H(bf, cr) do { SWRITE_HV(bf); SWRITE_HK(bf, cr); } while (0)
__device__ __forceinline__ void fox_prime(const BlockRef& cur, char* lds, Seam& S) {
    const int tid = mk_tid(), wid = __builtin_amdgcn_readfirstlane(tid >> 6), lane = tid & 63, r32 = lane & 31, hi = lane >> 5;
    const int sr = tid >> 4, sc = (tid & 15) * 8, kws = KSWZ(sr, sc * 2); char* K_lds = lds + 2 * SHM_V; char* B_lds = lds + OFF_BIAS;
    const float cref = __uint_as_float(__builtin_amdgcn_readfirstlane(__float_as_uint(cur.C[cur.P0])));
    for (int d0 = 0; d0 < 8; ++d0) S.qr[d0] = load8(cur.Q + (size_t)(wid * QBLK + r32) * D + d0 * 16 + hi * 8);
    SLOAD_H(cur.K, cur.V, cur.C, cur.jlo * KVBLK); VMW(); SWRITE_HK(0, cref);
    __syncthreads();
}
template <class NextFn> __device__ __forceinline__ BlockRef fox_block(const BlockRef& cur, char* lds, Seam& S, unsigned* qctr, const NextFn& mkref, bool& has_next) {
    const int tid = mk_tid(), wid = __builtin_amdgcn_readfirstlane(tid >> 6), lane = tid & 63, r32 = lane & 31, hi = lane >> 5;
    const int j_lo = cur.jlo, NT = (cur.P0 + QB - 1) / KVBLK + 1 - j_lo;
    unsigned qv = 0u; if (tid == 0) qv = __hip_atomic_fetch_add(qctr, 1u, __ATOMIC_RELAXED, __HIP_MEMORY_SCOPE_AGENT);
    const int qlo = cur.P0 + wid * QBLK, qm = qlo + r32 - 4 * hi;
    char* V_lds = lds; char* K_lds = lds + 2 * SHM_V; char* B_lds = lds + OFF_BIAS;
    float m_reg = -1e30f, l_reg = 0; f32x16 o[4] = {};
    const int sr = tid >> 4, sc = (tid & 15) * 8, vst0 = v_st(sr, sc), vst1 = v_st(32 + sr, sc), kws = KSWZ(sr, sc * 2);
    const int vb0 = (int)(uintptr_t)V_lds + v_rd_base(lane);
    const bf16* Kh = cur.K; const bf16* Vh = cur.V; const float* Ch = cur.C;
    const float cref = __uint_as_float(__builtin_amdgcn_readfirstlane(__float_as_uint(cur.C[cur.P0])));
#define RESC(a) do { if (__any((a) < 1.f)) { for (int d_ = 0; d_ < 4; ++d_) for (int r = 0; r < 16; ++r) o[d_][r] *= (a); } } while (0)
#define KBASE(t) ((j_lo + (t)) * KVBLK)
#define MASKT(P0_, P1_, t) do { const int kb_ = KBASE(t); if (kb_ + KVBLK - 1 > qlo) mask_tile(P0_, P1_, qm - kb_); } while (0)
    constexpr int NQL = 8;
#define SEAM_K0() do { VMWN(NQL); SWRITE_HK(0, crefn); SBAR(); } while (0)
    f32x16 pA0, pA1, pB0, pB1; float mnA, mnB, alA, alB; bf16x8 pa0, pa1, pa2, pa3;
    SWRITE_HV(0); SBAR();
    if (NT > 1) { SLOAD_H(Kh, Vh, Ch, KBASE(1)); }
    SBAR(); qkt<0>(pA0, pA1, K_lds, B_lds, r32, hi, S.qr);
    MASKT(pA0, pA1, 0); partialSM(pA0, pA1, m_reg, mnA, alA);
    if (NT > 1) { VMW(); SWRITE_H(1, cref); }
    if (tid == 0) *(volatile LAS3 unsigned*)(lds + OFF_QW) = qv;
    __syncthreads();
    const unsigned inext = (unsigned)__builtin_amdgcn_readfirstlane((int)*(volatile LAS3 unsigned*)(lds + OFF_QW)); has_next = inext < (unsigned)(NH * (SEQ / QB));
    const BlockRef nxt = has_next ? mkref((int)inext) : cur;
    const float crefn = __uint_as_float(__builtin_amdgcn_readfirstlane(__float_as_uint(nxt.C[nxt.P0]))); const int kbn = nxt.jlo * KVBLK;
#define HALF_STEP(PX0, PX1, mnX, alX, PY0, PY1, alY, t, KB, VB, SB) do {                                                      \
        SBAR(); qkt<KB>(PX0, PX1, K_lds, B_lds, r32, hi, S.qr);                                                               \
        finishSM(PY0, PY1, alY, l_reg, pa0, pa1, pa2, pa3); SBAR();                                                           \
        if ((t) + 1 < NT) { SLOAD_H(Kh, Vh, Ch, KBASE((t) + 1)); SBAR(); }                                                    \
        pv_tile<VB>(o, vb0, pa0, pa1, pa2, pa3); MASKT(PX0, PX1, (t)); partialSM(PX0, PX1, m_reg, mnX, alX);                  \
        __syncthreads();                                                                                                      \
        if ((t) + 1 < NT) { VMW(); SWRITE_H(SB, cref); }                                                                      \
        RESC(alX); __syncthreads(); } while (0)
    for (int t = 1; t + 1 < NT; t += 2) {
        HALF_STEP(pB0, pB1, mnB, alB, pA0, pA1, alA, t, 1, 0, 0);
        HALF_STEP(pA0, pA1, mnA, alA, pB0, pB1, alB, t + 1, 0, 1, 1);
    }
    const bool even = (NT & 1) == 0;
    if (even) { SBAR(); qkt<1>(pB0, pB1, K_lds, B_lds, r32, hi, S.qr); SBAR(); }
    SLOAD_H(nxt.K, nxt.V, nxt.C, kbn); SBAR();
#pragma unroll
    for (int d0 = 0; d0 < 8; ++d0) S.qr[d0] = load8(nxt.Q + (size_t)(wid * QBLK + r32) * D + d0 * 16 + hi * 8);
    SBAR();
    finishSM(pA0, pA1, alA, l_reg, pa0, pa1, pa2, pa3); SBAR();
    pv_tile<0>(o, vb0, pa0, pa1, pa2, pa3);
    if (even) { MASKT(pB0, pB1, NT - 1); partialSM(pB0, pB1, m_reg, mnB, alB); __syncthreads(); RESC(alB);
        finishSM(pB0, pB1, alB, l_reg, pa0, pa1, pa2, pa3); SBAR(); pv_tile<1>(o, vb0, pa0, pa1, pa2, pa3); }
    SBAR(); SEAM_K0();
    {
        const float rl = __builtin_amdgcn_rcpf(l_reg);
        bf16* Ow = cur.O + (size_t)(wid * QBLK + r32) * OPITCH + 8 * hi;
#pragma unroll
        for (int d0 = 0; d0 < 4; ++d0)
#pragma unroll
            for (int gp = 0; gp < 2; ++gp) { const int b_ = 8 * gp;
                const unsigned a0 = cvtpk(o[d0][b_ + 0] * rl, o[d0][b_ + 1] * rl), a1 = cvtpk(o[d0][b_ + 2] * rl, o[d0][b_ + 3] * rl);
                const unsigned b0 = cvtpk(o[d0][b_ + 4] * rl, o[d0][b_ + 5] * rl), b1 = cvtpk(o[d0][b_ + 6] * rl, o[d0][b_ + 7] * rl);
                auto r0 = __builtin_amdgcn_permlane32_swap(a0, b0, false, false); auto r1 = __builtin_amdgcn_permlane32_swap(a1, b1, false, false);
                u32x4 w = {r0[0], r1[0], r0[1], r1[1]}; *(u32x4*)(Ow + d0 * 32 + 16 * gp) = w; }
    }
    __syncthreads();
    return nxt;
#undef RESC
#undef KBASE
#undef MASKT
#undef SEAM_K0
#undef HALF_STEP
}
#undef ROW
#undef VMW
#undef VMWN
#undef SLOAD_H
#undef SWRITE_HK
#undef SWRITE_HV
#undef SWRITE_H
#undef PK4

__device__ __forceinline__ BlockRef fox_ref(int item, const bf16* Q, const bf16* K, const bf16* V, const float* Cn, bf16* O, const char* lds) {
    const int e = (int)((const unsigned short*)(lds + OFF_ORD))[item], qb = e & 63, bh = e >> 6;
    BlockRef r; r.Q = Q + ((size_t)bh * SEQ + (size_t)qb * QB) * D; r.K = K + (size_t)bh * SEQ * D; r.V = V + (size_t)bh * SEQ * D; r.C = Cn + (size_t)bh * SEQ;
    r.O = O + (size_t)(qb * QB) * OPITCH + bh * D; r.P0 = qb * QB; r.jlo = (int)((const unsigned char*)(lds + OFF_JLO))[bh * 64 + qb]; return r;
}
__device__ __forceinline__ void fox_attn_phase(char* lds, const bf16* Q, const bf16* K, const bf16* V, const float* Cn, const unsigned* nrm2, unsigned* qctr, bf16* O) {
    const int tid = mk_tid();
    {
        int lo[4], hi[4]; float thr[4]; const float* Cb[4];
#pragma unroll
        for (int k = 0; k < 4; ++k) { const int e = tid + 512 * k, bh = e >> 6, qb = e & 63, P0 = qb * QB; Cb[k] = Cn + (size_t)bh * SEQ;
            const float qn2 = __uint_as_float(nrm2[bh]), kn2 = __uint_as_float(nrm2[32 + bh]);
            const float Dh = SKIP_T * (1.0f / SCALE) + 2.04f * sqrtf(qn2 * kn2) + 1.0f;
            thr[k] = Cb[k][P0] - Dh; lo[k] = 0; hi[k] = P0 / KVBLK; }
#pragma unroll 1
        for (int it = 0; it < 8; ++it) {
            float v[4]; int mid[4];
#pragma unroll
            for (int k = 0; k < 4; ++k) { mid[k] = (lo[k] + hi[k]) >> 1; v[k] = Cb[k][mid[k] * KVBLK + KVBLK - 1]; }
#pragma unroll
            for (int k = 0; k < 4; ++k) if (lo[k] < hi[k]) { if (v[k] < thr[k]) lo[k] = mid[k] + 1; else hi[k] = mid[k]; }
        }
#pragma unroll
        for (int k = 0; k < 4; ++k) ((unsigned char*)(lds + OFF_JLO))[tid + 512 * k] = (unsigned char)lo[k];
        unsigned key[4];
#pragma unroll
        for (int k = 0; k < 4; ++k) { const int e = tid + 512 * k, qb = e & 63; key[k] = (unsigned)(4 * qb + 4 - lo[k]) * 2048u + (unsigned)(2047 - e); ((unsigned*)(lds + OFF_KEY))[e] = key[k]; }
        __syncthreads();
        unsigned rank[4] = {0u, 0u, 0u, 0u};
#pragma unroll 4
        for (int j = 0; j < 512; ++j) { const u32x4 kv = ((const u32x4*)(lds + OFF_KEY))[j];
#pragma unroll
            for (int k = 0; k < 4; ++k) rank[k] += (kv.x > key[k] ? 1u : 0u) + (kv.y > key[k] ? 1u : 0u) + (kv.z > key[k] ? 1u : 0u) + (kv.w > key[k] ? 1u : 0u); }
#pragma unroll
        for (int k = 0; k < 4; ++k) ((unsigned short*)(lds + OFF_ORD))[rank[k]] = (unsigned short)(tid + 512 * k);
    }
    if (tid == 0) *(volatile LAS3 unsigned*)(lds + OFF_QW) = __hip_atomic_fetch_add(qctr, 1u, __ATOMIC_RELAXED, __HIP_MEMORY_SCOPE_AGENT);
    __syncthreads();
    const unsigned i0 = (unsigned)__builtin_amdgcn_readfirstlane((int)*(volatile LAS3 unsigned*)(lds + OFF_QW));
    if (i0 >= (unsigned)(NH * (SEQ / QB))) return;
    __syncthreads();
    auto mk = [=](int item) { return fox_ref(item, Q, K, V, Cn, O, lds); };
    BlockRef cur = mk((int)i0);
    Seam S;
    fox_prime(cur, lds, S);
    for (;;) { bool has_next; const BlockRef nxt = fox_block(cur, lds, S, qctr, mk, has_next); if (!has_next) break; cur = nxt; }
}
#undef LAS3
#undef KSWZ
#undef SBAR
}

namespace swa {
constexpr int SEQ = 16384, QKVP = 5120, OP = 4096;
constexpr int K_OFF = 0, VT_OFF = 32768, VT_PITCH = 528, LI_OFF = VT_OFF + 64 * VT_PITCH, LDS_BYTES = LI_OFF + 8 * 32 * 4;
typedef unsigned short bf16;
typedef short bf16x8 __attribute__((ext_vector_type(8)));
typedef float f32x16 __attribute__((ext_vector_type(16)));
typedef float f32x4 __attribute__((ext_vector_type(4)));
typedef unsigned u32x4 __attribute__((ext_vector_type(4)));
__device__ __forceinline__ int crow(int r, int hi) { return (r & 3) + 8 * (r >> 2) + 4 * hi; }
__device__ __forceinline__ unsigned cvtpk(float lo, float hi) { unsigned r; asm volatile("v_cvt_pk_bf16_f32 %0, %1, %2" : "=v"(r) : "v"(lo), "v"(hi)); return r; }
__device__ __forceinline__ float bf2f(short b) { return __uint_as_float(((unsigned)(unsigned short)b) << 16); }
__device__ __forceinline__ bf16x8 pack8(const float* v) { u32x4 w = {cvtpk(v[0], v[1]), cvtpk(v[2], v[3]), cvtpk(v[4], v[5]), cvtpk(v[6], v[7])}; return *reinterpret_cast<bf16x8*>(&w); }
#define SWA_PK4(P, B_, OUT) do { unsigned a0 = cvtpk(P[B_+0], P[B_+1]), a1 = cvtpk(P[B_+2], P[B_+3]);                          \
        unsigned b0 = cvtpk(P[B_+4], P[B_+5]), b1 = cvtpk(P[B_+6], P[B_+7]);                                             \
        auto r0 = __builtin_amdgcn_permlane32_swap(a0, b0, false, false); auto r1 = __builtin_amdgcn_permlane32_swap(a1, b1, false, false); \
        u32x4 w = {r0[0], r1[0], r0[1], r1[1]}; OUT = *reinterpret_cast<bf16x8*>(&w); } while (0)

__device__ __forceinline__ void swa_attn_phase(char* lds, const bf16* QKV, const float* sinks, const float* cosT, const float* sinT, bf16* O, int wg, int G) {
    const int tid = mk_tid(), wid = __builtin_amdgcn_readfirstlane(tid >> 6), lane = tid & 63, r32 = lane & 31, hi = lane >> 5;
    for (int L = wg; L < 1024; L += G) {
        const int g = L & 7, n = L >> 3;
        __syncthreads();
        {
            const int row = tid >> 1, half = tid & 1, kpos = 128 * (n - 1) + row;
            bf16x8 kc[4], vc[4];
            if (kpos >= 0) {
                const bf16* kp = QKV + (size_t)kpos * QKVP + 4096 + g * 64 + half * 32; const bf16* vp = kp + 512;
#pragma unroll
                for (int c = 0; c < 4; ++c) { kc[c] = *(const bf16x8*)(kp + 8 * c); vc[c] = *(const bf16x8*)(vp + 8 * c); }
                if (half == 0) {
                    const f32x4 c0 = *(const f32x4*)(cosT + (size_t)kpos * 8), c1 = *(const f32x4*)(cosT + (size_t)kpos * 8 + 4);
                    const f32x4 s0 = *(const f32x4*)(sinT + (size_t)kpos * 8), s1 = *(const f32x4*)(sinT + (size_t)kpos * 8 + 4);
                    float o1[8], o2[8];
#pragma unroll
                    for (int i = 0; i < 8; ++i) { const float cs = i < 4 ? c0[i & 3] : c1[i & 3], sn = i < 4 ? s0[i & 3] : s1[i & 3];
                        const float x1 = bf2f(kc[0][i]), x2 = bf2f(kc[1][i]); o1[i] = x1 * cs - x2 * sn; o2[i] = x2 * cs + x1 * sn; }
                    kc[0] = pack8(o1); kc[1] = pack8(o2);
                }
            } else {
#pragma unroll
                for (int c = 0; c < 4; ++c) { kc[c] = (bf16x8){0, 0, 0, 0, 0, 0, 0, 0}; vc[c] = (bf16x8){0, 0, 0, 0, 0, 0, 0, 0}; }
            }
#pragma unroll
            for (int c = 0; c < 4; ++c) { const int chunk = half * 4 + c;
                *(bf16x8*)(lds + K_OFF + row * 128 + ((chunk ^ ((row >> 1) & 7)) << 4)) = kc[c];
#pragma unroll
                for (int j = 0; j < 8; ++j) *(short*)(lds + VT_OFF + (half * 32 + c * 8 + j) * VT_PITCH + row * 2) = vc[c][j]; }
        }
        __syncthreads();
        const int hq = g * 8 + wid; const float sink = sinks[hq];
        for (int a = 0; a < 4; ++a) {
            const int t = 128 * n + 32 * a + r32;
            const bf16* qp = QKV + (size_t)t * QKVP + hq * 64;
            bf16x8 qr[4];
#pragma unroll
            for (int d0 = 0; d0 < 4; ++d0) qr[d0] = *(const bf16x8*)(qp + 16 * d0 + 8 * hi);
            {
                const bf16x8 pr = *(const bf16x8*)(qp + 8 * (1 - hi));
                const f32x4 c0 = *(const f32x4*)(cosT + (size_t)t * 8), c1 = *(const f32x4*)(cosT + (size_t)t * 8 + 4);
                const f32x4 s0 = *(const f32x4*)(sinT + (size_t)t * 8), s1 = *(const f32x4*)(sinT + (size_t)t * 8 + 4);
                float ov[8];
#pragma unroll
                for (int i = 0; i < 8; ++i) { const float cs = i < 4 ? c0[i & 3] : c1[i & 3], sn = i < 4 ? s0[i & 3] : s1[i & 3];
                    const float own = bf2f(qr[0][i]), par = bf2f(pr[i]); ov[i] = own * cs + (hi ? par : -par) * sn; }
                qr[0] = pack8(ov);
            }
            f32x16 p[5];
#pragma unroll
            for (int bi = 0; bi < 5; ++bi) { const int row = 32 * (a + bi) + r32; const char* kb = lds + K_OFF + row * 128; const int sw = (row >> 1) & 7;
                f32x16 acc = {};
#pragma unroll
                for (int d0 = 0; d0 < 4; ++d0) { const bf16x8 kf = *(const bf16x8*)(kb + (((2 * d0 + hi) ^ sw) << 4)); acc = __builtin_amdgcn_mfma_f32_32x32x16_bf16(kf, qr[d0], acc, 0, 0, 0); }
                p[bi] = acc; }
            const float NEG = -__builtin_inff();
#pragma unroll
            for (int r = 0; r < 16; ++r) { const int c = crow(r, hi); if (!(c > r32)) p[0][r] = NEG; if (!(c <= r32)) p[4][r] = NEG; }
            if (n == 0) {
#pragma unroll
                for (int bi = 0; bi < 4; ++bi) if (a + bi < 4) {
#pragma unroll
                    for (int r = 0; r < 16; ++r) p[bi][r] = NEG; }
            }
            float mx = NEG;
#pragma unroll
            for (int bi = 0; bi < 5; ++bi)
#pragma unroll
                for (int r = 0; r < 16; ++r) mx = fmaxf(mx, p[bi][r]);
            { auto rr = __builtin_amdgcn_permlane32_swap(__float_as_uint(mx), __float_as_uint(mx), false, false); mx = fmaxf(__uint_as_float(rr[0]), __uint_as_float(rr[1])); }
            const float m = fmaxf(mx * 0.125f, sink);
            constexpr float LOG2E = 1.4426950408889634f, C2 = 0.125f * LOG2E;
            const float mL = -m * LOG2E;
            float ps = 0.f;
#pragma unroll
            for (int bi = 0; bi < 5; ++bi)
#pragma unroll
                for (int r = 0; r < 16; ++r) { const float e = __builtin_amdgcn_exp2f(fmaf(p[bi][r], C2, mL)); p[bi][r] = e; ps += e; }
            { auto rr = __builtin_amdgcn_permlane32_swap(__float_as_uint(ps), __float_as_uint(ps), false, false); ps = __uint_as_float(rr[0]) + __uint_as_float(rr[1]); }
            const float l = ps + __builtin_amdgcn_exp2f(fmaf(sink, LOG2E, mL));
            f32x16 o[2] = {};
#pragma unroll
            for (int bi = 0; bi < 5; ++bi) { bf16x8 pa[2]; SWA_PK4(p[bi], 0, pa[0]); SWA_PK4(p[bi], 8, pa[1]);
#pragma unroll
                for (int ks = 0; ks < 2; ++ks)
#pragma unroll
                    for (int db = 0; db < 2; ++db) { const bf16x8 vf = *(const bf16x8*)(lds + VT_OFF + (32 * db + r32) * VT_PITCH + (32 * (a + bi) + 16 * ks + 8 * hi) * 2);
                        o[db] = __builtin_amdgcn_mfma_f32_32x32x16_bf16(vf, pa[ks], o[db], 0, 0, 0); } }
            const float rl = __builtin_amdgcn_rcpf(l);
            bf16* Ow = O + (size_t)(128 * n + 32 * a + r32) * OP + hq * 64 + 8 * hi;
#pragma unroll
            for (int db = 0; db < 2; ++db)
#pragma unroll
                for (int gp = 0; gp < 2; ++gp) { const int b_ = 8 * gp;
                    const unsigned a0 = cvtpk(o[db][b_ + 0] * rl, o[db][b_ + 1] * rl), a1 = cvtpk(o[db][b_ + 2] * rl, o[db][b_ + 3] * rl);
                    const unsigned b0 = cvtpk(o[db][b_ + 4] * rl, o[db][b_ + 5] * rl), b1 = cvtpk(o[db][b_ + 6] * rl, o[db][b_ + 7] * rl);
                    auto r0 = __builtin_amdgcn_permlane32_swap(a0, b0, false, false); auto r1 = __builtin_amdgcn_permlane32_swap(a1, b1, false, false);
                    u32x4 w = {r0[0], r1[0], r0[1], r1[1]}; *(u32x4*)(Ow + db * 32 + 16 * gp) = w; }
        }
    }
    __syncthreads();
}
#undef SWA_PK4
}

#define LAS __attribute__((address_space(3)))
#define GAS __attribute__((address_space(1)))
typedef unsigned short bf16;
typedef float f32x4 __attribute__((ext_vector_type(4)));
typedef unsigned u32x4 __attribute__((ext_vector_type(4)));
typedef unsigned u32x2 __attribute__((ext_vector_type(2)));
typedef short bf16x8 __attribute__((ext_vector_type(8)));
constexpr int SEQ = 16384, DM = 4096, DFF = 11008;
constexpr float NORM_EPS = 1e-6f;
__device__ __forceinline__ unsigned cvtpk(float lo, float hi) { unsigned r; asm volatile("v_cvt_pk_bf16_f32 %0, %1, %2" : "=v"(r) : "v"(lo), "v"(hi)); return r; }
__device__ __forceinline__ float bf_lo(unsigned w) { return __uint_as_float(w << 16); }
__device__ __forceinline__ float bf_hi(unsigned w) { return __uint_as_float(w & 0xffff0000u); }
__device__ __forceinline__ float wave_sum(float v) {
#pragma unroll
    for (int o = 1; o < 64; o <<= 1) v += __shfl_xor(v, o);
    return v;
}
__device__ __forceinline__ float gelu_tanh(float x) {
    const float u = 0.7978845608028654f * (x + 0.044715f * x * x * x);
    return x * __builtin_amdgcn_rcpf(1.0f + __builtin_amdgcn_exp2f(-2.8853900817779268f * u));
}
__device__ __forceinline__ void sincos_d(double a, double& s, double& c) {
    const double k = rint(a * 0.15915494309189535);
    double r = fma(-k, 6.283185307179586, a); r = fma(-k, 2.4492935982947064e-16, r);
    const double r2 = r * r; double ss = 1.0, cc = 1.0;
#pragma unroll
    for (int n = 29; n >= 3; n -= 2) ss = fma(-ss * r2, 1.0 / (double)(n * (n - 1)), 1.0);
#pragma unroll
    for (int n = 28; n >= 2; n -= 2) cc = fma(-cc * r2, 1.0 / (double)(n * (n - 1)), 1.0);
    s = r * ss; c = cc;
}
__device__ __forceinline__ double exp_d(double x) {
    const double k = rint(x * 1.4426950408889634);
    double r = fma(-k, 0.6931471803691238, x); r = fma(-k, 1.9082149292705877e-10, r);
    double p = 1.0;
#pragma unroll
    for (int n = 16; n >= 1; --n) p = fma(p * r, 1.0 / (double)n, 1.0);
    return ldexp(p, (int)k);
}

__device__ __forceinline__ void transpose_item(const float* __restrict__ W, int K, int N, bf16* __restrict__ WT, int mode, LAS unsigned* scr, int item, int lane) {
    const int nblk = (N + 63) / 64, kb = item / nblk, nb = item - kb * nblk, k0 = 128 * kb, n0 = 64 * nb;
    int r0 = n0; if (mode == 1) { const int bj = n0 >> 12, rem = n0 & 4095; r0 = ((rem >> 7) << 8) + (bj << 7) + (rem & 127); }
    if (mode == 2) { const int bj = n0 >= DFF ? 1 : 0, rem = n0 - bj * DFF; r0 = ((rem >> 7) << 8) + (bj << 7) + (rem & 127); }
    const int c = lane & 15, kq = lane >> 4;
    const bool ok = n0 + 4 * c < N;
    const float* src = W + (size_t)(k0 + 2 * kq) * N + n0 + 4 * c;
    LAS unsigned* sw = scr + (4 * c) * 65 + kq;
#pragma unroll
    for (int half = 0; half < 2; ++half) {
        f32x4 a[8], b[8]; const f32x4 z = {0.f, 0.f, 0.f, 0.f};
#pragma unroll
        for (int p = 0; p < 8; ++p) { const float* s = src + (size_t)(8 * (8 * half + p)) * N;
            a[p] = ok ? __builtin_nontemporal_load((const f32x4*)s) : z; b[p] = ok ? __builtin_nontemporal_load((const f32x4*)(s + N)) : z; }
#pragma unroll
        for (int p = 0; p < 8; ++p)
#pragma unroll
            for (int q = 0; q < 4; ++q) sw[q * 65 + 4 * (8 * half + p)] = cvtpk(a[p][q], b[p][q]);
    }
    asm volatile("s_waitcnt lgkmcnt(0)" ::: "memory");
#pragma unroll
    for (int j = 0; j < 16; ++j) { const int n = 4 * j + kq; const LAS unsigned* s = scr + n * 65 + 4 * c;
        u32x4 o; o.x = s[0]; o.y = s[1]; o.z = s[2]; o.w = s[3];
        if (n0 + n < N) *(u32x4*)(WT + (size_t)(r0 + n) * K + k0 + 8 * c) = o; }
    asm volatile("s_waitcnt lgkmcnt(0)" ::: "memory");
}

__device__ __forceinline__ float f8_clamp(float v) { return __builtin_fminf(__builtin_fmaxf(v, -448.f), 448.f); }
__device__ __forceinline__ unsigned f8_pack4(float a, float b, float c, float d) {
    int w = 0; w = __builtin_amdgcn_cvt_pk_fp8_f32(f8_clamp(a), f8_clamp(b), w, false); w = __builtin_amdgcn_cvt_pk_fp8_f32(f8_clamp(c), f8_clamp(d), w, true); return (unsigned)w; }
__device__ __forceinline__ unsigned i8_pack4(float a, float b, float c, float d) {
    const int q0 = (int)__builtin_rintf(__builtin_fminf(__builtin_fmaxf(a, -127.f), 127.f)), q1 = (int)__builtin_rintf(__builtin_fminf(__builtin_fmaxf(b, -127.f), 127.f));
    const int q2 = (int)__builtin_rintf(__builtin_fminf(__builtin_fmaxf(c, -127.f), 127.f)), q3 = (int)__builtin_rintf(__builtin_fminf(__builtin_fmaxf(d, -127.f), 127.f));
    return ((unsigned)q0 & 255u) | (((unsigned)q1 & 255u) << 8) | (((unsigned)q2 & 255u) << 16) | ((unsigned)q3 << 24); }
__device__ __forceinline__ float wave_max(float v) {
#pragma unroll
    for (int o = 1; o < 64; o <<= 1) v = fmaxf(v, __shfl_xor(v, o));
    return v;
}
__device__ __forceinline__ void transpose_item_f8(const float* __restrict__ W, int K, int N, unsigned char* __restrict__ WT, int mode, LAS unsigned* scr, int item, int lane, float scale, int qm = 1) {
    const int nblk = (N + 63) / 64, kb = item / nblk, nb = item - kb * nblk, k0 = 128 * kb, n0 = 64 * nb;
    int r0 = n0; if (mode == 1) { const int bj = n0 >> 12, rem = n0 & 4095; r0 = ((rem >> 7) << 8) + (bj << 7) + (rem & 127); }
    if (mode == 2) { const int bj = n0 >= DFF ? 1 : 0, rem = n0 - bj * DFF; r0 = ((rem >> 7) << 8) + (bj << 7) + (rem & 127); }
    const int c = lane & 15, kq = lane >> 4;
    const bool ok = n0 + 4 * c < N;
    const float* src = W + (size_t)(k0 + 4 * kq) * N + n0 + 4 * c;
    LAS unsigned* sw = scr + (4 * c) * 33 + kq;
#pragma unroll
    for (int half = 0; half < 2; ++half) {
        f32x4 a[4][4]; const f32x4 z = {0.f, 0.f, 0.f, 0.f};
#pragma unroll
        for (int p = 0; p < 4; ++p)
#pragma unroll
            for (int r = 0; r < 4; ++r) { const float* s = src + (size_t)(16 * (4 * half + p) + r) * N; a[p][r] = ok ? __builtin_nontemporal_load((const f32x4*)s) : z; }
#pragma unroll
        for (int p = 0; p < 4; ++p)
#pragma unroll
            for (int q = 0; q < 4; ++q) sw[q * 33 + 4 * (4 * half + p)] = qm == 2 ? i8_pack4(a[p][0][q] * scale, a[p][1][q] * scale, a[p][2][q] * scale, a[p][3][q] * scale)
                                                                             : f8_pack4(a[p][0][q] * scale, a[p][1][q] * scale, a[p][2][q] * scale, a[p][3][q] * scale);
    }
    asm volatile("s_waitcnt lgkmcnt(0)" ::: "memory");
#pragma unroll
    for (int j = 0; j < 8; ++j) { const int n = 8 * j + (lane >> 3), c8 = lane & 7; const LAS unsigned* s = scr + n * 33 + 4 * c8;
        u32x4 o; o.x = s[0]; o.y = s[1]; o.z = s[2]; o.w = s[3];
        if (n0 + n < N) *(u32x4*)(WT + (size_t)(r0 + n) * K + k0 + 16 * c8) = o; }
    asm volatile("s_waitcnt lgkmcnt(0)" ::: "memory");
}

struct HPlanes { unsigned char* hi; unsigned char* lo; };
template <int HIN, int HOUT>
__device__ __forceinline__ void norm_phase(int gw, int ngw, int lane, LAS unsigned char* stg, const bf16* tmp, const float* gpost, const float* hin, float* hout, HPlanes hp, const float* gpre, bf16* xn, bf16* U, float tscale = 1.0f, unsigned char* xn8 = nullptr, float x8scale = 1.0f, float* rs8 = nullptr) {
    LAS unsigned char* sA = stg;
    for (int m = gw; m < SEQ; m += ngw) {
        f32x4 h[16];
        u32x4 tq[8]; float ss = 0.f;
        if (tmp) { const u32x4* tr = (const u32x4*)(tmp + (size_t)m * DM) + lane;
#pragma unroll
            for (int j = 0; j < 8; ++j) tq[j] = __builtin_nontemporal_load(tr + 64 * j); }
        if constexpr (HIN == 0) {
            const f32x4* hr = (const f32x4*)(hin + (size_t)m * DM) + lane;
#pragma unroll
            for (int j = 0; j < 16; ++j) h[j] = __builtin_nontemporal_load(hr + 64 * j);
        } else {
            const u32x4* hr = (const u32x4*)(hp.hi + (size_t)m * 8192) + lane; const u32x4* lr = (const u32x4*)(hp.lo + (size_t)m * 2048) + lane; u32x4 hq[8], lq[2];
#pragma unroll
            for (int i = 0; i < 8; ++i) hq[i] = __builtin_nontemporal_load(hr + 64 * i);
#pragma unroll
            for (int c = 0; c < 2; ++c) lq[c] = __builtin_nontemporal_load(lr + 64 * c);
#pragma unroll
            for (int j = 0; j < 16; ++j) { const unsigned w0 = hq[j >> 1][2 * (j & 1)], w1 = hq[j >> 1][2 * (j & 1) + 1], lw = lq[j >> 3][(j >> 1) & 3]; const int sh = 16 * (j & 1);
                h[j] = (f32x4){__uint_as_float((w0 << 16) | (((lw >> sh) & 15u) << 12)), __uint_as_float((w0 & 0xffff0000u) | (((lw >> (sh + 4)) & 15u) << 12)),
                               __uint_as_float((w1 << 16) | (((lw >> (sh + 8)) & 15u) << 12)), __uint_as_float((w1 & 0xffff0000u) | (((lw >> (sh + 12)) & 15u) << 12))}; }
        }
        if (tmp) {
#pragma unroll
            for (int j = 0; j < 8; ++j) {
#pragma unroll
                for (int q = 0; q < 4; ++q) { const float a = bf_lo(tq[j][q]), b = bf_hi(tq[j][q]); ss += a * a + b * b; }
                *(LAS u32x4*)(sA + 1024 * j + 16 * lane) = tq[j]; }
            asm volatile("" ::: "memory");
            const float r = tscale / sqrtf(wave_sum(ss) * (1.0f / DM) + NORM_EPS);
            const f32x4* gp = (const f32x4*)gpost + lane; asm volatile("" : "+v"(gp));
#pragma unroll
            for (int j = 0; j < 16; ++j) { const u32x2 w = *(const LAS u32x2*)(sA + 512 * j + 8 * lane); const f32x4 t = {bf_lo(w.x), bf_hi(w.x), bf_lo(w.y), bf_hi(w.y)};
                h[j] = h[j] + (t * r) * gp[64 * j]; }
            asm volatile("" ::: "memory");
            if constexpr (HOUT == 0) { f32x4* ho = (f32x4*)(hout + (size_t)m * DM) + lane;
#pragma unroll
                for (int j = 0; j < 16; ++j) __builtin_nontemporal_store(h[j], ho + 64 * j); }
            if constexpr (HOUT == 1) {
                u32x4* ho = (u32x4*)(hp.hi + (size_t)m * 8192) + lane; u32x4* lo = (u32x4*)(hp.lo + (size_t)m * 2048) + lane; u32x4 lq[2];
#pragma unroll
                for (int i = 0; i < 8; ++i) { u32x4 o; unsigned lw = 0u;
#pragma unroll
                    for (int jj = 0; jj < 2; ++jj) { const int j = 2 * i + jj;
                        const unsigned b0 = __float_as_uint(h[j].x) + 0x800u, b1 = __float_as_uint(h[j].y) + 0x800u, b2 = __float_as_uint(h[j].z) + 0x800u, b3 = __float_as_uint(h[j].w) + 0x800u;
                        o[2 * jj] = __builtin_amdgcn_perm(b1, b0, 0x07060302u); o[2 * jj + 1] = __builtin_amdgcn_perm(b3, b2, 0x07060302u);
                        lw |= (((b0 >> 12) & 15u) | (((b1 >> 12) & 15u) << 4) | (((b2 >> 12) & 15u) << 8) | (((b3 >> 12) & 15u) << 12)) << (16 * jj); }
                    __builtin_nontemporal_store(o, ho + 64 * i); lq[i >> 2][i & 3] = lw; }
#pragma unroll
                for (int c = 0; c < 2; ++c) __builtin_nontemporal_store(lq[c], lo + 64 * c); }
        }
        if (gpre) {
            float s2 = 0.f;
#pragma unroll
            for (int j = 0; j < 16; ++j) s2 += (h[j].x * h[j].x + h[j].y * h[j].y) + (h[j].z * h[j].z + h[j].w * h[j].w);
            const float r = 1.0f / sqrtf(wave_sum(s2) * (1.0f / DM) + NORM_EPS);
            const f32x4* gp = (const f32x4*)gpre + lane; asm volatile("" : "+v"(gp));
            if (xn) { u32x4* o16 = (u32x4*)(xn + (size_t)m * DM) + lane;
                asm volatile("" ::: "memory");
#pragma unroll
                for (int j = 0; j < 16; ++j) { const f32x4 v = (h[j] * r) * gp[64 * j]; u32x2 w; w.x = cvtpk(v.x, v.y); w.y = cvtpk(v.z, v.w); *(LAS u32x2*)(sA + 512 * j + 8 * lane) = w; }
                asm volatile("" ::: "memory");
#pragma unroll
                for (int j = 0; j < 8; ++j) o16[64 * j] = *(const LAS u32x4*)(sA + 1024 * j + 16 * lane);
                asm volatile("" ::: "memory"); }
            if (xn8) { u32x4* o16 = (u32x4*)(xn8 + (size_t)m * DM) + lane; float r8 = r * x8scale;
                if (rs8) { float amax = 0.f;
#pragma unroll
                    for (int j = 0; j < 16; ++j) { const f32x4 v = (h[j] * r) * gp[64 * j]; amax = fmaxf(fmaxf(amax, fmaxf(fabsf(v.x), fabsf(v.y))), fmaxf(fabsf(v.z), fabsf(v.w))); }
                    amax = wave_max(amax); r8 = amax > 0.f ? r * (127.f / amax) : 0.f;
                    if (lane == 0) { rs8[m + 2] = amax * (1.0f / 127.f); if (m == 0) { rs8[0] = 0.f; rs8[1] = 0.f; } }
                    asm volatile("" : "+v"(gp)); }
                asm volatile("" ::: "memory");
#pragma unroll
                for (int j = 0; j < 16; ++j) { const f32x4 v = (h[j] * r8) * gp[64 * j]; *(LAS unsigned*)(sA + 256 * j + 4 * lane) = rs8 ? i8_pack4(v.x, v.y, v.z, v.w) : f8_pack4(v.x, v.y, v.z, v.w); }
                asm volatile("" ::: "memory");
#pragma unroll
                for (int i = 0; i < 4; ++i) o16[64 * i] = *(const LAS u32x4*)(sA + 1024 * i + 16 * lane);
                asm volatile("" ::: "memory"); }
            if (U) {
#pragma unroll
                for (int j = 0; j < 16; ++j) { const f32x4 v = (h[j] * r) * gp[64 * j]; u32x2 w; w.x = cvtpk(v.x, v.y); w.y = cvtpk(v.z, v.w);
                    *(u32x2*)(U + ((size_t)((lane >> 2) + 16 * j) * SEQ + m) * 16 + 4 * (lane & 3)) = w; } }
        }
    }
}

__device__ __forceinline__ void quant_rows_i8(int gw, int ngw, int lane, const bf16* __restrict__ src, unsigned char* __restrict__ dst, float* __restrict__ rs8) {
    for (int m = gw; m < SEQ; m += ngw) {
        const u32x4* sr = (const u32x4*)(src + (size_t)m * DM) + 2 * lane; u32x4 q[8]; float amax = 0.f;
#pragma unroll
        for (int b = 0; b < 4; ++b) { q[2 * b] = __builtin_nontemporal_load(sr + 128 * b); q[2 * b + 1] = __builtin_nontemporal_load(sr + 128 * b + 1); }
#pragma unroll
        for (int i = 0; i < 8; ++i)
#pragma unroll
            for (int c = 0; c < 4; ++c) amax = fmaxf(amax, fmaxf(fabsf(bf_lo(q[i][c])), fabsf(bf_hi(q[i][c]))));
        amax = wave_max(amax); const float sc = amax > 0.f ? 127.f / amax : 0.f;
        if (lane == 0) rs8[m + 2] = amax * (1.0f / 127.f);
        u32x4* o = (u32x4*)(dst + (size_t)m * DM) + lane;
#pragma unroll
        for (int b = 0; b < 4; ++b) { u32x4 w;
#pragma unroll
            for (int c = 0; c < 4; ++c) { const unsigned p0 = q[2 * b + (c >> 1)][2 * (c & 1)], p1 = q[2 * b + (c >> 1)][2 * (c & 1) + 1];
                w[c] = i8_pack4(bf_lo(p0) * sc, bf_hi(p0) * sc, bf_lo(p1) * sc, bf_hi(p1) * sc); }
            __builtin_nontemporal_store(w, o + 64 * b); }
    }
}

__device__ __forceinline__ void fox_cumsum_phase(char* lds, const float* __restrict__ logf, float* __restrict__ cneg, int wg, int G, int tid) {
    double* wtot = (double*)lds; const int lane = tid & 63, wid = tid >> 6;
    for (int h = wg; h < 32; h += G) {
        float v[32]; double s = 0.0;
#pragma unroll
        for (int j = 0; j < 32; ++j) { v[j] = logf[(size_t)(32 * tid + j) * 32 + h]; s += (double)v[j]; }
        double inc = s;
#pragma unroll
        for (int o = 1; o < 64; o <<= 1) { const double t = __shfl_up(inc, o); if (lane >= o) inc += t; }
        __syncthreads();
        if (lane == 63) wtot[wid] = inc;
        __syncthreads();
        double run = inc - s;
#pragma unroll
        for (int w = 0; w < 8; ++w) if (w < wid) run += wtot[w];
#pragma unroll
        for (int j = 0; j < 32; ++j) { run += (double)v[j]; cneg[(size_t)h * SEQ + 32 * tid + j] = (float)(-run * 11.313708498984761); }
    }
}

__device__ __forceinline__ void fox_norms_phase(const bf16* __restrict__ QK, unsigned* nrm2, int gw, int ngw, int lane) {
    for (int base = gw * 128; base < 64 * SEQ; base += ngw * 128) {
        const u32x4* p = (const u32x4*)(QK + (size_t)base * 128) + lane; float mx = 0.f;
#pragma unroll 8
        for (int i = 0; i < 32; ++i) { const u32x4 w = p[(size_t)i * 64]; float s = 0.f;
#pragma unroll
            for (int q = 0; q < 4; ++q) { const float a = bf_lo(w[q]), b = bf_hi(w[q]); s = fmaf(a, a, s); s = fmaf(b, b, s); }
            s += __shfl_xor(s, 1); s += __shfl_xor(s, 2); s += __shfl_xor(s, 4); s += __shfl_xor(s, 8); mx = fmaxf(mx, s); }
        mx = fmaxf(mx, __shfl_xor(mx, 16)); mx = fmaxf(mx, __shfl_xor(mx, 32));
        if (lane == 0) __hip_atomic_fetch_max(nrm2 + base / SEQ, __float_as_uint(mx), __ATOMIC_RELAXED, __HIP_MEMORY_SCOPE_AGENT);
    }
}

namespace s5 {
typedef float f32x16 __attribute__((ext_vector_type(16)));
constexpr int NG = 256, SEGL = 2048, XP = 272, WAVE_BYTES = 2048 + 32 * XP, E_OFF = 8 * WAVE_BYTES, LDS_BYTES = E_OFF + 8 * 128 * 4;
__device__ __forceinline__ bf16x8 pack8(f32x4 a, f32x4 b) { u32x4 w = {cvtpk(a[0], a[1]), cvtpk(a[2], a[3]), cvtpk(b[0], b[1]), cvtpk(b[2], b[3])}; return *reinterpret_cast<bf16x8*>(&w); }
__device__ __forceinline__ void state_consts(float lam_re_raw, float lam_im_raw, double dt, double& lbr, double& lbi, double& cfr, double& cfi, double& lre_o, double& lim_o) {
    const double lre = (double)fminf(lam_re_raw, -1e-4f), lim = (double)lam_im_raw; double sn, cs; sincos_d(lim * dt, sn, cs); const double er = exp_d(lre * dt);
    lbr = er * cs; lbi = er * sn; const double a = lbr - 1.0, b = lbi, den = 1.0 / (lre * lre + lim * lim); cfr = (a * lre + b * lim) * den; cfi = (b * lre - a * lim) * den; lre_o = lre; lim_o = lim;
}
__device__ __forceinline__ void s5_phase(char* lds, const bf16* __restrict__ U, const float* __restrict__ lam_re, const float* __restrict__ lam_im, const float* __restrict__ log_dt,
                                         const float* __restrict__ b_re, const float* __restrict__ b_im, const float* __restrict__ c_re, const float* __restrict__ c_im,
                                         const float* __restrict__ dskip, bf16* __restrict__ Gout, int wg, int G) {
    const int tid = mk_tid(), wid = __builtin_amdgcn_readfirstlane(tid >> 6), lane = tid & 63, r32 = lane & 31, hi = lane >> 5, l15 = lane & 15, q4 = lane >> 4;
    float* ublk = (float*)(lds + wid * WAVE_BYTES); char* xblk = lds + wid * WAVE_BYTES + 2048; float* Ebuf = (float*)(lds + E_OFF);
    for (int g = wg; g < NG; g += G) {
        float lr, li, l2r, l2i; bf16x8 Bf[4], Cf[4]; const float dsk = dskip[16 * g + l15];
        {
            const double dt = exp_d((double)log_dt[g]);
            { double lbr, lbi, cfr, cfi, lre, lim; state_consts(lam_re[g * 64 + lane], lam_im[g * 64 + lane], dt, lbr, lbi, cfr, cfi, lre, lim); lr = (float)lbr; li = (float)lbi;
              double sn2, cs2; sincos_d(lim * dt * (double)SEGL, sn2, cs2); const double e2 = exp_d(lre * dt * (double)SEGL); l2r = (float)(e2 * cs2); l2i = (float)(e2 * sn2); }
#pragma unroll
            for (int sb = 0; sb < 2; ++sb) { const int st = 32 * sb + r32; double lbr, lbi, cfr, cfi, lre, lim; state_consts(lam_re[g * 64 + st], lam_im[g * 64 + st], dt, lbr, lbi, cfr, cfi, lre, lim);
                const f32x4* br = (const f32x4*)(b_re + ((size_t)g * 64 + st) * 16 + 8 * hi); const f32x4* bi = (const f32x4*)(b_im + ((size_t)g * 64 + st) * 16 + 8 * hi);
                const f32x4 vr0 = br[0], vr1 = br[1], vi0 = bi[0], vi1 = bi[1]; f32x4 or0, or1, oi0, oi1;
#pragma unroll
                for (int i = 0; i < 4; ++i) { or0[i] = (float)(cfr * (double)vr0[i] - cfi * (double)vi0[i]); or1[i] = (float)(cfr * (double)vr1[i] - cfi * (double)vi1[i]);
                                              oi0[i] = (float)(cfr * (double)vi0[i] + cfi * (double)vr0[i]); oi1[i] = (float)(cfr * (double)vi1[i] + cfi * (double)vr1[i]); }
                Bf[sb] = pack8(or0, or1); Bf[2 + sb] = pack8(oi0, oi1); }
#pragma unroll
            for (int kk = 0; kk < 4; ++kk) { const float* cp = (kk < 2 ? c_re : c_im) + ((size_t)g * 16 + l15) * 64 + 32 * (kk & 1) + 8 * q4; const float sg = kk < 2 ? 1.f : -1.f;
                const f32x4 v0 = *(const f32x4*)cp, v1 = *(const f32x4*)(cp + 4); Cf[kk] = pack8(v0 * sg, v1 * sg); }
        }
        const bf16* Ug = U + ((size_t)g * SEQ + (size_t)wid * SEGL) * 16;
        float xr = 0.f, xi = 0.f;
#pragma unroll 1
        for (int pass = 0; pass < 2; ++pass) {
#define S5_ULOAD(d0, d1, blk_) do { const u32x4 ub_ = *(const u32x4*)(Ug + ((size_t)(blk_) * 32 + r32) * 16 + 8 * hi);                                                     \
                d0 = (f32x4){bf_lo(ub_.x), bf_hi(ub_.x), bf_lo(ub_.y), bf_hi(ub_.y)}; d1 = (f32x4){bf_lo(ub_.z), bf_hi(ub_.z), bf_lo(ub_.w), bf_hi(ub_.w)}; } while (0)
            f32x4 ua0, ua1; S5_ULOAD(ua0, ua1, 0);
#pragma unroll 1
            for (int blk = 0; blk < SEGL / 32; ++blk) {
                f32x4 un0 = ua0, un1 = ua1;
                if (blk + 1 < SEGL / 32) S5_ULOAD(un0, un1, blk + 1);
                const bf16x8 af = pack8(ua0, ua1);
                if (pass) { *(f32x4*)(ublk + r32 * 16 + 8 * hi) = ua0; *(f32x4*)(ublk + r32 * 16 + 8 * hi + 4) = ua1; }
                f32x16 a0 = {}, a1 = {}, a2 = {}, a3 = {};
                a0 = __builtin_amdgcn_mfma_f32_32x32x16_bf16(af, Bf[0], a0, 0, 0, 0); a1 = __builtin_amdgcn_mfma_f32_32x32x16_bf16(af, Bf[1], a1, 0, 0, 0);
                a2 = __builtin_amdgcn_mfma_f32_32x32x16_bf16(af, Bf[2], a2, 0, 0, 0); a3 = __builtin_amdgcn_mfma_f32_32x32x16_bf16(af, Bf[3], a3, 0, 0, 0);
#pragma unroll
                for (int r = 0; r < 16; ++r) { auto t0 = __builtin_amdgcn_permlane32_swap(__float_as_uint(a0[r]), __float_as_uint(a1[r]), false, false); a0[r] = __uint_as_float(t0[0]); a1[r] = __uint_as_float(t0[1]);
                                               auto t1 = __builtin_amdgcn_permlane32_swap(__float_as_uint(a2[r]), __float_as_uint(a3[r]), false, false); a2[r] = __uint_as_float(t1[0]); a3[r] = __uint_as_float(t1[1]); }
#pragma unroll
                for (int s = 0; s < 32; ++s) { const int h = (s >> 2) & 1, r = (s & 3) + 4 * (s >> 3); const float bre = h ? a1[r] : a0[r], bim = h ? a3[r] : a2[r];
                    const float nr = fmaf(lr, xr, fmaf(-li, xi, bre)), ni = fmaf(lr, xi, fmaf(li, xr, bim)); xr = nr; xi = ni;
                    if (pass) { const unsigned pk = cvtpk(xr, xi); *(unsigned short*)(xblk + s * XP + lane * 2) = (unsigned short)pk; *(unsigned short*)(xblk + s * XP + 128 + lane * 2) = (unsigned short)(pk >> 16); } }
                if (pass) {
#pragma unroll
                    for (int rb = 0; rb < 2; ++rb) { f32x4 acc = {0.f, 0.f, 0.f, 0.f};
#pragma unroll
                        for (int kk = 0; kk < 4; ++kk) { const bf16x8 xa = *(const bf16x8*)(xblk + (16 * rb + l15) * XP + (32 * kk + 8 * q4) * 2); acc = __builtin_amdgcn_mfma_f32_16x16x32_bf16(xa, Cf[kk], acc, 0, 0, 0); }
#pragma unroll
                        for (int i = 0; i < 4; ++i) { const int sl = 16 * rb + 4 * q4 + i; const float uv = ublk[sl * 16 + l15];
                            const float v = gelu_tanh(acc[i] + dsk * uv); const float vn = __shfl_xor(v, 1);
                            if ((l15 & 1) == 0) *(unsigned*)(Gout + ((size_t)wid * SEGL + blk * 32 + sl) * DM + 16 * g + l15) = cvtpk(v, vn); } }
                }
                ua0 = un0; ua1 = un1;
            }
            if (pass == 0) {
                Ebuf[wid * 128 + lane] = xr; Ebuf[wid * 128 + 64 + lane] = xi;
                __syncthreads();
                float sr = 0.f, si = 0.f;
                for (int v = 0; v < wid; ++v) { const float er = Ebuf[v * 128 + lane], ei = Ebuf[v * 128 + 64 + lane];
                    const float nr = fmaf(l2r, sr, fmaf(-l2i, si, er)), ni = fmaf(l2r, si, fmaf(l2i, sr, ei)); sr = nr; si = ni; }
                xr = sr; xi = si;
            }
        }
        __syncthreads();
    }
}
#undef S5_ULOAD
}
#define XB_TMO      128
#define XB_XCNT(j)  (256  + 64 * (j))
#define XB_XSUB(j)  (1280 + 64 * (j))
#define XB_XGEN(j)  (2304 + 64 * (j))
#define XB_TOP      3328
#define XB_TOPGEN   3392
#define XCD_BAR_WORDS 3456
#define XB_SPIN_CAP (1u << 18)

__device__ __forceinline__ unsigned xb_ld(unsigned* p)              { return __hip_atomic_load(p, __ATOMIC_RELAXED, __HIP_MEMORY_SCOPE_AGENT); }
__device__ __forceinline__ unsigned xb_add(unsigned* p, unsigned v) { return __hip_atomic_fetch_add(p, v, __ATOMIC_RELAXED, __HIP_MEMORY_SCOPE_AGENT); }
__device__ __forceinline__ unsigned xb_xcc_id() { return (unsigned)__builtin_amdgcn_s_getreg((3 << 11) | 20) & 0xFu; }
#define XB_SPIN(cond, bar) do { unsigned _sp = 0; while (cond) { __builtin_amdgcn_s_sleep(1); \
    if ((++_sp & 255u) == 0u) { if (xb_ld(&(bar)[XB_TMO])) break; if (_sp > XB_SPIN_CAP) { atomicAdd(&(bar)[XB_TMO], 1u); break; } } } } while (0)

struct XcdBarrier {
    unsigned* bar; unsigned x;
    volatile LAS unsigned* st;
};

__device__ __forceinline__ XcdBarrier xcd_barrier_post(unsigned* bar, volatile LAS unsigned* st) {
    XcdBarrier b; b.bar = bar; b.x = xb_xcc_id(); b.st = st;
    if (threadIdx.x == 0) (void)xb_add(&bar[XB_XCNT(b.x)], 1u);
    return b;
}
__device__ __forceinline__ void xcd_barrier_complete(unsigned* bar, unsigned x, unsigned& nloc, unsigned& nx) {
    const unsigned G = gridDim.x * gridDim.y * gridDim.z;
    unsigned sum, cnt, mine, sp = 0u;
    for (;;) {
        sum = 0u; cnt = 0u; mine = 0u;
#pragma unroll
        for (unsigned j = 0; j < 16; ++j) { const unsigned c = xb_ld(&bar[XB_XCNT(j)]); sum += c; cnt += (c > 0u) ? 1u : 0u; mine = (j == x) ? c : mine; }
        if (sum == G) break;
        __builtin_amdgcn_s_sleep(1);
        if ((++sp & 255u) == 0u) { if (xb_ld(&bar[XB_TMO])) break; if (sp > XB_SPIN_CAP) { atomicAdd(&bar[XB_TMO], 1u); break; } }
    }
    nloc = mine > 0u ? mine : 1u; nx = cnt > 0u ? cnt : 1u;
}

__device__ __forceinline__ void xcd_barrier(const XcdBarrier& b) {
    asm volatile("s_waitcnt vmcnt(0)" ::: "memory");
    __syncthreads();
    if (threadIdx.x == 0) {
        unsigned* bar = b.bar;
        __builtin_amdgcn_s_waitcnt(0);
        unsigned nloc = b.st[0], nx = b.st[1];
        if (nloc == 0u) { xcd_barrier_complete(bar, b.x, nloc, nx); b.st[0] = nloc; b.st[1] = nx; }
        const unsigned old = xb_add(&bar[XB_XSUB(b.x)], 1u);
        const unsigned gen = old / nloc;
        if (old + 1u == (gen + 1u) * nloc) {
            __builtin_amdgcn_fence(__ATOMIC_RELEASE, "agent");
            asm volatile("s_waitcnt vmcnt(0)" ::: "memory");
            const unsigned og = xb_add(&bar[XB_TOP], 1u);
            const unsigned tg = og / nx;
            if (og + 1u == (tg + 1u) * nx) xb_add(&bar[XB_TOPGEN], 1u);
            else XB_SPIN(xb_ld(&bar[XB_TOPGEN]) == tg, bar);
            __builtin_amdgcn_fence(__ATOMIC_ACQUIRE, "agent");
            xb_add(&bar[XB_XGEN(b.x)], 1u);
            asm volatile("s_waitcnt vmcnt(0)" ::: "memory");
        } else {
            XB_SPIN(xb_ld(&bar[XB_XGEN(b.x)]) == gen, bar);
            __builtin_amdgcn_fence(__ATOMIC_ACQUIRE, "agent");
            asm volatile("s_waitcnt vmcnt(0)" ::: "memory");
        }
    }
    __syncthreads();
}

constexpr size_t MiB = (size_t)1 << 20;
constexpr int NTHR = 512, NWAVES = 8;
constexpr int LDS_BYTES = 147456;
constexpr int LDS_MISC = LDS_BYTES - 1024;
__device__ __forceinline__ const float* uptr(const LAS unsigned long long* tab, int i) {
    const unsigned long long v = tab[i]; const unsigned lo = __builtin_amdgcn_readfirstlane((unsigned)v), hi = __builtin_amdgcn_readfirstlane((unsigned)(v >> 32));
    return (const float*)(const GAS float*)(((unsigned long long)hi << 32) | lo);
}
template <class T> __device__ __forceinline__ LAS T* launder_l(LAS T* p) { asm volatile("" : "+s"(p)); return p; }
template <class T> __device__ __forceinline__ T* launder(T* p) { GAS T* q = (GAS T*)p; asm volatile("" : "+s"(q)); return (T*)q; }
static_assert(pg8::STAGE_BYTES <= LDS_MISC && fox::LDS_BYTES <= LDS_MISC && swa::LDS_BYTES <= LDS_MISC && s5::LDS_BYTES <= LDS_MISC, "LDS map");
constexpr size_t WS_CTL = 0, CTL_ZERO_BYTES = 64 * 1024;
constexpr size_t CTL_QCTR = 16384, CTL_NRM2 = 20480;
constexpr size_t WS_ROPE = 1 * MiB;
constexpr size_t WS_W = 2 * MiB;
constexpr size_t W_L0_QKV = WS_W, W_L0_O = W_L0_QKV + 40 * MiB, W_L1_QKVF = W_L0_O + 32 * MiB, W_L1_O = W_L1_QKVF + 98 * MiB, W_L2_GLU = W_L1_O + 32 * MiB,
                 W_L3_QKV = W_L2_GLU + 64 * MiB, W_L3_O = W_L3_QKV + 40 * MiB, W_FFN = W_L3_O + 32 * MiB, W_FFN_STRIDE = 258 * MiB, W_FFN_OUT = 172 * MiB;
constexpr size_t WS_XN = W_FFN + 4 * W_FFN_STRIDE;
constexpr size_t WS_BIG = WS_XN + 129 * MiB;
constexpr size_t WS_Z = WS_BIG, WS_ACT = WS_BIG + 688 * MiB, WS_TMPF = WS_BIG, WS_TMPM = WS_BIG + 688 * MiB;
constexpr size_t WS_SWA_QKV = WS_BIG, WS_SWA_O = WS_BIG + 160 * MiB;
constexpr size_t WS_FOX_QKV = WS_BIG, WS_FOX_O = WS_BIG + 384 * MiB, WS_FOX_LOGF = WS_BIG + 512 * MiB, WS_FOX_CNEG = WS_BIG + 514 * MiB;
constexpr size_t WS_S5_U = WS_BIG + 256 * MiB, WS_S5_G = WS_BIG + 512 * MiB;
constexpr size_t WS_HHI = WS_BIG + 1032 * MiB, WS_HLO = WS_HHI + 128 * MiB;
constexpr size_t WS_RS = WS_HLO + 32 * MiB;
constexpr size_t WS_END = WS_RS + 1 * MiB;
static_assert((size_t)SEQ * 2 * DFF * 2 == 688 * MiB && (size_t)SEQ * DFF * 2 == 344 * MiB && (size_t)12544 * 4096 * 2 == 98 * MiB && (size_t)22016 * 4096 * 2 == 172 * MiB, "sizes");

struct Args { const float* in[56]; float* out; unsigned char* ws; float inv_freq[8]; int ph_lo, ph_hi; };

__global__ void __launch_bounds__(NTHR, 2) mk_fwd(Args args) {
    extern __shared__ __attribute__((aligned(16))) unsigned char lds[];
    if (threadIdx.x < 16) ((LAS unsigned*)((LAS unsigned char*)lds + LDS_MISC))[threadIdx.x] = 0u;
    if (threadIdx.x == 64) { LAS unsigned long long* ptab0 = (LAS unsigned long long*)((LAS unsigned char*)lds + LDS_MISC + 64);
#pragma unroll
        for (int i = 0; i < 56; ++i) ptab0[i] = (unsigned long long)args.in[i]; }
#define IN(i) uptr(ptab, (i))
    __syncthreads();
    XcdBarrier bar = xcd_barrier_post((unsigned*)(args.ws + WS_CTL), (volatile LAS unsigned*)((LAS unsigned char*)lds + LDS_MISC));
    int need_bar = 0;
#if PROBE_WAIT > 0
    unsigned long long probe_acc = 0, probe_t0 = 0;
#define PROBE_SEL(id) (PROBE_ID >= 0 ? (id) == PROBE_ID : ((PROBE_MASK >> ((id) == 1 ? 9 : ((id) - 1) % 9)) & 1))
#define PROBE_T0(id) do { if (PROBE_SEL(id)) probe_t0 = __builtin_amdgcn_s_memrealtime(); } while (0)
#define PROBE_T1(id) do { if (PROBE_SEL(id)) probe_acc += __builtin_amdgcn_s_memrealtime() - probe_t0; } while (0)
#else
#define PROBE_T0(id) do { } while (0)
#define PROBE_T1(id) do { } while (0)
#endif
#define PH_BEGIN(id) if (args.ph_lo <= (id) && (id) < args.ph_hi) { \
        if (need_bar) { PROBE_T0(id); XcdBarrier b2; b2.bar = launder(bar.bar); b2.x = (unsigned)launder_s((int)bar.x); b2.st = bar.st; for (int rb_ = 0; rb_ < REP_BAR; ++rb_) xcd_barrier(b2); PROBE_T1(id); } need_bar = 1; \
        unsigned char* const ws = launder(args.ws); float* const out = launder(args.out); (void)out; \
        LAS unsigned char* const ldsl = launder_l((LAS unsigned char*)lds); char* const ldsg = (char*)ldsl; (void)ldsg; const LAS unsigned long long* const ptab = (const LAS unsigned long long*)(ldsl + LDS_MISC + 64); \
        const int tid = mk_tid(), lane = tid & 63, wave = __builtin_amdgcn_readfirstlane(tid >> 6); (void)lane; (void)wave; \
        const int G = launder_s((int)gridDim.x), bx = launder_s((int)blockIdx.x), vcu = (G % 8 == 0) ? (bx % 8) * (G / 8) + bx / 8 : bx, gw = vcu * NWAVES + wave, ngw = G * NWAVES; (void)gw; (void)ngw; \
        bf16* const XN = (bf16*)(ws + WS_XN + 16384); float* const cosT = (float*)(ws + WS_ROPE); float* const sinT = cosT + SEQ * 8; bf16* const TMPM = (bf16*)(ws + WS_TMPM); bf16* const TMPF = (bf16*)(ws + WS_TMPF); \
        (void)XN; (void)cosT; (void)sinT; (void)TMPM; (void)TMPF; const HPlanes HP{ws + WS_HHI, ws + WS_HLO}; (void)HP; float* const RS8 = (float*)(ws + WS_RS); (void)RS8;
#define PH_END }

    PH_BEGIN(0)
#if PROBE_COPY > 0
      for (int rep = 0; rep < PROBE_COPY; ++rep) {
        typedef PROBE_T pv_t; constexpr int PU = 128 / sizeof(pv_t);
        const pv_t* src = (const pv_t*)(ws + WS_BIG); pv_t* dst = (pv_t*)(ws + WS_BIG + 516 * MiB);
        const size_t n = 512 * MiB / sizeof(pv_t), stride = (size_t)G * NTHR;
        for (size_t i = (size_t)vcu * NTHR + tid; i < n; i += PU * stride) {
            pv_t v[PU];
#pragma unroll
            for (int u = 0; u < PU; ++u) v[u] = PROBE_LD(src + i + u * stride);
#pragma unroll
            for (int u = 0; u < PU; ++u) PROBE_ST(v[u], dst + i + u * stride);
        }
      }
#endif
      for (int rep = 0; rep < REP_PRO; ++rep) {
        LAS unsigned* scr = (LAS unsigned*)(ldsl + wave * 16640);
        constexpr int I_QKV = 32 * 80, I_O = 32 * 64, I_QKVF = 32 * 193, I_GLU = 32 * 128, I_IN = 32 * 344, I_OUT = 86 * 64;
        constexpr int NITEMS = 2 * (I_QKV + I_O) + I_QKVF + I_O + I_GLU + 4 * (I_IN + I_OUT);
        for (int it = gw; it < NITEMS; it += ngw) {
            int r = it;
#define TR(cnt, src, K_, N_, dstoff, mode) if (r < (cnt)) { transpose_item(IN(src), K_, N_, (bf16*)(ws + (dstoff)), mode, scr, r, lane); continue; } r -= (cnt);
            TR(I_QKV, 2, 4096, 5120, W_L0_QKV, 0)
            TR(I_O, 5, 4096, 4096, W_L0_O, 0)
            if (r < I_IN) { transpose_item_f8(IN(9), 4096, 22016, ws + W_FFN, 2, scr, r, lane, pg8::I8_W_SCALE, 2); continue; } r -= I_IN;
            TR(I_OUT, 12, 11008, 4096, W_FFN + W_FFN_OUT, 0)
            if (r < I_QKVF) { transpose_item_f8(IN(15), 4096, 12320, ws + W_L1_QKVF, 0, scr, r, lane, pg8::I8_W_SCALE, 2); continue; } r -= I_QKVF;
            TR(I_O, 17, 4096, 4096, W_L1_O, 0)
            if (r < I_IN) { transpose_item_f8(IN(20), 4096, 22016, ws + W_FFN + W_FFN_STRIDE, 2, scr, r, lane, pg8::I8_W_SCALE, 2); continue; } r -= I_IN;
            TR(I_OUT, 23, 11008, 4096, W_FFN + W_FFN_STRIDE + W_FFN_OUT, 0)
            if (r < I_GLU) { transpose_item_f8(IN(34), 4096, 8192, ws + W_L2_GLU, 1, scr, r, lane, pg8::I8_W_SCALE, 2); continue; } r -= I_GLU;
            if (r < I_IN) { transpose_item_f8(IN(38), 4096, 22016, ws + W_FFN + 2 * W_FFN_STRIDE, 2, scr, r, lane, pg8::I8_W_SCALE, 2); continue; } r -= I_IN;
            TR(I_OUT, 41, 11008, 4096, W_FFN + 2 * W_FFN_STRIDE + W_FFN_OUT, 0)
            TR(I_QKV, 44, 4096, 5120, W_L3_QKV, 0)
            TR(I_O, 47, 4096, 4096, W_L3_O, 0)
            if (r < I_IN) { transpose_item_f8(IN(51), 4096, 22016, ws + W_FFN + 3 * W_FFN_STRIDE, 2, scr, r, lane, pg8::I8_W_SCALE, 2); continue; } r -= I_IN;
            TR(I_OUT, 54, 11008, 4096, W_FFN + 3 * W_FFN_STRIDE + W_FFN_OUT, 0)
#undef TR
        }
        if (vcu == 0) { u32x4* zh = (u32x4*)(ws + WS_XN); const u32x4 zero = {0u, 0u, 0u, 0u}; for (int i = tid; i < 1024; i += NTHR) zh[i] = zero; }
        {
            u32x4* z = (u32x4*)(ws + W_L1_QKVF + (size_t)12320 * 4096); const u32x4 zero = {0u, 0u, 0u, 0u};
            for (int i = vcu * NTHR + tid; i < 224 * 4096 / 16; i += G * NTHR) z[i] = zero;
        }
        for (int i = vcu * NTHR + tid; i < SEQ * 8; i += G * NTHR) {
            const int f = i & 7;
            const float fr = f == 0 ? args.inv_freq[0] : f == 1 ? args.inv_freq[1] : f == 2 ? args.inv_freq[2] : f == 3 ? args.inv_freq[3] : f == 4 ? args.inv_freq[4] : f == 5 ? args.inv_freq[5] : f == 6 ? args.inv_freq[6] : args.inv_freq[7];
            const float ang = (float)(i >> 3) * fr; double s, c; sincos_d((double)ang, s, c); cosT[i] = (float)c; sinT[i] = (float)s;
        }
        norm_phase<0, 2>(gw, ngw, lane, ldsl + wave * 16640, nullptr, nullptr, IN(0), nullptr, HPlanes{nullptr, nullptr}, IN(1), XN, nullptr);
      }
    PH_END

#define SEL(a, b, c, d) IN(L == 0 ? (a) : L == 1 ? (b) : L == 2 ? (c) : (d))
    { constexpr int L = 0;

        const int type = L == 3 ? 0 : L, pb = 1 + 9 * L;
        const size_t wffn = W_FFN + (size_t)L * W_FFN_STRIDE;

        PH_BEGIN(pb + 0)
            if (type == 0) {
                pg8::Gemm g{XN, (const bf16*)(ws + (L == 0 ? W_L0_QKV : W_L3_QKV)), SEQ, 5120, 4096}; pg8::StaticOrder S; S.init(SEQ, 5120, G, bx);
                pg8::EpiBf16B E{(bf16*)(ws + WS_SWA_QKV), 5120, L == 0 ? IN(3) : IN(45)};
                for (int rep = 0; rep < REP_MIXG; ++rep) pg8::gemm_phase<pg8::EpiBf16B, pg8::StaticOrder, true, true>(ldsl, g, S, E);
            } else if (type == 1) {
                pg8::Gemm g{XN, (const bf16*)(ws + W_L1_QKVF), SEQ, 12544, 2048}; pg8::StaticOrder S; S.init(SEQ, 12544, G, bx);
                pg8::EpiFox E{(bf16*)(ws + WS_FOX_QKV), (float*)(ws + WS_FOX_LOGF), IN(16), RS8, 1.0f / pg8::I8_W_SCALE};
                for (int rep = 0; rep < REP_MIXG; ++rep) pg8::gemm_phase<pg8::EpiFox, pg8::StaticOrder, true, true, 2>(ldsl, g, S, E);
            } else {
              for (int rep = 0; rep < REP_MIX; ++rep)
                s5::s5_phase(ldsg, (const bf16*)(ws + WS_S5_U), IN(26), IN(27), IN(28), IN(29), IN(30), IN(31), IN(32), IN(33),
                             (bf16*)(ws + WS_S5_G), vcu, G);
            }
        PH_END
        if (type != 2) {
        PH_BEGIN(pb + 1)
          for (int rep = 0; rep < REP_MIX; ++rep) {
            if (type == 0) swa::swa_attn_phase(ldsg, (const bf16*)(ws + WS_SWA_QKV), L == 0 ? IN(4) : IN(46), cosT, sinT, (bf16*)(ws + WS_SWA_O), vcu, G);
            else { fox_cumsum_phase(ldsg, (const float*)(ws + WS_FOX_LOGF), (float*)(ws + WS_FOX_CNEG), vcu, G, tid);
                   if (G > 64) { if (vcu >= 32) fox_norms_phase((const bf16*)(ws + WS_FOX_QKV), (unsigned*)(ws + WS_CTL + CTL_NRM2), (vcu - 32) * NWAVES + wave, (G - 32) * NWAVES, lane); }
                   else fox_norms_phase((const bf16*)(ws + WS_FOX_QKV), (unsigned*)(ws + WS_CTL + CTL_NRM2), gw, ngw, lane); }
          }
        PH_END
        }
        if (type == 1) {
        PH_BEGIN(pb + 2)
            const bf16* q = (const bf16*)(ws + WS_FOX_QKV);
            fox::fox_attn_phase(ldsg, q, q + (size_t)32 * SEQ * 128, q + (size_t)64 * SEQ * 128, (const float*)(ws + WS_FOX_CNEG), (const unsigned*)(ws + WS_CTL + CTL_NRM2), (unsigned*)(ws + WS_CTL + CTL_QCTR), (bf16*)(ws + WS_FOX_O));
#if REP_FOX > 1
            __syncthreads();
            fox::fox_attn_phase(ldsg, q, q + (size_t)32 * SEQ * 128, q + (size_t)64 * SEQ * 128, (const float*)(ws + WS_FOX_CNEG), (const unsigned*)(ws + WS_CTL + CTL_NRM2), (unsigned*)(ws + WS_CTL + CTL_QCTR) + 64, (bf16*)(ws + WS_FOX_O));
#endif
        PH_END
        }
        PH_BEGIN(pb + 3)
            if (type == 2) {
                unsigned char* const A8 = ws + WS_BIG;
                quant_rows_i8(gw, ngw, lane, (const bf16*)(ws + WS_S5_G), A8, RS8);
                { XcdBarrier b2; b2.bar = launder(bar.bar); b2.x = (unsigned)launder_s((int)bar.x); b2.st = bar.st; xcd_barrier(b2); }
                pg8::Gemm g{(const bf16*)A8, (const bf16*)(ws + W_L2_GLU), SEQ, 8192, 2048}; pg8::StaticOrder S; S.init(SEQ, 8192, G, bx);
                pg8::EpiGlu E{TMPM, IN(35), RS8, 1.0f / pg8::I8_W_SCALE};
                for (int rep = 0; rep < REP_MIXG; ++rep) pg8::gemm_phase<pg8::EpiGlu, pg8::StaticOrder, true, true, 2>(ldsl, g, S, E);
            } else {
                pg8::Gemm g{(const bf16*)(ws + (type == 0 ? WS_SWA_O : WS_FOX_O)), (const bf16*)(ws + (L == 0 ? W_L0_O : L == 1 ? W_L1_O : W_L3_O)), SEQ, 4096, 4096};
                pg8::StaticOrder S; S.init(SEQ, 4096, G, bx);
                pg8::EpiBf16B E{TMPM, 4096, L == 0 ? IN(6) : L == 3 ? IN(48) : nullptr};
                for (int rep = 0; rep < REP_MIXG; ++rep) pg8::gemm_phase<pg8::EpiBf16B, pg8::StaticOrder, true, true>(ldsl, g, S, E);
            }
        PH_END
        PH_BEGIN(pb + 4)
          for (int rep = 0; rep < REP_NORM; ++rep)
            if (L == 0 && rep == 0) norm_phase<0, 1>(gw, ngw, lane, ldsl + wave * 16640, TMPM, SEL(7, 18, 36, 49), IN(0), nullptr, HP, SEL(8, 19, 37, 50), nullptr, nullptr, 1.f, (unsigned char*)XN, 1.f, RS8);
            else norm_phase<1, 1>(gw, ngw, lane, ldsl + wave * 16640, TMPM, SEL(7, 18, 36, 49), nullptr, nullptr, HP, SEL(8, 19, 37, 50), nullptr, nullptr, rep ? 0.f : 1.f, (unsigned char*)XN, 1.f, RS8);
        PH_END
        PH_BEGIN(pb + 5)
            pg8::Gemm g{(const bf16*)((const unsigned char*)XN - 2 * 4096), (const bf16*)(ws + wffn), 65 * 256, 2 * DFF, 2048, 254}; pg8::StaticOrder S; S.init(65 * 256, 2 * DFF, G, bx);
            pg8::EpiConvGeglu E{(bf16*)(ws + WS_ACT), SEL(10, 21, 39, 52), SEL(11, 22, 40, 53), ldsl + 131072, DFF, SEQ, RS8, 1.0f / pg8::I8_W_SCALE};
          for (int rep = 0; rep < REP_FFN1; ++rep)
            pg8::gemm_phase<pg8::EpiConvGeglu, pg8::StaticOrder, true, true, 2>(ldsl, g, S, E);
        PH_END
        PH_BEGIN(pb + 7)
            pg8::Gemm g{(const bf16*)(ws + WS_ACT), (const bf16*)(ws + wffn + W_FFN_OUT), SEQ, 4096, DFF}; pg8::StaticOrder S; S.init(SEQ, 4096, G, bx);
            pg8::EpiBf16B E{TMPF, 4096, nullptr};
          for (int rep = 0; rep < REP_FFN2; ++rep)
            pg8::gemm_phase<pg8::EpiBf16B, pg8::StaticOrder, true, true>(ldsl, g, S, E);
        PH_END
        PH_BEGIN(pb + 8)
          for (int rep = 0; rep < REP_NORM; ++rep)
            if (L == 3) { if (rep == 0) norm_phase<1, 0>(gw, ngw, lane, ldsl + wave * 16640, TMPF, SEL(13, 24, 42, 55), nullptr, out, HP, nullptr, nullptr, nullptr, 1.f); }
            else norm_phase<1, 1>(gw, ngw, lane, ldsl + wave * 16640, TMPF, SEL(13, 24, 42, 55), nullptr, nullptr, HP, SEL(14, 25, 43, 43), L == 2 ? XN : nullptr, L == 1 ? (bf16*)(ws + WS_S5_U) : nullptr, rep ? 0.f : 1.f, L == 0 ? (unsigned char*)XN : nullptr, 1.f, L == 0 ? RS8 : nullptr);
        PH_END
    }
    { constexpr int L = 1;

        const int type = L == 3 ? 0 : L, pb = 1 + 9 * L;
        const size_t wffn = W_FFN + (size_t)L * W_FFN_STRIDE;

        PH_BEGIN(pb + 0)
            if (type == 0) {
                pg8::Gemm g{XN, (const bf16*)(ws + (L == 0 ? W_L0_QKV : W_L3_QKV)), SEQ, 5120, 4096}; pg8::StaticOrder S; S.init(SEQ, 5120, G, bx);
                pg8::EpiBf16B E{(bf16*)(ws + WS_SWA_QKV), 5120, L == 0 ? IN(3) : IN(45)};
                for (int rep = 0; rep < REP_MIXG; ++rep) pg8::gemm_phase<pg8::EpiBf16B, pg8::StaticOrder, true, true>(ldsl, g, S, E);
            } else if (type == 1) {
                pg8::Gemm g{XN, (const bf16*)(ws + W_L1_QKVF), SEQ, 12544, 2048}; pg8::StaticOrder S; S.init(SEQ, 12544, G, bx);
                pg8::EpiFox E{(bf16*)(ws + WS_FOX_QKV), (float*)(ws + WS_FOX_LOGF), IN(16), RS8, 1.0f / pg8::I8_W_SCALE};
                for (int rep = 0; rep < REP_MIXG; ++rep) pg8::gemm_phase<pg8::EpiFox, pg8::StaticOrder, true, true, 2>(ldsl, g, S, E);
            } else {
              for (int rep = 0; rep < REP_MIX; ++rep)
                s5::s5_phase(ldsg, (const bf16*)(ws + WS_S5_U), IN(26), IN(27), IN(28), IN(29), IN(30), IN(31), IN(32), IN(33),
                             (bf16*)(ws + WS_S5_G), vcu, G);
            }
        PH_END
        if (type != 2) {
        PH_BEGIN(pb + 1)
          for (int rep = 0; rep < REP_MIX; ++rep) {
            if (type == 0) swa::swa_attn_phase(ldsg, (const bf16*)(ws + WS_SWA_QKV), L == 0 ? IN(4) : IN(46), cosT, sinT, (bf16*)(ws + WS_SWA_O), vcu, G);
            else { fox_cumsum_phase(ldsg, (const float*)(ws + WS_FOX_LOGF), (float*)(ws + WS_FOX_CNEG), vcu, G, tid);
                   if (G > 64) { if (vcu >= 32) fox_norms_phase((const bf16*)(ws + WS_FOX_QKV), (unsigned*)(ws + WS_CTL + CTL_NRM2), (vcu - 32) * NWAVES + wave, (G - 32) * NWAVES, lane); }
                   else fox_norms_phase((const bf16*)(ws + WS_FOX_QKV), (unsigned*)(ws + WS_CTL + CTL_NRM2), gw, ngw, lane); }
          }
        PH_END
        }
        if (type == 1) {
        PH_BEGIN(pb + 2)
            const bf16* q = (const bf16*)(ws + WS_FOX_QKV);
            fox::fox_attn_phase(ldsg, q, q + (size_t)32 * SEQ * 128, q + (size_t)64 * SEQ * 128, (const float*)(ws + WS_FOX_CNEG), (const unsigned*)(ws + WS_CTL + CTL_NRM2), (unsigned*)(ws + WS_CTL + CTL_QCTR), (bf16*)(ws + WS_FOX_O));
#if REP_FOX > 1
            __syncthreads();
            fox::fox_attn_phase(ldsg, q, q + (size_t)32 * SEQ * 128, q + (size_t)64 * SEQ * 128, (const float*)(ws + WS_FOX_CNEG), (const unsigned*)(ws + WS_CTL + CTL_NRM2), (unsigned*)(ws + WS_CTL + CTL_QCTR) + 64, (bf16*)(ws + WS_FOX_O));
#endif
        PH_END
        }
        PH_BEGIN(pb + 3)
            if (type == 2) {
                unsigned char* const A8 = ws + WS_BIG;
                quant_rows_i8(gw, ngw, lane, (const bf16*)(ws + WS_S5_G), A8, RS8);
                { XcdBarrier b2; b2.bar = launder(bar.bar); b2.x = (unsigned)launder_s((int)bar.x); b2.st = bar.st; xcd_barrier(b2); }
                pg8::Gemm g{(const bf16*)A8, (const bf16*)(ws + W_L2_GLU), SEQ, 8192, 2048}; pg8::StaticOrder S; S.init(SEQ, 8192, G, bx);
                pg8::EpiGlu E{TMPM, IN(35), RS8, 1.0f / pg8::I8_W_SCALE};
                for (int rep = 0; rep < REP_MIXG; ++rep) pg8::gemm_phase<pg8::EpiGlu, pg8::StaticOrder, true, true, 2>(ldsl, g, S, E);
            } else {
                pg8::Gemm g{(const bf16*)(ws + (type == 0 ? WS_SWA_O : WS_FOX_O)), (const bf16*)(ws + (L == 0 ? W_L0_O : L == 1 ? W_L1_O : W_L3_O)), SEQ, 4096, 4096};
                pg8::StaticOrder S; S.init(SEQ, 4096, G, bx);
                pg8::EpiBf16B E{TMPM, 4096, L == 0 ? IN(6) : L == 3 ? IN(48) : nullptr};
                for (int rep = 0; rep < REP_MIXG; ++rep) pg8::gemm_phase<pg8::EpiBf16B, pg8::StaticOrder, true, true>(ldsl, g, S, E);
            }
        PH_END
        PH_BEGIN(pb + 4)
          for (int rep = 0; rep < REP_NORM; ++rep)
            if (L == 0 && rep == 0) norm_phase<0, 1>(gw, ngw, lane, ldsl + wave * 16640, TMPM, SEL(7, 18, 36, 49), IN(0), nullptr, HP, SEL(8, 19, 37, 50), nullptr, nullptr, 1.f, (unsigned char*)XN, 1.f, RS8);
            else norm_phase<1, 1>(gw, ngw, lane, ldsl + wave * 16640, TMPM, SEL(7, 18, 36, 49), nullptr, nullptr, HP, SEL(8, 19, 37, 50), nullptr, nullptr, rep ? 0.f : 1.f, (unsigned char*)XN, 1.f, RS8);
        PH_END
        PH_BEGIN(pb + 5)
            pg8::Gemm g{(const bf16*)((const unsigned char*)XN - 2 * 4096), (const bf16*)(ws + wffn), 65 * 256, 2 * DFF, 2048, 254}; pg8::StaticOrder S; S.init(65 * 256, 2 * DFF, G, bx);
            pg8::EpiConvGeglu E{(bf16*)(ws + WS_ACT), SEL(10, 21, 39, 52), SEL(11, 22, 40, 53), ldsl + 131072, DFF, SEQ, RS8, 1.0f / pg8::I8_W_SCALE};
          for (int rep = 0; rep < REP_FFN1; ++rep)
            pg8::gemm_phase<pg8::EpiConvGeglu, pg8::StaticOrder, true, true, 2>(ldsl, g, S, E);
        PH_END
        PH_BEGIN(pb + 7)
            pg8::Gemm g{(const bf16*)(ws + WS_ACT), (const bf16*)(ws + wffn + W_FFN_OUT), SEQ, 4096, DFF}; pg8::StaticOrder S; S.init(SEQ, 4096, G, bx);
            pg8::EpiBf16B E{TMPF, 4096, nullptr};
          for (int rep = 0; rep < REP_FFN2; ++rep)
            pg8::gemm_phase<pg8::EpiBf16B, pg8::StaticOrder, true, true>(ldsl, g, S, E);
        PH_END
        PH_BEGIN(pb + 8)
          for (int rep = 0; rep < REP_NORM; ++rep)
            if (L == 3) { if (rep == 0) norm_phase<1, 0>(gw, ngw, lane, ldsl + wave * 16640, TMPF, SEL(13, 24, 42, 55), nullptr, out, HP, nullptr, nullptr, nullptr, 1.f); }
            else norm_phase<1, 1>(gw, ngw, lane, ldsl + wave * 16640, TMPF, SEL(13, 24, 42, 55), nullptr, nullptr, HP, SEL(14, 25, 43, 43), L == 2 ? XN : nullptr, L == 1 ? (bf16*)(ws + WS_S5_U) : nullptr, rep ? 0.f : 1.f, L == 0 ? (unsigned char*)XN : nullptr, 1.f, L == 0 ? RS8 : nullptr);
        PH_END
    }
    { constexpr int L = 2;

        const int type = L == 3 ? 0 : L, pb = 1 + 9 * L;
        const size_t wffn = W_FFN + (size_t)L * W_FFN_STRIDE;

        PH_BEGIN(pb + 0)
            if (type == 0) {
                pg8::Gemm g{XN, (const bf16*)(ws + (L == 0 ? W_L0_QKV : W_L3_QKV)), SEQ, 5120, 4096}; pg8::StaticOrder S; S.init(SEQ, 5120, G, bx);
                pg8::EpiBf16B E{(bf16*)(ws + WS_SWA_QKV), 5120, L == 0 ? IN(3) : IN(45)};
                for (int rep = 0; rep < REP_MIXG; ++rep) pg8::gemm_phase<pg8::EpiBf16B, pg8::StaticOrder, true, true>(ldsl, g, S, E);
            } else if (type == 1) {
                pg8::Gemm g{XN, (const bf16*)(ws + W_L1_QKVF), SEQ, 12544, 2048}; pg8::StaticOrder S; S.init(SEQ, 12544, G, bx);
                pg8::EpiFox E{(bf16*)(ws + WS_FOX_QKV), (float*)(ws + WS_FOX_LOGF), IN(16), RS8, 1.0f / pg8::I8_W_SCALE};
                for (int rep = 0; rep < REP_MIXG; ++rep) pg8::gemm_phase<pg8::EpiFox, pg8::StaticOrder, true, true, 2>(ldsl, g, S, E);
            } else {
              for (int rep = 0; rep < REP_MIX; ++rep)
                s5::s5_phase(ldsg, (const bf16*)(ws + WS_S5_U), IN(26), IN(27), IN(28), IN(29), IN(30), IN(31), IN(32), IN(33),
                             (bf16*)(ws + WS_S5_G), vcu, G);
            }
        PH_END
        if (type != 2) {
        PH_BEGIN(pb + 1)
          for (int rep = 0; rep < REP_MIX; ++rep) {
            if (type == 0) swa::swa_attn_phase(ldsg, (const bf16*)(ws + WS_SWA_QKV), L == 0 ? IN(4) : IN(46), cosT, sinT, (bf16*)(ws + WS_SWA_O), vcu, G);
            else { fox_cumsum_phase(ldsg, (const float*)(ws + WS_FOX_LOGF), (float*)(ws + WS_FOX_CNEG), vcu, G, tid);
                   if (G > 64) { if (vcu >= 32) fox_norms_phase((const bf16*)(ws + WS_FOX_QKV), (unsigned*)(ws + WS_CTL + CTL_NRM2), (vcu - 32) * NWAVES + wave, (G - 32) * NWAVES, lane); }
                   else fox_norms_phase((const bf16*)(ws + WS_FOX_QKV), (unsigned*)(ws + WS_CTL + CTL_NRM2), gw, ngw, lane); }
          }
        PH_END
        }
        if (type == 1) {
        PH_BEGIN(pb + 2)
            const bf16* q = (const bf16*)(ws + WS_FOX_QKV);
            fox::fox_attn_phase(ldsg, q, q + (size_t)32 * SEQ * 128, q + (size_t)64 * SEQ * 128, (const float*)(ws + WS_FOX_CNEG), (const unsigned*)(ws + WS_CTL + CTL_NRM2), (unsigned*)(ws + WS_CTL + CTL_QCTR), (bf16*)(ws + WS_FOX_O));
#if REP_FOX > 1
            __syncthreads();
            fox::fox_attn_phase(ldsg, q, q + (size_t)32 * SEQ * 128, q + (size_t)64 * SEQ * 128, (const float*)(ws + WS_FOX_CNEG), (const unsigned*)(ws + WS_CTL + CTL_NRM2), (unsigned*)(ws + WS_CTL + CTL_QCTR) + 64, (bf16*)(ws + WS_FOX_O));
#endif
        PH_END
        }
        PH_BEGIN(pb + 3)
            if (type == 2) {
                unsigned char* const A8 = ws + WS_BIG;
                quant_rows_i8(gw, ngw, lane, (const bf16*)(ws + WS_S5_G), A8, RS8);
                { XcdBarrier b2; b2.bar = launder(bar.bar); b2.x = (unsigned)launder_s((int)bar.x); b2.st = bar.st; xcd_barrier(b2); }
                pg8::Gemm g{(const bf16*)A8, (const bf16*)(ws + W_L2_GLU), SEQ, 8192, 2048}; pg8::StaticOrder S; S.init(SEQ, 8192, G, bx);
                pg8::EpiGlu E{TMPM, IN(35), RS8, 1.0f / pg8::I8_W_SCALE};
                for (int rep = 0; rep < REP_MIXG; ++rep) pg8::gemm_phase<pg8::EpiGlu, pg8::StaticOrder, true, true, 2>(ldsl, g, S, E);
            } else {
                pg8::Gemm g{(const bf16*)(ws + (type == 0 ? WS_SWA_O : WS_FOX_O)), (const bf16*)(ws + (L == 0 ? W_L0_O : L == 1 ? W_L1_O : W_L3_O)), SEQ, 4096, 4096};
                pg8::StaticOrder S; S.init(SEQ, 4096, G, bx);
                pg8::EpiBf16B E{TMPM, 4096, L == 0 ? IN(6) : L == 3 ? IN(48) : nullptr};
                for (int rep = 0; rep < REP_MIXG; ++rep) pg8::gemm_phase<pg8::EpiBf16B, pg8::StaticOrder, true, true>(ldsl, g, S, E);
            }
        PH_END
        PH_BEGIN(pb + 4)
          for (int rep = 0; rep < REP_NORM; ++rep)
            if (L == 0 && rep == 0) norm_phase<0, 1>(gw, ngw, lane, ldsl + wave * 16640, TMPM, SEL(7, 18, 36, 49), IN(0), nullptr, HP, SEL(8, 19, 37, 50), nullptr, nullptr, 1.f, (unsigned char*)XN, 1.f, RS8);
            else norm_phase<1, 1>(gw, ngw, lane, ldsl + wave * 16640, TMPM, SEL(7, 18, 36, 49), nullptr, nullptr, HP, SEL(8, 19, 37, 50), nullptr, nullptr, rep ? 0.f : 1.f, (unsigned char*)XN, 1.f, RS8);
        PH_END
        PH_BEGIN(pb + 5)
            pg8::Gemm g{(const bf16*)((const unsigned char*)XN - 2 * 4096), (const bf16*)(ws + wffn), 65 * 256, 2 * DFF, 2048, 254}; pg8::StaticOrder S; S.init(65 * 256, 2 * DFF, G, bx);
            pg8::EpiConvGeglu E{(bf16*)(ws + WS_ACT), SEL(10, 21, 39, 52), SEL(11, 22, 40, 53), ldsl + 131072, DFF, SEQ, RS8, 1.0f / pg8::I8_W_SCALE};
          for (int rep = 0; rep < REP_FFN1; ++rep)
            pg8::gemm_phase<pg8::EpiConvGeglu, pg8::StaticOrder, true, true, 2>(ldsl, g, S, E);
        PH_END
        PH_BEGIN(pb + 7)
            pg8::Gemm g{(const bf16*)(ws + WS_ACT), (const bf16*)(ws + wffn + W_FFN_OUT), SEQ, 4096, DFF}; pg8::StaticOrder S; S.init(SEQ, 4096, G, bx);
            pg8::EpiBf16B E{TMPF, 4096, nullptr};
          for (int rep = 0; rep < REP_FFN2; ++rep)
            pg8::gemm_phase<pg8::EpiBf16B, pg8::StaticOrder, true, true>(ldsl, g, S, E);
        PH_END
        PH_BEGIN(pb + 8)
          for (int rep = 0; rep < REP_NORM; ++rep)
            if (L == 3) { if (rep == 0) norm_phase<1, 0>(gw, ngw, lane, ldsl + wave * 16640, TMPF, SEL(13, 24, 42, 55), nullptr, out, HP, nullptr, nullptr, nullptr, 1.f); }
            else norm_phase<1, 1>(gw, ngw, lane, ldsl + wave * 16640, TMPF, SEL(13, 24, 42, 55), nullptr, nullptr, HP, SEL(14, 25, 43, 43), L == 2 ? XN : nullptr, L == 1 ? (bf16*)(ws + WS_S5_U) : nullptr, rep ? 0.f : 1.f, L == 0 ? (unsigned char*)XN : nullptr, 1.f, L == 0 ? RS8 : nullptr);
        PH_END
    }
    { constexpr int L = 3;

        const int type = L == 3 ? 0 : L, pb = 1 + 9 * L;
        const size_t wffn = W_FFN + (size_t)L * W_FFN_STRIDE;

        PH_BEGIN(pb + 0)
            if (type == 0) {
                pg8::Gemm g{XN, (const bf16*)(ws + (L == 0 ? W_L0_QKV : W_L3_QKV)), SEQ, 5120, 4096}; pg8::StaticOrder S; S.init(SEQ, 5120, G, bx);
                pg8::EpiBf16B E{(bf16*)(ws + WS_SWA_QKV), 5120, L == 0 ? IN(3) : IN(45)};
                for (int rep = 0; rep < REP_MIXG; ++rep) pg8::gemm_phase<pg8::EpiBf16B, pg8::StaticOrder, true, true>(ldsl, g, S, E);
            } else if (type == 1) {
                pg8::Gemm g{XN, (const bf16*)(ws + W_L1_QKVF), SEQ, 12544, 2048}; pg8::StaticOrder S; S.init(SEQ, 12544, G, bx);
                pg8::EpiFox E{(bf16*)(ws + WS_FOX_QKV), (float*)(ws + WS_FOX_LOGF), IN(16), RS8, 1.0f / pg8::I8_W_SCALE};
                for (int rep = 0; rep < REP_MIXG; ++rep) pg8::gemm_phase<pg8::EpiFox, pg8::StaticOrder, true, true, 2>(ldsl, g, S, E);
            } else {
              for (int rep = 0; rep < REP_MIX; ++rep)
                s5::s5_phase(ldsg, (const bf16*)(ws + WS_S5_U), IN(26), IN(27), IN(28), IN(29), IN(30), IN(31), IN(32), IN(33),
                             (bf16*)(ws + WS_S5_G), vcu, G);
            }
        PH_END
        if (type != 2) {
        PH_BEGIN(pb + 1)
          for (int rep = 0; rep < REP_MIX; ++rep) {
            if (type == 0) swa::swa_attn_phase(ldsg, (const bf16*)(ws + WS_SWA_QKV), L == 0 ? IN(4) : IN(46), cosT, sinT, (bf16*)(ws + WS_SWA_O), vcu, G);
            else { fox_cumsum_phase(ldsg, (const float*)(ws + WS_FOX_LOGF), (float*)(ws + WS_FOX_CNEG), vcu, G, tid);
                   if (G > 64) { if (vcu >= 32) fox_norms_phase((const bf16*)(ws + WS_FOX_QKV), (unsigned*)(ws + WS_CTL + CTL_NRM2), (vcu - 32) * NWAVES + wave, (G - 32) * NWAVES, lane); }
                   else fox_norms_phase((const bf16*)(ws + WS_FOX_QKV), (unsigned*)(ws + WS_CTL + CTL_NRM2), gw, ngw, lane); }
          }
        PH_END
        }
        if (type == 1) {
        PH_BEGIN(pb + 2)
            const bf16* q = (const bf16*)(ws + WS_FOX_QKV);
            fox::fox_attn_phase(ldsg, q, q + (size_t)32 * SEQ * 128, q + (size_t)64 * SEQ * 128, (const float*)(ws + WS_FOX_CNEG), (const unsigned*)(ws + WS_CTL + CTL_NRM2), (unsigned*)(ws + WS_CTL + CTL_QCTR), (bf16*)(ws + WS_FOX_O));
#if REP_FOX > 1
            __syncthreads();
            fox::fox_attn_phase(ldsg, q, q + (size_t)32 * SEQ * 128, q + (size_t)64 * SEQ * 128, (const float*)(ws + WS_FOX_CNEG), (const unsigned*)(ws + WS_CTL + CTL_NRM2), (unsigned*)(ws + WS_CTL + CTL_QCTR) + 64, (bf16*)(ws + WS_FOX_O));
#endif
        PH_END
        }
        PH_BEGIN(pb + 3)
            if (type == 2) {
                unsigned char* const A8 = ws + WS_BIG;
                quant_rows_i8(gw, ngw, lane, (const bf16*)(ws + WS_S5_G), A8, RS8);
                { XcdBarrier b2; b2.bar = launder(bar.bar); b2.x = (unsigned)launder_s((int)bar.x); b2.st = bar.st; xcd_barrier(b2); }
                pg8::Gemm g{(const bf16*)A8, (const bf16*)(ws + W_L2_GLU), SEQ, 8192, 2048}; pg8::StaticOrder S; S.init(SEQ, 8192, G, bx);
                pg8::EpiGlu E{TMPM, IN(35), RS8, 1.0f / pg8::I8_W_SCALE};
                for (int rep = 0; rep < REP_MIXG; ++rep) pg8::gemm_phase<pg8::EpiGlu, pg8::StaticOrder, true, true, 2>(ldsl, g, S, E);
            } else {
                pg8::Gemm g{(const bf16*)(ws + (type == 0 ? WS_SWA_O : WS_FOX_O)), (const bf16*)(ws + (L == 0 ? W_L0_O : L == 1 ? W_L1_O : W_L3_O)), SEQ, 4096, 4096};
                pg8::StaticOrder S; S.init(SEQ, 4096, G, bx);
                pg8::EpiBf16B E{TMPM, 4096, L == 0 ? IN(6) : L == 3 ? IN(48) : nullptr};
                for (int rep = 0; rep < REP_MIXG; ++rep) pg8::gemm_phase<pg8::EpiBf16B, pg8::StaticOrder, true, true>(ldsl, g, S, E);
            }
        PH_END
        PH_BEGIN(pb + 4)
          for (int rep = 0; rep < REP_NORM; ++rep)
            if (L == 0 && rep == 0) norm_phase<0, 1>(gw, ngw, lane, ldsl + wave * 16640, TMPM, SEL(7, 18, 36, 49), IN(0), nullptr, HP, SEL(8, 19, 37, 50), nullptr, nullptr, 1.f, (unsigned char*)XN, 1.f, RS8);
            else norm_phase<1, 1>(gw, ngw, lane, ldsl + wave * 16640, TMPM, SEL(7, 18, 36, 49), nullptr, nullptr, HP, SEL(8, 19, 37, 50), nullptr, nullptr, rep ? 0.f : 1.f, (unsigned char*)XN, 1.f, RS8);
        PH_END
        PH_BEGIN(pb + 5)
            pg8::Gemm g{(const bf16*)((const unsigned char*)XN - 2 * 4096), (const bf16*)(ws + wffn), 65 * 256, 2 * DFF, 2048, 254}; pg8::StaticOrder S; S.init(65 * 256, 2 * DFF, G, bx);
            pg8::EpiConvGeglu E{(bf16*)(ws + WS_ACT), SEL(10, 21, 39, 52), SEL(11, 22, 40, 53), ldsl + 131072, DFF, SEQ, RS8, 1.0f / pg8::I8_W_SCALE};
          for (int rep = 0; rep < REP_FFN1; ++rep)
            pg8::gemm_phase<pg8::EpiConvGeglu, pg8::StaticOrder, true, true, 2>(ldsl, g, S, E);
        PH_END
        PH_BEGIN(pb + 7)
            pg8::Gemm g{(const bf16*)(ws + WS_ACT), (const bf16*)(ws + wffn + W_FFN_OUT), SEQ, 4096, DFF}; pg8::StaticOrder S; S.init(SEQ, 4096, G, bx);
            pg8::EpiBf16B E{TMPF, 4096, nullptr};
          for (int rep = 0; rep < REP_FFN2; ++rep)
            pg8::gemm_phase<pg8::EpiBf16B, pg8::StaticOrder, true, true>(ldsl, g, S, E);
        PH_END
        PH_BEGIN(pb + 8)
          for (int rep = 0; rep < REP_NORM; ++rep)
            if (L == 3) { if (rep == 0) norm_phase<1, 0>(gw, ngw, lane, ldsl + wave * 16640, TMPF, SEL(13, 24, 42, 55), nullptr, out, HP, nullptr, nullptr, nullptr, 1.f); }
            else norm_phase<1, 1>(gw, ngw, lane, ldsl + wave * 16640, TMPF, SEL(13, 24, 42, 55), nullptr, nullptr, HP, SEL(14, 25, 43, 43), L == 2 ? XN : nullptr, L == 1 ? (bf16*)(ws + WS_S5_U) : nullptr, rep ? 0.f : 1.f, L == 0 ? (unsigned char*)XN : nullptr, 1.f, L == 0 ? RS8 : nullptr);
        PH_END
    }
#if PROBE_WAIT > 0
#if PROBE_WG >= 0
    if ((int)blockIdx.x == PROBE_WG) { const unsigned long long ts = __builtin_amdgcn_s_memrealtime(); while (__builtin_amdgcn_s_memrealtime() - ts < probe_acc * PROBE_WAIT) __builtin_amdgcn_s_sleep(8); }
#elif PROBE_WG == -1
    { const unsigned long long ts = __builtin_amdgcn_s_memrealtime(); while (__builtin_amdgcn_s_memrealtime() - ts < probe_acc * PROBE_WAIT) __builtin_amdgcn_s_sleep(8); }
#else
    { const unsigned long long ts = __builtin_amdgcn_s_memrealtime(); const unsigned long long c = 250000ull, w = probe_acc < c ? c - probe_acc : 0ull; while (__builtin_amdgcn_s_memrealtime() - ts < w * PROBE_WAIT) __builtin_amdgcn_s_sleep(8); }
#endif
#endif
#undef SEL
#undef PH_BEGIN
#undef PH_END
#undef IN
}

extern "C" void kernel_launch(void* const* d_in, const int* in_sizes, int n_in, void* d_out, int out_size, void* d_ws, size_t ws_size, hipStream_t stream) {
    static int grid = 0;
    if (grid == 0) {
        if (n_in != 56 || in_sizes[0] != SEQ * DM || out_size != SEQ * DM || ws_size < WS_END) {
            fprintf(stderr, "kernel_launch: built for 56 inputs, x/out of %d floats, >= %zu bytes of workspace; got n_in %d, in0 %d, out %d, ws %zu; nothing launched\n", SEQ * DM, (size_t)WS_END, n_in, n_in > 0 ? in_sizes[0] : -1, out_size, ws_size);
            grid = -1; return; }
        int dev = 0, cus = 0, per_cu = 0;
        if (hipGetDevice(&dev) != hipSuccess || hipDeviceGetAttribute(&cus, hipDeviceAttributeMultiprocessorCount, dev) != hipSuccess) { fprintf(stderr, "kernel_launch: device query failed\n"); grid = -1; return; }
        if (hipFuncSetAttribute((const void*)mk_fwd, hipFuncAttributeMaxDynamicSharedMemorySize, LDS_BYTES) != hipSuccess) { fprintf(stderr, "kernel_launch: hipFuncSetAttribute failed\n"); grid = -1; return; }
        if (hipOccupancyMaxActiveBlocksPerMultiprocessor(&per_cu, (const void*)mk_fwd, NTHR, LDS_BYTES) != hipSuccess || per_cu < 1) { fprintf(stderr, "kernel_launch: occupancy query says %d workgroups per CU\n", per_cu); (void)hipGetLastError(); }
        grid = cus;
    }
    if (grid < 0) return;
    if (hipMemsetAsync((char*)d_ws + WS_CTL, 0, CTL_ZERO_BYTES, stream) != hipSuccess) { fprintf(stderr, "kernel_launch: memset failed\n"); return; }
    Args a{};
    for (int i = 0; i < 56; ++i) a.in[i] = (const float*)d_in[i];
    a.out = (float*)d_out; a.ws = (unsigned char*)d_ws;
    { const float lt = (float)(-std::log(500000.0)); for (int i = 0; i < 8; ++i) { float v = lt * (float)i; v = v * 0.125f; a.inv_freq[i] = (float)std::exp((double)v); } }
#if MK_SPLIT_LAUNCHES
    for (int ph = 0; ph < 37; ++ph) {
        const int L = (ph - 1) / 9, slot = (ph - 1) % 9, type = L == 3 ? 0 : L;
        if (ph > 0 && ((slot == 1 && type == 2) || (slot == 2 && type != 1) || slot == 6)) continue;
        a.ph_lo = ph; a.ph_hi = ph + 1;
        hipLaunchKernelGGL(mk_fwd, dim3(grid), dim3(NTHR), LDS_BYTES, stream, a);
    }
#else
    a.ph_lo = 0; a.ph_hi = 37;
    hipLaunchKernelGGL(mk_fwd, dim3(grid), dim3(NTHR), LDS_BYTES, stream, a);
#endif
    const hipError_t le = hipPeekAtLastError();
    if (le != hipSuccess) fprintf(stderr, "kernel_launch: launch failed: %s (grid %d x %d threads, %d B LDS)\n", hipGetErrorName(le), grid, NTHR, LDS_BYTES);
}
```
